# Optimizing an MI355X kernel written in HIP

```python
import math
import jax, jax.numpy as jnp
from jax import lax
import numpy as np

D_MODEL = 1024
BATCH = 2
SEQ = 8192
DEPTH = 1

N_META = 16
GRID_W = 64
Q_BLOCK = 128
EPS = 1e-6

A_HEADS = 8
A_HEAD_DIM = 64
A_QK_WIDTH = A_HEADS * 2 * A_HEAD_DIM
A_V_WIDTH = A_HEADS * 2 * A_HEAD_DIM

B_HEADS = 8
B_KV_HEADS = 2
B_GROUP = B_HEADS // B_KV_HEADS
B_HEAD_DIM = 128
B_Q_WIDTH = B_HEADS * B_HEAD_DIM
B_KV_WIDTH = B_KV_HEADS * B_HEAD_DIM
ROPE_THETA = 10000.0

SPLITS = (A_QK_WIDTH, A_QK_WIDTH, A_V_WIDTH, B_Q_WIDTH, B_KV_WIDTH, B_KV_WIDTH, D_MODEL, D_MODEL)
IN_WIDTH = sum(SPLITS)

N_EXPERTS = 16
EXPERT_FF = 512
CAPACITY_FACTOR = 2

kernel_name = 'hybrid_diffattn_axialgqa_ecmoe_encoder'


def rms_norm(x, g):
    xf = x.astype(jnp.float32)
    y = xf * lax.rsqrt(jnp.mean(xf * xf, axis=-1, keepdims=True) + EPS)
    return (y * g.astype(jnp.float32)).astype(x.dtype)


def sweep_queries(block_fn, *qs):
    out_meta = block_fn(*[a[:, :N_META] for a in qs])

    def to_blocks(a):
        r = a[:, N_META:]
        n = r.shape[1] // Q_BLOCK
        r = r.reshape((r.shape[0], n, Q_BLOCK) + r.shape[2:])
        return jnp.moveaxis(r, 1, 0)

    out_real = lax.map(lambda args: block_fn(*args), tuple(to_blocks(a) for a in qs))
    out_real = jnp.moveaxis(out_real, 0, 1)
    out_real = out_real.reshape((out_real.shape[0], -1) + out_real.shape[3:])
    return jnp.concatenate([out_meta, out_real], axis=1)


def alibi_slopes(n_heads):
    return jnp.exp2(-8.0 * jnp.arange(1, n_heads + 1, dtype=jnp.float32) / n_heads)


def diff_attention(q, k, v, pos, slopes, lam):
    scale = A_HEAD_DIM ** -0.5
    k_meta = pos < N_META

    def block(qb, pb):
        qp = pb[0]
        s = jnp.einsum('bqhmd,bkhmd->bhmqk', qb, k).astype(jnp.float32) * scale
        dist = jnp.abs(qp[:, None] - pos[None, :]).astype(jnp.float32)
        dist = jnp.where((qp[:, None] < N_META) | k_meta[None, :], 0.0, dist)
        s = s - slopes[None, :, None, None, None] * dist
        p = jax.nn.softmax(s, axis=-1)
        w = p[:, :, 0] - lam * p[:, :, 1]
        return jnp.einsum('bhqk,bkhe->bqhe', w.astype(v.dtype), v)

    return sweep_queries(block, q, pos[None])


def gqa_attention(q, k, v):
    scale = B_HEAD_DIM ** -0.5

    def block(qb):
        s = jnp.einsum('bqngd,bknd->bngqk', qb, k).astype(jnp.float32) * scale
        p = jax.nn.softmax(s, axis=-1)
        return jnp.einsum('bngqk,bknd->bqngd', p.astype(v.dtype), v)

    return sweep_queries(block, q)


def axial_angles(total_len):
    n_tok = total_len - N_META
    rows = n_tok // GRID_W
    row_id = jnp.repeat(jnp.arange(rows, dtype=jnp.int32), GRID_W)
    col_id = jnp.tile(jnp.arange(GRID_W, dtype=jnp.int32), rows)
    zeros = jnp.zeros((N_META,), jnp.int32)
    row_id = jnp.concatenate([zeros, row_id])
    col_id = jnp.concatenate([zeros, col_id])
    half = B_HEAD_DIM // 2
    inv_freq = ROPE_THETA ** (-jnp.arange(0, half, 2, dtype=jnp.float32) / half)
    return (row_id.astype(jnp.float32)[:, None] * inv_freq[None, :],
            col_id.astype(jnp.float32)[:, None] * inv_freq[None, :])


def rotate(x, ang):
    m = ang.shape[-1]
    cos = jnp.cos(ang)[None, :, None, :].astype(x.dtype)
    sin = jnp.sin(ang)[None, :, None, :].astype(x.dtype)
    x1, x2 = x[..., :m], x[..., m:]
    return jnp.concatenate([x1 * cos - x2 * sin, x2 * cos + x1 * sin], axis=-1)


def axial_rope(x, ang_row, ang_col):
    half = x.shape[-1] // 2
    return jnp.concatenate([rotate(x[..., :half], ang_row), rotate(x[..., half:], ang_col)], axis=-1)


def expert_choice_ffn(u, w_router, w_gate, w_up, w_down):
    b, L, d = u.shape
    cap = CAPACITY_FACTOR * L // N_EXPERTS
    logits = jnp.einsum('bld,de->ble', u, w_router).astype(jnp.float32)
    aff = jax.nn.softmax(logits, axis=-1)
    top_aff, top_idx = lax.top_k(jnp.swapaxes(aff, 1, 2), cap)
    xs = jax.vmap(lambda ub, ib: ub[ib])(u, top_idx)
    hid = jax.nn.silu(jnp.einsum('becd,edf->becf', xs, w_gate)) * jnp.einsum('becd,edf->becf', xs, w_up)
    y = jnp.einsum('becf,efd->becd', hid, w_down) * top_aff[..., None].astype(u.dtype)
    return jax.vmap(lambda yb, ib: jnp.zeros((L, d), yb.dtype).at[ib.reshape(-1)].add(yb.reshape(-1, d)))(y, top_idx)


def setup_inputs(seed: int = 0) -> dict:
    key = jax.random.key(seed)
    ks = jax.random.split(key, 24)
    f32 = jnp.float32

    def nrm(k, shape, scale):
        return jax.random.normal(k, shape, f32) * scale

    def gain(k, shape):
        return 1.0 + 0.02 * jax.random.normal(k, shape, f32)

    return {
        'x': nrm(ks[0], (BATCH, SEQ, D_MODEL), 1.0),
        'meta_tokens': nrm(ks[1], (N_META, D_MODEL), 1.0),
        'g_mix': gain(ks[2], (DEPTH, D_MODEL)),
        'w_in': nrm(ks[3], (DEPTH, D_MODEL, IN_WIDTH), D_MODEL ** -0.5),
        'lambda_q1': nrm(ks[4], (DEPTH, A_HEAD_DIM), 0.1),
        'lambda_k1': nrm(ks[5], (DEPTH, A_HEAD_DIM), 0.1),
        'lambda_q2': nrm(ks[6], (DEPTH, A_HEAD_DIM), 0.1),
        'lambda_k2': nrm(ks[7], (DEPTH, A_HEAD_DIM), 0.1),
        'g_subln': gain(ks[8], (DEPTH, 2 * A_HEAD_DIM)),
        'g_qnorm': gain(ks[9], (DEPTH, B_HEAD_DIM)),
        'g_knorm': gain(ks[10], (DEPTH, B_HEAD_DIM)),
        'w_branch_a': nrm(ks[11], (DEPTH, A_V_WIDTH, D_MODEL), A_V_WIDTH ** -0.5),
        'w_branch_b': nrm(ks[12], (DEPTH, B_Q_WIDTH, D_MODEL), B_Q_WIDTH ** -0.5),
        'w_out': nrm(ks[13], (DEPTH, D_MODEL, D_MODEL), D_MODEL ** -0.5),
        'g_ffn': gain(ks[14], (DEPTH, D_MODEL)),
        'w_router': nrm(ks[15], (DEPTH, D_MODEL, N_EXPERTS), D_MODEL ** -0.5),
        'w_gate': nrm(ks[16], (DEPTH, N_EXPERTS, D_MODEL, EXPERT_FF), D_MODEL ** -0.5),
        'w_up': nrm(ks[17], (DEPTH, N_EXPERTS, D_MODEL, EXPERT_FF), D_MODEL ** -0.5),
        'w_down': nrm(ks[18], (DEPTH, N_EXPERTS, EXPERT_FF, D_MODEL), EXPERT_FF ** -0.5),
        'g_final': gain(ks[19], (D_MODEL,)),
    }


def reference(x, meta_tokens, g_mix, w_in, lambda_q1, lambda_k1, lambda_q2, lambda_k2,
              g_subln, g_qnorm, g_knorm, w_branch_a, w_branch_b, w_out, g_ffn,
              w_router, w_gate, w_up, w_down, g_final):
    b = x.shape[0]
    meta = jnp.broadcast_to(meta_tokens[None].astype(x.dtype), (b, N_META, x.shape[-1]))
    h = jnp.concatenate([meta, x], axis=1)
    L = h.shape[1]
    pos = jnp.arange(L, dtype=jnp.int32)
    ang_row, ang_col = axial_angles(L)
    slopes = alibi_slopes(A_HEADS)
    cut = list(np.cumsum(SPLITS)[:-1])

    for layer in range(DEPTH):
        u = rms_norm(h, g_mix[layer])
        z = jnp.einsum('bld,df->blf', u, w_in[layer])
        qa, ka, va, qb, kb, vb, ga, gb = jnp.split(z, cut, axis=-1)

        lam_init = 0.8 - 0.6 * math.exp(-0.3 * layer)
        lam = (jnp.exp(jnp.sum(lambda_q1[layer].astype(jnp.float32) * lambda_k1[layer].astype(jnp.float32)))
               - jnp.exp(jnp.sum(lambda_q2[layer].astype(jnp.float32) * lambda_k2[layer].astype(jnp.float32)))
               + lam_init)
        oa = diff_attention(qa.reshape(b, L, A_HEADS, 2, A_HEAD_DIM),
                            ka.reshape(b, L, A_HEADS, 2, A_HEAD_DIM),
                            va.reshape(b, L, A_HEADS, 2 * A_HEAD_DIM), pos, slopes, lam)
        oa = (rms_norm(oa, g_subln[layer]) * (1.0 - lam_init)).reshape(b, L, A_V_WIDTH)

        qh = axial_rope(rms_norm(qb.reshape(b, L, B_HEADS, B_HEAD_DIM), g_qnorm[layer]), ang_row, ang_col)
        kh = axial_rope(rms_norm(kb.reshape(b, L, B_KV_HEADS, B_HEAD_DIM), g_knorm[layer]), ang_row, ang_col)
        ob = gqa_attention(qh.reshape(b, L, B_KV_HEADS, B_GROUP, B_HEAD_DIM), kh,
                           vb.reshape(b, L, B_KV_HEADS, B_HEAD_DIM)).reshape(b, L, B_Q_WIDTH)

        ya = jnp.einsum('blf,fd->bld', oa, w_branch_a[layer])
        yb = jnp.einsum('blf,fd->bld', ob, w_branch_b[layer])
        merged = jax.nn.sigmoid(ga) * ya + jax.nn.sigmoid(gb) * yb
        h = h + jnp.einsum('bld,de->ble', merged, w_out[layer])

        h = h + expert_choice_ffn(rms_norm(h, g_ffn[layer]), w_router[layer], w_gate[layer],
                                  w_up[layer], w_down[layer])

    return rms_norm(h, g_final)[:, N_META:]
```

```cpp
#include <hip/hip_runtime.h>
#include <hip/hip_cooperative_groups.h>
#include <cstdio>
#include <cstdint>
namespace cg = cooperative_groups;

typedef unsigned short bf16_t;
typedef float f32x4 __attribute__((ext_vector_type(4)));
typedef unsigned u32x2 __attribute__((ext_vector_type(2)));
typedef unsigned u32x4 __attribute__((ext_vector_type(4)));

constexpr int NB = 2, SEQ = 8192, DM = 1024, NMETA = 16, LTOT = SEQ + NMETA;
constexpr int MREAL = NB * SEQ;
constexpr int MROWS = MREAL + NB * NMETA;
constexpr int MPAD = 16640;
constexpr int INW = 6656;
constexpr int KEYS = 8256;
constexpr int QROWS = 8256;
constexpr int NEXP = 16, EFF = 512, CAP = 1026, ESLOTS = NB * CAP;
constexpr float EPS = 1e-6f;
constexpr float LOG2E = 1.4426950408889634f;
constexpr float CA = 0.125f * LOG2E;
constexpr float CB = 0.08838834764831845f * LOG2E;
constexpr float LAM_INIT = 0.2f;
constexpr int NTHREADS = 512;
__device__ const float INVF[32] = {1.000000000e+00f, 7.498942614e-01f, 5.623413324e-01f, 4.216965139e-01f, 3.162277639e-01f, 2.371373773e-01f, 1.778279394e-01f, 1.333521307e-01f,
    1.000000015e-01f, 7.498941571e-02f, 5.623413250e-02f, 4.216965288e-02f, 3.162277490e-02f, 2.371373773e-02f, 1.778279431e-02f, 1.333521493e-02f,
    9.999999776e-03f, 7.498941850e-03f, 5.623413250e-03f, 4.216964822e-03f, 3.162277630e-03f, 2.371373586e-03f, 1.778279431e-03f, 1.333521446e-03f,
    1.000000047e-03f, 7.498942432e-04f, 5.623413017e-04f, 4.216965172e-04f, 3.162277571e-04f, 2.371373703e-04f, 1.778279402e-04f, 1.333521504e-04f};

constexpr size_t MiB = 1u << 20;
constexpr size_t OFF_ROPE = 0;
constexpr size_t OFF_LAM = 64 * 1024;
constexpr size_t OFF_AFF = 128 * 1024;
constexpr size_t OFF_IDX = OFF_AFF + (size_t)NB * NEXP * LTOT * 4 + 256;
constexpr size_t OFF_SEL = OFF_IDX + (size_t)NB * NEXP * CAP * 4 + 256;
constexpr size_t OFF_SGM = OFF_SEL + (size_t)NB * LTOT * NEXP * 4 + 256;
constexpr size_t OFF_H2M = OFF_SGM + 32 * 2048 * 2;
constexpr size_t OFF_MISC_END = OFF_H2M + 32 * 1024 * 4;
static_assert(OFF_MISC_END <= 4 * MiB, "misc region");
constexpr size_t OFF_UN = 24 * MiB;
constexpr size_t SZ_ROWS = (size_t)MPAD * DM * 2;
constexpr size_t OFF_OB = OFF_UN + SZ_ROWS + 256;
constexpr size_t OFF_ATT = OFF_OB + SZ_ROWS + 256;
constexpr size_t SZ_QH = (size_t)NB * 8 * QROWS * 128 * 2;
constexpr size_t SZ_KVB = (size_t)NB * 2 * KEYS * 128 * 2;
constexpr size_t OFF_QA = OFF_ATT, OFF_KA = OFF_QA + SZ_QH, OFF_VA = OFF_KA + SZ_QH, OFF_QB = OFF_VA + SZ_QH, OFF_KB = OFF_QB + SZ_QH, OFF_VB = OFF_KB + SZ_KVB;
constexpr size_t OFF_ATT_END = OFF_VB + SZ_KVB;
static_assert(OFF_ATT_END <= 256 * MiB, "workspace");
constexpr size_t OFF_T = OFF_ATT;
constexpr size_t OFF_MERGED = OFF_ATT + 80 * MiB;
constexpr size_t OFF_HID = OFF_MERGED;
constexpr size_t OFF_YB = OFF_ATT;
static_assert(OFF_T + (size_t)MPAD * DM * 4 <= OFF_MERGED && OFF_MERGED + (size_t)NEXP * (ESLOTS + 256) * EFF * 2 <= OFF_ATT_END && OFF_MERGED + SZ_ROWS <= OFF_ATT_END && OFF_YB + (size_t)NEXP * (ESLOTS + 256) * DM * 2 <= OFF_MERGED, "overlay map");

struct Params {
    const float *x, *meta, *g_mix, *w_in, *lq1, *lk1, *lq2, *lk2, *g_subln, *g_qnorm, *g_knorm, *w_ba, *w_bb, *w_out, *g_ffn, *w_router, *w_gate, *w_up, *w_down, *g_final;
    float* out; unsigned char* ws;
};

__device__ __forceinline__ unsigned f2bf(float f) { unsigned u = __builtin_bit_cast(unsigned, f); return (u + 0x7fffu + ((u >> 16) & 1u)) >> 16; }
__device__ __forceinline__ float bf2f(unsigned h) { return __builtin_bit_cast(float, h << 16); }
__device__ __forceinline__ float wave_sum(float v) {
#pragma unroll
    for (int o = 1; o < 64; o <<= 1) v += __shfl_xor(v, o);
    return v;
}
__device__ __forceinline__ float wave_max(float v) {
#pragma unroll
    for (int o = 1; o < 64; o <<= 1) v = fmaxf(v, __shfl_xor(v, o));
    return v;
}
struct RowInfo { int b, t, meta, valid; };
__device__ __forceinline__ RowInfo row_decode(int r) {
    RowInfo ri;
    if (r < MREAL) { ri.b = r >> 13; ri.t = r & (SEQ - 1); ri.meta = 0; ri.valid = 1; }
    else if (r < MROWS) { ri.b = (r - MREAL) >> 4; ri.t = (r - MREAL) & 15; ri.meta = 1; ri.valid = 1; }
    else { ri.b = 0; ri.t = 0; ri.meta = 1; ri.valid = 0; }
    return ri;
}
__device__ __forceinline__ int row_key(const RowInfo& ri) { return ri.meta ? ri.t : 64 + ri.t; }
__device__ __forceinline__ int row_q(const RowInfo& ri) { return ri.meta ? SEQ + ri.t : ri.t; }
__device__ __forceinline__ int row_pos(const RowInfo& ri) { return ri.meta ? ri.t : NMETA + ri.t; }
__device__ __forceinline__ int pos_row(int b, int pos) { return pos < NMETA ? MREAL + b * NMETA + pos : b * SEQ + (pos - NMETA); }
__device__ __forceinline__ const float* h_row(const Params& p, int r) { RowInfo ri = row_decode(r); return ri.meta ? p.meta + (size_t)ri.t * DM : p.x + (size_t)r * DM; }

__device__ void phase0(const Params& p, int vb, int nvb) {
    const int tid = threadIdx.x, lane = tid & 63, wave = tid >> 6;
    const int gt = vb * NTHREADS + tid;
    if (gt < 128 * 32) {
        const int pos = gt >> 5, j = gt & 31;
        const float ang = (float)pos * INVF[j];
        const double xd = (double)ang, kq = __builtin_rint(xd * 0.15915494309189535);
        const double rr = (xd - kq * 6.283185307179586) * 0.25, r2 = rr * rr;
        double sn = 1.0 / 1307674368000.0, cn = 1.0 / 87178291200.0;
        sn = sn * r2 * -1.0 + 1.0 / 6227020800.0; cn = cn * r2 * -1.0 + 1.0 / 479001600.0;
        sn = sn * r2 * -1.0 + 1.0 / 39916800.0;   cn = cn * r2 * -1.0 + 1.0 / 3628800.0;
        sn = sn * r2 * -1.0 + 1.0 / 362880.0;     cn = cn * r2 * -1.0 + 1.0 / 40320.0;
        sn = sn * r2 * -1.0 + 1.0 / 5040.0;       cn = cn * r2 * -1.0 + 1.0 / 720.0;
        sn = sn * r2 * -1.0 + 1.0 / 120.0;        cn = cn * r2 * -1.0 + 1.0 / 24.0;
        sn = sn * r2 * -1.0 + 1.0 / 6.0;          cn = cn * r2 * -1.0 + 0.5;
        sn = (sn * r2 * -1.0 + 1.0) * rr;         cn = cn * r2 * -1.0 + 1.0;
        double s2 = 2.0 * sn * cn, c2 = cn * cn - sn * sn;
        double s4 = 2.0 * s2 * c2, c4 = c2 * c2 - s2 * s2;
        float2 cs; cs.x = (float)c4; cs.y = (float)s4;
        ((float2*)(p.ws + OFF_ROPE))[gt] = cs;
    }
    if (vb == 0 && wave == 0) {
        float a = p.lq1[lane] * p.lk1[lane], c = p.lq2[lane] * p.lk2[lane];
        a = wave_sum(a); c = wave_sum(c);
        if (lane == 0) *(float*)(p.ws + OFF_LAM) = expf(a) - expf(c) + LAM_INIT;
    }
    bf16_t* UN = (bf16_t*)(p.ws + OFF_UN);
    for (int r = vb * 8 + wave; r < MPAD; r += nvb * 8) {
        u32x2* o = (u32x2*)(UN + (size_t)r * DM) + lane;
        if (r >= MROWS) {
#pragma unroll
            for (int j = 0; j < 4; ++j) o[64 * j] = (u32x2){0u, 0u};
            continue;
        }
        const f32x4* xr = (const f32x4*)h_row(p, r) + lane;
        f32x4 v[4]; float s = 0.f;
#pragma unroll
        for (int j = 0; j < 4; ++j) { v[j] = xr[64 * j]; s += (v[j].x * v[j].x + v[j].y * v[j].y) + (v[j].z * v[j].z + v[j].w * v[j].w); }
        const float rstd = 1.0f / sqrtf(wave_sum(s) * (1.0f / DM) + EPS);
#pragma unroll
        for (int j = 0; j < 4; ++j) {
            const f32x4 g = ((const f32x4*)p.g_mix)[lane + 64 * j];
            u32x2 w; w.x = f2bf(v[j].x * rstd * g.x) | (f2bf(v[j].y * rstd * g.y) << 16); w.y = f2bf(v[j].z * rstd * g.z) | (f2bf(v[j].w * rstd * g.w) << 16);
            o[64 * j] = w;
        }
    }
    {
        bf16_t* KA = (bf16_t*)(p.ws + OFF_KA); bf16_t* VA = (bf16_t*)(p.ws + OFF_VA); bf16_t* KB = (bf16_t*)(p.ws + OFF_KB); bf16_t* VB = (bf16_t*)(p.ws + OFF_VB);
        const int per = 48 * 128 / 8;
        for (int i = vb * NTHREADS + tid; i < (16 + 16 + 4 + 4) * per; i += nvb * NTHREADS) {
            const int bh = i / per, o = i % per; bf16_t* base;
            if (bh < 16) base = KA + (size_t)bh * KEYS * 128; else if (bh < 32) base = VA + (size_t)(bh - 16) * KEYS * 128;
            else if (bh < 36) base = KB + (size_t)(bh - 32) * KEYS * 128; else base = VB + (size_t)(bh - 36) * KEYS * 128;
            ((u32x4*)(base + 16 * 128))[o] = (u32x4){0u, 0u, 0u, 0u};
        }
    }
}

constexpr int NG_AS = 16 * 132, NG_BS = 16 * 128, NG_CT = 128 * 129;
template <class ARow, class BVal, class Epi>
__device__ __forceinline__ void ngemm_tile(float* lds, int K, ARow arow, BVal bval, Epi epi) {
    float* As = lds; float* Bs = lds + NG_AS; float* Ct = lds + NG_AS + NG_BS;
    const int tid = threadIdx.x, ty = tid >> 4, tx = tid & 15;
    const int ar = tid >> 2, ak = (tid & 3) * 4; const bf16_t* ap = arow(ar);
    const int bk = tid >> 5, bc = (tid & 31) * 4;
    float acc[4][8];
#pragma unroll
    for (int i = 0; i < 4; ++i)
#pragma unroll
        for (int j = 0; j < 8; ++j) acc[i][j] = 0.f;
    for (int k0 = 0; k0 < K; k0 += 16) {
        u32x2 av = (u32x2){0u, 0u}; if (ap) av = *(const u32x2*)(ap + k0 + ak);
        float b0 = bval(k0 + bk, bc), b1 = bval(k0 + bk, bc + 1), b2 = bval(k0 + bk, bc + 2), b3 = bval(k0 + bk, bc + 3);
        __syncthreads();
        As[(ak + 0) * 132 + ar] = bf2f(av.x & 0xffffu); As[(ak + 1) * 132 + ar] = bf2f(av.x >> 16);
        As[(ak + 2) * 132 + ar] = bf2f(av.y & 0xffffu); As[(ak + 3) * 132 + ar] = bf2f(av.y >> 16);
        *(f32x4*)(Bs + bk * 128 + bc) = (f32x4){b0, b1, b2, b3};
        __syncthreads();
#pragma unroll
        for (int k = 0; k < 16; ++k) {
            const f32x4 a = *(const f32x4*)(As + k * 132 + ty * 4);
            const f32x4 bA = *(const f32x4*)(Bs + k * 128 + tx * 8), bB = *(const f32x4*)(Bs + k * 128 + tx * 8 + 4);
            const float av4[4] = {a.x, a.y, a.z, a.w}; const float bv8[8] = {bA.x, bA.y, bA.z, bA.w, bB.x, bB.y, bB.z, bB.w};
#pragma unroll
            for (int i = 0; i < 4; ++i)
#pragma unroll
                for (int j = 0; j < 8; ++j) acc[i][j] = fmaf(av4[i], bv8[j], acc[i][j]);
        }
    }
    __syncthreads();
#pragma unroll
    for (int i = 0; i < 4; ++i)
#pragma unroll
        for (int j = 0; j < 8; ++j) Ct[(ty * 4 + i) * 129 + tx * 8 + j] = acc[i][j];
    __syncthreads();
    epi(Ct);
    __syncthreads();
}

__device__ void inproj_epi(const Params& p, const float* Ct, int row0, int col0) {
    const int tid = threadIdx.x, r = tid >> 2, q = tid & 3;
    const int grow = row0 + r; const RowInfo ri = row_decode(grow);
    const float* c = Ct + r * 129;
    float v[4][8];
#pragma unroll
    for (int g = 0; g < 4; ++g)
#pragma unroll
        for (int i = 0; i < 8; ++i) v[g][i] = c[g * 32 + 8 * q + i];
    const int sec = col0 < 1024 ? 0 : col0 < 2048 ? 1 : col0 < 3072 ? 2 : col0 < 4096 ? 3 : col0 < 4352 ? 4 : col0 < 4608 ? 5 : col0 < 5632 ? 6 : 7;
    const int secbase = sec == 0 ? 0 : sec == 1 ? 1024 : sec == 2 ? 2048 : sec == 3 ? 3072 : sec == 4 ? 4096 : sec == 5 ? 4352 : sec == 6 ? 4608 : 5632;
    const int head = (col0 - secbase) >> 7;
    if (sec == 3 || sec == 4) {
        float ss = 0.f;
#pragma unroll
        for (int g = 0; g < 4; ++g)
#pragma unroll
            for (int i = 0; i < 8; ++i) ss += v[g][i] * v[g][i];
        ss += __shfl_xor(ss, 1); ss += __shfl_xor(ss, 2);
        const float rstd = 1.0f / sqrtf(ss * (1.0f / 128.f) + EPS);
        const float* gn = sec == 3 ? p.g_qnorm : p.g_knorm;
#pragma unroll
        for (int g = 0; g < 4; ++g)
#pragma unroll
            for (int i = 0; i < 8; ++i) v[g][i] = v[g][i] * rstd * gn[g * 32 + 8 * q + i];
        if (!ri.meta) {
            const float2* rope = (const float2*)(p.ws + OFF_ROPE);
            const int prow = ri.t >> 6, pcol = ri.t & 63;
#pragma unroll
            for (int i = 0; i < 8; ++i) {
                const float2 cr = rope[prow * 32 + 8 * q + i], cc = rope[pcol * 32 + 8 * q + i];
                const float x1 = v[0][i], x2 = v[1][i]; v[0][i] = x1 * cr.x - x2 * cr.y; v[1][i] = x2 * cr.x + x1 * cr.y;
                const float y1 = v[2][i], y2 = v[3][i]; v[2][i] = y1 * cc.x - y2 * cc.y; v[3][i] = y2 * cc.x + y1 * cc.y;
            }
        }
    }
    if (!ri.valid) return;
    bf16_t* dst; float sc = 1.f; bool sig = false;
    if (sec == 0) { dst = (bf16_t*)(p.ws + OFF_QA) + ((size_t)(ri.b * 8 + head) * QROWS + row_q(ri)) * 128; sc = CA; }
    else if (sec == 1) dst = (bf16_t*)(p.ws + OFF_KA) + ((size_t)(ri.b * 8 + head) * KEYS + row_key(ri)) * 128;
    else if (sec == 2) dst = (bf16_t*)(p.ws + OFF_VA) + ((size_t)(ri.b * 8 + head) * KEYS + row_key(ri)) * 128;
    else if (sec == 3) { dst = (bf16_t*)(p.ws + OFF_QB) + ((size_t)(ri.b * 8 + head) * QROWS + row_q(ri)) * 128; sc = CB; }
    else if (sec == 4) dst = (bf16_t*)(p.ws + OFF_KB) + ((size_t)(ri.b * 2 + head) * KEYS + row_key(ri)) * 128;
    else if (sec == 5) dst = (bf16_t*)(p.ws + OFF_VB) + ((size_t)(ri.b * 2 + head) * KEYS + row_key(ri)) * 128;
    else { sig = true; const int cbase = (sec == 7 ? 1024 : 0) + head * 128;
           dst = (grow < MREAL ? (bf16_t*)p.out + (size_t)grow * 2048 : (bf16_t*)(p.ws + OFF_SGM) + (size_t)(grow - MREAL) * 2048) + cbase; }
#pragma unroll
    for (int g = 0; g < 4; ++g)
#pragma unroll
        for (int i = 0; i < 8; ++i) { float y = v[g][i] * sc; if (sig) y = 1.0f / (1.0f + __expf(-y)); dst[g * 32 + 8 * q + i] = (bf16_t)f2bf(y); }
}
__device__ void phase1_ref(const Params& p, float* lds, int vb, int nvb) {
    const bf16_t* UN = (const bf16_t*)(p.ws + OFF_UN);
    constexpr int NTM = MPAD / 128, NTN = INW / 128;
    for (int t = vb; t < NTM * NTN; t += nvb) {
        const int tm = t / NTN, tn = t % NTN, row0 = tm * 128, col0 = tn * 128;
        if (row0 >= MROWS) continue;
        ngemm_tile(lds, DM,
            [&](int r) { return UN + (size_t)(row0 + r) * DM; },
            [&](int k, int c) { return p.w_in[(size_t)k * INW + col0 + c]; },
            [&](const float* Ct) { inproj_epi(p, Ct, row0, col0); });
    }
}

__device__ float attn_row_ref(const bf16_t* qrow, int dq, const bf16_t* Kh, int kcol0, const bf16_t* Vh, float slopeC, int tq  ,
                              float* sc, float* qf, int lane, float& o0, float& o1) {
    if (lane < dq / 2) { const unsigned w = ((const unsigned*)qrow)[lane]; qf[2 * lane] = bf2f(w & 0xffffu); qf[2 * lane + 1] = bf2f(w >> 16); }
    __builtin_amdgcn_s_waitcnt(0);
    float mx = -1e30f;
    for (int i = 0; i < KEYS / 64; ++i) {
        const int kk = i * 64 + lane;
        const bf16_t* kr = Kh + (size_t)kk * 128 + kcol0;
        float s = 0.f;
        for (int d = 0; d < dq; d += 8) {
            const u32x4 w = *(const u32x4*)(kr + d);
            s = fmaf(qf[d + 0], bf2f(w.x & 0xffffu), s); s = fmaf(qf[d + 1], bf2f(w.x >> 16), s);
            s = fmaf(qf[d + 2], bf2f(w.y & 0xffffu), s); s = fmaf(qf[d + 3], bf2f(w.y >> 16), s);
            s = fmaf(qf[d + 4], bf2f(w.z & 0xffffu), s); s = fmaf(qf[d + 5], bf2f(w.z >> 16), s);
            s = fmaf(qf[d + 6], bf2f(w.w & 0xffffu), s); s = fmaf(qf[d + 7], bf2f(w.w >> 16), s);
        }
        const bool valid = kk < NMETA || kk >= 64;
        if (tq >= 0 && kk >= 64) s -= slopeC * fabsf((float)(tq - (kk - 64)));
        if (!valid) s = -1e30f;
        sc[kk] = s; mx = fmaxf(mx, s);
    }
    mx = wave_max(mx);
    float sum = 0.f;
    for (int i = 0; i < KEYS / 64; ++i) { const int kk = i * 64 + lane; const float pr = (kk < NMETA || kk >= 64) ? exp2f(sc[kk] - mx) : 0.f; sc[kk] = pr; sum += pr; }
    sum = wave_sum(sum);
    __builtin_amdgcn_s_waitcnt(0);
    float a0 = 0.f, a1 = 0.f;
    const unsigned* V2 = (const unsigned*)Vh + lane;
#pragma unroll 8
    for (int kk = 0; kk < KEYS; ++kk) {
        if (kk >= NMETA && kk < 64) continue;
        const float pr = sc[kk]; const unsigned w = V2[(size_t)kk * 64];
        a0 = fmaf(pr, bf2f(w & 0xffffu), a0); a1 = fmaf(pr, bf2f(w >> 16), a1);
    }
    o0 = a0; o1 = a1;
    return sum;
}
__device__ void phase2_ref(const Params& p, float* lds, int vb, int nvb) {
    const int tid = threadIdx.x, lane = tid & 63, wave = tid >> 6;
    if (wave >= 4) return;
    float* sc = lds + wave * KEYS; float* qf = lds + 4 * KEYS + wave * 128;
    const bf16_t *QA = (const bf16_t*)(p.ws + OFF_QA), *KA = (const bf16_t*)(p.ws + OFF_KA), *VA = (const bf16_t*)(p.ws + OFF_VA);
    const bf16_t *QB = (const bf16_t*)(p.ws + OFF_QB), *KB = (const bf16_t*)(p.ws + OFF_KB), *VB = (const bf16_t*)(p.ws + OFF_VB);
    bf16_t* OA = (bf16_t*)(p.ws + OFF_UN); bf16_t* OB = (bf16_t*)(p.ws + OFF_OB);
    const float lam = *(const float*)(p.ws + OFF_LAM);
    const int NTASK = 2 * 8 * MROWS / NB;
    for (int task = vb * 4 + wave; task < 2 * 8 * MROWS; task += nvb * 4) {
        const int type = task / (8 * MROWS), rem = task % (8 * MROWS), h = rem / MROWS, r = rem % MROWS;
        const RowInfo ri = row_decode(r); const int qr = row_q(ri); const int tq = ri.meta ? -1 : ri.t;
        if (type == 0) {
            const size_t bh = (size_t)(ri.b * 8 + h);
            const float slopeC = exp2f(-(float)(h + 1)) * LOG2E;
            float a0, a1, b0, b1;
            const float l1 = attn_row_ref(QA + (bh * QROWS + qr) * 128, 64, KA + bh * KEYS * 128, 0, VA + bh * KEYS * 128, slopeC, tq, sc, qf, lane, a0, a1);
            const float l2 = attn_row_ref(QA + (bh * QROWS + qr) * 128 + 64, 64, KA + bh * KEYS * 128, 64, VA + bh * KEYS * 128, slopeC, tq, sc, qf, lane, b0, b1);
            float y0 = a0 / l1 - lam * (b0 / l2), y1 = a1 / l1 - lam * (b1 / l2);
            const float ss = wave_sum(y0 * y0 + y1 * y1);
            const float rstd = 1.0f / sqrtf(ss * (1.0f / 128.f) + EPS) * (1.0f - LAM_INIT);
            y0 = y0 * rstd * p.g_subln[2 * lane]; y1 = y1 * rstd * p.g_subln[2 * lane + 1];
            ((unsigned*)(OA + (size_t)r * DM + h * 128))[lane] = f2bf(y0) | (f2bf(y1) << 16);
        } else {
            const size_t bh = (size_t)(ri.b * 8 + h), bk = (size_t)(ri.b * 2 + (h >> 2));
            float a0, a1;
            const float l = attn_row_ref(QB + (bh * QROWS + qr) * 128, 128, KB + bk * KEYS * 128, 0, VB + bk * KEYS * 128, 0.f, -1, sc, qf, lane, a0, a1);
            ((unsigned*)(OB + (size_t)r * DM + h * 128))[lane] = f2bf(a0 / l) | (f2bf(a1 / l) << 16);
        }
    }
    (void)NTASK;
}

__device__ __forceinline__ const bf16_t* sg_row(const Params& p, int grow) { return grow < MREAL ? (const bf16_t*)p.out + (size_t)grow * 2048 : (const bf16_t*)(p.ws + OFF_SGM) + (size_t)(grow - MREAL) * 2048; }
__device__ void phase3a_ref(const Params& p, float* lds, int vb, int nvb, int pass) {
    const bf16_t* A = (const bf16_t*)(p.ws + (pass == 0 ? OFF_UN : OFF_OB));
    const float* W = pass == 0 ? p.w_ba : p.w_bb;
    float* T = (float*)(p.ws + OFF_T); bf16_t* MG = (bf16_t*)(p.ws + OFF_MERGED);
    constexpr int NTM = MPAD / 128, NTN = DM / 128;
    for (int t = vb; t < NTM * NTN; t += nvb) {
        const int tm = t / NTN, tn = t % NTN, row0 = tm * 128, col0 = tn * 128;
        if (row0 >= MROWS) continue;
        ngemm_tile(lds, DM,
            [&](int r) { return A + (size_t)(row0 + r) * DM; },
            [&](int k, int c) { return W[(size_t)k * DM + col0 + c]; },
            [&](const float* Ct) {
                const int tid = threadIdx.x, r = tid >> 2, q = tid & 3, grow = row0 + r;
                if (grow >= MROWS) return;
                const bf16_t* sg = sg_row(p, grow) + (pass == 0 ? 0 : 1024) + col0 + q * 32;
                for (int i = 0; i < 32; ++i) {
                    const float y = Ct[r * 129 + q * 32 + i] * bf2f(sg[i]); const size_t o = (size_t)grow * DM + col0 + q * 32 + i;
                    if (pass == 0) T[o] = y; else MG[o] = (bf16_t)f2bf(T[o] + y);
                }
            });
    }
}
__device__ __forceinline__ float* h2_row(const Params& p, int grow) { return grow < MREAL ? p.out + (size_t)grow * DM : (float*)(p.ws + OFF_H2M) + (size_t)(grow - MREAL) * DM; }
__device__ void phase3b_ref(const Params& p, float* lds, int vb, int nvb) {
    const bf16_t* MG = (const bf16_t*)(p.ws + OFF_MERGED);
    constexpr int NTM = MPAD / 128, NTN = DM / 128;
    for (int t = vb; t < NTM * NTN; t += nvb) {
        const int tm = t / NTN, tn = t % NTN, row0 = tm * 128, col0 = tn * 128;
        if (row0 >= MROWS) continue;
        ngemm_tile(lds, DM,
            [&](int r) { return MG + (size_t)(row0 + r) * DM; },
            [&](int k, int c) { return p.w_out[(size_t)k * DM + col0 + c]; },
            [&](const float* Ct) {
                const int tid = threadIdx.x, r = tid >> 2, q = tid & 3, grow = row0 + r;
                if (grow >= MROWS) return;
                const float* hr = h_row(p, grow) + col0 + q * 32; float* o = h2_row(p, grow) + col0 + q * 32;
                for (int i = 0; i < 32; ++i) o[i] = hr[i] + Ct[r * 129 + q * 32 + i];
            });
    }
}

__device__ void phase4a(const Params& p, float* lds, int vb, int nvb) {
    const int tid = threadIdx.x, lane = tid & 63, wave = tid >> 6;
    for (int i = tid; i < DM * NEXP; i += NTHREADS) { const int k = i >> 4, e = i & 15; lds[e * DM + k] = p.w_router[i]; }
    __syncthreads();
    bf16_t* U2 = (bf16_t*)(p.ws + OFF_UN); float* AFF = (float*)(p.ws + OFF_AFF);
    for (int r = vb * 8 + wave; r < MROWS; r += nvb * 8) {
        const RowInfo ri = row_decode(r);
        const f32x4* xr = (const f32x4*)h2_row(p, r) + lane;
        f32x4 v[4]; float s = 0.f;
#pragma unroll
        for (int j = 0; j < 4; ++j) { v[j] = xr[64 * j]; s += (v[j].x * v[j].x + v[j].y * v[j].y) + (v[j].z * v[j].z + v[j].w * v[j].w); }
        const float rstd = 1.0f / sqrtf(wave_sum(s) * (1.0f / DM) + EPS);
        u32x2* o = (u32x2*)(U2 + (size_t)r * DM) + lane;
#pragma unroll
        for (int j = 0; j < 4; ++j) {
            const f32x4 g = ((const f32x4*)p.g_ffn)[lane + 64 * j];
            v[j].x *= rstd * g.x; v[j].y *= rstd * g.y; v[j].z *= rstd * g.z; v[j].w *= rstd * g.w;
            u32x2 w; w.x = f2bf(v[j].x) | (f2bf(v[j].y) << 16); w.y = f2bf(v[j].z) | (f2bf(v[j].w) << 16);
            o[64 * j] = w;
        }
        float mylg = -1e30f;
#pragma unroll 1
        for (int e = 0; e < NEXP; ++e) {
            float a = 0.f;
#pragma unroll
            for (int j = 0; j < 4; ++j) { const f32x4 w = *(const f32x4*)(lds + e * DM + 4 * (lane + 64 * j)); a += v[j].x * w.x + v[j].y * w.y + v[j].z * w.z + v[j].w * w.w; }
            a = wave_sum(a);
            if (lane == e) mylg = a;
        }
        const float mx = wave_max(mylg);
        const float ex = lane < NEXP ? expf(mylg - mx) : 0.f;
        const float mine = ex / wave_sum(ex);
        if (lane < NEXP) AFF[((size_t)ri.b * NEXP + lane) * LTOT + row_pos(ri)] = mine;
    }
    __syncthreads();
}

__device__ void phase4b_ref(const Params& p, float* lds, int vb, int nvb) {
    const float* AFF = (const float*)(p.ws + OFF_AFF); int* IDX = (int*)(p.ws + OFF_IDX); int* SEL = (int*)(p.ws + OFF_SEL);
    constexpr int NCH = (LTOT + NTHREADS - 1) / NTHREADS;
    for (int t = vb; t < NB * NEXP * NCH; t += nvb) {
        const int be = t / NCH, ch = t % NCH, b = be / NEXP, e = be % NEXP;
        const float* a = AFF + (size_t)be * LTOT;
        __syncthreads();
        for (int i = threadIdx.x; i < LTOT; i += NTHREADS) lds[i] = a[i];
        __syncthreads();
        const int tok = ch * NTHREADS + threadIdx.x;
        if (tok < LTOT) {
            const float mine = lds[tok]; int rank = 0;
            for (int j = 0; j < LTOT; ++j) { const float o = lds[j]; rank += (o > mine || (o == mine && j < tok)) ? 1 : 0; }
            if (rank < CAP) { IDX[(size_t)be * CAP + rank] = tok; SEL[((size_t)b * LTOT + tok) * NEXP + e] = rank; }
            else SEL[((size_t)b * LTOT + tok) * NEXP + e] = -1;
        }
    }
    __syncthreads();
}

__device__ void phase5a_ref(const Params& p, float* lds, int vb, int nvb) {
    const bf16_t* U2 = (const bf16_t*)(p.ws + OFF_UN); const int* IDX = (const int*)(p.ws + OFF_IDX); bf16_t* HID = (bf16_t*)(p.ws + OFF_HID);
    constexpr int NTM = (ESLOTS + 127) / 128, NTN = 2 * EFF / 128;
    for (int t = vb; t < NEXP * NTM * NTN; t += nvb) {
        const int e = t / (NTM * NTN), tm = (t / NTN) % NTM, tn = t % NTN, s0 = tm * 128, f0 = tn * 64;
        const float* Wg = p.w_gate + (size_t)e * DM * EFF; const float* Wu = p.w_up + (size_t)e * DM * EFF;
        ngemm_tile(lds, DM,
            [&](int r) -> const bf16_t* { const int s = s0 + r; if (s >= ESLOTS) return nullptr; const int b = s / CAP, c = s % CAP; return U2 + (size_t)pos_row(b, IDX[((size_t)b * NEXP + e) * CAP + c]) * DM; },
            [&](int k, int c) { return c < 64 ? Wg[(size_t)k * EFF + f0 + c] : Wu[(size_t)k * EFF + f0 + c - 64]; },
            [&](const float* Ct) {
                const int tid = threadIdx.x, r = tid >> 2, q = tid & 3, s = s0 + r;
                if (s >= ESLOTS) return;
                for (int i = 0; i < 16; ++i) { const float g = Ct[r * 129 + q * 16 + i], u = Ct[r * 129 + 64 + q * 16 + i];
                    HID[((size_t)e * ESLOTS + s) * EFF + f0 + q * 16 + i] = (bf16_t)f2bf(g / (1.0f + __expf(-g)) * u); }
            });
    }
}
__device__ void phase5b_ref(const Params& p, float* lds, int vb, int nvb) {
    const bf16_t* HID = (const bf16_t*)(p.ws + OFF_HID); const int* IDX = (const int*)(p.ws + OFF_IDX); const float* AFF = (const float*)(p.ws + OFF_AFF); bf16_t* YB = (bf16_t*)(p.ws + OFF_YB);
    constexpr int NTM = (ESLOTS + 127) / 128, NTN = DM / 128;
    for (int t = vb; t < NEXP * NTM * NTN; t += nvb) {
        const int e = t / (NTM * NTN), tm = (t / NTN) % NTM, tn = t % NTN, s0 = tm * 128, col0 = tn * 128;
        const float* Wd = p.w_down + (size_t)e * EFF * DM;
        ngemm_tile(lds, EFF,
            [&](int r) -> const bf16_t* { const int s = s0 + r; return s < ESLOTS ? HID + ((size_t)e * ESLOTS + s) * EFF : nullptr; },
            [&](int k, int c) { return Wd[(size_t)k * DM + col0 + c]; },
            [&](const float* Ct) {
                const int tid = threadIdx.x, r = tid >> 2, q = tid & 3, s = s0 + r;
                if (s >= ESLOTS) return;
                const int b = s / CAP, c = s % CAP; const int tok = IDX[((size_t)b * NEXP + e) * CAP + c];
                const float af = AFF[((size_t)b * NEXP + e) * LTOT + tok];
                for (int i = 0; i < 32; ++i) YB[((size_t)e * ESLOTS + s) * DM + col0 + q * 32 + i] = (bf16_t)f2bf(Ct[r * 129 + q * 32 + i] * af);
            });
    }
}

__device__ void phase6(const Params& p, int vb, int nvb) {
    const int tid = threadIdx.x, lane = tid & 63, wave = tid >> 6;
    const int* SEL = (const int*)(p.ws + OFF_SEL); const bf16_t* YB = (const bf16_t*)(p.ws + OFF_YB);
    for (int r = vb * 8 + wave; r < MREAL; r += nvb * 8) {
        const int b = r >> 13, tok = NMETA + (r & (SEQ - 1));
        f32x4* xr = (f32x4*)(p.out + (size_t)r * DM) + lane;
        f32x4 v[4];
#pragma unroll
        for (int j = 0; j < 4; ++j) v[j] = xr[64 * j];
        const int sel = lane < NEXP ? SEL[((size_t)b * LTOT + tok) * NEXP + lane] : -1;
        for (int e = 0; e < NEXP; ++e) {
            const int c = __shfl(sel, e);
            if (c >= 0) {
                const u32x2* y = (const u32x2*)(YB + ((size_t)e * ESLOTS + b * CAP + c) * DM) + lane;
#pragma unroll
                for (int j = 0; j < 4; ++j) { const u32x2 w = y[64 * j]; v[j].x += bf2f(w.x & 0xffffu); v[j].y += bf2f(w.x >> 16); v[j].z += bf2f(w.y & 0xffffu); v[j].w += bf2f(w.y >> 16); }
            }
        }
        float s = 0.f;
#pragma unroll
        for (int j = 0; j < 4; ++j) s += (v[j].x * v[j].x + v[j].y * v[j].y) + (v[j].z * v[j].z + v[j].w * v[j].w);
        const float rstd = 1.0f / sqrtf(wave_sum(s) * (1.0f / DM) + EPS);
#pragma unroll
        for (int j = 0; j < 4; ++j) { const f32x4 g = ((const f32x4*)p.g_final)[lane + 64 * j]; xr[64 * j] = (f32x4){v[j].x * rstd * g.x, v[j].y * rstd * g.y, v[j].z * rstd * g.z, v[j].w * rstd * g.w}; }
    }
}

constexpr int LDS_BYTES = 147456;
__global__ void __launch_bounds__(NTHREADS, 2) fwd_kernel(Params p) {
    extern __shared__ __attribute__((aligned(16))) unsigned char lds_raw[];
    float* lds = (float*)lds_raw;
    cg::grid_group grid = cg::this_grid();
    const int vb = blockIdx.x, nvb = gridDim.x;
    phase0(p, vb, nvb);
    grid.sync();
    phase1_ref(p, lds, vb, nvb);
    grid.sync();
    phase2_ref(p, lds, vb, nvb);
    grid.sync();
    phase3a_ref(p, lds, vb, nvb, 0);
    phase3a_ref(p, lds, vb, nvb, 1);
    grid.sync();
    phase3b_ref(p, lds, vb, nvb);
    grid.sync();
    phase4a(p, lds, vb, nvb);
    grid.sync();
    phase4b_ref(p, lds, vb, nvb);
    grid.sync();
    phase5a_ref(p, lds, vb, nvb);
    grid.sync();
    phase5b_ref(p, lds, vb, nvb);
    grid.sync();
    phase6(p, vb, nvb);
}

extern "C" void kernel_launch(void* const* d_in, const int* in_sizes, int n_in, void* d_out, int out_size, void* d_ws, size_t ws_size, hipStream_t stream) {
    static int grid_blocks = 0;
    if (grid_blocks == 0) {
        if (n_in != 20 || in_sizes[0] != MREAL * DM || out_size != MREAL * DM || ws_size < 256 * MiB) {
            fprintf(stderr, "kernel_launch: unexpected shapes: n_in %d in0 %d out %d ws %zu\n", n_in, n_in > 0 ? in_sizes[0] : -1, out_size, ws_size); grid_blocks = -1; return; }
        int dev = 0, cus = 0, per_cu = 0;
        (void)hipGetDevice(&dev); (void)hipDeviceGetAttribute(&cus, hipDeviceAttributeMultiprocessorCount, dev);
        if (hipFuncSetAttribute((const void*)fwd_kernel, hipFuncAttributeMaxDynamicSharedMemorySize, LDS_BYTES) != hipSuccess) { fprintf(stderr, "kernel_launch: hipFuncSetAttribute failed\n"); grid_blocks = -1; return; }
        if (hipOccupancyMaxActiveBlocksPerMultiprocessor(&per_cu, (const void*)fwd_kernel, NTHREADS, LDS_BYTES) != hipSuccess || per_cu < 1) { fprintf(stderr, "kernel_launch: occupancy query failed (%d)\n", per_cu); grid_blocks = -1; return; }
        grid_blocks = cus * per_cu;
    }
    if (grid_blocks < 0) return;
    Params p{};
    p.x = (const float*)d_in[0]; p.meta = (const float*)d_in[1]; p.g_mix = (const float*)d_in[2]; p.w_in = (const float*)d_in[3];
    p.lq1 = (const float*)d_in[4]; p.lk1 = (const float*)d_in[5]; p.lq2 = (const float*)d_in[6]; p.lk2 = (const float*)d_in[7];
    p.g_subln = (const float*)d_in[8]; p.g_qnorm = (const float*)d_in[9]; p.g_knorm = (const float*)d_in[10];
    p.w_ba = (const float*)d_in[11]; p.w_bb = (const float*)d_in[12]; p.w_out = (const float*)d_in[13]; p.g_ffn = (const float*)d_in[14];
    p.w_router = (const float*)d_in[15]; p.w_gate = (const float*)d_in[16]; p.w_up = (const float*)d_in[17]; p.w_down = (const float*)d_in[18]; p.g_final = (const float*)d_in[19];
    p.out = (float*)d_out; p.ws = (unsigned char*)d_ws;
    void* args[] = {&p};
    hipError_t e = hipLaunchCooperativeKernel((const void*)fwd_kernel, dim3(grid_blocks), dim3(NTHREADS), args, LDS_BYTES, stream);
    if (e != hipSuccess) fprintf(stderr, "kernel_launch: cooperative launch failed: %s (grid %d)\n", hipGetErrorString(e), grid_blocks);
}
```

```cpp
#include <hip/hip_runtime.h>
#include <hip/hip_cooperative_groups.h>
#include <cstdio>
#include <cstdint>
namespace cg = cooperative_groups;

typedef unsigned short bf16_t;
typedef float f32x4 __attribute__((ext_vector_type(4)));
typedef unsigned u32x2 __attribute__((ext_vector_type(2)));
typedef unsigned u32x4 __attribute__((ext_vector_type(4)));

constexpr int NB = 2, SEQ = 8192, DM = 1024, NMETA = 16, LTOT = SEQ + NMETA;
constexpr int MREAL = NB * SEQ;
constexpr int MROWS = MREAL + NB * NMETA;
constexpr int MPAD = 16640;
constexpr int INW = 6656;
constexpr int KEYS = 8256;
constexpr int QROWS = 8256;
constexpr int NEXP = 16, EFF = 512, CAP = 1026, ESLOTS = NB * CAP;
constexpr float EPS = 1e-6f;
constexpr float LOG2E = 1.4426950408889634f;
constexpr float CA = 0.125f * LOG2E;
constexpr float CB = 0.08838834764831845f * LOG2E;
constexpr float LAM_INIT = 0.2f;
constexpr int NTHREADS = 512;
#ifndef FAST_ATTN
#define FAST_ATTN 1
#endif
__device__ const float INVF[32] = {1.000000000e+00f, 7.498942614e-01f, 5.623413324e-01f, 4.216965139e-01f, 3.162277639e-01f, 2.371373773e-01f, 1.778279394e-01f, 1.333521307e-01f,
    1.000000015e-01f, 7.498941571e-02f, 5.623413250e-02f, 4.216965288e-02f, 3.162277490e-02f, 2.371373773e-02f, 1.778279431e-02f, 1.333521493e-02f,
    9.999999776e-03f, 7.498941850e-03f, 5.623413250e-03f, 4.216964822e-03f, 3.162277630e-03f, 2.371373586e-03f, 1.778279431e-03f, 1.333521446e-03f,
    1.000000047e-03f, 7.498942432e-04f, 5.623413017e-04f, 4.216965172e-04f, 3.162277571e-04f, 2.371373703e-04f, 1.778279402e-04f, 1.333521504e-04f};

constexpr size_t MiB = 1u << 20;
constexpr size_t OFF_ROPE = 0;
constexpr size_t OFF_LAM = 64 * 1024;
constexpr size_t OFF_AFF = 128 * 1024;
constexpr size_t OFF_IDX = OFF_AFF + (size_t)NB * NEXP * LTOT * 4 + 256;
constexpr size_t OFF_SEL = OFF_IDX + (size_t)NB * NEXP * CAP * 4 + 256;
constexpr size_t OFF_SGM = OFF_SEL + (size_t)NB * LTOT * NEXP * 4 + 256;
constexpr size_t OFF_H2M = OFF_SGM + 32 * 2048 * 2;
constexpr size_t OFF_MISC_END = OFF_H2M + 32 * 1024 * 4;
static_assert(OFF_MISC_END <= 4 * MiB, "misc region");
constexpr size_t OFF_UN = 24 * MiB;
constexpr size_t SZ_ROWS = (size_t)MPAD * DM * 2;
constexpr size_t OFF_OB = OFF_UN + SZ_ROWS + 256;
constexpr size_t OFF_ATT = OFF_OB + SZ_ROWS + 256;
constexpr size_t SZ_QH = (size_t)NB * 8 * QROWS * 128 * 2;
constexpr size_t SZ_KVB = (size_t)NB * 2 * KEYS * 128 * 2;
constexpr size_t OFF_QA = OFF_ATT, OFF_KA = OFF_QA + SZ_QH, OFF_VA = OFF_KA + SZ_QH, OFF_QB = OFF_VA + SZ_QH, OFF_KB = OFF_QB + SZ_QH, OFF_VB = OFF_KB + SZ_KVB;
constexpr size_t OFF_ATT_END = OFF_VB + SZ_KVB;
static_assert(OFF_ATT_END <= 256 * MiB, "workspace");
constexpr size_t OFF_T = OFF_ATT;
constexpr size_t OFF_MERGED = OFF_ATT + 80 * MiB;
constexpr size_t OFF_HID = OFF_MERGED;
constexpr size_t OFF_YB = OFF_ATT;
static_assert(OFF_T + (size_t)MPAD * DM * 4 <= OFF_MERGED && OFF_MERGED + (size_t)NEXP * (ESLOTS + 256) * EFF * 2 <= OFF_ATT_END && OFF_MERGED + SZ_ROWS <= OFF_ATT_END && OFF_YB + (size_t)NEXP * (ESLOTS + 256) * DM * 2 <= OFF_MERGED, "overlay map");

struct Params {
    const float *x, *meta, *g_mix, *w_in, *lq1, *lk1, *lq2, *lk2, *g_subln, *g_qnorm, *g_knorm, *w_ba, *w_bb, *w_out, *g_ffn, *w_router, *w_gate, *w_up, *w_down, *g_final;
    float* out; unsigned char* ws;
};

__device__ __forceinline__ unsigned f2bf(float f) { unsigned u = __builtin_bit_cast(unsigned, f); return (u + 0x7fffu + ((u >> 16) & 1u)) >> 16; }
__device__ __forceinline__ float bf2f(unsigned h) { return __builtin_bit_cast(float, h << 16); }
__device__ __forceinline__ float wave_sum(float v) {
#pragma unroll
    for (int o = 1; o < 64; o <<= 1) v += __shfl_xor(v, o);
    return v;
}
__device__ __forceinline__ float wave_max(float v) {
#pragma unroll
    for (int o = 1; o < 64; o <<= 1) v = fmaxf(v, __shfl_xor(v, o));
    return v;
}
struct RowInfo { int b, t, meta, valid; };
__device__ __forceinline__ RowInfo row_decode(int r) {
    RowInfo ri;
    if (r < MREAL) { ri.b = r >> 13; ri.t = r & (SEQ - 1); ri.meta = 0; ri.valid = 1; }
    else if (r < MROWS) { ri.b = (r - MREAL) >> 4; ri.t = (r - MREAL) & 15; ri.meta = 1; ri.valid = 1; }
    else { ri.b = 0; ri.t = 0; ri.meta = 1; ri.valid = 0; }
    return ri;
}
__device__ __forceinline__ int row_key(const RowInfo& ri) { return ri.meta ? ri.t : 64 + ri.t; }
__device__ __forceinline__ int row_q(const RowInfo& ri) { return ri.meta ? SEQ + ri.t : ri.t; }
__device__ __forceinline__ int row_pos(const RowInfo& ri) { return ri.meta ? ri.t : NMETA + ri.t; }
__device__ __forceinline__ int pos_row(int b, int pos) { return pos < NMETA ? MREAL + b * NMETA + pos : b * SEQ + (pos - NMETA); }
__device__ __forceinline__ const float* h_row(const Params& p, int r) { RowInfo ri = row_decode(r); return ri.meta ? p.meta + (size_t)ri.t * DM : p.x + (size_t)r * DM; }

__device__ void phase0(const Params& p, int vb, int nvb) {
    const int tid = threadIdx.x, lane = tid & 63, wave = tid >> 6;
    const int gt = vb * NTHREADS + tid;
    if (gt < 128 * 32) {
        const int pos = gt >> 5, j = gt & 31;
        const float ang = (float)pos * INVF[j];
        const double xd = (double)ang, kq = __builtin_rint(xd * 0.15915494309189535);
        const double rr = (xd - kq * 6.283185307179586) * 0.25, r2 = rr * rr;
        double sn = 1.0 / 1307674368000.0, cn = 1.0 / 87178291200.0;
        sn = sn * r2 * -1.0 + 1.0 / 6227020800.0; cn = cn * r2 * -1.0 + 1.0 / 479001600.0;
        sn = sn * r2 * -1.0 + 1.0 / 39916800.0;   cn = cn * r2 * -1.0 + 1.0 / 3628800.0;
        sn = sn * r2 * -1.0 + 1.0 / 362880.0;     cn = cn * r2 * -1.0 + 1.0 / 40320.0;
        sn = sn * r2 * -1.0 + 1.0 / 5040.0;       cn = cn * r2 * -1.0 + 1.0 / 720.0;
        sn = sn * r2 * -1.0 + 1.0 / 120.0;        cn = cn * r2 * -1.0 + 1.0 / 24.0;
        sn = sn * r2 * -1.0 + 1.0 / 6.0;          cn = cn * r2 * -1.0 + 0.5;
        sn = (sn * r2 * -1.0 + 1.0) * rr;         cn = cn * r2 * -1.0 + 1.0;
        double s2 = 2.0 * sn * cn, c2 = cn * cn - sn * sn;
        double s4 = 2.0 * s2 * c2, c4 = c2 * c2 - s2 * s2;
        float2 cs; cs.x = (float)c4; cs.y = (float)s4;
        ((float2*)(p.ws + OFF_ROPE))[gt] = cs;
    }
    if (vb == 0 && wave == 0) {
        float a = p.lq1[lane] * p.lk1[lane], c = p.lq2[lane] * p.lk2[lane];
        a = wave_sum(a); c = wave_sum(c);
        if (lane == 0) *(float*)(p.ws + OFF_LAM) = expf(a) - expf(c) + LAM_INIT;
    }
    bf16_t* UN = (bf16_t*)(p.ws + OFF_UN);
    for (int r = vb * 8 + wave; r < MPAD; r += nvb * 8) {
        u32x2* o = (u32x2*)(UN + (size_t)r * DM) + lane;
        if (r >= MROWS) {
#pragma unroll
            for (int j = 0; j < 4; ++j) o[64 * j] = (u32x2){0u, 0u};
            continue;
        }
        const f32x4* xr = (const f32x4*)h_row(p, r) + lane;
        f32x4 v[4]; float s = 0.f;
#pragma unroll
        for (int j = 0; j < 4; ++j) { v[j] = xr[64 * j]; s += (v[j].x * v[j].x + v[j].y * v[j].y) + (v[j].z * v[j].z + v[j].w * v[j].w); }
        const float rstd = 1.0f / sqrtf(wave_sum(s) * (1.0f / DM) + EPS);
#pragma unroll
        for (int j = 0; j < 4; ++j) {
            const f32x4 g = ((const f32x4*)p.g_mix)[lane + 64 * j];
            u32x2 w; w.x = f2bf(v[j].x * rstd * g.x) | (f2bf(v[j].y * rstd * g.y) << 16); w.y = f2bf(v[j].z * rstd * g.z) | (f2bf(v[j].w * rstd * g.w) << 16);
            o[64 * j] = w;
        }
    }
    {
        bf16_t* KA = (bf16_t*)(p.ws + OFF_KA); bf16_t* VA = (bf16_t*)(p.ws + OFF_VA); bf16_t* KB = (bf16_t*)(p.ws + OFF_KB); bf16_t* VB = (bf16_t*)(p.ws + OFF_VB);
        const int per = 48 * 128 / 8;
        for (int i = vb * NTHREADS + tid; i < (16 + 16 + 4 + 4) * per; i += nvb * NTHREADS) {
            const int bh = i / per, o = i % per; bf16_t* base;
            if (bh < 16) base = KA + (size_t)bh * KEYS * 128; else if (bh < 32) base = VA + (size_t)(bh - 16) * KEYS * 128;
            else if (bh < 36) base = KB + (size_t)(bh - 32) * KEYS * 128; else base = VB + (size_t)(bh - 36) * KEYS * 128;
            ((u32x4*)(base + 16 * 128))[o] = (u32x4){0u, 0u, 0u, 0u};
        }
    }
}

constexpr int NG_AS = 16 * 132, NG_BS = 16 * 128, NG_CT = 128 * 129;
template <class ARow, class BVal, class Epi>
__device__ __forceinline__ void ngemm_tile(float* lds, int K, ARow arow, BVal bval, Epi epi) {
    float* As = lds; float* Bs = lds + NG_AS; float* Ct = lds + NG_AS + NG_BS;
    const int tid = threadIdx.x, ty = tid >> 4, tx = tid & 15;
    const int ar = tid >> 2, ak = (tid & 3) * 4; const bf16_t* ap = arow(ar);
    const int bk = tid >> 5, bc = (tid & 31) * 4;
    float acc[4][8];
#pragma unroll
    for (int i = 0; i < 4; ++i)
#pragma unroll
        for (int j = 0; j < 8; ++j) acc[i][j] = 0.f;
    for (int k0 = 0; k0 < K; k0 += 16) {
        u32x2 av = (u32x2){0u, 0u}; if (ap) av = *(const u32x2*)(ap + k0 + ak);
        float b0 = bval(k0 + bk, bc), b1 = bval(k0 + bk, bc + 1), b2 = bval(k0 + bk, bc + 2), b3 = bval(k0 + bk, bc + 3);
        __syncthreads();
        As[(ak + 0) * 132 + ar] = bf2f(av.x & 0xffffu); As[(ak + 1) * 132 + ar] = bf2f(av.x >> 16);
        As[(ak + 2) * 132 + ar] = bf2f(av.y & 0xffffu); As[(ak + 3) * 132 + ar] = bf2f(av.y >> 16);
        *(f32x4*)(Bs + bk * 128 + bc) = (f32x4){b0, b1, b2, b3};
        __syncthreads();
#pragma unroll
        for (int k = 0; k < 16; ++k) {
            const f32x4 a = *(const f32x4*)(As + k * 132 + ty * 4);
            const f32x4 bA = *(const f32x4*)(Bs + k * 128 + tx * 8), bB = *(const f32x4*)(Bs + k * 128 + tx * 8 + 4);
            const float av4[4] = {a.x, a.y, a.z, a.w}; const float bv8[8] = {bA.x, bA.y, bA.z, bA.w, bB.x, bB.y, bB.z, bB.w};
#pragma unroll
            for (int i = 0; i < 4; ++i)
#pragma unroll
                for (int j = 0; j < 8; ++j) acc[i][j] = fmaf(av4[i], bv8[j], acc[i][j]);
        }
    }
    __syncthreads();
#pragma unroll
    for (int i = 0; i < 4; ++i)
#pragma unroll
        for (int j = 0; j < 8; ++j) Ct[(ty * 4 + i) * 129 + tx * 8 + j] = acc[i][j];
    __syncthreads();
    epi(Ct);
    __syncthreads();
}

__device__ void inproj_epi(const Params& p, const float* Ct, int row0, int col0) {
    const int tid = threadIdx.x, r = tid >> 2, q = tid & 3;
    const int grow = row0 + r; const RowInfo ri = row_decode(grow);
    const float* c = Ct + r * 129;
    float v[4][8];
#pragma unroll
    for (int g = 0; g < 4; ++g)
#pragma unroll
        for (int i = 0; i < 8; ++i) v[g][i] = c[g * 32 + 8 * q + i];
    const int sec = col0 < 1024 ? 0 : col0 < 2048 ? 1 : col0 < 3072 ? 2 : col0 < 4096 ? 3 : col0 < 4352 ? 4 : col0 < 4608 ? 5 : col0 < 5632 ? 6 : 7;
    const int secbase = sec == 0 ? 0 : sec == 1 ? 1024 : sec == 2 ? 2048 : sec == 3 ? 3072 : sec == 4 ? 4096 : sec == 5 ? 4352 : sec == 6 ? 4608 : 5632;
    const int head = (col0 - secbase) >> 7;
    if (sec == 3 || sec == 4) {
        float ss = 0.f;
#pragma unroll
        for (int g = 0; g < 4; ++g)
#pragma unroll
            for (int i = 0; i < 8; ++i) ss += v[g][i] * v[g][i];
        ss += __shfl_xor(ss, 1); ss += __shfl_xor(ss, 2);
        const float rstd = 1.0f / sqrtf(ss * (1.0f / 128.f) + EPS);
        const float* gn = sec == 3 ? p.g_qnorm : p.g_knorm;
#pragma unroll
        for (int g = 0; g < 4; ++g)
#pragma unroll
            for (int i = 0; i < 8; ++i) v[g][i] = v[g][i] * rstd * gn[g * 32 + 8 * q + i];
        if (!ri.meta) {
            const float2* rope = (const float2*)(p.ws + OFF_ROPE);
            const int prow = ri.t >> 6, pcol = ri.t & 63;
#pragma unroll
            for (int i = 0; i < 8; ++i) {
                const float2 cr = rope[prow * 32 + 8 * q + i], cc = rope[pcol * 32 + 8 * q + i];
                const float x1 = v[0][i], x2 = v[1][i]; v[0][i] = x1 * cr.x - x2 * cr.y; v[1][i] = x2 * cr.x + x1 * cr.y;
                const float y1 = v[2][i], y2 = v[3][i]; v[2][i] = y1 * cc.x - y2 * cc.y; v[3][i] = y2 * cc.x + y1 * cc.y;
            }
        }
    }
    if (!ri.valid) return;
    bf16_t* dst; float sc = 1.f; bool sig = false;
    if (sec == 0) { dst = (bf16_t*)(p.ws + OFF_QA) + ((size_t)(ri.b * 8 + head) * QROWS + row_q(ri)) * 128; sc = CA; }
    else if (sec == 1) dst = (bf16_t*)(p.ws + OFF_KA) + ((size_t)(ri.b * 8 + head) * KEYS + row_key(ri)) * 128;
    else if (sec == 2) dst = (bf16_t*)(p.ws + OFF_VA) + ((size_t)(ri.b * 8 + head) * KEYS + row_key(ri)) * 128;
    else if (sec == 3) { dst = (bf16_t*)(p.ws + OFF_QB) + ((size_t)(ri.b * 8 + head) * QROWS + row_q(ri)) * 128; sc = CB; }
    else if (sec == 4) dst = (bf16_t*)(p.ws + OFF_KB) + ((size_t)(ri.b * 2 + head) * KEYS + row_key(ri)) * 128;
    else if (sec == 5) dst = (bf16_t*)(p.ws + OFF_VB) + ((size_t)(ri.b * 2 + head) * KEYS + row_key(ri)) * 128;
    else { sig = true; const int cbase = (sec == 7 ? 1024 : 0) + head * 128;
           dst = (grow < MREAL ? (bf16_t*)p.out + (size_t)grow * 2048 : (bf16_t*)(p.ws + OFF_SGM) + (size_t)(grow - MREAL) * 2048) + cbase; }
#pragma unroll
    for (int g = 0; g < 4; ++g)
#pragma unroll
        for (int i = 0; i < 8; ++i) { float y = v[g][i] * sc; if (sig) y = 1.0f / (1.0f + __expf(-y)); dst[g * 32 + 8 * q + i] = (bf16_t)f2bf(y); }
}
__device__ void phase1_ref(const Params& p, float* lds, int vb, int nvb) {
    const bf16_t* UN = (const bf16_t*)(p.ws + OFF_UN);
    constexpr int NTM = MPAD / 128, NTN = INW / 128;
    for (int t = vb; t < NTM * NTN; t += nvb) {
        const int tm = t / NTN, tn = t % NTN, row0 = tm * 128, col0 = tn * 128;
        if (row0 >= MROWS) continue;
        ngemm_tile(lds, DM,
            [&](int r) { return UN + (size_t)(row0 + r) * DM; },
            [&](int k, int c) { return p.w_in[(size_t)k * INW + col0 + c]; },
            [&](const float* Ct) { inproj_epi(p, Ct, row0, col0); });
    }
}

__device__ float attn_row_ref(const bf16_t* qrow, int dq, const bf16_t* Kh, int kcol0, const bf16_t* Vh, float slopeC, int tq  ,
                              float* sc, float* qf, int lane, float& o0, float& o1) {
    if (lane < dq / 2) { const unsigned w = ((const unsigned*)qrow)[lane]; qf[2 * lane] = bf2f(w & 0xffffu); qf[2 * lane + 1] = bf2f(w >> 16); }
    __builtin_amdgcn_s_waitcnt(0);
    float mx = -1e30f;
    for (int i = 0; i < KEYS / 64; ++i) {
        const int kk = i * 64 + lane;
        const bf16_t* kr = Kh + (size_t)kk * 128 + kcol0;
        float s = 0.f;
        for (int d = 0; d < dq; d += 8) {
            const u32x4 w = *(const u32x4*)(kr + d);
            s = fmaf(qf[d + 0], bf2f(w.x & 0xffffu), s); s = fmaf(qf[d + 1], bf2f(w.x >> 16), s);
            s = fmaf(qf[d + 2], bf2f(w.y & 0xffffu), s); s = fmaf(qf[d + 3], bf2f(w.y >> 16), s);
            s = fmaf(qf[d + 4], bf2f(w.z & 0xffffu), s); s = fmaf(qf[d + 5], bf2f(w.z >> 16), s);
            s = fmaf(qf[d + 6], bf2f(w.w & 0xffffu), s); s = fmaf(qf[d + 7], bf2f(w.w >> 16), s);
        }
        const bool valid = kk < NMETA || kk >= 64;
        if (tq >= 0 && kk >= 64) s -= slopeC * fabsf((float)(tq - (kk - 64)));
        if (!valid) s = -1e30f;
        sc[kk] = s; mx = fmaxf(mx, s);
    }
    mx = wave_max(mx);
    float sum = 0.f;
    for (int i = 0; i < KEYS / 64; ++i) { const int kk = i * 64 + lane; const float pr = (kk < NMETA || kk >= 64) ? exp2f(sc[kk] - mx) : 0.f; sc[kk] = pr; sum += pr; }
    sum = wave_sum(sum);
    __builtin_amdgcn_s_waitcnt(0);
    float a0 = 0.f, a1 = 0.f;
    const unsigned* V2 = (const unsigned*)Vh + lane;
#pragma unroll 8
    for (int kk = 0; kk < KEYS; ++kk) {
        if (kk >= NMETA && kk < 64) continue;
        const float pr = sc[kk]; const unsigned w = V2[(size_t)kk * 64];
        a0 = fmaf(pr, bf2f(w & 0xffffu), a0); a1 = fmaf(pr, bf2f(w >> 16), a1);
    }
    o0 = a0; o1 = a1;
    return sum;
}
__device__ void phase2_ref(const Params& p, float* lds, int vb, int nvb) {
    const int tid = threadIdx.x, lane = tid & 63, wave = tid >> 6;
    if (wave >= 4) return;
    float* sc = lds + wave * KEYS; float* qf = lds + 4 * KEYS + wave * 128;
    const bf16_t *QA = (const bf16_t*)(p.ws + OFF_QA), *KA = (const bf16_t*)(p.ws + OFF_KA), *VA = (const bf16_t*)(p.ws + OFF_VA);
    const bf16_t *QB = (const bf16_t*)(p.ws + OFF_QB), *KB = (const bf16_t*)(p.ws + OFF_KB), *VB = (const bf16_t*)(p.ws + OFF_VB);
    bf16_t* OA = (bf16_t*)(p.ws + OFF_UN); bf16_t* OB = (bf16_t*)(p.ws + OFF_OB);
    const float lam = *(const float*)(p.ws + OFF_LAM);
    const int NTASK = 2 * 8 * MROWS / NB;
    for (int task = vb * 4 + wave; task < 2 * 8 * MROWS; task += nvb * 4) {
        const int type = task / (8 * MROWS), rem = task % (8 * MROWS), h = rem / MROWS, r = rem % MROWS;
        const RowInfo ri = row_decode(r); const int qr = row_q(ri); const int tq = ri.meta ? -1 : ri.t;
        if (type == 0) {
            const size_t bh = (size_t)(ri.b * 8 + h);
            const float slopeC = exp2f(-(float)(h + 1)) * LOG2E;
            float a0, a1, b0, b1;
            const float l1 = attn_row_ref(QA + (bh * QROWS + qr) * 128, 64, KA + bh * KEYS * 128, 0, VA + bh * KEYS * 128, slopeC, tq, sc, qf, lane, a0, a1);
            const float l2 = attn_row_ref(QA + (bh * QROWS + qr) * 128 + 64, 64, KA + bh * KEYS * 128, 64, VA + bh * KEYS * 128, slopeC, tq, sc, qf, lane, b0, b1);
            float y0 = a0 / l1 - lam * (b0 / l2), y1 = a1 / l1 - lam * (b1 / l2);
            const float ss = wave_sum(y0 * y0 + y1 * y1);
            const float rstd = 1.0f / sqrtf(ss * (1.0f / 128.f) + EPS) * (1.0f - LAM_INIT);
            y0 = y0 * rstd * p.g_subln[2 * lane]; y1 = y1 * rstd * p.g_subln[2 * lane + 1];
            ((unsigned*)(OA + (size_t)r * DM + h * 128))[lane] = f2bf(y0) | (f2bf(y1) << 16);
        } else {
            const size_t bh = (size_t)(ri.b * 8 + h), bk = (size_t)(ri.b * 2 + (h >> 2));
            float a0, a1;
            const float l = attn_row_ref(QB + (bh * QROWS + qr) * 128, 128, KB + bk * KEYS * 128, 0, VB + bk * KEYS * 128, 0.f, -1, sc, qf, lane, a0, a1);
            ((unsigned*)(OB + (size_t)r * DM + h * 128))[lane] = f2bf(a0 / l) | (f2bf(a1 / l) << 16);
        }
    }
    (void)NTASK;
}

namespace fa {
using bf16x8 = __attribute__((ext_vector_type(8))) short;
using s16x4  = __attribute__((ext_vector_type(4))) short;
using f32x16 = __attribute__((ext_vector_type(16))) float;
constexpr int NT = KEYS / 64;
constexpr int SHM_V = 16384, SHM_K = 16384;
constexpr int L_V = 0, L_K = 2 * SHM_V, L_WS = L_K + 2 * SHM_K, L_X = L_WS + 8 * 64 * 4;
constexpr int LDS_ATTN = L_X + 8 * 8704;
constexpr float THR = 8.f;
#define KSWZ(row, colB) ((row) * 256 + ((colB) ^ (((row) & 7) << 4)))
#define SBAR() __builtin_amdgcn_sched_barrier(0)
__device__ __forceinline__ int crow(int r, int hi) { return (r & 3) + 8 * (r >> 2) + 4 * hi; }
__device__ __forceinline__ unsigned cvtpk(float lo, float hi) { unsigned r; asm volatile("v_cvt_pk_bf16_f32 %0, %1, %2" : "=v"(r) : "v"(lo), "v"(hi)); return r; }
__device__ __forceinline__ void partialSM(f32x16& p0, f32x16& p1, float& m_reg, float& mn, float& alpha) {
    float pmax = p0[0];
#pragma unroll
    for (int r = 1; r < 16; ++r) pmax = fmaxf(pmax, p0[r]);
#pragma unroll
    for (int r = 0; r < 16; ++r) pmax = fmaxf(pmax, p1[r]);
    { auto rr = __builtin_amdgcn_permlane32_swap(__float_as_uint(pmax), __float_as_uint(pmax), false, false);
      pmax = fmaxf(__uint_as_float(rr[0]), __uint_as_float(rr[1])); }
    if (__builtin_expect(__all(pmax - m_reg <= THR), 1)) { mn = m_reg; alpha = 1.f; }
    else { mn = fmaxf(m_reg, pmax); alpha = __builtin_amdgcn_exp2f(m_reg - mn); m_reg = mn; }
#pragma unroll
    for (int r = 0; r < 16; ++r) { p0[r] -= mn; p1[r] -= mn; }
#pragma unroll
    for (int r = 0; r < 16; ++r) p0[r] = __builtin_amdgcn_exp2f(p0[r]);
}
__device__ __forceinline__ void finishSM(f32x16& p0, f32x16& p1, float alpha, float& l_reg, bf16x8& pa0, bf16x8& pa1, bf16x8& pa2, bf16x8& pa3) {
#pragma unroll
    for (int r = 0; r < 16; ++r) p1[r] = __builtin_amdgcn_exp2f(p1[r]);
    float ps = 0;
#pragma unroll
    for (int r = 0; r < 16; ++r) ps += p0[r];
#pragma unroll
    for (int r = 0; r < 16; ++r) ps += p1[r];
    { auto rr = __builtin_amdgcn_permlane32_swap(__float_as_uint(ps), __float_as_uint(ps), false, false);
      ps = __uint_as_float(rr[0]) + __uint_as_float(rr[1]); }
    l_reg = l_reg * alpha + ps;
#define PK4(P, BASE, OUT) do { unsigned a0 = cvtpk(P[BASE + 0], P[BASE + 1]), a1 = cvtpk(P[BASE + 2], P[BASE + 3]);   \
    unsigned b0 = cvtpk(P[BASE + 4], P[BASE + 5]), b1 = cvtpk(P[BASE + 6], P[BASE + 7]);                              \
    auto r0 = __builtin_amdgcn_permlane32_swap(a0, b0, false, false); auto r1 = __builtin_amdgcn_permlane32_swap(a1, b1, false, false); \
    u32x4 w = {r0[0], r1[0], r0[1], r1[1]}; OUT = *reinterpret_cast<bf16x8*>(&w); } while (0)
    PK4(p0, 0, pa0); PK4(p0, 8, pa1); PK4(p1, 0, pa2); PK4(p1, 8, pa3);
#undef PK4
}
template <int ND0>
__device__ __forceinline__ void qkt(f32x16& p0, f32x16& p1, const char* Ks, const bf16x8* qr, int d0b, int r32, int hi) {
    p0 = f32x16{}; p1 = f32x16{};
#pragma unroll
    for (int d0 = 0; d0 < ND0; ++d0) { const int cb = ((d0b + d0) * 16 + hi * 8) * 2;
        const bf16x8 b0 = *reinterpret_cast<const bf16x8*>(Ks + KSWZ(r32, cb));
        const bf16x8 b1 = *reinterpret_cast<const bf16x8*>(Ks + KSWZ(32 + r32, cb));
        p0 = __builtin_amdgcn_mfma_f32_32x32x16_bf16(b0, qr[d0], p0, 0, 0, 0);
        p1 = __builtin_amdgcn_mfma_f32_32x32x16_bf16(b1, qr[d0], p1, 0, 0, 0); }
}
__device__ __forceinline__ int v_st(int k, int c) { const int kk = (k & ~0xC) | ((k & 4) << 1) | ((k & 8) >> 1); return ((kk >> 3) * 4 + (c >> 5)) * 512 + ((kk & 7) * 32 + (c & 31)) * 2; }
__device__ __forceinline__ int v_rd_base(int lane) { return ((lane & 3) << 3) | (((lane >> 2) & 3) << 6) | (((lane >> 4) & 1) << 5) | (((lane >> 5) & 1) << 8); }
constexpr int v_rd_off(int d0, int ks, int half) { return d0 * 512 + ks * 4096 + half * 2048; }
template <int OFF> __device__ __forceinline__ s16x4 tr_read(int vb) {
    s16x4 r; asm volatile("ds_read_b64_tr_b16 %0, %1 offset:%2" : "=&v"(r) : "v"(vb), "i"(OFF) : "memory"); return r;
}
template <int D0> __device__ __forceinline__ void pv_one(f32x16& od, int vb, bf16x8 pa0, bf16x8 pa1, bf16x8 pa2, bf16x8 pa3) {
    const s16x4 l0 = tr_read<v_rd_off(D0, 0, 0)>(vb), h0 = tr_read<v_rd_off(D0, 0, 1)>(vb), l1 = tr_read<v_rd_off(D0, 1, 0)>(vb), h1 = tr_read<v_rd_off(D0, 1, 1)>(vb);
    const s16x4 l2 = tr_read<v_rd_off(D0, 2, 0)>(vb), h2 = tr_read<v_rd_off(D0, 2, 1)>(vb), l3 = tr_read<v_rd_off(D0, 3, 0)>(vb), h3 = tr_read<v_rd_off(D0, 3, 1)>(vb);
    asm volatile("s_waitcnt lgkmcnt(0)" ::: "memory"); SBAR();
#define PK(L, H) (bf16x8){L[0], L[1], L[2], L[3], H[0], H[1], H[2], H[3]}
    od = __builtin_amdgcn_mfma_f32_32x32x16_bf16(pa0, PK(l0, h0), od, 0, 0, 0);
    od = __builtin_amdgcn_mfma_f32_32x32x16_bf16(pa1, PK(l1, h1), od, 0, 0, 0);
    od = __builtin_amdgcn_mfma_f32_32x32x16_bf16(pa2, PK(l2, h2), od, 0, 0, 0);
    od = __builtin_amdgcn_mfma_f32_32x32x16_bf16(pa3, PK(l3, h3), od, 0, 0, 0);
#undef PK
}
__device__ __forceinline__ void pv_d0(f32x16* o, int vb, bf16x8 pa0, bf16x8 pa1, bf16x8 pa2, bf16x8 pa3) {
    pv_one<0>(o[0], vb, pa0, pa1, pa2, pa3); pv_one<1>(o[1], vb, pa0, pa1, pa2, pa3); pv_one<2>(o[2], vb, pa0, pa1, pa2, pa3); pv_one<3>(o[3], vb, pa0, pa1, pa2, pa3);
}

template <bool DIFF>
__device__ __forceinline__ void attn_unit(const bf16_t* __restrict__ Qlane, const bf16_t* __restrict__ Kh, const bf16_t* __restrict__ Vh, int tq, float slopeL, char* lds, f32x16 (&o)[4], float& l_reg) {
    constexpr int ND0 = DIFF ? 4 : 8;
    const int tid = threadIdx.x, wid = tid >> 6, lane = tid & 63, r32 = lane & 31, hi = lane >> 5;
    char* V_lds = lds + L_V; char* K_lds = lds + L_K;
    float* al_l = (float*)(lds + L_WS) + wid * 64 + 32;
    const int d0b = DIFF ? (wid >> 2) * 4 : 0;
    float m_reg = -1e30f; l_reg = 0.f;
#pragma unroll
    for (int d = 0; d < 4; ++d) o[d] = f32x16{};
    bf16x8 qr[ND0];
#pragma unroll
    for (int d0 = 0; d0 < ND0; ++d0) qr[d0] = *reinterpret_cast<const bf16x8*>(Qlane + d0 * 16 + hi * 8);
    const int sr = tid >> 4, sc = (tid & 15) * 8, vst0 = v_st(sr, sc), vst1 = v_st(32 + sr, sc);
    const int vb0 = (int)(uintptr_t)V_lds + v_rd_base(lane);
    struct { bf16x8 vs0, vs1, ks0, ks1; } st_[1];
#define SLOAD(i, k0) do { st_[i].vs0 = *(const bf16x8*)(&Vh[(size_t)((k0) + sr) * 128 + sc]); st_[i].vs1 = *(const bf16x8*)(&Vh[(size_t)((k0) + 32 + sr) * 128 + sc]); \
    st_[i].ks0 = *(const bf16x8*)(&Kh[(size_t)((k0) + sr) * 128 + sc]); st_[i].ks1 = *(const bf16x8*)(&Kh[(size_t)((k0) + 32 + sr) * 128 + sc]); } while (0)
#define SWRITE(b, i) do { *(bf16x8*)(V_lds + (b) * SHM_V + vst0) = st_[i].vs0; *(bf16x8*)(V_lds + (b) * SHM_V + vst1) = st_[i].vs1; const int kc = sc * 2; \
    *(bf16x8*)(K_lds + (b) * SHM_K + KSWZ(sr, kc)) = st_[i].ks0; *(bf16x8*)(K_lds + (b) * SHM_K + KSWZ(32 + sr, kc)) = st_[i].ks1; } while (0)
#define RESC(a) do { if (__any((a) < 1.f)) { if (hi == 0) al_l[r32] = (a); asm volatile("s_waitcnt lgkmcnt(0)" ::: "memory"); \
    _Pragma("unroll") for (int d = 0; d < 4; ++d) _Pragma("unroll") for (int r = 0; r < 16; ++r) o[d][r] *= al_l[crow(r, hi)]; } } while (0)
#define BIAS(P0, P1, j) do { if (DIFF) { const float base_ = (float)(tq - ((j) - 1) * 64 - 4 * hi); \
    _Pragma("unroll") for (int r = 0; r < 16; ++r) { const float d_ = base_ - (float)((r & 3) + 8 * (r >> 2)); \
        P0[r] = fmaf(-slopeL, fabsf(d_), P0[r]); P1[r] = fmaf(-slopeL, fabsf(d_ - 32.f), P1[r]); } } } while (0)
    f32x16 pA0, pA1, pB0, pB1; float mnA, mnB, alA, alB; bf16x8 pa0, pa1, pa2, pa3;
    SLOAD(0, 0); asm volatile("s_waitcnt vmcnt(0)" ::: "memory"); SWRITE(0, 0); __syncthreads();
    qkt<ND0>(pA0, pA1, K_lds, qr, d0b, r32, hi);
#pragma unroll
    for (int r = 8; r < 16; ++r) pA0[r] = -1e30f;
#pragma unroll
    for (int r = 0; r < 16; ++r) pA1[r] = -1e30f;
    partialSM(pA0, pA1, m_reg, mnA, alA);
    SLOAD(0, 64);
    SWRITE(1, 0); __syncthreads();
    for (int j = 1; j + 1 < NT; j += 2) {
        SBAR(); qkt<ND0>(pB0, pB1, K_lds + SHM_K, qr, d0b, r32, hi); BIAS(pB0, pB1, j);
        finishSM(pA0, pA1, alA, l_reg, pa0, pa1, pa2, pa3); SBAR();
        SLOAD(0, (j + 1) * 64); SBAR();
        pv_d0(o, vb0, pa0, pa1, pa2, pa3); partialSM(pB0, pB1, m_reg, mnB, alB);
        __syncthreads(); SWRITE(0, 0);
        RESC(alB); __syncthreads();
        SBAR(); qkt<ND0>(pA0, pA1, K_lds, qr, d0b, r32, hi); BIAS(pA0, pA1, j + 1);
        finishSM(pB0, pB1, alB, l_reg, pa0, pa1, pa2, pa3); SBAR();
        if (j + 2 < NT) SLOAD(0, (j + 2) * 64); SBAR();
        pv_d0(o, vb0 + SHM_V, pa0, pa1, pa2, pa3); partialSM(pA0, pA1, m_reg, mnA, alA);
        __syncthreads(); if (j + 2 < NT) { SWRITE(1, 0); }
        RESC(alA); __syncthreads();
    }
    finishSM(pA0, pA1, alA, l_reg, pa0, pa1, pa2, pa3); SBAR();
    pv_d0(o, vb0, pa0, pa1, pa2, pa3);
    asm volatile("s_waitcnt lgkmcnt(0)" ::: "memory");
#undef SLOAD
#undef SWRITE
#undef RESC
#undef BIAS
}

template <class RowPtr>
__device__ __forceinline__ void store_tile(const f32x16 (&y)[4], char* stage, int lane, RowPtr rowptr) {
    const int r32 = lane & 31, hi = lane >> 5;
    bf16_t* stg = (bf16_t*)stage;
#pragma unroll
    for (int r = 0; r < 16; ++r) { const int orow = crow(r, hi);
#pragma unroll
        for (int d0 = 0; d0 < 4; ++d0) stg[orow * 136 + d0 * 32 + r32] = (bf16_t)f2bf(y[d0][r]); }
    asm volatile("s_waitcnt lgkmcnt(0)" ::: "memory");
#pragma unroll
    for (int i = 0; i < 8; ++i) { const int row = i * 4 + (lane >> 4), ch = lane & 15;
        const u32x4 v = *(const u32x4*)(stg + row * 136 + ch * 8);
        bf16_t* gp = rowptr(row); if (gp) *(u32x4*)(gp + ch * 8) = v; }
    asm volatile("s_waitcnt lgkmcnt(0)" ::: "memory");
}
}

__device__ void phase2_fast(const Params& p, char* lds, int vb, int nvb) {
    using namespace fa;
    const int tid = threadIdx.x, wid = __builtin_amdgcn_readfirstlane(tid >> 6), lane0 = tid & 63;
    const bf16_t *QA = (const bf16_t*)(p.ws + OFF_QA), *KA = (const bf16_t*)(p.ws + OFF_KA), *VA = (const bf16_t*)(p.ws + OFF_VA);
    const bf16_t *QB = (const bf16_t*)(p.ws + OFF_QB), *KB = (const bf16_t*)(p.ws + OFF_KB), *VB = (const bf16_t*)(p.ws + OFF_VB);
    bf16_t* OA = (bf16_t*)(p.ws + OFF_UN); bf16_t* OB = (bf16_t*)(p.ws + OFF_OB);
    const float lam = *(const float*)(p.ws + OFF_LAM);
    float* li_l = (float*)(lds + L_WS) + wid * 64;
    constexpr int NU_B = NB * 8 * 33, NU_A = NB * 8 * 65;
    for (int u = vb; u < NU_B + NU_A; u += nvb) {
        f32x16 o[4]; float l_reg;
        if (u < NU_B) {
            const int bh = u / 33, qb = u % 33, b = bh >> 3, h = bh & 7;
            const bool is_meta = qb == 32;
            { const int r32q = lane0 & 31; const bool rvalid = !is_meta || (wid == 0 && r32q < 16);
              const int qrow = is_meta ? (rvalid ? SEQ + r32q : SEQ) : qb * 256 + wid * 32 + r32q;
              const size_t kvo = (size_t)(b * 2 + (h >> 2)) * KEYS * 128;
              attn_unit<false>(QB + ((size_t)bh * QROWS + qrow) * 128, KB + kvo, VB + kvo, 0, 0.f, lds, o, l_reg); }
            int lane = lane0; asm volatile("" : "+v"(lane));
            const int r32 = lane & 31, hi = lane >> 5;
            if (hi == 0) li_l[r32] = l_reg;
            asm volatile("s_waitcnt lgkmcnt(0)" ::: "memory");
#pragma unroll
            for (int r = 0; r < 16; ++r) { const float rl = __builtin_amdgcn_rcpf(li_l[crow(r, hi)]);
#pragma unroll
                for (int d = 0; d < 4; ++d) o[d][r] *= rl; }
            const int wave_row0 = is_meta ? 0 : qb * 256 + wid * 32;
            store_tile(o, lds + L_X + wid * 8704, lane, [&](int row) -> bf16_t* {
                if (is_meta) { if (wid != 0 || row >= 16) return nullptr; return OB + (size_t)(MREAL + b * NMETA + row) * DM + h * 128; }
                return OB + (size_t)(b * SEQ + wave_row0 + row) * DM + h * 128; });
            __syncthreads();
        } else {
            const int ua = u - NU_B, bh = ua / 65, qb = ua % 65, b = bh >> 3, h = bh & 7, mp = wid >> 2, wq = wid & 3;
            const bool is_meta = qb == 64;
            { const int r32q = lane0 & 31; const bool rvalid = !is_meta || (wq == 0 && r32q < 16);
              const int qrow = is_meta ? (rvalid ? SEQ + r32q : SEQ) : qb * 128 + wq * 32 + r32q;
              const float slopeL = is_meta ? 0.f : exp2f(-(float)(h + 1)) * LOG2E;
              const size_t kvo = (size_t)bh * KEYS * 128;
              attn_unit<true>(QA + ((size_t)bh * QROWS + qrow) * 128 + mp * 64, KA + kvo, VA + kvo, qrow, slopeL, lds, o, l_reg); }
            int lane = lane0; asm volatile("" : "+v"(lane));
            const int r32 = lane & 31, hi = lane >> 5;
            if (hi == 0) li_l[r32] = l_reg;
            asm volatile("s_waitcnt lgkmcnt(0)" ::: "memory");
#pragma unroll
            for (int r = 0; r < 16; ++r) { const float rl = __builtin_amdgcn_rcpf(li_l[crow(r, hi)]);
#pragma unroll
                for (int d = 0; d < 4; ++d) o[d][r] *= rl; }
            float* X = (float*)(lds + L_X) + wq * 4096;
            if (mp == 1) {
#pragma unroll
                for (int r = 0; r < 16; ++r)
#pragma unroll
                    for (int d = 0; d < 4; ++d) X[(r * 4 + d) * 64 + lane] = o[d][r];
            }
            __syncthreads();
            if (mp == 0) {
                float ss[16];
#pragma unroll
                for (int r = 0; r < 16; ++r) { float a = 0.f;
#pragma unroll
                    for (int d = 0; d < 4; ++d) { const float y = o[d][r] - lam * X[(r * 4 + d) * 64 + lane]; o[d][r] = y; a += y * y; }
                    ss[r] = a; }
#pragma unroll
                for (int r = 0; r < 16; ++r) {
                    float a = ss[r];
                    a += __shfl_xor(a, 1); a += __shfl_xor(a, 2); a += __shfl_xor(a, 4); a += __shfl_xor(a, 8); a += __shfl_xor(a, 16);
                    ss[r] = 1.0f / sqrtf(a * (1.0f / 128.f) + EPS) * (1.0f - LAM_INIT);
                }
                float g[4];
#pragma unroll
                for (int d = 0; d < 4; ++d) g[d] = p.g_subln[d * 32 + r32];
#pragma unroll
                for (int r = 0; r < 16; ++r)
#pragma unroll
                    for (int d = 0; d < 4; ++d) o[d][r] *= ss[r] * g[d];
            }
            __syncthreads();
            if (mp == 0) {
                const int wave_row0 = is_meta ? 0 : qb * 128 + wq * 32;
                store_tile(o, lds + L_X + wid * 8704, lane, [&](int row) -> bf16_t* {
                    if (is_meta) { if (wq != 0 || row >= 16) return nullptr; return OA + (size_t)(MREAL + b * NMETA + row) * DM + h * 128; }
                    return OA + (size_t)(b * SEQ + wave_row0 + row) * DM + h * 128; });
            }
            __syncthreads();
        }
    }
}

__device__ __forceinline__ const bf16_t* sg_row(const Params& p, int grow) { return grow < MREAL ? (const bf16_t*)p.out + (size_t)grow * 2048 : (const bf16_t*)(p.ws + OFF_SGM) + (size_t)(grow - MREAL) * 2048; }
__device__ void phase3a_ref(const Params& p, float* lds, int vb, int nvb, int pass) {
    const bf16_t* A = (const bf16_t*)(p.ws + (pass == 0 ? OFF_UN : OFF_OB));
    const float* W = pass == 0 ? p.w_ba : p.w_bb;
    float* T = (float*)(p.ws + OFF_T); bf16_t* MG = (bf16_t*)(p.ws + OFF_MERGED);
    constexpr int NTM = MPAD / 128, NTN = DM / 128;
    for (int t = vb; t < NTM * NTN; t += nvb) {
        const int tm = t / NTN, tn = t % NTN, row0 = tm * 128, col0 = tn * 128;
        if (row0 >= MROWS) continue;
        ngemm_tile(lds, DM,
            [&](int r) { return A + (size_t)(row0 + r) * DM; },
            [&](int k, int c) { return W[(size_t)k * DM + col0 + c]; },
            [&](const float* Ct) {
                const int tid = threadIdx.x, r = tid >> 2, q = tid & 3, grow = row0 + r;
                if (grow >= MROWS) return;
                const bf16_t* sg = sg_row(p, grow) + (pass == 0 ? 0 : 1024) + col0 + q * 32;
                for (int i = 0; i < 32; ++i) {
                    const float y = Ct[r * 129 + q * 32 + i] * bf2f(sg[i]); const size_t o = (size_t)grow * DM + col0 + q * 32 + i;
                    if (pass == 0) T[o] = y; else MG[o] = (bf16_t)f2bf(T[o] + y);
                }
            });
    }
}
__device__ __forceinline__ float* h2_row(const Params& p, int grow) { return grow < MREAL ? p.out + (size_t)grow * DM : (float*)(p.ws + OFF_H2M) + (size_t)(grow - MREAL) * DM; }
__device__ void phase3b_ref(const Params& p, float* lds, int vb, int nvb) {
    const bf16_t* MG = (const bf16_t*)(p.ws + OFF_MERGED);
    constexpr int NTM = MPAD / 128, NTN = DM / 128;
    for (int t = vb; t < NTM * NTN; t += nvb) {
        const int tm = t / NTN, tn = t % NTN, row0 = tm * 128, col0 = tn * 128;
        if (row0 >= MROWS) continue;
        ngemm_tile(lds, DM,
            [&](int r) { return MG + (size_t)(row0 + r) * DM; },
            [&](int k, int c) { return p.w_out[(size_t)k * DM + col0 + c]; },
            [&](const float* Ct) {
                const int tid = threadIdx.x, r = tid >> 2, q = tid & 3, grow = row0 + r;
                if (grow >= MROWS) return;
                const float* hr = h_row(p, grow) + col0 + q * 32; float* o = h2_row(p, grow) + col0 + q * 32;
                for (int i = 0; i < 32; ++i) o[i] = hr[i] + Ct[r * 129 + q * 32 + i];
            });
    }
}

__device__ void phase4a(const Params& p, float* lds, int vb, int nvb) {
    const int tid = threadIdx.x, lane = tid & 63, wave = tid >> 6;
    for (int i = tid; i < DM * NEXP; i += NTHREADS) { const int k = i >> 4, e = i & 15; lds[e * DM + k] = p.w_router[i]; }
    __syncthreads();
    bf16_t* U2 = (bf16_t*)(p.ws + OFF_UN); float* AFF = (float*)(p.ws + OFF_AFF);
    for (int r = vb * 8 + wave; r < MROWS; r += nvb * 8) {
        const RowInfo ri = row_decode(r);
        const f32x4* xr = (const f32x4*)h2_row(p, r) + lane;
        f32x4 v[4]; float s = 0.f;
#pragma unroll
        for (int j = 0; j < 4; ++j) { v[j] = xr[64 * j]; s += (v[j].x * v[j].x + v[j].y * v[j].y) + (v[j].z * v[j].z + v[j].w * v[j].w); }
        const float rstd = 1.0f / sqrtf(wave_sum(s) * (1.0f / DM) + EPS);
        u32x2* o = (u32x2*)(U2 + (size_t)r * DM) + lane;
#pragma unroll
        for (int j = 0; j < 4; ++j) {
            const f32x4 g = ((const f32x4*)p.g_ffn)[lane + 64 * j];
            v[j].x *= rstd * g.x; v[j].y *= rstd * g.y; v[j].z *= rstd * g.z; v[j].w *= rstd * g.w;
            u32x2 w; w.x = f2bf(v[j].x) | (f2bf(v[j].y) << 16); w.y = f2bf(v[j].z) | (f2bf(v[j].w) << 16);
            o[64 * j] = w;
        }
        float mylg = -1e30f;
#pragma unroll 1
        for (int e = 0; e < NEXP; ++e) {
            float a = 0.f;
#pragma unroll
            for (int j = 0; j < 4; ++j) { const f32x4 w = *(const f32x4*)(lds + e * DM + 4 * (lane + 64 * j)); a += v[j].x * w.x + v[j].y * w.y + v[j].z * w.z + v[j].w * w.w; }
            a = wave_sum(a);
            if (lane == e) mylg = a;
        }
        const float mx = wave_max(mylg);
        const float ex = lane < NEXP ? expf(mylg - mx) : 0.f;
        const float mine = ex / wave_sum(ex);
        if (lane < NEXP) AFF[((size_t)ri.b * NEXP + lane) * LTOT + row_pos(ri)] = mine;
    }
    __syncthreads();
}

__device__ void phase4b_ref(const Params& p, float* lds, int vb, int nvb) {
    const float* AFF = (const float*)(p.ws + OFF_AFF); int* IDX = (int*)(p.ws + OFF_IDX); int* SEL = (int*)(p.ws + OFF_SEL);
    constexpr int NCH = (LTOT + NTHREADS - 1) / NTHREADS;
    for (int t = vb; t < NB * NEXP * NCH; t += nvb) {
        const int be = t / NCH, ch = t % NCH, b = be / NEXP, e = be % NEXP;
        const float* a = AFF + (size_t)be * LTOT;
        __syncthreads();
        for (int i = threadIdx.x; i < LTOT; i += NTHREADS) lds[i] = a[i];
        __syncthreads();
        const int tok = ch * NTHREADS + threadIdx.x;
        if (tok < LTOT) {
            const float mine = lds[tok]; int rank = 0;
            for (int j = 0; j < LTOT; ++j) { const float o = lds[j]; rank += (o > mine || (o == mine && j < tok)) ? 1 : 0; }
            if (rank < CAP) { IDX[(size_t)be * CAP + rank] = tok; SEL[((size_t)b * LTOT + tok) * NEXP + e] = rank; }
            else SEL[((size_t)b * LTOT + tok) * NEXP + e] = -1;
        }
    }
    __syncthreads();
}

__device__ void phase5a_ref(const Params& p, float* lds, int vb, int nvb) {
    const bf16_t* U2 = (const bf16_t*)(p.ws + OFF_UN); const int* IDX = (const int*)(p.ws + OFF_IDX); bf16_t* HID = (bf16_t*)(p.ws + OFF_HID);
    constexpr int NTM = (ESLOTS + 127) / 128, NTN = 2 * EFF / 128;
    for (int t = vb; t < NEXP * NTM * NTN; t += nvb) {
        const int e = t / (NTM * NTN), tm = (t / NTN) % NTM, tn = t % NTN, s0 = tm * 128, f0 = tn * 64;
        const float* Wg = p.w_gate + (size_t)e * DM * EFF; const float* Wu = p.w_up + (size_t)e * DM * EFF;
        ngemm_tile(lds, DM,
            [&](int r) -> const bf16_t* { const int s = s0 + r; if (s >= ESLOTS) return nullptr; const int b = s / CAP, c = s % CAP; return U2 + (size_t)pos_row(b, IDX[((size_t)b * NEXP + e) * CAP + c]) * DM; },
            [&](int k, int c) { return c < 64 ? Wg[(size_t)k * EFF + f0 + c] : Wu[(size_t)k * EFF + f0 + c - 64]; },
            [&](const float* Ct) {
                const int tid = threadIdx.x, r = tid >> 2, q = tid & 3, s = s0 + r;
                if (s >= ESLOTS) return;
                for (int i = 0; i < 16; ++i) { const float g = Ct[r * 129 + q * 16 + i], u = Ct[r * 129 + 64 + q * 16 + i];
                    HID[((size_t)e * ESLOTS + s) * EFF + f0 + q * 16 + i] = (bf16_t)f2bf(g / (1.0f + __expf(-g)) * u); }
            });
    }
}
__device__ void phase5b_ref(const Params& p, float* lds, int vb, int nvb) {
    const bf16_t* HID = (const bf16_t*)(p.ws + OFF_HID); const int* IDX = (const int*)(p.ws + OFF_IDX); const float* AFF = (const float*)(p.ws + OFF_AFF); bf16_t* YB = (bf16_t*)(p.ws + OFF_YB);
    constexpr int NTM = (ESLOTS + 127) / 128, NTN = DM / 128;
    for (int t = vb; t < NEXP * NTM * NTN; t += nvb) {
        const int e = t / (NTM * NTN), tm = (t / NTN) % NTM, tn = t % NTN, s0 = tm * 128, col0 = tn * 128;
        const float* Wd = p.w_down + (size_t)e * EFF * DM;
        ngemm_tile(lds, EFF,
            [&](int r) -> const bf16_t* { const int s = s0 + r; return s < ESLOTS ? HID + ((size_t)e * ESLOTS + s) * EFF : nullptr; },
            [&](int k, int c) { return Wd[(size_t)k * DM + col0 + c]; },
            [&](const float* Ct) {
                const int tid = threadIdx.x, r = tid >> 2, q = tid & 3, s = s0 + r;
                if (s >= ESLOTS) return;
                const int b = s / CAP, c = s % CAP; const int tok = IDX[((size_t)b * NEXP + e) * CAP + c];
                const float af = AFF[((size_t)b * NEXP + e) * LTOT + tok];
                for (int i = 0; i < 32; ++i) YB[((size_t)e * ESLOTS + s) * DM + col0 + q * 32 + i] = (bf16_t)f2bf(Ct[r * 129 + q * 32 + i] * af);
            });
    }
}

__device__ void phase6(const Params& p, int vb, int nvb) {
    const int tid = threadIdx.x, lane = tid & 63, wave = tid >> 6;
    const int* SEL = (const int*)(p.ws + OFF_SEL); const bf16_t* YB = (const bf16_t*)(p.ws + OFF_YB);
    for (int r = vb * 8 + wave; r < MREAL; r += nvb * 8) {
        const int b = r >> 13, tok = NMETA + (r & (SEQ - 1));
        f32x4* xr = (f32x4*)(p.out + (size_t)r * DM) + lane;
        f32x4 v[4];
#pragma unroll
        for (int j = 0; j < 4; ++j) v[j] = xr[64 * j];
        const int sel = lane < NEXP ? SEL[((size_t)b * LTOT + tok) * NEXP + lane] : -1;
        for (int e = 0; e < NEXP; ++e) {
            const int c = __shfl(sel, e);
            if (c >= 0) {
                const u32x2* y = (const u32x2*)(YB + ((size_t)e * ESLOTS + b * CAP + c) * DM) + lane;
#pragma unroll
                for (int j = 0; j < 4; ++j) { const u32x2 w = y[64 * j]; v[j].x += bf2f(w.x & 0xffffu); v[j].y += bf2f(w.x >> 16); v[j].z += bf2f(w.y & 0xffffu); v[j].w += bf2f(w.y >> 16); }
            }
        }
        float s = 0.f;
#pragma unroll
        for (int j = 0; j < 4; ++j) s += (v[j].x * v[j].x + v[j].y * v[j].y) + (v[j].z * v[j].z + v[j].w * v[j].w);
        const float rstd = 1.0f / sqrtf(wave_sum(s) * (1.0f / DM) + EPS);
#pragma unroll
        for (int j = 0; j < 4; ++j) { const f32x4 g = ((const f32x4*)p.g_final)[lane + 64 * j]; xr[64 * j] = (f32x4){v[j].x * rstd * g.x, v[j].y * rstd * g.y, v[j].z * rstd * g.z, v[j].w * rstd * g.w}; }
    }
}

constexpr int LDS_BYTES = 147456;
__global__ void __launch_bounds__(NTHREADS, 2) fwd_kernel(Params p) {
    extern __shared__ __attribute__((aligned(16))) unsigned char lds_raw[];
    float* lds = (float*)lds_raw;
    cg::grid_group grid = cg::this_grid();
    const int vb = blockIdx.x, nvb = gridDim.x;
    phase0(p, vb, nvb);
    grid.sync();
    phase1_ref(p, lds, vb, nvb);
    grid.sync();
#if FAST_ATTN
    phase2_fast(p, (char*)lds_raw, vb, nvb);
#else
    phase2_ref(p, lds, vb, nvb);
#endif
    grid.sync();
    phase3a_ref(p, lds, vb, nvb, 0);
    phase3a_ref(p, lds, vb, nvb, 1);
    grid.sync();
    phase3b_ref(p, lds, vb, nvb);
    grid.sync();
    phase4a(p, lds, vb, nvb);
    grid.sync();
    phase4b_ref(p, lds, vb, nvb);
    grid.sync();
    phase5a_ref(p, lds, vb, nvb);
    grid.sync();
    phase5b_ref(p, lds, vb, nvb);
    grid.sync();
    phase6(p, vb, nvb);
}

extern "C" void kernel_launch(void* const* d_in, const int* in_sizes, int n_in, void* d_out, int out_size, void* d_ws, size_t ws_size, hipStream_t stream) {
    static int grid_blocks = 0;
    if (grid_blocks == 0) {
        if (n_in != 20 || in_sizes[0] != MREAL * DM || out_size != MREAL * DM || ws_size < 256 * MiB) {
            fprintf(stderr, "kernel_launch: unexpected shapes: n_in %d in0 %d out %d ws %zu\n", n_in, n_in > 0 ? in_sizes[0] : -1, out_size, ws_size); grid_blocks = -1; return; }
        int dev = 0, cus = 0, per_cu = 0;
        (void)hipGetDevice(&dev); (void)hipDeviceGetAttribute(&cus, hipDeviceAttributeMultiprocessorCount, dev);
        if (hipFuncSetAttribute((const void*)fwd_kernel, hipFuncAttributeMaxDynamicSharedMemorySize, LDS_BYTES) != hipSuccess) { fprintf(stderr, "kernel_launch: hipFuncSetAttribute failed\n"); grid_blocks = -1; return; }
        if (hipOccupancyMaxActiveBlocksPerMultiprocessor(&per_cu, (const void*)fwd_kernel, NTHREADS, LDS_BYTES) != hipSuccess || per_cu < 1) { fprintf(stderr, "kernel_launch: occupancy query failed (%d)\n", per_cu); grid_blocks = -1; return; }
        grid_blocks = cus * per_cu;
    }
    if (grid_blocks < 0) return;
    Params p{};
    p.x = (const float*)d_in[0]; p.meta = (const float*)d_in[1]; p.g_mix = (const float*)d_in[2]; p.w_in = (const float*)d_in[3];
    p.lq1 = (const float*)d_in[4]; p.lk1 = (const float*)d_in[5]; p.lq2 = (const float*)d_in[6]; p.lk2 = (const float*)d_in[7];
    p.g_subln = (const float*)d_in[8]; p.g_qnorm = (const float*)d_in[9]; p.g_knorm = (const float*)d_in[10];
    p.w_ba = (const float*)d_in[11]; p.w_bb = (const float*)d_in[12]; p.w_out = (const float*)d_in[13]; p.g_ffn = (const float*)d_in[14];
    p.w_router = (const float*)d_in[15]; p.w_gate = (const float*)d_in[16]; p.w_up = (const float*)d_in[17]; p.w_down = (const float*)d_in[18]; p.g_final = (const float*)d_in[19];
    p.out = (float*)d_out; p.ws = (unsigned char*)d_ws;
    void* args[] = {&p};
    hipError_t e = hipLaunchCooperativeKernel((const void*)fwd_kernel, dim3(grid_blocks), dim3(NTHREADS), args, LDS_BYTES, stream);
    if (e != hipSuccess) fprintf(stderr, "kernel_launch: cooperative launch failed: %s (grid %d)\n", hipGetErrorString(e), grid_blocks);
}
```

```cpp
#include <hip/hip_runtime.h>
#include <hip/hip_cooperative_groups.h>
#include <cstdio>
#include <cstdint>
namespace cg = cooperative_groups;

typedef unsigned short bf16_t;
typedef float f32x4 __attribute__((ext_vector_type(4)));
typedef unsigned u32x2 __attribute__((ext_vector_type(2)));
typedef unsigned u32x4 __attribute__((ext_vector_type(4)));

constexpr int NB = 2, SEQ = 8192, DM = 1024, NMETA = 16, LTOT = SEQ + NMETA;
constexpr int MREAL = NB * SEQ;
constexpr int MROWS = MREAL + NB * NMETA;
constexpr int MPAD = 16640;
constexpr int INW = 6656;
constexpr int KEYS = 8256;
constexpr int QROWS = 8256;
constexpr int NEXP = 16, EFF = 512, CAP = 1026, ESLOTS = NB * CAP;
constexpr float EPS = 1e-6f;
constexpr float LOG2E = 1.4426950408889634f;
constexpr float CA = 0.125f * LOG2E;
constexpr float CB = 0.08838834764831845f * LOG2E;
constexpr float LAM_INIT = 0.2f;
constexpr int NTHREADS = 512;
constexpr int AOP = 2048;
#ifndef FAST_ATTN
#define FAST_ATTN 1
#endif
#ifndef FAST_P1
#define FAST_P1 1
#endif
#ifndef FAST_P3
#define FAST_P3 0
#endif
#ifndef FAST_MOE
#define FAST_MOE 0
#endif
__device__ const float INVF[32] = {1.000000000e+00f, 7.498942614e-01f, 5.623413324e-01f, 4.216965139e-01f, 3.162277639e-01f, 2.371373773e-01f, 1.778279394e-01f, 1.333521307e-01f,
    1.000000015e-01f, 7.498941571e-02f, 5.623413250e-02f, 4.216965288e-02f, 3.162277490e-02f, 2.371373773e-02f, 1.778279431e-02f, 1.333521493e-02f,
    9.999999776e-03f, 7.498941850e-03f, 5.623413250e-03f, 4.216964822e-03f, 3.162277630e-03f, 2.371373586e-03f, 1.778279431e-03f, 1.333521446e-03f,
    1.000000047e-03f, 7.498942432e-04f, 5.623413017e-04f, 4.216965172e-04f, 3.162277571e-04f, 2.371373703e-04f, 1.778279402e-04f, 1.333521504e-04f};

constexpr size_t MiB = 1u << 20;
constexpr size_t OFF_ROPE = 0;
constexpr size_t OFF_LAM = 64 * 1024;
constexpr size_t OFF_AFF = 128 * 1024;
constexpr size_t OFF_IDX = OFF_AFF + (size_t)NB * NEXP * LTOT * 4 + 256;
constexpr size_t OFF_SEL = OFF_IDX + (size_t)NB * NEXP * CAP * 4 + 256;
constexpr size_t OFF_SGM = OFF_SEL + (size_t)NB * LTOT * NEXP * 4 + 256;
constexpr size_t OFF_H2M = OFF_SGM + 32 * 2048 * 2;
constexpr size_t OFF_SAFF = OFF_H2M + 32 * 1024 * 4;
constexpr size_t OFF_MISC_END = OFF_SAFF + (size_t)NEXP * ESLOTS * 4;
static_assert(OFF_MISC_END <= 4 * MiB, "misc region");
constexpr size_t OFF_WIN = 4 * MiB;
constexpr size_t OFF_WAB = OFF_WIN + (size_t)INW * DM * 2;
constexpr size_t OFF_WO = OFF_WAB + (size_t)DM * 2048 * 2;
static_assert(OFF_WO + (size_t)DM * DM * 2 <= 24 * MiB, "weights region");
constexpr size_t OFF_AO = 24 * MiB;
constexpr size_t SZ_ROWS = (size_t)MPAD * DM * 2;
constexpr size_t OFF_UN = OFF_AO;
constexpr size_t OFF_HID = OFF_AO + SZ_ROWS;
static_assert((size_t)(NEXP * ESLOTS + 256) * EFF * 2 <= SZ_ROWS, "HID overlay");
constexpr size_t OFF_ATT = OFF_AO + 2 * SZ_ROWS;
constexpr size_t SZ_QH = (size_t)NB * 8 * QROWS * 128 * 2;
constexpr size_t SZ_KVB = (size_t)NB * 2 * KEYS * 128 * 2;
constexpr size_t OFF_QA = OFF_ATT, OFF_KA = OFF_QA + SZ_QH, OFF_VA = OFF_KA + SZ_QH, OFF_QB = OFF_VA + SZ_QH, OFF_KB = OFF_QB + SZ_QH, OFF_VB = OFF_KB + SZ_KVB;
constexpr size_t OFF_ATT_END = OFF_VB + SZ_KVB;
static_assert(OFF_ATT_END <= 256 * MiB, "workspace");
constexpr size_t OFF_MERGED = OFF_ATT;
constexpr size_t OFF_WGU = OFF_ATT + 33 * MiB;
constexpr size_t OFF_WD = OFF_WGU + 32 * MiB;
constexpr size_t OFF_XS = OFF_WD + 16 * MiB;
constexpr size_t OFF_YB = OFF_XS;
static_assert(SZ_ROWS <= 33 * MiB && OFF_XS + (size_t)(NEXP * ESLOTS + 256) * DM * 2 <= 256 * MiB, "overlay map");

struct Params {
    const float *x, *meta, *g_mix, *w_in, *lq1, *lk1, *lq2, *lk2, *g_subln, *g_qnorm, *g_knorm, *w_ba, *w_bb, *w_out, *g_ffn, *w_router, *w_gate, *w_up, *w_down, *g_final;
    float* out; unsigned char* ws;
};

__device__ __forceinline__ int TID() { int t = threadIdx.x; asm volatile("" : "+v"(t)); return t; }
__device__ __forceinline__ unsigned f2bf(float f) { unsigned u = __builtin_bit_cast(unsigned, f); return (u + 0x7fffu + ((u >> 16) & 1u)) >> 16; }
__device__ __forceinline__ float bf2f(unsigned h) { return __builtin_bit_cast(float, h << 16); }
__device__ __forceinline__ float wave_sum(float v) {
#pragma unroll
    for (int o = 1; o < 64; o <<= 1) v += __shfl_xor(v, o);
    return v;
}
__device__ __forceinline__ float wave_max(float v) {
#pragma unroll
    for (int o = 1; o < 64; o <<= 1) v = fmaxf(v, __shfl_xor(v, o));
    return v;
}
struct RowInfo { int b, t, meta, valid; };
__device__ __forceinline__ RowInfo row_decode(int r) {
    RowInfo ri;
    if (r < MREAL) { ri.b = r >> 13; ri.t = r & (SEQ - 1); ri.meta = 0; ri.valid = 1; }
    else if (r < MROWS) { ri.b = (r - MREAL) >> 4; ri.t = (r - MREAL) & 15; ri.meta = 1; ri.valid = 1; }
    else { ri.b = 0; ri.t = 0; ri.meta = 1; ri.valid = 0; }
    return ri;
}
__device__ __forceinline__ int row_key(const RowInfo& ri) { return ri.meta ? ri.t : 64 + ri.t; }
__device__ __forceinline__ int row_q(const RowInfo& ri) { return ri.meta ? SEQ + ri.t : ri.t; }
__device__ __forceinline__ int row_pos(const RowInfo& ri) { return ri.meta ? ri.t : NMETA + ri.t; }
__device__ __forceinline__ int pos_row(int b, int pos) { return pos < NMETA ? MREAL + b * NMETA + pos : b * SEQ + (pos - NMETA); }
__device__ __forceinline__ const float* h_row(const Params& p, int r) { RowInfo ri = row_decode(r); return ri.meta ? p.meta + (size_t)ri.t * DM : p.x + (size_t)r * DM; }

__device__ void phase0(const Params& p, int vb, int nvb) {
    const int tid = TID(), lane = tid & 63, wave = tid >> 6;
    const int gt = vb * NTHREADS + tid;
    if (gt < 128 * 32) {
        const int pos = gt >> 5, j = gt & 31;
        const float ang = (float)pos * INVF[j];
        const double xd = (double)ang, kq = __builtin_rint(xd * 0.15915494309189535);
        const double rr = (xd - kq * 6.283185307179586) * 0.25, r2 = rr * rr;
        double sn = 1.0 / 1307674368000.0, cn = 1.0 / 87178291200.0;
        sn = sn * r2 * -1.0 + 1.0 / 6227020800.0; cn = cn * r2 * -1.0 + 1.0 / 479001600.0;
        sn = sn * r2 * -1.0 + 1.0 / 39916800.0;   cn = cn * r2 * -1.0 + 1.0 / 3628800.0;
        sn = sn * r2 * -1.0 + 1.0 / 362880.0;     cn = cn * r2 * -1.0 + 1.0 / 40320.0;
        sn = sn * r2 * -1.0 + 1.0 / 5040.0;       cn = cn * r2 * -1.0 + 1.0 / 720.0;
        sn = sn * r2 * -1.0 + 1.0 / 120.0;        cn = cn * r2 * -1.0 + 1.0 / 24.0;
        sn = sn * r2 * -1.0 + 1.0 / 6.0;          cn = cn * r2 * -1.0 + 0.5;
        sn = (sn * r2 * -1.0 + 1.0) * rr;         cn = cn * r2 * -1.0 + 1.0;
        double s2 = 2.0 * sn * cn, c2 = cn * cn - sn * sn;
        double s4 = 2.0 * s2 * c2, c4 = c2 * c2 - s2 * s2;
        float2 cs; cs.x = (float)c4; cs.y = (float)s4;
        ((float2*)(p.ws + OFF_ROPE))[gt] = cs;
    }
    if (vb == 0 && wave == 0) {
        float a = p.lq1[lane] * p.lk1[lane], c = p.lq2[lane] * p.lk2[lane];
        a = wave_sum(a); c = wave_sum(c);
        if (lane == 0) *(float*)(p.ws + OFF_LAM) = expf(a) - expf(c) + LAM_INIT;
    }
    bf16_t* UN = (bf16_t*)(p.ws + OFF_UN);
    for (int r = vb * 8 + wave; r < MPAD; r += nvb * 8) {
        u32x2* o = (u32x2*)(UN + (size_t)r * DM) + lane;
        if (r >= MROWS) {
#pragma unroll
            for (int j = 0; j < 4; ++j) o[64 * j] = (u32x2){0u, 0u};
            continue;
        }
        const f32x4* xr = (const f32x4*)h_row(p, r) + lane;
        f32x4 v[4]; float s = 0.f;
#pragma unroll
        for (int j = 0; j < 4; ++j) { v[j] = xr[64 * j]; s += (v[j].x * v[j].x + v[j].y * v[j].y) + (v[j].z * v[j].z + v[j].w * v[j].w); }
        const float rstd = 1.0f / sqrtf(wave_sum(s) * (1.0f / DM) + EPS);
#pragma unroll
        for (int j = 0; j < 4; ++j) {
            const f32x4 g = ((const f32x4*)p.g_mix)[lane + 64 * j];
            u32x2 w; w.x = f2bf(v[j].x * rstd * g.x) | (f2bf(v[j].y * rstd * g.y) << 16); w.y = f2bf(v[j].z * rstd * g.z) | (f2bf(v[j].w * rstd * g.w) << 16);
            o[64 * j] = w;
        }
    }
    {
        bf16_t* KA = (bf16_t*)(p.ws + OFF_KA); bf16_t* VA = (bf16_t*)(p.ws + OFF_VA); bf16_t* KB = (bf16_t*)(p.ws + OFF_KB); bf16_t* VB = (bf16_t*)(p.ws + OFF_VB);
        const int per = 48 * 128 / 8;
        for (int i = vb * NTHREADS + tid; i < (16 + 16 + 4 + 4) * per; i += nvb * NTHREADS) {
            const int bh = i / per, o = i % per; bf16_t* base;
            if (bh < 16) base = KA + (size_t)bh * KEYS * 128; else if (bh < 32) base = VA + (size_t)(bh - 16) * KEYS * 128;
            else if (bh < 36) base = KB + (size_t)(bh - 32) * KEYS * 128; else base = VB + (size_t)(bh - 36) * KEYS * 128;
            ((u32x4*)(base + 16 * 128))[o] = (u32x4){0u, 0u, 0u, 0u};
        }
    }
}

constexpr int NG_AS = 16 * 132, NG_BS = 16 * 128, NG_CT = 128 * 129;
template <class ARow, class BVal, class Epi>
__device__ __forceinline__ void ngemm_tile(float* lds, int K, ARow arow, BVal bval, Epi epi) {
    float* As = lds; float* Bs = lds + NG_AS; float* Ct = lds + NG_AS + NG_BS;
    const int tid = TID(), ty = tid >> 4, tx = tid & 15;
    const int ar = tid >> 2, ak = (tid & 3) * 4; const bf16_t* ap = arow(ar);
    const int bk = tid >> 5, bc = (tid & 31) * 4;
    float acc[4][8];
#pragma unroll
    for (int i = 0; i < 4; ++i)
#pragma unroll
        for (int j = 0; j < 8; ++j) acc[i][j] = 0.f;
    for (int k0 = 0; k0 < K; k0 += 16) {
        u32x2 av = (u32x2){0u, 0u}; if (ap) av = *(const u32x2*)(ap + k0 + ak);
        float b0 = bval(k0 + bk, bc), b1 = bval(k0 + bk, bc + 1), b2 = bval(k0 + bk, bc + 2), b3 = bval(k0 + bk, bc + 3);
        __syncthreads();
        As[(ak + 0) * 132 + ar] = bf2f(av.x & 0xffffu); As[(ak + 1) * 132 + ar] = bf2f(av.x >> 16);
        As[(ak + 2) * 132 + ar] = bf2f(av.y & 0xffffu); As[(ak + 3) * 132 + ar] = bf2f(av.y >> 16);
        *(f32x4*)(Bs + bk * 128 + bc) = (f32x4){b0, b1, b2, b3};
        __syncthreads();
#pragma unroll
        for (int k = 0; k < 16; ++k) {
            const f32x4 a = *(const f32x4*)(As + k * 132 + ty * 4);
            const f32x4 bA = *(const f32x4*)(Bs + k * 128 + tx * 8), bB = *(const f32x4*)(Bs + k * 128 + tx * 8 + 4);
            const float av4[4] = {a.x, a.y, a.z, a.w}; const float bv8[8] = {bA.x, bA.y, bA.z, bA.w, bB.x, bB.y, bB.z, bB.w};
#pragma unroll
            for (int i = 0; i < 4; ++i)
#pragma unroll
                for (int j = 0; j < 8; ++j) acc[i][j] = fmaf(av4[i], bv8[j], acc[i][j]);
        }
    }
    __syncthreads();
#pragma unroll
    for (int i = 0; i < 4; ++i)
#pragma unroll
        for (int j = 0; j < 8; ++j) Ct[(ty * 4 + i) * 129 + tx * 8 + j] = acc[i][j];
    __syncthreads();
    epi(Ct);
    __syncthreads();
}

__device__ void inproj_epi(const Params& p, const float* Ct, int row0, int col0) {
    const int tid = TID(), r = tid >> 2, q = tid & 3;
    const int grow = row0 + r; const RowInfo ri = row_decode(grow);
    const float* c = Ct + r * 129;
    float v[4][8];
#pragma unroll
    for (int g = 0; g < 4; ++g)
#pragma unroll
        for (int i = 0; i < 8; ++i) v[g][i] = c[g * 32 + 8 * q + i];
    const int sec = col0 < 1024 ? 0 : col0 < 2048 ? 1 : col0 < 3072 ? 2 : col0 < 4096 ? 3 : col0 < 4352 ? 4 : col0 < 4608 ? 5 : col0 < 5632 ? 6 : 7;
    const int secbase = sec == 0 ? 0 : sec == 1 ? 1024 : sec == 2 ? 2048 : sec == 3 ? 3072 : sec == 4 ? 4096 : sec == 5 ? 4352 : sec == 6 ? 4608 : 5632;
    const int head = (col0 - secbase) >> 7;
    if (sec == 3 || sec == 4) {
        float ss = 0.f;
#pragma unroll
        for (int g = 0; g < 4; ++g)
#pragma unroll
            for (int i = 0; i < 8; ++i) ss += v[g][i] * v[g][i];
        ss += __shfl_xor(ss, 1); ss += __shfl_xor(ss, 2);
        const float rstd = 1.0f / sqrtf(ss * (1.0f / 128.f) + EPS);
        const float* gn = sec == 3 ? p.g_qnorm : p.g_knorm;
#pragma unroll
        for (int g = 0; g < 4; ++g)
#pragma unroll
            for (int i = 0; i < 8; ++i) v[g][i] = v[g][i] * rstd * gn[g * 32 + 8 * q + i];
        if (!ri.meta) {
            const float2* rope = (const float2*)(p.ws + OFF_ROPE);
            const int prow = ri.t >> 6, pcol = ri.t & 63;
#pragma unroll
            for (int i = 0; i < 8; ++i) {
                const float2 cr = rope[prow * 32 + 8 * q + i], cc = rope[pcol * 32 + 8 * q + i];
                const float x1 = v[0][i], x2 = v[1][i]; v[0][i] = x1 * cr.x - x2 * cr.y; v[1][i] = x2 * cr.x + x1 * cr.y;
                const float y1 = v[2][i], y2 = v[3][i]; v[2][i] = y1 * cc.x - y2 * cc.y; v[3][i] = y2 * cc.x + y1 * cc.y;
            }
        }
    }
    if (!ri.valid) return;
    bf16_t* dst; float sc = 1.f; bool sig = false;
    if (sec == 0) { dst = (bf16_t*)(p.ws + OFF_QA) + ((size_t)(ri.b * 8 + head) * QROWS + row_q(ri)) * 128; sc = CA; }
    else if (sec == 1) dst = (bf16_t*)(p.ws + OFF_KA) + ((size_t)(ri.b * 8 + head) * KEYS + row_key(ri)) * 128;
    else if (sec == 2) dst = (bf16_t*)(p.ws + OFF_VA) + ((size_t)(ri.b * 8 + head) * KEYS + row_key(ri)) * 128;
    else if (sec == 3) { dst = (bf16_t*)(p.ws + OFF_QB) + ((size_t)(ri.b * 8 + head) * QROWS + row_q(ri)) * 128; sc = CB; }
    else if (sec == 4) dst = (bf16_t*)(p.ws + OFF_KB) + ((size_t)(ri.b * 2 + head) * KEYS + row_key(ri)) * 128;
    else if (sec == 5) dst = (bf16_t*)(p.ws + OFF_VB) + ((size_t)(ri.b * 2 + head) * KEYS + row_key(ri)) * 128;
    else { sig = true; const int cbase = (sec == 7 ? 1024 : 0) + head * 128;
           dst = (grow < MREAL ? (bf16_t*)p.out + (size_t)grow * 2048 : (bf16_t*)(p.ws + OFF_SGM) + (size_t)(grow - MREAL) * 2048) + cbase; }
#pragma unroll
    for (int g = 0; g < 4; ++g)
#pragma unroll
        for (int i = 0; i < 8; ++i) { float y = v[g][i] * sc; if (sig) y = 1.0f / (1.0f + __expf(-y)); dst[g * 32 + 8 * q + i] = (bf16_t)f2bf(y); }
}
__device__ void phase1_ref(const Params& p, float* lds, int vb, int nvb) {
    const bf16_t* UN = (const bf16_t*)(p.ws + OFF_UN);
    constexpr int NTM = MPAD / 128, NTN = INW / 128;
    for (int t = vb; t < NTM * NTN; t += nvb) {
        const int tm = t / NTN, tn = t % NTN, row0 = tm * 128, col0 = tn * 128;
        if (row0 >= MROWS) continue;
        ngemm_tile(lds, DM,
            [&](int r) { return UN + (size_t)(row0 + r) * DM; },
            [&](int k, int c) { return p.w_in[(size_t)k * INW + col0 + c]; },
            [&](const float* Ct) { inproj_epi(p, Ct, row0, col0); });
    }
}

__device__ float attn_row_ref(const bf16_t* qrow, int dq, const bf16_t* Kh, int kcol0, const bf16_t* Vh, float slopeC, int tq  ,
                              float* sc, float* qf, int lane, float& o0, float& o1) {
    if (lane < dq / 2) { const unsigned w = ((const unsigned*)qrow)[lane]; qf[2 * lane] = bf2f(w & 0xffffu); qf[2 * lane + 1] = bf2f(w >> 16); }
    __builtin_amdgcn_s_waitcnt(0);
    float mx = -1e30f;
    for (int i = 0; i < KEYS / 64; ++i) {
        const int kk = i * 64 + lane;
        const bf16_t* kr = Kh + (size_t)kk * 128 + kcol0;
        float s = 0.f;
        for (int d = 0; d < dq; d += 8) {
            const u32x4 w = *(const u32x4*)(kr + d);
            s = fmaf(qf[d + 0], bf2f(w.x & 0xffffu), s); s = fmaf(qf[d + 1], bf2f(w.x >> 16), s);
            s = fmaf(qf[d + 2], bf2f(w.y & 0xffffu), s); s = fmaf(qf[d + 3], bf2f(w.y >> 16), s);
            s = fmaf(qf[d + 4], bf2f(w.z & 0xffffu), s); s = fmaf(qf[d + 5], bf2f(w.z >> 16), s);
            s = fmaf(qf[d + 6], bf2f(w.w & 0xffffu), s); s = fmaf(qf[d + 7], bf2f(w.w >> 16), s);
        }
        const bool valid = kk < NMETA || kk >= 64;
        if (tq >= 0 && kk >= 64) s -= slopeC * fabsf((float)(tq - (kk - 64)));
        if (!valid) s = -1e30f;
        sc[kk] = s; mx = fmaxf(mx, s);
    }
    mx = wave_max(mx);
    float sum = 0.f;
    for (int i = 0; i < KEYS / 64; ++i) { const int kk = i * 64 + lane; const float pr = (kk < NMETA || kk >= 64) ? exp2f(sc[kk] - mx) : 0.f; sc[kk] = pr; sum += pr; }
    sum = wave_sum(sum);
    __builtin_amdgcn_s_waitcnt(0);
    float a0 = 0.f, a1 = 0.f;
    const unsigned* V2 = (const unsigned*)Vh + lane;
#pragma unroll 8
    for (int kk = 0; kk < KEYS; ++kk) {
        if (kk >= NMETA && kk < 64) continue;
        const float pr = sc[kk]; const unsigned w = V2[(size_t)kk * 64];
        a0 = fmaf(pr, bf2f(w & 0xffffu), a0); a1 = fmaf(pr, bf2f(w >> 16), a1);
    }
    o0 = a0; o1 = a1;
    return sum;
}
__device__ void phase2_ref(const Params& p, float* lds, int vb, int nvb) {
    const int tid = TID(), lane = tid & 63, wave = tid >> 6;
    if (wave >= 4) return;
    float* sc = lds + wave * KEYS; float* qf = lds + 4 * KEYS + wave * 128;
    const bf16_t *QA = (const bf16_t*)(p.ws + OFF_QA), *KA = (const bf16_t*)(p.ws + OFF_KA), *VA = (const bf16_t*)(p.ws + OFF_VA);
    const bf16_t *QB = (const bf16_t*)(p.ws + OFF_QB), *KB = (const bf16_t*)(p.ws + OFF_KB), *VB = (const bf16_t*)(p.ws + OFF_VB);
    bf16_t* OA = (bf16_t*)(p.ws + OFF_AO); bf16_t* OB = OA + 1024;
    const float lam = *(const float*)(p.ws + OFF_LAM);
    const int NTASK = 2 * 8 * MROWS / NB;
    for (int task = vb * 4 + wave; task < 2 * 8 * MROWS; task += nvb * 4) {
        const int type = task / (8 * MROWS), rem = task % (8 * MROWS), h = rem / MROWS, r = rem % MROWS;
        const RowInfo ri = row_decode(r); const int qr = row_q(ri); const int tq = ri.meta ? -1 : ri.t;
        if (type == 0) {
            const size_t bh = (size_t)(ri.b * 8 + h);
            const float slopeC = exp2f(-(float)(h + 1)) * LOG2E;
            float a0, a1, b0, b1;
            const float l1 = attn_row_ref(QA + (bh * QROWS + qr) * 128, 64, KA + bh * KEYS * 128, 0, VA + bh * KEYS * 128, slopeC, tq, sc, qf, lane, a0, a1);
            const float l2 = attn_row_ref(QA + (bh * QROWS + qr) * 128 + 64, 64, KA + bh * KEYS * 128, 64, VA + bh * KEYS * 128, slopeC, tq, sc, qf, lane, b0, b1);
            float y0 = a0 / l1 - lam * (b0 / l2), y1 = a1 / l1 - lam * (b1 / l2);
            const float ss = wave_sum(y0 * y0 + y1 * y1);
            const float rstd = 1.0f / sqrtf(ss * (1.0f / 128.f) + EPS) * (1.0f - LAM_INIT);
            y0 = y0 * rstd * p.g_subln[2 * lane]; y1 = y1 * rstd * p.g_subln[2 * lane + 1];
            ((unsigned*)(OA + (size_t)r * AOP + h * 128))[lane] = f2bf(y0) | (f2bf(y1) << 16);
        } else {
            const size_t bh = (size_t)(ri.b * 8 + h), bk = (size_t)(ri.b * 2 + (h >> 2));
            float a0, a1;
            const float l = attn_row_ref(QB + (bh * QROWS + qr) * 128, 128, KB + bk * KEYS * 128, 0, VB + bk * KEYS * 128, 0.f, -1, sc, qf, lane, a0, a1);
            ((unsigned*)(OB + (size_t)r * AOP + h * 128))[lane] = f2bf(a0 / l) | (f2bf(a1 / l) << 16);
        }
    }
    (void)NTASK;
}

namespace fa {
using bf16x8 = __attribute__((ext_vector_type(8))) short;
using s16x4  = __attribute__((ext_vector_type(4))) short;
using f32x16 = __attribute__((ext_vector_type(16))) float;
constexpr int NT = KEYS / 64;
constexpr int SHM_V = 16384, SHM_K = 16384;
constexpr int L_V = 0, L_K = 2 * SHM_V, L_WS = L_K + 2 * SHM_K, L_X = L_WS + 8 * 64 * 4;
constexpr int LDS_ATTN = L_X + 8 * 8704;
constexpr float THR = 8.f;
#define KSWZ(row, colB) ((row) * 256 + ((colB) ^ (((row) & 7) << 4)))
#define SBAR() __builtin_amdgcn_sched_barrier(0)
__device__ __forceinline__ int crow(int r, int hi) { return (r & 3) + 8 * (r >> 2) + 4 * hi; }
__device__ __forceinline__ unsigned cvtpk(float lo, float hi) { unsigned r; asm volatile("v_cvt_pk_bf16_f32 %0, %1, %2" : "=v"(r) : "v"(lo), "v"(hi)); return r; }
__device__ __forceinline__ void partialSM(f32x16& p0, f32x16& p1, float& m_reg, float& mn, float& alpha) {
    float pmax = p0[0];
#pragma unroll
    for (int r = 1; r < 16; ++r) pmax = fmaxf(pmax, p0[r]);
#pragma unroll
    for (int r = 0; r < 16; ++r) pmax = fmaxf(pmax, p1[r]);
    { auto rr = __builtin_amdgcn_permlane32_swap(__float_as_uint(pmax), __float_as_uint(pmax), false, false);
      pmax = fmaxf(__uint_as_float(rr[0]), __uint_as_float(rr[1])); }
    if (__builtin_expect(__all(pmax - m_reg <= THR), 1)) { mn = m_reg; alpha = 1.f; }
    else { mn = fmaxf(m_reg, pmax); alpha = __builtin_amdgcn_exp2f(m_reg - mn); m_reg = mn; }
#pragma unroll
    for (int r = 0; r < 16; ++r) { p0[r] -= mn; p1[r] -= mn; }
#pragma unroll
    for (int r = 0; r < 16; ++r) p0[r] = __builtin_amdgcn_exp2f(p0[r]);
}
__device__ __forceinline__ void finishSM(f32x16& p0, f32x16& p1, float alpha, float& l_reg, bf16x8& pa0, bf16x8& pa1, bf16x8& pa2, bf16x8& pa3) {
#pragma unroll
    for (int r = 0; r < 16; ++r) p1[r] = __builtin_amdgcn_exp2f(p1[r]);
    float ps = 0;
#pragma unroll
    for (int r = 0; r < 16; ++r) ps += p0[r];
#pragma unroll
    for (int r = 0; r < 16; ++r) ps += p1[r];
    { auto rr = __builtin_amdgcn_permlane32_swap(__float_as_uint(ps), __float_as_uint(ps), false, false);
      ps = __uint_as_float(rr[0]) + __uint_as_float(rr[1]); }
    l_reg = l_reg * alpha + ps;
#define PK4(P, BASE, OUT) do { unsigned a0 = cvtpk(P[BASE + 0], P[BASE + 1]), a1 = cvtpk(P[BASE + 2], P[BASE + 3]);   \
    unsigned b0 = cvtpk(P[BASE + 4], P[BASE + 5]), b1 = cvtpk(P[BASE + 6], P[BASE + 7]);                              \
    auto r0 = __builtin_amdgcn_permlane32_swap(a0, b0, false, false); auto r1 = __builtin_amdgcn_permlane32_swap(a1, b1, false, false); \
    u32x4 w = {r0[0], r1[0], r0[1], r1[1]}; OUT = *reinterpret_cast<bf16x8*>(&w); } while (0)
    PK4(p0, 0, pa0); PK4(p0, 8, pa1); PK4(p1, 0, pa2); PK4(p1, 8, pa3);
#undef PK4
}
template <int ND0>
__device__ __forceinline__ void qkt(f32x16& p0, f32x16& p1, const char* Ks, const bf16x8* qr, int d0b, int r32, int hi) {
    p0 = f32x16{}; p1 = f32x16{};
#pragma unroll
    for (int d0 = 0; d0 < ND0; ++d0) { const int cb = ((d0b + d0) * 16 + hi * 8) * 2;
        const bf16x8 b0 = *reinterpret_cast<const bf16x8*>(Ks + KSWZ(r32, cb));
        const bf16x8 b1 = *reinterpret_cast<const bf16x8*>(Ks + KSWZ(32 + r32, cb));
        p0 = __builtin_amdgcn_mfma_f32_32x32x16_bf16(b0, qr[d0], p0, 0, 0, 0);
        p1 = __builtin_amdgcn_mfma_f32_32x32x16_bf16(b1, qr[d0], p1, 0, 0, 0); }
}
__device__ __forceinline__ int v_st(int k, int c) { const int kk = (k & ~0xC) | ((k & 4) << 1) | ((k & 8) >> 1); return ((kk >> 3) * 4 + (c >> 5)) * 512 + ((kk & 7) * 32 + (c & 31)) * 2; }
__device__ __forceinline__ int v_rd_base(int lane) { return ((lane & 3) << 3) | (((lane >> 2) & 3) << 6) | (((lane >> 4) & 1) << 5) | (((lane >> 5) & 1) << 8); }
constexpr int v_rd_off(int d0, int ks, int half) { return d0 * 512 + ks * 4096 + half * 2048; }
template <int OFF> __device__ __forceinline__ s16x4 tr_read(int vb) {
    s16x4 r; asm volatile("ds_read_b64_tr_b16 %0, %1 offset:%2" : "=&v"(r) : "v"(vb), "i"(OFF) : "memory"); return r;
}
template <int D0> __device__ __forceinline__ void pv_one(f32x16& od, int vb, bf16x8 pa0, bf16x8 pa1, bf16x8 pa2, bf16x8 pa3) {
    const s16x4 l0 = tr_read<v_rd_off(D0, 0, 0)>(vb), h0 = tr_read<v_rd_off(D0, 0, 1)>(vb), l1 = tr_read<v_rd_off(D0, 1, 0)>(vb), h1 = tr_read<v_rd_off(D0, 1, 1)>(vb);
    const s16x4 l2 = tr_read<v_rd_off(D0, 2, 0)>(vb), h2 = tr_read<v_rd_off(D0, 2, 1)>(vb), l3 = tr_read<v_rd_off(D0, 3, 0)>(vb), h3 = tr_read<v_rd_off(D0, 3, 1)>(vb);
    asm volatile("s_waitcnt lgkmcnt(0)" ::: "memory"); SBAR();
#define PK(L, H) (bf16x8){L[0], L[1], L[2], L[3], H[0], H[1], H[2], H[3]}
    od = __builtin_amdgcn_mfma_f32_32x32x16_bf16(pa0, PK(l0, h0), od, 0, 0, 0);
    od = __builtin_amdgcn_mfma_f32_32x32x16_bf16(pa1, PK(l1, h1), od, 0, 0, 0);
    od = __builtin_amdgcn_mfma_f32_32x32x16_bf16(pa2, PK(l2, h2), od, 0, 0, 0);
    od = __builtin_amdgcn_mfma_f32_32x32x16_bf16(pa3, PK(l3, h3), od, 0, 0, 0);
#undef PK
}
__device__ __forceinline__ void pv_d0(f32x16* o, int vb, bf16x8 pa0, bf16x8 pa1, bf16x8 pa2, bf16x8 pa3) {
    pv_one<0>(o[0], vb, pa0, pa1, pa2, pa3); pv_one<1>(o[1], vb, pa0, pa1, pa2, pa3); pv_one<2>(o[2], vb, pa0, pa1, pa2, pa3); pv_one<3>(o[3], vb, pa0, pa1, pa2, pa3);
}

template <bool DIFF>
__device__ __forceinline__ void attn_unit(const bf16_t* __restrict__ Qlane, const bf16_t* __restrict__ Kh, const bf16_t* __restrict__ Vh, int tq, float slopeL, char* lds, f32x16 (&o)[4], float& l_reg) {
    constexpr int ND0 = DIFF ? 4 : 8;
    const int tid = TID(), wid = tid >> 6, lane = tid & 63, r32 = lane & 31, hi = lane >> 5;
    char* V_lds = lds + L_V; char* K_lds = lds + L_K;
    float* al_l = (float*)(lds + L_WS) + wid * 64 + 32;
    const int d0b = DIFF ? (wid >> 2) * 4 : 0;
    float m_reg = -1e30f; l_reg = 0.f;
#pragma unroll
    for (int d = 0; d < 4; ++d) o[d] = f32x16{};
    bf16x8 qr[ND0];
#pragma unroll
    for (int d0 = 0; d0 < ND0; ++d0) qr[d0] = *reinterpret_cast<const bf16x8*>(Qlane + d0 * 16 + hi * 8);
    const int sr = tid >> 4, sc = (tid & 15) * 8, vst0 = v_st(sr, sc), vst1 = v_st(32 + sr, sc);
    const int vb0 = (int)(uintptr_t)V_lds + v_rd_base(lane);
    struct { bf16x8 vs0, vs1, ks0, ks1; } st_[1];
#define SLOAD(i, k0) do { st_[i].vs0 = *(const bf16x8*)(&Vh[(size_t)((k0) + sr) * 128 + sc]); st_[i].vs1 = *(const bf16x8*)(&Vh[(size_t)((k0) + 32 + sr) * 128 + sc]); \
    st_[i].ks0 = *(const bf16x8*)(&Kh[(size_t)((k0) + sr) * 128 + sc]); st_[i].ks1 = *(const bf16x8*)(&Kh[(size_t)((k0) + 32 + sr) * 128 + sc]); } while (0)
#define SWRITE(b, i) do { *(bf16x8*)(V_lds + (b) * SHM_V + vst0) = st_[i].vs0; *(bf16x8*)(V_lds + (b) * SHM_V + vst1) = st_[i].vs1; const int kc = sc * 2; \
    *(bf16x8*)(K_lds + (b) * SHM_K + KSWZ(sr, kc)) = st_[i].ks0; *(bf16x8*)(K_lds + (b) * SHM_K + KSWZ(32 + sr, kc)) = st_[i].ks1; } while (0)
#define RESC(a) do { if (__any((a) < 1.f)) { if (hi == 0) al_l[r32] = (a); asm volatile("s_waitcnt lgkmcnt(0)" ::: "memory"); \
    _Pragma("unroll") for (int d = 0; d < 4; ++d) _Pragma("unroll") for (int r = 0; r < 16; ++r) o[d][r] *= al_l[crow(r, hi)]; } } while (0)
#define BIAS(P0, P1, j) do { if (DIFF) { const float base_ = (float)(tq - ((j) - 1) * 64 - 4 * hi); \
    _Pragma("unroll") for (int r = 0; r < 16; ++r) { const float d_ = base_ - (float)((r & 3) + 8 * (r >> 2)); \
        P0[r] = fmaf(-slopeL, fabsf(d_), P0[r]); P1[r] = fmaf(-slopeL, fabsf(d_ - 32.f), P1[r]); } } } while (0)
    f32x16 pA0, pA1, pB0, pB1; float mnA, mnB, alA, alB; bf16x8 pa0, pa1, pa2, pa3;
    SLOAD(0, 0); asm volatile("s_waitcnt vmcnt(0)" ::: "memory"); SWRITE(0, 0); __syncthreads();
    qkt<ND0>(pA0, pA1, K_lds, qr, d0b, r32, hi);
#pragma unroll
    for (int r = 8; r < 16; ++r) pA0[r] = -1e30f;
#pragma unroll
    for (int r = 0; r < 16; ++r) pA1[r] = -1e30f;
    partialSM(pA0, pA1, m_reg, mnA, alA);
    SLOAD(0, 64);
    SWRITE(1, 0); __syncthreads();
    for (int j = 1; j + 1 < NT; j += 2) {
        SBAR(); qkt<ND0>(pB0, pB1, K_lds + SHM_K, qr, d0b, r32, hi); BIAS(pB0, pB1, j);
        finishSM(pA0, pA1, alA, l_reg, pa0, pa1, pa2, pa3); SBAR();
        SLOAD(0, (j + 1) * 64); SBAR();
        pv_d0(o, vb0, pa0, pa1, pa2, pa3); partialSM(pB0, pB1, m_reg, mnB, alB);
        __syncthreads(); SWRITE(0, 0);
        RESC(alB); __syncthreads();
        SBAR(); qkt<ND0>(pA0, pA1, K_lds, qr, d0b, r32, hi); BIAS(pA0, pA1, j + 1);
        finishSM(pB0, pB1, alB, l_reg, pa0, pa1, pa2, pa3); SBAR();
        if (j + 2 < NT) SLOAD(0, (j + 2) * 64); SBAR();
        pv_d0(o, vb0 + SHM_V, pa0, pa1, pa2, pa3); partialSM(pA0, pA1, m_reg, mnA, alA);
        __syncthreads(); if (j + 2 < NT) { SWRITE(1, 0); }
        RESC(alA); __syncthreads();
    }
    finishSM(pA0, pA1, alA, l_reg, pa0, pa1, pa2, pa3); SBAR();
    pv_d0(o, vb0, pa0, pa1, pa2, pa3);
    asm volatile("s_waitcnt lgkmcnt(0)" ::: "memory");
#undef SLOAD
#undef SWRITE
#undef RESC
#undef BIAS
}

template <class RowPtr>
__device__ __forceinline__ void store_tile(const f32x16 (&y)[4], char* stage, int lane, RowPtr rowptr) {
    const int r32 = lane & 31, hi = lane >> 5;
    bf16_t* stg = (bf16_t*)stage;
#pragma unroll
    for (int r = 0; r < 16; ++r) { const int orow = crow(r, hi);
#pragma unroll
        for (int d0 = 0; d0 < 4; ++d0) stg[orow * 136 + d0 * 32 + r32] = (bf16_t)f2bf(y[d0][r]); }
    asm volatile("s_waitcnt lgkmcnt(0)" ::: "memory");
#pragma unroll
    for (int i = 0; i < 8; ++i) { const int row = i * 4 + (lane >> 4), ch = lane & 15;
        const u32x4 v = *(const u32x4*)(stg + row * 136 + ch * 8);
        bf16_t* gp = rowptr(row); if (gp) *(u32x4*)(gp + ch * 8) = v; }
    asm volatile("s_waitcnt lgkmcnt(0)" ::: "memory");
}
}

__device__ void phase2_fast(const Params& p, char* lds, int vb, int nvb) {
    using namespace fa;
    const int tid = TID(), wid = __builtin_amdgcn_readfirstlane(tid >> 6), lane0 = tid & 63;
    const bf16_t *QA = (const bf16_t*)(p.ws + OFF_QA), *KA = (const bf16_t*)(p.ws + OFF_KA), *VA = (const bf16_t*)(p.ws + OFF_VA);
    const bf16_t *QB = (const bf16_t*)(p.ws + OFF_QB), *KB = (const bf16_t*)(p.ws + OFF_KB), *VB = (const bf16_t*)(p.ws + OFF_VB);
    bf16_t* OA = (bf16_t*)(p.ws + OFF_AO); bf16_t* OB = OA + 1024;
    const float lam = *(const float*)(p.ws + OFF_LAM);
    float* li_l = (float*)(lds + L_WS) + wid * 64;
    constexpr int NU_B = NB * 8 * 33, NU_A = NB * 8 * 65;
    for (int u = vb; u < NU_B + NU_A; u += nvb) {
        f32x16 o[4]; float l_reg;
        if (u < NU_B) {
            const int bh = u / 33, qb = u % 33, b = bh >> 3, h = bh & 7;
            const bool is_meta = qb == 32;
            { const int r32q = lane0 & 31; const bool rvalid = !is_meta || (wid == 0 && r32q < 16);
              const int qrow = is_meta ? (rvalid ? SEQ + r32q : SEQ) : qb * 256 + wid * 32 + r32q;
              const size_t kvo = (size_t)(b * 2 + (h >> 2)) * KEYS * 128;
              attn_unit<false>(QB + ((size_t)bh * QROWS + qrow) * 128, KB + kvo, VB + kvo, 0, 0.f, lds, o, l_reg); }
            int lane = lane0; asm volatile("" : "+v"(lane));
            const int r32 = lane & 31, hi = lane >> 5;
            if (hi == 0) li_l[r32] = l_reg;
            asm volatile("s_waitcnt lgkmcnt(0)" ::: "memory");
#pragma unroll
            for (int r = 0; r < 16; ++r) { const float rl = __builtin_amdgcn_rcpf(li_l[crow(r, hi)]);
#pragma unroll
                for (int d = 0; d < 4; ++d) o[d][r] *= rl; }
            const int wave_row0 = is_meta ? 0 : qb * 256 + wid * 32;
            store_tile(o, lds + L_X + wid * 8704, lane, [&](int row) -> bf16_t* {
                if (is_meta) { if (wid != 0 || row >= 16) return nullptr; return OB + (size_t)(MREAL + b * NMETA + row) * AOP + h * 128; }
                return OB + (size_t)(b * SEQ + wave_row0 + row) * AOP + h * 128; });
            __syncthreads();
        } else {
            const int ua = u - NU_B, bh = ua / 65, qb = ua % 65, b = bh >> 3, h = bh & 7, mp = wid >> 2, wq = wid & 3;
            const bool is_meta = qb == 64;
            { const int r32q = lane0 & 31; const bool rvalid = !is_meta || (wq == 0 && r32q < 16);
              const int qrow = is_meta ? (rvalid ? SEQ + r32q : SEQ) : qb * 128 + wq * 32 + r32q;
              const float slopeL = is_meta ? 0.f : exp2f(-(float)(h + 1)) * LOG2E;
              const size_t kvo = (size_t)bh * KEYS * 128;
              attn_unit<true>(QA + ((size_t)bh * QROWS + qrow) * 128 + mp * 64, KA + kvo, VA + kvo, qrow, slopeL, lds, o, l_reg); }
            int lane = lane0; asm volatile("" : "+v"(lane));
            const int r32 = lane & 31, hi = lane >> 5;
            if (hi == 0) li_l[r32] = l_reg;
            asm volatile("s_waitcnt lgkmcnt(0)" ::: "memory");
#pragma unroll
            for (int r = 0; r < 16; ++r) { const float rl = __builtin_amdgcn_rcpf(li_l[crow(r, hi)]);
#pragma unroll
                for (int d = 0; d < 4; ++d) o[d][r] *= rl; }
            float* X = (float*)(lds + L_X) + wq * 4096;
            if (mp == 1) {
#pragma unroll
                for (int r = 0; r < 16; ++r)
#pragma unroll
                    for (int d = 0; d < 4; ++d) X[(r * 4 + d) * 64 + lane] = o[d][r];
            }
            __syncthreads();
            if (mp == 0) {
                float ss[16];
#pragma unroll
                for (int r = 0; r < 16; ++r) { float a = 0.f;
#pragma unroll
                    for (int d = 0; d < 4; ++d) { const float y = o[d][r] - lam * X[(r * 4 + d) * 64 + lane]; o[d][r] = y; a += y * y; }
                    ss[r] = a; }
#pragma unroll
                for (int r = 0; r < 16; ++r) {
                    float a = ss[r];
                    a += __shfl_xor(a, 1); a += __shfl_xor(a, 2); a += __shfl_xor(a, 4); a += __shfl_xor(a, 8); a += __shfl_xor(a, 16);
                    ss[r] = 1.0f / sqrtf(a * (1.0f / 128.f) + EPS) * (1.0f - LAM_INIT);
                }
                float g[4];
#pragma unroll
                for (int d = 0; d < 4; ++d) g[d] = p.g_subln[d * 32 + r32];
#pragma unroll
                for (int r = 0; r < 16; ++r)
#pragma unroll
                    for (int d = 0; d < 4; ++d) o[d][r] *= ss[r] * g[d];
            }
            __syncthreads();
            if (mp == 0) {
                const int wave_row0 = is_meta ? 0 : qb * 128 + wq * 32;
                store_tile(o, lds + L_X + wid * 8704, lane, [&](int row) -> bf16_t* {
                    if (is_meta) { if (wq != 0 || row >= 16) return nullptr; return OA + (size_t)(MREAL + b * NMETA + row) * AOP + h * 128; }
                    return OA + (size_t)(b * SEQ + wave_row0 + row) * AOP + h * 128; });
            }
            __syncthreads();
        }
    }
}

__device__ __forceinline__ const bf16_t* sg_row(const Params& p, int grow) { return grow < MREAL ? (const bf16_t*)p.out + (size_t)grow * 2048 : (const bf16_t*)(p.ws + OFF_SGM) + (size_t)(grow - MREAL) * 2048; }
__device__ void phase3a_ref(const Params& p, float* lds, int vb, int nvb, int pass) {
    const bf16_t* A = (const bf16_t*)(p.ws + OFF_AO) + (pass == 0 ? 0 : 1024);
    const float* W = pass == 0 ? p.w_ba : p.w_bb;
    float* T = (float*)(p.ws + OFF_WGU); bf16_t* MG = (bf16_t*)(p.ws + OFF_MERGED);
    constexpr int NTM = MPAD / 128, NTN = DM / 128;
    for (int t = vb; t < NTM * NTN; t += nvb) {
        const int tm = t / NTN, tn = t % NTN, row0 = tm * 128, col0 = tn * 128;
        if (row0 >= MROWS) continue;
        ngemm_tile(lds, DM,
            [&](int r) { return A + (size_t)(row0 + r) * AOP; },
            [&](int k, int c) { return W[(size_t)k * DM + col0 + c]; },
            [&](const float* Ct) {
                const int tid = TID(), r = tid >> 2, q = tid & 3, grow = row0 + r;
                if (grow >= MROWS) return;
                const bf16_t* sg = sg_row(p, grow) + (pass == 0 ? 0 : 1024) + col0 + q * 32;
                for (int i = 0; i < 32; ++i) {
                    const float y = Ct[r * 129 + q * 32 + i] * bf2f(sg[i]); const size_t o = (size_t)grow * DM + col0 + q * 32 + i;
                    if (pass == 0) T[o] = y; else MG[o] = (bf16_t)f2bf(T[o] + y);
                }
            });
    }
}
__device__ __forceinline__ float* h2_row(const Params& p, int grow) { return grow < MREAL ? p.out + (size_t)grow * DM : (float*)(p.ws + OFF_H2M) + (size_t)(grow - MREAL) * DM; }
__device__ void phase3b_ref(const Params& p, float* lds, int vb, int nvb) {
    const bf16_t* MG = (const bf16_t*)(p.ws + OFF_MERGED);
    constexpr int NTM = MPAD / 128, NTN = DM / 128;
    for (int t = vb; t < NTM * NTN; t += nvb) {
        const int tm = t / NTN, tn = t % NTN, row0 = tm * 128, col0 = tn * 128;
        if (row0 >= MROWS) continue;
        ngemm_tile(lds, DM,
            [&](int r) { return MG + (size_t)(row0 + r) * DM; },
            [&](int k, int c) { return p.w_out[(size_t)k * DM + col0 + c]; },
            [&](const float* Ct) {
                const int tid = TID(), r = tid >> 2, q = tid & 3, grow = row0 + r;
                if (grow >= MROWS) return;
                const float* hr = h_row(p, grow) + col0 + q * 32; float* o = h2_row(p, grow) + col0 + q * 32;
                for (int i = 0; i < 32; ++i) o[i] = hr[i] + Ct[r * 129 + q * 32 + i];
            });
    }
}

__device__ void phase4a(const Params& p, float* lds, int vb, int nvb) {
    const int tid = TID(), lane = tid & 63, wave = tid >> 6;
    for (int i = tid; i < DM * NEXP; i += NTHREADS) { const int k = i >> 4, e = i & 15; lds[e * DM + k] = p.w_router[i]; }
    __syncthreads();
    bf16_t* U2 = (bf16_t*)(p.ws + OFF_UN); float* AFF = (float*)(p.ws + OFF_AFF);
    for (int r = vb * 8 + wave; r < MROWS; r += nvb * 8) {
        const RowInfo ri = row_decode(r);
        const f32x4* xr = (const f32x4*)h2_row(p, r) + lane;
        f32x4 v[4]; float s = 0.f;
#pragma unroll
        for (int j = 0; j < 4; ++j) { v[j] = xr[64 * j]; s += (v[j].x * v[j].x + v[j].y * v[j].y) + (v[j].z * v[j].z + v[j].w * v[j].w); }
        const float rstd = 1.0f / sqrtf(wave_sum(s) * (1.0f / DM) + EPS);
        u32x2* o = (u32x2*)(U2 + (size_t)r * DM) + lane;
#pragma unroll
        for (int j = 0; j < 4; ++j) {
            const f32x4 g = ((const f32x4*)p.g_ffn)[lane + 64 * j];
            v[j].x *= rstd * g.x; v[j].y *= rstd * g.y; v[j].z *= rstd * g.z; v[j].w *= rstd * g.w;
            u32x2 w; w.x = f2bf(v[j].x) | (f2bf(v[j].y) << 16); w.y = f2bf(v[j].z) | (f2bf(v[j].w) << 16);
            o[64 * j] = w;
        }
        float mylg = -1e30f;
#pragma unroll 1
        for (int e = 0; e < NEXP; ++e) {
            float a = 0.f;
#pragma unroll
            for (int j = 0; j < 4; ++j) { const f32x4 w = *(const f32x4*)(lds + e * DM + 4 * (lane + 64 * j)); a += v[j].x * w.x + v[j].y * w.y + v[j].z * w.z + v[j].w * w.w; }
            a = wave_sum(a);
            if (lane == e) mylg = a;
        }
        const float mx = wave_max(mylg);
        const float ex = lane < NEXP ? expf(mylg - mx) : 0.f;
        const float mine = ex / wave_sum(ex);
        if (lane < NEXP) AFF[((size_t)ri.b * NEXP + lane) * LTOT + row_pos(ri)] = mine;
    }
    __syncthreads();
}

__device__ void phase4b_ref(const Params& p, float* lds, int vb, int nvb) {
    const float* AFF = (const float*)(p.ws + OFF_AFF); int* IDX = (int*)(p.ws + OFF_IDX); int* SEL = (int*)(p.ws + OFF_SEL);
    constexpr int NCH = (LTOT + NTHREADS - 1) / NTHREADS;
    for (int t = vb; t < NB * NEXP * NCH; t += nvb) {
        const int be = t / NCH, ch = t % NCH, b = be / NEXP, e = be % NEXP;
        const float* a = AFF + (size_t)be * LTOT;
        __syncthreads();
        for (int i = TID(); i < LTOT; i += NTHREADS) lds[i] = a[i];
        __syncthreads();
        const int tok = ch * NTHREADS + TID();
        if (tok < LTOT) {
            const float mine = lds[tok]; int rank = 0;
            for (int j = 0; j < LTOT; ++j) { const float o = lds[j]; rank += (o > mine || (o == mine && j < tok)) ? 1 : 0; }
            if (rank < CAP) { IDX[(size_t)be * CAP + rank] = tok; SEL[((size_t)b * LTOT + tok) * NEXP + e] = rank; }
            else SEL[((size_t)b * LTOT + tok) * NEXP + e] = -1;
        }
    }
    __syncthreads();
}

__device__ void phase5a_ref(const Params& p, float* lds, int vb, int nvb) {
    const bf16_t* U2 = (const bf16_t*)(p.ws + OFF_UN); const int* IDX = (const int*)(p.ws + OFF_IDX); bf16_t* HID = (bf16_t*)(p.ws + OFF_HID);
    constexpr int NTM = (ESLOTS + 127) / 128, NTN = 2 * EFF / 128;
    for (int t = vb; t < NEXP * NTM * NTN; t += nvb) {
        const int e = t / (NTM * NTN), tm = (t / NTN) % NTM, tn = t % NTN, s0 = tm * 128, f0 = tn * 64;
        const float* Wg = p.w_gate + (size_t)e * DM * EFF; const float* Wu = p.w_up + (size_t)e * DM * EFF;
        ngemm_tile(lds, DM,
            [&](int r) -> const bf16_t* { const int s = s0 + r; if (s >= ESLOTS) return nullptr; const int b = s / CAP, c = s % CAP; return U2 + (size_t)pos_row(b, IDX[((size_t)b * NEXP + e) * CAP + c]) * DM; },
            [&](int k, int c) { return c < 64 ? Wg[(size_t)k * EFF + f0 + c] : Wu[(size_t)k * EFF + f0 + c - 64]; },
            [&](const float* Ct) {
                const int tid = TID(), r = tid >> 2, q = tid & 3, s = s0 + r;
                if (s >= ESLOTS) return;
                for (int i = 0; i < 16; ++i) { const float g = Ct[r * 129 + q * 16 + i], u = Ct[r * 129 + 64 + q * 16 + i];
                    HID[((size_t)e * ESLOTS + s) * EFF + f0 + q * 16 + i] = (bf16_t)f2bf(g / (1.0f + __expf(-g)) * u); }
            });
    }
}
__device__ void phase5b_ref(const Params& p, float* lds, int vb, int nvb) {
    const bf16_t* HID = (const bf16_t*)(p.ws + OFF_HID); const int* IDX = (const int*)(p.ws + OFF_IDX); const float* AFF = (const float*)(p.ws + OFF_AFF); bf16_t* YB = (bf16_t*)(p.ws + OFF_YB);
    constexpr int NTM = (ESLOTS + 127) / 128, NTN = DM / 128;
    for (int t = vb; t < NEXP * NTM * NTN; t += nvb) {
        const int e = t / (NTM * NTN), tm = (t / NTN) % NTM, tn = t % NTN, s0 = tm * 128, col0 = tn * 128;
        const float* Wd = p.w_down + (size_t)e * EFF * DM;
        ngemm_tile(lds, EFF,
            [&](int r) -> const bf16_t* { const int s = s0 + r; return s < ESLOTS ? HID + ((size_t)e * ESLOTS + s) * EFF : nullptr; },
            [&](int k, int c) { return Wd[(size_t)k * DM + col0 + c]; },
            [&](const float* Ct) {
                const int tid = TID(), r = tid >> 2, q = tid & 3, s = s0 + r;
                if (s >= ESLOTS) return;
                const int b = s / CAP, c = s % CAP; const int tok = IDX[((size_t)b * NEXP + e) * CAP + c];
                const float af = AFF[((size_t)b * NEXP + e) * LTOT + tok];
                for (int i = 0; i < 32; ++i) YB[((size_t)e * ESLOTS + s) * DM + col0 + q * 32 + i] = (bf16_t)f2bf(Ct[r * 129 + q * 32 + i] * af);
            });
    }
}

__device__ void phase6(const Params& p, int vb, int nvb) {
    const int tid = TID(), lane = tid & 63, wave = tid >> 6;
    const int* SEL = (const int*)(p.ws + OFF_SEL); const bf16_t* YB = (const bf16_t*)(p.ws + OFF_YB);
    for (int r = vb * 8 + wave; r < MREAL; r += nvb * 8) {
        const int b = r >> 13, tok = NMETA + (r & (SEQ - 1));
        f32x4* xr = (f32x4*)(p.out + (size_t)r * DM) + lane;
        f32x4 v[4];
#pragma unroll
        for (int j = 0; j < 4; ++j) v[j] = xr[64 * j];
        const int sel = lane < NEXP ? SEL[((size_t)b * LTOT + tok) * NEXP + lane] : -1;
        for (int e = 0; e < NEXP; ++e) {
            const int c = __shfl(sel, e);
            if (c >= 0) {
                const u32x2* y = (const u32x2*)(YB + ((size_t)e * ESLOTS + b * CAP + c) * DM) + lane;
#pragma unroll
                for (int j = 0; j < 4; ++j) { const u32x2 w = y[64 * j]; v[j].x += bf2f(w.x & 0xffffu); v[j].y += bf2f(w.x >> 16); v[j].z += bf2f(w.y & 0xffffu); v[j].w += bf2f(w.y >> 16); }
            }
        }
        float s = 0.f;
#pragma unroll
        for (int j = 0; j < 4; ++j) s += (v[j].x * v[j].x + v[j].y * v[j].y) + (v[j].z * v[j].z + v[j].w * v[j].w);
        const float rstd = 1.0f / sqrtf(wave_sum(s) * (1.0f / DM) + EPS);
#pragma unroll
        for (int j = 0; j < 4; ++j) { const f32x4 g = ((const f32x4*)p.g_final)[lane + 64 * j]; xr[64 * j] = (f32x4){v[j].x * rstd * g.x, v[j].y * rstd * g.y, v[j].z * rstd * g.z, v[j].w * rstd * g.w}; }
    }
}

template <class DstRow>
__device__ __forceinline__ void transpose_item(const float* __restrict__ W, int N, bf16_t* __restrict__ WT, int ldk, int koff, float* scr, int k0, int n0, int lane, DstRow dst) {
#pragma unroll 8
    for (int i = 0; i < 32; ++i) { const int kk = 2 * i + (lane >> 5); scr[kk * 33 + (lane & 31)] = W[(size_t)(k0 + kk) * N + n0 + (lane & 31)]; }
    asm volatile("s_waitcnt vmcnt(0) lgkmcnt(0)" ::: "memory");
    const int c = lane & 7;
#pragma unroll
    for (int j = 0; j < 4; ++j) { const int n = (lane >> 3) + 8 * j; const float* sp = scr + (8 * c) * 33 + n;
        u32x4 o; o.x = f2bf(sp[0 * 33]) | (f2bf(sp[1 * 33]) << 16); o.y = f2bf(sp[2 * 33]) | (f2bf(sp[3 * 33]) << 16);
        o.z = f2bf(sp[4 * 33]) | (f2bf(sp[5 * 33]) << 16); o.w = f2bf(sp[6 * 33]) | (f2bf(sp[7 * 33]) << 16);
        *(u32x4*)(WT + (size_t)dst(n0 + n) * ldk + koff + k0 + 8 * c) = o; }
    asm volatile("s_waitcnt lgkmcnt(0)" ::: "memory");
}
__device__ __forceinline__ int rope_slot(int e) { const int half = e >> 6, el = e & 63, j = el & 31, n = el >> 5, g = half * 8 + (j >> 2); return 32 * (g >> 2) + 8 * (g & 3) + 4 * n + (j & 3); }
__device__ void transpose_p0(const Params& p, float* lds, int vb, int nvb) {
    const int tid = TID(), lane = tid & 63, wave = tid >> 6;
    float* scr = lds + wave * (64 * 33);
    bf16_t* WIN = (bf16_t*)(p.ws + OFF_WIN); bf16_t* WAB = (bf16_t*)(p.ws + OFF_WAB); bf16_t* WO = (bf16_t*)(p.ws + OFF_WO);
    constexpr int I_IN = 16 * (INW / 32), I_SQ = 16 * 32;
    for (int it = vb * 8 + wave; it < I_IN + 3 * I_SQ; it += nvb * 8) {
        int r = it;
        if (r < I_IN) { const int kb = r / (INW / 32), nb = r % (INW / 32);
            transpose_item(p.w_in, INW, WIN, DM, 0, scr, kb * 64, nb * 32, lane, [](int n) { return (n >= 3072 && n < 4352) ? (n & ~127) + rope_slot(n & 127) : n; }); continue; }
        r -= I_IN; const int m = r / I_SQ, q = r % I_SQ, kb = q / 32, nb = q % 32;
        if (m == 0) transpose_item(p.w_ba, DM, WAB, 2048, 0, scr, kb * 64, nb * 32, lane, [](int n) { return n; });
        else if (m == 1) transpose_item(p.w_bb, DM, WAB, 2048, 1024, scr, kb * 64, nb * 32, lane, [](int n) { return n; });
        else transpose_item(p.w_out, DM, WO, DM, 0, scr, kb * 64, nb * 32, lane, [](int n) { return n; });
    }
}
__device__ void transpose_moe(const Params& p, float* lds, int vbl, int nvbl) {
    const int tid = TID(), lane = tid & 63, wave = tid >> 6;
    float* scr = lds + wave * (64 * 33);
    bf16_t* WGU = (bf16_t*)(p.ws + OFF_WGU); bf16_t* WD = (bf16_t*)(p.ws + OFF_WD);
    constexpr int I_G = 16 * 16, I_D = 8 * 32, I_E = 2 * I_G + I_D;
    for (int it = vbl * 8 + wave; it < NEXP * I_E; it += nvbl * 8) {
        const int e = it / I_E; int r = it % I_E;
        if (r < 2 * I_G) { const int up = r / I_G, q = r % I_G, kb = q / 16, nb = q % 16;
            const float* W = (up ? p.w_up : p.w_gate) + (size_t)e * DM * EFF;
            transpose_item(W, EFF, WGU + (size_t)e * DM * DM, DM, 0, scr, kb * 64, nb * 32, lane, [up](int f) { return 8 * (f >> 2) + 4 * up + (f & 3); }); }
        else { r -= 2 * I_G; const int kb = r / 32, nb = r % 32;
            transpose_item(p.w_down + (size_t)e * EFF * DM, DM, WD + (size_t)e * DM * EFF, EFF, 0, scr, kb * 64, nb * 32, lane, [](int n) { return n; }); }
    }
}

namespace pg8 {
#define PG8_LAS __attribute__((address_space(3)))
typedef short bf16x8 __attribute__((ext_vector_type(8)));
constexpr int BM = 256, BK = 64, HALF = 128, HTB = HALF * BK * 2, STAGE_BYTES = 8 * HTB, NXCD = 8, WGM = 8;
__host__ __device__ __forceinline__ int lds_byte(int r, int c) { const int st = (r >> 4) * 2 + (c >> 5), rr = r & 15, cc = c & 31, ob = rr * 64 + cc * 2; return st * 1024 + (ob ^ (((ob >> 9) & 1) << 5)); }
__host__ __device__ __forceinline__ void stage_rc(int b, int& R, int& C) { const int st = b / 1024, sb = b % 1024, swz = sb ^ (((sb >> 9) & 1) << 5); R = (st >> 1) * 16 + swz / 64; C = (st & 1) * 32 + (swz % 64) / 2; }
__host__ __device__ __forceinline__ int perm32(int rho) { const int n = rho >> 4, i = rho & 15; return 8 * (i >> 2) + 4 * n + (i & 3); }
struct Unit { int arow0, brow0, pm, pn, e; };
struct Gemm { const bf16_t* A; const bf16_t* Bt; int K; };
struct GridOrder {
    int nM, nN, nwg, G, c;
    __device__ void init(int nM_, int nN_, int G_, int c_) { nM = nM_; nN = nN_; nwg = nM * nN; G = G_; c = c_; }
    __device__ bool next(int i, Unit& u) const {
        const long L = (long)i * G + c; if (L >= nwg) return false;
        int wgid = (int)L; { const int q = nwg / NXCD, r = nwg % NXCD, xcd = wgid % NXCD, off = wgid / NXCD; wgid = (xcd < r ? xcd * (q + 1) : r * (q + 1) + (xcd - r) * q) + off; }
        const int nig = WGM * nN, gid = wgid / nig, fm = gid * WGM, gsz = (nM - fm) < WGM ? (nM - fm) : WGM;
        u.pm = fm + ((wgid % nig) % gsz); u.pn = (wgid % nig) / gsz; u.e = 0; u.arow0 = u.pm * BM; u.brow0 = u.pn * BM; return true;
    }
};
struct MoeOrder {
    int G, c;
    __device__ bool next(int i, Unit& u) const {
        const int L = i * G + c; if (L >= NEXP * 36) return false;
        u.e = L / 36; const int r = L % 36; u.pm = r % 9; u.pn = r / 9; u.arow0 = u.e * ESLOTS + u.pm * BM; u.brow0 = u.e * DM + u.pn * BM; return true;
    }
};
__device__ __forceinline__ unsigned cvt_pk_bf16(float lo, float hi) { unsigned r; asm volatile("v_cvt_pk_bf16_f32 %0, %1, %2" : "=v"(r) : "v"(lo), "v"(hi)); return r; }

template <class Epi, class Sched>
__device__ __forceinline__ void gemm_phase(PG8_LAS unsigned char* lds, const Gemm g, const Sched& S, const Epi& E) {
    const int tid = TID(), wid = __builtin_amdgcn_readfirstlane(tid >> 6), lane = tid & 63, wr = wid >> 2, wc = wid & 3, fr = lane & 15, fq = lane >> 4;
    const int K = g.K, nt = K / BK;
    unsigned voffA[2], voffB[2];
#pragma unroll
    for (int i = 0; i < 2; ++i) { int R, C; stage_rc(tid * 16 + i * 8192, R, C); const int Rb = Epi::PERM ? ((R & ~31) + perm32(R & 31)) : R;
        voffA[i] = (unsigned)(R * K + C) * 2u; voffB[i] = (unsigned)(Rb * K + C) * 2u; }
    const size_t kstep = (size_t)(BK * 2);
    const size_t hstep = (size_t)HALF * K * 2;
    const size_t rstep = (size_t)K * 2;
    const unsigned ldsw = (unsigned)wid * 1024u;
    const int aoff = lds_byte(wr * 64 + fr, fq * 8), boff = lds_byte(wc * 32 + fr, fq * 8);
#define PG8_SA(b, h) (((b) * 2 + (h)) * HTB)
#define PG8_SB(b, h) ((4 + (b) * 2 + (h)) * HTB)
#define PG8_STAGE(bufoff, gbase, voff) do { _Pragma("unroll") for (int _i = 0; _i < 2; ++_i) \
        __builtin_amdgcn_global_load_lds((const unsigned*)((const char*)(gbase) + (voff)[_i]), (PG8_LAS unsigned*)(lds + (bufoff) + ldsw + _i * 8192), 16, 0, 0); } while (0)
#define PG8_LDA(dst, b, h) do { _Pragma("unroll") for (int m = 0; m < 4; ++m) _Pragma("unroll") for (int k = 0; k < 2; ++k) dst[m][k] = *(const PG8_LAS bf16x8*)(lds + PG8_SA(b, h) + aoff + m * 2048 + k * 1024); } while (0)
#define PG8_LDB(dst, b, h) do { _Pragma("unroll") for (int n = 0; n < 2; ++n) _Pragma("unroll") for (int k = 0; k < 2; ++k) dst[n][k] = *(const PG8_LAS bf16x8*)(lds + PG8_SB(b, h) + boff + n * 2048 + k * 1024); } while (0)
#define PG8_MMA(ai, bj, At, Bt) do { __builtin_amdgcn_s_setprio(1); _Pragma("unroll") for (int m = 0; m < 4; ++m) _Pragma("unroll") for (int n = 0; n < 2; ++n) _Pragma("unroll") for (int k = 0; k < 2; ++k) \
        acc[ai][bj][m][n] = __builtin_amdgcn_mfma_f32_16x16x32_bf16(Bt[n][k], At[m][k], acc[ai][bj][m][n], 0, 0, 0); __builtin_amdgcn_s_setprio(0); } while (0)
#define PG8_WAIT_V(n) asm volatile("s_waitcnt vmcnt(" #n ")" ::: "memory")
#define PG8_WAIT_L(n) asm volatile("s_waitcnt lgkmcnt(" #n ")" ::: "memory")
#define PG8_BAR __builtin_amdgcn_s_barrier()
#define PG8_SCHED __builtin_amdgcn_sched_barrier(0)
    Unit cur, nxt; int ui = 0;
    if (!S.next(0, cur)) return;
    f32x4 acc[2][2][4][2];
#pragma unroll
    for (int a = 0; a < 2; ++a)
#pragma unroll
        for (int b = 0; b < 2; ++b)
#pragma unroll
            for (int m = 0; m < 4; ++m)
#pragma unroll
                for (int n = 0; n < 2; ++n) acc[a][b][m][n] = (f32x4){0.f, 0.f, 0.f, 0.f};
    bf16x8 At[4][2], B0[2][2], B1[2][2];
    const char* cA = (const char*)g.A + (size_t)cur.arow0 * rstep; const char* cB = (const char*)g.Bt + (size_t)cur.brow0 * rstep;
    PG8_STAGE(PG8_SB(0, 0), cB, voffB); PG8_STAGE(PG8_SB(0, 1), cB + hstep, voffB); PG8_STAGE(PG8_SA(0, 0), cA, voffA); PG8_STAGE(PG8_SA(0, 1), cA + hstep, voffA);
    if (wr == 1) PG8_BAR;
    PG8_WAIT_V(2); PG8_BAR;
    PG8_STAGE(PG8_SB(1, 0), cB + kstep, voffB); PG8_STAGE(PG8_SA(1, 0), cA + kstep, voffA); PG8_STAGE(PG8_SB(1, 1), cB + hstep + kstep, voffB);
    PG8_WAIT_V(6); PG8_BAR;
    for (;;) {
        const bool has_next = S.next(ui + 1, nxt);
        const char* nA = has_next ? (const char*)g.A + (size_t)nxt.arow0 * rstep : cA; const char* nB = has_next ? (const char*)g.Bt + (size_t)nxt.brow0 * rstep : cB;
        for (int t = 0; t < nt; t += 2) {
            const bool last = (t == nt - 2);
            const char* a1 = cA + (size_t)(t + 1) * kstep;
            const char* a2 = last ? nA : cA + (size_t)(t + 2) * kstep; const char* b2 = last ? nB : cB + (size_t)(t + 2) * kstep;
            const char* a3 = a2 + kstep; const char* b3 = b2 + kstep;
            if constexpr (Epi::HAS_MID) { if (t == nt / 2) E.mid(acc, cur, wr, wc, fr, fq); }
            PG8_LDB(B0, 0, 0); PG8_LDB(B1, 0, 1); PG8_SCHED; PG8_LDA(At, 0, 0); PG8_STAGE(PG8_SA(1, 1), a1 + hstep, voffA);
            PG8_WAIT_V(8); PG8_WAIT_L(0); PG8_BAR; PG8_MMA(0, 0, At, B0); PG8_MMA(0, 1, At, B1); PG8_BAR; PG8_SCHED;
            PG8_LDA(At, 0, 1); PG8_STAGE(PG8_SB(0, 0), b2, voffB); PG8_STAGE(PG8_SB(0, 1), b2 + hstep, voffB); PG8_STAGE(PG8_SA(0, 0), a2, voffA);
            PG8_WAIT_V(8); PG8_WAIT_L(0); PG8_BAR; PG8_MMA(1, 0, At, B0); PG8_MMA(1, 1, At, B1); PG8_BAR; PG8_SCHED;
            PG8_LDB(B0, 1, 0); PG8_LDB(B1, 1, 1); PG8_SCHED; PG8_LDA(At, 1, 0); PG8_STAGE(PG8_SA(0, 1), a2 + hstep, voffA);
            PG8_WAIT_V(8); PG8_WAIT_L(0); PG8_BAR; PG8_MMA(0, 0, At, B0); PG8_MMA(0, 1, At, B1); PG8_BAR; PG8_SCHED;
            PG8_LDA(At, 1, 1); PG8_STAGE(PG8_SB(1, 0), b3, voffB); PG8_STAGE(PG8_SB(1, 1), b3 + hstep, voffB); PG8_STAGE(PG8_SA(1, 0), a3, voffA);
            PG8_WAIT_V(8); PG8_WAIT_L(0); PG8_BAR; PG8_MMA(1, 0, At, B0); PG8_MMA(1, 1, At, B1); PG8_BAR; PG8_SCHED;
        }
        if (wr == 0) PG8_BAR;
        E(acc, cur, wr, wc, fr, fq, lds);
        if (!has_next) break;
#pragma unroll
        for (int a = 0; a < 2; ++a)
#pragma unroll
            for (int b = 0; b < 2; ++b)
#pragma unroll
                for (int m = 0; m < 4; ++m)
#pragma unroll
                    for (int n = 0; n < 2; ++n) acc[a][b][m][n] = (f32x4){0.f, 0.f, 0.f, 0.f};
        cur = nxt; cA = nA; cB = nB; ++ui;
        if (wr == 1) PG8_BAR;
    }
    PG8_WAIT_V(0);
    PG8_BAR;
#undef PG8_SA
#undef PG8_SB
#undef PG8_STAGE
#undef PG8_LDA
#undef PG8_LDB
#undef PG8_MMA
#undef PG8_WAIT_V
#undef PG8_WAIT_L
#undef PG8_SCHED
}
#define PG8_FOR_AM _Pragma("unroll") for (int ai = 0; ai < 2; ++ai) _Pragma("unroll") for (int m = 0; m < 4; ++m)
#define PG8_FOR_BJ _Pragma("unroll") for (int bj = 0; bj < 2; ++bj)

struct EpiInProj {
    static constexpr bool PERM = true, HAS_MID = false;
    Params p;
    __device__ __forceinline__ void operator()(f32x4 (&acc)[2][2][4][2], const Unit& u, int wr, int wc, int fr, int fq, PG8_LAS unsigned char* lds) const {
        const int pn = u.pn;
        const int sec = pn < 4 ? 0 : pn < 8 ? 1 : pn < 12 ? 2 : pn < 16 ? 3 : pn == 16 ? 4 : pn == 17 ? 5 : pn < 22 ? 6 : 7;
        const int head0 = (sec == 0 ? pn : sec == 1 ? pn - 4 : sec == 2 ? pn - 8 : sec == 3 ? pn - 12 : sec == 6 ? pn - 18 : sec == 7 ? pn - 22 : 0) * 2;
        const int cl = wc * 32 + fq * 8;
        if (sec == 3 || sec == 4) {
            PG8_LAS float* X = (PG8_LAS float*)(lds + STAGE_BYTES);
            PG8_FOR_AM { PG8_FOR_BJ { const f32x4 a = acc[ai][bj][m][0], b = acc[ai][bj][m][1];
                float ss = (a.x * a.x + a.y * a.y) + (a.z * a.z + a.w * a.w) + (b.x * b.x + b.y * b.y) + (b.z * b.z + b.w * b.w);
                ss += __shfl_xor(ss, 16); ss += __shfl_xor(ss, 32);
                if (fq == 0) X[((ai * 128 + wr * 64 + m * 16 + fr) * 2 + bj) * 4 + wc] = ss; } }
            asm volatile("s_waitcnt lgkmcnt(0)" ::: "memory"); __builtin_amdgcn_s_barrier(); asm volatile("" ::: "memory");
            const int g = wc * 4 + fq, j0 = (g & 7) * 4, e0 = (g >> 3) * 64 + j0;
            const float* gn = sec == 3 ? p.g_qnorm : p.g_knorm;
            const f32x4 g1 = *(const f32x4*)(gn + e0), g2 = *(const f32x4*)(gn + e0 + 32);
            const float sc = sec == 3 ? CB : 1.f;
            const float2* rope = (const float2*)(p.ws + OFF_ROPE);
            PG8_FOR_AM { const int rl = ai * 128 + wr * 64 + m * 16 + fr, grow = u.pm * BM + rl; const RowInfo ri = row_decode(grow);
                f32x4 c4 = (f32x4){1.f, 1.f, 1.f, 1.f}, s4 = (f32x4){0.f, 0.f, 0.f, 0.f};
                if (!ri.meta) { const int pos = (g >> 3) ? (ri.t & 63) : (ri.t >> 6); const f32x4 t0 = *(const f32x4*)(rope + pos * 32 + j0), t1 = *(const f32x4*)(rope + pos * 32 + j0 + 2);
                    c4 = (f32x4){t0.x, t0.z, t1.x, t1.z}; s4 = (f32x4){t0.y, t0.w, t1.y, t1.w}; }
                PG8_FOR_BJ { const f32x4 pq = *(const PG8_LAS f32x4*)(X + (rl * 2 + bj) * 4);
                    const float rstd = 1.0f / sqrtf(((pq.x + pq.y) + (pq.z + pq.w)) * (1.0f / 128.f) + EPS) * sc;
                    const f32x4 x1 = acc[ai][bj][m][0] * g1 * rstd, x2 = acc[ai][bj][m][1] * g2 * rstd;
                    const f32x4 y1 = x1 * c4 - x2 * s4, y2 = x2 * c4 + x1 * s4;
                    if (ri.valid) { const int head = head0 + bj;
                        bf16_t* dst = sec == 3 ? (bf16_t*)(p.ws + OFF_QB) + ((size_t)(ri.b * 8 + head) * QROWS + row_q(ri)) * 128 : (bf16_t*)(p.ws + OFF_KB) + ((size_t)(ri.b * 2 + head) * KEYS + row_key(ri)) * 128;
                        *(u32x2*)(dst + e0) = (u32x2){cvt_pk_bf16(y1.x, y1.y), cvt_pk_bf16(y1.z, y1.w)};
                        *(u32x2*)(dst + e0 + 32) = (u32x2){cvt_pk_bf16(y2.x, y2.y), cvt_pk_bf16(y2.z, y2.w)}; } } }
            return;
        }
        PG8_FOR_AM { const int grow = u.pm * BM + ai * 128 + wr * 64 + m * 16 + fr; const RowInfo ri = row_decode(grow);
            if (!ri.valid) continue;
            PG8_FOR_BJ { const int head = head0 + bj; f32x4 a = acc[ai][bj][m][0], b = acc[ai][bj][m][1]; bf16_t* dst;
                if (sec == 0) { dst = (bf16_t*)(p.ws + OFF_QA) + ((size_t)(ri.b * 8 + head) * QROWS + row_q(ri)) * 128; a = a * CA; b = b * CA; }
                else if (sec == 1) dst = (bf16_t*)(p.ws + OFF_KA) + ((size_t)(ri.b * 8 + head) * KEYS + row_key(ri)) * 128;
                else if (sec == 2) dst = (bf16_t*)(p.ws + OFF_VA) + ((size_t)(ri.b * 8 + head) * KEYS + row_key(ri)) * 128;
                else if (sec == 5) dst = (bf16_t*)(p.ws + OFF_VB) + ((size_t)(ri.b * 2 + head) * KEYS + row_key(ri)) * 128;
                else { dst = (grow < MREAL ? (bf16_t*)p.out + (size_t)grow * 2048 : (bf16_t*)(p.ws + OFF_SGM) + (size_t)(grow - MREAL) * 2048) + (sec == 7 ? 1024 : 0) + head * 128;
                    a.x = 1.0f / (1.0f + __expf(-a.x)); a.y = 1.0f / (1.0f + __expf(-a.y)); a.z = 1.0f / (1.0f + __expf(-a.z)); a.w = 1.0f / (1.0f + __expf(-a.w));
                    b.x = 1.0f / (1.0f + __expf(-b.x)); b.y = 1.0f / (1.0f + __expf(-b.y)); b.z = 1.0f / (1.0f + __expf(-b.z)); b.w = 1.0f / (1.0f + __expf(-b.w)); }
                *(u32x4*)(dst + cl) = (u32x4){cvt_pk_bf16(a.x, a.y), cvt_pk_bf16(a.z, a.w), cvt_pk_bf16(b.x, b.y), cvt_pk_bf16(b.z, b.w)}; } }
    }
};
__device__ __forceinline__ f32x4 bf4(u32x2 w) { return (f32x4){bf2f(w.x & 0xffffu), bf2f(w.x >> 16), bf2f(w.y & 0xffffu), bf2f(w.y >> 16)}; }
struct EpiMerge {
    static constexpr bool PERM = true, HAS_MID = true;
    Params p;
    __device__ __forceinline__ const bf16_t* sg(int grow) const { return grow < MREAL ? (const bf16_t*)p.out + (size_t)grow * 2048 : (const bf16_t*)(p.ws + OFF_SGM) + (size_t)(grow - MREAL) * 2048; }
    __device__ __forceinline__ void mid(f32x4 (&acc)[2][2][4][2], const Unit& u, int wr, int wc, int fr, int fq) const {
        PG8_FOR_AM { const int grow = u.pm * BM + ai * 128 + wr * 64 + m * 16 + fr; if (grow >= MROWS) continue; const bf16_t* s = sg(grow) + u.pn * BM + wc * 32 + fq * 8;
            PG8_FOR_BJ { const u32x4 wa = *(const u32x4*)(s + bj * 128), wb = *(const u32x4*)(s + 1024 + bj * 128);
                const f32x4 b0 = bf4((u32x2){wb.x, wb.y}), b1 = bf4((u32x2){wb.z, wb.w});
                const f32x4 r0 = (f32x4){__builtin_amdgcn_rcpf(b0.x), __builtin_amdgcn_rcpf(b0.y), __builtin_amdgcn_rcpf(b0.z), __builtin_amdgcn_rcpf(b0.w)};
                const f32x4 r1 = (f32x4){__builtin_amdgcn_rcpf(b1.x), __builtin_amdgcn_rcpf(b1.y), __builtin_amdgcn_rcpf(b1.z), __builtin_amdgcn_rcpf(b1.w)};
                acc[ai][bj][m][0] = acc[ai][bj][m][0] * bf4((u32x2){wa.x, wa.y}) * r0;
                acc[ai][bj][m][1] = acc[ai][bj][m][1] * bf4((u32x2){wa.z, wa.w}) * r1; } }
    }
    __device__ __forceinline__ void operator()(f32x4 (&acc)[2][2][4][2], const Unit& u, int wr, int wc, int fr, int fq, PG8_LAS unsigned char*) const {
        bf16_t* MG = (bf16_t*)(p.ws + OFF_MERGED);
        PG8_FOR_AM { const int grow = u.pm * BM + ai * 128 + wr * 64 + m * 16 + fr; if (grow >= MROWS) continue; const int col = u.pn * BM + wc * 32 + fq * 8; const bf16_t* s = sg(grow) + 1024 + col;
            PG8_FOR_BJ { const u32x4 wb = *(const u32x4*)(s + bj * 128);
                const f32x4 a = acc[ai][bj][m][0] * bf4((u32x2){wb.x, wb.y}), b = acc[ai][bj][m][1] * bf4((u32x2){wb.z, wb.w});
                *(u32x4*)(MG + (size_t)grow * DM + col + bj * 128) = (u32x4){cvt_pk_bf16(a.x, a.y), cvt_pk_bf16(a.z, a.w), cvt_pk_bf16(b.x, b.y), cvt_pk_bf16(b.z, b.w)}; } }
    }
};
struct EpiOut {
    static constexpr bool PERM = false, HAS_MID = false;
    Params p;
    __device__ __forceinline__ void operator()(f32x4 (&acc)[2][2][4][2], const Unit& u, int wr, int wc, int fr, int fq, PG8_LAS unsigned char*) const {
        PG8_FOR_AM { const int grow = u.pm * BM + ai * 128 + wr * 64 + m * 16 + fr; if (grow >= MROWS) continue; const int col = u.pn * BM + wc * 32 + fq * 4;
            const float* hr = h_row(p, grow) + col; float* o = h2_row(p, grow) + col;
            PG8_FOR_BJ {
#pragma unroll
                for (int n = 0; n < 2; ++n) *(f32x4*)(o + bj * 128 + n * 16) = *(const f32x4*)(hr + bj * 128 + n * 16) + acc[ai][bj][m][n]; } }
    }
};
struct EpiMoeUp {
    static constexpr bool PERM = true, HAS_MID = false;
    Params p;
    __device__ __forceinline__ void operator()(f32x4 (&acc)[2][2][4][2], const Unit& u, int wr, int wc, int fr, int fq, PG8_LAS unsigned char*) const {
        bf16_t* HID = (bf16_t*)(p.ws + OFF_HID);
        PG8_FOR_AM { const int s = u.pm * BM + ai * 128 + wr * 64 + m * 16 + fr; if (s >= ESLOTS) continue;
            PG8_FOR_BJ { const f32x4 gt = acc[ai][bj][m][0], up = acc[ai][bj][m][1]; const int f0 = (u.pn * BM + bj * 128 + wc * 32 + fq * 8) >> 1;
                const float h0 = gt.x / (1.0f + __expf(-gt.x)) * up.x, h1 = gt.y / (1.0f + __expf(-gt.y)) * up.y, h2 = gt.z / (1.0f + __expf(-gt.z)) * up.z, h3 = gt.w / (1.0f + __expf(-gt.w)) * up.w;
                *(u32x2*)(HID + ((size_t)u.e * ESLOTS + s) * EFF + f0) = (u32x2){cvt_pk_bf16(h0, h1), cvt_pk_bf16(h2, h3)}; } }
    }
};
struct EpiMoeDown {
    static constexpr bool PERM = true, HAS_MID = false;
    Params p;
    __device__ __forceinline__ void operator()(f32x4 (&acc)[2][2][4][2], const Unit& u, int wr, int wc, int fr, int fq, PG8_LAS unsigned char*) const {
        bf16_t* YB = (bf16_t*)(p.ws + OFF_YB); const float* SAFF = (const float*)(p.ws + OFF_SAFF);
        PG8_FOR_AM { const int s = u.pm * BM + ai * 128 + wr * 64 + m * 16 + fr; if (s >= ESLOTS) continue; const float af = SAFF[u.e * ESLOTS + s]; const int col = u.pn * BM + wc * 32 + fq * 8;
            PG8_FOR_BJ { const f32x4 a = acc[ai][bj][m][0] * af, b = acc[ai][bj][m][1] * af;
                *(u32x4*)(YB + ((size_t)u.e * ESLOTS + s) * DM + col + bj * 128) = (u32x4){cvt_pk_bf16(a.x, a.y), cvt_pk_bf16(a.z, a.w), cvt_pk_bf16(b.x, b.y), cvt_pk_bf16(b.z, b.w)}; } }
    }
};
#undef PG8_BAR
}

__device__ __forceinline__ void phase1_fast(const Params& p, unsigned char* lds_raw, int vb, int nvb) {
    pg8::Gemm g{(const bf16_t*)(p.ws + OFF_UN), (const bf16_t*)(p.ws + OFF_WIN), DM};
    pg8::GridOrder S; S.init(MPAD / 256, INW / 256, nvb, vb);
    pg8::EpiInProj E{p};
    pg8::gemm_phase(( __attribute__((address_space(3))) unsigned char*)lds_raw, g, S, E);
}
__device__ __forceinline__ void phase3a_fast(const Params& p, unsigned char* lds_raw, int vb, int nvb) {
    pg8::Gemm g{(const bf16_t*)(p.ws + OFF_AO), (const bf16_t*)(p.ws + OFF_WAB), 2048};
    pg8::GridOrder S; S.init(MPAD / 256, DM / 256, nvb, vb);
    pg8::EpiMerge E{p};
    pg8::gemm_phase(( __attribute__((address_space(3))) unsigned char*)lds_raw, g, S, E);
}
__device__ __forceinline__ void phase3b_fast(const Params& p, unsigned char* lds_raw, int vb, int nvb) {
    pg8::Gemm g{(const bf16_t*)(p.ws + OFF_MERGED), (const bf16_t*)(p.ws + OFF_WO), DM};
    pg8::GridOrder S; S.init(MPAD / 256, DM / 256, nvb, vb);
    pg8::EpiOut E{p};
    pg8::gemm_phase(( __attribute__((address_space(3))) unsigned char*)lds_raw, g, S, E);
}
__device__ __forceinline__ void phase5a_fast(const Params& p, unsigned char* lds_raw, int vb, int nvb) {
    pg8::Gemm g{(const bf16_t*)(p.ws + OFF_XS), (const bf16_t*)(p.ws + OFF_WGU), DM};
    pg8::MoeOrder S{nvb, vb};
    pg8::EpiMoeUp E{p};
    pg8::gemm_phase(( __attribute__((address_space(3))) unsigned char*)lds_raw, g, S, E);
}
__device__ __forceinline__ void phase5b_fast(const Params& p, unsigned char* lds_raw, int vb, int nvb) {
    pg8::Gemm g{(const bf16_t*)(p.ws + OFF_HID), (const bf16_t*)(p.ws + OFF_WD), EFF};
    pg8::MoeOrder S{nvb, vb};
    pg8::EpiMoeDown E{p};
    pg8::gemm_phase(( __attribute__((address_space(3))) unsigned char*)lds_raw, g, S, E);
}

__device__ void phase4b_fast(const Params& p, float* lds, int vb, int nvb) {
    const int tid = TID(), lane = tid & 63, wave = tid >> 6;
    constexpr int NBE = NB * NEXP;
    if (vb >= NBE) { transpose_moe(p, lds, vb - NBE, nvb - NBE); return; }
    if (nvb <= NBE) transpose_moe(p, lds, vb, nvb);
    const float* AFF = (const float*)(p.ws + OFF_AFF); int* IDX = (int*)(p.ws + OFF_IDX); int* SEL = (int*)(p.ws + OFF_SEL);
    unsigned* keys = (unsigned*)lds;
    unsigned* hist = keys + 8448;
    unsigned* sh = hist + 256;
    for (int be = vb; be < NBE; be += nvb) {
        const int b = be / NEXP, e = be % NEXP;
        __syncthreads();
        for (int i = tid; i < LTOT; i += NTHREADS) keys[i] = __float_as_uint(AFF[(size_t)be * LTOT + i]);
        if (tid == 0) { sh[0] = 0u; sh[1] = CAP; }
        __syncthreads();
        for (int pass = 0; pass < 4; ++pass) {
            const int shift = 24 - 8 * pass;
            if (tid < 256) hist[tid] = 0u;
            __syncthreads();
            const unsigned prefix = sh[0], pmask = pass == 0 ? 0u : (0xffffffffu << (shift + 8));
            for (int i = tid; i < LTOT; i += NTHREADS) { const unsigned k = keys[i]; if ((k & pmask) == prefix) atomicAdd(&hist[(k >> shift) & 255u], 1u); }
            __syncthreads();
            if (tid == 0) { unsigned rem = sh[1], d = 255u;
                for (;; --d) { const unsigned c = hist[d]; if (c >= rem || d == 0u) break; rem -= c; }
                sh[0] = prefix | (d << shift); sh[1] = rem; }
            __syncthreads();
        }
        const unsigned T = sh[0], need_eq = sh[1];
        const int t0 = tid * 17; int cnt_gt = 0, cnt_eq = 0;
        for (int i = 0; i < 17; ++i) { const int tok = t0 + i; if (tok < LTOT) { const unsigned k = keys[tok]; cnt_gt += k > T; cnt_eq += k == T; } }
        int incl = cnt_eq;
#pragma unroll
        for (int o = 1; o < 64; o <<= 1) { const int v = __shfl_up(incl, o); if (lane >= o) incl += v; }
        if (lane == 63) sh[8 + wave] = (unsigned)incl;
        __syncthreads();
        int eq_before = incl - cnt_eq; for (int w = 0; w < wave; ++w) eq_before += (int)sh[8 + w];
        __syncthreads();
        int take_eq = (int)need_eq - eq_before; take_eq = take_eq < 0 ? 0 : (take_eq > cnt_eq ? cnt_eq : take_eq);
        const int mysel = cnt_gt + take_eq;
        incl = mysel;
#pragma unroll
        for (int o = 1; o < 64; o <<= 1) { const int v = __shfl_up(incl, o); if (lane >= o) incl += v; }
        if (lane == 63) sh[8 + wave] = (unsigned)incl;
        __syncthreads();
        int slot = incl - mysel; for (int w = 0; w < wave; ++w) slot += (int)sh[8 + w];
        int eqi = eq_before;
        for (int i = 0; i < 17; ++i) { const int tok = t0 + i; if (tok < LTOT) { const unsigned k = keys[tok];
            bool take = k > T; if (k == T) { take = eqi < (int)need_eq; ++eqi; }
            if (take) { IDX[(size_t)be * CAP + slot] = tok; SEL[((size_t)b * LTOT + tok) * NEXP + e] = slot; ++slot; } else SEL[((size_t)b * LTOT + tok) * NEXP + e] = -1; } }
    }
    __syncthreads();
}
__device__ void phase4c(const Params& p, int vb, int nvb) {
    const int tid = TID(), lane = tid & 63, wave = tid >> 6;
    const bf16_t* U2 = (const bf16_t*)(p.ws + OFF_UN); bf16_t* XS = (bf16_t*)(p.ws + OFF_XS); const int* IDX = (const int*)(p.ws + OFF_IDX);
    const float* AFF = (const float*)(p.ws + OFF_AFF); float* SAFF = (float*)(p.ws + OFF_SAFF);
    for (int r = vb * 8 + wave; r < NEXP * ESLOTS; r += nvb * 8) {
        const int e = r / ESLOTS, s = r % ESLOTS, b = s / CAP, c = s % CAP;
        const int tok = IDX[((size_t)b * NEXP + e) * CAP + c];
        const u32x4* src = (const u32x4*)(U2 + (size_t)pos_row(b, tok) * DM) + lane; u32x4* dst = (u32x4*)(XS + (size_t)r * DM) + lane;
        const u32x4 v0 = src[0], v1 = src[64]; dst[0] = v0; dst[64] = v1;
        if (lane == 0) SAFF[r] = AFF[((size_t)b * NEXP + e) * LTOT + tok];
    }
}

constexpr int LDS_BYTES = 147456;
#if defined(__HIP_DEVICE_COMPILE__)
#define PHASE_PARAMS() ({ const __attribute__((address_space(4))) Params* q_ = (const __attribute__((address_space(4))) Params*)__builtin_amdgcn_kernarg_segment_ptr(); asm volatile("" : "+s"(q_)); *q_; })
#else
#define PHASE_PARAMS() (pk)
#endif
__global__ void __launch_bounds__(NTHREADS, 2) fwd_kernel(Params pk) {
    extern __shared__ __attribute__((aligned(16))) unsigned char lds_raw[];
    float* lds = (float*)lds_raw;
    cg::grid_group grid = cg::this_grid();
    const int vb = blockIdx.x, nvb = gridDim.x;
    { const Params p = PHASE_PARAMS(); phase0(p, vb, nvb); }
#if FAST_P1 || FAST_P3
    { const Params p = PHASE_PARAMS(); transpose_p0(p, lds, vb, nvb); }
#endif
    grid.sync();
#if FAST_P1
    { const Params p = PHASE_PARAMS(); phase1_fast(p, lds_raw, vb, nvb); }
#else
    { const Params p = PHASE_PARAMS(); phase1_ref(p, lds, vb, nvb); }
#endif
    grid.sync();
#if FAST_ATTN
    { const Params p = PHASE_PARAMS(); phase2_fast(p, (char*)lds_raw, vb, nvb); }
#else
    { const Params p = PHASE_PARAMS(); phase2_ref(p, lds, vb, nvb); }
#endif
    grid.sync();
#if FAST_P3
    { const Params p = PHASE_PARAMS(); phase3a_fast(p, lds_raw, vb, nvb); }
#else
    { const Params p = PHASE_PARAMS(); phase3a_ref(p, lds, vb, nvb, 0); }
    { const Params p = PHASE_PARAMS(); phase3a_ref(p, lds, vb, nvb, 1); }
#endif
    grid.sync();
#if FAST_P3
    { const Params p = PHASE_PARAMS(); phase3b_fast(p, lds_raw, vb, nvb); }
#else
    { const Params p = PHASE_PARAMS(); phase3b_ref(p, lds, vb, nvb); }
#endif
    grid.sync();
    { const Params p = PHASE_PARAMS(); phase4a(p, lds, vb, nvb); }
    grid.sync();
#if FAST_MOE
    { const Params p = PHASE_PARAMS(); phase4b_fast(p, lds, vb, nvb); }
    grid.sync();
    { const Params p = PHASE_PARAMS(); phase4c(p, vb, nvb); }
    grid.sync();
    { const Params p = PHASE_PARAMS(); phase5a_fast(p, lds_raw, vb, nvb); }
    grid.sync();
    { const Params p = PHASE_PARAMS(); phase5b_fast(p, lds_raw, vb, nvb); }
#else
    { const Params p = PHASE_PARAMS(); phase4b_ref(p, lds, vb, nvb); }
    grid.sync();
    { const Params p = PHASE_PARAMS(); phase5a_ref(p, lds, vb, nvb); }
    grid.sync();
    { const Params p = PHASE_PARAMS(); phase5b_ref(p, lds, vb, nvb); }
#endif
    grid.sync();
    { const Params p = PHASE_PARAMS(); phase6(p, vb, nvb); }
}

extern "C" void kernel_launch(void* const* d_in, const int* in_sizes, int n_in, void* d_out, int out_size, void* d_ws, size_t ws_size, hipStream_t stream) {
    static int grid_blocks = 0;
    if (grid_blocks == 0) {
        if (n_in != 20 || in_sizes[0] != MREAL * DM || out_size != MREAL * DM || ws_size < 256 * MiB) {
            fprintf(stderr, "kernel_launch: unexpected shapes: n_in %d in0 %d out %d ws %zu\n", n_in, n_in > 0 ? in_sizes[0] : -1, out_size, ws_size); grid_blocks = -1; return; }
        int dev = 0, cus = 0, per_cu = 0;
        (void)hipGetDevice(&dev); (void)hipDeviceGetAttribute(&cus, hipDeviceAttributeMultiprocessorCount, dev);
        if (hipFuncSetAttribute((const void*)fwd_kernel, hipFuncAttributeMaxDynamicSharedMemorySize, LDS_BYTES) != hipSuccess) { fprintf(stderr, "kernel_launch: hipFuncSetAttribute failed\n"); grid_blocks = -1; return; }
        if (hipOccupancyMaxActiveBlocksPerMultiprocessor(&per_cu, (const void*)fwd_kernel, NTHREADS, LDS_BYTES) != hipSuccess || per_cu < 1) { fprintf(stderr, "kernel_launch: occupancy query failed (%d)\n", per_cu); grid_blocks = -1; return; }
        grid_blocks = cus * per_cu;
    }
    if (grid_blocks < 0) return;
    Params p{};
    p.x = (const float*)d_in[0]; p.meta = (const float*)d_in[1]; p.g_mix = (const float*)d_in[2]; p.w_in = (const float*)d_in[3];
    p.lq1 = (const float*)d_in[4]; p.lk1 = (const float*)d_in[5]; p.lq2 = (const float*)d_in[6]; p.lk2 = (const float*)d_in[7];
    p.g_subln = (const float*)d_in[8]; p.g_qnorm = (const float*)d_in[9]; p.g_knorm = (const float*)d_in[10];
    p.w_ba = (const float*)d_in[11]; p.w_bb = (const float*)d_in[12]; p.w_out = (const float*)d_in[13]; p.g_ffn = (const float*)d_in[14];
    p.w_router = (const float*)d_in[15]; p.w_gate = (const float*)d_in[16]; p.w_up = (const float*)d_in[17]; p.w_down = (const float*)d_in[18]; p.g_final = (const float*)d_in[19];
    p.out = (float*)d_out; p.ws = (unsigned char*)d_ws;
    void* args[] = {&p};
    hipError_t e = hipLaunchCooperativeKernel((const void*)fwd_kernel, dim3(grid_blocks), dim3(NTHREADS), args, LDS_BYTES, stream);
    if (e != hipSuccess) fprintf(stderr, "kernel_launch: cooperative launch failed: %s (grid %d)\n", hipGetErrorString(e), grid_blocks);
}
```

```cpp
#include <hip/hip_runtime.h>
#include <hip/hip_cooperative_groups.h>
#include <cstdio>
#include <cstdint>
namespace cg = cooperative_groups;

typedef unsigned short bf16_t;
typedef float f32x4 __attribute__((ext_vector_type(4)));
typedef unsigned u32x2 __attribute__((ext_vector_type(2)));
typedef unsigned u32x4 __attribute__((ext_vector_type(4)));

constexpr int NB = 2, SEQ = 8192, DM = 1024, NMETA = 16, LTOT = SEQ + NMETA;
constexpr int MREAL = NB * SEQ;
constexpr int MROWS = MREAL + NB * NMETA;
constexpr int MPAD = 16640;
constexpr int INW = 6656;
constexpr int KEYS = 8256;
constexpr int QROWS = 8256;
constexpr int NEXP = 16, EFF = 512, CAP = 1026, ESLOTS = NB * CAP;
constexpr float EPS = 1e-6f;
constexpr float LOG2E = 1.4426950408889634f;
constexpr float CA = 0.125f * LOG2E;
constexpr float CB = 0.08838834764831845f * LOG2E;
constexpr float LAM_INIT = 0.2f;
constexpr int NTHREADS = 512;
constexpr int AOP = 2048;
#ifndef FAST_ATTN
#define FAST_ATTN 1
#endif
#ifndef FAST_P1
#define FAST_P1 1
#endif
#ifndef FAST_P3
#define FAST_P3 1
#endif
#ifndef FAST_MOE
#define FAST_MOE 0
#endif
__device__ const float INVF[32] = {1.000000000e+00f, 7.498942614e-01f, 5.623413324e-01f, 4.216965139e-01f, 3.162277639e-01f, 2.371373773e-01f, 1.778279394e-01f, 1.333521307e-01f,
    1.000000015e-01f, 7.498941571e-02f, 5.623413250e-02f, 4.216965288e-02f, 3.162277490e-02f, 2.371373773e-02f, 1.778279431e-02f, 1.333521493e-02f,
    9.999999776e-03f, 7.498941850e-03f, 5.623413250e-03f, 4.216964822e-03f, 3.162277630e-03f, 2.371373586e-03f, 1.778279431e-03f, 1.333521446e-03f,
    1.000000047e-03f, 7.498942432e-04f, 5.623413017e-04f, 4.216965172e-04f, 3.162277571e-04f, 2.371373703e-04f, 1.778279402e-04f, 1.333521504e-04f};

constexpr size_t MiB = 1u << 20;
constexpr size_t OFF_ROPE = 0;
constexpr size_t OFF_LAM = 64 * 1024;
constexpr size_t OFF_AFF = 128 * 1024;
constexpr size_t OFF_IDX = OFF_AFF + (size_t)NB * NEXP * LTOT * 4 + 256;
constexpr size_t OFF_SEL = OFF_IDX + (size_t)NB * NEXP * CAP * 4 + 256;
constexpr size_t OFF_SGM = OFF_SEL + (size_t)NB * LTOT * NEXP * 4 + 256;
constexpr size_t OFF_H2M = OFF_SGM + 32 * 2048 * 2;
constexpr size_t OFF_SAFF = OFF_H2M + 32 * 1024 * 4;
constexpr size_t OFF_MISC_END = OFF_SAFF + (size_t)NEXP * ESLOTS * 4;
static_assert(OFF_MISC_END <= 4 * MiB, "misc region");
constexpr size_t OFF_WIN = 4 * MiB;
constexpr size_t OFF_WAB = OFF_WIN + (size_t)INW * DM * 2;
constexpr size_t OFF_WO = OFF_WAB + (size_t)DM * 2048 * 2;
static_assert(OFF_WO + (size_t)DM * DM * 2 <= 24 * MiB, "weights region");
constexpr size_t OFF_AO = 24 * MiB;
constexpr size_t SZ_ROWS = (size_t)MPAD * DM * 2;
constexpr size_t OFF_UN = OFF_AO;
constexpr size_t OFF_HID = OFF_AO + SZ_ROWS;
static_assert((size_t)(NEXP * ESLOTS + 256) * EFF * 2 <= SZ_ROWS, "HID overlay");
constexpr size_t OFF_ATT = OFF_AO + 2 * SZ_ROWS;
constexpr size_t SZ_QH = (size_t)NB * 8 * QROWS * 128 * 2;
constexpr size_t SZ_KVB = (size_t)NB * 2 * KEYS * 128 * 2;
constexpr size_t OFF_QA = OFF_ATT, OFF_KA = OFF_QA + SZ_QH, OFF_VA = OFF_KA + SZ_QH, OFF_QB = OFF_VA + SZ_QH, OFF_KB = OFF_QB + SZ_QH, OFF_VB = OFF_KB + SZ_KVB;
constexpr size_t OFF_ATT_END = OFF_VB + SZ_KVB;
static_assert(OFF_ATT_END <= 256 * MiB, "workspace");
constexpr size_t OFF_MERGED = OFF_ATT;
constexpr size_t OFF_WGU = OFF_ATT + 33 * MiB;
constexpr size_t OFF_WD = OFF_WGU + 32 * MiB;
constexpr size_t OFF_XS = OFF_WD + 16 * MiB;
constexpr size_t OFF_YB = OFF_XS;
static_assert(SZ_ROWS <= 33 * MiB && OFF_XS + (size_t)(NEXP * ESLOTS + 256) * DM * 2 <= 256 * MiB, "overlay map");

struct Params {
    const float *x, *meta, *g_mix, *w_in, *lq1, *lk1, *lq2, *lk2, *g_subln, *g_qnorm, *g_knorm, *w_ba, *w_bb, *w_out, *g_ffn, *w_router, *w_gate, *w_up, *w_down, *g_final;
    float* out; unsigned char* ws;
};

__device__ __forceinline__ int TID() { int t = threadIdx.x; asm volatile("" : "+v"(t)); return t; }
__device__ __forceinline__ unsigned f2bf(float f) { unsigned u = __builtin_bit_cast(unsigned, f); return (u + 0x7fffu + ((u >> 16) & 1u)) >> 16; }
__device__ __forceinline__ float bf2f(unsigned h) { return __builtin_bit_cast(float, h << 16); }
__device__ __forceinline__ float wave_sum(float v) {
#pragma unroll
    for (int o = 1; o < 64; o <<= 1) v += __shfl_xor(v, o);
    return v;
}
__device__ __forceinline__ float wave_max(float v) {
#pragma unroll
    for (int o = 1; o < 64; o <<= 1) v = fmaxf(v, __shfl_xor(v, o));
    return v;
}
struct RowInfo { int b, t, meta, valid; };
__device__ __forceinline__ RowInfo row_decode(int r) {
    RowInfo ri;
    if (r < MREAL) { ri.b = r >> 13; ri.t = r & (SEQ - 1); ri.meta = 0; ri.valid = 1; }
    else if (r < MROWS) { ri.b = (r - MREAL) >> 4; ri.t = (r - MREAL) & 15; ri.meta = 1; ri.valid = 1; }
    else { ri.b = 0; ri.t = 0; ri.meta = 1; ri.valid = 0; }
    return ri;
}
__device__ __forceinline__ int row_key(const RowInfo& ri) { return ri.meta ? ri.t : 64 + ri.t; }
__device__ __forceinline__ int row_q(const RowInfo& ri) { return ri.meta ? SEQ + ri.t : ri.t; }
__device__ __forceinline__ int row_pos(const RowInfo& ri) { return ri.meta ? ri.t : NMETA + ri.t; }
__device__ __forceinline__ int pos_row(int b, int pos) { return pos < NMETA ? MREAL + b * NMETA + pos : b * SEQ + (pos - NMETA); }
__device__ __forceinline__ const float* h_row(const Params& p, int r) { RowInfo ri = row_decode(r); return ri.meta ? p.meta + (size_t)ri.t * DM : p.x + (size_t)r * DM; }

__device__ void phase0(const Params& p, int vb, int nvb) {
    const int tid = TID(), lane = tid & 63, wave = tid >> 6;
    const int gt = vb * NTHREADS + tid;
    if (gt < 128 * 32) {
        const int pos = gt >> 5, j = gt & 31;
        const float ang = (float)pos * INVF[j];
        const double xd = (double)ang, kq = __builtin_rint(xd * 0.15915494309189535);
        const double rr = (xd - kq * 6.283185307179586) * 0.25, r2 = rr * rr;
        double sn = 1.0 / 1307674368000.0, cn = 1.0 / 87178291200.0;
        sn = sn * r2 * -1.0 + 1.0 / 6227020800.0; cn = cn * r2 * -1.0 + 1.0 / 479001600.0;
        sn = sn * r2 * -1.0 + 1.0 / 39916800.0;   cn = cn * r2 * -1.0 + 1.0 / 3628800.0;
        sn = sn * r2 * -1.0 + 1.0 / 362880.0;     cn = cn * r2 * -1.0 + 1.0 / 40320.0;
        sn = sn * r2 * -1.0 + 1.0 / 5040.0;       cn = cn * r2 * -1.0 + 1.0 / 720.0;
        sn = sn * r2 * -1.0 + 1.0 / 120.0;        cn = cn * r2 * -1.0 + 1.0 / 24.0;
        sn = sn * r2 * -1.0 + 1.0 / 6.0;          cn = cn * r2 * -1.0 + 0.5;
        sn = (sn * r2 * -1.0 + 1.0) * rr;         cn = cn * r2 * -1.0 + 1.0;
        double s2 = 2.0 * sn * cn, c2 = cn * cn - sn * sn;
        double s4 = 2.0 * s2 * c2, c4 = c2 * c2 - s2 * s2;
        float2 cs; cs.x = (float)c4; cs.y = (float)s4;
        ((float2*)(p.ws + OFF_ROPE))[gt] = cs;
    }
    if (vb == 0 && wave == 0) {
        float a = p.lq1[lane] * p.lk1[lane], c = p.lq2[lane] * p.lk2[lane];
        a = wave_sum(a); c = wave_sum(c);
        if (lane == 0) *(float*)(p.ws + OFF_LAM) = expf(a) - expf(c) + LAM_INIT;
    }
    bf16_t* UN = (bf16_t*)(p.ws + OFF_UN);
    for (int r = vb * 8 + wave; r < MPAD; r += nvb * 8) {
        u32x2* o = (u32x2*)(UN + (size_t)r * DM) + lane;
        if (r >= MROWS) {
#pragma unroll
            for (int j = 0; j < 4; ++j) o[64 * j] = (u32x2){0u, 0u};
            continue;
        }
        const f32x4* xr = (const f32x4*)h_row(p, r) + lane;
        f32x4 v[4]; float s = 0.f;
#pragma unroll
        for (int j = 0; j < 4; ++j) { v[j] = xr[64 * j]; s += (v[j].x * v[j].x + v[j].y * v[j].y) + (v[j].z * v[j].z + v[j].w * v[j].w); }
        const float rstd = 1.0f / sqrtf(wave_sum(s) * (1.0f / DM) + EPS);
#pragma unroll
        for (int j = 0; j < 4; ++j) {
            const f32x4 g = ((const f32x4*)p.g_mix)[lane + 64 * j];
            u32x2 w; w.x = f2bf(v[j].x * rstd * g.x) | (f2bf(v[j].y * rstd * g.y) << 16); w.y = f2bf(v[j].z * rstd * g.z) | (f2bf(v[j].w * rstd * g.w) << 16);
            o[64 * j] = w;
        }
    }
    {
        bf16_t* KA = (bf16_t*)(p.ws + OFF_KA); bf16_t* VA = (bf16_t*)(p.ws + OFF_VA); bf16_t* KB = (bf16_t*)(p.ws + OFF_KB); bf16_t* VB = (bf16_t*)(p.ws + OFF_VB);
        const int per = 48 * 128 / 8;
        for (int i = vb * NTHREADS + tid; i < (16 + 16 + 4 + 4) * per; i += nvb * NTHREADS) {
            const int bh = i / per, o = i % per; bf16_t* base;
            if (bh < 16) base = KA + (size_t)bh * KEYS * 128; else if (bh < 32) base = VA + (size_t)(bh - 16) * KEYS * 128;
            else if (bh < 36) base = KB + (size_t)(bh - 32) * KEYS * 128; else base = VB + (size_t)(bh - 36) * KEYS * 128;
            ((u32x4*)(base + 16 * 128))[o] = (u32x4){0u, 0u, 0u, 0u};
        }
    }
}

constexpr int NG_AS = 16 * 132, NG_BS = 16 * 128, NG_CT = 128 * 129;
template <class ARow, class BVal, class Epi>
__device__ __forceinline__ void ngemm_tile(float* lds, int K, ARow arow, BVal bval, Epi epi) {
    float* As = lds; float* Bs = lds + NG_AS; float* Ct = lds + NG_AS + NG_BS;
    const int tid = TID(), ty = tid >> 4, tx = tid & 15;
    const int ar = tid >> 2, ak = (tid & 3) * 4; const bf16_t* ap = arow(ar);
    const int bk = tid >> 5, bc = (tid & 31) * 4;
    float acc[4][8];
#pragma unroll
    for (int i = 0; i < 4; ++i)
#pragma unroll
        for (int j = 0; j < 8; ++j) acc[i][j] = 0.f;
    for (int k0 = 0; k0 < K; k0 += 16) {
        u32x2 av = (u32x2){0u, 0u}; if (ap) av = *(const u32x2*)(ap + k0 + ak);
        float b0 = bval(k0 + bk, bc), b1 = bval(k0 + bk, bc + 1), b2 = bval(k0 + bk, bc + 2), b3 = bval(k0 + bk, bc + 3);
        __syncthreads();
        As[(ak + 0) * 132 + ar] = bf2f(av.x & 0xffffu); As[(ak + 1) * 132 + ar] = bf2f(av.x >> 16);
        As[(ak + 2) * 132 + ar] = bf2f(av.y & 0xffffu); As[(ak + 3) * 132 + ar] = bf2f(av.y >> 16);
        *(f32x4*)(Bs + bk * 128 + bc) = (f32x4){b0, b1, b2, b3};
        __syncthreads();
#pragma unroll
        for (int k = 0; k < 16; ++k) {
            const f32x4 a = *(const f32x4*)(As + k * 132 + ty * 4);
            const f32x4 bA = *(const f32x4*)(Bs + k * 128 + tx * 8), bB = *(const f32x4*)(Bs + k * 128 + tx * 8 + 4);
            const float av4[4] = {a.x, a.y, a.z, a.w}; const float bv8[8] = {bA.x, bA.y, bA.z, bA.w, bB.x, bB.y, bB.z, bB.w};
#pragma unroll
            for (int i = 0; i < 4; ++i)
#pragma unroll
                for (int j = 0; j < 8; ++j) acc[i][j] = fmaf(av4[i], bv8[j], acc[i][j]);
        }
    }
    __syncthreads();
#pragma unroll
    for (int i = 0; i < 4; ++i)
#pragma unroll
        for (int j = 0; j < 8; ++j) Ct[(ty * 4 + i) * 129 + tx * 8 + j] = acc[i][j];
    __syncthreads();
    epi(Ct);
    __syncthreads();
}

__device__ void inproj_epi(const Params& p, const float* Ct, int row0, int col0) {
    const int tid = TID(), r = tid >> 2, q = tid & 3;
    const int grow = row0 + r; const RowInfo ri = row_decode(grow);
    const float* c = Ct + r * 129;
    float v[4][8];
#pragma unroll
    for (int g = 0; g < 4; ++g)
#pragma unroll
        for (int i = 0; i < 8; ++i) v[g][i] = c[g * 32 + 8 * q + i];
    const int sec = col0 < 1024 ? 0 : col0 < 2048 ? 1 : col0 < 3072 ? 2 : col0 < 4096 ? 3 : col0 < 4352 ? 4 : col0 < 4608 ? 5 : col0 < 5632 ? 6 : 7;
    const int secbase = sec == 0 ? 0 : sec == 1 ? 1024 : sec == 2 ? 2048 : sec == 3 ? 3072 : sec == 4 ? 4096 : sec == 5 ? 4352 : sec == 6 ? 4608 : 5632;
    const int head = (col0 - secbase) >> 7;
    if (sec == 3 || sec == 4) {
        float ss = 0.f;
#pragma unroll
        for (int g = 0; g < 4; ++g)
#pragma unroll
            for (int i = 0; i < 8; ++i) ss += v[g][i] * v[g][i];
        ss += __shfl_xor(ss, 1); ss += __shfl_xor(ss, 2);
        const float rstd = 1.0f / sqrtf(ss * (1.0f / 128.f) + EPS);
        const float* gn = sec == 3 ? p.g_qnorm : p.g_knorm;
#pragma unroll
        for (int g = 0; g < 4; ++g)
#pragma unroll
            for (int i = 0; i < 8; ++i) v[g][i] = v[g][i] * rstd * gn[g * 32 + 8 * q + i];
        if (!ri.meta) {
            const float2* rope = (const float2*)(p.ws + OFF_ROPE);
            const int prow = ri.t >> 6, pcol = ri.t & 63;
#pragma unroll
            for (int i = 0; i < 8; ++i) {
                const float2 cr = rope[prow * 32 + 8 * q + i], cc = rope[pcol * 32 + 8 * q + i];
                const float x1 = v[0][i], x2 = v[1][i]; v[0][i] = x1 * cr.x - x2 * cr.y; v[1][i] = x2 * cr.x + x1 * cr.y;
                const float y1 = v[2][i], y2 = v[3][i]; v[2][i] = y1 * cc.x - y2 * cc.y; v[3][i] = y2 * cc.x + y1 * cc.y;
            }
        }
    }
    if (!ri.valid) return;
    bf16_t* dst; float sc = 1.f; bool sig = false;
    if (sec == 0) { dst = (bf16_t*)(p.ws + OFF_QA) + ((size_t)(ri.b * 8 + head) * QROWS + row_q(ri)) * 128; sc = CA; }
    else if (sec == 1) dst = (bf16_t*)(p.ws + OFF_KA) + ((size_t)(ri.b * 8 + head) * KEYS + row_key(ri)) * 128;
    else if (sec == 2) dst = (bf16_t*)(p.ws + OFF_VA) + ((size_t)(ri.b * 8 + head) * KEYS + row_key(ri)) * 128;
    else if (sec == 3) { dst = (bf16_t*)(p.ws + OFF_QB) + ((size_t)(ri.b * 8 + head) * QROWS + row_q(ri)) * 128; sc = CB; }
    else if (sec == 4) dst = (bf16_t*)(p.ws + OFF_KB) + ((size_t)(ri.b * 2 + head) * KEYS + row_key(ri)) * 128;
    else if (sec == 5) dst = (bf16_t*)(p.ws + OFF_VB) + ((size_t)(ri.b * 2 + head) * KEYS + row_key(ri)) * 128;
    else { sig = true; const int cbase = (sec == 7 ? 1024 : 0) + head * 128;
           dst = (grow < MREAL ? (bf16_t*)p.out + (size_t)grow * 2048 : (bf16_t*)(p.ws + OFF_SGM) + (size_t)(grow - MREAL) * 2048) + cbase; }
#pragma unroll
    for (int g = 0; g < 4; ++g)
#pragma unroll
        for (int i = 0; i < 8; ++i) { float y = v[g][i] * sc; if (sig) y = 1.0f / (1.0f + __expf(-y)); dst[g * 32 + 8 * q + i] = (bf16_t)f2bf(y); }
}
__device__ void phase1_ref(const Params& p, float* lds, int vb, int nvb) {
    const bf16_t* UN = (const bf16_t*)(p.ws + OFF_UN);
    constexpr int NTM = MPAD / 128, NTN = INW / 128;
    for (int t = vb; t < NTM * NTN; t += nvb) {
        const int tm = t / NTN, tn = t % NTN, row0 = tm * 128, col0 = tn * 128;
        if (row0 >= MROWS) continue;
        ngemm_tile(lds, DM,
            [&](int r) { return UN + (size_t)(row0 + r) * DM; },
            [&](int k, int c) { return p.w_in[(size_t)k * INW + col0 + c]; },
            [&](const float* Ct) { inproj_epi(p, Ct, row0, col0); });
    }
}

__device__ float attn_row_ref(const bf16_t* qrow, int dq, const bf16_t* Kh, int kcol0, const bf16_t* Vh, float slopeC, int tq  ,
                              float* sc, float* qf, int lane, float& o0, float& o1) {
    if (lane < dq / 2) { const unsigned w = ((const unsigned*)qrow)[lane]; qf[2 * lane] = bf2f(w & 0xffffu); qf[2 * lane + 1] = bf2f(w >> 16); }
    __builtin_amdgcn_s_waitcnt(0);
    float mx = -1e30f;
    for (int i = 0; i < KEYS / 64; ++i) {
        const int kk = i * 64 + lane;
        const bf16_t* kr = Kh + (size_t)kk * 128 + kcol0;
        float s = 0.f;
        for (int d = 0; d < dq; d += 8) {
            const u32x4 w = *(const u32x4*)(kr + d);
            s = fmaf(qf[d + 0], bf2f(w.x & 0xffffu), s); s = fmaf(qf[d + 1], bf2f(w.x >> 16), s);
            s = fmaf(qf[d + 2], bf2f(w.y & 0xffffu), s); s = fmaf(qf[d + 3], bf2f(w.y >> 16), s);
            s = fmaf(qf[d + 4], bf2f(w.z & 0xffffu), s); s = fmaf(qf[d + 5], bf2f(w.z >> 16), s);
            s = fmaf(qf[d + 6], bf2f(w.w & 0xffffu), s); s = fmaf(qf[d + 7], bf2f(w.w >> 16), s);
        }
        const bool valid = kk < NMETA || kk >= 64;
        if (tq >= 0 && kk >= 64) s -= slopeC * fabsf((float)(tq - (kk - 64)));
        if (!valid) s = -1e30f;
        sc[kk] = s; mx = fmaxf(mx, s);
    }
    mx = wave_max(mx);
    float sum = 0.f;
    for (int i = 0; i < KEYS / 64; ++i) { const int kk = i * 64 + lane; const float pr = (kk < NMETA || kk >= 64) ? exp2f(sc[kk] - mx) : 0.f; sc[kk] = pr; sum += pr; }
    sum = wave_sum(sum);
    __builtin_amdgcn_s_waitcnt(0);
    float a0 = 0.f, a1 = 0.f;
    const unsigned* V2 = (const unsigned*)Vh + lane;
#pragma unroll 8
    for (int kk = 0; kk < KEYS; ++kk) {
        if (kk >= NMETA && kk < 64) continue;
        const float pr = sc[kk]; const unsigned w = V2[(size_t)kk * 64];
        a0 = fmaf(pr, bf2f(w & 0xffffu), a0); a1 = fmaf(pr, bf2f(w >> 16), a1);
    }
    o0 = a0; o1 = a1;
    return sum;
}
__device__ void phase2_ref(const Params& p, float* lds, int vb, int nvb) {
    const int tid = TID(), lane = tid & 63, wave = tid >> 6;
    if (wave >= 4) return;
    float* sc = lds + wave * KEYS; float* qf = lds + 4 * KEYS + wave * 128;
    const bf16_t *QA = (const bf16_t*)(p.ws + OFF_QA), *KA = (const bf16_t*)(p.ws + OFF_KA), *VA = (const bf16_t*)(p.ws + OFF_VA);
    const bf16_t *QB = (const bf16_t*)(p.ws + OFF_QB), *KB = (const bf16_t*)(p.ws + OFF_KB), *VB = (const bf16_t*)(p.ws + OFF_VB);
    bf16_t* OA = (bf16_t*)(p.ws + OFF_AO); bf16_t* OB = OA + 1024;
    const float lam = *(const float*)(p.ws + OFF_LAM);
    const int NTASK = 2 * 8 * MROWS / NB;
    for (int task = vb * 4 + wave; task < 2 * 8 * MROWS; task += nvb * 4) {
        const int type = task / (8 * MROWS), rem = task % (8 * MROWS), h = rem / MROWS, r = rem % MROWS;
        const RowInfo ri = row_decode(r); const int qr = row_q(ri); const int tq = ri.meta ? -1 : ri.t;
        if (type == 0) {
            const size_t bh = (size_t)(ri.b * 8 + h);
            const float slopeC = exp2f(-(float)(h + 1)) * LOG2E;
            float a0, a1, b0, b1;
            const float l1 = attn_row_ref(QA + (bh * QROWS + qr) * 128, 64, KA + bh * KEYS * 128, 0, VA + bh * KEYS * 128, slopeC, tq, sc, qf, lane, a0, a1);
            const float l2 = attn_row_ref(QA + (bh * QROWS + qr) * 128 + 64, 64, KA + bh * KEYS * 128, 64, VA + bh * KEYS * 128, slopeC, tq, sc, qf, lane, b0, b1);
            float y0 = a0 / l1 - lam * (b0 / l2), y1 = a1 / l1 - lam * (b1 / l2);
            const float ss = wave_sum(y0 * y0 + y1 * y1);
            const float rstd = 1.0f / sqrtf(ss * (1.0f / 128.f) + EPS) * (1.0f - LAM_INIT);
            y0 = y0 * rstd * p.g_subln[2 * lane]; y1 = y1 * rstd * p.g_subln[2 * lane + 1];
            ((unsigned*)(OA + (size_t)r * AOP + h * 128))[lane] = f2bf(y0) | (f2bf(y1) << 16);
        } else {
            const size_t bh = (size_t)(ri.b * 8 + h), bk = (size_t)(ri.b * 2 + (h >> 2));
            float a0, a1;
            const float l = attn_row_ref(QB + (bh * QROWS + qr) * 128, 128, KB + bk * KEYS * 128, 0, VB + bk * KEYS * 128, 0.f, -1, sc, qf, lane, a0, a1);
            ((unsigned*)(OB + (size_t)r * AOP + h * 128))[lane] = f2bf(a0 / l) | (f2bf(a1 / l) << 16);
        }
    }
    (void)NTASK;
}

namespace fa {
using bf16x8 = __attribute__((ext_vector_type(8))) short;
using s16x4  = __attribute__((ext_vector_type(4))) short;
using f32x16 = __attribute__((ext_vector_type(16))) float;
constexpr int NT = KEYS / 64;
constexpr int SHM_V = 16384, SHM_K = 16384;
constexpr int L_V = 0, L_K = 2 * SHM_V, L_WS = L_K + 2 * SHM_K, L_X = L_WS + 8 * 64 * 4;
constexpr int LDS_ATTN = L_X + 8 * 8704;
constexpr float THR = 8.f;
#define KSWZ(row, colB) ((row) * 256 + ((colB) ^ (((row) & 7) << 4)))
#define SBAR() __builtin_amdgcn_sched_barrier(0)
__device__ __forceinline__ int crow(int r, int hi) { return (r & 3) + 8 * (r >> 2) + 4 * hi; }
__device__ __forceinline__ unsigned cvtpk(float lo, float hi) { unsigned r; asm volatile("v_cvt_pk_bf16_f32 %0, %1, %2" : "=v"(r) : "v"(lo), "v"(hi)); return r; }
__device__ __forceinline__ void partialSM(f32x16& p0, f32x16& p1, float& m_reg, float& mn, float& alpha) {
    float pmax = p0[0];
#pragma unroll
    for (int r = 1; r < 16; ++r) pmax = fmaxf(pmax, p0[r]);
#pragma unroll
    for (int r = 0; r < 16; ++r) pmax = fmaxf(pmax, p1[r]);
    { auto rr = __builtin_amdgcn_permlane32_swap(__float_as_uint(pmax), __float_as_uint(pmax), false, false);
      pmax = fmaxf(__uint_as_float(rr[0]), __uint_as_float(rr[1])); }
    if (__builtin_expect(__all(pmax - m_reg <= THR), 1)) { mn = m_reg; alpha = 1.f; }
    else { mn = fmaxf(m_reg, pmax); alpha = __builtin_amdgcn_exp2f(m_reg - mn); m_reg = mn; }
#pragma unroll
    for (int r = 0; r < 16; ++r) { p0[r] -= mn; p1[r] -= mn; }
#pragma unroll
    for (int r = 0; r < 16; ++r) p0[r] = __builtin_amdgcn_exp2f(p0[r]);
}
__device__ __forceinline__ void finishSM(f32x16& p0, f32x16& p1, float alpha, float& l_reg, bf16x8& pa0, bf16x8& pa1, bf16x8& pa2, bf16x8& pa3) {
#pragma unroll
    for (int r = 0; r < 16; ++r) p1[r] = __builtin_amdgcn_exp2f(p1[r]);
    float ps = 0;
#pragma unroll
    for (int r = 0; r < 16; ++r) ps += p0[r];
#pragma unroll
    for (int r = 0; r < 16; ++r) ps += p1[r];
    { auto rr = __builtin_amdgcn_permlane32_swap(__float_as_uint(ps), __float_as_uint(ps), false, false);
      ps = __uint_as_float(rr[0]) + __uint_as_float(rr[1]); }
    l_reg = l_reg * alpha + ps;
#define PK4(P, BASE, OUT) do { unsigned a0 = cvtpk(P[BASE + 0], P[BASE + 1]), a1 = cvtpk(P[BASE + 2], P[BASE + 3]);   \
    unsigned b0 = cvtpk(P[BASE + 4], P[BASE + 5]), b1 = cvtpk(P[BASE + 6], P[BASE + 7]);                              \
    auto r0 = __builtin_amdgcn_permlane32_swap(a0, b0, false, false); auto r1 = __builtin_amdgcn_permlane32_swap(a1, b1, false, false); \
    u32x4 w = {r0[0], r1[0], r0[1], r1[1]}; OUT = *reinterpret_cast<bf16x8*>(&w); } while (0)
    PK4(p0, 0, pa0); PK4(p0, 8, pa1); PK4(p1, 0, pa2); PK4(p1, 8, pa3);
#undef PK4
}
template <int ND0>
__device__ __forceinline__ void qkt(f32x16& p0, f32x16& p1, const char* Ks, const bf16x8* qr, int d0b, int r32, int hi) {
    p0 = f32x16{}; p1 = f32x16{};
#pragma unroll
    for (int d0 = 0; d0 < ND0; ++d0) { const int cb = ((d0b + d0) * 16 + hi * 8) * 2;
        const bf16x8 b0 = *reinterpret_cast<const bf16x8*>(Ks + KSWZ(r32, cb));
        const bf16x8 b1 = *reinterpret_cast<const bf16x8*>(Ks + KSWZ(32 + r32, cb));
        p0 = __builtin_amdgcn_mfma_f32_32x32x16_bf16(b0, qr[d0], p0, 0, 0, 0);
        p1 = __builtin_amdgcn_mfma_f32_32x32x16_bf16(b1, qr[d0], p1, 0, 0, 0); }
}
__device__ __forceinline__ int v_st(int k, int c) { const int kk = (k & ~0xC) | ((k & 4) << 1) | ((k & 8) >> 1); return ((kk >> 3) * 4 + (c >> 5)) * 512 + ((kk & 7) * 32 + (c & 31)) * 2; }
__device__ __forceinline__ int v_rd_base(int lane) { return ((lane & 3) << 3) | (((lane >> 2) & 3) << 6) | (((lane >> 4) & 1) << 5) | (((lane >> 5) & 1) << 8); }
constexpr int v_rd_off(int d0, int ks, int half) { return d0 * 512 + ks * 4096 + half * 2048; }
template <int OFF> __device__ __forceinline__ s16x4 tr_read(int vb) {
    s16x4 r; asm volatile("ds_read_b64_tr_b16 %0, %1 offset:%2" : "=&v"(r) : "v"(vb), "i"(OFF) : "memory"); return r;
}
template <int D0> __device__ __forceinline__ void pv_one(f32x16& od, int vb, bf16x8 pa0, bf16x8 pa1, bf16x8 pa2, bf16x8 pa3) {
    const s16x4 l0 = tr_read<v_rd_off(D0, 0, 0)>(vb), h0 = tr_read<v_rd_off(D0, 0, 1)>(vb), l1 = tr_read<v_rd_off(D0, 1, 0)>(vb), h1 = tr_read<v_rd_off(D0, 1, 1)>(vb);
    const s16x4 l2 = tr_read<v_rd_off(D0, 2, 0)>(vb), h2 = tr_read<v_rd_off(D0, 2, 1)>(vb), l3 = tr_read<v_rd_off(D0, 3, 0)>(vb), h3 = tr_read<v_rd_off(D0, 3, 1)>(vb);
    asm volatile("s_waitcnt lgkmcnt(0)" ::: "memory"); SBAR();
#define PK(L, H) (bf16x8){L[0], L[1], L[2], L[3], H[0], H[1], H[2], H[3]}
    od = __builtin_amdgcn_mfma_f32_32x32x16_bf16(pa0, PK(l0, h0), od, 0, 0, 0);
    od = __builtin_amdgcn_mfma_f32_32x32x16_bf16(pa1, PK(l1, h1), od, 0, 0, 0);
    od = __builtin_amdgcn_mfma_f32_32x32x16_bf16(pa2, PK(l2, h2), od, 0, 0, 0);
    od = __builtin_amdgcn_mfma_f32_32x32x16_bf16(pa3, PK(l3, h3), od, 0, 0, 0);
#undef PK
}
__device__ __forceinline__ void pv_d0(f32x16* o, int vb, bf16x8 pa0, bf16x8 pa1, bf16x8 pa2, bf16x8 pa3) {
    pv_one<0>(o[0], vb, pa0, pa1, pa2, pa3); pv_one<1>(o[1], vb, pa0, pa1, pa2, pa3); pv_one<2>(o[2], vb, pa0, pa1, pa2, pa3); pv_one<3>(o[3], vb, pa0, pa1, pa2, pa3);
}

template <bool DIFF>
__device__ __forceinline__ void attn_unit(const bf16_t* __restrict__ Qlane, const bf16_t* __restrict__ Kh, const bf16_t* __restrict__ Vh, int tq, float slopeL, char* lds, f32x16 (&o)[4], float& l_reg) {
    constexpr int ND0 = DIFF ? 4 : 8;
    const int tid = TID(), wid = tid >> 6, lane = tid & 63, r32 = lane & 31, hi = lane >> 5;
    char* V_lds = lds + L_V; char* K_lds = lds + L_K;
    float* al_l = (float*)(lds + L_WS) + wid * 64 + 32;
    const int d0b = DIFF ? (wid >> 2) * 4 : 0;
    float m_reg = -1e30f; l_reg = 0.f;
#pragma unroll
    for (int d = 0; d < 4; ++d) o[d] = f32x16{};
    bf16x8 qr[ND0];
#pragma unroll
    for (int d0 = 0; d0 < ND0; ++d0) qr[d0] = *reinterpret_cast<const bf16x8*>(Qlane + d0 * 16 + hi * 8);
    const int sr = tid >> 4, sc = (tid & 15) * 8, vst0 = v_st(sr, sc), vst1 = v_st(32 + sr, sc);
    const int vb0 = (int)(uintptr_t)V_lds + v_rd_base(lane);
    struct { bf16x8 vs0, vs1, ks0, ks1; } st_[1];
#define SLOAD(i, k0) do { st_[i].vs0 = *(const bf16x8*)(&Vh[(size_t)((k0) + sr) * 128 + sc]); st_[i].vs1 = *(const bf16x8*)(&Vh[(size_t)((k0) + 32 + sr) * 128 + sc]); \
    st_[i].ks0 = *(const bf16x8*)(&Kh[(size_t)((k0) + sr) * 128 + sc]); st_[i].ks1 = *(const bf16x8*)(&Kh[(size_t)((k0) + 32 + sr) * 128 + sc]); } while (0)
#define SWRITE(b, i) do { *(bf16x8*)(V_lds + (b) * SHM_V + vst0) = st_[i].vs0; *(bf16x8*)(V_lds + (b) * SHM_V + vst1) = st_[i].vs1; const int kc = sc * 2; \
    *(bf16x8*)(K_lds + (b) * SHM_K + KSWZ(sr, kc)) = st_[i].ks0; *(bf16x8*)(K_lds + (b) * SHM_K + KSWZ(32 + sr, kc)) = st_[i].ks1; } while (0)
#define RESC(a) do { if (__any((a) < 1.f)) { if (hi == 0) al_l[r32] = (a); asm volatile("s_waitcnt lgkmcnt(0)" ::: "memory"); \
    _Pragma("unroll") for (int d = 0; d < 4; ++d) _Pragma("unroll") for (int r = 0; r < 16; ++r) o[d][r] *= al_l[crow(r, hi)]; } } while (0)
#define BIAS(P0, P1, j) do { if (DIFF) { const float base_ = (float)(tq - ((j) - 1) * 64 - 4 * hi); \
    _Pragma("unroll") for (int r = 0; r < 16; ++r) { const float d_ = base_ - (float)((r & 3) + 8 * (r >> 2)); \
        P0[r] = fmaf(-slopeL, fabsf(d_), P0[r]); P1[r] = fmaf(-slopeL, fabsf(d_ - 32.f), P1[r]); } } } while (0)
    f32x16 pA0, pA1, pB0, pB1; float mnA, mnB, alA, alB; bf16x8 pa0, pa1, pa2, pa3;
    SLOAD(0, 0); asm volatile("s_waitcnt vmcnt(0)" ::: "memory"); SWRITE(0, 0); __syncthreads();
    qkt<ND0>(pA0, pA1, K_lds, qr, d0b, r32, hi);
#pragma unroll
    for (int r = 8; r < 16; ++r) pA0[r] = -1e30f;
#pragma unroll
    for (int r = 0; r < 16; ++r) pA1[r] = -1e30f;
    partialSM(pA0, pA1, m_reg, mnA, alA);
    SLOAD(0, 64);
    SWRITE(1, 0); __syncthreads();
    for (int j = 1; j + 1 < NT; j += 2) {
        SBAR(); qkt<ND0>(pB0, pB1, K_lds + SHM_K, qr, d0b, r32, hi); BIAS(pB0, pB1, j);
        finishSM(pA0, pA1, alA, l_reg, pa0, pa1, pa2, pa3); SBAR();
        SLOAD(0, (j + 1) * 64); SBAR();
        pv_d0(o, vb0, pa0, pa1, pa2, pa3); partialSM(pB0, pB1, m_reg, mnB, alB);
        __syncthreads(); SWRITE(0, 0);
        RESC(alB); __syncthreads();
        SBAR(); qkt<ND0>(pA0, pA1, K_lds, qr, d0b, r32, hi); BIAS(pA0, pA1, j + 1);
        finishSM(pB0, pB1, alB, l_reg, pa0, pa1, pa2, pa3); SBAR();
        if (j + 2 < NT) SLOAD(0, (j + 2) * 64); SBAR();
        pv_d0(o, vb0 + SHM_V, pa0, pa1, pa2, pa3); partialSM(pA0, pA1, m_reg, mnA, alA);
        __syncthreads(); if (j + 2 < NT) { SWRITE(1, 0); }
        RESC(alA); __syncthreads();
    }
    finishSM(pA0, pA1, alA, l_reg, pa0, pa1, pa2, pa3); SBAR();
    pv_d0(o, vb0, pa0, pa1, pa2, pa3);
    asm volatile("s_waitcnt lgkmcnt(0)" ::: "memory");
#undef SLOAD
#undef SWRITE
#undef RESC
#undef BIAS
}

template <class RowPtr>
__device__ __forceinline__ void store_tile(const f32x16 (&y)[4], char* stage, int lane, RowPtr rowptr) {
    const int r32 = lane & 31, hi = lane >> 5;
    bf16_t* stg = (bf16_t*)stage;
#pragma unroll
    for (int r = 0; r < 16; ++r) { const int orow = crow(r, hi);
#pragma unroll
        for (int d0 = 0; d0 < 4; ++d0) stg[orow * 136 + d0 * 32 + r32] = (bf16_t)f2bf(y[d0][r]); }
    asm volatile("s_waitcnt lgkmcnt(0)" ::: "memory");
#pragma unroll
    for (int i = 0; i < 8; ++i) { const int row = i * 4 + (lane >> 4), ch = lane & 15;
        const u32x4 v = *(const u32x4*)(stg + row * 136 + ch * 8);
        bf16_t* gp = rowptr(row); if (gp) *(u32x4*)(gp + ch * 8) = v; }
    asm volatile("s_waitcnt lgkmcnt(0)" ::: "memory");
}
}

__device__ void phase2_fast(const Params& p, char* lds, int vb, int nvb) {
    using namespace fa;
    const int tid = TID(), wid = __builtin_amdgcn_readfirstlane(tid >> 6), lane0 = tid & 63;
    const bf16_t *QA = (const bf16_t*)(p.ws + OFF_QA), *KA = (const bf16_t*)(p.ws + OFF_KA), *VA = (const bf16_t*)(p.ws + OFF_VA);
    const bf16_t *QB = (const bf16_t*)(p.ws + OFF_QB), *KB = (const bf16_t*)(p.ws + OFF_KB), *VB = (const bf16_t*)(p.ws + OFF_VB);
    bf16_t* OA = (bf16_t*)(p.ws + OFF_AO); bf16_t* OB = OA + 1024;
    const float lam = *(const float*)(p.ws + OFF_LAM);
    float* li_l = (float*)(lds + L_WS) + wid * 64;
    constexpr int NU_B = NB * 8 * 33, NU_A = NB * 8 * 65;
    for (int u = vb; u < NU_B + NU_A; u += nvb) {
        f32x16 o[4]; float l_reg;
        if (u < NU_B) {
            const int bh = u / 33, qb = u % 33, b = bh >> 3, h = bh & 7;
            const bool is_meta = qb == 32;
            { const int r32q = lane0 & 31; const bool rvalid = !is_meta || (wid == 0 && r32q < 16);
              const int qrow = is_meta ? (rvalid ? SEQ + r32q : SEQ) : qb * 256 + wid * 32 + r32q;
              const size_t kvo = (size_t)(b * 2 + (h >> 2)) * KEYS * 128;
              attn_unit<false>(QB + ((size_t)bh * QROWS + qrow) * 128, KB + kvo, VB + kvo, 0, 0.f, lds, o, l_reg); }
            int lane = lane0; asm volatile("" : "+v"(lane));
            const int r32 = lane & 31, hi = lane >> 5;
            if (hi == 0) li_l[r32] = l_reg;
            asm volatile("s_waitcnt lgkmcnt(0)" ::: "memory");
#pragma unroll
            for (int r = 0; r < 16; ++r) { const float rl = __builtin_amdgcn_rcpf(li_l[crow(r, hi)]);
#pragma unroll
                for (int d = 0; d < 4; ++d) o[d][r] *= rl; }
            const int wave_row0 = is_meta ? 0 : qb * 256 + wid * 32;
            store_tile(o, lds + L_X + wid * 8704, lane, [&](int row) -> bf16_t* {
                if (is_meta) { if (wid != 0 || row >= 16) return nullptr; return OB + (size_t)(MREAL + b * NMETA + row) * AOP + h * 128; }
                return OB + (size_t)(b * SEQ + wave_row0 + row) * AOP + h * 128; });
            __syncthreads();
        } else {
            const int ua = u - NU_B, bh = ua / 65, qb = ua % 65, b = bh >> 3, h = bh & 7, mp = wid >> 2, wq = wid & 3;
            const bool is_meta = qb == 64;
            { const int r32q = lane0 & 31; const bool rvalid = !is_meta || (wq == 0 && r32q < 16);
              const int qrow = is_meta ? (rvalid ? SEQ + r32q : SEQ) : qb * 128 + wq * 32 + r32q;
              const float slopeL = is_meta ? 0.f : exp2f(-(float)(h + 1)) * LOG2E;
              const size_t kvo = (size_t)bh * KEYS * 128;
              attn_unit<true>(QA + ((size_t)bh * QROWS + qrow) * 128 + mp * 64, KA + kvo, VA + kvo, qrow, slopeL, lds, o, l_reg); }
            int lane = lane0; asm volatile("" : "+v"(lane));
            const int r32 = lane & 31, hi = lane >> 5;
            if (hi == 0) li_l[r32] = l_reg;
            asm volatile("s_waitcnt lgkmcnt(0)" ::: "memory");
#pragma unroll
            for (int r = 0; r < 16; ++r) { const float rl = __builtin_amdgcn_rcpf(li_l[crow(r, hi)]);
#pragma unroll
                for (int d = 0; d < 4; ++d) o[d][r] *= rl; }
            float* X = (float*)(lds + L_X) + wq * 4096;
            if (mp == 1) {
#pragma unroll
                for (int r = 0; r < 16; ++r)
#pragma unroll
                    for (int d = 0; d < 4; ++d) X[(r * 4 + d) * 64 + lane] = o[d][r];
            }
            __syncthreads();
            if (mp == 0) {
                float ss[16];
#pragma unroll
                for (int r = 0; r < 16; ++r) { float a = 0.f;
#pragma unroll
                    for (int d = 0; d < 4; ++d) { const float y = o[d][r] - lam * X[(r * 4 + d) * 64 + lane]; o[d][r] = y; a += y * y; }
                    ss[r] = a; }
#pragma unroll
                for (int r = 0; r < 16; ++r) {
                    float a = ss[r];
                    a += __shfl_xor(a, 1); a += __shfl_xor(a, 2); a += __shfl_xor(a, 4); a += __shfl_xor(a, 8); a += __shfl_xor(a, 16);
                    ss[r] = 1.0f / sqrtf(a * (1.0f / 128.f) + EPS) * (1.0f - LAM_INIT);
                }
                float g[4];
#pragma unroll
                for (int d = 0; d < 4; ++d) g[d] = p.g_subln[d * 32 + r32];
#pragma unroll
                for (int r = 0; r < 16; ++r)
#pragma unroll
                    for (int d = 0; d < 4; ++d) o[d][r] *= ss[r] * g[d];
            }
            __syncthreads();
            if (mp == 0) {
                const int wave_row0 = is_meta ? 0 : qb * 128 + wq * 32;
                store_tile(o, lds + L_X + wid * 8704, lane, [&](int row) -> bf16_t* {
                    if (is_meta) { if (wq != 0 || row >= 16) return nullptr; return OA + (size_t)(MREAL + b * NMETA + row) * AOP + h * 128; }
                    return OA + (size_t)(b * SEQ + wave_row0 + row) * AOP + h * 128; });
            }
            __syncthreads();
        }
    }
}

__device__ __forceinline__ const bf16_t* sg_row(const Params& p, int grow) { return grow < MREAL ? (const bf16_t*)p.out + (size_t)grow * 2048 : (const bf16_t*)(p.ws + OFF_SGM) + (size_t)(grow - MREAL) * 2048; }
__device__ void phase3a_ref(const Params& p, float* lds, int vb, int nvb, int pass) {
    const bf16_t* A = (const bf16_t*)(p.ws + OFF_AO) + (pass == 0 ? 0 : 1024);
    const float* W = pass == 0 ? p.w_ba : p.w_bb;
    float* T = (float*)(p.ws + OFF_WGU); bf16_t* MG = (bf16_t*)(p.ws + OFF_MERGED);
    constexpr int NTM = MPAD / 128, NTN = DM / 128;
    for (int t = vb; t < NTM * NTN; t += nvb) {
        const int tm = t / NTN, tn = t % NTN, row0 = tm * 128, col0 = tn * 128;
        if (row0 >= MROWS) continue;
        ngemm_tile(lds, DM,
            [&](int r) { return A + (size_t)(row0 + r) * AOP; },
            [&](int k, int c) { return W[(size_t)k * DM + col0 + c]; },
            [&](const float* Ct) {
                const int tid = TID(), r = tid >> 2, q = tid & 3, grow = row0 + r;
                if (grow >= MROWS) return;
                const bf16_t* sg = sg_row(p, grow) + (pass == 0 ? 0 : 1024) + col0 + q * 32;
                for (int i = 0; i < 32; ++i) {
                    const float y = Ct[r * 129 + q * 32 + i] * bf2f(sg[i]); const size_t o = (size_t)grow * DM + col0 + q * 32 + i;
                    if (pass == 0) T[o] = y; else MG[o] = (bf16_t)f2bf(T[o] + y);
                }
            });
    }
}
__device__ __forceinline__ float* h2_row(const Params& p, int grow) { return grow < MREAL ? p.out + (size_t)grow * DM : (float*)(p.ws + OFF_H2M) + (size_t)(grow - MREAL) * DM; }
__device__ void phase3b_ref(const Params& p, float* lds, int vb, int nvb) {
    const bf16_t* MG = (const bf16_t*)(p.ws + OFF_MERGED);
    constexpr int NTM = MPAD / 128, NTN = DM / 128;
    for (int t = vb; t < NTM * NTN; t += nvb) {
        const int tm = t / NTN, tn = t % NTN, row0 = tm * 128, col0 = tn * 128;
        if (row0 >= MROWS) continue;
        ngemm_tile(lds, DM,
            [&](int r) { return MG + (size_t)(row0 + r) * DM; },
            [&](int k, int c) { return p.w_out[(size_t)k * DM + col0 + c]; },
            [&](const float* Ct) {
                const int tid = TID(), r = tid >> 2, q = tid & 3, grow = row0 + r;
                if (grow >= MROWS) return;
                const float* hr = h_row(p, grow) + col0 + q * 32; float* o = h2_row(p, grow) + col0 + q * 32;
                for (int i = 0; i < 32; ++i) o[i] = hr[i] + Ct[r * 129 + q * 32 + i];
            });
    }
}

__device__ void phase4a(const Params& p, float* lds, int vb, int nvb) {
    const int tid = TID(), lane = tid & 63, wave = tid >> 6;
    for (int i = tid; i < DM * NEXP; i += NTHREADS) { const int k = i >> 4, e = i & 15; lds[e * DM + k] = p.w_router[i]; }
    __syncthreads();
    bf16_t* U2 = (bf16_t*)(p.ws + OFF_UN); float* AFF = (float*)(p.ws + OFF_AFF);
    for (int r = vb * 8 + wave; r < MROWS; r += nvb * 8) {
        const RowInfo ri = row_decode(r);
        const f32x4* xr = (const f32x4*)h2_row(p, r) + lane;
        f32x4 v[4]; float s = 0.f;
#pragma unroll
        for (int j = 0; j < 4; ++j) { v[j] = xr[64 * j]; s += (v[j].x * v[j].x + v[j].y * v[j].y) + (v[j].z * v[j].z + v[j].w * v[j].w); }
        const float rstd = 1.0f / sqrtf(wave_sum(s) * (1.0f / DM) + EPS);
        u32x2* o = (u32x2*)(U2 + (size_t)r * DM) + lane;
#pragma unroll
        for (int j = 0; j < 4; ++j) {
            const f32x4 g = ((const f32x4*)p.g_ffn)[lane + 64 * j];
            v[j].x *= rstd * g.x; v[j].y *= rstd * g.y; v[j].z *= rstd * g.z; v[j].w *= rstd * g.w;
            u32x2 w; w.x = f2bf(v[j].x) | (f2bf(v[j].y) << 16); w.y = f2bf(v[j].z) | (f2bf(v[j].w) << 16);
            o[64 * j] = w;
        }
        float mylg = -1e30f;
#pragma unroll 1
        for (int e = 0; e < NEXP; ++e) {
            float a = 0.f;
#pragma unroll
            for (int j = 0; j < 4; ++j) { const f32x4 w = *(const f32x4*)(lds + e * DM + 4 * (lane + 64 * j)); a += v[j].x * w.x + v[j].y * w.y + v[j].z * w.z + v[j].w * w.w; }
            a = wave_sum(a);
            if (lane == e) mylg = a;
        }
        const float mx = wave_max(mylg);
        const float ex = lane < NEXP ? expf(mylg - mx) : 0.f;
        const float mine = ex / wave_sum(ex);
        if (lane < NEXP) AFF[((size_t)ri.b * NEXP + lane) * LTOT + row_pos(ri)] = mine;
    }
    __syncthreads();
}

__device__ void phase4b_ref(const Params& p, float* lds, int vb, int nvb) {
    const float* AFF = (const float*)(p.ws + OFF_AFF); int* IDX = (int*)(p.ws + OFF_IDX); int* SEL = (int*)(p.ws + OFF_SEL);
    constexpr int NCH = (LTOT + NTHREADS - 1) / NTHREADS;
    for (int t = vb; t < NB * NEXP * NCH; t += nvb) {
        const int be = t / NCH, ch = t % NCH, b = be / NEXP, e = be % NEXP;
        const float* a = AFF + (size_t)be * LTOT;
        __syncthreads();
        for (int i = TID(); i < LTOT; i += NTHREADS) lds[i] = a[i];
        __syncthreads();
        const int tok = ch * NTHREADS + TID();
        if (tok < LTOT) {
            const float mine = lds[tok]; int rank = 0;
            for (int j = 0; j < LTOT; ++j) { const float o = lds[j]; rank += (o > mine || (o == mine && j < tok)) ? 1 : 0; }
            if (rank < CAP) { IDX[(size_t)be * CAP + rank] = tok; SEL[((size_t)b * LTOT + tok) * NEXP + e] = rank; }
            else SEL[((size_t)b * LTOT + tok) * NEXP + e] = -1;
        }
    }
    __syncthreads();
}

__device__ void phase5a_ref(const Params& p, float* lds, int vb, int nvb) {
    const bf16_t* U2 = (const bf16_t*)(p.ws + OFF_UN); const int* IDX = (const int*)(p.ws + OFF_IDX); bf16_t* HID = (bf16_t*)(p.ws + OFF_HID);
    constexpr int NTM = (ESLOTS + 127) / 128, NTN = 2 * EFF / 128;
    for (int t = vb; t < NEXP * NTM * NTN; t += nvb) {
        const int e = t / (NTM * NTN), tm = (t / NTN) % NTM, tn = t % NTN, s0 = tm * 128, f0 = tn * 64;
        const float* Wg = p.w_gate + (size_t)e * DM * EFF; const float* Wu = p.w_up + (size_t)e * DM * EFF;
        ngemm_tile(lds, DM,
            [&](int r) -> const bf16_t* { const int s = s0 + r; if (s >= ESLOTS) return nullptr; const int b = s / CAP, c = s % CAP; return U2 + (size_t)pos_row(b, IDX[((size_t)b * NEXP + e) * CAP + c]) * DM; },
            [&](int k, int c) { return c < 64 ? Wg[(size_t)k * EFF + f0 + c] : Wu[(size_t)k * EFF + f0 + c - 64]; },
            [&](const float* Ct) {
                const int tid = TID(), r = tid >> 2, q = tid & 3, s = s0 + r;
                if (s >= ESLOTS) return;
                for (int i = 0; i < 16; ++i) { const float g = Ct[r * 129 + q * 16 + i], u = Ct[r * 129 + 64 + q * 16 + i];
                    HID[((size_t)e * ESLOTS + s) * EFF + f0 + q * 16 + i] = (bf16_t)f2bf(g / (1.0f + __expf(-g)) * u); }
            });
    }
}
__device__ void phase5b_ref(const Params& p, float* lds, int vb, int nvb) {
    const bf16_t* HID = (const bf16_t*)(p.ws + OFF_HID); const int* IDX = (const int*)(p.ws + OFF_IDX); const float* AFF = (const float*)(p.ws + OFF_AFF); bf16_t* YB = (bf16_t*)(p.ws + OFF_YB);
    constexpr int NTM = (ESLOTS + 127) / 128, NTN = DM / 128;
    for (int t = vb; t < NEXP * NTM * NTN; t += nvb) {
        const int e = t / (NTM * NTN), tm = (t / NTN) % NTM, tn = t % NTN, s0 = tm * 128, col0 = tn * 128;
        const float* Wd = p.w_down + (size_t)e * EFF * DM;
        ngemm_tile(lds, EFF,
            [&](int r) -> const bf16_t* { const int s = s0 + r; return s < ESLOTS ? HID + ((size_t)e * ESLOTS + s) * EFF : nullptr; },
            [&](int k, int c) { return Wd[(size_t)k * DM + col0 + c]; },
            [&](const float* Ct) {
                const int tid = TID(), r = tid >> 2, q = tid & 3, s = s0 + r;
                if (s >= ESLOTS) return;
                const int b = s / CAP, c = s % CAP; const int tok = IDX[((size_t)b * NEXP + e) * CAP + c];
                const float af = AFF[((size_t)b * NEXP + e) * LTOT + tok];
                for (int i = 0; i < 32; ++i) YB[((size_t)e * ESLOTS + s) * DM + col0 + q * 32 + i] = (bf16_t)f2bf(Ct[r * 129 + q * 32 + i] * af);
            });
    }
}

__device__ void phase6(const Params& p, int vb, int nvb) {
    const int tid = TID(), lane = tid & 63, wave = tid >> 6;
    const int* SEL = (const int*)(p.ws + OFF_SEL); const bf16_t* YB = (const bf16_t*)(p.ws + OFF_YB);
    for (int r = vb * 8 + wave; r < MREAL; r += nvb * 8) {
        const int b = r >> 13, tok = NMETA + (r & (SEQ - 1));
        f32x4* xr = (f32x4*)(p.out + (size_t)r * DM) + lane;
        f32x4 v[4];
#pragma unroll
        for (int j = 0; j < 4; ++j) v[j] = xr[64 * j];
        const int sel = lane < NEXP ? SEL[((size_t)b * LTOT + tok) * NEXP + lane] : -1;
        for (int e = 0; e < NEXP; ++e) {
            const int c = __shfl(sel, e);
            if (c >= 0) {
                const u32x2* y = (const u32x2*)(YB + ((size_t)e * ESLOTS + b * CAP + c) * DM) + lane;
#pragma unroll
                for (int j = 0; j < 4; ++j) { const u32x2 w = y[64 * j]; v[j].x += bf2f(w.x & 0xffffu); v[j].y += bf2f(w.x >> 16); v[j].z += bf2f(w.y & 0xffffu); v[j].w += bf2f(w.y >> 16); }
            }
        }
        float s = 0.f;
#pragma unroll
        for (int j = 0; j < 4; ++j) s += (v[j].x * v[j].x + v[j].y * v[j].y) + (v[j].z * v[j].z + v[j].w * v[j].w);
        const float rstd = 1.0f / sqrtf(wave_sum(s) * (1.0f / DM) + EPS);
#pragma unroll
        for (int j = 0; j < 4; ++j) { const f32x4 g = ((const f32x4*)p.g_final)[lane + 64 * j]; xr[64 * j] = (f32x4){v[j].x * rstd * g.x, v[j].y * rstd * g.y, v[j].z * rstd * g.z, v[j].w * rstd * g.w}; }
    }
}

template <class DstRow>
__device__ __forceinline__ void transpose_item(const float* __restrict__ W, int N, bf16_t* __restrict__ WT, int ldk, int koff, float* scr, int k0, int n0, int lane, DstRow dst) {
#pragma unroll 8
    for (int i = 0; i < 32; ++i) { const int kk = 2 * i + (lane >> 5); scr[kk * 33 + (lane & 31)] = W[(size_t)(k0 + kk) * N + n0 + (lane & 31)]; }
    asm volatile("s_waitcnt vmcnt(0) lgkmcnt(0)" ::: "memory");
    const int c = lane & 7;
#pragma unroll
    for (int j = 0; j < 4; ++j) { const int n = (lane >> 3) + 8 * j; const float* sp = scr + (8 * c) * 33 + n;
        u32x4 o; o.x = f2bf(sp[0 * 33]) | (f2bf(sp[1 * 33]) << 16); o.y = f2bf(sp[2 * 33]) | (f2bf(sp[3 * 33]) << 16);
        o.z = f2bf(sp[4 * 33]) | (f2bf(sp[5 * 33]) << 16); o.w = f2bf(sp[6 * 33]) | (f2bf(sp[7 * 33]) << 16);
        *(u32x4*)(WT + (size_t)dst(n0 + n) * ldk + koff + k0 + 8 * c) = o; }
    asm volatile("s_waitcnt lgkmcnt(0)" ::: "memory");
}
__device__ __forceinline__ int rope_slot(int e) { const int half = e >> 6, el = e & 63, j = el & 31, n = el >> 5, g = half * 8 + (j >> 2); return 32 * (g >> 2) + 8 * (g & 3) + 4 * n + (j & 3); }
__device__ void transpose_p0(const Params& p, float* lds, int vb, int nvb) {
    const int tid = TID(), lane = tid & 63, wave = tid >> 6;
    float* scr = lds + wave * (64 * 33);
    bf16_t* WIN = (bf16_t*)(p.ws + OFF_WIN); bf16_t* WAB = (bf16_t*)(p.ws + OFF_WAB); bf16_t* WO = (bf16_t*)(p.ws + OFF_WO);
    constexpr int I_IN = 16 * (INW / 32), I_SQ = 16 * 32;
    for (int it = vb * 8 + wave; it < I_IN + 3 * I_SQ; it += nvb * 8) {
        int r = it;
        if (r < I_IN) { const int kb = r / (INW / 32), nb = r % (INW / 32);
            transpose_item(p.w_in, INW, WIN, DM, 0, scr, kb * 64, nb * 32, lane, [](int n) { return (n >= 3072 && n < 4352) ? (n & ~127) + rope_slot(n & 127) : n; }); continue; }
        r -= I_IN; const int m = r / I_SQ, q = r % I_SQ, kb = q / 32, nb = q % 32;
        if (m == 0) transpose_item(p.w_ba, DM, WAB, 2048, 0, scr, kb * 64, nb * 32, lane, [](int n) { return n; });
        else if (m == 1) transpose_item(p.w_bb, DM, WAB, 2048, 1024, scr, kb * 64, nb * 32, lane, [](int n) { return n; });
        else transpose_item(p.w_out, DM, WO, DM, 0, scr, kb * 64, nb * 32, lane, [](int n) { return n; });
    }
}
__device__ void transpose_moe(const Params& p, float* lds, int vbl, int nvbl) {
    const int tid = TID(), lane = tid & 63, wave = tid >> 6;
    float* scr = lds + wave * (64 * 33);
    bf16_t* WGU = (bf16_t*)(p.ws + OFF_WGU); bf16_t* WD = (bf16_t*)(p.ws + OFF_WD);
    constexpr int I_G = 16 * 16, I_D = 8 * 32, I_E = 2 * I_G + I_D;
    for (int it = vbl * 8 + wave; it < NEXP * I_E; it += nvbl * 8) {
        const int e = it / I_E; int r = it % I_E;
        if (r < 2 * I_G) { const int up = r / I_G, q = r % I_G, kb = q / 16, nb = q % 16;
            const float* W = (up ? p.w_up : p.w_gate) + (size_t)e * DM * EFF;
            transpose_item(W, EFF, WGU + (size_t)e * DM * DM, DM, 0, scr, kb * 64, nb * 32, lane, [up](int f) { return 8 * (f >> 2) + 4 * up + (f & 3); }); }
        else { r -= 2 * I_G; const int kb = r / 32, nb = r % 32;
            transpose_item(p.w_down + (size_t)e * EFF * DM, DM, WD + (size_t)e * DM * EFF, EFF, 0, scr, kb * 64, nb * 32, lane, [](int n) { return n; }); }
    }
}

namespace pg8 {
#define PG8_LAS __attribute__((address_space(3)))
typedef short bf16x8 __attribute__((ext_vector_type(8)));
constexpr int BM = 256, BK = 64, HALF = 128, HTB = HALF * BK * 2, STAGE_BYTES = 8 * HTB, NXCD = 8, WGM = 8;
__host__ __device__ __forceinline__ int lds_byte(int r, int c) { const int st = (r >> 4) * 2 + (c >> 5), rr = r & 15, cc = c & 31, ob = rr * 64 + cc * 2; return st * 1024 + (ob ^ (((ob >> 9) & 1) << 5)); }
__host__ __device__ __forceinline__ void stage_rc(int b, int& R, int& C) { const int st = b / 1024, sb = b % 1024, swz = sb ^ (((sb >> 9) & 1) << 5); R = (st >> 1) * 16 + swz / 64; C = (st & 1) * 32 + (swz % 64) / 2; }
__host__ __device__ __forceinline__ int perm32(int rho) { const int n = rho >> 4, i = rho & 15; return 8 * (i >> 2) + 4 * n + (i & 3); }
struct Unit { int arow0, brow0, pm, pn, e; };
struct Gemm { const bf16_t* A; const bf16_t* Bt; int K; };
struct GridOrder {
    int nM, nN, nwg, G, c;
    __device__ void init(int nM_, int nN_, int G_, int c_) { nM = nM_; nN = nN_; nwg = nM * nN; G = G_; c = c_; }
    __device__ bool next(int i, Unit& u) const {
        const long L = (long)i * G + c; if (L >= nwg) return false;
        int wgid = (int)L; { const int q = nwg / NXCD, r = nwg % NXCD, xcd = wgid % NXCD, off = wgid / NXCD; wgid = (xcd < r ? xcd * (q + 1) : r * (q + 1) + (xcd - r) * q) + off; }
        const int nig = WGM * nN, gid = wgid / nig, fm = gid * WGM, gsz = (nM - fm) < WGM ? (nM - fm) : WGM;
        u.pm = fm + ((wgid % nig) % gsz); u.pn = (wgid % nig) / gsz; u.e = 0; u.arow0 = u.pm * BM; u.brow0 = u.pn * BM; return true;
    }
};
struct MoeOrder {
    int G, c;
    __device__ bool next(int i, Unit& u) const {
        const int L = i * G + c; if (L >= NEXP * 36) return false;
        u.e = L / 36; const int r = L % 36; u.pm = r % 9; u.pn = r / 9; u.arow0 = u.e * ESLOTS + u.pm * BM; u.brow0 = u.e * DM + u.pn * BM; return true;
    }
};
__device__ __forceinline__ unsigned cvt_pk_bf16(float lo, float hi) { unsigned r; asm volatile("v_cvt_pk_bf16_f32 %0, %1, %2" : "=v"(r) : "v"(lo), "v"(hi)); return r; }

template <class Epi, class Sched>
__device__ __forceinline__ void gemm_phase(PG8_LAS unsigned char* lds, const Gemm g, const Sched& S, const Epi& E) {
    const int tid = TID(), wid = __builtin_amdgcn_readfirstlane(tid >> 6), lane = tid & 63, wr = wid >> 2, wc = wid & 3, fr = lane & 15, fq = lane >> 4;
    const int K = g.K, nt = K / BK;
    unsigned voffA[2], voffB[2];
#pragma unroll
    for (int i = 0; i < 2; ++i) { int R, C; stage_rc(tid * 16 + i * 8192, R, C); const int Rb = Epi::PERM ? ((R & ~31) + perm32(R & 31)) : R;
        voffA[i] = (unsigned)(R * K + C) * 2u; voffB[i] = (unsigned)(Rb * K + C) * 2u; }
    const size_t kstep = (size_t)(BK * 2);
    const size_t hstep = (size_t)HALF * K * 2;
    const size_t rstep = (size_t)K * 2;
    const unsigned ldsw = (unsigned)wid * 1024u;
    const int aoff = lds_byte(wr * 64 + fr, fq * 8), boff = lds_byte(wc * 32 + fr, fq * 8);
#define PG8_SA(b, h) (((b) * 2 + (h)) * HTB)
#define PG8_SB(b, h) ((4 + (b) * 2 + (h)) * HTB)
#define PG8_STAGE(bufoff, gbase, voff) do { _Pragma("unroll") for (int _i = 0; _i < 2; ++_i) \
        __builtin_amdgcn_global_load_lds((const unsigned*)((const char*)(gbase) + (voff)[_i]), (PG8_LAS unsigned*)(lds + (bufoff) + ldsw + _i * 8192), 16, 0, 0); } while (0)
#define PG8_LDA(dst, b, h) do { _Pragma("unroll") for (int m = 0; m < 4; ++m) _Pragma("unroll") for (int k = 0; k < 2; ++k) dst[m][k] = *(const PG8_LAS bf16x8*)(lds + PG8_SA(b, h) + aoff + m * 2048 + k * 1024); } while (0)
#define PG8_LDB(dst, b, h) do { _Pragma("unroll") for (int n = 0; n < 2; ++n) _Pragma("unroll") for (int k = 0; k < 2; ++k) dst[n][k] = *(const PG8_LAS bf16x8*)(lds + PG8_SB(b, h) + boff + n * 2048 + k * 1024); } while (0)
#define PG8_MMA(ai, bj, At, Bt) do { __builtin_amdgcn_s_setprio(1); _Pragma("unroll") for (int m = 0; m < 4; ++m) _Pragma("unroll") for (int n = 0; n < 2; ++n) _Pragma("unroll") for (int k = 0; k < 2; ++k) \
        acc[ai][bj][m][n] = __builtin_amdgcn_mfma_f32_16x16x32_bf16(Bt[n][k], At[m][k], acc[ai][bj][m][n], 0, 0, 0); __builtin_amdgcn_s_setprio(0); } while (0)
#define PG8_WAIT_V(n) asm volatile("s_waitcnt vmcnt(" #n ")" ::: "memory")
#define PG8_WAIT_L(n) asm volatile("s_waitcnt lgkmcnt(" #n ")" ::: "memory")
#define PG8_BAR __builtin_amdgcn_s_barrier()
#define PG8_SCHED __builtin_amdgcn_sched_barrier(0)
    Unit cur, nxt; int ui = 0;
    if (!S.next(0, cur)) return;
    f32x4 acc[2][2][4][2];
#pragma unroll
    for (int a = 0; a < 2; ++a)
#pragma unroll
        for (int b = 0; b < 2; ++b)
#pragma unroll
            for (int m = 0; m < 4; ++m)
#pragma unroll
                for (int n = 0; n < 2; ++n) acc[a][b][m][n] = (f32x4){0.f, 0.f, 0.f, 0.f};
    bf16x8 At[4][2], B0[2][2], B1[2][2];
    const char* cA = (const char*)g.A + (size_t)cur.arow0 * rstep; const char* cB = (const char*)g.Bt + (size_t)cur.brow0 * rstep;
    PG8_STAGE(PG8_SB(0, 0), cB, voffB); PG8_STAGE(PG8_SB(0, 1), cB + hstep, voffB); PG8_STAGE(PG8_SA(0, 0), cA, voffA); PG8_STAGE(PG8_SA(0, 1), cA + hstep, voffA);
    if (wr == 1) PG8_BAR;
    PG8_WAIT_V(2); PG8_BAR;
    PG8_STAGE(PG8_SB(1, 0), cB + kstep, voffB); PG8_STAGE(PG8_SA(1, 0), cA + kstep, voffA); PG8_STAGE(PG8_SB(1, 1), cB + hstep + kstep, voffB);
    PG8_WAIT_V(6); PG8_BAR;
    for (;;) {
        const bool has_next = S.next(ui + 1, nxt);
        const char* nA = has_next ? (const char*)g.A + (size_t)nxt.arow0 * rstep : cA; const char* nB = has_next ? (const char*)g.Bt + (size_t)nxt.brow0 * rstep : cB;
        for (int t = 0; t < nt; t += 2) {
            const bool last = (t == nt - 2);
            const char* a1 = cA + (size_t)(t + 1) * kstep;
            const char* a2 = last ? nA : cA + (size_t)(t + 2) * kstep; const char* b2 = last ? nB : cB + (size_t)(t + 2) * kstep;
            const char* a3 = a2 + kstep; const char* b3 = b2 + kstep;
            if constexpr (Epi::HAS_MID) { if (t == nt / 2) E.mid(acc, cur, wr, wc, fr, fq); }
            PG8_LDB(B0, 0, 0); PG8_LDB(B1, 0, 1); PG8_SCHED; PG8_LDA(At, 0, 0); PG8_STAGE(PG8_SA(1, 1), a1 + hstep, voffA);
            PG8_WAIT_V(8); PG8_WAIT_L(0); PG8_BAR; PG8_MMA(0, 0, At, B0); PG8_MMA(0, 1, At, B1); PG8_BAR; PG8_SCHED;
            PG8_LDA(At, 0, 1); PG8_STAGE(PG8_SB(0, 0), b2, voffB); PG8_STAGE(PG8_SB(0, 1), b2 + hstep, voffB); PG8_STAGE(PG8_SA(0, 0), a2, voffA);
            PG8_WAIT_V(8); PG8_WAIT_L(0); PG8_BAR; PG8_MMA(1, 0, At, B0); PG8_MMA(1, 1, At, B1); PG8_BAR; PG8_SCHED;
            PG8_LDB(B0, 1, 0); PG8_LDB(B1, 1, 1); PG8_SCHED; PG8_LDA(At, 1, 0); PG8_STAGE(PG8_SA(0, 1), a2 + hstep, voffA);
            PG8_WAIT_V(8); PG8_WAIT_L(0); PG8_BAR; PG8_MMA(0, 0, At, B0); PG8_MMA(0, 1, At, B1); PG8_BAR; PG8_SCHED;
            PG8_LDA(At, 1, 1); PG8_STAGE(PG8_SB(1, 0), b3, voffB); PG8_STAGE(PG8_SB(1, 1), b3 + hstep, voffB); PG8_STAGE(PG8_SA(1, 0), a3, voffA);
            PG8_WAIT_V(8); PG8_WAIT_L(0); PG8_BAR; PG8_MMA(1, 0, At, B0); PG8_MMA(1, 1, At, B1); PG8_BAR; PG8_SCHED;
        }
        if (wr == 0) PG8_BAR;
        E(acc, cur, wr, wc, fr, fq, lds);
        if (!has_next) break;
#pragma unroll
        for (int a = 0; a < 2; ++a)
#pragma unroll
            for (int b = 0; b < 2; ++b)
#pragma unroll
                for (int m = 0; m < 4; ++m)
#pragma unroll
                    for (int n = 0; n < 2; ++n) acc[a][b][m][n] = (f32x4){0.f, 0.f, 0.f, 0.f};
        cur = nxt; cA = nA; cB = nB; ++ui;
        if (wr == 1) PG8_BAR;
    }
    PG8_WAIT_V(0);
    PG8_BAR;
#undef PG8_SA
#undef PG8_SB
#undef PG8_STAGE
#undef PG8_LDA
#undef PG8_LDB
#undef PG8_MMA
#undef PG8_WAIT_V
#undef PG8_WAIT_L
#undef PG8_SCHED
}
#define PG8_FOR_AM _Pragma("unroll") for (int ai = 0; ai < 2; ++ai) _Pragma("unroll") for (int m = 0; m < 4; ++m)
#define PG8_FOR_BJ _Pragma("unroll") for (int bj = 0; bj < 2; ++bj)

struct EpiInProj {
    static constexpr bool PERM = true, HAS_MID = false;
    Params p;
    __device__ __forceinline__ void operator()(f32x4 (&acc)[2][2][4][2], const Unit& u, int wr, int wc, int fr, int fq, PG8_LAS unsigned char* lds) const {
        const int pn = u.pn;
        const int sec = pn < 4 ? 0 : pn < 8 ? 1 : pn < 12 ? 2 : pn < 16 ? 3 : pn == 16 ? 4 : pn == 17 ? 5 : pn < 22 ? 6 : 7;
        const int head0 = (sec == 0 ? pn : sec == 1 ? pn - 4 : sec == 2 ? pn - 8 : sec == 3 ? pn - 12 : sec == 6 ? pn - 18 : sec == 7 ? pn - 22 : 0) * 2;
        const int cl = wc * 32 + fq * 8;
        if (sec == 3 || sec == 4) {
            PG8_LAS float* X = (PG8_LAS float*)(lds + STAGE_BYTES);
            PG8_FOR_AM { PG8_FOR_BJ { const f32x4 a = acc[ai][bj][m][0], b = acc[ai][bj][m][1];
                float ss = (a.x * a.x + a.y * a.y) + (a.z * a.z + a.w * a.w) + (b.x * b.x + b.y * b.y) + (b.z * b.z + b.w * b.w);
                ss += __shfl_xor(ss, 16); ss += __shfl_xor(ss, 32);
                if (fq == 0) X[((ai * 128 + wr * 64 + m * 16 + fr) * 2 + bj) * 4 + wc] = ss; } }
            asm volatile("s_waitcnt lgkmcnt(0)" ::: "memory"); __builtin_amdgcn_s_barrier(); asm volatile("" ::: "memory");
            const int g = wc * 4 + fq, j0 = (g & 7) * 4, e0 = (g >> 3) * 64 + j0;
            const float* gn = sec == 3 ? p.g_qnorm : p.g_knorm;
            const f32x4 g1 = *(const f32x4*)(gn + e0), g2 = *(const f32x4*)(gn + e0 + 32);
            const float sc = sec == 3 ? CB : 1.f;
            const float2* rope = (const float2*)(p.ws + OFF_ROPE);
            PG8_FOR_AM { const int rl = ai * 128 + wr * 64 + m * 16 + fr, grow = u.pm * BM + rl; const RowInfo ri = row_decode(grow);
                f32x4 c4 = (f32x4){1.f, 1.f, 1.f, 1.f}, s4 = (f32x4){0.f, 0.f, 0.f, 0.f};
                if (!ri.meta) { const int pos = (g >> 3) ? (ri.t & 63) : (ri.t >> 6); const f32x4 t0 = *(const f32x4*)(rope + pos * 32 + j0), t1 = *(const f32x4*)(rope + pos * 32 + j0 + 2);
                    c4 = (f32x4){t0.x, t0.z, t1.x, t1.z}; s4 = (f32x4){t0.y, t0.w, t1.y, t1.w}; }
                PG8_FOR_BJ { const f32x4 pq = *(const PG8_LAS f32x4*)(X + (rl * 2 + bj) * 4);
                    const float rstd = 1.0f / sqrtf(((pq.x + pq.y) + (pq.z + pq.w)) * (1.0f / 128.f) + EPS) * sc;
                    const f32x4 x1 = acc[ai][bj][m][0] * g1 * rstd, x2 = acc[ai][bj][m][1] * g2 * rstd;
                    const f32x4 y1 = x1 * c4 - x2 * s4, y2 = x2 * c4 + x1 * s4;
                    if (ri.valid) { const int head = head0 + bj;
                        bf16_t* dst = sec == 3 ? (bf16_t*)(p.ws + OFF_QB) + ((size_t)(ri.b * 8 + head) * QROWS + row_q(ri)) * 128 : (bf16_t*)(p.ws + OFF_KB) + ((size_t)(ri.b * 2 + head) * KEYS + row_key(ri)) * 128;
                        *(u32x2*)(dst + e0) = (u32x2){cvt_pk_bf16(y1.x, y1.y), cvt_pk_bf16(y1.z, y1.w)};
                        *(u32x2*)(dst + e0 + 32) = (u32x2){cvt_pk_bf16(y2.x, y2.y), cvt_pk_bf16(y2.z, y2.w)}; } } }
            return;
        }
        PG8_FOR_AM { const int grow = u.pm * BM + ai * 128 + wr * 64 + m * 16 + fr; const RowInfo ri = row_decode(grow);
            if (!ri.valid) continue;
            PG8_FOR_BJ { const int head = head0 + bj; f32x4 a = acc[ai][bj][m][0], b = acc[ai][bj][m][1]; bf16_t* dst;
                if (sec == 0) { dst = (bf16_t*)(p.ws + OFF_QA) + ((size_t)(ri.b * 8 + head) * QROWS + row_q(ri)) * 128; a = a * CA; b = b * CA; }
                else if (sec == 1) dst = (bf16_t*)(p.ws + OFF_KA) + ((size_t)(ri.b * 8 + head) * KEYS + row_key(ri)) * 128;
                else if (sec == 2) dst = (bf16_t*)(p.ws + OFF_VA) + ((size_t)(ri.b * 8 + head) * KEYS + row_key(ri)) * 128;
                else if (sec == 5) dst = (bf16_t*)(p.ws + OFF_VB) + ((size_t)(ri.b * 2 + head) * KEYS + row_key(ri)) * 128;
                else { dst = (grow < MREAL ? (bf16_t*)p.out + (size_t)grow * 2048 : (bf16_t*)(p.ws + OFF_SGM) + (size_t)(grow - MREAL) * 2048) + (sec == 7 ? 1024 : 0) + head * 128;
                    a.x = 1.0f / (1.0f + __expf(-a.x)); a.y = 1.0f / (1.0f + __expf(-a.y)); a.z = 1.0f / (1.0f + __expf(-a.z)); a.w = 1.0f / (1.0f + __expf(-a.w));
                    b.x = 1.0f / (1.0f + __expf(-b.x)); b.y = 1.0f / (1.0f + __expf(-b.y)); b.z = 1.0f / (1.0f + __expf(-b.z)); b.w = 1.0f / (1.0f + __expf(-b.w)); }
                *(u32x4*)(dst + cl) = (u32x4){cvt_pk_bf16(a.x, a.y), cvt_pk_bf16(a.z, a.w), cvt_pk_bf16(b.x, b.y), cvt_pk_bf16(b.z, b.w)}; } }
    }
};
__device__ __forceinline__ f32x4 bf4(u32x2 w) { return (f32x4){bf2f(w.x & 0xffffu), bf2f(w.x >> 16), bf2f(w.y & 0xffffu), bf2f(w.y >> 16)}; }
struct EpiMerge {
    static constexpr bool PERM = true, HAS_MID = true;
    Params p;
    __device__ __forceinline__ const bf16_t* sg(int grow) const { return grow < MREAL ? (const bf16_t*)p.out + (size_t)grow * 2048 : (const bf16_t*)(p.ws + OFF_SGM) + (size_t)(grow - MREAL) * 2048; }
    __device__ __forceinline__ void mid(f32x4 (&acc)[2][2][4][2], const Unit& u, int wr, int wc, int fr, int fq) const {
        PG8_FOR_AM { const int grow = u.pm * BM + ai * 128 + wr * 64 + m * 16 + fr; if (grow >= MROWS) continue; const bf16_t* s = sg(grow) + u.pn * BM + wc * 32 + fq * 8;
            PG8_FOR_BJ { const u32x4 wa = *(const u32x4*)(s + bj * 128), wb = *(const u32x4*)(s + 1024 + bj * 128);
                const f32x4 b0 = bf4((u32x2){wb.x, wb.y}), b1 = bf4((u32x2){wb.z, wb.w});
                const f32x4 r0 = (f32x4){__builtin_amdgcn_rcpf(b0.x), __builtin_amdgcn_rcpf(b0.y), __builtin_amdgcn_rcpf(b0.z), __builtin_amdgcn_rcpf(b0.w)};
                const f32x4 r1 = (f32x4){__builtin_amdgcn_rcpf(b1.x), __builtin_amdgcn_rcpf(b1.y), __builtin_amdgcn_rcpf(b1.z), __builtin_amdgcn_rcpf(b1.w)};
                acc[ai][bj][m][0] = acc[ai][bj][m][0] * bf4((u32x2){wa.x, wa.y}) * r0;
                acc[ai][bj][m][1] = acc[ai][bj][m][1] * bf4((u32x2){wa.z, wa.w}) * r1; } }
    }
    __device__ __forceinline__ void operator()(f32x4 (&acc)[2][2][4][2], const Unit& u, int wr, int wc, int fr, int fq, PG8_LAS unsigned char*) const {
        bf16_t* MG = (bf16_t*)(p.ws + OFF_MERGED);
        PG8_FOR_AM { const int grow = u.pm * BM + ai * 128 + wr * 64 + m * 16 + fr; if (grow >= MROWS) continue; const int col = u.pn * BM + wc * 32 + fq * 8; const bf16_t* s = sg(grow) + 1024 + col;
            PG8_FOR_BJ { const u32x4 wb = *(const u32x4*)(s + bj * 128);
                const f32x4 a = acc[ai][bj][m][0] * bf4((u32x2){wb.x, wb.y}), b = acc[ai][bj][m][1] * bf4((u32x2){wb.z, wb.w});
                *(u32x4*)(MG + (size_t)grow * DM + col + bj * 128) = (u32x4){cvt_pk_bf16(a.x, a.y), cvt_pk_bf16(a.z, a.w), cvt_pk_bf16(b.x, b.y), cvt_pk_bf16(b.z, b.w)}; } }
    }
};
struct EpiOut {
    static constexpr bool PERM = false, HAS_MID = false;
    Params p;
    __device__ __forceinline__ void operator()(f32x4 (&acc)[2][2][4][2], const Unit& u, int wr, int wc, int fr, int fq, PG8_LAS unsigned char*) const {
        PG8_FOR_AM { const int grow = u.pm * BM + ai * 128 + wr * 64 + m * 16 + fr; if (grow >= MROWS) continue; const int col = u.pn * BM + wc * 32 + fq * 4;
            const float* hr = h_row(p, grow) + col; float* o = h2_row(p, grow) + col;
            PG8_FOR_BJ {
#pragma unroll
                for (int n = 0; n < 2; ++n) *(f32x4*)(o + bj * 128 + n * 16) = *(const f32x4*)(hr + bj * 128 + n * 16) + acc[ai][bj][m][n]; } }
    }
};
struct EpiMoeUp {
    static constexpr bool PERM = true, HAS_MID = false;
    Params p;
    __device__ __forceinline__ void operator()(f32x4 (&acc)[2][2][4][2], const Unit& u, int wr, int wc, int fr, int fq, PG8_LAS unsigned char*) const {
        bf16_t* HID = (bf16_t*)(p.ws + OFF_HID);
        PG8_FOR_AM { const int s = u.pm * BM + ai * 128 + wr * 64 + m * 16 + fr; if (s >= ESLOTS) continue;
            PG8_FOR_BJ { const f32x4 gt = acc[ai][bj][m][0], up = acc[ai][bj][m][1]; const int f0 = (u.pn * BM + bj * 128 + wc * 32 + fq * 8) >> 1;
                const float h0 = gt.x / (1.0f + __expf(-gt.x)) * up.x, h1 = gt.y / (1.0f + __expf(-gt.y)) * up.y, h2 = gt.z / (1.0f + __expf(-gt.z)) * up.z, h3 = gt.w / (1.0f + __expf(-gt.w)) * up.w;
                *(u32x2*)(HID + ((size_t)u.e * ESLOTS + s) * EFF + f0) = (u32x2){cvt_pk_bf16(h0, h1), cvt_pk_bf16(h2, h3)}; } }
    }
};
struct EpiMoeDown {
    static constexpr bool PERM = true, HAS_MID = false;
    Params p;
    __device__ __forceinline__ void operator()(f32x4 (&acc)[2][2][4][2], const Unit& u, int wr, int wc, int fr, int fq, PG8_LAS unsigned char*) const {
        bf16_t* YB = (bf16_t*)(p.ws + OFF_YB); const float* SAFF = (const float*)(p.ws + OFF_SAFF);
        PG8_FOR_AM { const int s = u.pm * BM + ai * 128 + wr * 64 + m * 16 + fr; if (s >= ESLOTS) continue; const float af = SAFF[u.e * ESLOTS + s]; const int col = u.pn * BM + wc * 32 + fq * 8;
            PG8_FOR_BJ { const f32x4 a = acc[ai][bj][m][0] * af, b = acc[ai][bj][m][1] * af;
                *(u32x4*)(YB + ((size_t)u.e * ESLOTS + s) * DM + col + bj * 128) = (u32x4){cvt_pk_bf16(a.x, a.y), cvt_pk_bf16(a.z, a.w), cvt_pk_bf16(b.x, b.y), cvt_pk_bf16(b.z, b.w)}; } }
    }
};
#undef PG8_BAR
}

__device__ __forceinline__ void phase1_fast(const Params& p, unsigned char* lds_raw, int vb, int nvb) {
    pg8::Gemm g{(const bf16_t*)(p.ws + OFF_UN), (const bf16_t*)(p.ws + OFF_WIN), DM};
    pg8::GridOrder S; S.init(MPAD / 256, INW / 256, nvb, vb);
    pg8::EpiInProj E{p};
    pg8::gemm_phase(( __attribute__((address_space(3))) unsigned char*)lds_raw, g, S, E);
}
__device__ __forceinline__ void phase3a_fast(const Params& p, unsigned char* lds_raw, int vb, int nvb) {
    pg8::Gemm g{(const bf16_t*)(p.ws + OFF_AO), (const bf16_t*)(p.ws + OFF_WAB), 2048};
    pg8::GridOrder S; S.init(MPAD / 256, DM / 256, nvb, vb);
    pg8::EpiMerge E{p};
    pg8::gemm_phase(( __attribute__((address_space(3))) unsigned char*)lds_raw, g, S, E);
}
__device__ __forceinline__ void phase3b_fast(const Params& p, unsigned char* lds_raw, int vb, int nvb) {
    pg8::Gemm g{(const bf16_t*)(p.ws + OFF_MERGED), (const bf16_t*)(p.ws + OFF_WO), DM};
    pg8::GridOrder S; S.init(MPAD / 256, DM / 256, nvb, vb);
    pg8::EpiOut E{p};
    pg8::gemm_phase(( __attribute__((address_space(3))) unsigned char*)lds_raw, g, S, E);
}
__device__ __forceinline__ void phase5a_fast(const Params& p, unsigned char* lds_raw, int vb, int nvb) {
    pg8::Gemm g{(const bf16_t*)(p.ws + OFF_XS), (const bf16_t*)(p.ws + OFF_WGU), DM};
    pg8::MoeOrder S{nvb, vb};
    pg8::EpiMoeUp E{p};
    pg8::gemm_phase(( __attribute__((address_space(3))) unsigned char*)lds_raw, g, S, E);
}
__device__ __forceinline__ void phase5b_fast(const Params& p, unsigned char* lds_raw, int vb, int nvb) {
    pg8::Gemm g{(const bf16_t*)(p.ws + OFF_HID), (const bf16_t*)(p.ws + OFF_WD), EFF};
    pg8::MoeOrder S{nvb, vb};
    pg8::EpiMoeDown E{p};
    pg8::gemm_phase(( __attribute__((address_space(3))) unsigned char*)lds_raw, g, S, E);
}

__device__ void phase4b_fast(const Params& p, float* lds, int vb, int nvb) {
    const int tid = TID(), lane = tid & 63, wave = tid >> 6;
    constexpr int NBE = NB * NEXP;
    if (vb >= NBE) { transpose_moe(p, lds, vb - NBE, nvb - NBE); return; }
    if (nvb <= NBE) transpose_moe(p, lds, vb, nvb);
    const float* AFF = (const float*)(p.ws + OFF_AFF); int* IDX = (int*)(p.ws + OFF_IDX); int* SEL = (int*)(p.ws + OFF_SEL);
    unsigned* keys = (unsigned*)lds;
    unsigned* hist = keys + 8448;
    unsigned* sh = hist + 256;
    for (int be = vb; be < NBE; be += nvb) {
        const int b = be / NEXP, e = be % NEXP;
        __syncthreads();
        for (int i = tid; i < LTOT; i += NTHREADS) keys[i] = __float_as_uint(AFF[(size_t)be * LTOT + i]);
        if (tid == 0) { sh[0] = 0u; sh[1] = CAP; }
        __syncthreads();
        for (int pass = 0; pass < 4; ++pass) {
            const int shift = 24 - 8 * pass;
            if (tid < 256) hist[tid] = 0u;
            __syncthreads();
            const unsigned prefix = sh[0], pmask = pass == 0 ? 0u : (0xffffffffu << (shift + 8));
            for (int i = tid; i < LTOT; i += NTHREADS) { const unsigned k = keys[i]; if ((k & pmask) == prefix) atomicAdd(&hist[(k >> shift) & 255u], 1u); }
            __syncthreads();
            if (tid == 0) { unsigned rem = sh[1], d = 255u;
                for (;; --d) { const unsigned c = hist[d]; if (c >= rem || d == 0u) break; rem -= c; }
                sh[0] = prefix | (d << shift); sh[1] = rem; }
            __syncthreads();
        }
        const unsigned T = sh[0], need_eq = sh[1];
        const int t0 = tid * 17; int cnt_gt = 0, cnt_eq = 0;
        for (int i = 0; i < 17; ++i) { const int tok = t0 + i; if (tok < LTOT) { const unsigned k = keys[tok]; cnt_gt += k > T; cnt_eq += k == T; } }
        int incl = cnt_eq;
#pragma unroll
        for (int o = 1; o < 64; o <<= 1) { const int v = __shfl_up(incl, o); if (lane >= o) incl += v; }
        if (lane == 63) sh[8 + wave] = (unsigned)incl;
        __syncthreads();
        int eq_before = incl - cnt_eq; for (int w = 0; w < wave; ++w) eq_before += (int)sh[8 + w];
        __syncthreads();
        int take_eq = (int)need_eq - eq_before; take_eq = take_eq < 0 ? 0 : (take_eq > cnt_eq ? cnt_eq : take_eq);
        const int mysel = cnt_gt + take_eq;
        incl = mysel;
#pragma unroll
        for (int o = 1; o < 64; o <<= 1) { const int v = __shfl_up(incl, o); if (lane >= o) incl += v; }
        if (lane == 63) sh[8 + wave] = (unsigned)incl;
        __syncthreads();
        int slot = incl - mysel; for (int w = 0; w < wave; ++w) slot += (int)sh[8 + w];
        int eqi = eq_before;
        for (int i = 0; i < 17; ++i) { const int tok = t0 + i; if (tok < LTOT) { const unsigned k = keys[tok];
            bool take = k > T; if (k == T) { take = eqi < (int)need_eq; ++eqi; }
            if (take) { IDX[(size_t)be * CAP + slot] = tok; SEL[((size_t)b * LTOT + tok) * NEXP + e] = slot; ++slot; } else SEL[((size_t)b * LTOT + tok) * NEXP + e] = -1; } }
    }
    __syncthreads();
}
__device__ void phase4c(const Params& p, int vb, int nvb) {
    const int tid = TID(), lane = tid & 63, wave = tid >> 6;
    const bf16_t* U2 = (const bf16_t*)(p.ws + OFF_UN); bf16_t* XS = (bf16_t*)(p.ws + OFF_XS); const int* IDX = (const int*)(p.ws + OFF_IDX);
    const float* AFF = (const float*)(p.ws + OFF_AFF); float* SAFF = (float*)(p.ws + OFF_SAFF);
    for (int r = vb * 8 + wave; r < NEXP * ESLOTS; r += nvb * 8) {
        const int e = r / ESLOTS, s = r % ESLOTS, b = s / CAP, c = s % CAP;
        const int tok = IDX[((size_t)b * NEXP + e) * CAP + c];
        const u32x4* src = (const u32x4*)(U2 + (size_t)pos_row(b, tok) * DM) + lane; u32x4* dst = (u32x4*)(XS + (size_t)r * DM) + lane;
        const u32x4 v0 = src[0], v1 = src[64]; dst[0] = v0; dst[64] = v1;
        if (lane == 0) SAFF[r] = AFF[((size_t)b * NEXP + e) * LTOT + tok];
    }
}

constexpr int LDS_BYTES = 147456;
#if defined(__HIP_DEVICE_COMPILE__)
#define PHASE_PARAMS() ({ const __attribute__((address_space(4))) Params* q_ = (const __attribute__((address_space(4))) Params*)__builtin_amdgcn_kernarg_segment_ptr(); asm volatile("" : "+s"(q_)); *q_; })
#else
#define PHASE_PARAMS() (pk)
#endif
__global__ void __launch_bounds__(NTHREADS, 2) fwd_kernel(Params pk) {
    extern __shared__ __attribute__((aligned(16))) unsigned char lds_raw[];
    float* lds = (float*)lds_raw;
    cg::grid_group grid = cg::this_grid();
    const int vb = blockIdx.x, nvb = gridDim.x;
    { const Params p = PHASE_PARAMS(); phase0(p, vb, nvb); }
#if FAST_P1 || FAST_P3
    { const Params p = PHASE_PARAMS(); transpose_p0(p, lds, vb, nvb); }
#endif
    grid.sync();
#if FAST_P1
    { const Params p = PHASE_PARAMS(); phase1_fast(p, lds_raw, vb, nvb); }
#else
    { const Params p = PHASE_PARAMS(); phase1_ref(p, lds, vb, nvb); }
#endif
    grid.sync();
#if FAST_ATTN
    { const Params p = PHASE_PARAMS(); phase2_fast(p, (char*)lds_raw, vb, nvb); }
#else
    { const Params p = PHASE_PARAMS(); phase2_ref(p, lds, vb, nvb); }
#endif
    grid.sync();
#if FAST_P3
    { const Params p = PHASE_PARAMS(); phase3a_fast(p, lds_raw, vb, nvb); }
#else
    { const Params p = PHASE_PARAMS(); phase3a_ref(p, lds, vb, nvb, 0); }
    { const Params p = PHASE_PARAMS(); phase3a_ref(p, lds, vb, nvb, 1); }
#endif
    grid.sync();
#if FAST_P3
    { const Params p = PHASE_PARAMS(); phase3b_fast(p, lds_raw, vb, nvb); }
#else
    { const Params p = PHASE_PARAMS(); phase3b_ref(p, lds, vb, nvb); }
#endif
    grid.sync();
    { const Params p = PHASE_PARAMS(); phase4a(p, lds, vb, nvb); }
    grid.sync();
#if FAST_MOE
    { const Params p = PHASE_PARAMS(); phase4b_fast(p, lds, vb, nvb); }
    grid.sync();
    { const Params p = PHASE_PARAMS(); phase4c(p, vb, nvb); }
    grid.sync();
    { const Params p = PHASE_PARAMS(); phase5a_fast(p, lds_raw, vb, nvb); }
    grid.sync();
    { const Params p = PHASE_PARAMS(); phase5b_fast(p, lds_raw, vb, nvb); }
#else
    { const Params p = PHASE_PARAMS(); phase4b_ref(p, lds, vb, nvb); }
    grid.sync();
    { const Params p = PHASE_PARAMS(); phase5a_ref(p, lds, vb, nvb); }
    grid.sync();
    { const Params p = PHASE_PARAMS(); phase5b_ref(p, lds, vb, nvb); }
#endif
    grid.sync();
    { const Params p = PHASE_PARAMS(); phase6(p, vb, nvb); }
}

extern "C" void kernel_launch(void* const* d_in, const int* in_sizes, int n_in, void* d_out, int out_size, void* d_ws, size_t ws_size, hipStream_t stream) {
    static int grid_blocks = 0;
    if (grid_blocks == 0) {
        if (n_in != 20 || in_sizes[0] != MREAL * DM || out_size != MREAL * DM || ws_size < 256 * MiB) {
            fprintf(stderr, "kernel_launch: unexpected shapes: n_in %d in0 %d out %d ws %zu\n", n_in, n_in > 0 ? in_sizes[0] : -1, out_size, ws_size); grid_blocks = -1; return; }
        int dev = 0, cus = 0, per_cu = 0;
        (void)hipGetDevice(&dev); (void)hipDeviceGetAttribute(&cus, hipDeviceAttributeMultiprocessorCount, dev);
        if (hipFuncSetAttribute((const void*)fwd_kernel, hipFuncAttributeMaxDynamicSharedMemorySize, LDS_BYTES) != hipSuccess) { fprintf(stderr, "kernel_launch: hipFuncSetAttribute failed\n"); grid_blocks = -1; return; }
        if (hipOccupancyMaxActiveBlocksPerMultiprocessor(&per_cu, (const void*)fwd_kernel, NTHREADS, LDS_BYTES) != hipSuccess || per_cu < 1) { fprintf(stderr, "kernel_launch: occupancy query failed (%d)\n", per_cu); grid_blocks = -1; return; }
        grid_blocks = cus * per_cu;
    }
    if (grid_blocks < 0) return;
    Params p{};
    p.x = (const float*)d_in[0]; p.meta = (const float*)d_in[1]; p.g_mix = (const float*)d_in[2]; p.w_in = (const float*)d_in[3];
    p.lq1 = (const float*)d_in[4]; p.lk1 = (const float*)d_in[5]; p.lq2 = (const float*)d_in[6]; p.lk2 = (const float*)d_in[7];
    p.g_subln = (const float*)d_in[8]; p.g_qnorm = (const float*)d_in[9]; p.g_knorm = (const float*)d_in[10];
    p.w_ba = (const float*)d_in[11]; p.w_bb = (const float*)d_in[12]; p.w_out = (const float*)d_in[13]; p.g_ffn = (const float*)d_in[14];
    p.w_router = (const float*)d_in[15]; p.w_gate = (const float*)d_in[16]; p.w_up = (const float*)d_in[17]; p.w_down = (const float*)d_in[18]; p.g_final = (const float*)d_in[19];
    p.out = (float*)d_out; p.ws = (unsigned char*)d_ws;
    void* args[] = {&p};
    hipError_t e = hipLaunchCooperativeKernel((const void*)fwd_kernel, dim3(grid_blocks), dim3(NTHREADS), args, LDS_BYTES, stream);
    if (e != hipSuccess) fprintf(stderr, "kernel_launch: cooperative launch failed: %s (grid %d)\n", hipGetErrorString(e), grid_blocks);
}
```

```cpp
#include <hip/hip_runtime.h>
#include <hip/hip_cooperative_groups.h>
#include <cstdio>
#include <cstdint>
namespace cg = cooperative_groups;

typedef unsigned short bf16_t;
typedef float f32x4 __attribute__((ext_vector_type(4)));
typedef unsigned u32x2 __attribute__((ext_vector_type(2)));
typedef unsigned u32x4 __attribute__((ext_vector_type(4)));

constexpr int NB = 2, SEQ = 8192, DM = 1024, NMETA = 16, LTOT = SEQ + NMETA;
constexpr int MREAL = NB * SEQ;
constexpr int MROWS = MREAL + NB * NMETA;
constexpr int MPAD = 16640;
constexpr int INW = 6656;
constexpr int KEYS = 8256;
constexpr int QROWS = 8256;
constexpr int NEXP = 16, EFF = 512, CAP = 1026, ESLOTS = NB * CAP;
constexpr float EPS = 1e-6f;
constexpr float LOG2E = 1.4426950408889634f;
constexpr float CA = 0.125f * LOG2E;
constexpr float CB = 0.08838834764831845f * LOG2E;
constexpr float LAM_INIT = 0.2f;
constexpr int NTHREADS = 512;
constexpr int AOP = 2048;
#ifndef FAST_ATTN
#define FAST_ATTN 1
#endif
#ifndef FAST_P1
#define FAST_P1 1
#endif
#ifndef FAST_P3
#define FAST_P3 1
#endif
#ifndef FAST_MOE
#define FAST_MOE 1
#endif
__device__ const float INVF[32] = {1.000000000e+00f, 7.498942614e-01f, 5.623413324e-01f, 4.216965139e-01f, 3.162277639e-01f, 2.371373773e-01f, 1.778279394e-01f, 1.333521307e-01f,
    1.000000015e-01f, 7.498941571e-02f, 5.623413250e-02f, 4.216965288e-02f, 3.162277490e-02f, 2.371373773e-02f, 1.778279431e-02f, 1.333521493e-02f,
    9.999999776e-03f, 7.498941850e-03f, 5.623413250e-03f, 4.216964822e-03f, 3.162277630e-03f, 2.371373586e-03f, 1.778279431e-03f, 1.333521446e-03f,
    1.000000047e-03f, 7.498942432e-04f, 5.623413017e-04f, 4.216965172e-04f, 3.162277571e-04f, 2.371373703e-04f, 1.778279402e-04f, 1.333521504e-04f};

constexpr size_t MiB = 1u << 20;
constexpr size_t OFF_ROPE = 0;
constexpr size_t OFF_LAM = 64 * 1024;
constexpr size_t OFF_AFF = 128 * 1024;
constexpr size_t OFF_IDX = OFF_AFF + (size_t)NB * NEXP * LTOT * 4 + 256;
constexpr size_t OFF_SEL = OFF_IDX + (size_t)NB * NEXP * CAP * 4 + 256;
constexpr size_t OFF_SGM = OFF_SEL + (size_t)NB * LTOT * NEXP * 4 + 256;
constexpr size_t OFF_H2M = OFF_SGM + 32 * 2048 * 2;
constexpr size_t OFF_SAFF = OFF_H2M + 32 * 1024 * 4;
constexpr size_t OFF_MISC_END = OFF_SAFF + (size_t)NEXP * ESLOTS * 4;
static_assert(OFF_MISC_END <= 4 * MiB, "misc region");
constexpr size_t OFF_WIN = 4 * MiB;
constexpr size_t OFF_WAB = OFF_WIN + (size_t)INW * DM * 2;
constexpr size_t OFF_WO = OFF_WAB + (size_t)DM * 2048 * 2;
static_assert(OFF_WO + (size_t)DM * DM * 2 <= 24 * MiB, "weights region");
constexpr size_t OFF_AO = 24 * MiB;
constexpr size_t SZ_ROWS = (size_t)MPAD * DM * 2;
constexpr size_t OFF_UN = OFF_AO;
constexpr size_t OFF_HID = OFF_AO + SZ_ROWS;
static_assert((size_t)(NEXP * ESLOTS + 256) * EFF * 2 <= SZ_ROWS, "HID overlay");
constexpr size_t OFF_ATT = OFF_AO + 2 * SZ_ROWS;
constexpr size_t SZ_QH = (size_t)NB * 8 * QROWS * 128 * 2;
constexpr size_t SZ_KVB = (size_t)NB * 2 * KEYS * 128 * 2;
constexpr size_t OFF_QA = OFF_ATT, OFF_KA = OFF_QA + SZ_QH, OFF_VA = OFF_KA + SZ_QH, OFF_QB = OFF_VA + SZ_QH, OFF_KB = OFF_QB + SZ_QH, OFF_VB = OFF_KB + SZ_KVB;
constexpr size_t OFF_ATT_END = OFF_VB + SZ_KVB;
static_assert(OFF_ATT_END <= 256 * MiB, "workspace");
constexpr size_t OFF_MERGED = OFF_ATT;
constexpr size_t OFF_WGU = OFF_ATT + 33 * MiB;
constexpr size_t OFF_WD = OFF_WGU + 32 * MiB;
constexpr size_t OFF_XS = OFF_WD + 16 * MiB;
constexpr size_t OFF_YB = OFF_XS;
static_assert(SZ_ROWS <= 33 * MiB && OFF_XS + (size_t)(NEXP * ESLOTS + 256) * DM * 2 <= 256 * MiB, "overlay map");

struct Params {
    const float *x, *meta, *g_mix, *w_in, *lq1, *lk1, *lq2, *lk2, *g_subln, *g_qnorm, *g_knorm, *w_ba, *w_bb, *w_out, *g_ffn, *w_router, *w_gate, *w_up, *w_down, *g_final;
    float* out; unsigned char* ws;
};

__device__ __forceinline__ int TID() { int t = threadIdx.x; asm volatile("" : "+v"(t)); return t; }
__device__ __forceinline__ unsigned f2bf(float f) { unsigned u = __builtin_bit_cast(unsigned, f); return (u + 0x7fffu + ((u >> 16) & 1u)) >> 16; }
__device__ __forceinline__ float bf2f(unsigned h) { return __builtin_bit_cast(float, h << 16); }
__device__ __forceinline__ float wave_sum(float v) {
#pragma unroll
    for (int o = 1; o < 64; o <<= 1) v += __shfl_xor(v, o);
    return v;
}
__device__ __forceinline__ float wave_max(float v) {
#pragma unroll
    for (int o = 1; o < 64; o <<= 1) v = fmaxf(v, __shfl_xor(v, o));
    return v;
}
struct RowInfo { int b, t, meta, valid; };
__device__ __forceinline__ RowInfo row_decode(int r) {
    RowInfo ri;
    if (r < MREAL) { ri.b = r >> 13; ri.t = r & (SEQ - 1); ri.meta = 0; ri.valid = 1; }
    else if (r < MROWS) { ri.b = (r - MREAL) >> 4; ri.t = (r - MREAL) & 15; ri.meta = 1; ri.valid = 1; }
    else { ri.b = 0; ri.t = 0; ri.meta = 1; ri.valid = 0; }
    return ri;
}
__device__ __forceinline__ int row_key(const RowInfo& ri) { return ri.meta ? ri.t : 64 + ri.t; }
__device__ __forceinline__ int row_q(const RowInfo& ri) { return ri.meta ? SEQ + ri.t : ri.t; }
__device__ __forceinline__ int row_pos(const RowInfo& ri) { return ri.meta ? ri.t : NMETA + ri.t; }
__device__ __forceinline__ int pos_row(int b, int pos) { return pos < NMETA ? MREAL + b * NMETA + pos : b * SEQ + (pos - NMETA); }
__device__ __forceinline__ const float* h_row(const Params& p, int r) { RowInfo ri = row_decode(r); return ri.meta ? p.meta + (size_t)ri.t * DM : p.x + (size_t)r * DM; }

__device__ void phase0(const Params& p, int vb, int nvb) {
    const int tid = TID(), lane = tid & 63, wave = tid >> 6;
    const int gt = vb * NTHREADS + tid;
    if (gt < 128 * 32) {
        const int pos = gt >> 5, j = gt & 31;
        const float ang = (float)pos * INVF[j];
        const double xd = (double)ang, kq = __builtin_rint(xd * 0.15915494309189535);
        const double rr = (xd - kq * 6.283185307179586) * 0.25, r2 = rr * rr;
        double sn = 1.0 / 1307674368000.0, cn = 1.0 / 87178291200.0;
        sn = sn * r2 * -1.0 + 1.0 / 6227020800.0; cn = cn * r2 * -1.0 + 1.0 / 479001600.0;
        sn = sn * r2 * -1.0 + 1.0 / 39916800.0;   cn = cn * r2 * -1.0 + 1.0 / 3628800.0;
        sn = sn * r2 * -1.0 + 1.0 / 362880.0;     cn = cn * r2 * -1.0 + 1.0 / 40320.0;
        sn = sn * r2 * -1.0 + 1.0 / 5040.0;       cn = cn * r2 * -1.0 + 1.0 / 720.0;
        sn = sn * r2 * -1.0 + 1.0 / 120.0;        cn = cn * r2 * -1.0 + 1.0 / 24.0;
        sn = sn * r2 * -1.0 + 1.0 / 6.0;          cn = cn * r2 * -1.0 + 0.5;
        sn = (sn * r2 * -1.0 + 1.0) * rr;         cn = cn * r2 * -1.0 + 1.0;
        double s2 = 2.0 * sn * cn, c2 = cn * cn - sn * sn;
        double s4 = 2.0 * s2 * c2, c4 = c2 * c2 - s2 * s2;
        float2 cs; cs.x = (float)c4; cs.y = (float)s4;
        ((float2*)(p.ws + OFF_ROPE))[gt] = cs;
    }
    if (vb == 0 && wave == 0) {
        float a = p.lq1[lane] * p.lk1[lane], c = p.lq2[lane] * p.lk2[lane];
        a = wave_sum(a); c = wave_sum(c);
        if (lane == 0) *(float*)(p.ws + OFF_LAM) = expf(a) - expf(c) + LAM_INIT;
    }
    bf16_t* UN = (bf16_t*)(p.ws + OFF_UN);
    for (int r = vb * 8 + wave; r < MPAD; r += nvb * 8) {
        u32x2* o = (u32x2*)(UN + (size_t)r * DM) + lane;
        if (r >= MROWS) {
#pragma unroll
            for (int j = 0; j < 4; ++j) o[64 * j] = (u32x2){0u, 0u};
            continue;
        }
        const f32x4* xr = (const f32x4*)h_row(p, r) + lane;
        f32x4 v[4]; float s = 0.f;
#pragma unroll
        for (int j = 0; j < 4; ++j) { v[j] = xr[64 * j]; s += (v[j].x * v[j].x + v[j].y * v[j].y) + (v[j].z * v[j].z + v[j].w * v[j].w); }
        const float rstd = 1.0f / sqrtf(wave_sum(s) * (1.0f / DM) + EPS);
#pragma unroll
        for (int j = 0; j < 4; ++j) {
            const f32x4 g = ((const f32x4*)p.g_mix)[lane + 64 * j];
            u32x2 w; w.x = f2bf(v[j].x * rstd * g.x) | (f2bf(v[j].y * rstd * g.y) << 16); w.y = f2bf(v[j].z * rstd * g.z) | (f2bf(v[j].w * rstd * g.w) << 16);
            o[64 * j] = w;
        }
    }
    {
        bf16_t* KA = (bf16_t*)(p.ws + OFF_KA); bf16_t* VA = (bf16_t*)(p.ws + OFF_VA); bf16_t* KB = (bf16_t*)(p.ws + OFF_KB); bf16_t* VB = (bf16_t*)(p.ws + OFF_VB);
        const int per = 48 * 128 / 8;
        for (int i = vb * NTHREADS + tid; i < (16 + 16 + 4 + 4) * per; i += nvb * NTHREADS) {
            const int bh = i / per, o = i % per; bf16_t* base;
            if (bh < 16) base = KA + (size_t)bh * KEYS * 128; else if (bh < 32) base = VA + (size_t)(bh - 16) * KEYS * 128;
            else if (bh < 36) base = KB + (size_t)(bh - 32) * KEYS * 128; else base = VB + (size_t)(bh - 36) * KEYS * 128;
            ((u32x4*)(base + 16 * 128))[o] = (u32x4){0u, 0u, 0u, 0u};
        }
    }
}

constexpr int NG_AS = 16 * 132, NG_BS = 16 * 128, NG_CT = 128 * 129;
template <class ARow, class BVal, class Epi>
__device__ __forceinline__ void ngemm_tile(float* lds, int K, ARow arow, BVal bval, Epi epi) {
    float* As = lds; float* Bs = lds + NG_AS; float* Ct = lds + NG_AS + NG_BS;
    const int tid = TID(), ty = tid >> 4, tx = tid & 15;
    const int ar = tid >> 2, ak = (tid & 3) * 4; const bf16_t* ap = arow(ar);
    const int bk = tid >> 5, bc = (tid & 31) * 4;
    float acc[4][8];
#pragma unroll
    for (int i = 0; i < 4; ++i)
#pragma unroll
        for (int j = 0; j < 8; ++j) acc[i][j] = 0.f;
    for (int k0 = 0; k0 < K; k0 += 16) {
        u32x2 av = (u32x2){0u, 0u}; if (ap) av = *(const u32x2*)(ap + k0 + ak);
        float b0 = bval(k0 + bk, bc), b1 = bval(k0 + bk, bc + 1), b2 = bval(k0 + bk, bc + 2), b3 = bval(k0 + bk, bc + 3);
        __syncthreads();
        As[(ak + 0) * 132 + ar] = bf2f(av.x & 0xffffu); As[(ak + 1) * 132 + ar] = bf2f(av.x >> 16);
        As[(ak + 2) * 132 + ar] = bf2f(av.y & 0xffffu); As[(ak + 3) * 132 + ar] = bf2f(av.y >> 16);
        *(f32x4*)(Bs + bk * 128 + bc) = (f32x4){b0, b1, b2, b3};
        __syncthreads();
#pragma unroll
        for (int k = 0; k < 16; ++k) {
            const f32x4 a = *(const f32x4*)(As + k * 132 + ty * 4);
            const f32x4 bA = *(const f32x4*)(Bs + k * 128 + tx * 8), bB = *(const f32x4*)(Bs + k * 128 + tx * 8 + 4);
            const float av4[4] = {a.x, a.y, a.z, a.w}; const float bv8[8] = {bA.x, bA.y, bA.z, bA.w, bB.x, bB.y, bB.z, bB.w};
#pragma unroll
            for (int i = 0; i < 4; ++i)
#pragma unroll
                for (int j = 0; j < 8; ++j) acc[i][j] = fmaf(av4[i], bv8[j], acc[i][j]);
        }
    }
    __syncthreads();
#pragma unroll
    for (int i = 0; i < 4; ++i)
#pragma unroll
        for (int j = 0; j < 8; ++j) Ct[(ty * 4 + i) * 129 + tx * 8 + j] = acc[i][j];
    __syncthreads();
    epi(Ct);
    __syncthreads();
}

__device__ void inproj_epi(const Params& p, const float* Ct, int row0, int col0) {
    const int tid = TID(), r = tid >> 2, q = tid & 3;
    const int grow = row0 + r; const RowInfo ri = row_decode(grow);
    const float* c = Ct + r * 129;
    float v[4][8];
#pragma unroll
    for (int g = 0; g < 4; ++g)
#pragma unroll
        for (int i = 0; i < 8; ++i) v[g][i] = c[g * 32 + 8 * q + i];
    const int sec = col0 < 1024 ? 0 : col0 < 2048 ? 1 : col0 < 3072 ? 2 : col0 < 4096 ? 3 : col0 < 4352 ? 4 : col0 < 4608 ? 5 : col0 < 5632 ? 6 : 7;
    const int secbase = sec == 0 ? 0 : sec == 1 ? 1024 : sec == 2 ? 2048 : sec == 3 ? 3072 : sec == 4 ? 4096 : sec == 5 ? 4352 : sec == 6 ? 4608 : 5632;
    const int head = (col0 - secbase) >> 7;
    if (sec == 3 || sec == 4) {
        float ss = 0.f;
#pragma unroll
        for (int g = 0; g < 4; ++g)
#pragma unroll
            for (int i = 0; i < 8; ++i) ss += v[g][i] * v[g][i];
        ss += __shfl_xor(ss, 1); ss += __shfl_xor(ss, 2);
        const float rstd = 1.0f / sqrtf(ss * (1.0f / 128.f) + EPS);
        const float* gn = sec == 3 ? p.g_qnorm : p.g_knorm;
#pragma unroll
        for (int g = 0; g < 4; ++g)
#pragma unroll
            for (int i = 0; i < 8; ++i) v[g][i] = v[g][i] * rstd * gn[g * 32 + 8 * q + i];
        if (!ri.meta) {
            const float2* rope = (const float2*)(p.ws + OFF_ROPE);
            const int prow = ri.t >> 6, pcol = ri.t & 63;
#pragma unroll
            for (int i = 0; i < 8; ++i) {
                const float2 cr = rope[prow * 32 + 8 * q + i], cc = rope[pcol * 32 + 8 * q + i];
                const float x1 = v[0][i], x2 = v[1][i]; v[0][i] = x1 * cr.x - x2 * cr.y; v[1][i] = x2 * cr.x + x1 * cr.y;
                const float y1 = v[2][i], y2 = v[3][i]; v[2][i] = y1 * cc.x - y2 * cc.y; v[3][i] = y2 * cc.x + y1 * cc.y;
            }
        }
    }
    if (!ri.valid) return;
    bf16_t* dst; float sc = 1.f; bool sig = false;
    if (sec == 0) { dst = (bf16_t*)(p.ws + OFF_QA) + ((size_t)(ri.b * 8 + head) * QROWS + row_q(ri)) * 128; sc = CA; }
    else if (sec == 1) dst = (bf16_t*)(p.ws + OFF_KA) + ((size_t)(ri.b * 8 + head) * KEYS + row_key(ri)) * 128;
    else if (sec == 2) dst = (bf16_t*)(p.ws + OFF_VA) + ((size_t)(ri.b * 8 + head) * KEYS + row_key(ri)) * 128;
    else if (sec == 3) { dst = (bf16_t*)(p.ws + OFF_QB) + ((size_t)(ri.b * 8 + head) * QROWS + row_q(ri)) * 128; sc = CB; }
    else if (sec == 4) dst = (bf16_t*)(p.ws + OFF_KB) + ((size_t)(ri.b * 2 + head) * KEYS + row_key(ri)) * 128;
    else if (sec == 5) dst = (bf16_t*)(p.ws + OFF_VB) + ((size_t)(ri.b * 2 + head) * KEYS + row_key(ri)) * 128;
    else { sig = true; const int cbase = (sec == 7 ? 1024 : 0) + head * 128;
           dst = (grow < MREAL ? (bf16_t*)p.out + (size_t)grow * 2048 : (bf16_t*)(p.ws + OFF_SGM) + (size_t)(grow - MREAL) * 2048) + cbase; }
#pragma unroll
    for (int g = 0; g < 4; ++g)
#pragma unroll
        for (int i = 0; i < 8; ++i) { float y = v[g][i] * sc; if (sig) y = 1.0f / (1.0f + __expf(-y)); dst[g * 32 + 8 * q + i] = (bf16_t)f2bf(y); }
}
__device__ void phase1_ref(const Params& p, float* lds, int vb, int nvb) {
    const bf16_t* UN = (const bf16_t*)(p.ws + OFF_UN);
    constexpr int NTM = MPAD / 128, NTN = INW / 128;
    for (int t = vb; t < NTM * NTN; t += nvb) {
        const int tm = t / NTN, tn = t % NTN, row0 = tm * 128, col0 = tn * 128;
        if (row0 >= MROWS) continue;
        ngemm_tile(lds, DM,
            [&](int r) { return UN + (size_t)(row0 + r) * DM; },
            [&](int k, int c) { return p.w_in[(size_t)k * INW + col0 + c]; },
            [&](const float* Ct) { inproj_epi(p, Ct, row0, col0); });
    }
}

__device__ float attn_row_ref(const bf16_t* qrow, int dq, const bf16_t* Kh, int kcol0, const bf16_t* Vh, float slopeC, int tq  ,
                              float* sc, float* qf, int lane, float& o0, float& o1) {
    if (lane < dq / 2) { const unsigned w = ((const unsigned*)qrow)[lane]; qf[2 * lane] = bf2f(w & 0xffffu); qf[2 * lane + 1] = bf2f(w >> 16); }
    __builtin_amdgcn_s_waitcnt(0);
    float mx = -1e30f;
    for (int i = 0; i < KEYS / 64; ++i) {
        const int kk = i * 64 + lane;
        const bf16_t* kr = Kh + (size_t)kk * 128 + kcol0;
        float s = 0.f;
        for (int d = 0; d < dq; d += 8) {
            const u32x4 w = *(const u32x4*)(kr + d);
            s = fmaf(qf[d + 0], bf2f(w.x & 0xffffu), s); s = fmaf(qf[d + 1], bf2f(w.x >> 16), s);
            s = fmaf(qf[d + 2], bf2f(w.y & 0xffffu), s); s = fmaf(qf[d + 3], bf2f(w.y >> 16), s);
            s = fmaf(qf[d + 4], bf2f(w.z & 0xffffu), s); s = fmaf(qf[d + 5], bf2f(w.z >> 16), s);
            s = fmaf(qf[d + 6], bf2f(w.w & 0xffffu), s); s = fmaf(qf[d + 7], bf2f(w.w >> 16), s);
        }
        const bool valid = kk < NMETA || kk >= 64;
        if (tq >= 0 && kk >= 64) s -= slopeC * fabsf((float)(tq - (kk - 64)));
        if (!valid) s = -1e30f;
        sc[kk] = s; mx = fmaxf(mx, s);
    }
    mx = wave_max(mx);
    float sum = 0.f;
    for (int i = 0; i < KEYS / 64; ++i) { const int kk = i * 64 + lane; const float pr = (kk < NMETA || kk >= 64) ? exp2f(sc[kk] - mx) : 0.f; sc[kk] = pr; sum += pr; }
    sum = wave_sum(sum);
    __builtin_amdgcn_s_waitcnt(0);
    float a0 = 0.f, a1 = 0.f;
    const unsigned* V2 = (const unsigned*)Vh + lane;
#pragma unroll 8
    for (int kk = 0; kk < KEYS; ++kk) {
        if (kk >= NMETA && kk < 64) continue;
        const float pr = sc[kk]; const unsigned w = V2[(size_t)kk * 64];
        a0 = fmaf(pr, bf2f(w & 0xffffu), a0); a1 = fmaf(pr, bf2f(w >> 16), a1);
    }
    o0 = a0; o1 = a1;
    return sum;
}
__device__ void phase2_ref(const Params& p, float* lds, int vb, int nvb) {
    const int tid = TID(), lane = tid & 63, wave = tid >> 6;
    if (wave >= 4) return;
    float* sc = lds + wave * KEYS; float* qf = lds + 4 * KEYS + wave * 128;
    const bf16_t *QA = (const bf16_t*)(p.ws + OFF_QA), *KA = (const bf16_t*)(p.ws + OFF_KA), *VA = (const bf16_t*)(p.ws + OFF_VA);
    const bf16_t *QB = (const bf16_t*)(p.ws + OFF_QB), *KB = (const bf16_t*)(p.ws + OFF_KB), *VB = (const bf16_t*)(p.ws + OFF_VB);
    bf16_t* OA = (bf16_t*)(p.ws + OFF_AO); bf16_t* OB = OA + 1024;
    const float lam = *(const float*)(p.ws + OFF_LAM);
    const int NTASK = 2 * 8 * MROWS / NB;
    for (int task = vb * 4 + wave; task < 2 * 8 * MROWS; task += nvb * 4) {
        const int type = task / (8 * MROWS), rem = task % (8 * MROWS), h = rem / MROWS, r = rem % MROWS;
        const RowInfo ri = row_decode(r); const int qr = row_q(ri); const int tq = ri.meta ? -1 : ri.t;
        if (type == 0) {
            const size_t bh = (size_t)(ri.b * 8 + h);
            const float slopeC = exp2f(-(float)(h + 1)) * LOG2E;
            float a0, a1, b0, b1;
            const float l1 = attn_row_ref(QA + (bh * QROWS + qr) * 128, 64, KA + bh * KEYS * 128, 0, VA + bh * KEYS * 128, slopeC, tq, sc, qf, lane, a0, a1);
            const float l2 = attn_row_ref(QA + (bh * QROWS + qr) * 128 + 64, 64, KA + bh * KEYS * 128, 64, VA + bh * KEYS * 128, slopeC, tq, sc, qf, lane, b0, b1);
            float y0 = a0 / l1 - lam * (b0 / l2), y1 = a1 / l1 - lam * (b1 / l2);
            const float ss = wave_sum(y0 * y0 + y1 * y1);
            const float rstd = 1.0f / sqrtf(ss * (1.0f / 128.f) + EPS) * (1.0f - LAM_INIT);
            y0 = y0 * rstd * p.g_subln[2 * lane]; y1 = y1 * rstd * p.g_subln[2 * lane + 1];
            ((unsigned*)(OA + (size_t)r * AOP + h * 128))[lane] = f2bf(y0) | (f2bf(y1) << 16);
        } else {
            const size_t bh = (size_t)(ri.b * 8 + h), bk = (size_t)(ri.b * 2 + (h >> 2));
            float a0, a1;
            const float l = attn_row_ref(QB + (bh * QROWS + qr) * 128, 128, KB + bk * KEYS * 128, 0, VB + bk * KEYS * 128, 0.f, -1, sc, qf, lane, a0, a1);
            ((unsigned*)(OB + (size_t)r * AOP + h * 128))[lane] = f2bf(a0 / l) | (f2bf(a1 / l) << 16);
        }
    }
    (void)NTASK;
}

namespace fa {
using bf16x8 = __attribute__((ext_vector_type(8))) short;
using s16x4  = __attribute__((ext_vector_type(4))) short;
using f32x16 = __attribute__((ext_vector_type(16))) float;
constexpr int NT = KEYS / 64;
constexpr int SHM_V = 16384, SHM_K = 16384;
constexpr int L_V = 0, L_K = 2 * SHM_V, L_WS = L_K + 2 * SHM_K, L_X = L_WS + 8 * 64 * 4;
constexpr int LDS_ATTN = L_X + 8 * 8704;
constexpr float THR = 8.f;
#define KSWZ(row, colB) ((row) * 256 + ((colB) ^ (((row) & 7) << 4)))
#define SBAR() __builtin_amdgcn_sched_barrier(0)
__device__ __forceinline__ int crow(int r, int hi) { return (r & 3) + 8 * (r >> 2) + 4 * hi; }
__device__ __forceinline__ unsigned cvtpk(float lo, float hi) { unsigned r; asm volatile("v_cvt_pk_bf16_f32 %0, %1, %2" : "=v"(r) : "v"(lo), "v"(hi)); return r; }
__device__ __forceinline__ void partialSM(f32x16& p0, f32x16& p1, float& m_reg, float& mn, float& alpha) {
    float pmax = p0[0];
#pragma unroll
    for (int r = 1; r < 16; ++r) pmax = fmaxf(pmax, p0[r]);
#pragma unroll
    for (int r = 0; r < 16; ++r) pmax = fmaxf(pmax, p1[r]);
    { auto rr = __builtin_amdgcn_permlane32_swap(__float_as_uint(pmax), __float_as_uint(pmax), false, false);
      pmax = fmaxf(__uint_as_float(rr[0]), __uint_as_float(rr[1])); }
    if (__builtin_expect(__all(pmax - m_reg <= THR), 1)) { mn = m_reg; alpha = 1.f; }
    else { mn = fmaxf(m_reg, pmax); alpha = __builtin_amdgcn_exp2f(m_reg - mn); m_reg = mn; }
#pragma unroll
    for (int r = 0; r < 16; ++r) { p0[r] -= mn; p1[r] -= mn; }
#pragma unroll
    for (int r = 0; r < 16; ++r) p0[r] = __builtin_amdgcn_exp2f(p0[r]);
}
__device__ __forceinline__ void finishSM(f32x16& p0, f32x16& p1, float alpha, float& l_reg, bf16x8& pa0, bf16x8& pa1, bf16x8& pa2, bf16x8& pa3) {
#pragma unroll
    for (int r = 0; r < 16; ++r) p1[r] = __builtin_amdgcn_exp2f(p1[r]);
    float ps = 0;
#pragma unroll
    for (int r = 0; r < 16; ++r) ps += p0[r];
#pragma unroll
    for (int r = 0; r < 16; ++r) ps += p1[r];
    { auto rr = __builtin_amdgcn_permlane32_swap(__float_as_uint(ps), __float_as_uint(ps), false, false);
      ps = __uint_as_float(rr[0]) + __uint_as_float(rr[1]); }
    l_reg = l_reg * alpha + ps;
#define PK4(P, BASE, OUT) do { unsigned a0 = cvtpk(P[BASE + 0], P[BASE + 1]), a1 = cvtpk(P[BASE + 2], P[BASE + 3]);   \
    unsigned b0 = cvtpk(P[BASE + 4], P[BASE + 5]), b1 = cvtpk(P[BASE + 6], P[BASE + 7]);                              \
    auto r0 = __builtin_amdgcn_permlane32_swap(a0, b0, false, false); auto r1 = __builtin_amdgcn_permlane32_swap(a1, b1, false, false); \
    u32x4 w = {r0[0], r1[0], r0[1], r1[1]}; OUT = *reinterpret_cast<bf16x8*>(&w); } while (0)
    PK4(p0, 0, pa0); PK4(p0, 8, pa1); PK4(p1, 0, pa2); PK4(p1, 8, pa3);
#undef PK4
}
template <int ND0>
__device__ __forceinline__ void qkt(f32x16& p0, f32x16& p1, const char* Ks, const bf16x8* qr, int d0b, int r32, int hi) {
    p0 = f32x16{}; p1 = f32x16{};
#pragma unroll
    for (int d0 = 0; d0 < ND0; ++d0) { const int cb = ((d0b + d0) * 16 + hi * 8) * 2;
        const bf16x8 b0 = *reinterpret_cast<const bf16x8*>(Ks + KSWZ(r32, cb));
        const bf16x8 b1 = *reinterpret_cast<const bf16x8*>(Ks + KSWZ(32 + r32, cb));
        p0 = __builtin_amdgcn_mfma_f32_32x32x16_bf16(b0, qr[d0], p0, 0, 0, 0);
        p1 = __builtin_amdgcn_mfma_f32_32x32x16_bf16(b1, qr[d0], p1, 0, 0, 0); }
}
__device__ __forceinline__ int v_st(int k, int c) { const int kk = (k & ~0xC) | ((k & 4) << 1) | ((k & 8) >> 1); return ((kk >> 3) * 4 + (c >> 5)) * 512 + ((kk & 7) * 32 + (c & 31)) * 2; }
__device__ __forceinline__ int v_rd_base(int lane) { return ((lane & 3) << 3) | (((lane >> 2) & 3) << 6) | (((lane >> 4) & 1) << 5) | (((lane >> 5) & 1) << 8); }
constexpr int v_rd_off(int d0, int ks, int half) { return d0 * 512 + ks * 4096 + half * 2048; }
template <int OFF> __device__ __forceinline__ s16x4 tr_read(int vb) {
    s16x4 r; asm volatile("ds_read_b64_tr_b16 %0, %1 offset:%2" : "=&v"(r) : "v"(vb), "i"(OFF) : "memory"); return r;
}
template <int D0> __device__ __forceinline__ void pv_one(f32x16& od, int vb, bf16x8 pa0, bf16x8 pa1, bf16x8 pa2, bf16x8 pa3) {
    const s16x4 l0 = tr_read<v_rd_off(D0, 0, 0)>(vb), h0 = tr_read<v_rd_off(D0, 0, 1)>(vb), l1 = tr_read<v_rd_off(D0, 1, 0)>(vb), h1 = tr_read<v_rd_off(D0, 1, 1)>(vb);
    const s16x4 l2 = tr_read<v_rd_off(D0, 2, 0)>(vb), h2 = tr_read<v_rd_off(D0, 2, 1)>(vb), l3 = tr_read<v_rd_off(D0, 3, 0)>(vb), h3 = tr_read<v_rd_off(D0, 3, 1)>(vb);
    asm volatile("s_waitcnt lgkmcnt(0)" ::: "memory"); SBAR();
#define PK(L, H) (bf16x8){L[0], L[1], L[2], L[3], H[0], H[1], H[2], H[3]}
    od = __builtin_amdgcn_mfma_f32_32x32x16_bf16(pa0, PK(l0, h0), od, 0, 0, 0);
    od = __builtin_amdgcn_mfma_f32_32x32x16_bf16(pa1, PK(l1, h1), od, 0, 0, 0);
    od = __builtin_amdgcn_mfma_f32_32x32x16_bf16(pa2, PK(l2, h2), od, 0, 0, 0);
    od = __builtin_amdgcn_mfma_f32_32x32x16_bf16(pa3, PK(l3, h3), od, 0, 0, 0);
#undef PK
}
__device__ __forceinline__ void pv_d0(f32x16* o, int vb, bf16x8 pa0, bf16x8 pa1, bf16x8 pa2, bf16x8 pa3) {
    pv_one<0>(o[0], vb, pa0, pa1, pa2, pa3); pv_one<1>(o[1], vb, pa0, pa1, pa2, pa3); pv_one<2>(o[2], vb, pa0, pa1, pa2, pa3); pv_one<3>(o[3], vb, pa0, pa1, pa2, pa3);
}

template <bool DIFF>
__device__ __forceinline__ void attn_unit(const bf16_t* __restrict__ Qlane, const bf16_t* __restrict__ Kh, const bf16_t* __restrict__ Vh, int tq, float slopeL, char* lds, f32x16 (&o)[4], float& l_reg) {
    constexpr int ND0 = DIFF ? 4 : 8;
    const int tid = TID(), wid = tid >> 6, lane = tid & 63, r32 = lane & 31, hi = lane >> 5;
    char* V_lds = lds + L_V; char* K_lds = lds + L_K;
    float* al_l = (float*)(lds + L_WS) + wid * 64 + 32;
    const int d0b = DIFF ? (wid >> 2) * 4 : 0;
    float m_reg = -1e30f; l_reg = 0.f;
#pragma unroll
    for (int d = 0; d < 4; ++d) o[d] = f32x16{};
    bf16x8 qr[ND0];
#pragma unroll
    for (int d0 = 0; d0 < ND0; ++d0) qr[d0] = *reinterpret_cast<const bf16x8*>(Qlane + d0 * 16 + hi * 8);
    const int sr = tid >> 4, sc = (tid & 15) * 8, vst0 = v_st(sr, sc), vst1 = v_st(32 + sr, sc);
    const int vb0 = (int)(uintptr_t)V_lds + v_rd_base(lane);
    struct { bf16x8 vs0, vs1, ks0, ks1; } st_[1];
#define SLOAD(i, k0) do { st_[i].vs0 = *(const bf16x8*)(&Vh[(size_t)((k0) + sr) * 128 + sc]); st_[i].vs1 = *(const bf16x8*)(&Vh[(size_t)((k0) + 32 + sr) * 128 + sc]); \
    st_[i].ks0 = *(const bf16x8*)(&Kh[(size_t)((k0) + sr) * 128 + sc]); st_[i].ks1 = *(const bf16x8*)(&Kh[(size_t)((k0) + 32 + sr) * 128 + sc]); } while (0)
#define SWRITE(b, i) do { *(bf16x8*)(V_lds + (b) * SHM_V + vst0) = st_[i].vs0; *(bf16x8*)(V_lds + (b) * SHM_V + vst1) = st_[i].vs1; const int kc = sc * 2; \
    *(bf16x8*)(K_lds + (b) * SHM_K + KSWZ(sr, kc)) = st_[i].ks0; *(bf16x8*)(K_lds + (b) * SHM_K + KSWZ(32 + sr, kc)) = st_[i].ks1; } while (0)
#define RESC(a) do { if (__any((a) < 1.f)) { if (hi == 0) al_l[r32] = (a); asm volatile("s_waitcnt lgkmcnt(0)" ::: "memory"); \
    _Pragma("unroll") for (int d = 0; d < 4; ++d) _Pragma("unroll") for (int r = 0; r < 16; ++r) o[d][r] *= al_l[crow(r, hi)]; } } while (0)
#define BIAS(P0, P1, j) do { if (DIFF) { const float base_ = (float)(tq - ((j) - 1) * 64 - 4 * hi); \
    _Pragma("unroll") for (int r = 0; r < 16; ++r) { const float d_ = base_ - (float)((r & 3) + 8 * (r >> 2)); \
        P0[r] = fmaf(-slopeL, fabsf(d_), P0[r]); P1[r] = fmaf(-slopeL, fabsf(d_ - 32.f), P1[r]); } } } while (0)
    f32x16 pA0, pA1, pB0, pB1; float mnA, mnB, alA, alB; bf16x8 pa0, pa1, pa2, pa3;
    SLOAD(0, 0); asm volatile("s_waitcnt vmcnt(0)" ::: "memory"); SWRITE(0, 0); __syncthreads();
    qkt<ND0>(pA0, pA1, K_lds, qr, d0b, r32, hi);
#pragma unroll
    for (int r = 8; r < 16; ++r) pA0[r] = -1e30f;
#pragma unroll
    for (int r = 0; r < 16; ++r) pA1[r] = -1e30f;
    partialSM(pA0, pA1, m_reg, mnA, alA);
    SLOAD(0, 64);
    SWRITE(1, 0); __syncthreads();
    for (int j = 1; j + 1 < NT; j += 2) {
        SBAR(); qkt<ND0>(pB0, pB1, K_lds + SHM_K, qr, d0b, r32, hi); BIAS(pB0, pB1, j);
        finishSM(pA0, pA1, alA, l_reg, pa0, pa1, pa2, pa3); SBAR();
        SLOAD(0, (j + 1) * 64); SBAR();
        pv_d0(o, vb0, pa0, pa1, pa2, pa3); partialSM(pB0, pB1, m_reg, mnB, alB);
        __syncthreads(); SWRITE(0, 0);
        RESC(alB); __syncthreads();
        SBAR(); qkt<ND0>(pA0, pA1, K_lds, qr, d0b, r32, hi); BIAS(pA0, pA1, j + 1);
        finishSM(pB0, pB1, alB, l_reg, pa0, pa1, pa2, pa3); SBAR();
        if (j + 2 < NT) SLOAD(0, (j + 2) * 64); SBAR();
        pv_d0(o, vb0 + SHM_V, pa0, pa1, pa2, pa3); partialSM(pA0, pA1, m_reg, mnA, alA);
        __syncthreads(); if (j + 2 < NT) { SWRITE(1, 0); }
        RESC(alA); __syncthreads();
    }
    finishSM(pA0, pA1, alA, l_reg, pa0, pa1, pa2, pa3); SBAR();
    pv_d0(o, vb0, pa0, pa1, pa2, pa3);
    asm volatile("s_waitcnt lgkmcnt(0)" ::: "memory");
#undef SLOAD
#undef SWRITE
#undef RESC
#undef BIAS
}

template <class RowPtr>
__device__ __forceinline__ void store_tile(const f32x16 (&y)[4], char* stage, int lane, RowPtr rowptr) {
    const int r32 = lane & 31, hi = lane >> 5;
    bf16_t* stg = (bf16_t*)stage;
#pragma unroll
    for (int r = 0; r < 16; ++r) { const int orow = crow(r, hi);
#pragma unroll
        for (int d0 = 0; d0 < 4; ++d0) stg[orow * 136 + d0 * 32 + r32] = (bf16_t)f2bf(y[d0][r]); }
    asm volatile("s_waitcnt lgkmcnt(0)" ::: "memory");
#pragma unroll
    for (int i = 0; i < 8; ++i) { const int row = i * 4 + (lane >> 4), ch = lane & 15;
        const u32x4 v = *(const u32x4*)(stg + row * 136 + ch * 8);
        bf16_t* gp = rowptr(row); if (gp) *(u32x4*)(gp + ch * 8) = v; }
    asm volatile("s_waitcnt lgkmcnt(0)" ::: "memory");
}
}

__device__ void phase2_fast(const Params& p, char* lds, int vb, int nvb) {
    using namespace fa;
    const int tid = TID(), wid = __builtin_amdgcn_readfirstlane(tid >> 6), lane0 = tid & 63;
    const bf16_t *QA = (const bf16_t*)(p.ws + OFF_QA), *KA = (const bf16_t*)(p.ws + OFF_KA), *VA = (const bf16_t*)(p.ws + OFF_VA);
    const bf16_t *QB = (const bf16_t*)(p.ws + OFF_QB), *KB = (const bf16_t*)(p.ws + OFF_KB), *VB = (const bf16_t*)(p.ws + OFF_VB);
    bf16_t* OA = (bf16_t*)(p.ws + OFF_AO); bf16_t* OB = OA + 1024;
    const float lam = *(const float*)(p.ws + OFF_LAM);
    float* li_l = (float*)(lds + L_WS) + wid * 64;
    constexpr int NU_B = NB * 8 * 33, NU_A = NB * 8 * 65;
    for (int u = vb; u < NU_B + NU_A; u += nvb) {
        f32x16 o[4]; float l_reg;
        if (u < NU_B) {
            const int bh = u / 33, qb = u % 33, b = bh >> 3, h = bh & 7;
            const bool is_meta = qb == 32;
            { const int r32q = lane0 & 31; const bool rvalid = !is_meta || (wid == 0 && r32q < 16);
              const int qrow = is_meta ? (rvalid ? SEQ + r32q : SEQ) : qb * 256 + wid * 32 + r32q;
              const size_t kvo = (size_t)(b * 2 + (h >> 2)) * KEYS * 128;
              attn_unit<false>(QB + ((size_t)bh * QROWS + qrow) * 128, KB + kvo, VB + kvo, 0, 0.f, lds, o, l_reg); }
            int lane = lane0; asm volatile("" : "+v"(lane));
            const int r32 = lane & 31, hi = lane >> 5;
            if (hi == 0) li_l[r32] = l_reg;
            asm volatile("s_waitcnt lgkmcnt(0)" ::: "memory");
#pragma unroll
            for (int r = 0; r < 16; ++r) { const float rl = __builtin_amdgcn_rcpf(li_l[crow(r, hi)]);
#pragma unroll
                for (int d = 0; d < 4; ++d) o[d][r] *= rl; }
            const int wave_row0 = is_meta ? 0 : qb * 256 + wid * 32;
            store_tile(o, lds + L_X + wid * 8704, lane, [&](int row) -> bf16_t* {
                if (is_meta) { if (wid != 0 || row >= 16) return nullptr; return OB + (size_t)(MREAL + b * NMETA + row) * AOP + h * 128; }
                return OB + (size_t)(b * SEQ + wave_row0 + row) * AOP + h * 128; });
            __syncthreads();
        } else {
            const int ua = u - NU_B, bh = ua / 65, qb = ua % 65, b = bh >> 3, h = bh & 7, mp = wid >> 2, wq = wid & 3;
            const bool is_meta = qb == 64;
            { const int r32q = lane0 & 31; const bool rvalid = !is_meta || (wq == 0 && r32q < 16);
              const int qrow = is_meta ? (rvalid ? SEQ + r32q : SEQ) : qb * 128 + wq * 32 + r32q;
              const float slopeL = is_meta ? 0.f : exp2f(-(float)(h + 1)) * LOG2E;
              const size_t kvo = (size_t)bh * KEYS * 128;
              attn_unit<true>(QA + ((size_t)bh * QROWS + qrow) * 128 + mp * 64, KA + kvo, VA + kvo, qrow, slopeL, lds, o, l_reg); }
            int lane = lane0; asm volatile("" : "+v"(lane));
            const int r32 = lane & 31, hi = lane >> 5;
            if (hi == 0) li_l[r32] = l_reg;
            asm volatile("s_waitcnt lgkmcnt(0)" ::: "memory");
#pragma unroll
            for (int r = 0; r < 16; ++r) { const float rl = __builtin_amdgcn_rcpf(li_l[crow(r, hi)]);
#pragma unroll
                for (int d = 0; d < 4; ++d) o[d][r] *= rl; }
            float* X = (float*)(lds + L_X) + wq * 4096;
            if (mp == 1) {
#pragma unroll
                for (int r = 0; r < 16; ++r)
#pragma unroll
                    for (int d = 0; d < 4; ++d) X[(r * 4 + d) * 64 + lane] = o[d][r];
            }
            __syncthreads();
            if (mp == 0) {
                float ss[16];
#pragma unroll
                for (int r = 0; r < 16; ++r) { float a = 0.f;
#pragma unroll
                    for (int d = 0; d < 4; ++d) { const float y = o[d][r] - lam * X[(r * 4 + d) * 64 + lane]; o[d][r] = y; a += y * y; }
                    ss[r] = a; }
#pragma unroll
                for (int r = 0; r < 16; ++r) {
                    float a = ss[r];
                    a += __shfl_xor(a, 1); a += __shfl_xor(a, 2); a += __shfl_xor(a, 4); a += __shfl_xor(a, 8); a += __shfl_xor(a, 16);
                    ss[r] = 1.0f / sqrtf(a * (1.0f / 128.f) + EPS) * (1.0f - LAM_INIT);
                }
                float g[4];
#pragma unroll
                for (int d = 0; d < 4; ++d) g[d] = p.g_subln[d * 32 + r32];
#pragma unroll
                for (int r = 0; r < 16; ++r)
#pragma unroll
                    for (int d = 0; d < 4; ++d) o[d][r] *= ss[r] * g[d];
            }
            __syncthreads();
            if (mp == 0) {
                const int wave_row0 = is_meta ? 0 : qb * 128 + wq * 32;
                store_tile(o, lds + L_X + wid * 8704, lane, [&](int row) -> bf16_t* {
                    if (is_meta) { if (wq != 0 || row >= 16) return nullptr; return OA + (size_t)(MREAL + b * NMETA + row) * AOP + h * 128; }
                    return OA + (size_t)(b * SEQ + wave_row0 + row) * AOP + h * 128; });
            }
            __syncthreads();
        }
    }
}

__device__ __forceinline__ const bf16_t* sg_row(const Params& p, int grow) { return grow < MREAL ? (const bf16_t*)p.out + (size_t)grow * 2048 : (const bf16_t*)(p.ws + OFF_SGM) + (size_t)(grow - MREAL) * 2048; }
__device__ void phase3a_ref(const Params& p, float* lds, int vb, int nvb, int pass) {
    const bf16_t* A = (const bf16_t*)(p.ws + OFF_AO) + (pass == 0 ? 0 : 1024);
    const float* W = pass == 0 ? p.w_ba : p.w_bb;
    float* T = (float*)(p.ws + OFF_WGU); bf16_t* MG = (bf16_t*)(p.ws + OFF_MERGED);
    constexpr int NTM = MPAD / 128, NTN = DM / 128;
    for (int t = vb; t < NTM * NTN; t += nvb) {
        const int tm = t / NTN, tn = t % NTN, row0 = tm * 128, col0 = tn * 128;
        if (row0 >= MROWS) continue;
        ngemm_tile(lds, DM,
            [&](int r) { return A + (size_t)(row0 + r) * AOP; },
            [&](int k, int c) { return W[(size_t)k * DM + col0 + c]; },
            [&](const float* Ct) {
                const int tid = TID(), r = tid >> 2, q = tid & 3, grow = row0 + r;
                if (grow >= MROWS) return;
                const bf16_t* sg = sg_row(p, grow) + (pass == 0 ? 0 : 1024) + col0 + q * 32;
                for (int i = 0; i < 32; ++i) {
                    const float y = Ct[r * 129 + q * 32 + i] * bf2f(sg[i]); const size_t o = (size_t)grow * DM + col0 + q * 32 + i;
                    if (pass == 0) T[o] = y; else MG[o] = (bf16_t)f2bf(T[o] + y);
                }
            });
    }
}
__device__ __forceinline__ float* h2_row(const Params& p, int grow) { return grow < MREAL ? p.out + (size_t)grow * DM : (float*)(p.ws + OFF_H2M) + (size_t)(grow - MREAL) * DM; }
__device__ void phase3b_ref(const Params& p, float* lds, int vb, int nvb) {
    const bf16_t* MG = (const bf16_t*)(p.ws + OFF_MERGED);
    constexpr int NTM = MPAD / 128, NTN = DM / 128;
    for (int t = vb; t < NTM * NTN; t += nvb) {
        const int tm = t / NTN, tn = t % NTN, row0 = tm * 128, col0 = tn * 128;
        if (row0 >= MROWS) continue;
        ngemm_tile(lds, DM,
            [&](int r) { return MG + (size_t)(row0 + r) * DM; },
            [&](int k, int c) { return p.w_out[(size_t)k * DM + col0 + c]; },
            [&](const float* Ct) {
                const int tid = TID(), r = tid >> 2, q = tid & 3, grow = row0 + r;
                if (grow >= MROWS) return;
                const float* hr = h_row(p, grow) + col0 + q * 32; float* o = h2_row(p, grow) + col0 + q * 32;
                for (int i = 0; i < 32; ++i) o[i] = hr[i] + Ct[r * 129 + q * 32 + i];
            });
    }
}

__device__ void phase4a(const Params& p, float* lds, int vb, int nvb) {
    const int tid = TID(), lane = tid & 63, wave = tid >> 6;
    for (int i = tid; i < DM * NEXP; i += NTHREADS) { const int k = i >> 4, e = i & 15; lds[e * DM + k] = p.w_router[i]; }
    __syncthreads();
    bf16_t* U2 = (bf16_t*)(p.ws + OFF_UN); float* AFF = (float*)(p.ws + OFF_AFF);
    for (int r = vb * 8 + wave; r < MROWS; r += nvb * 8) {
        const RowInfo ri = row_decode(r);
        const f32x4* xr = (const f32x4*)h2_row(p, r) + lane;
        f32x4 v[4]; float s = 0.f;
#pragma unroll
        for (int j = 0; j < 4; ++j) { v[j] = xr[64 * j]; s += (v[j].x * v[j].x + v[j].y * v[j].y) + (v[j].z * v[j].z + v[j].w * v[j].w); }
        const float rstd = 1.0f / sqrtf(wave_sum(s) * (1.0f / DM) + EPS);
        u32x2* o = (u32x2*)(U2 + (size_t)r * DM) + lane;
#pragma unroll
        for (int j = 0; j < 4; ++j) {
            const f32x4 g = ((const f32x4*)p.g_ffn)[lane + 64 * j];
            v[j].x *= rstd * g.x; v[j].y *= rstd * g.y; v[j].z *= rstd * g.z; v[j].w *= rstd * g.w;
            u32x2 w; w.x = f2bf(v[j].x) | (f2bf(v[j].y) << 16); w.y = f2bf(v[j].z) | (f2bf(v[j].w) << 16);
            o[64 * j] = w;
        }
        float mylg = -1e30f;
#pragma unroll 1
        for (int e = 0; e < NEXP; ++e) {
            float a = 0.f;
#pragma unroll
            for (int j = 0; j < 4; ++j) { const f32x4 w = *(const f32x4*)(lds + e * DM + 4 * (lane + 64 * j)); a += v[j].x * w.x + v[j].y * w.y + v[j].z * w.z + v[j].w * w.w; }
            a = wave_sum(a);
            if (lane == e) mylg = a;
        }
        const float mx = wave_max(mylg);
        const float ex = lane < NEXP ? expf(mylg - mx) : 0.f;
        const float mine = ex / wave_sum(ex);
        if (lane < NEXP) AFF[((size_t)ri.b * NEXP + lane) * LTOT + row_pos(ri)] = mine;
    }
    __syncthreads();
}

__device__ void phase4b_ref(const Params& p, float* lds, int vb, int nvb) {
    const float* AFF = (const float*)(p.ws + OFF_AFF); int* IDX = (int*)(p.ws + OFF_IDX); int* SEL = (int*)(p.ws + OFF_SEL);
    constexpr int NCH = (LTOT + NTHREADS - 1) / NTHREADS;
    for (int t = vb; t < NB * NEXP * NCH; t += nvb) {
        const int be = t / NCH, ch = t % NCH, b = be / NEXP, e = be % NEXP;
        const float* a = AFF + (size_t)be * LTOT;
        __syncthreads();
        for (int i = TID(); i < LTOT; i += NTHREADS) lds[i] = a[i];
        __syncthreads();
        const int tok = ch * NTHREADS + TID();
        if (tok < LTOT) {
            const float mine = lds[tok]; int rank = 0;
            for (int j = 0; j < LTOT; ++j) { const float o = lds[j]; rank += (o > mine || (o == mine && j < tok)) ? 1 : 0; }
            if (rank < CAP) { IDX[(size_t)be * CAP + rank] = tok; SEL[((size_t)b * LTOT + tok) * NEXP + e] = rank; }
            else SEL[((size_t)b * LTOT + tok) * NEXP + e] = -1;
        }
    }
    __syncthreads();
}

__device__ void phase5a_ref(const Params& p, float* lds, int vb, int nvb) {
    const bf16_t* U2 = (const bf16_t*)(p.ws + OFF_UN); const int* IDX = (const int*)(p.ws + OFF_IDX); bf16_t* HID = (bf16_t*)(p.ws + OFF_HID);
    constexpr int NTM = (ESLOTS + 127) / 128, NTN = 2 * EFF / 128;
    for (int t = vb; t < NEXP * NTM * NTN; t += nvb) {
        const int e = t / (NTM * NTN), tm = (t / NTN) % NTM, tn = t % NTN, s0 = tm * 128, f0 = tn * 64;
        const float* Wg = p.w_gate + (size_t)e * DM * EFF; const float* Wu = p.w_up + (size_t)e * DM * EFF;
        ngemm_tile(lds, DM,
            [&](int r) -> const bf16_t* { const int s = s0 + r; if (s >= ESLOTS) return nullptr; const int b = s / CAP, c = s % CAP; return U2 + (size_t)pos_row(b, IDX[((size_t)b * NEXP + e) * CAP + c]) * DM; },
            [&](int k, int c) { return c < 64 ? Wg[(size_t)k * EFF + f0 + c] : Wu[(size_t)k * EFF + f0 + c - 64]; },
            [&](const float* Ct) {
                const int tid = TID(), r = tid >> 2, q = tid & 3, s = s0 + r;
                if (s >= ESLOTS) return;
                for (int i = 0; i < 16; ++i) { const float g = Ct[r * 129 + q * 16 + i], u = Ct[r * 129 + 64 + q * 16 + i];
                    HID[((size_t)e * ESLOTS + s) * EFF + f0 + q * 16 + i] = (bf16_t)f2bf(g / (1.0f + __expf(-g)) * u); }
            });
    }
}
__device__ void phase5b_ref(const Params& p, float* lds, int vb, int nvb) {
    const bf16_t* HID = (const bf16_t*)(p.ws + OFF_HID); const int* IDX = (const int*)(p.ws + OFF_IDX); const float* AFF = (const float*)(p.ws + OFF_AFF); bf16_t* YB = (bf16_t*)(p.ws + OFF_YB);
    constexpr int NTM = (ESLOTS + 127) / 128, NTN = DM / 128;
    for (int t = vb; t < NEXP * NTM * NTN; t += nvb) {
        const int e = t / (NTM * NTN), tm = (t / NTN) % NTM, tn = t % NTN, s0 = tm * 128, col0 = tn * 128;
        const float* Wd = p.w_down + (size_t)e * EFF * DM;
        ngemm_tile(lds, EFF,
            [&](int r) -> const bf16_t* { const int s = s0 + r; return s < ESLOTS ? HID + ((size_t)e * ESLOTS + s) * EFF : nullptr; },
            [&](int k, int c) { return Wd[(size_t)k * DM + col0 + c]; },
            [&](const float* Ct) {
                const int tid = TID(), r = tid >> 2, q = tid & 3, s = s0 + r;
                if (s >= ESLOTS) return;
                const int b = s / CAP, c = s % CAP; const int tok = IDX[((size_t)b * NEXP + e) * CAP + c];
                const float af = AFF[((size_t)b * NEXP + e) * LTOT + tok];
                for (int i = 0; i < 32; ++i) YB[((size_t)e * ESLOTS + s) * DM + col0 + q * 32 + i] = (bf16_t)f2bf(Ct[r * 129 + q * 32 + i] * af);
            });
    }
}

__device__ void phase6(const Params& p, int vb, int nvb) {
    const int tid = TID(), lane = tid & 63, wave = tid >> 6;
    const int* SEL = (const int*)(p.ws + OFF_SEL); const bf16_t* YB = (const bf16_t*)(p.ws + OFF_YB);
    for (int r = vb * 8 + wave; r < MREAL; r += nvb * 8) {
        const int b = r >> 13, tok = NMETA + (r & (SEQ - 1));
        f32x4* xr = (f32x4*)(p.out + (size_t)r * DM) + lane;
        f32x4 v[4];
#pragma unroll
        for (int j = 0; j < 4; ++j) v[j] = xr[64 * j];
        const int sel = lane < NEXP ? SEL[((size_t)b * LTOT + tok) * NEXP + lane] : -1;
        for (int e = 0; e < NEXP; ++e) {
            const int c = __shfl(sel, e);
            if (c >= 0) {
                const u32x2* y = (const u32x2*)(YB + ((size_t)e * ESLOTS + b * CAP + c) * DM) + lane;
#pragma unroll
                for (int j = 0; j < 4; ++j) { const u32x2 w = y[64 * j]; v[j].x += bf2f(w.x & 0xffffu); v[j].y += bf2f(w.x >> 16); v[j].z += bf2f(w.y & 0xffffu); v[j].w += bf2f(w.y >> 16); }
            }
        }
        float s = 0.f;
#pragma unroll
        for (int j = 0; j < 4; ++j) s += (v[j].x * v[j].x + v[j].y * v[j].y) + (v[j].z * v[j].z + v[j].w * v[j].w);
        const float rstd = 1.0f / sqrtf(wave_sum(s) * (1.0f / DM) + EPS);
#pragma unroll
        for (int j = 0; j < 4; ++j) { const f32x4 g = ((const f32x4*)p.g_final)[lane + 64 * j]; xr[64 * j] = (f32x4){v[j].x * rstd * g.x, v[j].y * rstd * g.y, v[j].z * rstd * g.z, v[j].w * rstd * g.w}; }
    }
}

template <class DstRow>
__device__ __forceinline__ void transpose_item(const float* __restrict__ W, int N, bf16_t* __restrict__ WT, int ldk, int koff, float* scr, int k0, int n0, int lane, DstRow dst) {
#pragma unroll 8
    for (int i = 0; i < 32; ++i) { const int kk = 2 * i + (lane >> 5); scr[kk * 33 + (lane & 31)] = W[(size_t)(k0 + kk) * N + n0 + (lane & 31)]; }
    asm volatile("s_waitcnt vmcnt(0) lgkmcnt(0)" ::: "memory");
    const int c = lane & 7;
#pragma unroll
    for (int j = 0; j < 4; ++j) { const int n = (lane >> 3) + 8 * j; const float* sp = scr + (8 * c) * 33 + n;
        u32x4 o; o.x = f2bf(sp[0 * 33]) | (f2bf(sp[1 * 33]) << 16); o.y = f2bf(sp[2 * 33]) | (f2bf(sp[3 * 33]) << 16);
        o.z = f2bf(sp[4 * 33]) | (f2bf(sp[5 * 33]) << 16); o.w = f2bf(sp[6 * 33]) | (f2bf(sp[7 * 33]) << 16);
        *(u32x4*)(WT + (size_t)dst(n0 + n) * ldk + koff + k0 + 8 * c) = o; }
    asm volatile("s_waitcnt lgkmcnt(0)" ::: "memory");
}
__device__ __forceinline__ int rope_slot(int e) { const int half = e >> 6, el = e & 63, j = el & 31, n = el >> 5, g = half * 8 + (j >> 2); return 32 * (g >> 2) + 8 * (g & 3) + 4 * n + (j & 3); }
__device__ void transpose_p0(const Params& p, float* lds, int vb, int nvb) {
    const int tid = TID(), lane = tid & 63, wave = tid >> 6;
    float* scr = lds + wave * (64 * 33);
    bf16_t* WIN = (bf16_t*)(p.ws + OFF_WIN); bf16_t* WAB = (bf16_t*)(p.ws + OFF_WAB); bf16_t* WO = (bf16_t*)(p.ws + OFF_WO);
    constexpr int I_IN = 16 * (INW / 32), I_SQ = 16 * 32;
    for (int it = vb * 8 + wave; it < I_IN + 3 * I_SQ; it += nvb * 8) {
        int r = it;
        if (r < I_IN) { const int kb = r / (INW / 32), nb = r % (INW / 32);
            transpose_item(p.w_in, INW, WIN, DM, 0, scr, kb * 64, nb * 32, lane, [](int n) { return (n >= 3072 && n < 4352) ? (n & ~127) + rope_slot(n & 127) : n; }); continue; }
        r -= I_IN; const int m = r / I_SQ, q = r % I_SQ, kb = q / 32, nb = q % 32;
        if (m == 0) transpose_item(p.w_ba, DM, WAB, 2048, 0, scr, kb * 64, nb * 32, lane, [](int n) { return n; });
        else if (m == 1) transpose_item(p.w_bb, DM, WAB, 2048, 1024, scr, kb * 64, nb * 32, lane, [](int n) { return n; });
        else transpose_item(p.w_out, DM, WO, DM, 0, scr, kb * 64, nb * 32, lane, [](int n) { return n; });
    }
}
__device__ void transpose_moe(const Params& p, float* lds, int vbl, int nvbl) {
    const int tid = TID(), lane = tid & 63, wave = tid >> 6;
    float* scr = lds + wave * (64 * 33);
    bf16_t* WGU = (bf16_t*)(p.ws + OFF_WGU); bf16_t* WD = (bf16_t*)(p.ws + OFF_WD);
    constexpr int I_G = 16 * 16, I_D = 8 * 32, I_E = 2 * I_G + I_D;
    for (int it = vbl * 8 + wave; it < NEXP * I_E; it += nvbl * 8) {
        const int e = it / I_E; int r = it % I_E;
        if (r < 2 * I_G) { const int up = r / I_G, q = r % I_G, kb = q / 16, nb = q % 16;
            const float* W = (up ? p.w_up : p.w_gate) + (size_t)e * DM * EFF;
            transpose_item(W, EFF, WGU + (size_t)e * DM * DM, DM, 0, scr, kb * 64, nb * 32, lane, [up](int f) { return 8 * (f >> 2) + 4 * up + (f & 3); }); }
        else { r -= 2 * I_G; const int kb = r / 32, nb = r % 32;
            transpose_item(p.w_down + (size_t)e * EFF * DM, DM, WD + (size_t)e * DM * EFF, EFF, 0, scr, kb * 64, nb * 32, lane, [](int n) { return n; }); }
    }
}

namespace pg8 {
#define PG8_LAS __attribute__((address_space(3)))
typedef short bf16x8 __attribute__((ext_vector_type(8)));
constexpr int BM = 256, BK = 64, HALF = 128, HTB = HALF * BK * 2, STAGE_BYTES = 8 * HTB, NXCD = 8, WGM = 8;
__host__ __device__ __forceinline__ int lds_byte(int r, int c) { const int st = (r >> 4) * 2 + (c >> 5), rr = r & 15, cc = c & 31, ob = rr * 64 + cc * 2; return st * 1024 + (ob ^ (((ob >> 9) & 1) << 5)); }
__host__ __device__ __forceinline__ void stage_rc(int b, int& R, int& C) { const int st = b / 1024, sb = b % 1024, swz = sb ^ (((sb >> 9) & 1) << 5); R = (st >> 1) * 16 + swz / 64; C = (st & 1) * 32 + (swz % 64) / 2; }
__host__ __device__ __forceinline__ int perm32(int rho) { const int n = rho >> 4, i = rho & 15; return 8 * (i >> 2) + 4 * n + (i & 3); }
struct Unit { int arow0, brow0, pm, pn, e; };
struct Gemm { const bf16_t* A; const bf16_t* Bt; int K; };
struct GridOrder {
    int nM, nN, nwg, G, c;
    __device__ void init(int nM_, int nN_, int G_, int c_) { nM = nM_; nN = nN_; nwg = nM * nN; G = G_; c = c_; }
    __device__ bool next(int i, Unit& u) const {
        const long L = (long)i * G + c; if (L >= nwg) return false;
        int wgid = (int)L; { const int q = nwg / NXCD, r = nwg % NXCD, xcd = wgid % NXCD, off = wgid / NXCD; wgid = (xcd < r ? xcd * (q + 1) : r * (q + 1) + (xcd - r) * q) + off; }
        const int nig = WGM * nN, gid = wgid / nig, fm = gid * WGM, gsz = (nM - fm) < WGM ? (nM - fm) : WGM;
        u.pm = fm + ((wgid % nig) % gsz); u.pn = (wgid % nig) / gsz; u.e = 0; u.arow0 = u.pm * BM; u.brow0 = u.pn * BM; return true;
    }
};
struct MoeOrder {
    int G, c;
    __device__ bool next(int i, Unit& u) const {
        const int L = i * G + c; if (L >= NEXP * 36) return false;
        u.e = L / 36; const int r = L % 36; u.pm = r % 9; u.pn = r / 9; u.arow0 = u.e * ESLOTS + u.pm * BM; u.brow0 = u.e * DM + u.pn * BM; return true;
    }
};
__device__ __forceinline__ unsigned cvt_pk_bf16(float lo, float hi) { unsigned r; asm volatile("v_cvt_pk_bf16_f32 %0, %1, %2" : "=v"(r) : "v"(lo), "v"(hi)); return r; }

template <class Epi, class Sched>
__device__ __forceinline__ void gemm_phase(PG8_LAS unsigned char* lds, const Gemm g, const Sched& S, const Epi& E) {
    const int tid = TID(), wid = __builtin_amdgcn_readfirstlane(tid >> 6), lane = tid & 63, wr = wid >> 2, wc = wid & 3, fr = lane & 15, fq = lane >> 4;
    const int K = g.K, nt = K / BK;
    unsigned voffA[2], voffB[2];
#pragma unroll
    for (int i = 0; i < 2; ++i) { int R, C; stage_rc(tid * 16 + i * 8192, R, C); const int Rb = Epi::PERM ? ((R & ~31) + perm32(R & 31)) : R;
        voffA[i] = (unsigned)(R * K + C) * 2u; voffB[i] = (unsigned)(Rb * K + C) * 2u; }
    const size_t kstep = (size_t)(BK * 2);
    const size_t hstep = (size_t)HALF * K * 2;
    const size_t rstep = (size_t)K * 2;
    const unsigned ldsw = (unsigned)wid * 1024u;
    const int aoff = lds_byte(wr * 64 + fr, fq * 8), boff = lds_byte(wc * 32 + fr, fq * 8);
#define PG8_SA(b, h) (((b) * 2 + (h)) * HTB)
#define PG8_SB(b, h) ((4 + (b) * 2 + (h)) * HTB)
#define PG8_STAGE(bufoff, gbase, voff) do { _Pragma("unroll") for (int _i = 0; _i < 2; ++_i) \
        __builtin_amdgcn_global_load_lds((const unsigned*)((const char*)(gbase) + (voff)[_i]), (PG8_LAS unsigned*)(lds + (bufoff) + ldsw + _i * 8192), 16, 0, 0); } while (0)
#define PG8_LDA(dst, b, h) do { _Pragma("unroll") for (int m = 0; m < 4; ++m) _Pragma("unroll") for (int k = 0; k < 2; ++k) dst[m][k] = *(const PG8_LAS bf16x8*)(lds + PG8_SA(b, h) + aoff + m * 2048 + k * 1024); } while (0)
#define PG8_LDB(dst, b, h) do { _Pragma("unroll") for (int n = 0; n < 2; ++n) _Pragma("unroll") for (int k = 0; k < 2; ++k) dst[n][k] = *(const PG8_LAS bf16x8*)(lds + PG8_SB(b, h) + boff + n * 2048 + k * 1024); } while (0)
#define PG8_MMA(ai, bj, At, Bt) do { __builtin_amdgcn_s_setprio(1); _Pragma("unroll") for (int m = 0; m < 4; ++m) _Pragma("unroll") for (int n = 0; n < 2; ++n) _Pragma("unroll") for (int k = 0; k < 2; ++k) \
        acc[ai][bj][m][n] = __builtin_amdgcn_mfma_f32_16x16x32_bf16(Bt[n][k], At[m][k], acc[ai][bj][m][n], 0, 0, 0); __builtin_amdgcn_s_setprio(0); } while (0)
#define PG8_WAIT_V(n) asm volatile("s_waitcnt vmcnt(" #n ")" ::: "memory")
#define PG8_WAIT_L(n) asm volatile("s_waitcnt lgkmcnt(" #n ")" ::: "memory")
#define PG8_BAR __builtin_amdgcn_s_barrier()
#define PG8_SCHED __builtin_amdgcn_sched_barrier(0)
    Unit cur, nxt; int ui = 0;
    if (!S.next(0, cur)) return;
    f32x4 acc[2][2][4][2];
#pragma unroll
    for (int a = 0; a < 2; ++a)
#pragma unroll
        for (int b = 0; b < 2; ++b)
#pragma unroll
            for (int m = 0; m < 4; ++m)
#pragma unroll
                for (int n = 0; n < 2; ++n) acc[a][b][m][n] = (f32x4){0.f, 0.f, 0.f, 0.f};
    bf16x8 At[4][2], B0[2][2], B1[2][2];
    const char* cA = (const char*)g.A + (size_t)cur.arow0 * rstep; const char* cB = (const char*)g.Bt + (size_t)cur.brow0 * rstep;
    PG8_STAGE(PG8_SB(0, 0), cB, voffB); PG8_STAGE(PG8_SB(0, 1), cB + hstep, voffB); PG8_STAGE(PG8_SA(0, 0), cA, voffA); PG8_STAGE(PG8_SA(0, 1), cA + hstep, voffA);
    if (wr == 1) PG8_BAR;
    PG8_WAIT_V(2); PG8_BAR;
    PG8_STAGE(PG8_SB(1, 0), cB + kstep, voffB); PG8_STAGE(PG8_SA(1, 0), cA + kstep, voffA); PG8_STAGE(PG8_SB(1, 1), cB + hstep + kstep, voffB);
    PG8_WAIT_V(6); PG8_BAR;
    for (;;) {
        const bool has_next = S.next(ui + 1, nxt);
        const char* nA = has_next ? (const char*)g.A + (size_t)nxt.arow0 * rstep : cA; const char* nB = has_next ? (const char*)g.Bt + (size_t)nxt.brow0 * rstep : cB;
        for (int t = 0; t < nt; t += 2) {
            const bool last = (t == nt - 2);
            const char* a1 = cA + (size_t)(t + 1) * kstep;
            const char* a2 = last ? nA : cA + (size_t)(t + 2) * kstep; const char* b2 = last ? nB : cB + (size_t)(t + 2) * kstep;
            const char* a3 = a2 + kstep; const char* b3 = b2 + kstep;
            if constexpr (Epi::HAS_MID) { if (t == nt / 2) E.mid(acc, cur, wr, wc, fr, fq); }
            PG8_LDB(B0, 0, 0); PG8_LDB(B1, 0, 1); PG8_SCHED; PG8_LDA(At, 0, 0); PG8_STAGE(PG8_SA(1, 1), a1 + hstep, voffA);
            PG8_WAIT_V(8); PG8_WAIT_L(0); PG8_BAR; PG8_MMA(0, 0, At, B0); PG8_MMA(0, 1, At, B1); PG8_BAR; PG8_SCHED;
            PG8_LDA(At, 0, 1); PG8_STAGE(PG8_SB(0, 0), b2, voffB); PG8_STAGE(PG8_SB(0, 1), b2 + hstep, voffB); PG8_STAGE(PG8_SA(0, 0), a2, voffA);
            PG8_WAIT_V(8); PG8_WAIT_L(0); PG8_BAR; PG8_MMA(1, 0, At, B0); PG8_MMA(1, 1, At, B1); PG8_BAR; PG8_SCHED;
            PG8_LDB(B0, 1, 0); PG8_LDB(B1, 1, 1); PG8_SCHED; PG8_LDA(At, 1, 0); PG8_STAGE(PG8_SA(0, 1), a2 + hstep, voffA);
            PG8_WAIT_V(8); PG8_WAIT_L(0); PG8_BAR; PG8_MMA(0, 0, At, B0); PG8_MMA(0, 1, At, B1); PG8_BAR; PG8_SCHED;
            PG8_LDA(At, 1, 1); PG8_STAGE(PG8_SB(1, 0), b3, voffB); PG8_STAGE(PG8_SB(1, 1), b3 + hstep, voffB); PG8_STAGE(PG8_SA(1, 0), a3, voffA);
            PG8_WAIT_V(8); PG8_WAIT_L(0); PG8_BAR; PG8_MMA(1, 0, At, B0); PG8_MMA(1, 1, At, B1); PG8_BAR; PG8_SCHED;
        }
        if (wr == 0) PG8_BAR;
        E(acc, cur, wr, wc, fr, fq, lds);
        if (!has_next) break;
#pragma unroll
        for (int a = 0; a < 2; ++a)
#pragma unroll
            for (int b = 0; b < 2; ++b)
#pragma unroll
                for (int m = 0; m < 4; ++m)
#pragma unroll
                    for (int n = 0; n < 2; ++n) acc[a][b][m][n] = (f32x4){0.f, 0.f, 0.f, 0.f};
        cur = nxt; cA = nA; cB = nB; ++ui;
        if (wr == 1) PG8_BAR;
    }
    PG8_WAIT_V(0);
    PG8_BAR;
#undef PG8_SA
#undef PG8_SB
#undef PG8_STAGE
#undef PG8_LDA
#undef PG8_LDB
#undef PG8_MMA
#undef PG8_WAIT_V
#undef PG8_WAIT_L
#undef PG8_SCHED
}
#define PG8_FOR_AM _Pragma("unroll") for (int ai = 0; ai < 2; ++ai) _Pragma("unroll") for (int m = 0; m < 4; ++m)
#define PG8_FOR_BJ _Pragma("unroll") for (int bj = 0; bj < 2; ++bj)

struct EpiInProj {
    static constexpr bool PERM = true, HAS_MID = false;
    Params p;
    __device__ __forceinline__ void operator()(f32x4 (&acc)[2][2][4][2], const Unit& u, int wr, int wc, int fr, int fq, PG8_LAS unsigned char* lds) const {
        const int pn = u.pn;
        const int sec = pn < 4 ? 0 : pn < 8 ? 1 : pn < 12 ? 2 : pn < 16 ? 3 : pn == 16 ? 4 : pn == 17 ? 5 : pn < 22 ? 6 : 7;
        const int head0 = (sec == 0 ? pn : sec == 1 ? pn - 4 : sec == 2 ? pn - 8 : sec == 3 ? pn - 12 : sec == 6 ? pn - 18 : sec == 7 ? pn - 22 : 0) * 2;
        const int cl = wc * 32 + fq * 8;
        if (sec == 3 || sec == 4) {
            PG8_LAS float* X = (PG8_LAS float*)(lds + STAGE_BYTES);
            PG8_FOR_AM { PG8_FOR_BJ { const f32x4 a = acc[ai][bj][m][0], b = acc[ai][bj][m][1];
                float ss = (a.x * a.x + a.y * a.y) + (a.z * a.z + a.w * a.w) + (b.x * b.x + b.y * b.y) + (b.z * b.z + b.w * b.w);
                ss += __shfl_xor(ss, 16); ss += __shfl_xor(ss, 32);
                if (fq == 0) X[((ai * 128 + wr * 64 + m * 16 + fr) * 2 + bj) * 4 + wc] = ss; } }
            asm volatile("s_waitcnt lgkmcnt(0)" ::: "memory"); __builtin_amdgcn_s_barrier(); asm volatile("" ::: "memory");
            const int g = wc * 4 + fq, j0 = (g & 7) * 4, e0 = (g >> 3) * 64 + j0;
            const float* gn = sec == 3 ? p.g_qnorm : p.g_knorm;
            const f32x4 g1 = *(const f32x4*)(gn + e0), g2 = *(const f32x4*)(gn + e0 + 32);
            const float sc = sec == 3 ? CB : 1.f;
            const float2* rope = (const float2*)(p.ws + OFF_ROPE);
            PG8_FOR_AM { const int rl = ai * 128 + wr * 64 + m * 16 + fr, grow = u.pm * BM + rl; const RowInfo ri = row_decode(grow);
                f32x4 c4 = (f32x4){1.f, 1.f, 1.f, 1.f}, s4 = (f32x4){0.f, 0.f, 0.f, 0.f};
                if (!ri.meta) { const int pos = (g >> 3) ? (ri.t & 63) : (ri.t >> 6); const f32x4 t0 = *(const f32x4*)(rope + pos * 32 + j0), t1 = *(const f32x4*)(rope + pos * 32 + j0 + 2);
                    c4 = (f32x4){t0.x, t0.z, t1.x, t1.z}; s4 = (f32x4){t0.y, t0.w, t1.y, t1.w}; }
                PG8_FOR_BJ { const f32x4 pq = *(const PG8_LAS f32x4*)(X + (rl * 2 + bj) * 4);
                    const float rstd = 1.0f / sqrtf(((pq.x + pq.y) + (pq.z + pq.w)) * (1.0f / 128.f) + EPS) * sc;
                    const f32x4 x1 = acc[ai][bj][m][0] * g1 * rstd, x2 = acc[ai][bj][m][1] * g2 * rstd;
                    const f32x4 y1 = x1 * c4 - x2 * s4, y2 = x2 * c4 + x1 * s4;
                    if (ri.valid) { const int head = head0 + bj;
                        bf16_t* dst = sec == 3 ? (bf16_t*)(p.ws + OFF_QB) + ((size_t)(ri.b * 8 + head) * QROWS + row_q(ri)) * 128 : (bf16_t*)(p.ws + OFF_KB) + ((size_t)(ri.b * 2 + head) * KEYS + row_key(ri)) * 128;
                        *(u32x2*)(dst + e0) = (u32x2){cvt_pk_bf16(y1.x, y1.y), cvt_pk_bf16(y1.z, y1.w)};
                        *(u32x2*)(dst + e0 + 32) = (u32x2){cvt_pk_bf16(y2.x, y2.y), cvt_pk_bf16(y2.z, y2.w)}; } } }
            return;
        }
        PG8_FOR_AM { const int grow = u.pm * BM + ai * 128 + wr * 64 + m * 16 + fr; const RowInfo ri = row_decode(grow);
            if (!ri.valid) continue;
            PG8_FOR_BJ { const int head = head0 + bj; f32x4 a = acc[ai][bj][m][0], b = acc[ai][bj][m][1]; bf16_t* dst;
                if (sec == 0) { dst = (bf16_t*)(p.ws + OFF_QA) + ((size_t)(ri.b * 8 + head) * QROWS + row_q(ri)) * 128; a = a * CA; b = b * CA; }
                else if (sec == 1) dst = (bf16_t*)(p.ws + OFF_KA) + ((size_t)(ri.b * 8 + head) * KEYS + row_key(ri)) * 128;
                else if (sec == 2) dst = (bf16_t*)(p.ws + OFF_VA) + ((size_t)(ri.b * 8 + head) * KEYS + row_key(ri)) * 128;
                else if (sec == 5) dst = (bf16_t*)(p.ws + OFF_VB) + ((size_t)(ri.b * 2 + head) * KEYS + row_key(ri)) * 128;
                else { dst = (grow < MREAL ? (bf16_t*)p.out + (size_t)grow * 2048 : (bf16_t*)(p.ws + OFF_SGM) + (size_t)(grow - MREAL) * 2048) + (sec == 7 ? 1024 : 0) + head * 128;
                    a.x = 1.0f / (1.0f + __expf(-a.x)); a.y = 1.0f / (1.0f + __expf(-a.y)); a.z = 1.0f / (1.0f + __expf(-a.z)); a.w = 1.0f / (1.0f + __expf(-a.w));
                    b.x = 1.0f / (1.0f + __expf(-b.x)); b.y = 1.0f / (1.0f + __expf(-b.y)); b.z = 1.0f / (1.0f + __expf(-b.z)); b.w = 1.0f / (1.0f + __expf(-b.w)); }
                *(u32x4*)(dst + cl) = (u32x4){cvt_pk_bf16(a.x, a.y), cvt_pk_bf16(a.z, a.w), cvt_pk_bf16(b.x, b.y), cvt_pk_bf16(b.z, b.w)}; } }
    }
};
__device__ __forceinline__ f32x4 bf4(u32x2 w) { return (f32x4){bf2f(w.x & 0xffffu), bf2f(w.x >> 16), bf2f(w.y & 0xffffu), bf2f(w.y >> 16)}; }
struct EpiMerge {
    static constexpr bool PERM = true, HAS_MID = true;
    Params p;
    __device__ __forceinline__ const bf16_t* sg(int grow) const { return grow < MREAL ? (const bf16_t*)p.out + (size_t)grow * 2048 : (const bf16_t*)(p.ws + OFF_SGM) + (size_t)(grow - MREAL) * 2048; }
    __device__ __forceinline__ void mid(f32x4 (&acc)[2][2][4][2], const Unit& u, int wr, int wc, int fr, int fq) const {
        PG8_FOR_AM { const int grow = u.pm * BM + ai * 128 + wr * 64 + m * 16 + fr; if (grow >= MROWS) continue; const bf16_t* s = sg(grow) + u.pn * BM + wc * 32 + fq * 8;
            PG8_FOR_BJ { const u32x4 wa = *(const u32x4*)(s + bj * 128), wb = *(const u32x4*)(s + 1024 + bj * 128);
                const f32x4 b0 = bf4((u32x2){wb.x, wb.y}), b1 = bf4((u32x2){wb.z, wb.w});
                const f32x4 r0 = (f32x4){__builtin_amdgcn_rcpf(b0.x), __builtin_amdgcn_rcpf(b0.y), __builtin_amdgcn_rcpf(b0.z), __builtin_amdgcn_rcpf(b0.w)};
                const f32x4 r1 = (f32x4){__builtin_amdgcn_rcpf(b1.x), __builtin_amdgcn_rcpf(b1.y), __builtin_amdgcn_rcpf(b1.z), __builtin_amdgcn_rcpf(b1.w)};
                acc[ai][bj][m][0] = acc[ai][bj][m][0] * bf4((u32x2){wa.x, wa.y}) * r0;
                acc[ai][bj][m][1] = acc[ai][bj][m][1] * bf4((u32x2){wa.z, wa.w}) * r1; } }
    }
    __device__ __forceinline__ void operator()(f32x4 (&acc)[2][2][4][2], const Unit& u, int wr, int wc, int fr, int fq, PG8_LAS unsigned char*) const {
        bf16_t* MG = (bf16_t*)(p.ws + OFF_MERGED);
        PG8_FOR_AM { const int grow = u.pm * BM + ai * 128 + wr * 64 + m * 16 + fr; if (grow >= MROWS) continue; const int col = u.pn * BM + wc * 32 + fq * 8; const bf16_t* s = sg(grow) + 1024 + col;
            PG8_FOR_BJ { const u32x4 wb = *(const u32x4*)(s + bj * 128);
                const f32x4 a = acc[ai][bj][m][0] * bf4((u32x2){wb.x, wb.y}), b = acc[ai][bj][m][1] * bf4((u32x2){wb.z, wb.w});
                *(u32x4*)(MG + (size_t)grow * DM + col + bj * 128) = (u32x4){cvt_pk_bf16(a.x, a.y), cvt_pk_bf16(a.z, a.w), cvt_pk_bf16(b.x, b.y), cvt_pk_bf16(b.z, b.w)}; } }
    }
};
struct EpiOut {
    static constexpr bool PERM = false, HAS_MID = false;
    Params p;
    __device__ __forceinline__ void operator()(f32x4 (&acc)[2][2][4][2], const Unit& u, int wr, int wc, int fr, int fq, PG8_LAS unsigned char*) const {
        PG8_FOR_AM { const int grow = u.pm * BM + ai * 128 + wr * 64 + m * 16 + fr; if (grow >= MROWS) continue; const int col = u.pn * BM + wc * 32 + fq * 4;
            const float* hr = h_row(p, grow) + col; float* o = h2_row(p, grow) + col;
            PG8_FOR_BJ {
#pragma unroll
                for (int n = 0; n < 2; ++n) *(f32x4*)(o + bj * 128 + n * 16) = *(const f32x4*)(hr + bj * 128 + n * 16) + acc[ai][bj][m][n]; } }
    }
};
struct EpiMoeUp {
    static constexpr bool PERM = true, HAS_MID = false;
    Params p;
    __device__ __forceinline__ void operator()(f32x4 (&acc)[2][2][4][2], const Unit& u, int wr, int wc, int fr, int fq, PG8_LAS unsigned char*) const {
        bf16_t* HID = (bf16_t*)(p.ws + OFF_HID);
        PG8_FOR_AM { const int s = u.pm * BM + ai * 128 + wr * 64 + m * 16 + fr; if (s >= ESLOTS) continue;
            PG8_FOR_BJ { const f32x4 gt = acc[ai][bj][m][0], up = acc[ai][bj][m][1]; const int f0 = (u.pn * BM + bj * 128 + wc * 32 + fq * 8) >> 1;
                const float h0 = gt.x / (1.0f + __expf(-gt.x)) * up.x, h1 = gt.y / (1.0f + __expf(-gt.y)) * up.y, h2 = gt.z / (1.0f + __expf(-gt.z)) * up.z, h3 = gt.w / (1.0f + __expf(-gt.w)) * up.w;
                *(u32x2*)(HID + ((size_t)u.e * ESLOTS + s) * EFF + f0) = (u32x2){cvt_pk_bf16(h0, h1), cvt_pk_bf16(h2, h3)}; } }
    }
};
struct EpiMoeDown {
    static constexpr bool PERM = true, HAS_MID = false;
    Params p;
    __device__ __forceinline__ void operator()(f32x4 (&acc)[2][2][4][2], const Unit& u, int wr, int wc, int fr, int fq, PG8_LAS unsigned char*) const {
        bf16_t* YB = (bf16_t*)(p.ws + OFF_YB); const float* SAFF = (const float*)(p.ws + OFF_SAFF);
        PG8_FOR_AM { const int s = u.pm * BM + ai * 128 + wr * 64 + m * 16 + fr; if (s >= ESLOTS) continue; const float af = SAFF[u.e * ESLOTS + s]; const int col = u.pn * BM + wc * 32 + fq * 8;
            PG8_FOR_BJ { const f32x4 a = acc[ai][bj][m][0] * af, b = acc[ai][bj][m][1] * af;
                *(u32x4*)(YB + ((size_t)u.e * ESLOTS + s) * DM + col + bj * 128) = (u32x4){cvt_pk_bf16(a.x, a.y), cvt_pk_bf16(a.z, a.w), cvt_pk_bf16(b.x, b.y), cvt_pk_bf16(b.z, b.w)}; } }
    }
};
#undef PG8_BAR
}

__device__ __forceinline__ void phase1_fast(const Params& p, unsigned char* lds_raw, int vb, int nvb) {
    pg8::Gemm g{(const bf16_t*)(p.ws + OFF_UN), (const bf16_t*)(p.ws + OFF_WIN), DM};
    pg8::GridOrder S; S.init(MPAD / 256, INW / 256, nvb, vb);
    pg8::EpiInProj E{p};
    pg8::gemm_phase(( __attribute__((address_space(3))) unsigned char*)lds_raw, g, S, E);
}
__device__ __forceinline__ void phase3a_fast(const Params& p, unsigned char* lds_raw, int vb, int nvb) {
    pg8::Gemm g{(const bf16_t*)(p.ws + OFF_AO), (const bf16_t*)(p.ws + OFF_WAB), 2048};
    pg8::GridOrder S; S.init(MPAD / 256, DM / 256, nvb, vb);
    pg8::EpiMerge E{p};
    pg8::gemm_phase(( __attribute__((address_space(3))) unsigned char*)lds_raw, g, S, E);
}
__device__ __forceinline__ void phase3b_fast(const Params& p, unsigned char* lds_raw, int vb, int nvb) {
    pg8::Gemm g{(const bf16_t*)(p.ws + OFF_MERGED), (const bf16_t*)(p.ws + OFF_WO), DM};
    pg8::GridOrder S; S.init(MPAD / 256, DM / 256, nvb, vb);
    pg8::EpiOut E{p};
    pg8::gemm_phase(( __attribute__((address_space(3))) unsigned char*)lds_raw, g, S, E);
}
__device__ __forceinline__ void phase5a_fast(const Params& p, unsigned char* lds_raw, int vb, int nvb) {
    pg8::Gemm g{(const bf16_t*)(p.ws + OFF_XS), (const bf16_t*)(p.ws + OFF_WGU), DM};
    pg8::MoeOrder S{nvb, vb};
    pg8::EpiMoeUp E{p};
    pg8::gemm_phase(( __attribute__((address_space(3))) unsigned char*)lds_raw, g, S, E);
}
__device__ __forceinline__ void phase5b_fast(const Params& p, unsigned char* lds_raw, int vb, int nvb) {
    pg8::Gemm g{(const bf16_t*)(p.ws + OFF_HID), (const bf16_t*)(p.ws + OFF_WD), EFF};
    pg8::MoeOrder S{nvb, vb};
    pg8::EpiMoeDown E{p};
    pg8::gemm_phase(( __attribute__((address_space(3))) unsigned char*)lds_raw, g, S, E);
}

__device__ void phase4b_fast(const Params& p, float* lds, int vb, int nvb) {
    const int tid = TID(), lane = tid & 63, wave = tid >> 6;
    constexpr int NBE = NB * NEXP;
    if (vb >= NBE) { transpose_moe(p, lds, vb - NBE, nvb - NBE); return; }
    if (nvb <= NBE) transpose_moe(p, lds, vb, nvb);
    const float* AFF = (const float*)(p.ws + OFF_AFF); int* IDX = (int*)(p.ws + OFF_IDX); int* SEL = (int*)(p.ws + OFF_SEL);
    unsigned* keys = (unsigned*)lds;
    unsigned* hist = keys + 8448;
    unsigned* sh = hist + 256;
    for (int be = vb; be < NBE; be += nvb) {
        const int b = be / NEXP, e = be % NEXP;
        __syncthreads();
        for (int i = tid; i < LTOT; i += NTHREADS) keys[i] = __float_as_uint(AFF[(size_t)be * LTOT + i]);
        if (tid == 0) { sh[0] = 0u; sh[1] = CAP; }
        __syncthreads();
        for (int pass = 0; pass < 4; ++pass) {
            const int shift = 24 - 8 * pass;
            if (tid < 256) hist[tid] = 0u;
            __syncthreads();
            const unsigned prefix = sh[0], pmask = pass == 0 ? 0u : (0xffffffffu << (shift + 8));
            for (int i = tid; i < LTOT; i += NTHREADS) { const unsigned k = keys[i]; if ((k & pmask) == prefix) atomicAdd(&hist[(k >> shift) & 255u], 1u); }
            __syncthreads();
            if (tid == 0) { unsigned rem = sh[1], d = 255u;
                for (;; --d) { const unsigned c = hist[d]; if (c >= rem || d == 0u) break; rem -= c; }
                sh[0] = prefix | (d << shift); sh[1] = rem; }
            __syncthreads();
        }
        const unsigned T = sh[0], need_eq = sh[1];
        const int t0 = tid * 17; int cnt_gt = 0, cnt_eq = 0;
        for (int i = 0; i < 17; ++i) { const int tok = t0 + i; if (tok < LTOT) { const unsigned k = keys[tok]; cnt_gt += k > T; cnt_eq += k == T; } }
        int incl = cnt_eq;
#pragma unroll
        for (int o = 1; o < 64; o <<= 1) { const int v = __shfl_up(incl, o); if (lane >= o) incl += v; }
        if (lane == 63) sh[8 + wave] = (unsigned)incl;
        __syncthreads();
        int eq_before = incl - cnt_eq; for (int w = 0; w < wave; ++w) eq_before += (int)sh[8 + w];
        __syncthreads();
        int take_eq = (int)need_eq - eq_before; take_eq = take_eq < 0 ? 0 : (take_eq > cnt_eq ? cnt_eq : take_eq);
        const int mysel = cnt_gt + take_eq;
        incl = mysel;
#pragma unroll
        for (int o = 1; o < 64; o <<= 1) { const int v = __shfl_up(incl, o); if (lane >= o) incl += v; }
        if (lane == 63) sh[8 + wave] = (unsigned)incl;
        __syncthreads();
        int slot = incl - mysel; for (int w = 0; w < wave; ++w) slot += (int)sh[8 + w];
        int eqi = eq_before;
        for (int i = 0; i < 17; ++i) { const int tok = t0 + i; if (tok < LTOT) { const unsigned k = keys[tok];
            bool take = k > T; if (k == T) { take = eqi < (int)need_eq; ++eqi; }
            if (take) { IDX[(size_t)be * CAP + slot] = tok; SEL[((size_t)b * LTOT + tok) * NEXP + e] = slot; ++slot; } else SEL[((size_t)b * LTOT + tok) * NEXP + e] = -1; } }
    }
    __syncthreads();
}
__device__ void phase4c(const Params& p, int vb, int nvb) {
    const int tid = TID(), lane = tid & 63, wave = tid >> 6;
    const bf16_t* U2 = (const bf16_t*)(p.ws + OFF_UN); bf16_t* XS = (bf16_t*)(p.ws + OFF_XS); const int* IDX = (const int*)(p.ws + OFF_IDX);
    const float* AFF = (const float*)(p.ws + OFF_AFF); float* SAFF = (float*)(p.ws + OFF_SAFF);
    for (int r = vb * 8 + wave; r < NEXP * ESLOTS; r += nvb * 8) {
        const int e = r / ESLOTS, s = r % ESLOTS, b = s / CAP, c = s % CAP;
        const int tok = IDX[((size_t)b * NEXP + e) * CAP + c];
        const u32x4* src = (const u32x4*)(U2 + (size_t)pos_row(b, tok) * DM) + lane; u32x4* dst = (u32x4*)(XS + (size_t)r * DM) + lane;
        const u32x4 v0 = src[0], v1 = src[64]; dst[0] = v0; dst[64] = v1;
        if (lane == 0) SAFF[r] = AFF[((size_t)b * NEXP + e) * LTOT + tok];
    }
}

constexpr int LDS_BYTES = 147456;
#if defined(__HIP_DEVICE_COMPILE__)
#define PHASE_PARAMS() ({ const __attribute__((address_space(4))) Params* q_ = (const __attribute__((address_space(4))) Params*)__builtin_amdgcn_kernarg_segment_ptr(); asm volatile("" : "+s"(q_)); *q_; })
#else
#define PHASE_PARAMS() (pk)
#endif
__global__ void __launch_bounds__(NTHREADS, 2) fwd_kernel(Params pk) {
    extern __shared__ __attribute__((aligned(16))) unsigned char lds_raw[];
    float* lds = (float*)lds_raw;
    cg::grid_group grid = cg::this_grid();
    const int vb = blockIdx.x, nvb = gridDim.x;
    { const Params p = PHASE_PARAMS(); phase0(p, vb, nvb); }
#if FAST_P1 || FAST_P3
    { const Params p = PHASE_PARAMS(); transpose_p0(p, lds, vb, nvb); }
#endif
    grid.sync();
#if FAST_P1
    { const Params p = PHASE_PARAMS(); phase1_fast(p, lds_raw, vb, nvb); }
#else
    { const Params p = PHASE_PARAMS(); phase1_ref(p, lds, vb, nvb); }
#endif
    grid.sync();
#if FAST_ATTN
    { const Params p = PHASE_PARAMS(); phase2_fast(p, (char*)lds_raw, vb, nvb); }
#else
    { const Params p = PHASE_PARAMS(); phase2_ref(p, lds, vb, nvb); }
#endif
    grid.sync();
#if FAST_P3
    { const Params p = PHASE_PARAMS(); phase3a_fast(p, lds_raw, vb, nvb); }
#else
    { const Params p = PHASE_PARAMS(); phase3a_ref(p, lds, vb, nvb, 0); }
    { const Params p = PHASE_PARAMS(); phase3a_ref(p, lds, vb, nvb, 1); }
#endif
    grid.sync();
#if FAST_P3
    { const Params p = PHASE_PARAMS(); phase3b_fast(p, lds_raw, vb, nvb); }
#else
    { const Params p = PHASE_PARAMS(); phase3b_ref(p, lds, vb, nvb); }
#endif
    grid.sync();
    { const Params p = PHASE_PARAMS(); phase4a(p, lds, vb, nvb); }
    grid.sync();
#if FAST_MOE
    { const Params p = PHASE_PARAMS(); phase4b_fast(p, lds, vb, nvb); }
    grid.sync();
    { const Params p = PHASE_PARAMS(); phase4c(p, vb, nvb); }
    grid.sync();
    { const Params p = PHASE_PARAMS(); phase5a_fast(p, lds_raw, vb, nvb); }
    grid.sync();
    { const Params p = PHASE_PARAMS(); phase5b_fast(p, lds_raw, vb, nvb); }
#else
    { const Params p = PHASE_PARAMS(); phase4b_ref(p, lds, vb, nvb); }
    grid.sync();
    { const Params p = PHASE_PARAMS(); phase5a_ref(p, lds, vb, nvb); }
    grid.sync();
    { const Params p = PHASE_PARAMS(); phase5b_ref(p, lds, vb, nvb); }
#endif
    grid.sync();
    { const Params p = PHASE_PARAMS(); phase6(p, vb, nvb); }
}

extern "C" void kernel_launch(void* const* d_in, const int* in_sizes, int n_in, void* d_out, int out_size, void* d_ws, size_t ws_size, hipStream_t stream) {
    static int grid_blocks = 0;
    if (grid_blocks == 0) {
        if (n_in != 20 || in_sizes[0] != MREAL * DM || out_size != MREAL * DM || ws_size < 256 * MiB) {
            fprintf(stderr, "kernel_launch: unexpected shapes: n_in %d in0 %d out %d ws %zu\n", n_in, n_in > 0 ? in_sizes[0] : -1, out_size, ws_size); grid_blocks = -1; return; }
        int dev = 0, cus = 0, per_cu = 0;
        (void)hipGetDevice(&dev); (void)hipDeviceGetAttribute(&cus, hipDeviceAttributeMultiprocessorCount, dev);
        if (hipFuncSetAttribute((const void*)fwd_kernel, hipFuncAttributeMaxDynamicSharedMemorySize, LDS_BYTES) != hipSuccess) { fprintf(stderr, "kernel_launch: hipFuncSetAttribute failed\n"); grid_blocks = -1; return; }
        if (hipOccupancyMaxActiveBlocksPerMultiprocessor(&per_cu, (const void*)fwd_kernel, NTHREADS, LDS_BYTES) != hipSuccess || per_cu < 1) { fprintf(stderr, "kernel_launch: occupancy query failed (%d)\n", per_cu); grid_blocks = -1; return; }
        grid_blocks = cus * per_cu;
    }
    if (grid_blocks < 0) return;
    Params p{};
    p.x = (const float*)d_in[0]; p.meta = (const float*)d_in[1]; p.g_mix = (const float*)d_in[2]; p.w_in = (const float*)d_in[3];
    p.lq1 = (const float*)d_in[4]; p.lk1 = (const float*)d_in[5]; p.lq2 = (const float*)d_in[6]; p.lk2 = (const float*)d_in[7];
    p.g_subln = (const float*)d_in[8]; p.g_qnorm = (const float*)d_in[9]; p.g_knorm = (const float*)d_in[10];
    p.w_ba = (const float*)d_in[11]; p.w_bb = (const float*)d_in[12]; p.w_out = (const float*)d_in[13]; p.g_ffn = (const float*)d_in[14];
    p.w_router = (const float*)d_in[15]; p.w_gate = (const float*)d_in[16]; p.w_up = (const float*)d_in[17]; p.w_down = (const float*)d_in[18]; p.g_final = (const float*)d_in[19];
    p.out = (float*)d_out; p.ws = (unsigned char*)d_ws;
    void* args[] = {&p};
    hipError_t e = hipLaunchCooperativeKernel((const void*)fwd_kernel, dim3(grid_blocks), dim3(NTHREADS), args, LDS_BYTES, stream);
    if (e != hipSuccess) fprintf(stderr, "kernel_launch: cooperative launch failed: %s (grid %d)\n", hipGetErrorString(e), grid_blocks);
}
```

```cpp
#include <hip/hip_runtime.h>
#include <hip/hip_cooperative_groups.h>
#include <cstdio>
#include <cstdint>
namespace cg = cooperative_groups;

typedef unsigned short bf16_t;
typedef float f32x4 __attribute__((ext_vector_type(4)));
typedef unsigned u32x2 __attribute__((ext_vector_type(2)));
typedef unsigned u32x4 __attribute__((ext_vector_type(4)));

constexpr int NB = 2, SEQ = 8192, DM = 1024, NMETA = 16, LTOT = SEQ + NMETA;
constexpr int MREAL = NB * SEQ;
constexpr int MROWS = MREAL + NB * NMETA;
constexpr int MPAD = 16640;
constexpr int INW = 6656;
constexpr int KEYS = 8256;
constexpr int QROWS = 8256;
constexpr int NEXP = 16, EFF = 512, CAP = 1026, ESLOTS = NB * CAP;
constexpr float EPS = 1e-6f;
constexpr float LOG2E = 1.4426950408889634f;
constexpr float CA = 0.125f * LOG2E;
constexpr float CB = 0.08838834764831845f * LOG2E;
constexpr float LAM_INIT = 0.2f;
constexpr int NTHREADS = 512;
constexpr int AOP = 2048;
__device__ const float INVF[32] = {1.000000000e+00f, 7.498942614e-01f, 5.623413324e-01f, 4.216965139e-01f, 3.162277639e-01f, 2.371373773e-01f, 1.778279394e-01f, 1.333521307e-01f,
    1.000000015e-01f, 7.498941571e-02f, 5.623413250e-02f, 4.216965288e-02f, 3.162277490e-02f, 2.371373773e-02f, 1.778279431e-02f, 1.333521493e-02f,
    9.999999776e-03f, 7.498941850e-03f, 5.623413250e-03f, 4.216964822e-03f, 3.162277630e-03f, 2.371373586e-03f, 1.778279431e-03f, 1.333521446e-03f,
    1.000000047e-03f, 7.498942432e-04f, 5.623413017e-04f, 4.216965172e-04f, 3.162277571e-04f, 2.371373703e-04f, 1.778279402e-04f, 1.333521504e-04f};

constexpr size_t MiB = 1u << 20;
constexpr size_t OFF_ROPE = 0;
constexpr size_t OFF_LAM = 64 * 1024;
constexpr size_t OFF_AFF = 128 * 1024;
constexpr size_t OFF_IDX = OFF_AFF + (size_t)NB * NEXP * LTOT * 4 + 256;
constexpr size_t OFF_SEL = OFF_IDX + (size_t)NB * NEXP * CAP * 4 + 256;
constexpr size_t OFF_SGM = OFF_SEL + (size_t)NB * LTOT * NEXP * 4 + 256;
constexpr size_t OFF_H2M = OFF_SGM + 32 * 2048 * 2;
constexpr size_t OFF_SAFF = OFF_H2M + 32 * 1024 * 4;
constexpr size_t OFF_MISC_END = OFF_SAFF + (size_t)NEXP * ESLOTS * 4;
static_assert(OFF_MISC_END <= 4 * MiB, "misc region");
constexpr size_t OFF_WIN = 4 * MiB;
constexpr size_t OFF_WAB = OFF_WIN + (size_t)INW * DM * 2;
constexpr size_t OFF_WO = OFF_WAB + (size_t)DM * 2048 * 2;
static_assert(OFF_WO + (size_t)DM * DM * 2 <= 24 * MiB, "weights region");
constexpr size_t OFF_AO = 24 * MiB;
constexpr size_t SZ_ROWS = (size_t)MPAD * DM * 2;
constexpr size_t OFF_UN = OFF_AO;
constexpr size_t OFF_HID = OFF_AO + SZ_ROWS;
static_assert((size_t)(NEXP * ESLOTS + 256) * EFF * 2 <= SZ_ROWS, "HID overlay");
constexpr size_t OFF_ATT = OFF_AO + 2 * SZ_ROWS;
constexpr size_t SZ_QH = (size_t)NB * 8 * QROWS * 128 * 2;
constexpr size_t SZ_KVB = (size_t)NB * 2 * KEYS * 128 * 2;
constexpr size_t OFF_QA = OFF_ATT, OFF_KA = OFF_QA + SZ_QH, OFF_VA = OFF_KA + SZ_QH, OFF_QB = OFF_VA + SZ_QH, OFF_KB = OFF_QB + SZ_QH, OFF_VB = OFF_KB + SZ_KVB;
constexpr size_t OFF_ATT_END = OFF_VB + SZ_KVB;
static_assert(OFF_ATT_END <= 256 * MiB, "workspace");
constexpr size_t OFF_MERGED = OFF_ATT;
constexpr size_t OFF_WGU = OFF_ATT + 33 * MiB;
constexpr size_t OFF_WD = OFF_WGU + 32 * MiB;
constexpr size_t OFF_XS = OFF_WD + 16 * MiB;
constexpr size_t OFF_YB = OFF_XS;
static_assert(SZ_ROWS <= 33 * MiB && OFF_XS + (size_t)(NEXP * ESLOTS + 256) * DM * 2 <= 256 * MiB, "overlay map");

struct Params {
    const float *x, *meta, *g_mix, *w_in, *lq1, *lk1, *lq2, *lk2, *g_subln, *g_qnorm, *g_knorm, *w_ba, *w_bb, *w_out, *g_ffn, *w_router, *w_gate, *w_up, *w_down, *g_final;
    float* out; unsigned char* ws;
};

__device__ __forceinline__ int TID() { int t = threadIdx.x; asm volatile("" : "+v"(t)); return t; }
__device__ __forceinline__ unsigned f2bf(float f) { unsigned u = __builtin_bit_cast(unsigned, f); return (u + 0x7fffu + ((u >> 16) & 1u)) >> 16; }
__device__ __forceinline__ float bf2f(unsigned h) { return __builtin_bit_cast(float, h << 16); }
__device__ __forceinline__ float wave_sum(float v) {
#pragma unroll
    for (int o = 1; o < 64; o <<= 1) v += __shfl_xor(v, o);
    return v;
}
__device__ __forceinline__ float wave_max(float v) {
#pragma unroll
    for (int o = 1; o < 64; o <<= 1) v = fmaxf(v, __shfl_xor(v, o));
    return v;
}
struct RowInfo { int b, t, meta, valid; };
__device__ __forceinline__ RowInfo row_decode(int r) {
    RowInfo ri;
    if (r < MREAL) { ri.b = r >> 13; ri.t = r & (SEQ - 1); ri.meta = 0; ri.valid = 1; }
    else if (r < MROWS) { ri.b = (r - MREAL) >> 4; ri.t = (r - MREAL) & 15; ri.meta = 1; ri.valid = 1; }
    else { ri.b = 0; ri.t = 0; ri.meta = 1; ri.valid = 0; }
    return ri;
}
__device__ __forceinline__ int row_key(const RowInfo& ri) { return ri.meta ? ri.t : 64 + ri.t; }
__device__ __forceinline__ int row_q(const RowInfo& ri) { return ri.meta ? SEQ + ri.t : ri.t; }
__device__ __forceinline__ int row_pos(const RowInfo& ri) { return ri.meta ? ri.t : NMETA + ri.t; }
__device__ __forceinline__ int pos_row(int b, int pos) { return pos < NMETA ? MREAL + b * NMETA + pos : b * SEQ + (pos - NMETA); }
__device__ __forceinline__ const float* h_row(const Params& p, int r) { RowInfo ri = row_decode(r); return ri.meta ? p.meta + (size_t)ri.t * DM : p.x + (size_t)r * DM; }

__device__ __forceinline__ void phase0(const Params& p, int vb, int nvb) {
    const int tid = TID(), lane = tid & 63, wave = tid >> 6;
    const int gt = vb * NTHREADS + tid;
    if (gt < 128 * 32) {
        const int pos = gt >> 5, j = gt & 31;
        const float ang = (float)pos * INVF[j];
        const double xd = (double)ang, kq = __builtin_rint(xd * 0.15915494309189535);
        const double rr = (xd - kq * 6.283185307179586) * 0.25, r2 = rr * rr;
        double sn = 1.0 / 1307674368000.0, cn = 1.0 / 87178291200.0;
        sn = sn * r2 * -1.0 + 1.0 / 6227020800.0; cn = cn * r2 * -1.0 + 1.0 / 479001600.0;
        sn = sn * r2 * -1.0 + 1.0 / 39916800.0;   cn = cn * r2 * -1.0 + 1.0 / 3628800.0;
        sn = sn * r2 * -1.0 + 1.0 / 362880.0;     cn = cn * r2 * -1.0 + 1.0 / 40320.0;
        sn = sn * r2 * -1.0 + 1.0 / 5040.0;       cn = cn * r2 * -1.0 + 1.0 / 720.0;
        sn = sn * r2 * -1.0 + 1.0 / 120.0;        cn = cn * r2 * -1.0 + 1.0 / 24.0;
        sn = sn * r2 * -1.0 + 1.0 / 6.0;          cn = cn * r2 * -1.0 + 0.5;
        sn = (sn * r2 * -1.0 + 1.0) * rr;         cn = cn * r2 * -1.0 + 1.0;
        double s2 = 2.0 * sn * cn, c2 = cn * cn - sn * sn;
        double s4 = 2.0 * s2 * c2, c4 = c2 * c2 - s2 * s2;
        float2 cs; cs.x = (float)c4; cs.y = (float)s4;
        ((float2*)(p.ws + OFF_ROPE))[gt] = cs;
    }
    if (vb == 0 && wave == 0) {
        float a = p.lq1[lane] * p.lk1[lane], c = p.lq2[lane] * p.lk2[lane];
        a = wave_sum(a); c = wave_sum(c);
        if (lane == 0) *(float*)(p.ws + OFF_LAM) = expf(a) - expf(c) + LAM_INIT;
    }
    bf16_t* UN = (bf16_t*)(p.ws + OFF_UN);
    for (int r = vb * 8 + wave; r < MPAD; r += nvb * 8) {
        u32x2* o = (u32x2*)(UN + (size_t)r * DM) + lane;
        if (r >= MROWS) {
#pragma unroll
            for (int j = 0; j < 4; ++j) o[64 * j] = (u32x2){0u, 0u};
            continue;
        }
        const f32x4* xr = (const f32x4*)h_row(p, r) + lane;
        f32x4 v[4]; float s = 0.f;
#pragma unroll
        for (int j = 0; j < 4; ++j) { v[j] = xr[64 * j]; s += (v[j].x * v[j].x + v[j].y * v[j].y) + (v[j].z * v[j].z + v[j].w * v[j].w); }
        const float rstd = 1.0f / sqrtf(wave_sum(s) * (1.0f / DM) + EPS);
#pragma unroll
        for (int j = 0; j < 4; ++j) {
            const f32x4 g = ((const f32x4*)p.g_mix)[lane + 64 * j];
            u32x2 w; w.x = f2bf(v[j].x * rstd * g.x) | (f2bf(v[j].y * rstd * g.y) << 16); w.y = f2bf(v[j].z * rstd * g.z) | (f2bf(v[j].w * rstd * g.w) << 16);
            o[64 * j] = w;
        }
    }
    {
        bf16_t* KA = (bf16_t*)(p.ws + OFF_KA); bf16_t* VA = (bf16_t*)(p.ws + OFF_VA); bf16_t* KB = (bf16_t*)(p.ws + OFF_KB); bf16_t* VB = (bf16_t*)(p.ws + OFF_VB);
        const int per = 48 * 128 / 8;
        for (int i = vb * NTHREADS + tid; i < (16 + 16 + 4 + 4) * per; i += nvb * NTHREADS) {
            const int bh = i / per, o = i % per; bf16_t* base;
            if (bh < 16) base = KA + (size_t)bh * KEYS * 128; else if (bh < 32) base = VA + (size_t)(bh - 16) * KEYS * 128;
            else if (bh < 36) base = KB + (size_t)(bh - 32) * KEYS * 128; else base = VB + (size_t)(bh - 36) * KEYS * 128;
            ((u32x4*)(base + 16 * 128))[o] = (u32x4){0u, 0u, 0u, 0u};
        }
    }
}

namespace fa {
using bf16x8 = __attribute__((ext_vector_type(8))) short;
using s16x4  = __attribute__((ext_vector_type(4))) short;
using f32x16 = __attribute__((ext_vector_type(16))) float;
constexpr int NT = KEYS / 64;
constexpr int SHM_V = 16384, SHM_K = 16384;
constexpr int L_V = 0, L_K = 2 * SHM_V, L_WS = L_K + 2 * SHM_K, L_X = L_WS + 8 * 64 * 4;
constexpr int LDS_ATTN = L_X + 8 * 8704;
constexpr float THR = 8.f;
#define KSWZ(row, colB) ((row) * 256 + ((colB) ^ (((row) & 7) << 4)))
#define SBAR() __builtin_amdgcn_sched_barrier(0)
__device__ __forceinline__ int crow(int r, int hi) { return (r & 3) + 8 * (r >> 2) + 4 * hi; }
__device__ __forceinline__ unsigned cvtpk(float lo, float hi) { unsigned r; asm volatile("v_cvt_pk_bf16_f32 %0, %1, %2" : "=v"(r) : "v"(lo), "v"(hi)); return r; }
__device__ __forceinline__ void partialSM(f32x16& p0, f32x16& p1, float& m_reg, float& mn, float& alpha) {
    float pmax = p0[0];
#pragma unroll
    for (int r = 1; r < 16; ++r) pmax = fmaxf(pmax, p0[r]);
#pragma unroll
    for (int r = 0; r < 16; ++r) pmax = fmaxf(pmax, p1[r]);
    { auto rr = __builtin_amdgcn_permlane32_swap(__float_as_uint(pmax), __float_as_uint(pmax), false, false);
      pmax = fmaxf(__uint_as_float(rr[0]), __uint_as_float(rr[1])); }
    if (__builtin_expect(__all(pmax - m_reg <= THR), 1)) { mn = m_reg; alpha = 1.f; }
    else { mn = fmaxf(m_reg, pmax); alpha = __builtin_amdgcn_exp2f(m_reg - mn); m_reg = mn; }
#pragma unroll
    for (int r = 0; r < 16; ++r) { p0[r] -= mn; p1[r] -= mn; }
#pragma unroll
    for (int r = 0; r < 16; ++r) p0[r] = __builtin_amdgcn_exp2f(p0[r]);
}
__device__ __forceinline__ void finishSM(f32x16& p0, f32x16& p1, float alpha, float& l_reg, bf16x8& pa0, bf16x8& pa1, bf16x8& pa2, bf16x8& pa3) {
#pragma unroll
    for (int r = 0; r < 16; ++r) p1[r] = __builtin_amdgcn_exp2f(p1[r]);
    float ps = 0;
#pragma unroll
    for (int r = 0; r < 16; ++r) ps += p0[r];
#pragma unroll
    for (int r = 0; r < 16; ++r) ps += p1[r];
    { auto rr = __builtin_amdgcn_permlane32_swap(__float_as_uint(ps), __float_as_uint(ps), false, false);
      ps = __uint_as_float(rr[0]) + __uint_as_float(rr[1]); }
    l_reg = l_reg * alpha + ps;
#define PK4(P, BASE, OUT) do { unsigned a0 = cvtpk(P[BASE + 0], P[BASE + 1]), a1 = cvtpk(P[BASE + 2], P[BASE + 3]);   \
    unsigned b0 = cvtpk(P[BASE + 4], P[BASE + 5]), b1 = cvtpk(P[BASE + 6], P[BASE + 7]);                              \
    auto r0 = __builtin_amdgcn_permlane32_swap(a0, b0, false, false); auto r1 = __builtin_amdgcn_permlane32_swap(a1, b1, false, false); \
    u32x4 w = {r0[0], r1[0], r0[1], r1[1]}; OUT = *reinterpret_cast<bf16x8*>(&w); } while (0)
    PK4(p0, 0, pa0); PK4(p0, 8, pa1); PK4(p1, 0, pa2); PK4(p1, 8, pa3);
#undef PK4
}
template <int ND0>
__device__ __forceinline__ void qkt(f32x16& p0, f32x16& p1, const char* Ks, const bf16x8* qr, int d0b, int r32, int hi) {
    p0 = f32x16{}; p1 = f32x16{};
#pragma unroll
    for (int d0 = 0; d0 < ND0; ++d0) { const int cb = ((d0b + d0) * 16 + hi * 8) * 2;
        const bf16x8 b0 = *reinterpret_cast<const bf16x8*>(Ks + KSWZ(r32, cb));
        const bf16x8 b1 = *reinterpret_cast<const bf16x8*>(Ks + KSWZ(32 + r32, cb));
        p0 = __builtin_amdgcn_mfma_f32_32x32x16_bf16(b0, qr[d0], p0, 0, 0, 0);
        p1 = __builtin_amdgcn_mfma_f32_32x32x16_bf16(b1, qr[d0], p1, 0, 0, 0); }
}
__device__ __forceinline__ int v_st(int k, int c) { const int kk = (k & ~0xC) | ((k & 4) << 1) | ((k & 8) >> 1); return ((kk >> 3) * 4 + (c >> 5)) * 512 + ((kk & 7) * 32 + (c & 31)) * 2; }
__device__ __forceinline__ int v_rd_base(int lane) { return ((lane & 3) << 3) | (((lane >> 2) & 3) << 6) | (((lane >> 4) & 1) << 5) | (((lane >> 5) & 1) << 8); }
constexpr int v_rd_off(int d0, int ks, int half) { return d0 * 512 + ks * 4096 + half * 2048; }
template <int OFF> __device__ __forceinline__ s16x4 tr_read(int vb) {
    s16x4 r; asm volatile("ds_read_b64_tr_b16 %0, %1 offset:%2" : "=&v"(r) : "v"(vb), "i"(OFF) : "memory"); return r;
}
template <int D0> __device__ __forceinline__ void pv_one(f32x16& od, int vb, bf16x8 pa0, bf16x8 pa1, bf16x8 pa2, bf16x8 pa3) {
    const s16x4 l0 = tr_read<v_rd_off(D0, 0, 0)>(vb), h0 = tr_read<v_rd_off(D0, 0, 1)>(vb), l1 = tr_read<v_rd_off(D0, 1, 0)>(vb), h1 = tr_read<v_rd_off(D0, 1, 1)>(vb);
    const s16x4 l2 = tr_read<v_rd_off(D0, 2, 0)>(vb), h2 = tr_read<v_rd_off(D0, 2, 1)>(vb), l3 = tr_read<v_rd_off(D0, 3, 0)>(vb), h3 = tr_read<v_rd_off(D0, 3, 1)>(vb);
    asm volatile("s_waitcnt lgkmcnt(0)" ::: "memory"); SBAR();
#define PK(L, H) (bf16x8){L[0], L[1], L[2], L[3], H[0], H[1], H[2], H[3]}
    od = __builtin_amdgcn_mfma_f32_32x32x16_bf16(pa0, PK(l0, h0), od, 0, 0, 0);
    od = __builtin_amdgcn_mfma_f32_32x32x16_bf16(pa1, PK(l1, h1), od, 0, 0, 0);
    od = __builtin_amdgcn_mfma_f32_32x32x16_bf16(pa2, PK(l2, h2), od, 0, 0, 0);
    od = __builtin_amdgcn_mfma_f32_32x32x16_bf16(pa3, PK(l3, h3), od, 0, 0, 0);
#undef PK
}
__device__ __forceinline__ void pv_d0(f32x16* o, int vb, bf16x8 pa0, bf16x8 pa1, bf16x8 pa2, bf16x8 pa3) {
    pv_one<0>(o[0], vb, pa0, pa1, pa2, pa3); pv_one<1>(o[1], vb, pa0, pa1, pa2, pa3); pv_one<2>(o[2], vb, pa0, pa1, pa2, pa3); pv_one<3>(o[3], vb, pa0, pa1, pa2, pa3);
}

template <bool DIFF>
__device__ __forceinline__ void attn_unit(const bf16_t* __restrict__ Qlane, const bf16_t* __restrict__ Kh, const bf16_t* __restrict__ Vh, int tq, float slopeL, char* lds, f32x16 (&o)[4], float& l_reg) {
    constexpr int ND0 = DIFF ? 4 : 8;
    const int tid = TID(), wid = tid >> 6, lane = tid & 63, r32 = lane & 31, hi = lane >> 5;
    char* V_lds = lds + L_V; char* K_lds = lds + L_K;
    float* al_l = (float*)(lds + L_WS) + wid * 64 + 32;
    const int d0b = DIFF ? (wid >> 2) * 4 : 0;
    float m_reg = -1e30f; l_reg = 0.f;
#pragma unroll
    for (int d = 0; d < 4; ++d) o[d] = f32x16{};
    bf16x8 qr[ND0];
#pragma unroll
    for (int d0 = 0; d0 < ND0; ++d0) qr[d0] = *reinterpret_cast<const bf16x8*>(Qlane + d0 * 16 + hi * 8);
    const int sr = tid >> 4, sc = (tid & 15) * 8, vst0 = v_st(sr, sc), vst1 = v_st(32 + sr, sc);
    const int vb0 = (int)(uintptr_t)V_lds + v_rd_base(lane);
    struct { bf16x8 vs0, vs1, ks0, ks1; } st_[1];
#define SLOAD(i, k0) do { st_[i].vs0 = *(const bf16x8*)(&Vh[(size_t)((k0) + sr) * 128 + sc]); st_[i].vs1 = *(const bf16x8*)(&Vh[(size_t)((k0) + 32 + sr) * 128 + sc]); \
    st_[i].ks0 = *(const bf16x8*)(&Kh[(size_t)((k0) + sr) * 128 + sc]); st_[i].ks1 = *(const bf16x8*)(&Kh[(size_t)((k0) + 32 + sr) * 128 + sc]); } while (0)
#define SWRITE(b, i) do { *(bf16x8*)(V_lds + (b) * SHM_V + vst0) = st_[i].vs0; *(bf16x8*)(V_lds + (b) * SHM_V + vst1) = st_[i].vs1; const int kc = sc * 2; \
    *(bf16x8*)(K_lds + (b) * SHM_K + KSWZ(sr, kc)) = st_[i].ks0; *(bf16x8*)(K_lds + (b) * SHM_K + KSWZ(32 + sr, kc)) = st_[i].ks1; } while (0)
#define RESC(a) do { if (__any((a) < 1.f)) { if (hi == 0) al_l[r32] = (a); asm volatile("s_waitcnt lgkmcnt(0)" ::: "memory"); \
    _Pragma("unroll") for (int d = 0; d < 4; ++d) _Pragma("unroll") for (int r = 0; r < 16; ++r) o[d][r] *= al_l[crow(r, hi)]; } } while (0)
#define BIAS(P0, P1, j) do { if (DIFF) { const float base_ = (float)(tq - ((j) - 1) * 64 - 4 * hi); \
    _Pragma("unroll") for (int r = 0; r < 16; ++r) { const float d_ = base_ - (float)((r & 3) + 8 * (r >> 2)); \
        P0[r] = fmaf(-slopeL, fabsf(d_), P0[r]); P1[r] = fmaf(-slopeL, fabsf(d_ - 32.f), P1[r]); } } } while (0)
    f32x16 pA0, pA1, pB0, pB1; float mnA, mnB, alA, alB; bf16x8 pa0, pa1, pa2, pa3;
    SLOAD(0, 0); asm volatile("s_waitcnt vmcnt(0)" ::: "memory"); SWRITE(0, 0); __syncthreads();
    qkt<ND0>(pA0, pA1, K_lds, qr, d0b, r32, hi);
#pragma unroll
    for (int r = 8; r < 16; ++r) pA0[r] = -1e30f;
#pragma unroll
    for (int r = 0; r < 16; ++r) pA1[r] = -1e30f;
    partialSM(pA0, pA1, m_reg, mnA, alA);
    SLOAD(0, 64);
    SWRITE(1, 0); __syncthreads();
    for (int j = 1; j + 1 < NT; j += 2) {
        SBAR(); qkt<ND0>(pB0, pB1, K_lds + SHM_K, qr, d0b, r32, hi); BIAS(pB0, pB1, j);
        finishSM(pA0, pA1, alA, l_reg, pa0, pa1, pa2, pa3); SBAR();
        SLOAD(0, (j + 1) * 64); SBAR();
        pv_d0(o, vb0, pa0, pa1, pa2, pa3); partialSM(pB0, pB1, m_reg, mnB, alB);
        __syncthreads(); SWRITE(0, 0);
        RESC(alB); __syncthreads();
        SBAR(); qkt<ND0>(pA0, pA1, K_lds, qr, d0b, r32, hi); BIAS(pA0, pA1, j + 1);
        finishSM(pB0, pB1, alB, l_reg, pa0, pa1, pa2, pa3); SBAR();
        if (j + 2 < NT) SLOAD(0, (j + 2) * 64); SBAR();
        pv_d0(o, vb0 + SHM_V, pa0, pa1, pa2, pa3); partialSM(pA0, pA1, m_reg, mnA, alA);
        __syncthreads(); if (j + 2 < NT) { SWRITE(1, 0); }
        RESC(alA); __syncthreads();
    }
    finishSM(pA0, pA1, alA, l_reg, pa0, pa1, pa2, pa3); SBAR();
    pv_d0(o, vb0, pa0, pa1, pa2, pa3);
    asm volatile("s_waitcnt lgkmcnt(0)" ::: "memory");
#undef SLOAD
#undef SWRITE
#undef RESC
#undef BIAS
}

template <class RowPtr>
__device__ __forceinline__ void store_tile(const f32x16 (&y)[4], char* stage, int lane, RowPtr rowptr) {
    const int r32 = lane & 31, hi = lane >> 5;
    bf16_t* stg = (bf16_t*)stage;
#pragma unroll
    for (int r = 0; r < 16; ++r) { const int orow = crow(r, hi);
#pragma unroll
        for (int d0 = 0; d0 < 4; ++d0) stg[orow * 136 + d0 * 32 + r32] = (bf16_t)f2bf(y[d0][r]); }
    asm volatile("s_waitcnt lgkmcnt(0)" ::: "memory");
#pragma unroll
    for (int i = 0; i < 8; ++i) { const int row = i * 4 + (lane >> 4), ch = lane & 15;
        const u32x4 v = *(const u32x4*)(stg + row * 136 + ch * 8);
        bf16_t* gp = rowptr(row); if (gp) *(u32x4*)(gp + ch * 8) = v; }
    asm volatile("s_waitcnt lgkmcnt(0)" ::: "memory");
}
}

__device__ __forceinline__ void phase2_fast(const Params& p, char* lds, int vb, int nvb) {
    using namespace fa;
    const int tid = TID(), wid = __builtin_amdgcn_readfirstlane(tid >> 6), lane0 = tid & 63;
    const bf16_t *QA = (const bf16_t*)(p.ws + OFF_QA), *KA = (const bf16_t*)(p.ws + OFF_KA), *VA = (const bf16_t*)(p.ws + OFF_VA);
    const bf16_t *QB = (const bf16_t*)(p.ws + OFF_QB), *KB = (const bf16_t*)(p.ws + OFF_KB), *VB = (const bf16_t*)(p.ws + OFF_VB);
    bf16_t* OA = (bf16_t*)(p.ws + OFF_AO); bf16_t* OB = OA + 1024;
    const float lam = *(const float*)(p.ws + OFF_LAM);
    float* li_l = (float*)(lds + L_WS) + wid * 64;
    constexpr int NU_B = NB * 8 * 33, NU_A = NB * 8 * 65;
    for (int u = vb; u < NU_B + NU_A; u += nvb) {
        f32x16 o[4]; float l_reg;
        if (u < NU_B) {
            const int bh = u / 33, qb = u % 33, b = bh >> 3, h = bh & 7;
            const bool is_meta = qb == 32;
            { const int r32q = lane0 & 31; const bool rvalid = !is_meta || (wid == 0 && r32q < 16);
              const int qrow = is_meta ? (rvalid ? SEQ + r32q : SEQ) : qb * 256 + wid * 32 + r32q;
              const size_t kvo = (size_t)(b * 2 + (h >> 2)) * KEYS * 128;
              attn_unit<false>(QB + ((size_t)bh * QROWS + qrow) * 128, KB + kvo, VB + kvo, 0, 0.f, lds, o, l_reg); }
            int lane = lane0; asm volatile("" : "+v"(lane));
            const int r32 = lane & 31, hi = lane >> 5;
            if (hi == 0) li_l[r32] = l_reg;
            asm volatile("s_waitcnt lgkmcnt(0)" ::: "memory");
#pragma unroll
            for (int r = 0; r < 16; ++r) { const float rl = __builtin_amdgcn_rcpf(li_l[crow(r, hi)]);
#pragma unroll
                for (int d = 0; d < 4; ++d) o[d][r] *= rl; }
            const int wave_row0 = is_meta ? 0 : qb * 256 + wid * 32;
            store_tile(o, lds + L_X + wid * 8704, lane, [&](int row) -> bf16_t* {
                if (is_meta) { if (wid != 0 || row >= 16) return nullptr; return OB + (size_t)(MREAL + b * NMETA + row) * AOP + h * 128; }
                return OB + (size_t)(b * SEQ + wave_row0 + row) * AOP + h * 128; });
            __syncthreads();
        } else {
            const int ua = u - NU_B, bh = ua / 65, qb = ua % 65, b = bh >> 3, h = bh & 7, mp = wid >> 2, wq = wid & 3;
            const bool is_meta = qb == 64;
            { const int r32q = lane0 & 31; const bool rvalid = !is_meta || (wq == 0 && r32q < 16);
              const int qrow = is_meta ? (rvalid ? SEQ + r32q : SEQ) : qb * 128 + wq * 32 + r32q;
              const float slopeL = is_meta ? 0.f : exp2f(-(float)(h + 1)) * LOG2E;
              const size_t kvo = (size_t)bh * KEYS * 128;
              attn_unit<true>(QA + ((size_t)bh * QROWS + qrow) * 128 + mp * 64, KA + kvo, VA + kvo, qrow, slopeL, lds, o, l_reg); }
            int lane = lane0; asm volatile("" : "+v"(lane));
            const int r32 = lane & 31, hi = lane >> 5;
            if (hi == 0) li_l[r32] = l_reg;
            asm volatile("s_waitcnt lgkmcnt(0)" ::: "memory");
#pragma unroll
            for (int r = 0; r < 16; ++r) { const float rl = __builtin_amdgcn_rcpf(li_l[crow(r, hi)]);
#pragma unroll
                for (int d = 0; d < 4; ++d) o[d][r] *= rl; }
            float* X = (float*)(lds + L_X) + wq * 4096;
            if (mp == 1) {
#pragma unroll
                for (int r = 0; r < 16; ++r)
#pragma unroll
                    for (int d = 0; d < 4; ++d) X[(r * 4 + d) * 64 + lane] = o[d][r];
            }
            __syncthreads();
            if (mp == 0) {
                float ss[16];
#pragma unroll
                for (int r = 0; r < 16; ++r) { float a = 0.f;
#pragma unroll
                    for (int d = 0; d < 4; ++d) { const float y = o[d][r] - lam * X[(r * 4 + d) * 64 + lane]; o[d][r] = y; a += y * y; }
                    ss[r] = a; }
#pragma unroll
                for (int r = 0; r < 16; ++r) {
                    float a = ss[r];
                    a += __shfl_xor(a, 1); a += __shfl_xor(a, 2); a += __shfl_xor(a, 4); a += __shfl_xor(a, 8); a += __shfl_xor(a, 16);
                    ss[r] = 1.0f / sqrtf(a * (1.0f / 128.f) + EPS) * (1.0f - LAM_INIT);
                }
                float g[4];
#pragma unroll
                for (int d = 0; d < 4; ++d) g[d] = p.g_subln[d * 32 + r32];
#pragma unroll
                for (int r = 0; r < 16; ++r)
#pragma unroll
                    for (int d = 0; d < 4; ++d) o[d][r] *= ss[r] * g[d];
            }
            __syncthreads();
            if (mp == 0) {
                const int wave_row0 = is_meta ? 0 : qb * 128 + wq * 32;
                store_tile(o, lds + L_X + wid * 8704, lane, [&](int row) -> bf16_t* {
                    if (is_meta) { if (wq != 0 || row >= 16) return nullptr; return OA + (size_t)(MREAL + b * NMETA + row) * AOP + h * 128; }
                    return OA + (size_t)(b * SEQ + wave_row0 + row) * AOP + h * 128; });
            }
            __syncthreads();
        }
    }
}

__device__ __forceinline__ float* h2_row(const Params& p, int grow) { return grow < MREAL ? p.out + (size_t)grow * DM : (float*)(p.ws + OFF_H2M) + (size_t)(grow - MREAL) * DM; }
__device__ __forceinline__ void phase4a(const Params& p, float* lds, int vb, int nvb) {
    const int tid = TID(), lane = tid & 63, wave = tid >> 6;
    for (int i = tid; i < DM * NEXP; i += NTHREADS) { const int k = i >> 4, e = i & 15; lds[e * DM + k] = p.w_router[i]; }
    __syncthreads();
    bf16_t* U2 = (bf16_t*)(p.ws + OFF_UN); float* AFF = (float*)(p.ws + OFF_AFF);
    for (int r = vb * 8 + wave; r < MROWS; r += nvb * 8) {
        const RowInfo ri = row_decode(r);
        const f32x4* xr = (const f32x4*)h2_row(p, r) + lane;
        f32x4 v[4]; float s = 0.f;
#pragma unroll
        for (int j = 0; j < 4; ++j) { v[j] = xr[64 * j]; s += (v[j].x * v[j].x + v[j].y * v[j].y) + (v[j].z * v[j].z + v[j].w * v[j].w); }
        const float rstd = 1.0f / sqrtf(wave_sum(s) * (1.0f / DM) + EPS);
        u32x2* o = (u32x2*)(U2 + (size_t)r * DM) + lane;
#pragma unroll
        for (int j = 0; j < 4; ++j) {
            const f32x4 g = ((const f32x4*)p.g_ffn)[lane + 64 * j];
            v[j].x *= rstd * g.x; v[j].y *= rstd * g.y; v[j].z *= rstd * g.z; v[j].w *= rstd * g.w;
            u32x2 w; w.x = f2bf(v[j].x) | (f2bf(v[j].y) << 16); w.y = f2bf(v[j].z) | (f2bf(v[j].w) << 16);
            o[64 * j] = w;
        }
        float mylg = -1e30f;
#pragma unroll 1
        for (int e = 0; e < NEXP; ++e) {
            float a = 0.f;
#pragma unroll
            for (int j = 0; j < 4; ++j) { const f32x4 w = *(const f32x4*)(lds + e * DM + 4 * (lane + 64 * j)); a += v[j].x * w.x + v[j].y * w.y + v[j].z * w.z + v[j].w * w.w; }
            a = wave_sum(a);
            if (lane == e) mylg = a;
        }
        const float mx = wave_max(mylg);
        const float ex = lane < NEXP ? expf(mylg - mx) : 0.f;
        const float mine = ex / wave_sum(ex);
        if (lane < NEXP) AFF[((size_t)ri.b * NEXP + lane) * LTOT + row_pos(ri)] = mine;
    }
    __syncthreads();
}

__device__ __forceinline__ void phase6(const Params& p, int vb, int nvb) {
    const int tid = TID(), lane = tid & 63, wave = tid >> 6;
    const int* SEL = (const int*)(p.ws + OFF_SEL); const bf16_t* YB = (const bf16_t*)(p.ws + OFF_YB);
    for (int r = vb * 8 + wave; r < MREAL; r += nvb * 8) {
        const int b = r >> 13, tok = NMETA + (r & (SEQ - 1));
        f32x4* xr = (f32x4*)(p.out + (size_t)r * DM) + lane;
        f32x4 v[4];
#pragma unroll
        for (int j = 0; j < 4; ++j) v[j] = xr[64 * j];
        const int sel = lane < NEXP ? SEL[((size_t)b * LTOT + tok) * NEXP + lane] : -1;
        for (int e = 0; e < NEXP; ++e) {
            const int c = __shfl(sel, e);
            if (c >= 0) {
                const u32x2* y = (const u32x2*)(YB + ((size_t)e * ESLOTS + b * CAP + c) * DM) + lane;
#pragma unroll
                for (int j = 0; j < 4; ++j) { const u32x2 w = y[64 * j]; v[j].x += bf2f(w.x & 0xffffu); v[j].y += bf2f(w.x >> 16); v[j].z += bf2f(w.y & 0xffffu); v[j].w += bf2f(w.y >> 16); }
            }
        }
        float s = 0.f;
#pragma unroll
        for (int j = 0; j < 4; ++j) s += (v[j].x * v[j].x + v[j].y * v[j].y) + (v[j].z * v[j].z + v[j].w * v[j].w);
        const float rstd = 1.0f / sqrtf(wave_sum(s) * (1.0f / DM) + EPS);
#pragma unroll
        for (int j = 0; j < 4; ++j) { const f32x4 g = ((const f32x4*)p.g_final)[lane + 64 * j]; xr[64 * j] = (f32x4){v[j].x * rstd * g.x, v[j].y * rstd * g.y, v[j].z * rstd * g.z, v[j].w * rstd * g.w}; }
    }
}

template <class DstRow>
__device__ __forceinline__ void transpose_item(const float* __restrict__ W, int N, bf16_t* __restrict__ WT, int ldk, int koff, float* scr, int k0, int n0, int lane, DstRow dst) {
#pragma unroll 8
    for (int i = 0; i < 32; ++i) { const int kk = 2 * i + (lane >> 5); scr[kk * 33 + (lane & 31)] = W[(size_t)(k0 + kk) * N + n0 + (lane & 31)]; }
    asm volatile("s_waitcnt vmcnt(0) lgkmcnt(0)" ::: "memory");
    const int c = lane & 7;
#pragma unroll
    for (int j = 0; j < 4; ++j) { const int n = (lane >> 3) + 8 * j; const float* sp = scr + (8 * c) * 33 + n;
        u32x4 o; o.x = f2bf(sp[0 * 33]) | (f2bf(sp[1 * 33]) << 16); o.y = f2bf(sp[2 * 33]) | (f2bf(sp[3 * 33]) << 16);
        o.z = f2bf(sp[4 * 33]) | (f2bf(sp[5 * 33]) << 16); o.w = f2bf(sp[6 * 33]) | (f2bf(sp[7 * 33]) << 16);
        *(u32x4*)(WT + (size_t)dst(n0 + n) * ldk + koff + k0 + 8 * c) = o; }
    asm volatile("s_waitcnt lgkmcnt(0)" ::: "memory");
}
__device__ __forceinline__ int rope_slot(int e) { const int half = e >> 6, el = e & 63, j = el & 31, n = el >> 5, g = half * 8 + (j >> 2); return 32 * (g >> 2) + 8 * (g & 3) + 4 * n + (j & 3); }
__device__ __forceinline__ void transpose_p0(const Params& p, float* lds, int vb, int nvb) {
    const int tid = TID(), lane = tid & 63, wave = tid >> 6;
    float* scr = lds + wave * (64 * 33);
    bf16_t* WIN = (bf16_t*)(p.ws + OFF_WIN); bf16_t* WAB = (bf16_t*)(p.ws + OFF_WAB); bf16_t* WO = (bf16_t*)(p.ws + OFF_WO);
    constexpr int I_IN = 16 * (INW / 32), I_SQ = 16 * 32;
    for (int it = vb * 8 + wave; it < I_IN + 3 * I_SQ; it += nvb * 8) {
        int r = it;
        if (r < I_IN) { const int kb = r / (INW / 32), nb = r % (INW / 32);
            transpose_item(p.w_in, INW, WIN, DM, 0, scr, kb * 64, nb * 32, lane, [](int n) { return (n >= 3072 && n < 4352) ? (n & ~127) + rope_slot(n & 127) : n; }); continue; }
        r -= I_IN; const int m = r / I_SQ, q = r % I_SQ, kb = q / 32, nb = q % 32;
        if (m == 0) transpose_item(p.w_ba, DM, WAB, 2048, 0, scr, kb * 64, nb * 32, lane, [](int n) { return n; });
        else if (m == 1) transpose_item(p.w_bb, DM, WAB, 2048, 1024, scr, kb * 64, nb * 32, lane, [](int n) { return n; });
        else transpose_item(p.w_out, DM, WO, DM, 0, scr, kb * 64, nb * 32, lane, [](int n) { return n; });
    }
}
__device__ __forceinline__ void transpose_moe(const Params& p, float* lds, int vbl, int nvbl) {
    const int tid = TID(), lane = tid & 63, wave = tid >> 6;
    float* scr = lds + wave * (64 * 33);
    bf16_t* WGU = (bf16_t*)(p.ws + OFF_WGU); bf16_t* WD = (bf16_t*)(p.ws + OFF_WD);
    constexpr int I_G = 16 * 16, I_D = 8 * 32, I_E = 2 * I_G + I_D;
    for (int it = vbl * 8 + wave; it < NEXP * I_E; it += nvbl * 8) {
        const int e = it / I_E; int r = it % I_E;
        if (r < 2 * I_G) { const int up = r / I_G, q = r % I_G, kb = q / 16, nb = q % 16;
            const float* W = (up ? p.w_up : p.w_gate) + (size_t)e * DM * EFF;
            transpose_item(W, EFF, WGU + (size_t)e * DM * DM, DM, 0, scr, kb * 64, nb * 32, lane, [up](int f) { return 8 * (f >> 2) + 4 * up + (f & 3); }); }
        else { r -= 2 * I_G; const int kb = r / 32, nb = r % 32;
            transpose_item(p.w_down + (size_t)e * EFF * DM, DM, WD + (size_t)e * DM * EFF, EFF, 0, scr, kb * 64, nb * 32, lane, [](int n) { return n; }); }
    }
}

namespace pg8 {
#define PG8_LAS __attribute__((address_space(3)))
typedef short bf16x8 __attribute__((ext_vector_type(8)));
constexpr int BM = 256, BK = 64, HALF = 128, HTB = HALF * BK * 2, STAGE_BYTES = 8 * HTB, NXCD = 8, WGM = 8;
__host__ __device__ __forceinline__ int lds_byte(int r, int c) { const int st = (r >> 4) * 2 + (c >> 5), rr = r & 15, cc = c & 31, ob = rr * 64 + cc * 2; return st * 1024 + (ob ^ (((ob >> 9) & 1) << 5)); }
__host__ __device__ __forceinline__ void stage_rc(int b, int& R, int& C) { const int st = b / 1024, sb = b % 1024, swz = sb ^ (((sb >> 9) & 1) << 5); R = (st >> 1) * 16 + swz / 64; C = (st & 1) * 32 + (swz % 64) / 2; }
__host__ __device__ __forceinline__ int perm32(int rho) { const int n = rho >> 4, i = rho & 15; return 8 * (i >> 2) + 4 * n + (i & 3); }
struct Unit { int arow0, brow0, pm, pn, e; };
struct Gemm { const bf16_t* A; const bf16_t* Bt; int K; };
struct GridOrder {
    int nM, nN, nwg, G, c;
    __device__ void init(int nM_, int nN_, int G_, int c_) { nM = nM_; nN = nN_; nwg = nM * nN; G = G_; c = c_; }
    __device__ bool next(int i, Unit& u) const {
        const long L = (long)i * G + c; if (L >= nwg) return false;
        int wgid = (int)L; { const int q = nwg / NXCD, r = nwg % NXCD, xcd = wgid % NXCD, off = wgid / NXCD; wgid = (xcd < r ? xcd * (q + 1) : r * (q + 1) + (xcd - r) * q) + off; }
        const int nig = WGM * nN, gid = wgid / nig, fm = gid * WGM, gsz = (nM - fm) < WGM ? (nM - fm) : WGM;
        u.pm = fm + ((wgid % nig) % gsz); u.pn = (wgid % nig) / gsz; u.e = 0; u.arow0 = u.pm * BM; u.brow0 = u.pn * BM; return true;
    }
};
struct MoeOrder {
    int G, c;
    __device__ bool next(int i, Unit& u) const {
        const int L = i * G + c; if (L >= NEXP * 36) return false;
        u.e = L / 36; const int r = L % 36; u.pm = r % 9; u.pn = r / 9; u.arow0 = u.e * ESLOTS + u.pm * BM; u.brow0 = u.e * DM + u.pn * BM; return true;
    }
};
__device__ __forceinline__ unsigned cvt_pk_bf16(float lo, float hi) { unsigned r; asm volatile("v_cvt_pk_bf16_f32 %0, %1, %2" : "=v"(r) : "v"(lo), "v"(hi)); return r; }

template <class Epi, class Sched>
__device__ __forceinline__ void gemm_phase(PG8_LAS unsigned char* lds, const Gemm g, const Sched& S, const Epi& E) {
    const int tid = TID(), wid = __builtin_amdgcn_readfirstlane(tid >> 6), lane = tid & 63, wr = wid >> 2, wc = wid & 3, fr = lane & 15, fq = lane >> 4;
    const int K = g.K, nt = K / BK;
    unsigned voffA[2], voffB[2];
#pragma unroll
    for (int i = 0; i < 2; ++i) { int R, C; stage_rc(tid * 16 + i * 8192, R, C); const int Rb = Epi::PERM ? ((R & ~31) + perm32(R & 31)) : R;
        voffA[i] = (unsigned)(R * K + C) * 2u; voffB[i] = (unsigned)(Rb * K + C) * 2u; }
    const size_t kstep = (size_t)(BK * 2);
    const size_t hstep = (size_t)HALF * K * 2;
    const size_t rstep = (size_t)K * 2;
    const unsigned ldsw = (unsigned)wid * 1024u;
    const int aoff = lds_byte(wr * 64 + fr, fq * 8), boff = lds_byte(wc * 32 + fr, fq * 8);
#define PG8_SA(b, h) (((b) * 2 + (h)) * HTB)
#define PG8_SB(b, h) ((4 + (b) * 2 + (h)) * HTB)
#define PG8_STAGE(bufoff, gbase, voff) do { _Pragma("unroll") for (int _i = 0; _i < 2; ++_i) \
        __builtin_amdgcn_global_load_lds((const unsigned*)((const char*)(gbase) + (voff)[_i]), (PG8_LAS unsigned*)(lds + (bufoff) + ldsw + _i * 8192), 16, 0, 0); } while (0)
#define PG8_LDA(dst, b, h) do { _Pragma("unroll") for (int m = 0; m < 4; ++m) _Pragma("unroll") for (int k = 0; k < 2; ++k) dst[m][k] = *(const PG8_LAS bf16x8*)(lds + PG8_SA(b, h) + aoff + m * 2048 + k * 1024); } while (0)
#define PG8_LDB(dst, b, h) do { _Pragma("unroll") for (int n = 0; n < 2; ++n) _Pragma("unroll") for (int k = 0; k < 2; ++k) dst[n][k] = *(const PG8_LAS bf16x8*)(lds + PG8_SB(b, h) + boff + n * 2048 + k * 1024); } while (0)
#define PG8_MMA(ai, bj, At, Bt) do { __builtin_amdgcn_s_setprio(1); _Pragma("unroll") for (int m = 0; m < 4; ++m) _Pragma("unroll") for (int n = 0; n < 2; ++n) _Pragma("unroll") for (int k = 0; k < 2; ++k) \
        acc[ai][bj][m][n] = __builtin_amdgcn_mfma_f32_16x16x32_bf16(Bt[n][k], At[m][k], acc[ai][bj][m][n], 0, 0, 0); __builtin_amdgcn_s_setprio(0); } while (0)
#define PG8_WAIT_V(n) asm volatile("s_waitcnt vmcnt(" #n ")" ::: "memory")
#define PG8_WAIT_L(n) asm volatile("s_waitcnt lgkmcnt(" #n ")" ::: "memory")
#define PG8_BAR __builtin_amdgcn_s_barrier()
#define PG8_SCHED __builtin_amdgcn_sched_barrier(0)
    Unit cur, nxt; int ui = 0;
    if (!S.next(0, cur)) return;
    f32x4 acc[2][2][4][2];
#pragma unroll
    for (int a = 0; a < 2; ++a)
#pragma unroll
        for (int b = 0; b < 2; ++b)
#pragma unroll
            for (int m = 0; m < 4; ++m)
#pragma unroll
                for (int n = 0; n < 2; ++n) acc[a][b][m][n] = (f32x4){0.f, 0.f, 0.f, 0.f};
    bf16x8 At[4][2], B0[2][2], B1[2][2];
    const char* cA = (const char*)g.A + (size_t)cur.arow0 * rstep; const char* cB = (const char*)g.Bt + (size_t)cur.brow0 * rstep;
    PG8_STAGE(PG8_SB(0, 0), cB, voffB); PG8_STAGE(PG8_SB(0, 1), cB + hstep, voffB); PG8_STAGE(PG8_SA(0, 0), cA, voffA); PG8_STAGE(PG8_SA(0, 1), cA + hstep, voffA);
    if (wr == 1) PG8_BAR;
    PG8_WAIT_V(2); PG8_BAR;
    PG8_STAGE(PG8_SB(1, 0), cB + kstep, voffB); PG8_STAGE(PG8_SA(1, 0), cA + kstep, voffA); PG8_STAGE(PG8_SB(1, 1), cB + hstep + kstep, voffB);
    PG8_WAIT_V(6); PG8_BAR;
    for (;;) {
        const bool has_next = S.next(ui + 1, nxt);
        const char* nA = has_next ? (const char*)g.A + (size_t)nxt.arow0 * rstep : cA; const char* nB = has_next ? (const char*)g.Bt + (size_t)nxt.brow0 * rstep : cB;
        for (int t = 0; t < nt; t += 2) {
            const bool last = (t == nt - 2);
            const char* a1 = cA + (size_t)(t + 1) * kstep;
            const char* a2 = last ? nA : cA + (size_t)(t + 2) * kstep; const char* b2 = last ? nB : cB + (size_t)(t + 2) * kstep;
            const char* a3 = a2 + kstep; const char* b3 = b2 + kstep;
            if constexpr (Epi::HAS_MID) { if (t == nt / 2) E.mid(acc, cur, wr, wc, fr, fq); }
            PG8_LDB(B0, 0, 0); PG8_LDB(B1, 0, 1); PG8_SCHED; PG8_LDA(At, 0, 0); PG8_STAGE(PG8_SA(1, 1), a1 + hstep, voffA);
            PG8_WAIT_V(8); PG8_WAIT_L(0); PG8_BAR; PG8_MMA(0, 0, At, B0); PG8_MMA(0, 1, At, B1); PG8_BAR; PG8_SCHED;
            PG8_LDA(At, 0, 1); PG8_STAGE(PG8_SB(0, 0), b2, voffB); PG8_STAGE(PG8_SB(0, 1), b2 + hstep, voffB); PG8_STAGE(PG8_SA(0, 0), a2, voffA);
            PG8_WAIT_V(8); PG8_WAIT_L(0); PG8_BAR; PG8_MMA(1, 0, At, B0); PG8_MMA(1, 1, At, B1); PG8_BAR; PG8_SCHED;
            PG8_LDB(B0, 1, 0); PG8_LDB(B1, 1, 1); PG8_SCHED; PG8_LDA(At, 1, 0); PG8_STAGE(PG8_SA(0, 1), a2 + hstep, voffA);
            PG8_WAIT_V(8); PG8_WAIT_L(0); PG8_BAR; PG8_MMA(0, 0, At, B0); PG8_MMA(0, 1, At, B1); PG8_BAR; PG8_SCHED;
            PG8_LDA(At, 1, 1); PG8_STAGE(PG8_SB(1, 0), b3, voffB); PG8_STAGE(PG8_SB(1, 1), b3 + hstep, voffB); PG8_STAGE(PG8_SA(1, 0), a3, voffA);
            PG8_WAIT_V(8); PG8_WAIT_L(0); PG8_BAR; PG8_MMA(1, 0, At, B0); PG8_MMA(1, 1, At, B1); PG8_BAR; PG8_SCHED;
        }
        if (wr == 0) PG8_BAR;
        E(acc, cur, wr, wc, fr, fq, lds);
        if (!has_next) break;
#pragma unroll
        for (int a = 0; a < 2; ++a)
#pragma unroll
            for (int b = 0; b < 2; ++b)
#pragma unroll
                for (int m = 0; m < 4; ++m)
#pragma unroll
                    for (int n = 0; n < 2; ++n) acc[a][b][m][n] = (f32x4){0.f, 0.f, 0.f, 0.f};
        cur = nxt; cA = nA; cB = nB; ++ui;
        if (wr == 1) PG8_BAR;
    }
    PG8_WAIT_V(0);
    PG8_BAR;
#undef PG8_SA
#undef PG8_SB
#undef PG8_STAGE
#undef PG8_LDA
#undef PG8_LDB
#undef PG8_MMA
#undef PG8_WAIT_V
#undef PG8_WAIT_L
#undef PG8_SCHED
}
#define PG8_FOR_AM _Pragma("unroll") for (int ai = 0; ai < 2; ++ai) _Pragma("unroll") for (int m = 0; m < 4; ++m)
#define PG8_FOR_BJ _Pragma("unroll") for (int bj = 0; bj < 2; ++bj)

struct EpiInProj {
    static constexpr bool PERM = true, HAS_MID = false;
    Params p;
    __device__ __forceinline__ void operator()(f32x4 (&acc)[2][2][4][2], const Unit& u, int wr, int wc, int fr, int fq, PG8_LAS unsigned char* lds) const {
        const int pn = u.pn;
        const int sec = pn < 4 ? 0 : pn < 8 ? 1 : pn < 12 ? 2 : pn < 16 ? 3 : pn == 16 ? 4 : pn == 17 ? 5 : pn < 22 ? 6 : 7;
        const int head0 = (sec == 0 ? pn : sec == 1 ? pn - 4 : sec == 2 ? pn - 8 : sec == 3 ? pn - 12 : sec == 6 ? pn - 18 : sec == 7 ? pn - 22 : 0) * 2;
        const int cl = wc * 32 + fq * 8;
        if (sec == 3 || sec == 4) {
            PG8_LAS float* X = (PG8_LAS float*)(lds + STAGE_BYTES);
            PG8_FOR_AM { PG8_FOR_BJ { const f32x4 a = acc[ai][bj][m][0], b = acc[ai][bj][m][1];
                float ss = (a.x * a.x + a.y * a.y) + (a.z * a.z + a.w * a.w) + (b.x * b.x + b.y * b.y) + (b.z * b.z + b.w * b.w);
                ss += __shfl_xor(ss, 16); ss += __shfl_xor(ss, 32);
                if (fq == 0) X[((ai * 128 + wr * 64 + m * 16 + fr) * 2 + bj) * 4 + wc] = ss; } }
            asm volatile("s_waitcnt lgkmcnt(0)" ::: "memory"); __builtin_amdgcn_s_barrier(); asm volatile("" ::: "memory");
            const int g = wc * 4 + fq, j0 = (g & 7) * 4, e0 = (g >> 3) * 64 + j0;
            const float* gn = sec == 3 ? p.g_qnorm : p.g_knorm;
            const f32x4 g1 = *(const f32x4*)(gn + e0), g2 = *(const f32x4*)(gn + e0 + 32);
            const float sc = sec == 3 ? CB : 1.f;
            const float2* rope = (const float2*)(p.ws + OFF_ROPE);
            PG8_FOR_AM { const int rl = ai * 128 + wr * 64 + m * 16 + fr, grow = u.pm * BM + rl; const RowInfo ri = row_decode(grow);
                f32x4 c4 = (f32x4){1.f, 1.f, 1.f, 1.f}, s4 = (f32x4){0.f, 0.f, 0.f, 0.f};
                if (!ri.meta) { const int pos = (g >> 3) ? (ri.t & 63) : (ri.t >> 6); const f32x4 t0 = *(const f32x4*)(rope + pos * 32 + j0), t1 = *(const f32x4*)(rope + pos * 32 + j0 + 2);
                    c4 = (f32x4){t0.x, t0.z, t1.x, t1.z}; s4 = (f32x4){t0.y, t0.w, t1.y, t1.w}; }
                PG8_FOR_BJ { const f32x4 pq = *(const PG8_LAS f32x4*)(X + (rl * 2 + bj) * 4);
                    const float rstd = 1.0f / sqrtf(((pq.x + pq.y) + (pq.z + pq.w)) * (1.0f / 128.f) + EPS) * sc;
                    const f32x4 x1 = acc[ai][bj][m][0] * g1 * rstd, x2 = acc[ai][bj][m][1] * g2 * rstd;
                    const f32x4 y1 = x1 * c4 - x2 * s4, y2 = x2 * c4 + x1 * s4;
                    if (ri.valid) { const int head = head0 + bj;
                        bf16_t* dst = sec == 3 ? (bf16_t*)(p.ws + OFF_QB) + ((size_t)(ri.b * 8 + head) * QROWS + row_q(ri)) * 128 : (bf16_t*)(p.ws + OFF_KB) + ((size_t)(ri.b * 2 + head) * KEYS + row_key(ri)) * 128;
                        *(u32x2*)(dst + e0) = (u32x2){cvt_pk_bf16(y1.x, y1.y), cvt_pk_bf16(y1.z, y1.w)};
                        *(u32x2*)(dst + e0 + 32) = (u32x2){cvt_pk_bf16(y2.x, y2.y), cvt_pk_bf16(y2.z, y2.w)}; } } }
            return;
        }
        PG8_FOR_AM { const int grow = u.pm * BM + ai * 128 + wr * 64 + m * 16 + fr; const RowInfo ri = row_decode(grow);
            if (!ri.valid) continue;
            PG8_FOR_BJ { const int head = head0 + bj; f32x4 a = acc[ai][bj][m][0], b = acc[ai][bj][m][1]; bf16_t* dst;
                if (sec == 0) { dst = (bf16_t*)(p.ws + OFF_QA) + ((size_t)(ri.b * 8 + head) * QROWS + row_q(ri)) * 128; a = a * CA; b = b * CA; }
                else if (sec == 1) dst = (bf16_t*)(p.ws + OFF_KA) + ((size_t)(ri.b * 8 + head) * KEYS + row_key(ri)) * 128;
                else if (sec == 2) dst = (bf16_t*)(p.ws + OFF_VA) + ((size_t)(ri.b * 8 + head) * KEYS + row_key(ri)) * 128;
                else if (sec == 5) dst = (bf16_t*)(p.ws + OFF_VB) + ((size_t)(ri.b * 2 + head) * KEYS + row_key(ri)) * 128;
                else { dst = (grow < MREAL ? (bf16_t*)p.out + (size_t)grow * 2048 : (bf16_t*)(p.ws + OFF_SGM) + (size_t)(grow - MREAL) * 2048) + (sec == 7 ? 1024 : 0) + head * 128;
                    a.x = 1.0f / (1.0f + __expf(-a.x)); a.y = 1.0f / (1.0f + __expf(-a.y)); a.z = 1.0f / (1.0f + __expf(-a.z)); a.w = 1.0f / (1.0f + __expf(-a.w));
                    b.x = 1.0f / (1.0f + __expf(-b.x)); b.y = 1.0f / (1.0f + __expf(-b.y)); b.z = 1.0f / (1.0f + __expf(-b.z)); b.w = 1.0f / (1.0f + __expf(-b.w)); }
                *(u32x4*)(dst + cl) = (u32x4){cvt_pk_bf16(a.x, a.y), cvt_pk_bf16(a.z, a.w), cvt_pk_bf16(b.x, b.y), cvt_pk_bf16(b.z, b.w)}; } }
    }
};
__device__ __forceinline__ f32x4 bf4(u32x2 w) { return (f32x4){bf2f(w.x & 0xffffu), bf2f(w.x >> 16), bf2f(w.y & 0xffffu), bf2f(w.y >> 16)}; }
struct EpiMerge {
    static constexpr bool PERM = true, HAS_MID = true;
    Params p;
    __device__ __forceinline__ const bf16_t* sg(int grow) const { return grow < MREAL ? (const bf16_t*)p.out + (size_t)grow * 2048 : (const bf16_t*)(p.ws + OFF_SGM) + (size_t)(grow - MREAL) * 2048; }
    __device__ __forceinline__ void mid(f32x4 (&acc)[2][2][4][2], const Unit& u, int wr, int wc, int fr, int fq) const {
        PG8_FOR_AM { const int grow = u.pm * BM + ai * 128 + wr * 64 + m * 16 + fr; if (grow >= MROWS) continue; const bf16_t* s = sg(grow) + u.pn * BM + wc * 32 + fq * 8;
            PG8_FOR_BJ { const u32x4 wa = *(const u32x4*)(s + bj * 128), wb = *(const u32x4*)(s + 1024 + bj * 128);
                const f32x4 b0 = bf4((u32x2){wb.x, wb.y}), b1 = bf4((u32x2){wb.z, wb.w});
                const f32x4 r0 = (f32x4){__builtin_amdgcn_rcpf(b0.x), __builtin_amdgcn_rcpf(b0.y), __builtin_amdgcn_rcpf(b0.z), __builtin_amdgcn_rcpf(b0.w)};
                const f32x4 r1 = (f32x4){__builtin_amdgcn_rcpf(b1.x), __builtin_amdgcn_rcpf(b1.y), __builtin_amdgcn_rcpf(b1.z), __builtin_amdgcn_rcpf(b1.w)};
                acc[ai][bj][m][0] = acc[ai][bj][m][0] * bf4((u32x2){wa.x, wa.y}) * r0;
                acc[ai][bj][m][1] = acc[ai][bj][m][1] * bf4((u32x2){wa.z, wa.w}) * r1; } }
    }
    __device__ __forceinline__ void operator()(f32x4 (&acc)[2][2][4][2], const Unit& u, int wr, int wc, int fr, int fq, PG8_LAS unsigned char*) const {
        bf16_t* MG = (bf16_t*)(p.ws + OFF_MERGED);
        PG8_FOR_AM { const int grow = u.pm * BM + ai * 128 + wr * 64 + m * 16 + fr; if (grow >= MROWS) continue; const int col = u.pn * BM + wc * 32 + fq * 8; const bf16_t* s = sg(grow) + 1024 + col;
            PG8_FOR_BJ { const u32x4 wb = *(const u32x4*)(s + bj * 128);
                const f32x4 a = acc[ai][bj][m][0] * bf4((u32x2){wb.x, wb.y}), b = acc[ai][bj][m][1] * bf4((u32x2){wb.z, wb.w});
                *(u32x4*)(MG + (size_t)grow * DM + col + bj * 128) = (u32x4){cvt_pk_bf16(a.x, a.y), cvt_pk_bf16(a.z, a.w), cvt_pk_bf16(b.x, b.y), cvt_pk_bf16(b.z, b.w)}; } }
    }
};
struct EpiOut {
    static constexpr bool PERM = false, HAS_MID = false;
    Params p;
    __device__ __forceinline__ void operator()(f32x4 (&acc)[2][2][4][2], const Unit& u, int wr, int wc, int fr, int fq, PG8_LAS unsigned char*) const {
        PG8_FOR_AM { const int grow = u.pm * BM + ai * 128 + wr * 64 + m * 16 + fr; if (grow >= MROWS) continue; const int col = u.pn * BM + wc * 32 + fq * 4;
            const float* hr = h_row(p, grow) + col; float* o = h2_row(p, grow) + col;
            PG8_FOR_BJ {
#pragma unroll
                for (int n = 0; n < 2; ++n) *(f32x4*)(o + bj * 128 + n * 16) = *(const f32x4*)(hr + bj * 128 + n * 16) + acc[ai][bj][m][n]; } }
    }
};
struct EpiMoeUp {
    static constexpr bool PERM = true, HAS_MID = false;
    Params p;
    __device__ __forceinline__ void operator()(f32x4 (&acc)[2][2][4][2], const Unit& u, int wr, int wc, int fr, int fq, PG8_LAS unsigned char*) const {
        bf16_t* HID = (bf16_t*)(p.ws + OFF_HID);
        PG8_FOR_AM { const int s = u.pm * BM + ai * 128 + wr * 64 + m * 16 + fr; if (s >= ESLOTS) continue;
            PG8_FOR_BJ { const f32x4 gt = acc[ai][bj][m][0], up = acc[ai][bj][m][1]; const int f0 = (u.pn * BM + bj * 128 + wc * 32 + fq * 8) >> 1;
                const float h0 = gt.x / (1.0f + __expf(-gt.x)) * up.x, h1 = gt.y / (1.0f + __expf(-gt.y)) * up.y, h2 = gt.z / (1.0f + __expf(-gt.z)) * up.z, h3 = gt.w / (1.0f + __expf(-gt.w)) * up.w;
                *(u32x2*)(HID + ((size_t)u.e * ESLOTS + s) * EFF + f0) = (u32x2){cvt_pk_bf16(h0, h1), cvt_pk_bf16(h2, h3)}; } }
    }
};
struct EpiMoeDown {
    static constexpr bool PERM = true, HAS_MID = false;
    Params p;
    __device__ __forceinline__ void operator()(f32x4 (&acc)[2][2][4][2], const Unit& u, int wr, int wc, int fr, int fq, PG8_LAS unsigned char*) const {
        bf16_t* YB = (bf16_t*)(p.ws + OFF_YB); const float* SAFF = (const float*)(p.ws + OFF_SAFF);
        PG8_FOR_AM { const int s = u.pm * BM + ai * 128 + wr * 64 + m * 16 + fr; if (s >= ESLOTS) continue; const float af = SAFF[u.e * ESLOTS + s]; const int col = u.pn * BM + wc * 32 + fq * 8;
            PG8_FOR_BJ { const f32x4 a = acc[ai][bj][m][0] * af, b = acc[ai][bj][m][1] * af;
                *(u32x4*)(YB + ((size_t)u.e * ESLOTS + s) * DM + col + bj * 128) = (u32x4){cvt_pk_bf16(a.x, a.y), cvt_pk_bf16(a.z, a.w), cvt_pk_bf16(b.x, b.y), cvt_pk_bf16(b.z, b.w)}; } }
    }
};
#undef PG8_BAR
}

__device__ __forceinline__ void phase1_fast(const Params& p, unsigned char* lds_raw, int vb, int nvb) {
    pg8::Gemm g{(const bf16_t*)(p.ws + OFF_UN), (const bf16_t*)(p.ws + OFF_WIN), DM};
    pg8::GridOrder S; S.init(MPAD / 256, INW / 256, nvb, vb);
    pg8::EpiInProj E{p};
    pg8::gemm_phase(( __attribute__((address_space(3))) unsigned char*)lds_raw, g, S, E);
}
__device__ __forceinline__ void phase3a_fast(const Params& p, unsigned char* lds_raw, int vb, int nvb) {
    pg8::Gemm g{(const bf16_t*)(p.ws + OFF_AO), (const bf16_t*)(p.ws + OFF_WAB), 2048};
    pg8::GridOrder S; S.init(MPAD / 256, DM / 256, nvb, vb);
    pg8::EpiMerge E{p};
    pg8::gemm_phase(( __attribute__((address_space(3))) unsigned char*)lds_raw, g, S, E);
}
__device__ __forceinline__ void phase3b_fast(const Params& p, unsigned char* lds_raw, int vb, int nvb) {
    pg8::Gemm g{(const bf16_t*)(p.ws + OFF_MERGED), (const bf16_t*)(p.ws + OFF_WO), DM};
    pg8::GridOrder S; S.init(MPAD / 256, DM / 256, nvb, vb);
    pg8::EpiOut E{p};
    pg8::gemm_phase(( __attribute__((address_space(3))) unsigned char*)lds_raw, g, S, E);
}
__device__ __forceinline__ void phase5a_fast(const Params& p, unsigned char* lds_raw, int vb, int nvb) {
    pg8::Gemm g{(const bf16_t*)(p.ws + OFF_XS), (const bf16_t*)(p.ws + OFF_WGU), DM};
    pg8::MoeOrder S{nvb, vb};
    pg8::EpiMoeUp E{p};
    pg8::gemm_phase(( __attribute__((address_space(3))) unsigned char*)lds_raw, g, S, E);
}
__device__ __forceinline__ void phase5b_fast(const Params& p, unsigned char* lds_raw, int vb, int nvb) {
    pg8::Gemm g{(const bf16_t*)(p.ws + OFF_HID), (const bf16_t*)(p.ws + OFF_WD), EFF};
    pg8::MoeOrder S{nvb, vb};
    pg8::EpiMoeDown E{p};
    pg8::gemm_phase(( __attribute__((address_space(3))) unsigned char*)lds_raw, g, S, E);
}

__device__ __forceinline__ void phase4b_fast(const Params& p, float* lds, int vb, int nvb) {
    const int tid = TID(), lane = tid & 63, wave = tid >> 6;
    constexpr int NBE = NB * NEXP;
    if (vb >= NBE || nvb <= NBE) { const bool small = nvb <= NBE; transpose_moe(p, lds, small ? vb : vb - NBE, small ? nvb : nvb - NBE); if (!small) return; }
    const float* AFF = (const float*)(p.ws + OFF_AFF); int* IDX = (int*)(p.ws + OFF_IDX); int* SEL = (int*)(p.ws + OFF_SEL);
    unsigned* keys = (unsigned*)lds;
    unsigned* hist = keys + 8448;
    unsigned* sh = hist + 256;
    for (int be = vb; be < NBE; be += nvb) {
        const int b = be / NEXP, e = be % NEXP;
        __syncthreads();
        for (int i = tid; i < LTOT; i += NTHREADS) keys[i] = __float_as_uint(AFF[(size_t)be * LTOT + i]);
        if (tid == 0) { sh[0] = 0u; sh[1] = CAP; }
        __syncthreads();
        for (int pass = 0; pass < 4; ++pass) {
            const int shift = 24 - 8 * pass;
            if (tid < 256) hist[tid] = 0u;
            __syncthreads();
            const unsigned prefix = sh[0], pmask = pass == 0 ? 0u : (0xffffffffu << (shift + 8));
            for (int i = tid; i < LTOT; i += NTHREADS) { const unsigned k = keys[i]; if ((k & pmask) == prefix) atomicAdd(&hist[(k >> shift) & 255u], 1u); }
            __syncthreads();
            if (tid == 0) { unsigned rem = sh[1], d = 255u;
                for (;; --d) { const unsigned c = hist[d]; if (c >= rem || d == 0u) break; rem -= c; }
                sh[0] = prefix | (d << shift); sh[1] = rem; }
            __syncthreads();
        }
        const unsigned T = sh[0], need_eq = sh[1];
        const int t0 = tid * 17; int cnt_gt = 0, cnt_eq = 0;
        for (int i = 0; i < 17; ++i) { const int tok = t0 + i; if (tok < LTOT) { const unsigned k = keys[tok]; cnt_gt += k > T; cnt_eq += k == T; } }
        int incl = cnt_eq;
#pragma unroll
        for (int o = 1; o < 64; o <<= 1) { const int v = __shfl_up(incl, o); if (lane >= o) incl += v; }
        if (lane == 63) sh[8 + wave] = (unsigned)incl;
        __syncthreads();
        int eq_before = incl - cnt_eq; for (int w = 0; w < wave; ++w) eq_before += (int)sh[8 + w];
        __syncthreads();
        int take_eq = (int)need_eq - eq_before; take_eq = take_eq < 0 ? 0 : (take_eq > cnt_eq ? cnt_eq : take_eq);
        const int mysel = cnt_gt + take_eq;
        incl = mysel;
#pragma unroll
        for (int o = 1; o < 64; o <<= 1) { const int v = __shfl_up(incl, o); if (lane >= o) incl += v; }
        if (lane == 63) sh[8 + wave] = (unsigned)incl;
        __syncthreads();
        int slot = incl - mysel; for (int w = 0; w < wave; ++w) slot += (int)sh[8 + w];
        int eqi = eq_before;
        for (int i = 0; i < 17; ++i) { const int tok = t0 + i; if (tok < LTOT) { const unsigned k = keys[tok];
            bool take = k > T; if (k == T) { take = eqi < (int)need_eq; ++eqi; }
            if (take) { IDX[(size_t)be * CAP + slot] = tok; SEL[((size_t)b * LTOT + tok) * NEXP + e] = slot; ++slot; } else SEL[((size_t)b * LTOT + tok) * NEXP + e] = -1; } }
    }
    __syncthreads();
}
__device__ __forceinline__ void phase4c(const Params& p, int vb, int nvb) {
    const int tid = TID(), lane = tid & 63, wave = tid >> 6;
    const bf16_t* U2 = (const bf16_t*)(p.ws + OFF_UN); bf16_t* XS = (bf16_t*)(p.ws + OFF_XS); const int* IDX = (const int*)(p.ws + OFF_IDX);
    const float* AFF = (const float*)(p.ws + OFF_AFF); float* SAFF = (float*)(p.ws + OFF_SAFF);
    for (int r = vb * 8 + wave; r < NEXP * ESLOTS; r += nvb * 8) {
        const int e = r / ESLOTS, s = r % ESLOTS, b = s / CAP, c = s % CAP;
        const int tok = IDX[((size_t)b * NEXP + e) * CAP + c];
        const u32x4* src = (const u32x4*)(U2 + (size_t)pos_row(b, tok) * DM) + lane; u32x4* dst = (u32x4*)(XS + (size_t)r * DM) + lane;
        const u32x4 v0 = src[0], v1 = src[64]; dst[0] = v0; dst[64] = v1;
        if (lane == 0) SAFF[r] = AFF[((size_t)b * NEXP + e) * LTOT + tok];
    }
}

#define LAS __attribute__((address_space(3)))
#define XB_TMO      128
#define XB_XCNT(j)  (256  + 64 * (j))
#define XB_XSUB(j)  (1280 + 64 * (j))
#define XB_XGEN(j)  (2304 + 64 * (j))
#define XB_TOP      3328
#define XB_TOPGEN   3392
#define XCD_BAR_WORDS 3456
#define XB_SPIN_CAP (1u << 22)
__device__ __forceinline__ unsigned xb_ld(unsigned* p)              { return __hip_atomic_load(p, __ATOMIC_RELAXED, __HIP_MEMORY_SCOPE_AGENT); }
__device__ __forceinline__ unsigned xb_add(unsigned* p, unsigned v) { return __hip_atomic_fetch_add(p, v, __ATOMIC_RELAXED, __HIP_MEMORY_SCOPE_AGENT); }
__device__ __forceinline__ unsigned xb_xcc_id() { return (unsigned)__builtin_amdgcn_s_getreg((3 << 11) | 20) & 0xFu; }
#define XB_SPIN(cond, bar) do { unsigned _sp = 0; while (cond) { __builtin_amdgcn_s_sleep(1); \
    if ((++_sp & 255u) == 0u) { if (xb_ld(&(bar)[XB_TMO])) break; if (_sp > XB_SPIN_CAP) { atomicAdd(&(bar)[XB_TMO], 1u); break; } } } } while (0)
struct XcdBarrier { unsigned* bar; unsigned x; volatile LAS unsigned* st; };
__device__ __forceinline__ XcdBarrier xcd_barrier_post(unsigned* bar, volatile LAS unsigned* st) {
    XcdBarrier b; b.bar = bar; b.x = xb_xcc_id(); b.st = st;
    if (threadIdx.x == 0) (void)xb_add(&bar[XB_XCNT(b.x)], 1u);
    return b;
}
__device__ __forceinline__ void xcd_barrier_complete(unsigned* bar, unsigned x, unsigned& nloc, unsigned& nx) {
    const unsigned G = gridDim.x * gridDim.y * gridDim.z;
    unsigned sum, cnt, mine, sp = 0u;
    for (;;) {
        sum = 0u; cnt = 0u; mine = 0u;
#pragma unroll
        for (unsigned j = 0; j < 16; ++j) { const unsigned c = xb_ld(&bar[XB_XCNT(j)]); sum += c; cnt += (c > 0u) ? 1u : 0u; mine = (j == x) ? c : mine; }
        if (sum == G) break;
        __builtin_amdgcn_s_sleep(1);
        if ((++sp & 255u) == 0u) { if (xb_ld(&bar[XB_TMO])) break; if (sp > XB_SPIN_CAP) { atomicAdd(&bar[XB_TMO], 1u); break; } }
    }
    nloc = mine > 0u ? mine : 1u; nx = cnt > 0u ? cnt : 1u;
}
__device__ __forceinline__ void xcd_barrier(const XcdBarrier& b) {
    asm volatile("s_waitcnt vmcnt(0)" ::: "memory");
    __syncthreads();
    if (threadIdx.x == 0) {
        unsigned* bar = b.bar;
        __builtin_amdgcn_s_waitcnt(0);
        unsigned nloc = b.st[0], nx = b.st[1];
        if (nloc == 0u) { xcd_barrier_complete(bar, b.x, nloc, nx); b.st[0] = nloc; b.st[1] = nx; }
        const unsigned old = xb_add(&bar[XB_XSUB(b.x)], 1u);
        const unsigned gen = old / nloc;
        if (old + 1u == (gen + 1u) * nloc) {
            __builtin_amdgcn_fence(__ATOMIC_RELEASE, "agent");
            asm volatile("s_waitcnt vmcnt(0)" ::: "memory");
            const unsigned og = xb_add(&bar[XB_TOP], 1u);
            const unsigned tg = og / nx;
            if (og + 1u == (tg + 1u) * nx) xb_add(&bar[XB_TOPGEN], 1u);
            else XB_SPIN(xb_ld(&bar[XB_TOPGEN]) == tg, bar);
            __builtin_amdgcn_fence(__ATOMIC_ACQUIRE, "agent");
            xb_add(&bar[XB_XGEN(b.x)], 1u);
            asm volatile("s_waitcnt vmcnt(0)" ::: "memory");
        } else {
            XB_SPIN(xb_ld(&bar[XB_XGEN(b.x)]) == gen, bar);
            __builtin_amdgcn_fence(__ATOMIC_ACQUIRE, "agent");
            asm volatile("s_waitcnt vmcnt(0)" ::: "memory");
        }
    }
    __syncthreads();
}

constexpr int LDS_BYTES = 147456;
constexpr int LDS_BARST = LDS_BYTES - 64;
constexpr size_t OFF_CTL = 68 * 1024;
#if defined(__HIP_DEVICE_COMPILE__)
#define PHASE_PARAMS() ({ const __attribute__((address_space(4))) Params* q_ = (const __attribute__((address_space(4))) Params*)__builtin_amdgcn_kernarg_segment_ptr(); asm volatile("" : "+s"(q_)); *q_; })
#else
#define PHASE_PARAMS() (pk)
#endif
#define PHASE(call) do { const Params p = PHASE_PARAMS(); call; } while (0)
__global__ void __launch_bounds__(NTHREADS, 2) fwd_kernel(Params pk) {
    extern __shared__ __attribute__((aligned(16))) unsigned char lds_raw[];
    float* lds = (float*)lds_raw;
    cg::grid_group grid = cg::this_grid();
    const int vb = blockIdx.x, nvb = gridDim.x;
    if (threadIdx.x < 16) ((LAS unsigned*)(lds_raw + LDS_BARST))[threadIdx.x] = 0u;
    __syncthreads();
    const XcdBarrier bar = xcd_barrier_post((unsigned*)(pk.ws + OFF_CTL), (volatile LAS unsigned*)(lds_raw + LDS_BARST));
#define GRID_BAR() xcd_barrier(bar)
    PHASE(phase0(p, vb, nvb));
    PHASE(transpose_p0(p, lds, vb, nvb));
    grid.sync();
    PHASE(phase1_fast(p, lds_raw, vb, nvb));
    GRID_BAR();
    PHASE(phase2_fast(p, (char*)lds_raw, vb, nvb));
    GRID_BAR();
    PHASE(phase3a_fast(p, lds_raw, vb, nvb));
    GRID_BAR();
    PHASE(phase3b_fast(p, lds_raw, vb, nvb));
    GRID_BAR();
    PHASE(phase4a(p, lds, vb, nvb));
    GRID_BAR();
    PHASE(phase4b_fast(p, lds, vb, nvb));
    GRID_BAR();
    PHASE(phase4c(p, vb, nvb));
    GRID_BAR();
    PHASE(phase5a_fast(p, lds_raw, vb, nvb));
    GRID_BAR();
    PHASE(phase5b_fast(p, lds_raw, vb, nvb));
    GRID_BAR();
    PHASE(phase6(p, vb, nvb));
}

extern "C" void kernel_launch(void* const* d_in, const int* in_sizes, int n_in, void* d_out, int out_size, void* d_ws, size_t ws_size, hipStream_t stream) {
    static int grid_blocks = 0;
    if (grid_blocks == 0) {
        if (n_in != 20 || in_sizes[0] != MREAL * DM || out_size != MREAL * DM || ws_size < 256 * MiB) {
            fprintf(stderr, "kernel_launch: unexpected shapes: n_in %d in0 %d out %d ws %zu\n", n_in, n_in > 0 ? in_sizes[0] : -1, out_size, ws_size); grid_blocks = -1; return; }
        int dev = 0, cus = 0, per_cu = 0;
        (void)hipGetDevice(&dev); (void)hipDeviceGetAttribute(&cus, hipDeviceAttributeMultiprocessorCount, dev);
        if (hipFuncSetAttribute((const void*)fwd_kernel, hipFuncAttributeMaxDynamicSharedMemorySize, LDS_BYTES) != hipSuccess) { fprintf(stderr, "kernel_launch: hipFuncSetAttribute failed\n"); grid_blocks = -1; return; }
        if (hipOccupancyMaxActiveBlocksPerMultiprocessor(&per_cu, (const void*)fwd_kernel, NTHREADS, LDS_BYTES) != hipSuccess || per_cu < 1) { fprintf(stderr, "kernel_launch: occupancy query failed (%d)\n", per_cu); grid_blocks = -1; return; }
        grid_blocks = cus * per_cu;
    }
    if (grid_blocks < 0) return;
    if (hipMemsetAsync((char*)d_ws + OFF_CTL, 0, XCD_BAR_WORDS * 4, stream) != hipSuccess) { fprintf(stderr, "kernel_launch: memset failed\n"); return; }
    Params p{};
    p.x = (const float*)d_in[0]; p.meta = (const float*)d_in[1]; p.g_mix = (const float*)d_in[2]; p.w_in = (const float*)d_in[3];
    p.lq1 = (const float*)d_in[4]; p.lk1 = (const float*)d_in[5]; p.lq2 = (const float*)d_in[6]; p.lk2 = (const float*)d_in[7];
    p.g_subln = (const float*)d_in[8]; p.g_qnorm = (const float*)d_in[9]; p.g_knorm = (const float*)d_in[10];
    p.w_ba = (const float*)d_in[11]; p.w_bb = (const float*)d_in[12]; p.w_out = (const float*)d_in[13]; p.g_ffn = (const float*)d_in[14];
    p.w_router = (const float*)d_in[15]; p.w_gate = (const float*)d_in[16]; p.w_up = (const float*)d_in[17]; p.w_down = (const float*)d_in[18]; p.g_final = (const float*)d_in[19];
    p.out = (float*)d_out; p.ws = (unsigned char*)d_ws;
    void* args[] = {&p};
    hipError_t e = hipLaunchCooperativeKernel((const void*)fwd_kernel, dim3(grid_blocks), dim3(NTHREADS), args, LDS_BYTES, stream);
    if (e != hipSuccess) fprintf(stderr, "kernel_launch: cooperative launch failed: %s (grid %d)\n", hipGetErrorString(e), grid_blocks);
}
```

```cpp
#include <hip/hip_runtime.h>
#include <hip/hip_cooperative_groups.h>
#include <cstdio>
#include <cstdint>
namespace cg = cooperative_groups;

typedef unsigned short bf16_t;
typedef float f32x4 __attribute__((ext_vector_type(4)));
typedef unsigned u32x2 __attribute__((ext_vector_type(2)));
typedef unsigned u32x4 __attribute__((ext_vector_type(4)));

constexpr int NB = 2, SEQ = 8192, DM = 1024, NMETA = 16, LTOT = SEQ + NMETA;
constexpr int MREAL = NB * SEQ;
constexpr int MROWS = MREAL + NB * NMETA;
constexpr int MPAD = 16640;
constexpr int INW = 6656;
constexpr int KEYS = 8256;
constexpr int QROWS = 8256;
constexpr int NEXP = 16, EFF = 512, CAP = 1026, ESLOTS = NB * CAP;
constexpr float EPS = 1e-6f;
constexpr float LOG2E = 1.4426950408889634f;
constexpr float CA = 0.125f * LOG2E;
constexpr float CB = 0.08838834764831845f * LOG2E;
constexpr float LAM_INIT = 0.2f;
constexpr int NTHREADS = 512;
constexpr int AOP = 2048;
__device__ const float INVF[32] = {1.000000000e+00f, 7.498942614e-01f, 5.623413324e-01f, 4.216965139e-01f, 3.162277639e-01f, 2.371373773e-01f, 1.778279394e-01f, 1.333521307e-01f,
    1.000000015e-01f, 7.498941571e-02f, 5.623413250e-02f, 4.216965288e-02f, 3.162277490e-02f, 2.371373773e-02f, 1.778279431e-02f, 1.333521493e-02f,
    9.999999776e-03f, 7.498941850e-03f, 5.623413250e-03f, 4.216964822e-03f, 3.162277630e-03f, 2.371373586e-03f, 1.778279431e-03f, 1.333521446e-03f,
    1.000000047e-03f, 7.498942432e-04f, 5.623413017e-04f, 4.216965172e-04f, 3.162277571e-04f, 2.371373703e-04f, 1.778279402e-04f, 1.333521504e-04f};

constexpr size_t MiB = 1u << 20;
constexpr size_t OFF_ROPE = 0;
constexpr size_t OFF_LAM = 64 * 1024;
constexpr size_t OFF_AFF = 128 * 1024;
constexpr size_t OFF_IDX = OFF_AFF + (size_t)NB * NEXP * LTOT * 4 + 256;
constexpr size_t OFF_SEL = OFF_IDX + (size_t)NB * NEXP * CAP * 4 + 256;
constexpr size_t OFF_SGM = OFF_SEL + (size_t)NB * LTOT * NEXP * 4 + 256;
constexpr size_t OFF_H2M = OFF_SGM + 32 * 2048 * 2;
constexpr size_t OFF_SAFF = OFF_H2M + 32 * 1024 * 4;
constexpr size_t OFF_MISC_END = OFF_SAFF + (size_t)NEXP * ESLOTS * 4;
static_assert(OFF_MISC_END <= 4 * MiB, "misc region");
constexpr size_t OFF_WIN = 4 * MiB;
constexpr size_t OFF_WAB = OFF_WIN + (size_t)INW * DM * 2;
constexpr size_t OFF_WO = OFF_WAB + (size_t)DM * 2048 * 2;
static_assert(OFF_WO + (size_t)DM * DM * 2 <= 24 * MiB, "weights region");
constexpr size_t OFF_AO = 24 * MiB;
constexpr size_t SZ_ROWS = (size_t)MPAD * DM * 2;
constexpr size_t OFF_UN = OFF_AO;
constexpr size_t OFF_HID = OFF_AO + SZ_ROWS;
static_assert((size_t)(NEXP * ESLOTS + 256) * EFF * 2 <= SZ_ROWS, "HID overlay");
constexpr size_t OFF_ATT = OFF_AO + 2 * SZ_ROWS;
constexpr size_t SZ_QH = (size_t)NB * 8 * QROWS * 128 * 2;
constexpr size_t SZ_KVB = (size_t)NB * 2 * KEYS * 128 * 2;
constexpr size_t OFF_QA = OFF_ATT, OFF_KA = OFF_QA + SZ_QH, OFF_VA = OFF_KA + SZ_QH, OFF_QB = OFF_VA + SZ_QH, OFF_KB = OFF_QB + SZ_QH, OFF_VB = OFF_KB + SZ_KVB;
constexpr size_t OFF_ATT_END = OFF_VB + SZ_KVB;
static_assert(OFF_ATT_END <= 256 * MiB, "workspace");
constexpr size_t OFF_MERGED = OFF_ATT;
constexpr size_t OFF_WGU = OFF_ATT + 33 * MiB;
constexpr size_t OFF_WD = OFF_WGU + 32 * MiB;
constexpr size_t OFF_XS = OFF_WD + 16 * MiB;
constexpr size_t OFF_YB = OFF_XS;
static_assert(SZ_ROWS <= 33 * MiB && OFF_XS + (size_t)(NEXP * ESLOTS + 256) * DM * 2 <= 256 * MiB, "overlay map");

struct Params {
    const float *x, *meta, *g_mix, *w_in, *lq1, *lk1, *lq2, *lk2, *g_subln, *g_qnorm, *g_knorm, *w_ba, *w_bb, *w_out, *g_ffn, *w_router, *w_gate, *w_up, *w_down, *g_final;
    float* out; unsigned char* ws;
};

__device__ __forceinline__ int TID() { int t = threadIdx.x; asm volatile("" : "+v"(t)); return t; }
__device__ __forceinline__ unsigned f2bf(float f) { unsigned u = __builtin_bit_cast(unsigned, f); return (u + 0x7fffu + ((u >> 16) & 1u)) >> 16; }
__device__ __forceinline__ float bf2f(unsigned h) { return __builtin_bit_cast(float, h << 16); }
__device__ __forceinline__ float wave_sum(float v) {
#pragma unroll
    for (int o = 1; o < 64; o <<= 1) v += __shfl_xor(v, o);
    return v;
}
__device__ __forceinline__ float wave_max(float v) {
#pragma unroll
    for (int o = 1; o < 64; o <<= 1) v = fmaxf(v, __shfl_xor(v, o));
    return v;
}
struct RowInfo { int b, t, meta, valid; };
__device__ __forceinline__ RowInfo row_decode(int r) {
    RowInfo ri;
    if (r < MREAL) { ri.b = r >> 13; ri.t = r & (SEQ - 1); ri.meta = 0; ri.valid = 1; }
    else if (r < MROWS) { ri.b = (r - MREAL) >> 4; ri.t = (r - MREAL) & 15; ri.meta = 1; ri.valid = 1; }
    else { ri.b = 0; ri.t = 0; ri.meta = 1; ri.valid = 0; }
    return ri;
}
__device__ __forceinline__ int row_key(const RowInfo& ri) { return ri.meta ? ri.t : 64 + ri.t; }
__device__ __forceinline__ int row_q(const RowInfo& ri) { return ri.meta ? SEQ + ri.t : ri.t; }
__device__ __forceinline__ int row_pos(const RowInfo& ri) { return ri.meta ? ri.t : NMETA + ri.t; }
__device__ __forceinline__ int pos_row(int b, int pos) { return pos < NMETA ? MREAL + b * NMETA + pos : b * SEQ + (pos - NMETA); }
__device__ __forceinline__ const float* h_row(const Params& p, int r) { RowInfo ri = row_decode(r); return ri.meta ? p.meta + (size_t)ri.t * DM : p.x + (size_t)r * DM; }

__device__ __forceinline__ void phase0(const Params& p, int vb, int nvb) {
    const int tid = TID(), lane = tid & 63, wave = tid >> 6;
    const int gt = vb * NTHREADS + tid;
    if (gt < 128 * 32) {
        const int pos = gt >> 5, j = gt & 31;
        const float ang = (float)pos * INVF[j];
        const double xd = (double)ang, kq = __builtin_rint(xd * 0.15915494309189535);
        const double rr = (xd - kq * 6.283185307179586) * 0.25, r2 = rr * rr;
        double sn = 1.0 / 1307674368000.0, cn = 1.0 / 87178291200.0;
        sn = sn * r2 * -1.0 + 1.0 / 6227020800.0; cn = cn * r2 * -1.0 + 1.0 / 479001600.0;
        sn = sn * r2 * -1.0 + 1.0 / 39916800.0;   cn = cn * r2 * -1.0 + 1.0 / 3628800.0;
        sn = sn * r2 * -1.0 + 1.0 / 362880.0;     cn = cn * r2 * -1.0 + 1.0 / 40320.0;
        sn = sn * r2 * -1.0 + 1.0 / 5040.0;       cn = cn * r2 * -1.0 + 1.0 / 720.0;
        sn = sn * r2 * -1.0 + 1.0 / 120.0;        cn = cn * r2 * -1.0 + 1.0 / 24.0;
        sn = sn * r2 * -1.0 + 1.0 / 6.0;          cn = cn * r2 * -1.0 + 0.5;
        sn = (sn * r2 * -1.0 + 1.0) * rr;         cn = cn * r2 * -1.0 + 1.0;
        double s2 = 2.0 * sn * cn, c2 = cn * cn - sn * sn;
        double s4 = 2.0 * s2 * c2, c4 = c2 * c2 - s2 * s2;
        float2 cs; cs.x = (float)c4; cs.y = (float)s4;
        ((float2*)(p.ws + OFF_ROPE))[gt] = cs;
    }
    if (vb == 0 && wave == 0) {
        float a = p.lq1[lane] * p.lk1[lane], c = p.lq2[lane] * p.lk2[lane];
        a = wave_sum(a); c = wave_sum(c);
        if (lane == 0) *(float*)(p.ws + OFF_LAM) = expf(a) - expf(c) + LAM_INIT;
    }
    bf16_t* UN = (bf16_t*)(p.ws + OFF_UN);
    for (int r = vb * 8 + wave; r < MPAD; r += nvb * 8) {
        u32x2* o = (u32x2*)(UN + (size_t)r * DM) + lane;
        if (r >= MROWS) {
#pragma unroll
            for (int j = 0; j < 4; ++j) o[64 * j] = (u32x2){0u, 0u};
            continue;
        }
        const f32x4* xr = (const f32x4*)h_row(p, r) + lane;
        f32x4 v[4]; float s = 0.f;
#pragma unroll
        for (int j = 0; j < 4; ++j) { v[j] = xr[64 * j]; s += (v[j].x * v[j].x + v[j].y * v[j].y) + (v[j].z * v[j].z + v[j].w * v[j].w); }
        const float rstd = 1.0f / sqrtf(wave_sum(s) * (1.0f / DM) + EPS);
#pragma unroll
        for (int j = 0; j < 4; ++j) {
            const f32x4 g = ((const f32x4*)p.g_mix)[lane + 64 * j];
            u32x2 w; w.x = f2bf(v[j].x * rstd * g.x) | (f2bf(v[j].y * rstd * g.y) << 16); w.y = f2bf(v[j].z * rstd * g.z) | (f2bf(v[j].w * rstd * g.w) << 16);
            o[64 * j] = w;
        }
    }
    {
        bf16_t* KA = (bf16_t*)(p.ws + OFF_KA); bf16_t* VA = (bf16_t*)(p.ws + OFF_VA); bf16_t* KB = (bf16_t*)(p.ws + OFF_KB); bf16_t* VB = (bf16_t*)(p.ws + OFF_VB);
        const int per = 48 * 128 / 8;
        for (int i = vb * NTHREADS + tid; i < (16 + 16 + 4 + 4) * per; i += nvb * NTHREADS) {
            const int bh = i / per, o = i % per; bf16_t* base;
            if (bh < 16) base = KA + (size_t)bh * KEYS * 128; else if (bh < 32) base = VA + (size_t)(bh - 16) * KEYS * 128;
            else if (bh < 36) base = KB + (size_t)(bh - 32) * KEYS * 128; else base = VB + (size_t)(bh - 36) * KEYS * 128;
            ((u32x4*)(base + 16 * 128))[o] = (u32x4){0u, 0u, 0u, 0u};
        }
    }
}

namespace fa {
using bf16x8 = __attribute__((ext_vector_type(8))) short;
using s16x4  = __attribute__((ext_vector_type(4))) short;
using f32x16 = __attribute__((ext_vector_type(16))) float;
constexpr int NT = KEYS / 64;
constexpr int SLOT = 16384;
constexpr int L_V = 0, L_K = 3 * SLOT, L_WS = 6 * SLOT, L_X = 0;
constexpr int LDS_ATTN = L_WS + 8 * 64 * 4;
constexpr float THR = 8.f;
#define KSWZ(row, colB) ((row) * 256 + ((colB) ^ (((row) & 7) << 4)))
#define SBAR() __builtin_amdgcn_sched_barrier(0)
__device__ __forceinline__ int crow(int r, int hi) { return (r & 3) + 8 * (r >> 2) + 4 * hi; }
__device__ __forceinline__ unsigned cvtpk(float lo, float hi) { unsigned r; asm volatile("v_cvt_pk_bf16_f32 %0, %1, %2" : "=v"(r) : "v"(lo), "v"(hi)); return r; }
__device__ __forceinline__ void partialSM(f32x16& p0, f32x16& p1, float& m_reg, float& mn, float& alpha) {
    float pmax = p0[0];
#pragma unroll
    for (int r = 1; r < 16; ++r) pmax = fmaxf(pmax, p0[r]);
#pragma unroll
    for (int r = 0; r < 16; ++r) pmax = fmaxf(pmax, p1[r]);
    { auto rr = __builtin_amdgcn_permlane32_swap(__float_as_uint(pmax), __float_as_uint(pmax), false, false);
      pmax = fmaxf(__uint_as_float(rr[0]), __uint_as_float(rr[1])); }
    if (__builtin_expect(__all(pmax - m_reg <= THR), 1)) { mn = m_reg; alpha = 1.f; }
    else { mn = fmaxf(m_reg, pmax); alpha = __builtin_amdgcn_exp2f(m_reg - mn); m_reg = mn; }
#pragma unroll
    for (int r = 0; r < 16; ++r) { p0[r] -= mn; p1[r] -= mn; }
#pragma unroll
    for (int r = 0; r < 16; ++r) p0[r] = __builtin_amdgcn_exp2f(p0[r]);
}
__device__ __forceinline__ void finishSM(f32x16& p0, f32x16& p1, float alpha, float& l_reg, bf16x8& pa0, bf16x8& pa1, bf16x8& pa2, bf16x8& pa3) {
#pragma unroll
    for (int r = 0; r < 16; ++r) p1[r] = __builtin_amdgcn_exp2f(p1[r]);
    float ps = 0;
#pragma unroll
    for (int r = 0; r < 16; ++r) ps += p0[r];
#pragma unroll
    for (int r = 0; r < 16; ++r) ps += p1[r];
    { auto rr = __builtin_amdgcn_permlane32_swap(__float_as_uint(ps), __float_as_uint(ps), false, false);
      ps = __uint_as_float(rr[0]) + __uint_as_float(rr[1]); }
    l_reg = l_reg * alpha + ps;
#define PK4(P, BASE, OUT) do { unsigned a0 = cvtpk(P[BASE + 0], P[BASE + 1]), a1 = cvtpk(P[BASE + 2], P[BASE + 3]);   \
    unsigned b0 = cvtpk(P[BASE + 4], P[BASE + 5]), b1 = cvtpk(P[BASE + 6], P[BASE + 7]);                              \
    auto r0 = __builtin_amdgcn_permlane32_swap(a0, b0, false, false); auto r1 = __builtin_amdgcn_permlane32_swap(a1, b1, false, false); \
    u32x4 w = {r0[0], r1[0], r0[1], r1[1]}; OUT = *reinterpret_cast<bf16x8*>(&w); } while (0)
    PK4(p0, 0, pa0); PK4(p0, 8, pa1); PK4(p1, 0, pa2); PK4(p1, 8, pa3);
#undef PK4
}
template <int ND0>
__device__ __forceinline__ void qkt(f32x16& p0, f32x16& p1, const char* Ks, const bf16x8* qr, int d0b, int r32, int hi) {
    p0 = f32x16{}; p1 = f32x16{};
#pragma unroll
    for (int d0 = 0; d0 < ND0; ++d0) { const int cb = ((d0b + d0) * 16 + hi * 8) * 2;
        const bf16x8 b0 = *reinterpret_cast<const bf16x8*>(Ks + KSWZ(r32, cb));
        const bf16x8 b1 = *reinterpret_cast<const bf16x8*>(Ks + KSWZ(32 + r32, cb));
        p0 = __builtin_amdgcn_mfma_f32_32x32x16_bf16(b0, qr[d0], p0, 0, 0, 0);
        p1 = __builtin_amdgcn_mfma_f32_32x32x16_bf16(b1, qr[d0], p1, 0, 0, 0); }
}
__device__ __forceinline__ int v_st(int k, int c) { const int kk = (k & ~0xC) | ((k & 4) << 1) | ((k & 8) >> 1); return ((kk >> 3) * 4 + (c >> 5)) * 512 + ((kk & 7) * 32 + (c & 31)) * 2; }
__device__ __forceinline__ int v_rd_base(int lane) { return ((lane & 3) << 3) | (((lane >> 2) & 3) << 6) | (((lane >> 4) & 1) << 5) | (((lane >> 5) & 1) << 8); }
constexpr int v_rd_off(int d0, int ks, int half) { return d0 * 512 + ks * 4096 + half * 2048; }
template <int OFF> __device__ __forceinline__ s16x4 tr_read(int vb) {
    s16x4 r; asm volatile("ds_read_b64_tr_b16 %0, %1 offset:%2" : "=&v"(r) : "v"(vb), "i"(OFF) : "memory"); return r;
}
template <int D0> __device__ __forceinline__ void pv_one(f32x16& od, int vb, bf16x8 pa0, bf16x8 pa1, bf16x8 pa2, bf16x8 pa3) {
    const s16x4 l0 = tr_read<v_rd_off(D0, 0, 0)>(vb), h0 = tr_read<v_rd_off(D0, 0, 1)>(vb), l1 = tr_read<v_rd_off(D0, 1, 0)>(vb), h1 = tr_read<v_rd_off(D0, 1, 1)>(vb);
    const s16x4 l2 = tr_read<v_rd_off(D0, 2, 0)>(vb), h2 = tr_read<v_rd_off(D0, 2, 1)>(vb), l3 = tr_read<v_rd_off(D0, 3, 0)>(vb), h3 = tr_read<v_rd_off(D0, 3, 1)>(vb);
    asm volatile("s_waitcnt lgkmcnt(0)" ::: "memory"); SBAR();
#define PK(L, H) (bf16x8){L[0], L[1], L[2], L[3], H[0], H[1], H[2], H[3]}
    od = __builtin_amdgcn_mfma_f32_32x32x16_bf16(pa0, PK(l0, h0), od, 0, 0, 0);
    od = __builtin_amdgcn_mfma_f32_32x32x16_bf16(pa1, PK(l1, h1), od, 0, 0, 0);
    od = __builtin_amdgcn_mfma_f32_32x32x16_bf16(pa2, PK(l2, h2), od, 0, 0, 0);
    od = __builtin_amdgcn_mfma_f32_32x32x16_bf16(pa3, PK(l3, h3), od, 0, 0, 0);
#undef PK
}
__device__ __forceinline__ void pv_d0(f32x16* o, int vb, bf16x8 pa0, bf16x8 pa1, bf16x8 pa2, bf16x8 pa3) {
    pv_one<0>(o[0], vb, pa0, pa1, pa2, pa3); pv_one<1>(o[1], vb, pa0, pa1, pa2, pa3); pv_one<2>(o[2], vb, pa0, pa1, pa2, pa3); pv_one<3>(o[3], vb, pa0, pa1, pa2, pa3);
}

__device__ __forceinline__ void glds16(const void* gsrc, unsigned lds_dst) { unsigned keep;
    asm volatile("s_mov_b32 %0, m0\n\ts_mov_b32 m0, %2\n\ts_nop 0\n\tglobal_load_lds_dwordx4 %1, off\n\ts_mov_b32 m0, %0" : "=&s"(keep) : "v"(gsrc), "s"(lds_dst) : "memory"); }
#define WAIT_BAR() asm volatile("s_waitcnt vmcnt(0) lgkmcnt(0)\n\ts_barrier" ::: "memory")
template <bool DIFF>
__device__ __forceinline__ void attn_unit(const bf16x8 (&qr)[DIFF ? 4 : 8], const bf16_t* __restrict__ Kh, const bf16_t* __restrict__ Vh, int tq, float slopeL, char* lds, int t0, int t1, bool active,
                                          f32x16 (&o)[4], float& l_reg, float& m_reg) {
    constexpr int ND0 = DIFF ? 4 : 8;
    const int tid = TID(), wid = __builtin_amdgcn_readfirstlane(tid >> 6), lane = tid & 63, r32 = lane & 31, hi = lane >> 5;
    char* V_lds = lds + L_V; char* K_lds = lds + L_K;
    float* al_l = (float*)(lds + L_WS) + wid * 64 + 32;
    const int d0b = DIFF ? (wid >> 2) * 4 : 0;
    m_reg = -1e30f; l_reg = 0.f;
#pragma unroll
    for (int d = 0; d < 4; ++d) o[d] = f32x16{};
    const char* ksrc; const char* vsrc;
    { const int row = 4 * wid + (lane >> 4), colB = ((lane & 15) * 16) ^ ((row & 7) << 4);
      ksrc = (const char*)Kh + row * 256 + colB;
      const int sub = 2 * wid + (lane >> 5), kk = (sub >> 2) * 8 + ((lane & 31) >> 2), col = (sub & 3) * 32 + (lane & 3) * 8, k = (kk & ~0xC) | ((kk & 4) << 1) | ((kk & 8) >> 1);
      vsrc = (const char*)Vh + k * 256 + col * 2; }
    const unsigned lds0 = (unsigned)(uintptr_t)lds;
    const unsigned kdst = lds0 + L_K + wid * 1024, vdst = lds0 + L_V + wid * 1024;
#define DMA_TILE(t, slot) do { const size_t to_ = (size_t)(t) * SLOT; const unsigned kd_ = (unsigned)__builtin_amdgcn_readfirstlane(kdst + (slot)), vd_ = (unsigned)__builtin_amdgcn_readfirstlane(vdst + (slot)); \
    glds16(ksrc + to_, kd_); glds16(ksrc + to_ + 8192, kd_ + 8192); glds16(vsrc + to_, vd_); glds16(vsrc + to_ + 8192, vd_ + 8192); } while (0)
    const int vb0 = (int)(uintptr_t)V_lds + v_rd_base(lane);
#define RESC(a) do { if (__any((a) < 1.f)) { if (hi == 0) al_l[r32] = (a); asm volatile("s_waitcnt lgkmcnt(0)" ::: "memory"); \
    _Pragma("unroll") for (int d = 0; d < 4; ++d) _Pragma("unroll") for (int r = 0; r < 16; ++r) o[d][r] *= al_l[crow(r, hi)]; } } while (0)
#define MASK0(P0, P1) do { _Pragma("unroll") for (int r = 8; r < 16; ++r) P0[r] = -1e30f; _Pragma("unroll") for (int r = 0; r < 16; ++r) P1[r] = -1e30f; } while (0)
#define FIXUP(P0, P1, j) do { if (DIFF) { const float base_ = (float)(tq - ((j) - 1) * 64 - 4 * hi); \
    _Pragma("unroll") for (int r = 0; r < 16; ++r) { const float d_ = base_ - (float)((r & 3) + 8 * (r >> 2)); \
        P0[r] = fmaf(-slopeL, fabsf(d_), P0[r]); P1[r] = fmaf(-slopeL, fabsf(d_ - 32.f), P1[r]); } } } while (0)
#define ROT() do { prv = cur; cur = nxt; nxt = (nxt == 2 * SLOT) ? 0 : nxt + SLOT; } while (0)
    f32x16 pA0, pA1, pB0, pB1; float mnA = 0.f, mnB = 0.f, alA = 1.f, alB = 1.f; bf16x8 pa0, pa1, pa2, pa3;
    int prv = 0, cur = 0, nxt = SLOT;
    DMA_TILE(t0, 0);
    WAIT_BAR();
    if (t0 + 1 < t1) DMA_TILE(t0 + 1, SLOT);
    if (active) { qkt<ND0>(pA0, pA1, K_lds, qr, d0b, r32, hi); if (t0 == 0) MASK0(pA0, pA1); else FIXUP(pA0, pA1, t0); partialSM(pA0, pA1, m_reg, mnA, alA); }
    WAIT_BAR(); ROT();
    for (int j = t0 + 1; j + 1 < t1; j += 2) {
        DMA_TILE(j + 1, nxt);
        if (active) { SBAR(); qkt<ND0>(pB0, pB1, K_lds + cur, qr, d0b, r32, hi); FIXUP(pB0, pB1, j);
            finishSM(pA0, pA1, alA, l_reg, pa0, pa1, pa2, pa3); SBAR();
            pv_d0(o, vb0 + prv, pa0, pa1, pa2, pa3); partialSM(pB0, pB1, m_reg, mnB, alB);
            RESC(alB); }
        WAIT_BAR(); ROT();
        if (j + 2 < t1) DMA_TILE(j + 2, nxt);
        if (active) { SBAR(); qkt<ND0>(pA0, pA1, K_lds + cur, qr, d0b, r32, hi); FIXUP(pA0, pA1, j + 1);
            finishSM(pB0, pB1, alB, l_reg, pa0, pa1, pa2, pa3); SBAR();
            pv_d0(o, vb0 + prv, pa0, pa1, pa2, pa3); partialSM(pA0, pA1, m_reg, mnA, alA);
            RESC(alA); }
        WAIT_BAR(); ROT();
    }
    if (active) {
        finishSM(pA0, pA1, alA, l_reg, pa0, pa1, pa2, pa3); SBAR();
        pv_d0(o, vb0 + prv, pa0, pa1, pa2, pa3);
    }
    WAIT_BAR();
#undef DMA_TILE
#undef RESC
#undef FIXUP
#undef MASK0
#undef ROT
}

template <class RowPtr>
__device__ __forceinline__ void store_tile(const f32x16 (&y)[4], char* stage, int lane, RowPtr rowptr) {
    const int r32 = lane & 31, hi = lane >> 5;
    bf16_t* stg = (bf16_t*)stage;
#pragma unroll
    for (int r = 0; r < 16; ++r) { const int orow = crow(r, hi);
#pragma unroll
        for (int d0 = 0; d0 < 4; ++d0) stg[orow * 136 + d0 * 32 + r32] = (bf16_t)f2bf(y[d0][r]); }
    asm volatile("s_waitcnt lgkmcnt(0)" ::: "memory");
#pragma unroll
    for (int i = 0; i < 8; ++i) { const int row = i * 4 + (lane >> 4), ch = lane & 15;
        const u32x4 v = *(const u32x4*)(stg + row * 136 + ch * 8);
        bf16_t* gp = rowptr(row); if (gp) *(u32x4*)(gp + ch * 8) = v; }
    asm volatile("s_waitcnt lgkmcnt(0)" ::: "memory");
}
}

constexpr int NPRB = 4 * 9 * 2 + 16 * 9;
constexpr size_t OFF_PART = (OFF_ATT_END + 255) / 256 * 256;
constexpr size_t OFF_PML = OFF_PART + (size_t)NPRB * 32 * 128 * 4;
static_assert(OFF_PML + NPRB * 32 * 2 * 4 <= 256 * MiB, "meta partials");
constexpr int NRANGE = 9;
__device__ __forceinline__ void meta_range(int r, int& t0, int& t1) { t0 = 15 * r; t1 = r == NRANGE - 1 ? fa::NT : 15 * (r + 1); }

__device__ __forceinline__ void phase2_fast(const Params& p, char* lds, int vb, int nvb) {
    using namespace fa;
    const int tid = TID(), wid = __builtin_amdgcn_readfirstlane(tid >> 6), lane0 = tid & 63;
    const bf16_t *QA = (const bf16_t*)(p.ws + OFF_QA), *KA = (const bf16_t*)(p.ws + OFF_KA), *VA = (const bf16_t*)(p.ws + OFF_VA);
    const bf16_t *QB = (const bf16_t*)(p.ws + OFF_QB), *KB = (const bf16_t*)(p.ws + OFF_KB), *VB = (const bf16_t*)(p.ws + OFF_VB);
    bf16_t* OA = (bf16_t*)(p.ws + OFF_AO); bf16_t* OB = OA + 1024;
    float* PART = (float*)(p.ws + OFF_PART); float* PML = (float*)(p.ws + OFF_PML);
    const float lam = *(const float*)(p.ws + OFF_LAM);
    float* li_l = (float*)(lds + L_WS) + wid * 64;
    for (int v = vb; v < 256; v += nvb) {
        const int xcd = v & 7, slot = v >> 3;
        if (v < 36 + 144) {
            f32x16 o[4]; float l_reg, m_reg; bf16x8 qr[8]; int t0, t1, rb; bool active;
            const int r32q = lane0 & 31, hiq = lane0 >> 5;
            if (v < 36) { const int g = v / NRANGE, rg = v % NRANGE, b = g >> 1, kvh = g & 1; meta_range(rg, t0, t1);
                active = wid < 2; const int h = kvh * 4 + (wid & 1) * 2 + (r32q >> 4);
                const bf16_t* q = QB + ((size_t)(b * 8 + h) * QROWS + SEQ + (r32q & 15)) * 128 + hiq * 8;
#pragma unroll
                for (int d0 = 0; d0 < 8; ++d0) qr[d0] = *reinterpret_cast<const bf16x8*>(q + d0 * 16);
                const size_t kvo = (size_t)(b * 2 + kvh) * KEYS * 128; rb = (g * NRANGE + rg) * 2 + (wid & 1);
                attn_unit<false>(qr, KB + kvo, VB + kvo, 0, 0.f, lds, t0, t1, active, o, l_reg, m_reg);
            } else { const int bh = (v - 36) / NRANGE, rg = (v - 36) % NRANGE; meta_range(rg, t0, t1);
                active = wid == 0; const int mp = r32q >> 4;
                const bf16_t* q = QA + ((size_t)bh * QROWS + SEQ + (r32q & 15)) * 128 + mp * 64 + hiq * 8;
#pragma unroll
                for (int d0 = 0; d0 < 8; ++d0) { const bf16x8 x = *reinterpret_cast<const bf16x8*>(q + (d0 & 3) * 16); qr[d0] = ((d0 >> 2) == mp) ? x : bf16x8{}; }
                const size_t kvo = (size_t)bh * KEYS * 128; rb = 72 + bh * NRANGE + rg;
                attn_unit<false>(qr, KA + kvo, VA + kvo, 0, 0.f, lds, t0, t1, active, o, l_reg, m_reg);
            }
            if (active) {
                int lane = lane0; asm volatile("" : "+v"(lane));
                const int r32 = lane & 31, hi = lane >> 5;
                float* po = PART + (size_t)rb * 32 * 128;
#pragma unroll
                for (int r = 0; r < 16; ++r)
#pragma unroll
                    for (int d = 0; d < 4; ++d) po[crow(r, hi) * 128 + d * 32 + r32] = o[d][r];
                if (hi == 0) { PML[(rb * 32 + r32) * 2] = m_reg; PML[(rb * 32 + r32) * 2 + 1] = l_reg; }
            }
            __syncthreads();
        }
        for (int k = 0; k < 6; ++k) {
            f32x16 o[4]; float l_reg, m_reg;
            if (k < 2) {
                const int b = xcd >> 2, kvh = (xcd >> 1) & 1, h = kvh * 4 + (xcd & 1) * 2 + k, bh = b * 8 + h, qb = slot;
                { bf16x8 qr[8]; const int r32q = lane0 & 31, hiq = lane0 >> 5;
                  const bf16_t* q = QB + ((size_t)bh * QROWS + qb * 256 + wid * 32 + r32q) * 128 + hiq * 8;
#pragma unroll
                  for (int d0 = 0; d0 < 8; ++d0) qr[d0] = *reinterpret_cast<const bf16x8*>(q + d0 * 16);
                  const size_t kvo = (size_t)(b * 2 + kvh) * KEYS * 128;
                  attn_unit<false>(qr, KB + kvo, VB + kvo, 0, 0.f, lds, 0, NT, true, o, l_reg, m_reg); }
                int lane = lane0; asm volatile("" : "+v"(lane));
                const int r32 = lane & 31, hi = lane >> 5;
                if (hi == 0) li_l[r32] = l_reg;
                asm volatile("s_waitcnt lgkmcnt(0)" ::: "memory");
#pragma unroll
                for (int r = 0; r < 16; ++r) { const float rl = __builtin_amdgcn_rcpf(li_l[crow(r, hi)]);
#pragma unroll
                    for (int d = 0; d < 4; ++d) o[d][r] *= rl; }
                const int wave_row0 = qb * 256 + wid * 32;
                store_tile(o, lds + L_X + wid * 8704, lane, [&](int row) -> bf16_t* { return OB + (size_t)(b * SEQ + wave_row0 + row) * AOP + h * 128; });
                __syncthreads();
            } else {
                const int bh = 2 * xcd + ((k - 2) >> 1), qb = 2 * slot + ((k - 2) & 1), b = bh >> 3, h = bh & 7, mp = wid >> 2, wq = wid & 3;
                { bf16x8 qr[4]; const int r32q = lane0 & 31, hiq = lane0 >> 5; const int qrow = qb * 128 + wq * 32 + r32q;
                  const bf16_t* q = QA + ((size_t)bh * QROWS + qrow) * 128 + mp * 64 + hiq * 8;
#pragma unroll
                  for (int d0 = 0; d0 < 4; ++d0) qr[d0] = *reinterpret_cast<const bf16x8*>(q + d0 * 16);
                  const float slopeL = exp2f(-(float)(h + 1)) * LOG2E;
                  const size_t kvo = (size_t)bh * KEYS * 128;
                  attn_unit<true>(qr, KA + kvo, VA + kvo, qrow, slopeL, lds, 0, NT, true, o, l_reg, m_reg); }
                int lane = lane0; asm volatile("" : "+v"(lane));
                const int r32 = lane & 31, hi = lane >> 5;
                if (hi == 0) li_l[r32] = l_reg;
                asm volatile("s_waitcnt lgkmcnt(0)" ::: "memory");
#pragma unroll
                for (int r = 0; r < 16; ++r) { const float rl = __builtin_amdgcn_rcpf(li_l[crow(r, hi)]);
#pragma unroll
                    for (int d = 0; d < 4; ++d) o[d][r] *= rl; }
                float* X = (float*)(lds + L_X) + wq * 4096;
                if (mp == 1) {
#pragma unroll
                    for (int r = 0; r < 16; ++r)
#pragma unroll
                        for (int d = 0; d < 4; ++d) X[(r * 4 + d) * 64 + lane] = o[d][r];
                }
                __syncthreads();
                if (mp == 0) {
                    float ss[16];
#pragma unroll
                    for (int r = 0; r < 16; ++r) { float a = 0.f;
#pragma unroll
                        for (int d = 0; d < 4; ++d) { const float y = o[d][r] - lam * X[(r * 4 + d) * 64 + lane]; o[d][r] = y; a += y * y; }
                        ss[r] = a; }
#pragma unroll
                    for (int r = 0; r < 16; ++r) {
                        float a = ss[r];
                        a += __shfl_xor(a, 1); a += __shfl_xor(a, 2); a += __shfl_xor(a, 4); a += __shfl_xor(a, 8); a += __shfl_xor(a, 16);
                        ss[r] = 1.0f / sqrtf(a * (1.0f / 128.f) + EPS) * (1.0f - LAM_INIT);
                    }
                    float g[4];
#pragma unroll
                    for (int d = 0; d < 4; ++d) g[d] = p.g_subln[d * 32 + r32];
#pragma unroll
                    for (int r = 0; r < 16; ++r)
#pragma unroll
                        for (int d = 0; d < 4; ++d) o[d][r] *= ss[r] * g[d];
                }
                __syncthreads();
                if (mp == 0) {
                    const int wave_row0 = qb * 128 + wq * 32;
                    store_tile(o, lds + L_X + wid * 8704, lane, [&](int row) -> bf16_t* { return OA + (size_t)(b * SEQ + wave_row0 + row) * AOP + h * 128; });
                }
                __syncthreads();
            }
        }
    }
}
__device__ __forceinline__ void phase2b(const Params& p, int vb, int nvb) {
    const int tid = TID(), lane = tid & 63, wave = tid >> 6;
    const float* PART = (const float*)(p.ws + OFF_PART); const float* PML = (const float*)(p.ws + OFF_PML);
    bf16_t* OA = (bf16_t*)(p.ws + OFF_AO); bf16_t* OB = OA + 1024;
    const float lam = *(const float*)(p.ws + OFF_LAM);
    for (int t = vb * 8 + wave; t < 512; t += nvb * 8) {
        const int type = t >> 8, b = (t >> 7) & 1, h = (t >> 4) & 7, i = t & 15;
        float y0 = 0.f, y1 = 0.f;
        for (int mp = 0; mp < (type == 0 ? 1 : 2); ++mp) {
            int rb0, row;
            if (type == 0) { const int kvh = h >> 2, w = (h & 3) >> 1; rb0 = ((b * 2 + kvh) * NRANGE) * 2 + w; row = (h & 1) * 16 + i; }
            else { rb0 = 72 + (b * 8 + h) * NRANGE; row = mp * 16 + i; }
            const int rbs = type == 0 ? 2 : 1;
            float M = -1e30f;
            for (int r = 0; r < NRANGE; ++r) M = fmaxf(M, PML[((rb0 + r * rbs) * 32 + row) * 2]);
            float L = 0.f, a0 = 0.f, a1 = 0.f;
            for (int r = 0; r < NRANGE; ++r) { const int rb = rb0 + r * rbs; const float w = exp2f(PML[(rb * 32 + row) * 2] - M);
                L += PML[(rb * 32 + row) * 2 + 1] * w; const float2 ov = *(const float2*)(PART + ((size_t)rb * 32 + row) * 128 + 2 * lane); a0 += ov.x * w; a1 += ov.y * w; }
            const float sgn = mp == 0 ? 1.f : -lam;
            y0 += sgn * a0 / L; y1 += sgn * a1 / L;
        }
        const size_t grow = (size_t)(MREAL + b * NMETA + i);
        if (type == 0) ((unsigned*)(OB + grow * AOP + h * 128))[lane] = f2bf(y0) | (f2bf(y1) << 16);
        else { const float ss = wave_sum(y0 * y0 + y1 * y1); const float rstd = 1.0f / sqrtf(ss * (1.0f / 128.f) + EPS) * (1.0f - LAM_INIT);
            ((unsigned*)(OA + grow * AOP + h * 128))[lane] = f2bf(y0 * rstd * p.g_subln[2 * lane]) | (f2bf(y1 * rstd * p.g_subln[2 * lane + 1]) << 16); }
    }
}

__device__ __forceinline__ float* h2_row(const Params& p, int grow) { return grow < MREAL ? p.out + (size_t)grow * DM : (float*)(p.ws + OFF_H2M) + (size_t)(grow - MREAL) * DM; }
__device__ __forceinline__ void phase4a(const Params& p, float* lds, int vb, int nvb) {
    const int tid = TID(), lane = tid & 63, wave = tid >> 6;
    for (int i = tid; i < DM * NEXP; i += NTHREADS) { const int k = i >> 4, e = i & 15; lds[e * DM + k] = p.w_router[i]; }
    __syncthreads();
    bf16_t* U2 = (bf16_t*)(p.ws + OFF_UN); float* AFF = (float*)(p.ws + OFF_AFF);
    for (int r = vb * 8 + wave; r < MROWS; r += nvb * 8) {
        const RowInfo ri = row_decode(r);
        const f32x4* xr = (const f32x4*)h2_row(p, r) + lane;
        f32x4 v[4]; float s = 0.f;
#pragma unroll
        for (int j = 0; j < 4; ++j) { v[j] = xr[64 * j]; s += (v[j].x * v[j].x + v[j].y * v[j].y) + (v[j].z * v[j].z + v[j].w * v[j].w); }
        const float rstd = 1.0f / sqrtf(wave_sum(s) * (1.0f / DM) + EPS);
        u32x2* o = (u32x2*)(U2 + (size_t)r * DM) + lane;
#pragma unroll
        for (int j = 0; j < 4; ++j) {
            const f32x4 g = ((const f32x4*)p.g_ffn)[lane + 64 * j];
            v[j].x *= rstd * g.x; v[j].y *= rstd * g.y; v[j].z *= rstd * g.z; v[j].w *= rstd * g.w;
            u32x2 w; w.x = f2bf(v[j].x) | (f2bf(v[j].y) << 16); w.y = f2bf(v[j].z) | (f2bf(v[j].w) << 16);
            o[64 * j] = w;
        }
        float mylg = -1e30f;
#pragma unroll 1
        for (int e = 0; e < NEXP; ++e) {
            float a = 0.f;
#pragma unroll
            for (int j = 0; j < 4; ++j) { const f32x4 w = *(const f32x4*)(lds + e * DM + 4 * (lane + 64 * j)); a += v[j].x * w.x + v[j].y * w.y + v[j].z * w.z + v[j].w * w.w; }
            a = wave_sum(a);
            if (lane == e) mylg = a;
        }
        const float mx = wave_max(mylg);
        const float ex = lane < NEXP ? expf(mylg - mx) : 0.f;
        const float mine = ex / wave_sum(ex);
        if (lane < NEXP) AFF[((size_t)ri.b * NEXP + lane) * LTOT + row_pos(ri)] = mine;
    }
    __syncthreads();
}

__device__ __forceinline__ void phase6(const Params& p, int vb, int nvb) {
    const int tid = TID(), lane = tid & 63, wave = tid >> 6;
    const int* SEL = (const int*)(p.ws + OFF_SEL); const bf16_t* YB = (const bf16_t*)(p.ws + OFF_YB);
    for (int r = vb * 8 + wave; r < MREAL; r += nvb * 8) {
        const int b = r >> 13, tok = NMETA + (r & (SEQ - 1));
        f32x4* xr = (f32x4*)(p.out + (size_t)r * DM) + lane;
        f32x4 v[4];
#pragma unroll
        for (int j = 0; j < 4; ++j) v[j] = xr[64 * j];
        const int sel = lane < NEXP ? SEL[((size_t)b * LTOT + tok) * NEXP + lane] : -1;
        for (int e = 0; e < NEXP; ++e) {
            const int c = __shfl(sel, e);
            if (c >= 0) {
                const u32x2* y = (const u32x2*)(YB + ((size_t)e * ESLOTS + b * CAP + c) * DM) + lane;
#pragma unroll
                for (int j = 0; j < 4; ++j) { const u32x2 w = y[64 * j]; v[j].x += bf2f(w.x & 0xffffu); v[j].y += bf2f(w.x >> 16); v[j].z += bf2f(w.y & 0xffffu); v[j].w += bf2f(w.y >> 16); }
            }
        }
        float s = 0.f;
#pragma unroll
        for (int j = 0; j < 4; ++j) s += (v[j].x * v[j].x + v[j].y * v[j].y) + (v[j].z * v[j].z + v[j].w * v[j].w);
        const float rstd = 1.0f / sqrtf(wave_sum(s) * (1.0f / DM) + EPS);
#pragma unroll
        for (int j = 0; j < 4; ++j) { const f32x4 g = ((const f32x4*)p.g_final)[lane + 64 * j]; xr[64 * j] = (f32x4){v[j].x * rstd * g.x, v[j].y * rstd * g.y, v[j].z * rstd * g.z, v[j].w * rstd * g.w}; }
    }
}

template <class DstRow>
__device__ __forceinline__ void transpose_item(const float* __restrict__ W, int N, bf16_t* __restrict__ WT, int ldk, int koff, float* scr, int k0, int n0, int lane, DstRow dst) {
#pragma unroll 8
    for (int i = 0; i < 32; ++i) { const int kk = 2 * i + (lane >> 5); scr[kk * 33 + (lane & 31)] = W[(size_t)(k0 + kk) * N + n0 + (lane & 31)]; }
    asm volatile("s_waitcnt vmcnt(0) lgkmcnt(0)" ::: "memory");
    const int c = lane & 7;
#pragma unroll
    for (int j = 0; j < 4; ++j) { const int n = (lane >> 3) + 8 * j; const float* sp = scr + (8 * c) * 33 + n;
        u32x4 o; o.x = f2bf(sp[0 * 33]) | (f2bf(sp[1 * 33]) << 16); o.y = f2bf(sp[2 * 33]) | (f2bf(sp[3 * 33]) << 16);
        o.z = f2bf(sp[4 * 33]) | (f2bf(sp[5 * 33]) << 16); o.w = f2bf(sp[6 * 33]) | (f2bf(sp[7 * 33]) << 16);
        *(u32x4*)(WT + (size_t)dst(n0 + n) * ldk + koff + k0 + 8 * c) = o; }
    asm volatile("s_waitcnt lgkmcnt(0)" ::: "memory");
}
__device__ __forceinline__ int rope_slot(int e) { const int half = e >> 6, el = e & 63, j = el & 31, n = el >> 5, g = half * 8 + (j >> 2); return 32 * (g >> 2) + 8 * (g & 3) + 4 * n + (j & 3); }
__device__ __forceinline__ void transpose_p0(const Params& p, float* lds, int vb, int nvb) {
    const int tid = TID(), lane = tid & 63, wave = tid >> 6;
    float* scr = lds + wave * (64 * 33);
    bf16_t* WIN = (bf16_t*)(p.ws + OFF_WIN); bf16_t* WAB = (bf16_t*)(p.ws + OFF_WAB); bf16_t* WO = (bf16_t*)(p.ws + OFF_WO);
    constexpr int I_IN = 16 * (INW / 32), I_SQ = 16 * 32;
    for (int it = vb * 8 + wave; it < I_IN + 3 * I_SQ; it += nvb * 8) {
        int r = it;
        if (r < I_IN) { const int kb = r / (INW / 32), nb = r % (INW / 32);
            transpose_item(p.w_in, INW, WIN, DM, 0, scr, kb * 64, nb * 32, lane, [](int n) { return (n >= 3072 && n < 4352) ? (n & ~127) + rope_slot(n & 127) : n; }); continue; }
        r -= I_IN; const int m = r / I_SQ, q = r % I_SQ, kb = q / 32, nb = q % 32;
        if (m == 0) transpose_item(p.w_ba, DM, WAB, 2048, 0, scr, kb * 64, nb * 32, lane, [](int n) { return n; });
        else if (m == 1) transpose_item(p.w_bb, DM, WAB, 2048, 1024, scr, kb * 64, nb * 32, lane, [](int n) { return n; });
        else transpose_item(p.w_out, DM, WO, DM, 0, scr, kb * 64, nb * 32, lane, [](int n) { return n; });
    }
}
__device__ __forceinline__ void transpose_moe(const Params& p, float* lds, int vbl, int nvbl) {
    const int tid = TID(), lane = tid & 63, wave = tid >> 6;
    float* scr = lds + wave * (64 * 33);
    bf16_t* WGU = (bf16_t*)(p.ws + OFF_WGU); bf16_t* WD = (bf16_t*)(p.ws + OFF_WD);
    constexpr int I_G = 16 * 16, I_D = 8 * 32, I_E = 2 * I_G + I_D;
    for (int it = vbl * 8 + wave; it < NEXP * I_E; it += nvbl * 8) {
        const int e = it / I_E; int r = it % I_E;
        if (r < 2 * I_G) { const int up = r / I_G, q = r % I_G, kb = q / 16, nb = q % 16;
            const float* W = (up ? p.w_up : p.w_gate) + (size_t)e * DM * EFF;
            transpose_item(W, EFF, WGU + (size_t)e * DM * DM, DM, 0, scr, kb * 64, nb * 32, lane, [up](int f) { return 8 * (f >> 2) + 4 * up + (f & 3); }); }
        else { r -= 2 * I_G; const int kb = r / 32, nb = r % 32;
            transpose_item(p.w_down + (size_t)e * EFF * DM, DM, WD + (size_t)e * DM * EFF, EFF, 0, scr, kb * 64, nb * 32, lane, [](int n) { return n; }); }
    }
}

namespace pg8 {
#define PG8_LAS __attribute__((address_space(3)))
typedef short bf16x8 __attribute__((ext_vector_type(8)));
constexpr int BM = 256, BK = 64, HALF = 128, HTB = HALF * BK * 2, STAGE_BYTES = 8 * HTB, NXCD = 8, WGM = 8;
__host__ __device__ __forceinline__ int lds_byte(int r, int c) { const int st = (r >> 4) * 2 + (c >> 5), rr = r & 15, cc = c & 31, ob = rr * 64 + cc * 2; return st * 1024 + (ob ^ (((ob >> 9) & 1) << 5)); }
__host__ __device__ __forceinline__ void stage_rc(int b, int& R, int& C) { const int st = b / 1024, sb = b % 1024, swz = sb ^ (((sb >> 9) & 1) << 5); R = (st >> 1) * 16 + swz / 64; C = (st & 1) * 32 + (swz % 64) / 2; }
__host__ __device__ __forceinline__ int perm32(int rho) { const int n = rho >> 4, i = rho & 15; return 8 * (i >> 2) + 4 * n + (i & 3); }
struct Unit { int arow0, brow0, pm, pn, e; };
struct Gemm { const bf16_t* A; const bf16_t* Bt; int K; };
struct GridOrder {
    int nM, nN, nwg, G, c;
    __device__ void init(int nM_, int nN_, int G_, int c_) { nM = nM_; nN = nN_; nwg = nM * nN; G = G_; c = c_; }
    __device__ bool next(int i, Unit& u) const {
        const long L = (long)i * G + c; if (L >= nwg) return false;
        int wgid = (int)L; { const int q = nwg / NXCD, r = nwg % NXCD, xcd = wgid % NXCD, off = wgid / NXCD; wgid = (xcd < r ? xcd * (q + 1) : r * (q + 1) + (xcd - r) * q) + off; }
        const int nig = WGM * nN, gid = wgid / nig, fm = gid * WGM, gsz = (nM - fm) < WGM ? (nM - fm) : WGM;
        u.pm = fm + ((wgid % nig) % gsz); u.pn = (wgid % nig) / gsz; u.e = 0; u.arow0 = u.pm * BM; u.brow0 = u.pn * BM; return true;
    }
};
struct MoeOrder {
    int G, c;
    __device__ bool next(int i, Unit& u) const {
        const int L = i * G + c; if (L >= NEXP * 36) return false;
        u.e = L / 36; const int r = L % 36; u.pm = r % 9; u.pn = r / 9; u.arow0 = u.e * ESLOTS + u.pm * BM; u.brow0 = u.e * DM + u.pn * BM; return true;
    }
};
__device__ __forceinline__ unsigned cvt_pk_bf16(float lo, float hi) { unsigned r; asm volatile("v_cvt_pk_bf16_f32 %0, %1, %2" : "=v"(r) : "v"(lo), "v"(hi)); return r; }

template <class Epi, class Sched>
__device__ __forceinline__ void gemm_phase(PG8_LAS unsigned char* lds, const Gemm g, const Sched& S, const Epi& E) {
    const int tid = TID(), wid = __builtin_amdgcn_readfirstlane(tid >> 6), lane = tid & 63, wr = wid >> 2, wc = wid & 3, fr = lane & 15, fq = lane >> 4;
    const int K = g.K, nt = K / BK;
    unsigned voffA[2], voffB[2];
#pragma unroll
    for (int i = 0; i < 2; ++i) { int R, C; stage_rc(tid * 16 + i * 8192, R, C); const int Rb = Epi::PERM ? ((R & ~31) + perm32(R & 31)) : R;
        voffA[i] = (unsigned)(R * K + C) * 2u; voffB[i] = (unsigned)(Rb * K + C) * 2u; }
    const size_t kstep = (size_t)(BK * 2);
    const size_t hstep = (size_t)HALF * K * 2;
    const size_t rstep = (size_t)K * 2;
    const unsigned ldsw = (unsigned)wid * 1024u;
    const int aoff = lds_byte(wr * 64 + fr, fq * 8), boff = lds_byte(wc * 32 + fr, fq * 8);
#define PG8_SA(b, h) (((b) * 2 + (h)) * HTB)
#define PG8_SB(b, h) ((4 + (b) * 2 + (h)) * HTB)
#define PG8_STAGE(bufoff, gbase, voff) do { _Pragma("unroll") for (int _i = 0; _i < 2; ++_i) \
        __builtin_amdgcn_global_load_lds((const unsigned*)((const char*)(gbase) + (voff)[_i]), (PG8_LAS unsigned*)(lds + (bufoff) + ldsw + _i * 8192), 16, 0, 0); } while (0)
#define PG8_LDA(dst, b, h) do { _Pragma("unroll") for (int m = 0; m < 4; ++m) _Pragma("unroll") for (int k = 0; k < 2; ++k) dst[m][k] = *(const PG8_LAS bf16x8*)(lds + PG8_SA(b, h) + aoff + m * 2048 + k * 1024); } while (0)
#define PG8_LDB(dst, b, h) do { _Pragma("unroll") for (int n = 0; n < 2; ++n) _Pragma("unroll") for (int k = 0; k < 2; ++k) dst[n][k] = *(const PG8_LAS bf16x8*)(lds + PG8_SB(b, h) + boff + n * 2048 + k * 1024); } while (0)
#define PG8_MMA(ai, bj, At, Bt) do { __builtin_amdgcn_s_setprio(1); _Pragma("unroll") for (int m = 0; m < 4; ++m) _Pragma("unroll") for (int n = 0; n < 2; ++n) _Pragma("unroll") for (int k = 0; k < 2; ++k) \
        acc[ai][bj][m][n] = __builtin_amdgcn_mfma_f32_16x16x32_bf16(Bt[n][k], At[m][k], acc[ai][bj][m][n], 0, 0, 0); __builtin_amdgcn_s_setprio(0); } while (0)
#define PG8_WAIT_V(n) asm volatile("s_waitcnt vmcnt(" #n ")" ::: "memory")
#define PG8_WAIT_L(n) asm volatile("s_waitcnt lgkmcnt(" #n ")" ::: "memory")
#define PG8_BAR __builtin_amdgcn_s_barrier()
#define PG8_SCHED __builtin_amdgcn_sched_barrier(0)
    Unit cur, nxt; int ui = 0;
    if (!S.next(0, cur)) return;
    f32x4 acc[2][2][4][2];
#pragma unroll
    for (int a = 0; a < 2; ++a)
#pragma unroll
        for (int b = 0; b < 2; ++b)
#pragma unroll
            for (int m = 0; m < 4; ++m)
#pragma unroll
                for (int n = 0; n < 2; ++n) acc[a][b][m][n] = (f32x4){0.f, 0.f, 0.f, 0.f};
    bf16x8 At[4][2], B0[2][2], B1[2][2];
    const char* cA = (const char*)g.A + (size_t)cur.arow0 * rstep; const char* cB = (const char*)g.Bt + (size_t)cur.brow0 * rstep;
    PG8_STAGE(PG8_SB(0, 0), cB, voffB); PG8_STAGE(PG8_SB(0, 1), cB + hstep, voffB); PG8_STAGE(PG8_SA(0, 0), cA, voffA); PG8_STAGE(PG8_SA(0, 1), cA + hstep, voffA);
    if (wr == 1) PG8_BAR;
    PG8_WAIT_V(2); PG8_BAR;
    PG8_STAGE(PG8_SB(1, 0), cB + kstep, voffB); PG8_STAGE(PG8_SA(1, 0), cA + kstep, voffA); PG8_STAGE(PG8_SB(1, 1), cB + hstep + kstep, voffB);
    PG8_WAIT_V(6); PG8_BAR;
    for (;;) {
        const bool has_next = S.next(ui + 1, nxt);
        const char* nA = has_next ? (const char*)g.A + (size_t)nxt.arow0 * rstep : cA; const char* nB = has_next ? (const char*)g.Bt + (size_t)nxt.brow0 * rstep : cB;
        for (int t = 0; t < nt; t += 2) {
            const bool last = (t == nt - 2);
            const char* a1 = cA + (size_t)(t + 1) * kstep;
            const char* a2 = last ? nA : cA + (size_t)(t + 2) * kstep; const char* b2 = last ? nB : cB + (size_t)(t + 2) * kstep;
            const char* a3 = a2 + kstep; const char* b3 = b2 + kstep;
            if constexpr (Epi::HAS_MID) { if (t == nt / 2) E.mid(acc, cur, wr, wc, fr, fq); }
            PG8_LDB(B0, 0, 0); PG8_LDB(B1, 0, 1); PG8_SCHED; PG8_LDA(At, 0, 0); PG8_STAGE(PG8_SA(1, 1), a1 + hstep, voffA);
            PG8_WAIT_V(8); PG8_WAIT_L(0); PG8_BAR; PG8_MMA(0, 0, At, B0); PG8_MMA(0, 1, At, B1); PG8_BAR; PG8_SCHED;
            PG8_LDA(At, 0, 1); PG8_STAGE(PG8_SB(0, 0), b2, voffB); PG8_STAGE(PG8_SB(0, 1), b2 + hstep, voffB); PG8_STAGE(PG8_SA(0, 0), a2, voffA);
            PG8_WAIT_V(8); PG8_WAIT_L(0); PG8_BAR; PG8_MMA(1, 0, At, B0); PG8_MMA(1, 1, At, B1); PG8_BAR; PG8_SCHED;
            PG8_LDB(B0, 1, 0); PG8_LDB(B1, 1, 1); PG8_SCHED; PG8_LDA(At, 1, 0); PG8_STAGE(PG8_SA(0, 1), a2 + hstep, voffA);
            PG8_WAIT_V(8); PG8_WAIT_L(0); PG8_BAR; PG8_MMA(0, 0, At, B0); PG8_MMA(0, 1, At, B1); PG8_BAR; PG8_SCHED;
            PG8_LDA(At, 1, 1); PG8_STAGE(PG8_SB(1, 0), b3, voffB); PG8_STAGE(PG8_SB(1, 1), b3 + hstep, voffB); PG8_STAGE(PG8_SA(1, 0), a3, voffA);
            PG8_WAIT_V(8); PG8_WAIT_L(0); PG8_BAR; PG8_MMA(1, 0, At, B0); PG8_MMA(1, 1, At, B1); PG8_BAR; PG8_SCHED;
        }
        if (wr == 0) PG8_BAR;
        E(acc, cur, wr, wc, fr, fq, lds);
        if (!has_next) break;
#pragma unroll
        for (int a = 0; a < 2; ++a)
#pragma unroll
            for (int b = 0; b < 2; ++b)
#pragma unroll
                for (int m = 0; m < 4; ++m)
#pragma unroll
                    for (int n = 0; n < 2; ++n) acc[a][b][m][n] = (f32x4){0.f, 0.f, 0.f, 0.f};
        cur = nxt; cA = nA; cB = nB; ++ui;
        if (wr == 1) PG8_BAR;
    }
    PG8_WAIT_V(0);
    PG8_BAR;
#undef PG8_SA
#undef PG8_SB
#undef PG8_STAGE
#undef PG8_LDA
#undef PG8_LDB
#undef PG8_MMA
#undef PG8_WAIT_V
#undef PG8_WAIT_L
#undef PG8_SCHED
}
#define PG8_FOR_AM _Pragma("unroll") for (int ai = 0; ai < 2; ++ai) _Pragma("unroll") for (int m = 0; m < 4; ++m)
#define PG8_FOR_BJ _Pragma("unroll") for (int bj = 0; bj < 2; ++bj)

struct EpiInProj {
    static constexpr bool PERM = true, HAS_MID = false;
    Params p;
    __device__ __forceinline__ void operator()(f32x4 (&acc)[2][2][4][2], const Unit& u, int wr, int wc, int fr, int fq, PG8_LAS unsigned char* lds) const {
        const int pn = u.pn;
        const int sec = pn < 4 ? 0 : pn < 8 ? 1 : pn < 12 ? 2 : pn < 16 ? 3 : pn == 16 ? 4 : pn == 17 ? 5 : pn < 22 ? 6 : 7;
        const int head0 = (sec == 0 ? pn : sec == 1 ? pn - 4 : sec == 2 ? pn - 8 : sec == 3 ? pn - 12 : sec == 6 ? pn - 18 : sec == 7 ? pn - 22 : 0) * 2;
        const int cl = wc * 32 + fq * 8;
        if (sec == 3 || sec == 4) {
            PG8_LAS float* X = (PG8_LAS float*)(lds + STAGE_BYTES);
            PG8_FOR_AM { PG8_FOR_BJ { const f32x4 a = acc[ai][bj][m][0], b = acc[ai][bj][m][1];
                float ss = (a.x * a.x + a.y * a.y) + (a.z * a.z + a.w * a.w) + (b.x * b.x + b.y * b.y) + (b.z * b.z + b.w * b.w);
                ss += __shfl_xor(ss, 16); ss += __shfl_xor(ss, 32);
                if (fq == 0) X[((ai * 128 + wr * 64 + m * 16 + fr) * 2 + bj) * 4 + wc] = ss; } }
            asm volatile("s_waitcnt lgkmcnt(0)" ::: "memory"); __builtin_amdgcn_s_barrier(); asm volatile("" ::: "memory");
            const int g = wc * 4 + fq, j0 = (g & 7) * 4, e0 = (g >> 3) * 64 + j0;
            const float* gn = sec == 3 ? p.g_qnorm : p.g_knorm;
            const f32x4 g1 = *(const f32x4*)(gn + e0), g2 = *(const f32x4*)(gn + e0 + 32);
            const float sc = sec == 3 ? CB : 1.f;
            const float2* rope = (const float2*)(p.ws + OFF_ROPE);
            PG8_FOR_AM { const int rl = ai * 128 + wr * 64 + m * 16 + fr, grow = u.pm * BM + rl; const RowInfo ri = row_decode(grow);
                f32x4 c4 = (f32x4){1.f, 1.f, 1.f, 1.f}, s4 = (f32x4){0.f, 0.f, 0.f, 0.f};
                if (!ri.meta) { const int pos = (g >> 3) ? (ri.t & 63) : (ri.t >> 6); const f32x4 t0 = *(const f32x4*)(rope + pos * 32 + j0), t1 = *(const f32x4*)(rope + pos * 32 + j0 + 2);
                    c4 = (f32x4){t0.x, t0.z, t1.x, t1.z}; s4 = (f32x4){t0.y, t0.w, t1.y, t1.w}; }
                PG8_FOR_BJ { const f32x4 pq = *(const PG8_LAS f32x4*)(X + (rl * 2 + bj) * 4);
                    const float rstd = 1.0f / sqrtf(((pq.x + pq.y) + (pq.z + pq.w)) * (1.0f / 128.f) + EPS) * sc;
                    const f32x4 x1 = acc[ai][bj][m][0] * g1 * rstd, x2 = acc[ai][bj][m][1] * g2 * rstd;
                    const f32x4 y1 = x1 * c4 - x2 * s4, y2 = x2 * c4 + x1 * s4;
                    if (ri.valid) { const int head = head0 + bj;
                        bf16_t* dst = sec == 3 ? (bf16_t*)(p.ws + OFF_QB) + ((size_t)(ri.b * 8 + head) * QROWS + row_q(ri)) * 128 : (bf16_t*)(p.ws + OFF_KB) + ((size_t)(ri.b * 2 + head) * KEYS + row_key(ri)) * 128;
                        *(u32x2*)(dst + e0) = (u32x2){cvt_pk_bf16(y1.x, y1.y), cvt_pk_bf16(y1.z, y1.w)};
                        *(u32x2*)(dst + e0 + 32) = (u32x2){cvt_pk_bf16(y2.x, y2.y), cvt_pk_bf16(y2.z, y2.w)}; } } }
            return;
        }
        PG8_FOR_AM { const int grow = u.pm * BM + ai * 128 + wr * 64 + m * 16 + fr; const RowInfo ri = row_decode(grow);
            if (!ri.valid) continue;
            PG8_FOR_BJ { const int head = head0 + bj; f32x4 a = acc[ai][bj][m][0], b = acc[ai][bj][m][1]; bf16_t* dst;
                if (sec == 0) { dst = (bf16_t*)(p.ws + OFF_QA) + ((size_t)(ri.b * 8 + head) * QROWS + row_q(ri)) * 128; a = a * CA; b = b * CA; }
                else if (sec == 1) dst = (bf16_t*)(p.ws + OFF_KA) + ((size_t)(ri.b * 8 + head) * KEYS + row_key(ri)) * 128;
                else if (sec == 2) dst = (bf16_t*)(p.ws + OFF_VA) + ((size_t)(ri.b * 8 + head) * KEYS + row_key(ri)) * 128;
                else if (sec == 5) dst = (bf16_t*)(p.ws + OFF_VB) + ((size_t)(ri.b * 2 + head) * KEYS + row_key(ri)) * 128;
                else { dst = (grow < MREAL ? (bf16_t*)p.out + (size_t)grow * 2048 : (bf16_t*)(p.ws + OFF_SGM) + (size_t)(grow - MREAL) * 2048) + (sec == 7 ? 1024 : 0) + head * 128;
                    a.x = 1.0f / (1.0f + __expf(-a.x)); a.y = 1.0f / (1.0f + __expf(-a.y)); a.z = 1.0f / (1.0f + __expf(-a.z)); a.w = 1.0f / (1.0f + __expf(-a.w));
                    b.x = 1.0f / (1.0f + __expf(-b.x)); b.y = 1.0f / (1.0f + __expf(-b.y)); b.z = 1.0f / (1.0f + __expf(-b.z)); b.w = 1.0f / (1.0f + __expf(-b.w)); }
                *(u32x4*)(dst + cl) = (u32x4){cvt_pk_bf16(a.x, a.y), cvt_pk_bf16(a.z, a.w), cvt_pk_bf16(b.x, b.y), cvt_pk_bf16(b.z, b.w)}; } }
    }
};
__device__ __forceinline__ f32x4 bf4(u32x2 w) { return (f32x4){bf2f(w.x & 0xffffu), bf2f(w.x >> 16), bf2f(w.y & 0xffffu), bf2f(w.y >> 16)}; }
struct EpiMerge {
    static constexpr bool PERM = true, HAS_MID = true;
    Params p;
    __device__ __forceinline__ const bf16_t* sg(int grow) const { return grow < MREAL ? (const bf16_t*)p.out + (size_t)grow * 2048 : (const bf16_t*)(p.ws + OFF_SGM) + (size_t)(grow - MREAL) * 2048; }
    __device__ __forceinline__ void mid(f32x4 (&acc)[2][2][4][2], const Unit& u, int wr, int wc, int fr, int fq) const {
        PG8_FOR_AM { const int grow = u.pm * BM + ai * 128 + wr * 64 + m * 16 + fr; if (grow >= MROWS) continue; const bf16_t* s = sg(grow) + u.pn * BM + wc * 32 + fq * 8;
            PG8_FOR_BJ { const u32x4 wa = *(const u32x4*)(s + bj * 128), wb = *(const u32x4*)(s + 1024 + bj * 128);
                const f32x4 b0 = bf4((u32x2){wb.x, wb.y}), b1 = bf4((u32x2){wb.z, wb.w});
                const f32x4 r0 = (f32x4){__builtin_amdgcn_rcpf(b0.x), __builtin_amdgcn_rcpf(b0.y), __builtin_amdgcn_rcpf(b0.z), __builtin_amdgcn_rcpf(b0.w)};
                const f32x4 r1 = (f32x4){__builtin_amdgcn_rcpf(b1.x), __builtin_amdgcn_rcpf(b1.y), __builtin_amdgcn_rcpf(b1.z), __builtin_amdgcn_rcpf(b1.w)};
                acc[ai][bj][m][0] = acc[ai][bj][m][0] * bf4((u32x2){wa.x, wa.y}) * r0;
                acc[ai][bj][m][1] = acc[ai][bj][m][1] * bf4((u32x2){wa.z, wa.w}) * r1; } }
    }
    __device__ __forceinline__ void operator()(f32x4 (&acc)[2][2][4][2], const Unit& u, int wr, int wc, int fr, int fq, PG8_LAS unsigned char*) const {
        bf16_t* MG = (bf16_t*)(p.ws + OFF_MERGED);
        PG8_FOR_AM { const int grow = u.pm * BM + ai * 128 + wr * 64 + m * 16 + fr; if (grow >= MROWS) continue; const int col = u.pn * BM + wc * 32 + fq * 8; const bf16_t* s = sg(grow) + 1024 + col;
            PG8_FOR_BJ { const u32x4 wb = *(const u32x4*)(s + bj * 128);
                const f32x4 a = acc[ai][bj][m][0] * bf4((u32x2){wb.x, wb.y}), b = acc[ai][bj][m][1] * bf4((u32x2){wb.z, wb.w});
                *(u32x4*)(MG + (size_t)grow * DM + col + bj * 128) = (u32x4){cvt_pk_bf16(a.x, a.y), cvt_pk_bf16(a.z, a.w), cvt_pk_bf16(b.x, b.y), cvt_pk_bf16(b.z, b.w)}; } }
    }
};
struct EpiOut {
    static constexpr bool PERM = false, HAS_MID = false;
    Params p;
    __device__ __forceinline__ void operator()(f32x4 (&acc)[2][2][4][2], const Unit& u, int wr, int wc, int fr, int fq, PG8_LAS unsigned char*) const {
        PG8_FOR_AM { const int grow = u.pm * BM + ai * 128 + wr * 64 + m * 16 + fr; if (grow >= MROWS) continue; const int col = u.pn * BM + wc * 32 + fq * 4;
            const float* hr = h_row(p, grow) + col; float* o = h2_row(p, grow) + col;
            PG8_FOR_BJ {
#pragma unroll
                for (int n = 0; n < 2; ++n) *(f32x4*)(o + bj * 128 + n * 16) = *(const f32x4*)(hr + bj * 128 + n * 16) + acc[ai][bj][m][n]; } }
    }
};
struct EpiMoeUp {
    static constexpr bool PERM = true, HAS_MID = false;
    Params p;
    __device__ __forceinline__ void operator()(f32x4 (&acc)[2][2][4][2], const Unit& u, int wr, int wc, int fr, int fq, PG8_LAS unsigned char*) const {
        bf16_t* HID = (bf16_t*)(p.ws + OFF_HID);
        PG8_FOR_AM { const int s = u.pm * BM + ai * 128 + wr * 64 + m * 16 + fr; if (s >= ESLOTS) continue;
            PG8_FOR_BJ { const f32x4 gt = acc[ai][bj][m][0], up = acc[ai][bj][m][1]; const int f0 = (u.pn * BM + bj * 128 + wc * 32 + fq * 8) >> 1;
                const float h0 = gt.x / (1.0f + __expf(-gt.x)) * up.x, h1 = gt.y / (1.0f + __expf(-gt.y)) * up.y, h2 = gt.z / (1.0f + __expf(-gt.z)) * up.z, h3 = gt.w / (1.0f + __expf(-gt.w)) * up.w;
                *(u32x2*)(HID + ((size_t)u.e * ESLOTS + s) * EFF + f0) = (u32x2){cvt_pk_bf16(h0, h1), cvt_pk_bf16(h2, h3)}; } }
    }
};
struct EpiMoeDown {
    static constexpr bool PERM = true, HAS_MID = false;
    Params p;
    __device__ __forceinline__ void operator()(f32x4 (&acc)[2][2][4][2], const Unit& u, int wr, int wc, int fr, int fq, PG8_LAS unsigned char*) const {
        bf16_t* YB = (bf16_t*)(p.ws + OFF_YB); const float* SAFF = (const float*)(p.ws + OFF_SAFF);
        PG8_FOR_AM { const int s = u.pm * BM + ai * 128 + wr * 64 + m * 16 + fr; if (s >= ESLOTS) continue; const float af = SAFF[u.e * ESLOTS + s]; const int col = u.pn * BM + wc * 32 + fq * 8;
            PG8_FOR_BJ { const f32x4 a = acc[ai][bj][m][0] * af, b = acc[ai][bj][m][1] * af;
                *(u32x4*)(YB + ((size_t)u.e * ESLOTS + s) * DM + col + bj * 128) = (u32x4){cvt_pk_bf16(a.x, a.y), cvt_pk_bf16(a.z, a.w), cvt_pk_bf16(b.x, b.y), cvt_pk_bf16(b.z, b.w)}; } }
    }
};
#undef PG8_BAR
}

__device__ __forceinline__ void phase1_fast(const Params& p, unsigned char* lds_raw, int vb, int nvb) {
    pg8::Gemm g{(const bf16_t*)(p.ws + OFF_UN), (const bf16_t*)(p.ws + OFF_WIN), DM};
    pg8::GridOrder S; S.init(MPAD / 256, INW / 256, nvb, vb);
    pg8::EpiInProj E{p};
    pg8::gemm_phase(( __attribute__((address_space(3))) unsigned char*)lds_raw, g, S, E);
}
__device__ __forceinline__ void phase3a_fast(const Params& p, unsigned char* lds_raw, int vb, int nvb) {
    pg8::Gemm g{(const bf16_t*)(p.ws + OFF_AO), (const bf16_t*)(p.ws + OFF_WAB), 2048};
    pg8::GridOrder S; S.init(MPAD / 256, DM / 256, nvb, vb);
    pg8::EpiMerge E{p};
    pg8::gemm_phase(( __attribute__((address_space(3))) unsigned char*)lds_raw, g, S, E);
}
__device__ __forceinline__ void phase3b_fast(const Params& p, unsigned char* lds_raw, int vb, int nvb) {
    pg8::Gemm g{(const bf16_t*)(p.ws + OFF_MERGED), (const bf16_t*)(p.ws + OFF_WO), DM};
    pg8::GridOrder S; S.init(MPAD / 256, DM / 256, nvb, vb);
    pg8::EpiOut E{p};
    pg8::gemm_phase(( __attribute__((address_space(3))) unsigned char*)lds_raw, g, S, E);
}
__device__ __forceinline__ void phase5a_fast(const Params& p, unsigned char* lds_raw, int vb, int nvb) {
    pg8::Gemm g{(const bf16_t*)(p.ws + OFF_XS), (const bf16_t*)(p.ws + OFF_WGU), DM};
    pg8::MoeOrder S{nvb, vb};
    pg8::EpiMoeUp E{p};
    pg8::gemm_phase(( __attribute__((address_space(3))) unsigned char*)lds_raw, g, S, E);
}
__device__ __forceinline__ void phase5b_fast(const Params& p, unsigned char* lds_raw, int vb, int nvb) {
    pg8::Gemm g{(const bf16_t*)(p.ws + OFF_HID), (const bf16_t*)(p.ws + OFF_WD), EFF};
    pg8::MoeOrder S{nvb, vb};
    pg8::EpiMoeDown E{p};
    pg8::gemm_phase(( __attribute__((address_space(3))) unsigned char*)lds_raw, g, S, E);
}

__device__ __forceinline__ void phase4b_fast(const Params& p, float* lds, int vb, int nvb) {
    const int tid = TID(), lane = tid & 63, wave = tid >> 6;
    constexpr int NBE = NB * NEXP;
    if (vb >= NBE || nvb <= NBE) { const bool small = nvb <= NBE; transpose_moe(p, lds, small ? vb : vb - NBE, small ? nvb : nvb - NBE); if (!small) return; }
    const float* AFF = (const float*)(p.ws + OFF_AFF); int* IDX = (int*)(p.ws + OFF_IDX); int* SEL = (int*)(p.ws + OFF_SEL);
    unsigned* keys = (unsigned*)lds;
    unsigned* hist = keys + 8448;
    unsigned* sh = hist + 256;
    for (int be = vb; be < NBE; be += nvb) {
        const int b = be / NEXP, e = be % NEXP;
        __syncthreads();
        for (int i = tid; i < LTOT; i += NTHREADS) keys[i] = __float_as_uint(AFF[(size_t)be * LTOT + i]);
        if (tid == 0) { sh[0] = 0u; sh[1] = CAP; }
        __syncthreads();
        for (int pass = 0; pass < 4; ++pass) {
            const int shift = 24 - 8 * pass;
            if (tid < 256) hist[tid] = 0u;
            __syncthreads();
            const unsigned prefix = sh[0], pmask = pass == 0 ? 0u : (0xffffffffu << (shift + 8));
            for (int i = tid; i < LTOT; i += NTHREADS) { const unsigned k = keys[i]; if ((k & pmask) == prefix) atomicAdd(&hist[(k >> shift) & 255u], 1u); }
            __syncthreads();
            if (tid == 0) { unsigned rem = sh[1], d = 255u;
                for (;; --d) { const unsigned c = hist[d]; if (c >= rem || d == 0u) break; rem -= c; }
                sh[0] = prefix | (d << shift); sh[1] = rem; }
            __syncthreads();
        }
        const unsigned T = sh[0], need_eq = sh[1];
        const int t0 = tid * 17; int cnt_gt = 0, cnt_eq = 0;
        for (int i = 0; i < 17; ++i) { const int tok = t0 + i; if (tok < LTOT) { const unsigned k = keys[tok]; cnt_gt += k > T; cnt_eq += k == T; } }
        int incl = cnt_eq;
#pragma unroll
        for (int o = 1; o < 64; o <<= 1) { const int v = __shfl_up(incl, o); if (lane >= o) incl += v; }
        if (lane == 63) sh[8 + wave] = (unsigned)incl;
        __syncthreads();
        int eq_before = incl - cnt_eq; for (int w = 0; w < wave; ++w) eq_before += (int)sh[8 + w];
        __syncthreads();
        int take_eq = (int)need_eq - eq_before; take_eq = take_eq < 0 ? 0 : (take_eq > cnt_eq ? cnt_eq : take_eq);
        const int mysel = cnt_gt + take_eq;
        incl = mysel;
#pragma unroll
        for (int o = 1; o < 64; o <<= 1) { const int v = __shfl_up(incl, o); if (lane >= o) incl += v; }
        if (lane == 63) sh[8 + wave] = (unsigned)incl;
        __syncthreads();
        int slot = incl - mysel; for (int w = 0; w < wave; ++w) slot += (int)sh[8 + w];
        int eqi = eq_before;
        for (int i = 0; i < 17; ++i) { const int tok = t0 + i; if (tok < LTOT) { const unsigned k = keys[tok];
            bool take = k > T; if (k == T) { take = eqi < (int)need_eq; ++eqi; }
            if (take) { IDX[(size_t)be * CAP + slot] = tok; SEL[((size_t)b * LTOT + tok) * NEXP + e] = slot; ++slot; } else SEL[((size_t)b * LTOT + tok) * NEXP + e] = -1; } }
    }
    __syncthreads();
}
__device__ __forceinline__ void phase4c(const Params& p, int vb, int nvb) {
    const int tid = TID(), lane = tid & 63, wave = tid >> 6;
    const bf16_t* U2 = (const bf16_t*)(p.ws + OFF_UN); bf16_t* XS = (bf16_t*)(p.ws + OFF_XS); const int* IDX = (const int*)(p.ws + OFF_IDX);
    const float* AFF = (const float*)(p.ws + OFF_AFF); float* SAFF = (float*)(p.ws + OFF_SAFF);
    for (int r = vb * 8 + wave; r < NEXP * ESLOTS; r += nvb * 8) {
        const int e = r / ESLOTS, s = r % ESLOTS, b = s / CAP, c = s % CAP;
        const int tok = IDX[((size_t)b * NEXP + e) * CAP + c];
        const u32x4* src = (const u32x4*)(U2 + (size_t)pos_row(b, tok) * DM) + lane; u32x4* dst = (u32x4*)(XS + (size_t)r * DM) + lane;
        const u32x4 v0 = src[0], v1 = src[64]; dst[0] = v0; dst[64] = v1;
        if (lane == 0) SAFF[r] = AFF[((size_t)b * NEXP + e) * LTOT + tok];
    }
}

#define LAS __attribute__((address_space(3)))
#define XB_TMO      128
#define XB_XCNT(j)  (256  + 64 * (j))
#define XB_XSUB(j)  (1280 + 64 * (j))
#define XB_XGEN(j)  (2304 + 64 * (j))
#define XB_TOP      3328
#define XB_TOPGEN   3392
#define XCD_BAR_WORDS 3456
#define XB_SPIN_CAP (1u << 22)
__device__ __forceinline__ unsigned xb_ld(unsigned* p)              { return __hip_atomic_load(p, __ATOMIC_RELAXED, __HIP_MEMORY_SCOPE_AGENT); }
__device__ __forceinline__ unsigned xb_add(unsigned* p, unsigned v) { return __hip_atomic_fetch_add(p, v, __ATOMIC_RELAXED, __HIP_MEMORY_SCOPE_AGENT); }
__device__ __forceinline__ unsigned xb_xcc_id() { return (unsigned)__builtin_amdgcn_s_getreg((3 << 11) | 20) & 0xFu; }
#define XB_SPIN(cond, bar) do { unsigned _sp = 0; while (cond) { __builtin_amdgcn_s_sleep(1); \
    if ((++_sp & 255u) == 0u) { if (xb_ld(&(bar)[XB_TMO])) break; if (_sp > XB_SPIN_CAP) { atomicAdd(&(bar)[XB_TMO], 1u); break; } } } } while (0)
struct XcdBarrier { unsigned* bar; unsigned x; volatile LAS unsigned* st; };
__device__ __forceinline__ XcdBarrier xcd_barrier_post(unsigned* bar, volatile LAS unsigned* st) {
    XcdBarrier b; b.bar = bar; b.x = xb_xcc_id(); b.st = st;
    if (threadIdx.x == 0) (void)xb_add(&bar[XB_XCNT(b.x)], 1u);
    return b;
}
__device__ __forceinline__ void xcd_barrier_complete(unsigned* bar, unsigned x, unsigned& nloc, unsigned& nx) {
    const unsigned G = gridDim.x * gridDim.y * gridDim.z;
    unsigned sum, cnt, mine, sp = 0u;
    for (;;) {
        sum = 0u; cnt = 0u; mine = 0u;
#pragma unroll
        for (unsigned j = 0; j < 16; ++j) { const unsigned c = xb_ld(&bar[XB_XCNT(j)]); sum += c; cnt += (c > 0u) ? 1u : 0u; mine = (j == x) ? c : mine; }
        if (sum == G) break;
        __builtin_amdgcn_s_sleep(1);
        if ((++sp & 255u) == 0u) { if (xb_ld(&bar[XB_TMO])) break; if (sp > XB_SPIN_CAP) { atomicAdd(&bar[XB_TMO], 1u); break; } }
    }
    nloc = mine > 0u ? mine : 1u; nx = cnt > 0u ? cnt : 1u;
}
__device__ __forceinline__ void xcd_barrier(const XcdBarrier& b) {
    asm volatile("s_waitcnt vmcnt(0)" ::: "memory");
    __syncthreads();
    if (threadIdx.x == 0) {
        unsigned* bar = b.bar;
        __builtin_amdgcn_s_waitcnt(0);
        unsigned nloc = b.st[0], nx = b.st[1];
        if (nloc == 0u) { xcd_barrier_complete(bar, b.x, nloc, nx); b.st[0] = nloc; b.st[1] = nx; }
        const unsigned old = xb_add(&bar[XB_XSUB(b.x)], 1u);
        const unsigned gen = old / nloc;
        if (old + 1u == (gen + 1u) * nloc) {
            __builtin_amdgcn_fence(__ATOMIC_RELEASE, "agent");
            asm volatile("s_waitcnt vmcnt(0)" ::: "memory");
            const unsigned og = xb_add(&bar[XB_TOP], 1u);
            const unsigned tg = og / nx;
            if (og + 1u == (tg + 1u) * nx) xb_add(&bar[XB_TOPGEN], 1u);
            else XB_SPIN(xb_ld(&bar[XB_TOPGEN]) == tg, bar);
            __builtin_amdgcn_fence(__ATOMIC_ACQUIRE, "agent");
            xb_add(&bar[XB_XGEN(b.x)], 1u);
            asm volatile("s_waitcnt vmcnt(0)" ::: "memory");
        } else {
            XB_SPIN(xb_ld(&bar[XB_XGEN(b.x)]) == gen, bar);
            __builtin_amdgcn_fence(__ATOMIC_ACQUIRE, "agent");
            asm volatile("s_waitcnt vmcnt(0)" ::: "memory");
        }
    }
    __syncthreads();
}

constexpr int LDS_BYTES = 147456;
constexpr int LDS_BARST = LDS_BYTES - 64;
constexpr size_t OFF_CTL = 68 * 1024;
#if defined(__HIP_DEVICE_COMPILE__)
#define PHASE_PARAMS() ({ const __attribute__((address_space(4))) Params* q_ = (const __attribute__((address_space(4))) Params*)__builtin_amdgcn_kernarg_segment_ptr(); asm volatile("" : "+s"(q_)); *q_; })
#else
#define PHASE_PARAMS() (pk)
#endif
#define PHASE(call) do { const Params p = PHASE_PARAMS(); call; } while (0)
__global__ void __launch_bounds__(NTHREADS, 2) fwd_kernel(Params pk) {
    extern __shared__ __attribute__((aligned(16))) unsigned char lds_raw[];
    float* lds = (float*)lds_raw;
    cg::grid_group grid = cg::this_grid();
    const int vb = blockIdx.x, nvb = gridDim.x;
    if (threadIdx.x < 16) ((LAS unsigned*)(lds_raw + LDS_BARST))[threadIdx.x] = 0u;
    __syncthreads();
    const XcdBarrier bar = xcd_barrier_post((unsigned*)(pk.ws + OFF_CTL), (volatile LAS unsigned*)(lds_raw + LDS_BARST));
#define GRID_BAR() xcd_barrier(bar)
    PHASE(phase0(p, vb, nvb));
    PHASE(transpose_p0(p, lds, vb, nvb));
    grid.sync();
    PHASE(phase1_fast(p, lds_raw, vb, nvb));
    GRID_BAR();
    PHASE(phase2_fast(p, (char*)lds_raw, vb, nvb));
    GRID_BAR();
    PHASE(phase2b(p, vb, nvb));
    GRID_BAR();
    PHASE(phase3a_fast(p, lds_raw, vb, nvb));
    GRID_BAR();
    PHASE(phase3b_fast(p, lds_raw, vb, nvb));
    GRID_BAR();
    PHASE(phase4a(p, lds, vb, nvb));
    GRID_BAR();
    PHASE(phase4b_fast(p, lds, vb, nvb));
    GRID_BAR();
    PHASE(phase4c(p, vb, nvb));
    GRID_BAR();
    PHASE(phase5a_fast(p, lds_raw, vb, nvb));
    GRID_BAR();
    PHASE(phase5b_fast(p, lds_raw, vb, nvb));
    GRID_BAR();
    PHASE(phase6(p, vb, nvb));
}

extern "C" void kernel_launch(void* const* d_in, const int* in_sizes, int n_in, void* d_out, int out_size, void* d_ws, size_t ws_size, hipStream_t stream) {
    static int grid_blocks = 0;
    if (grid_blocks == 0) {
        if (n_in != 20 || in_sizes[0] != MREAL * DM || out_size != MREAL * DM || ws_size < 256 * MiB) {
            fprintf(stderr, "kernel_launch: unexpected shapes: n_in %d in0 %d out %d ws %zu\n", n_in, n_in > 0 ? in_sizes[0] : -1, out_size, ws_size); grid_blocks = -1; return; }
        int dev = 0, cus = 0, per_cu = 0;
        (void)hipGetDevice(&dev); (void)hipDeviceGetAttribute(&cus, hipDeviceAttributeMultiprocessorCount, dev);
        if (hipFuncSetAttribute((const void*)fwd_kernel, hipFuncAttributeMaxDynamicSharedMemorySize, LDS_BYTES) != hipSuccess) { fprintf(stderr, "kernel_launch: hipFuncSetAttribute failed\n"); grid_blocks = -1; return; }
        if (hipOccupancyMaxActiveBlocksPerMultiprocessor(&per_cu, (const void*)fwd_kernel, NTHREADS, LDS_BYTES) != hipSuccess || per_cu < 1) { fprintf(stderr, "kernel_launch: occupancy query failed (%d)\n", per_cu); grid_blocks = -1; return; }
        grid_blocks = cus * per_cu;
    }
    if (grid_blocks < 0) return;
    if (hipMemsetAsync((char*)d_ws + OFF_CTL, 0, XCD_BAR_WORDS * 4, stream) != hipSuccess) { fprintf(stderr, "kernel_launch: memset failed\n"); return; }
    Params p{};
    p.x = (const float*)d_in[0]; p.meta = (const float*)d_in[1]; p.g_mix = (const float*)d_in[2]; p.w_in = (const float*)d_in[3];
    p.lq1 = (const float*)d_in[4]; p.lk1 = (const float*)d_in[5]; p.lq2 = (const float*)d_in[6]; p.lk2 = (const float*)d_in[7];
    p.g_subln = (const float*)d_in[8]; p.g_qnorm = (const float*)d_in[9]; p.g_knorm = (const float*)d_in[10];
    p.w_ba = (const float*)d_in[11]; p.w_bb = (const float*)d_in[12]; p.w_out = (const float*)d_in[13]; p.g_ffn = (const float*)d_in[14];
    p.w_router = (const float*)d_in[15]; p.w_gate = (const float*)d_in[16]; p.w_up = (const float*)d_in[17]; p.w_down = (const float*)d_in[18]; p.g_final = (const float*)d_in[19];
    p.out = (float*)d_out; p.ws = (unsigned char*)d_ws;
    void* args[] = {&p};
    hipError_t e = hipLaunchCooperativeKernel((const void*)fwd_kernel, dim3(grid_blocks), dim3(NTHREADS), args, LDS_BYTES, stream);
    if (e != hipSuccess) fprintf(stderr, "kernel_launch: cooperative launch failed: %s (grid %d)\n", hipGetErrorString(e), grid_blocks);
}
```

```cpp
#include <hip/hip_runtime.h>
#include <hip/hip_cooperative_groups.h>
#include <cstdio>
#include <cstdint>
namespace cg = cooperative_groups;

typedef unsigned short bf16_t;
typedef float f32x4 __attribute__((ext_vector_type(4)));
typedef unsigned u32x2 __attribute__((ext_vector_type(2)));
typedef unsigned u32x4 __attribute__((ext_vector_type(4)));

constexpr int NB = 2, SEQ = 8192, DM = 1024, NMETA = 16, LTOT = SEQ + NMETA;
constexpr int MREAL = NB * SEQ;
constexpr int MROWS = MREAL + NB * NMETA;
constexpr int MPAD = 16640;
constexpr int INW = 6656;
constexpr int KEYS = 8256;
constexpr int QROWS = 8256;
constexpr int NEXP = 16, EFF = 512, CAP = 1026, ESLOTS = NB * CAP;
constexpr float EPS = 1e-6f;
constexpr float LOG2E = 1.4426950408889634f;
constexpr float CA = 0.125f * LOG2E;
constexpr float CB = 0.08838834764831845f * LOG2E;
constexpr float LAM_INIT = 0.2f;
constexpr int NTHREADS = 512;
constexpr int AOP = 2048;
__device__ const float INVF[32] = {1.000000000e+00f, 7.498942614e-01f, 5.623413324e-01f, 4.216965139e-01f, 3.162277639e-01f, 2.371373773e-01f, 1.778279394e-01f, 1.333521307e-01f,
    1.000000015e-01f, 7.498941571e-02f, 5.623413250e-02f, 4.216965288e-02f, 3.162277490e-02f, 2.371373773e-02f, 1.778279431e-02f, 1.333521493e-02f,
    9.999999776e-03f, 7.498941850e-03f, 5.623413250e-03f, 4.216964822e-03f, 3.162277630e-03f, 2.371373586e-03f, 1.778279431e-03f, 1.333521446e-03f,
    1.000000047e-03f, 7.498942432e-04f, 5.623413017e-04f, 4.216965172e-04f, 3.162277571e-04f, 2.371373703e-04f, 1.778279402e-04f, 1.333521504e-04f};

constexpr size_t MiB = 1u << 20;
constexpr size_t OFF_ROPE = 0;
constexpr size_t OFF_LAM = 64 * 1024;
constexpr size_t OFF_AFF = 128 * 1024;
constexpr size_t OFF_IDX = OFF_AFF + (size_t)NB * NEXP * LTOT * 4 + 256;
constexpr size_t OFF_SEL = OFF_IDX + (size_t)NB * NEXP * CAP * 4 + 256;
constexpr size_t OFF_SGM = OFF_SEL + (size_t)NB * LTOT * NEXP * 4 + 256;
constexpr size_t OFF_H2M = OFF_SGM + 32 * 2048 * 2;
constexpr size_t OFF_SAFF = OFF_H2M + 32 * 1024 * 4;
constexpr size_t OFF_MISC_END = OFF_SAFF + (size_t)NEXP * ESLOTS * 4;
static_assert(OFF_MISC_END <= 4 * MiB, "misc region");
constexpr size_t OFF_WIN = 4 * MiB;
constexpr size_t OFF_WAB = OFF_WIN + (size_t)INW * DM * 2;
constexpr size_t OFF_WO = OFF_WAB + (size_t)DM * 2048 * 2;
static_assert(OFF_WO + (size_t)DM * DM * 2 <= 24 * MiB, "weights region");
constexpr size_t OFF_AO = 24 * MiB;
constexpr size_t SZ_ROWS = (size_t)MPAD * DM * 2;
constexpr size_t OFF_UN = OFF_AO;
constexpr size_t OFF_HID = OFF_AO + SZ_ROWS;
static_assert((size_t)(NEXP * ESLOTS + 256) * EFF * 2 <= SZ_ROWS, "HID overlay");
constexpr size_t OFF_ATT = OFF_AO + 2 * SZ_ROWS;
constexpr size_t SZ_QH = (size_t)NB * 8 * QROWS * 128 * 2;
constexpr size_t SZ_KVB = (size_t)NB * 2 * KEYS * 128 * 2;
constexpr size_t OFF_QA = OFF_ATT, OFF_KA = OFF_QA + SZ_QH, OFF_VA = OFF_KA + SZ_QH, OFF_QB = OFF_VA + SZ_QH, OFF_KB = OFF_QB + SZ_QH, OFF_VB = OFF_KB + SZ_KVB;
constexpr size_t OFF_ATT_END = OFF_VB + SZ_KVB;
static_assert(OFF_ATT_END <= 256 * MiB, "workspace");
constexpr size_t OFF_MERGED = OFF_ATT;
constexpr size_t OFF_WGU = OFF_ATT + 33 * MiB;
constexpr size_t OFF_WD = OFF_WGU + 32 * MiB;
constexpr size_t OFF_XS = OFF_WD + 16 * MiB;
constexpr size_t OFF_YB = OFF_XS;
static_assert(SZ_ROWS <= 33 * MiB && OFF_XS + (size_t)(NEXP * ESLOTS + 256) * DM * 2 <= 256 * MiB, "overlay map");

struct Params {
    const float *x, *meta, *g_mix, *w_in, *lq1, *lk1, *lq2, *lk2, *g_subln, *g_qnorm, *g_knorm, *w_ba, *w_bb, *w_out, *g_ffn, *w_router, *w_gate, *w_up, *w_down, *g_final;
    float* out; unsigned char* ws;
};

__device__ __forceinline__ int TID() { int t = threadIdx.x; asm volatile("" : "+v"(t)); return t; }
__device__ __forceinline__ unsigned f2bf(float f) { unsigned u = __builtin_bit_cast(unsigned, f); return (u + 0x7fffu + ((u >> 16) & 1u)) >> 16; }
__device__ __forceinline__ float bf2f(unsigned h) { return __builtin_bit_cast(float, h << 16); }
__device__ __forceinline__ float wave_sum(float v) {
#pragma unroll
    for (int o = 1; o < 64; o <<= 1) v += __shfl_xor(v, o);
    return v;
}
__device__ __forceinline__ float wave_max(float v) {
#pragma unroll
    for (int o = 1; o < 64; o <<= 1) v = fmaxf(v, __shfl_xor(v, o));
    return v;
}
struct RowInfo { int b, t, meta, valid; };
__device__ __forceinline__ RowInfo row_decode(int r) {
    RowInfo ri;
    if (r < MREAL) { ri.b = r >> 13; ri.t = r & (SEQ - 1); ri.meta = 0; ri.valid = 1; }
    else if (r < MROWS) { ri.b = (r - MREAL) >> 4; ri.t = (r - MREAL) & 15; ri.meta = 1; ri.valid = 1; }
    else { ri.b = 0; ri.t = 0; ri.meta = 1; ri.valid = 0; }
    return ri;
}
__device__ __forceinline__ int row_key(const RowInfo& ri) { return ri.meta ? ri.t : 64 + ri.t; }
__device__ __forceinline__ int row_q(const RowInfo& ri) { return ri.meta ? SEQ + ri.t : ri.t; }
__device__ __forceinline__ int row_pos(const RowInfo& ri) { return ri.meta ? ri.t : NMETA + ri.t; }
__device__ __forceinline__ int pos_row(int b, int pos) { return pos < NMETA ? MREAL + b * NMETA + pos : b * SEQ + (pos - NMETA); }
__device__ __forceinline__ const float* h_row(const Params& p, int r) { RowInfo ri = row_decode(r); return ri.meta ? p.meta + (size_t)ri.t * DM : p.x + (size_t)r * DM; }

__device__ __forceinline__ void phase0(const Params& p, int vb, int nvb) {
    const int tid = TID(), lane = tid & 63, wave = tid >> 6;
    const int gt = vb * NTHREADS + tid;
    if (gt < 128 * 32) {
        const int pos = gt >> 5, j = gt & 31;
        const float ang = (float)pos * INVF[j];
        const double xd = (double)ang, kq = __builtin_rint(xd * 0.15915494309189535);
        const double rr = (xd - kq * 6.283185307179586) * 0.25, r2 = rr * rr;
        double sn = 1.0 / 1307674368000.0, cn = 1.0 / 87178291200.0;
        sn = sn * r2 * -1.0 + 1.0 / 6227020800.0; cn = cn * r2 * -1.0 + 1.0 / 479001600.0;
        sn = sn * r2 * -1.0 + 1.0 / 39916800.0;   cn = cn * r2 * -1.0 + 1.0 / 3628800.0;
        sn = sn * r2 * -1.0 + 1.0 / 362880.0;     cn = cn * r2 * -1.0 + 1.0 / 40320.0;
        sn = sn * r2 * -1.0 + 1.0 / 5040.0;       cn = cn * r2 * -1.0 + 1.0 / 720.0;
        sn = sn * r2 * -1.0 + 1.0 / 120.0;        cn = cn * r2 * -1.0 + 1.0 / 24.0;
        sn = sn * r2 * -1.0 + 1.0 / 6.0;          cn = cn * r2 * -1.0 + 0.5;
        sn = (sn * r2 * -1.0 + 1.0) * rr;         cn = cn * r2 * -1.0 + 1.0;
        double s2 = 2.0 * sn * cn, c2 = cn * cn - sn * sn;
        double s4 = 2.0 * s2 * c2, c4 = c2 * c2 - s2 * s2;
        float2 cs; cs.x = (float)c4; cs.y = (float)s4;
        ((float2*)(p.ws + OFF_ROPE))[gt] = cs;
    }
    if (vb == 0 && wave == 0) {
        float a = p.lq1[lane] * p.lk1[lane], c = p.lq2[lane] * p.lk2[lane];
        a = wave_sum(a); c = wave_sum(c);
        if (lane == 0) *(float*)(p.ws + OFF_LAM) = expf(a) - expf(c) + LAM_INIT;
    }
    bf16_t* UN = (bf16_t*)(p.ws + OFF_UN);
    for (int r = vb * 8 + wave; r < MPAD; r += nvb * 8) {
        u32x2* o = (u32x2*)(UN + (size_t)r * DM) + lane;
        if (r >= MROWS) {
#pragma unroll
            for (int j = 0; j < 4; ++j) o[64 * j] = (u32x2){0u, 0u};
            continue;
        }
        const f32x4* xr = (const f32x4*)h_row(p, r) + lane;
        f32x4 v[4]; float s = 0.f;
#pragma unroll
        for (int j = 0; j < 4; ++j) { v[j] = xr[64 * j]; s += (v[j].x * v[j].x + v[j].y * v[j].y) + (v[j].z * v[j].z + v[j].w * v[j].w); }
        const float rstd = 1.0f / sqrtf(wave_sum(s) * (1.0f / DM) + EPS);
#pragma unroll
        for (int j = 0; j < 4; ++j) {
            const f32x4 g = ((const f32x4*)p.g_mix)[lane + 64 * j];
            u32x2 w; w.x = f2bf(v[j].x * rstd * g.x) | (f2bf(v[j].y * rstd * g.y) << 16); w.y = f2bf(v[j].z * rstd * g.z) | (f2bf(v[j].w * rstd * g.w) << 16);
            o[64 * j] = w;
        }
    }
    {
        bf16_t* KA = (bf16_t*)(p.ws + OFF_KA); bf16_t* VA = (bf16_t*)(p.ws + OFF_VA); bf16_t* KB = (bf16_t*)(p.ws + OFF_KB); bf16_t* VB = (bf16_t*)(p.ws + OFF_VB);
        const int per = 48 * 128 / 8;
        for (int i = vb * NTHREADS + tid; i < (16 + 16 + 4 + 4) * per; i += nvb * NTHREADS) {
            const int bh = i / per, o = i % per; bf16_t* base;
            if (bh < 16) base = KA + (size_t)bh * KEYS * 128; else if (bh < 32) base = VA + (size_t)(bh - 16) * KEYS * 128;
            else if (bh < 36) base = KB + (size_t)(bh - 32) * KEYS * 128; else base = VB + (size_t)(bh - 36) * KEYS * 128;
            ((u32x4*)(base + 16 * 128))[o] = (u32x4){0u, 0u, 0u, 0u};
        }
    }
}

namespace fa {
using bf16x8 = __attribute__((ext_vector_type(8))) short;
using s16x4  = __attribute__((ext_vector_type(4))) short;
using f32x16 = __attribute__((ext_vector_type(16))) float;
constexpr int NT = KEYS / 64;
constexpr int SLOT = 16384;
constexpr int NSLOT = 4;
constexpr int L_V = 0, L_K = NSLOT * SLOT, L_WS = 2 * NSLOT * SLOT, L_X = 0;
constexpr int LDS_ATTN = L_WS + 8 * 64 * 4;
constexpr float THR = 8.f;
#define KSWZ(row, colB) ((row) * 256 + ((colB) ^ (((row) & 7) << 4)))
#define SBAR() __builtin_amdgcn_sched_barrier(0)
__device__ __forceinline__ int crow(int r, int hi) { return (r & 3) + 8 * (r >> 2) + 4 * hi; }
__device__ __forceinline__ unsigned cvtpk(float lo, float hi) { unsigned r; asm volatile("v_cvt_pk_bf16_f32 %0, %1, %2" : "=v"(r) : "v"(lo), "v"(hi)); return r; }
__device__ __forceinline__ void partialSM(f32x16& p0, f32x16& p1, float& m_reg, float& mn, float& alpha) {
    float pmax = p0[0];
#pragma unroll
    for (int r = 1; r < 16; ++r) pmax = fmaxf(pmax, p0[r]);
#pragma unroll
    for (int r = 0; r < 16; ++r) pmax = fmaxf(pmax, p1[r]);
    { auto rr = __builtin_amdgcn_permlane32_swap(__float_as_uint(pmax), __float_as_uint(pmax), false, false);
      pmax = fmaxf(__uint_as_float(rr[0]), __uint_as_float(rr[1])); }
    if (__builtin_expect(__all(pmax - m_reg <= THR), 1)) { mn = m_reg; alpha = 1.f; }
    else { mn = fmaxf(m_reg, pmax); alpha = __builtin_amdgcn_exp2f(m_reg - mn); m_reg = mn; }
#pragma unroll
    for (int r = 0; r < 16; ++r) { p0[r] -= mn; p1[r] -= mn; }
#pragma unroll
    for (int r = 0; r < 16; ++r) p0[r] = __builtin_amdgcn_exp2f(p0[r]);
}
__device__ __forceinline__ void finishSM(f32x16& p0, f32x16& p1, float alpha, float& l_reg, bf16x8& pa0, bf16x8& pa1, bf16x8& pa2, bf16x8& pa3) {
#pragma unroll
    for (int r = 0; r < 16; ++r) p1[r] = __builtin_amdgcn_exp2f(p1[r]);
    float ps = 0;
#pragma unroll
    for (int r = 0; r < 16; ++r) ps += p0[r];
#pragma unroll
    for (int r = 0; r < 16; ++r) ps += p1[r];
    { auto rr = __builtin_amdgcn_permlane32_swap(__float_as_uint(ps), __float_as_uint(ps), false, false);
      ps = __uint_as_float(rr[0]) + __uint_as_float(rr[1]); }
    l_reg = l_reg * alpha + ps;
#define PK4(P, BASE, OUT) do { unsigned a0 = cvtpk(P[BASE + 0], P[BASE + 1]), a1 = cvtpk(P[BASE + 2], P[BASE + 3]);   \
    unsigned b0 = cvtpk(P[BASE + 4], P[BASE + 5]), b1 = cvtpk(P[BASE + 6], P[BASE + 7]);                              \
    auto r0 = __builtin_amdgcn_permlane32_swap(a0, b0, false, false); auto r1 = __builtin_amdgcn_permlane32_swap(a1, b1, false, false); \
    u32x4 w = {r0[0], r1[0], r0[1], r1[1]}; OUT = *reinterpret_cast<bf16x8*>(&w); } while (0)
    PK4(p0, 0, pa0); PK4(p0, 8, pa1); PK4(p1, 0, pa2); PK4(p1, 8, pa3);
#undef PK4
}
template <int ND0>
__device__ __forceinline__ void qkt(f32x16& p0, f32x16& p1, const char* Ks, const bf16x8* qr, int d0b, int r32, int hi) {
    p0 = f32x16{}; p1 = f32x16{};
#pragma unroll
    for (int d0 = 0; d0 < ND0; ++d0) { const int cb = ((d0b + d0) * 16 + hi * 8) * 2;
        const bf16x8 b0 = *reinterpret_cast<const bf16x8*>(Ks + KSWZ(r32, cb));
        const bf16x8 b1 = *reinterpret_cast<const bf16x8*>(Ks + KSWZ(32 + r32, cb));
        p0 = __builtin_amdgcn_mfma_f32_32x32x16_bf16(b0, qr[d0], p0, 0, 0, 0);
        p1 = __builtin_amdgcn_mfma_f32_32x32x16_bf16(b1, qr[d0], p1, 0, 0, 0); }
}
__device__ __forceinline__ int v_st(int k, int c) { const int kk = (k & ~0xC) | ((k & 4) << 1) | ((k & 8) >> 1); return ((kk >> 3) * 4 + (c >> 5)) * 512 + ((kk & 7) * 32 + (c & 31)) * 2; }
__device__ __forceinline__ int v_rd_base(int lane) { return ((lane & 3) << 3) | (((lane >> 2) & 3) << 6) | (((lane >> 4) & 1) << 5) | (((lane >> 5) & 1) << 8); }
constexpr int v_rd_off(int d0, int ks, int half) { return d0 * 512 + ks * 4096 + half * 2048; }
template <int OFF> __device__ __forceinline__ s16x4 tr_read(int vb) {
    s16x4 r; asm volatile("ds_read_b64_tr_b16 %0, %1 offset:%2" : "=&v"(r) : "v"(vb), "i"(OFF) : "memory"); return r;
}
template <int D0> __device__ __forceinline__ void pv_one(f32x16& od, int vb, bf16x8 pa0, bf16x8 pa1, bf16x8 pa2, bf16x8 pa3) {
    const s16x4 l0 = tr_read<v_rd_off(D0, 0, 0)>(vb), h0 = tr_read<v_rd_off(D0, 0, 1)>(vb), l1 = tr_read<v_rd_off(D0, 1, 0)>(vb), h1 = tr_read<v_rd_off(D0, 1, 1)>(vb);
    const s16x4 l2 = tr_read<v_rd_off(D0, 2, 0)>(vb), h2 = tr_read<v_rd_off(D0, 2, 1)>(vb), l3 = tr_read<v_rd_off(D0, 3, 0)>(vb), h3 = tr_read<v_rd_off(D0, 3, 1)>(vb);
    asm volatile("s_waitcnt lgkmcnt(0)" ::: "memory"); SBAR();
#define PK(L, H) (bf16x8){L[0], L[1], L[2], L[3], H[0], H[1], H[2], H[3]}
    od = __builtin_amdgcn_mfma_f32_32x32x16_bf16(pa0, PK(l0, h0), od, 0, 0, 0);
    od = __builtin_amdgcn_mfma_f32_32x32x16_bf16(pa1, PK(l1, h1), od, 0, 0, 0);
    od = __builtin_amdgcn_mfma_f32_32x32x16_bf16(pa2, PK(l2, h2), od, 0, 0, 0);
    od = __builtin_amdgcn_mfma_f32_32x32x16_bf16(pa3, PK(l3, h3), od, 0, 0, 0);
#undef PK
}
__device__ __forceinline__ void pv_d0(f32x16* o, int vb, bf16x8 pa0, bf16x8 pa1, bf16x8 pa2, bf16x8 pa3) {
    pv_one<0>(o[0], vb, pa0, pa1, pa2, pa3); pv_one<1>(o[1], vb, pa0, pa1, pa2, pa3); pv_one<2>(o[2], vb, pa0, pa1, pa2, pa3); pv_one<3>(o[3], vb, pa0, pa1, pa2, pa3);
}

__device__ __forceinline__ void glds16(const void* gsrc, unsigned lds_dst) { unsigned keep;
    asm volatile("s_mov_b32 %0, m0\n\ts_mov_b32 m0, %2\n\ts_nop 0\n\tglobal_load_lds_dwordx4 %1, off\n\ts_mov_b32 m0, %0" : "=&s"(keep) : "v"(gsrc), "s"(lds_dst) : "memory"); }
#define WAIT_BAR() asm volatile("s_waitcnt vmcnt(0) lgkmcnt(0)\n\ts_barrier" ::: "memory")
#define WAIT_BAR4() asm volatile("s_waitcnt vmcnt(4) lgkmcnt(0)\n\ts_barrier" ::: "memory")
template <bool DIFF>
__device__ __forceinline__ void attn_unit(const bf16x8 (&qr)[DIFF ? 4 : 8], const bf16_t* __restrict__ Kh, const bf16_t* __restrict__ Vh, int tq, float slopeL, char* lds, int t0, int t1, bool active,
                                          f32x16 (&o)[4], float& l_reg, float& m_reg) {
    constexpr int ND0 = DIFF ? 4 : 8;
    const int tid = TID(), wid = __builtin_amdgcn_readfirstlane(tid >> 6), lane = tid & 63, r32 = lane & 31, hi = lane >> 5;
    char* V_lds = lds + L_V; char* K_lds = lds + L_K;
    float* al_l = (float*)(lds + L_WS) + wid * 64 + 32;
    const int d0b = DIFF ? (wid >> 2) * 4 : 0;
    m_reg = -1e30f; l_reg = 0.f;
#pragma unroll
    for (int d = 0; d < 4; ++d) o[d] = f32x16{};
    const char* ksrc; const char* vsrc;
    { const int row = 4 * wid + (lane >> 4), colB = ((lane & 15) * 16) ^ ((row & 7) << 4);
      ksrc = (const char*)Kh + row * 256 + colB;
      const int sub = 2 * wid + (lane >> 5), kk = (sub >> 2) * 8 + ((lane & 31) >> 2), col = (sub & 3) * 32 + (lane & 3) * 8, k = (kk & ~0xC) | ((kk & 4) << 1) | ((kk & 8) >> 1);
      vsrc = (const char*)Vh + k * 256 + col * 2; }
    const unsigned lds0 = (unsigned)(uintptr_t)lds;
    const unsigned kdst = lds0 + L_K + wid * 1024, vdst = lds0 + L_V + wid * 1024;
#define DMA_TILE(t, slot) do { const size_t to_ = (size_t)(t) * SLOT; const unsigned kd_ = (unsigned)__builtin_amdgcn_readfirstlane(kdst + (slot)), vd_ = (unsigned)__builtin_amdgcn_readfirstlane(vdst + (slot)); \
    glds16(ksrc + to_, kd_); glds16(ksrc + to_ + 8192, kd_ + 8192); glds16(vsrc + to_, vd_); glds16(vsrc + to_ + 8192, vd_ + 8192); } while (0)
    const int vb0 = (int)(uintptr_t)V_lds + v_rd_base(lane);
#define RESC(a) do { if (__any((a) < 1.f)) { if (hi == 0) al_l[r32] = (a); asm volatile("s_waitcnt lgkmcnt(0)" ::: "memory"); \
    _Pragma("unroll") for (int d = 0; d < 4; ++d) _Pragma("unroll") for (int r = 0; r < 16; ++r) o[d][r] *= al_l[crow(r, hi)]; } } while (0)
#define MASK0(P0, P1) do { _Pragma("unroll") for (int r = 8; r < 16; ++r) P0[r] = -1e30f; _Pragma("unroll") for (int r = 0; r < 16; ++r) P1[r] = -1e30f; } while (0)
#define FIXUP(P0, P1, j) do { if (DIFF) { const float base_ = (float)(tq - ((j) - 1) * 64 - 4 * hi); \
    _Pragma("unroll") for (int r = 0; r < 16; ++r) { const float d_ = base_ - (float)((r & 3) + 8 * (r >> 2)); \
        P0[r] = fmaf(-slopeL, fabsf(d_), P0[r]); P1[r] = fmaf(-slopeL, fabsf(d_ - 32.f), P1[r]); } } } while (0)
#define ROT() do { prv = cur; cur = nxt; nxt = nx2; nx2 = (nx2 == (NSLOT - 1) * SLOT) ? 0 : nx2 + SLOT; } while (0)
    f32x16 pA0, pA1, pB0, pB1; float mnA = 0.f, mnB = 0.f, alA = 1.f, alB = 1.f; bf16x8 pa0, pa1, pa2, pa3;
    int prv = 0, cur = 0, nxt = SLOT, nx2 = 2 * SLOT;
    DMA_TILE(t0, 0); DMA_TILE(t0 + 1, SLOT);
    WAIT_BAR4();
    DMA_TILE(t0 + 2, 2 * SLOT);
    if (active) { qkt<ND0>(pA0, pA1, K_lds, qr, d0b, r32, hi); if (t0 == 0) MASK0(pA0, pA1); else FIXUP(pA0, pA1, t0); partialSM(pA0, pA1, m_reg, mnA, alA); }
    WAIT_BAR4(); ROT();
    for (int j = t0 + 1; j + 1 < t1; j += 2) {
        if (j + 2 < t1) DMA_TILE(j + 2, nx2);
        if (active) { SBAR(); qkt<ND0>(pB0, pB1, K_lds + cur, qr, d0b, r32, hi); FIXUP(pB0, pB1, j);
            finishSM(pA0, pA1, alA, l_reg, pa0, pa1, pa2, pa3); SBAR();
            pv_d0(o, vb0 + prv, pa0, pa1, pa2, pa3); partialSM(pB0, pB1, m_reg, mnB, alB);
            RESC(alB); }
        if (j + 2 < t1) WAIT_BAR4(); else WAIT_BAR();
        ROT();
        if (j + 3 < t1) DMA_TILE(j + 3, nx2);
        if (active) { SBAR(); qkt<ND0>(pA0, pA1, K_lds + cur, qr, d0b, r32, hi); FIXUP(pA0, pA1, j + 1);
            finishSM(pB0, pB1, alB, l_reg, pa0, pa1, pa2, pa3); SBAR();
            pv_d0(o, vb0 + prv, pa0, pa1, pa2, pa3); partialSM(pA0, pA1, m_reg, mnA, alA);
            RESC(alA); }
        if (j + 3 < t1) WAIT_BAR4(); else WAIT_BAR();
        ROT();
    }
    if (active) {
        finishSM(pA0, pA1, alA, l_reg, pa0, pa1, pa2, pa3); SBAR();
        pv_d0(o, vb0 + prv, pa0, pa1, pa2, pa3);
    }
    WAIT_BAR();
#undef DMA_TILE
#undef RESC
#undef FIXUP
#undef MASK0
#undef ROT
}

namespace fb {
using fa::bf16x8; using fa::s16x4; using fa::f32x16; using fa::crow; using fa::cvtpk; using fa::glds16;
constexpr int SLOT = 16384, KSL = 4, VSL = 3;
constexpr int L_K = 0, L_V = KSL * SLOT, L_WS = L_V + VSL * SLOT, L_END = L_WS + 8 * 64 * 4;
constexpr float THR = 8.f;
typedef __attribute__((address_space(3))) const char* lds_cptr;
typedef short v4i16_t __attribute__((ext_vector_type(4)));
#define FB_SBAR() __builtin_amdgcn_sched_barrier(0)
#define FB_PIN(x) asm volatile("" : "+v"(x))
#define FB_MFMA(a, b, c) __builtin_amdgcn_mfma_f32_32x32x16_bf16(a, b, c, 0, 0, 0)
#define FB_WAIT_BAR(N) asm volatile("s_waitcnt vmcnt(" #N ") lgkmcnt(0)\n\ts_barrier" ::: "memory")
#define FB_MX3(a, b, c) __builtin_fmaxf(__builtin_fmaxf((a), (b)), (c))
__device__ __forceinline__ bf16x8 kfrag(lds_cptr kp, int f) { return *(const __attribute__((address_space(3))) bf16x8*)(kp + (f >> 1) * 2048 + (f & 1) * 512); }
__device__ __forceinline__ s16x4 vtr(lds_cptr p) { return __builtin_bit_cast(s16x4, __builtin_amdgcn_ds_read_tr16_b64_v4i16((__attribute__((address_space(3))) v4i16_t*)p)); }
__device__ __forceinline__ float rowmax(const f32x16& p0, const f32x16& p1) {
    float a = FB_MX3(p0[0], p0[1], p1[0]), b = FB_MX3(p0[2], p0[3], p1[1]); a = FB_MX3(a, p1[2], p1[3]);
#pragma unroll
    for (int r = 4; r < 16; r += 4) { a = FB_MX3(a, p0[r], p0[r + 1]); b = FB_MX3(b, p0[r + 2], p0[r + 3]); a = FB_MX3(a, p1[r], p1[r + 1]); b = FB_MX3(b, p1[r + 2], p1[r + 3]); }
    float m = __builtin_fmaxf(a, b); auto rr = __builtin_amdgcn_permlane32_swap(__float_as_uint(m), __float_as_uint(m), false, false);
    return __builtin_fmaxf(__uint_as_float(rr[0]), __uint_as_float(rr[1])); }
__device__ __forceinline__ void split3(float w, unsigned& h1, unsigned& h2, unsigned& h3) {
    h1 = __float_as_uint(w) & 0xffff0000u; const float r1 = w - __uint_as_float(h1);
    h2 = __float_as_uint(r1) & 0xffff0000u; const float r2 = r1 - __uint_as_float(h2);
    h3 = __float_as_uint(r2) & 0xffff0000u; }

template <bool DIFF, bool IDLE = false>
__device__ __forceinline__ void attn_unit(const bf16x8 (&qr)[DIFF ? 4 : 8], const bf16_t* __restrict__ Kh, const bf16_t* __restrict__ Vh, int tq, int wrow0, float slopeL, char* lds,
                                          int tfirst, int tbase, int n, f32x16 (&o)[4], float& l_reg, float& mhat) {
    constexpr bool active = !IDLE;
    constexpr int ND0 = DIFF ? 4 : 8, NQ = 2 * ND0;
    const int tid = TID(), lane = tid & 63, r32 = lane & 31, hi = lane >> 5; const int wid = __builtin_amdgcn_readfirstlane(tid >> 6);
    const unsigned lds0 = (unsigned)(uintptr_t)lds; float* wsf = (float*)(lds + L_WS) + wid * 64;
    const char* ksrc = (const char*)Kh + lane * 256 + wid * 16;
    const char* vsrc = (const char*)Vh + (16 * (wid & 3) + (lane >> 2)) * 256 + (wid >> 2) * 64 + (lane & 3) * 16;
    const unsigned kdst = lds0 + L_K + wid * 1024, vdst = lds0 + L_V + wid * 1024;
#define TILE_OF(i) (tbase + (i))
#define DMA_K(i, slot) do { const char* s_ = ksrc + (size_t)TILE_OF(i) * SLOT; const unsigned d_ = (unsigned)__builtin_amdgcn_readfirstlane(kdst + (slot)); glds16(s_, d_); glds16(s_ + 128, d_ + 8192); } while (0)
#define DMA_V(i, slot) do { const char* s_ = vsrc + (size_t)TILE_OF(i) * SLOT; const unsigned d_ = (unsigned)__builtin_amdgcn_readfirstlane(vdst + (slot)); glds16(s_, d_); glds16(s_ + 128, d_ + 8192); } while (0)
    const lds_cptr vp0 = (lds_cptr)lds + L_V + ((lane >> 4) & 1) * 32 + (lane & 3) * 8 + (4 * hi + ((lane & 15) >> 2)) * 64;
    const lds_cptr kp0 = (lds_cptr)lds + L_K + hi * 1024 + r32 * 16 + (DIFF ? (wid >> 2) * 8192 : 0);
    mhat = 0.f; l_reg = 0.f;
#pragma unroll
    for (int d = 0; d < 4; ++d) o[d] = f32x16{};
    const f32x16 zero16 = f32x16{};
    bool resc = false;
    f32x16 pA0, pA1, pB0, pB1; bf16x8 kf[4]; s16x4 vlo[4], vhi[4]; u32x4 pw0, pw1, pw2, pw3;
    bf16x8 kx0 = bf16x8{}, kx1 = bf16x8{}, qx = bf16x8{}; unsigned sl1 = 0, sl2 = 0, sl3 = 0;
    if (DIFF) { if (hi == 0) { const unsigned c0 = __float_as_uint((float)r32) >> 16, c1 = __float_as_uint((float)(32 + r32)) >> 16;
            u32x4 a = {0x3F803F80u, 0x3F80u | (c0 << 16), c0 | (c0 << 16), 0u}, b = {0x3F803F80u, 0x3F80u | (c1 << 16), c1 | (c1 << 16), 0u};
            kx0 = __builtin_bit_cast(bf16x8, a); kx1 = __builtin_bit_cast(bf16x8, b); }
        split3(slopeL, sl1, sl2, sl3); }
#define SIDE_OF(j) ((j) == 0 ? 0 : (64 * ((j) - 1) + 63 <= wrow0) ? 1 : (64 * ((j) - 1) >= wrow0 + 31) ? -1 : 0)
#define BUILD_QX(j) do { if (DIFF) { const int sd_ = SIDE_OF(j); float w_ = -mhat; unsigned sg_ = 0u, keep_ = 0u; \
        if (sd_ != 0) { const float lin_ = slopeL * (float)(tq - 64 * ((j) - 1)); w_ += sd_ > 0 ? -lin_ : lin_; sg_ = sd_ > 0 ? 0u : 0x80000000u; keep_ = 0xffffffffu; } \
        unsigned h1_, h2_, h3_; split3(w_, h1_, h2_, h3_); const unsigned a1_ = (sl1 ^ sg_) & keep_, a2_ = (sl2 ^ sg_) & keep_, a3_ = (sl3 ^ sg_) & keep_; \
        u32x4 q_ = {(h1_ >> 16) | h2_, (h3_ >> 16) | a1_, (a2_ >> 16) | a3_, 0u}; if (hi != 0) q_ = (u32x4){0u, 0u, 0u, 0u}; qx = __builtin_bit_cast(bf16x8, q_); } } while (0)
#define FIXUP(C0, C1, j) do { if ((j) == 0) { _Pragma("unroll") for (int r = 8; r < 16; ++r) C0[r] = -1e30f; _Pragma("unroll") for (int r = 0; r < 16; ++r) C1[r] = -1e30f; } \
        else if (DIFF && SIDE_OF(j) == 0) { const float base_ = (float)(tq - ((j) - 1) * 64 - 4 * hi); \
            _Pragma("unroll") for (int r = 0; r < 16; ++r) { const float d_ = base_ - (float)((r & 3) + 8 * (r >> 2)); \
                C0[r] = fmaf(-slopeL, fabsf(d_), C0[r]); C1[r] = fmaf(-slopeL, fabsf(d_ - 32.f), C1[r]); } } } while (0)
#define PFLAT(P0, P1, e) ((e) < 16 ? P0[(e) & 15] : P1[(e) & 15])
#define PWSET(u, v) do { if ((u) < 4) pw0[(u) & 3] = (v); else if ((u) < 8) pw1[(u) & 3] = (v); else if ((u) < 12) pw2[(u) & 3] = (v); else pw3[(u) & 3] = (v); } while (0)
#define PAF(k) __builtin_bit_cast(bf16x8, (k) == 0 ? pw0 : (k) == 1 ? pw1 : (k) == 2 ? pw2 : pw3)
#define VFR(i) (bf16x8){vlo[i][0], vlo[i][1], vlo[i][2], vlo[i][3], vhi[i][0], vhi[i][1], vhi[i][2], vhi[i][3]}
#define VRD(slotv, f, dst) do { const lds_cptr a_ = vp0 + (slotv) + ((f) >> 2) * 4096 + ((f) & 3) * 1024; vlo[dst] = vtr(a_); vhi[dst] = vtr(a_ + 512); } while (0)
#define AUNIT(P0, P1, u) do { sacc += PFLAT(P0, P1, 2 * (u)); sacc += PFLAT(P0, P1, 2 * (u) + 1); PWSET(u, cvtpk(PFLAT(P0, P1, 2 * (u)), PFLAT(P0, P1, 2 * (u) + 1))); } while (0)
#define EXPU(C0, C1, u) do { if ((u) < 8) { C0[2 * ((u) & 7)] = __builtin_amdgcn_exp2f(C0[2 * ((u) & 7)] - sub_); C0[2 * ((u) & 7) + 1] = __builtin_amdgcn_exp2f(C0[2 * ((u) & 7) + 1] - sub_); } \
        else { C1[2 * ((u) & 7)] = __builtin_amdgcn_exp2f(C1[2 * ((u) & 7)] - sub_); C1[2 * ((u) & 7) + 1] = __builtin_amdgcn_exp2f(C1[2 * ((u) & 7) + 1] - sub_); } } while (0)
#define STEP(C0, C1, P0, P1, i, GK, GV, GL) do { \
    const int j_ = TILE_OF(i); const lds_cptr kp_ = kp0 + kcur; const lds_cptr kn_ = kp0 + knxt; \
    if (active) { BUILD_QX(j_); FB_SBAR(); float sacc = 0.f; \
        if (DIFF) { C0 = FB_MFMA(kx0, qx, zero16); AUNIT(P0, P1, 0); FB_PIN(sacc); FB_PIN(pw0); FB_SBAR(); \
                    C1 = FB_MFMA(kx1, qx, zero16); AUNIT(P0, P1, 1); AUNIT(P0, P1, 2); FB_PIN(sacc); FB_PIN(pw0); FB_SBAR(); } \
        _Pragma("unroll") for (int g = 0; g < NQ; ++g) { \
            if (g & 1) C1 = FB_MFMA(kf[g & 3], qr[g >> 1], (!DIFF && g < 2) ? zero16 : C1); else C0 = FB_MFMA(kf[g & 3], qr[g >> 1], (!DIFF && g < 2) ? zero16 : C0); \
            if (g + 4 < NQ) kf[g & 3] = kfrag(kp_, g + 4); \
            if (DIFF) { if (g < 5) { AUNIT(P0, P1, 3 + 2 * g); AUNIT(P0, P1, 4 + 2 * g); } else AUNIT(P0, P1, 8 + g); } else AUNIT(P0, P1, g); \
            if (g >= NQ - 4) VRD(vprv, g - (NQ - 4), g - (NQ - 4)); \
            FB_PIN(sacc); FB_PIN(pw0); FB_PIN(pw1); FB_PIN(pw2); FB_PIN(pw3); FB_SBAR(); } \
        l_reg += sacc; } \
    if (GK) DMA_K((i) + 3, kfree); if (GV) DMA_V((i) + 1, vnxt); \
    float sub_ = 0.f; \
    if (active) { FIXUP(C0, C1, j_); \
        { const float rm = rowmax(C0, C1) - (DIFF ? 0.f : mhat); resc = false; \
          if (__builtin_expect(__any(rm > THR), 0)) { const float dl = __builtin_fmaxf(rm, 0.f); mhat += dl; \
              if (DIFF) { _Pragma("unroll") for (int r = 0; r < 16; ++r) { C0[r] -= dl; C1[r] -= dl; } } \
              const float f = __builtin_amdgcn_exp2f(-dl); l_reg *= f; if (hi == 0) wsf[r32] = f; resc = true; } } \
        sub_ = DIFF ? 0.f : mhat; FB_SBAR(); \
        _Pragma("unroll") for (int g = 0; g < 16; ++g) { \
            o[g >> 2] = FB_MFMA(PAF(g & 3), VFR(g & 3), o[g >> 2]); \
            if (g + 4 < 16) VRD(vprv, g + 4, g & 3); \
            EXPU(C0, C1, g); \
            if ((GL) && g >= 4 && g < 8) kf[g - 4] = kfrag(kn_, g - 4); \
            FB_PIN(C0); FB_PIN(C1); FB_SBAR(); } } \
    } while (0)
#define RESC() do { if (active && resc) { _Pragma("unroll") for (int d_ = 0; d_ < 4; ++d_) _Pragma("unroll") for (int r = 0; r < 16; ++r) o[d_][r] *= wsf[crow(r, hi)]; } } while (0)
    int kcur = 0, knxt = SLOT, kfree = 3 * SLOT, vprv = 0, vnxt = SLOT;
#define ROT() do { kfree = kcur; kcur = knxt; knxt = (knxt == (KSL - 1) * SLOT) ? 0 : knxt + SLOT; vprv = (vnxt == 0) ? (VSL - 1) * SLOT : vnxt - SLOT; vnxt = (vnxt == (VSL - 1) * SLOT) ? 0 : vnxt + SLOT; } while (0)
    DMA_K(0, 0); DMA_V(0, 0); DMA_K(1, SLOT); DMA_K(2, 2 * SLOT);
    FB_WAIT_BAR(6);
    if (n > 3) DMA_K(3, 3 * SLOT);
    DMA_V(1, SLOT);
    if (active) { const int j0 = tfirst; BUILD_QX(j0);
        if (DIFF) { pA0 = FB_MFMA(kx0, qx, zero16); pA1 = FB_MFMA(kx1, qx, zero16); }
#pragma unroll
        for (int g = 0; g < NQ; ++g) { const bf16x8 kk = kfrag(kp0, g);
            if (g & 1) pA1 = FB_MFMA(kk, qr[g >> 1], (!DIFF && g < 2) ? zero16 : pA1); else pA0 = FB_MFMA(kk, qr[g >> 1], (!DIFF && g < 2) ? zero16 : pA0); }
        FIXUP(pA0, pA1, j0);
        const float rm = rowmax(pA0, pA1); mhat = rm;
#pragma unroll
        for (int r = 0; r < 16; ++r) { pA0[r] = __builtin_amdgcn_exp2f(pA0[r] - rm); pA1[r] = __builtin_amdgcn_exp2f(pA1[r] - rm); } }
    if (n > 3) FB_WAIT_BAR(4); else FB_WAIT_BAR(2);
    kcur = SLOT; knxt = 2 * SLOT; kfree = 0; vprv = 0; vnxt = 2 * SLOT;
    if (active) {
#pragma unroll
        for (int g = 0; g < 4; ++g) kf[g] = kfrag(kp0 + kcur, g); }
    int i = 1;
    for (; i + 1 < n; i += 2) {
        STEP(pB0, pB1, pA0, pA1, i, (i + 3 < n), (i + 1 < n), (i + 1 < n));
        if (i + 3 < n) FB_WAIT_BAR(4); else FB_WAIT_BAR(0);
        RESC(); ROT();
        STEP(pA0, pA1, pB0, pB1, i + 1, (i + 4 < n), (i + 2 < n), (i + 2 < n));
        if (i + 4 < n) FB_WAIT_BAR(4); else FB_WAIT_BAR(0);
        RESC(); ROT();
    }
    if (active) { float sacc = 0.f;
#pragma unroll
        for (int u = 0; u < 16; ++u) AUNIT(pA0, pA1, u);
        l_reg += sacc;
#pragma unroll
        for (int g = 0; g < 16; ++g) { VRD(vprv, g, 0); o[g >> 2] = FB_MFMA(PAF(g & 3), VFR(0), o[g >> 2]); } }
    FB_WAIT_BAR(0);
#undef TILE_OF
#undef DMA_K
#undef DMA_V
#undef SIDE_OF
#undef BUILD_QX
#undef FIXUP
#undef PFLAT
#undef PWSET
#undef PAF
#undef VFR
#undef VRD
#undef AUNIT
#undef EXPU
#undef STEP
#undef RESC
#undef ROT
}
}

template <class RowPtr>
__device__ __forceinline__ void store_tile(const f32x16 (&y)[4], char* stage, int lane, RowPtr rowptr) {
    const int r32 = lane & 31, hi = lane >> 5;
    bf16_t* stg = (bf16_t*)stage;
#pragma unroll
    for (int r = 0; r < 16; ++r) { const int orow = crow(r, hi);
#pragma unroll
        for (int d0 = 0; d0 < 4; ++d0) stg[orow * 136 + d0 * 32 + r32] = (bf16_t)f2bf(y[d0][r]); }
    asm volatile("s_waitcnt lgkmcnt(0)" ::: "memory");
#pragma unroll
    for (int i = 0; i < 8; ++i) { const int row = i * 4 + (lane >> 4), ch = lane & 15;
        const u32x4 v = *(const u32x4*)(stg + row * 136 + ch * 8);
        bf16_t* gp = rowptr(row); if (gp) *(u32x4*)(gp + ch * 8) = v; }
    asm volatile("s_waitcnt lgkmcnt(0)" ::: "memory");
}
}

constexpr int NPRB = 4 * 9 * 2 + 16 * 9;
constexpr size_t OFF_PART = (OFF_ATT_END + 255) / 256 * 256;
constexpr size_t OFF_PML = OFF_PART + (size_t)NPRB * 32 * 128 * 4;
static_assert(OFF_PML + NPRB * 32 * 2 * 4 <= 256 * MiB, "meta partials");
constexpr int NRANGE = 9;
__device__ __forceinline__ void meta_range(int r, int& t0, int& t1) { t0 = 15 * r; t1 = r == NRANGE - 1 ? fa::NT : 15 * (r + 1); }

__device__ __forceinline__ void phase2_fast(const Params& p, char* lds, int vb, int nvb) {
    using namespace fa;
    const int tid = TID(), wid = __builtin_amdgcn_readfirstlane(tid >> 6), lane0 = tid & 63;
#define WS_() ({ unsigned char* w_ = p.ws; asm volatile("" : "+s"(w_)); w_; })
#define LSUM2(l) do { auto rr_ = __builtin_amdgcn_permlane32_swap(__float_as_uint(l), __float_as_uint(l), false, false); l = __uint_as_float(rr_[0]) + __uint_as_float(rr_[1]); } while (0)
    for (int v = vb; v < 256; v += nvb) {
        const int xcd = v & 7, slot = v >> 3;
        if (v < 36 + 144) {
            f32x16 o[4]; float l_reg, m_reg; bf16x8 qr[8]; int t0, t1, rb; bool active;
            const int r32q = lane0 & 31, hiq = lane0 >> 5;
            if (v < 36) { const int g = v / NRANGE, rg = v % NRANGE, b = g >> 1, kvh = g & 1; meta_range(rg, t0, t1);
                active = wid < 2; const int h = kvh * 4 + (wid & 1) * 2 + (r32q >> 4);
                unsigned char* ws = WS_(); const bf16_t *QB = (const bf16_t*)(ws + OFF_QB), *KB = (const bf16_t*)(ws + OFF_KB), *VB = (const bf16_t*)(ws + OFF_VB);
                const bf16_t* q = QB + ((size_t)(b * 8 + h) * QROWS + SEQ + (r32q & 15)) * 128 + hiq * 8;
#pragma unroll
                for (int d0 = 0; d0 < 8; ++d0) qr[d0] = *reinterpret_cast<const bf16x8*>(q + d0 * 16);
                const size_t kvo = (size_t)(b * 2 + kvh) * KEYS * 128; rb = (g * NRANGE + rg) * 2 + (wid & 1);
                if (active) fb::attn_unit<false, false>(qr, KB + kvo, VB + kvo, 0, 0, 0.f, lds, t0, t0, t1 - t0, o, l_reg, m_reg); else fb::attn_unit<false, true>(qr, KB + kvo, VB + kvo, 0, 0, 0.f, lds, t0, t0, t1 - t0, o, l_reg, m_reg);
            } else { const int bh = (v - 36) / NRANGE, rg = (v - 36) % NRANGE; meta_range(rg, t0, t1);
                active = wid == 0; const int mp = r32q >> 4;
                unsigned char* ws = WS_(); const bf16_t *QA = (const bf16_t*)(ws + OFF_QA), *KA = (const bf16_t*)(ws + OFF_KA), *VA = (const bf16_t*)(ws + OFF_VA);
                const bf16_t* q = QA + ((size_t)bh * QROWS + SEQ + (r32q & 15)) * 128 + mp * 64 + hiq * 8;
#pragma unroll
                for (int d0 = 0; d0 < 8; ++d0) { const bf16x8 x = *reinterpret_cast<const bf16x8*>(q + (d0 & 3) * 16); qr[d0] = ((d0 >> 2) == mp) ? x : bf16x8{}; }
                const size_t kvo = (size_t)bh * KEYS * 128; rb = 72 + bh * NRANGE + rg;
                if (active) fb::attn_unit<false, false>(qr, KA + kvo, VA + kvo, 0, 0, 0.f, lds, t0, t0, t1 - t0, o, l_reg, m_reg); else fb::attn_unit<false, true>(qr, KA + kvo, VA + kvo, 0, 0, 0.f, lds, t0, t0, t1 - t0, o, l_reg, m_reg);
            }
            if (active) {
                int lane = lane0; asm volatile("" : "+v"(lane));
                const int r32 = lane & 31, hi = lane >> 5;
                LSUM2(l_reg);
                unsigned char* ws = WS_(); float* PART = (float*)(ws + OFF_PART); float* PML = (float*)(ws + OFF_PML);
                float* po = PART + (size_t)rb * 32 * 128;
#pragma unroll
                for (int r = 0; r < 16; ++r)
#pragma unroll
                    for (int d = 0; d < 4; ++d) po[crow(r, hi) * 128 + d * 32 + r32] = o[d][r];
                if (hi == 0) { PML[(rb * 32 + r32) * 2] = m_reg; PML[(rb * 32 + r32) * 2 + 1] = l_reg; }
            }
            __syncthreads();
        }
        for (int k = 0; k < 6; ++k) {
            f32x16 o[4]; float l_reg, m_reg;
            if (k < 2) {
                const int b = xcd >> 2, kvh = (xcd >> 1) & 1, h = kvh * 4 + (xcd & 1) * 2 + k, bh = b * 8 + h, qb = slot;
                { bf16x8 qr[8]; const int r32q = lane0 & 31, hiq = lane0 >> 5;
                  unsigned char* ws = WS_(); const bf16_t *QB = (const bf16_t*)(ws + OFF_QB), *KB = (const bf16_t*)(ws + OFF_KB), *VB = (const bf16_t*)(ws + OFF_VB);
                  const bf16_t* q = QB + ((size_t)bh * QROWS + qb * 256 + wid * 32 + r32q) * 128 + hiq * 8;
#pragma unroll
                  for (int d0 = 0; d0 < 8; ++d0) qr[d0] = *reinterpret_cast<const bf16x8*>(q + d0 * 16);
                  const size_t kvo = (size_t)(b * 2 + kvh) * KEYS * 128;
                  fb::attn_unit<false>(qr, KB + kvo, VB + kvo, 0, 0, 0.f, lds, 0, 0, NT, o, l_reg, m_reg); }
                int lane = lane0; asm volatile("" : "+v"(lane));
                const int r32 = lane & 31, hi = lane >> 5;
                LSUM2(l_reg);
                float* li_l = (float*)(lds + fb::L_WS) + wid * 64;
                if (hi == 0) li_l[r32] = l_reg;
                asm volatile("s_waitcnt lgkmcnt(0)" ::: "memory");
#pragma unroll
                for (int r = 0; r < 16; ++r) { const float rl = __builtin_amdgcn_rcpf(li_l[crow(r, hi)]);
#pragma unroll
                    for (int d = 0; d < 4; ++d) o[d][r] *= rl; }
                const int wave_row0 = qb * 256 + wid * 32;
                bf16_t* OB = (bf16_t*)(WS_() + OFF_AO) + 1024;
                store_tile(o, lds + wid * 8704, lane, [&](int row) -> bf16_t* { return OB + (size_t)(b * SEQ + wave_row0 + row) * AOP + h * 128; });
                __syncthreads();
            } else {
                const int bh = 2 * xcd + ((k - 2) >> 1), qb = 2 * slot + ((k - 2) & 1), b = bh >> 3, h = bh & 7, mp = wid >> 2, wq = wid & 3;
                { bf16x8 qr[4]; const int r32q = lane0 & 31, hiq = lane0 >> 5; const int qrow = qb * 128 + wq * 32 + r32q;
                  unsigned char* ws = WS_(); const bf16_t *QA = (const bf16_t*)(ws + OFF_QA), *KA = (const bf16_t*)(ws + OFF_KA), *VA = (const bf16_t*)(ws + OFF_VA);
                  const bf16_t* q = QA + ((size_t)bh * QROWS + qrow) * 128 + mp * 64 + hiq * 8;
#pragma unroll
                  for (int d0 = 0; d0 < 4; ++d0) qr[d0] = *reinterpret_cast<const bf16x8*>(q + d0 * 16);
                  const float slopeL = exp2f(-(float)(h + 1)) * LOG2E;
                  const size_t kvo = (size_t)bh * KEYS * 128;
                  fb::attn_unit<true>(qr, KA + kvo, VA + kvo, qrow, qb * 128 + wq * 32, slopeL, lds, 0, 0, NT, o, l_reg, m_reg); }
                int lane = lane0; asm volatile("" : "+v"(lane));
                const int r32 = lane & 31, hi = lane >> 5;
                LSUM2(l_reg);
                float* li_l = (float*)(lds + fb::L_WS) + wid * 64;
                if (hi == 0) li_l[r32] = l_reg;
                asm volatile("s_waitcnt lgkmcnt(0)" ::: "memory");
#pragma unroll
                for (int r = 0; r < 16; ++r) { const float rl = __builtin_amdgcn_rcpf(li_l[crow(r, hi)]);
#pragma unroll
                    for (int d = 0; d < 4; ++d) o[d][r] *= rl; }
                float* X = (float*)lds + wq * 4096;
                if (mp == 1) {
#pragma unroll
                    for (int r = 0; r < 16; ++r)
#pragma unroll
                        for (int d = 0; d < 4; ++d) X[(r * 4 + d) * 64 + lane] = o[d][r];
                }
                __syncthreads();
                if (mp == 0) {
                    const float lam = *(const float*)(WS_() + OFF_LAM);
                    float ss[16];
#pragma unroll
                    for (int r = 0; r < 16; ++r) { float a = 0.f;
#pragma unroll
                        for (int d = 0; d < 4; ++d) { const float y = o[d][r] - lam * X[(r * 4 + d) * 64 + lane]; o[d][r] = y; a += y * y; }
                        ss[r] = a; }
#pragma unroll
                    for (int r = 0; r < 16; ++r) {
                        float a = ss[r];
                        a += __shfl_xor(a, 1); a += __shfl_xor(a, 2); a += __shfl_xor(a, 4); a += __shfl_xor(a, 8); a += __shfl_xor(a, 16);
                        ss[r] = 1.0f / sqrtf(a * (1.0f / 128.f) + EPS) * (1.0f - LAM_INIT);
                    }
                    float g[4];
#pragma unroll
                    for (int d = 0; d < 4; ++d) g[d] = p.g_subln[d * 32 + r32];
#pragma unroll
                    for (int r = 0; r < 16; ++r)
#pragma unroll
                        for (int d = 0; d < 4; ++d) o[d][r] *= ss[r] * g[d];
                }
                __syncthreads();
                if (mp == 0) {
                    const int wave_row0 = qb * 128 + wq * 32;
                    bf16_t* OA = (bf16_t*)(WS_() + OFF_AO);
                    store_tile(o, lds + wid * 8704, lane, [&](int row) -> bf16_t* { return OA + (size_t)(b * SEQ + wave_row0 + row) * AOP + h * 128; });
                }
                __syncthreads();
            }
        }
    }
#undef LSUM2
#undef WS_
}
__device__ __forceinline__ void phase2b(const Params& p, int vb, int nvb) {
    const int tid = TID(), lane = tid & 63, wave = tid >> 6;
    const float* PART = (const float*)(p.ws + OFF_PART); const float* PML = (const float*)(p.ws + OFF_PML);
    bf16_t* OA = (bf16_t*)(p.ws + OFF_AO); bf16_t* OB = OA + 1024;
    const float lam = *(const float*)(p.ws + OFF_LAM);
    for (int t = vb * 8 + wave; t < 512; t += nvb * 8) {
        const int type = t >> 8, b = (t >> 7) & 1, h = (t >> 4) & 7, i = t & 15;
        float y0 = 0.f, y1 = 0.f;
        for (int mp = 0; mp < (type == 0 ? 1 : 2); ++mp) {
            int rb0, row;
            if (type == 0) { const int kvh = h >> 2, w = (h & 3) >> 1; rb0 = ((b * 2 + kvh) * NRANGE) * 2 + w; row = (h & 1) * 16 + i; }
            else { rb0 = 72 + (b * 8 + h) * NRANGE; row = mp * 16 + i; }
            const int rbs = type == 0 ? 2 : 1;
            float M = -1e30f;
            for (int r = 0; r < NRANGE; ++r) M = fmaxf(M, PML[((rb0 + r * rbs) * 32 + row) * 2]);
            float L = 0.f, a0 = 0.f, a1 = 0.f;
            for (int r = 0; r < NRANGE; ++r) { const int rb = rb0 + r * rbs; const float w = exp2f(PML[(rb * 32 + row) * 2] - M);
                L += PML[(rb * 32 + row) * 2 + 1] * w; const float2 ov = *(const float2*)(PART + ((size_t)rb * 32 + row) * 128 + 2 * lane); a0 += ov.x * w; a1 += ov.y * w; }
            const float sgn = mp == 0 ? 1.f : -lam;
            y0 += sgn * a0 / L; y1 += sgn * a1 / L;
        }
        const size_t grow = (size_t)(MREAL + b * NMETA + i);
        if (type == 0) ((unsigned*)(OB + grow * AOP + h * 128))[lane] = f2bf(y0) | (f2bf(y1) << 16);
        else { const float ss = wave_sum(y0 * y0 + y1 * y1); const float rstd = 1.0f / sqrtf(ss * (1.0f / 128.f) + EPS) * (1.0f - LAM_INIT);
            ((unsigned*)(OA + grow * AOP + h * 128))[lane] = f2bf(y0 * rstd * p.g_subln[2 * lane]) | (f2bf(y1 * rstd * p.g_subln[2 * lane + 1]) << 16); }
    }
}

__device__ __forceinline__ float* h2_row(const Params& p, int grow) { return grow < MREAL ? p.out + (size_t)grow * DM : (float*)(p.ws + OFF_H2M) + (size_t)(grow - MREAL) * DM; }
__device__ __forceinline__ void phase4a(const Params& p, float* lds, int vb, int nvb) {
    const int tid = TID(), lane = tid & 63, wave = tid >> 6;
    for (int i = tid; i < DM * NEXP; i += NTHREADS) { const int k = i >> 4, e = i & 15; lds[e * DM + k] = p.w_router[i]; }
    __syncthreads();
    bf16_t* U2 = (bf16_t*)(p.ws + OFF_UN); float* AFF = (float*)(p.ws + OFF_AFF);
    for (int r = vb * 8 + wave; r < MROWS; r += nvb * 8) {
        const RowInfo ri = row_decode(r);
        const f32x4* xr = (const f32x4*)h2_row(p, r) + lane;
        f32x4 v[4]; float s = 0.f;
#pragma unroll
        for (int j = 0; j < 4; ++j) { v[j] = xr[64 * j]; s += (v[j].x * v[j].x + v[j].y * v[j].y) + (v[j].z * v[j].z + v[j].w * v[j].w); }
        const float rstd = 1.0f / sqrtf(wave_sum(s) * (1.0f / DM) + EPS);
        u32x2* o = (u32x2*)(U2 + (size_t)r * DM) + lane;
#pragma unroll
        for (int j = 0; j < 4; ++j) {
            const f32x4 g = ((const f32x4*)p.g_ffn)[lane + 64 * j];
            v[j].x *= rstd * g.x; v[j].y *= rstd * g.y; v[j].z *= rstd * g.z; v[j].w *= rstd * g.w;
            u32x2 w; w.x = f2bf(v[j].x) | (f2bf(v[j].y) << 16); w.y = f2bf(v[j].z) | (f2bf(v[j].w) << 16);
            o[64 * j] = w;
        }
        float mylg = -1e30f;
#pragma unroll 1
        for (int e = 0; e < NEXP; ++e) {
            float a = 0.f;
#pragma unroll
            for (int j = 0; j < 4; ++j) { const f32x4 w = *(const f32x4*)(lds + e * DM + 4 * (lane + 64 * j)); a += v[j].x * w.x + v[j].y * w.y + v[j].z * w.z + v[j].w * w.w; }
            a = wave_sum(a);
            if (lane == e) mylg = a;
        }
        const float mx = wave_max(mylg);
        const float ex = lane < NEXP ? expf(mylg - mx) : 0.f;
        const float mine = ex / wave_sum(ex);
        if (lane < NEXP) AFF[((size_t)ri.b * NEXP + lane) * LTOT + row_pos(ri)] = mine;
    }
    __syncthreads();
}

__device__ __forceinline__ void phase6(const Params& p, int vb, int nvb) {
    const int tid = TID(), lane = tid & 63, wave = tid >> 6;
    const int* SEL = (const int*)(p.ws + OFF_SEL); const bf16_t* YB = (const bf16_t*)(p.ws + OFF_YB);
    for (int r = vb * 8 + wave; r < MREAL; r += nvb * 8) {
        const int b = r >> 13, tok = NMETA + (r & (SEQ - 1));
        f32x4* xr = (f32x4*)(p.out + (size_t)r * DM) + lane;
        f32x4 v[4];
#pragma unroll
        for (int j = 0; j < 4; ++j) v[j] = xr[64 * j];
        const int sel = lane < NEXP ? SEL[((size_t)b * LTOT + tok) * NEXP + lane] : -1;
        for (int e = 0; e < NEXP; ++e) {
            const int c = __shfl(sel, e);
            if (c >= 0) {
                const u32x2* y = (const u32x2*)(YB + ((size_t)e * ESLOTS + b * CAP + c) * DM) + lane;
#pragma unroll
                for (int j = 0; j < 4; ++j) { const u32x2 w = y[64 * j]; v[j].x += bf2f(w.x & 0xffffu); v[j].y += bf2f(w.x >> 16); v[j].z += bf2f(w.y & 0xffffu); v[j].w += bf2f(w.y >> 16); }
            }
        }
        float s = 0.f;
#pragma unroll
        for (int j = 0; j < 4; ++j) s += (v[j].x * v[j].x + v[j].y * v[j].y) + (v[j].z * v[j].z + v[j].w * v[j].w);
        const float rstd = 1.0f / sqrtf(wave_sum(s) * (1.0f / DM) + EPS);
#pragma unroll
        for (int j = 0; j < 4; ++j) { const f32x4 g = ((const f32x4*)p.g_final)[lane + 64 * j]; xr[64 * j] = (f32x4){v[j].x * rstd * g.x, v[j].y * rstd * g.y, v[j].z * rstd * g.z, v[j].w * rstd * g.w}; }
    }
}

template <class DstRow>
__device__ __forceinline__ void transpose_item(const float* __restrict__ W, int N, bf16_t* __restrict__ WT, int ldk, int koff, float* scr, int k0, int n0, int lane, DstRow dst) {
#pragma unroll 8
    for (int i = 0; i < 32; ++i) { const int kk = 2 * i + (lane >> 5); scr[kk * 33 + (lane & 31)] = W[(size_t)(k0 + kk) * N + n0 + (lane & 31)]; }
    asm volatile("s_waitcnt vmcnt(0) lgkmcnt(0)" ::: "memory");
    const int c = lane & 7;
#pragma unroll
    for (int j = 0; j < 4; ++j) { const int n = (lane >> 3) + 8 * j; const float* sp = scr + (8 * c) * 33 + n;
        u32x4 o; o.x = f2bf(sp[0 * 33]) | (f2bf(sp[1 * 33]) << 16); o.y = f2bf(sp[2 * 33]) | (f2bf(sp[3 * 33]) << 16);
        o.z = f2bf(sp[4 * 33]) | (f2bf(sp[5 * 33]) << 16); o.w = f2bf(sp[6 * 33]) | (f2bf(sp[7 * 33]) << 16);
        *(u32x4*)(WT + (size_t)dst(n0 + n) * ldk + koff + k0 + 8 * c) = o; }
    asm volatile("s_waitcnt lgkmcnt(0)" ::: "memory");
}
__device__ __forceinline__ int rope_slot(int e) { const int half = e >> 6, el = e & 63, j = el & 31, n = el >> 5, g = half * 8 + (j >> 2); return 32 * (g >> 2) + 8 * (g & 3) + 4 * n + (j & 3); }
__device__ __forceinline__ void transpose_p0(const Params& p, float* lds, int vb, int nvb) {
    const int tid = TID(), lane = tid & 63, wave = tid >> 6;
    float* scr = lds + wave * (64 * 33);
    bf16_t* WIN = (bf16_t*)(p.ws + OFF_WIN); bf16_t* WAB = (bf16_t*)(p.ws + OFF_WAB); bf16_t* WO = (bf16_t*)(p.ws + OFF_WO);
    constexpr int I_IN = 16 * (INW / 32), I_SQ = 16 * 32;
    for (int it = vb * 8 + wave; it < I_IN + 3 * I_SQ; it += nvb * 8) {
        int r = it;
        if (r < I_IN) { const int kb = r / (INW / 32), nb = r % (INW / 32);
            transpose_item(p.w_in, INW, WIN, DM, 0, scr, kb * 64, nb * 32, lane, [](int n) { return (n >= 3072 && n < 4352) ? (n & ~127) + rope_slot(n & 127) : n; }); continue; }
        r -= I_IN; const int m = r / I_SQ, q = r % I_SQ, kb = q / 32, nb = q % 32;
        if (m == 0) transpose_item(p.w_ba, DM, WAB, 2048, 0, scr, kb * 64, nb * 32, lane, [](int n) { return n; });
        else if (m == 1) transpose_item(p.w_bb, DM, WAB, 2048, 1024, scr, kb * 64, nb * 32, lane, [](int n) { return n; });
        else transpose_item(p.w_out, DM, WO, DM, 0, scr, kb * 64, nb * 32, lane, [](int n) { return n; });
    }
}
__device__ __forceinline__ void transpose_moe(const Params& p, float* lds, int vbl, int nvbl) {
    const int tid = TID(), lane = tid & 63, wave = tid >> 6;
    float* scr = lds + wave * (64 * 33);
    bf16_t* WGU = (bf16_t*)(p.ws + OFF_WGU); bf16_t* WD = (bf16_t*)(p.ws + OFF_WD);
    constexpr int I_G = 16 * 16, I_D = 8 * 32, I_E = 2 * I_G + I_D;
    for (int it = vbl * 8 + wave; it < NEXP * I_E; it += nvbl * 8) {
        const int e = it / I_E; int r = it % I_E;
        if (r < 2 * I_G) { const int up = r / I_G, q = r % I_G, kb = q / 16, nb = q % 16;
            const float* W = (up ? p.w_up : p.w_gate) + (size_t)e * DM * EFF;
            transpose_item(W, EFF, WGU + (size_t)e * DM * DM, DM, 0, scr, kb * 64, nb * 32, lane, [up](int f) { return 8 * (f >> 2) + 4 * up + (f & 3); }); }
        else { r -= 2 * I_G; const int kb = r / 32, nb = r % 32;
            transpose_item(p.w_down + (size_t)e * EFF * DM, DM, WD + (size_t)e * DM * EFF, EFF, 0, scr, kb * 64, nb * 32, lane, [](int n) { return n; }); }
    }
}

namespace pg8 {
#define PG8_LAS __attribute__((address_space(3)))
typedef short bf16x8 __attribute__((ext_vector_type(8)));
constexpr int BM = 256, BK = 64, HALF = 128, HTB = HALF * BK * 2, STAGE_BYTES = 8 * HTB, NXCD = 8, WGM = 8;
__host__ __device__ __forceinline__ int lds_byte(int r, int c) { const int st = (r >> 4) * 2 + (c >> 5), rr = r & 15, cc = c & 31, ob = rr * 64 + cc * 2; return st * 1024 + (ob ^ (((ob >> 9) & 1) << 5)); }
__host__ __device__ __forceinline__ void stage_rc(int b, int& R, int& C) { const int st = b / 1024, sb = b % 1024, swz = sb ^ (((sb >> 9) & 1) << 5); R = (st >> 1) * 16 + swz / 64; C = (st & 1) * 32 + (swz % 64) / 2; }
__host__ __device__ __forceinline__ int perm32(int rho) { const int n = rho >> 4, i = rho & 15; return 8 * (i >> 2) + 4 * n + (i & 3); }
struct Unit { int arow0, brow0, pm, pn, e; };
struct Gemm { const bf16_t* A; const bf16_t* Bt; int K; };
struct GridOrder {
    int nM, nN, nwg, G, c;
    __device__ void init(int nM_, int nN_, int G_, int c_) { nM = nM_; nN = nN_; nwg = nM * nN; G = G_; c = c_; }
    __device__ bool next(int i, Unit& u) const {
        const long L = (long)i * G + c; if (L >= nwg) return false;
        int wgid = (int)L; { const int q = nwg / NXCD, r = nwg % NXCD, xcd = wgid % NXCD, off = wgid / NXCD; wgid = (xcd < r ? xcd * (q + 1) : r * (q + 1) + (xcd - r) * q) + off; }
        const int nig = WGM * nN, gid = wgid / nig, fm = gid * WGM, gsz = (nM - fm) < WGM ? (nM - fm) : WGM;
        u.pm = fm + ((wgid % nig) % gsz); u.pn = (wgid % nig) / gsz; u.e = 0; u.arow0 = u.pm * BM; u.brow0 = u.pn * BM; return true;
    }
};
struct MoeOrder {
    int G, c;
    __device__ bool next(int i, Unit& u) const {
        const int L = i * G + c; if (L >= NEXP * 36) return false;
        u.e = L / 36; const int r = L % 36; u.pm = r % 9; u.pn = r / 9; u.arow0 = u.e * ESLOTS + u.pm * BM; u.brow0 = u.e * DM + u.pn * BM; return true;
    }
};
__device__ __forceinline__ unsigned cvt_pk_bf16(float lo, float hi) { unsigned r; asm volatile("v_cvt_pk_bf16_f32 %0, %1, %2" : "=v"(r) : "v"(lo), "v"(hi)); return r; }

template <class Epi, class Sched>
__device__ __forceinline__ void gemm_phase(PG8_LAS unsigned char* lds, const Gemm g, const Sched& S, const Epi& E) {
    const int tid = TID(), wid = __builtin_amdgcn_readfirstlane(tid >> 6), lane = tid & 63, wr = wid >> 2, wc = wid & 3, fr = lane & 15, fq = lane >> 4;
    const int K = g.K, nt = K / BK;
    unsigned voffA[2], voffB[2];
#pragma unroll
    for (int i = 0; i < 2; ++i) { int R, C; stage_rc(tid * 16 + i * 8192, R, C); const int Rb = Epi::PERM ? ((R & ~31) + perm32(R & 31)) : R;
        voffA[i] = (unsigned)(R * K + C) * 2u; voffB[i] = (unsigned)(Rb * K + C) * 2u; }
    const size_t kstep = (size_t)(BK * 2);
    const size_t hstep = (size_t)HALF * K * 2;
    const size_t rstep = (size_t)K * 2;
    const unsigned ldsw = (unsigned)wid * 1024u;
    const int aoff = lds_byte(wr * 64 + fr, fq * 8), boff = lds_byte(wc * 32 + fr, fq * 8);
#define PG8_SA(b, h) (((b) * 2 + (h)) * HTB)
#define PG8_SB(b, h) ((4 + (b) * 2 + (h)) * HTB)
#define PG8_STAGE(bufoff, gbase, voff) do { _Pragma("unroll") for (int _i = 0; _i < 2; ++_i) \
        __builtin_amdgcn_global_load_lds((const unsigned*)((const char*)(gbase) + (voff)[_i]), (PG8_LAS unsigned*)(lds + (bufoff) + ldsw + _i * 8192), 16, 0, 0); } while (0)
#define PG8_LDA(dst, b, h) do { _Pragma("unroll") for (int m = 0; m < 4; ++m) _Pragma("unroll") for (int k = 0; k < 2; ++k) dst[m][k] = *(const PG8_LAS bf16x8*)(lds + PG8_SA(b, h) + aoff + m * 2048 + k * 1024); } while (0)
#define PG8_LDB(dst, b, h) do { _Pragma("unroll") for (int n = 0; n < 2; ++n) _Pragma("unroll") for (int k = 0; k < 2; ++k) dst[n][k] = *(const PG8_LAS bf16x8*)(lds + PG8_SB(b, h) + boff + n * 2048 + k * 1024); } while (0)
#define PG8_MMA(ai, bj, At, Bt) do { __builtin_amdgcn_s_setprio(1); _Pragma("unroll") for (int m = 0; m < 4; ++m) _Pragma("unroll") for (int n = 0; n < 2; ++n) _Pragma("unroll") for (int k = 0; k < 2; ++k) \
        acc[ai][bj][m][n] = __builtin_amdgcn_mfma_f32_16x16x32_bf16(Bt[n][k], At[m][k], acc[ai][bj][m][n], 0, 0, 0); __builtin_amdgcn_s_setprio(0); } while (0)
#define PG8_WAIT_V(n) asm volatile("s_waitcnt vmcnt(" #n ")" ::: "memory")
#define PG8_WAIT_L(n) asm volatile("s_waitcnt lgkmcnt(" #n ")" ::: "memory")
#define PG8_BAR __builtin_amdgcn_s_barrier()
#define PG8_SCHED __builtin_amdgcn_sched_barrier(0)
    Unit cur, nxt; int ui = 0;
    if (!S.next(0, cur)) return;
    f32x4 acc[2][2][4][2];
#pragma unroll
    for (int a = 0; a < 2; ++a)
#pragma unroll
        for (int b = 0; b < 2; ++b)
#pragma unroll
            for (int m = 0; m < 4; ++m)
#pragma unroll
                for (int n = 0; n < 2; ++n) acc[a][b][m][n] = (f32x4){0.f, 0.f, 0.f, 0.f};
    bf16x8 At[4][2], B0[2][2], B1[2][2];
    const char* cA = (const char*)g.A + (size_t)cur.arow0 * rstep; const char* cB = (const char*)g.Bt + (size_t)cur.brow0 * rstep;
    PG8_STAGE(PG8_SB(0, 0), cB, voffB); PG8_STAGE(PG8_SB(0, 1), cB + hstep, voffB); PG8_STAGE(PG8_SA(0, 0), cA, voffA); PG8_STAGE(PG8_SA(0, 1), cA + hstep, voffA);
    if (wr == 1) PG8_BAR;
    PG8_WAIT_V(2); PG8_BAR;
    PG8_STAGE(PG8_SB(1, 0), cB + kstep, voffB); PG8_STAGE(PG8_SA(1, 0), cA + kstep, voffA); PG8_STAGE(PG8_SB(1, 1), cB + hstep + kstep, voffB);
    PG8_WAIT_V(6); PG8_BAR;
    for (;;) {
        const bool has_next = S.next(ui + 1, nxt);
        const char* nA = has_next ? (const char*)g.A + (size_t)nxt.arow0 * rstep : cA; const char* nB = has_next ? (const char*)g.Bt + (size_t)nxt.brow0 * rstep : cB;
        for (int t = 0; t < nt; t += 2) {
            const bool last = (t == nt - 2);
            const char* a1 = cA + (size_t)(t + 1) * kstep;
            const char* a2 = last ? nA : cA + (size_t)(t + 2) * kstep; const char* b2 = last ? nB : cB + (size_t)(t + 2) * kstep;
            const char* a3 = a2 + kstep; const char* b3 = b2 + kstep;
            if constexpr (Epi::HAS_MID) { if (t == nt / 2) E.mid(acc, cur, wr, wc, fr, fq); }
            PG8_LDB(B0, 0, 0); PG8_LDB(B1, 0, 1); PG8_SCHED; PG8_LDA(At, 0, 0); PG8_STAGE(PG8_SA(1, 1), a1 + hstep, voffA);
            PG8_WAIT_V(8); PG8_WAIT_L(0); PG8_BAR; PG8_MMA(0, 0, At, B0); PG8_MMA(0, 1, At, B1); PG8_BAR; PG8_SCHED;
            PG8_LDA(At, 0, 1); PG8_STAGE(PG8_SB(0, 0), b2, voffB); PG8_STAGE(PG8_SB(0, 1), b2 + hstep, voffB); PG8_STAGE(PG8_SA(0, 0), a2, voffA);
            PG8_WAIT_V(8); PG8_WAIT_L(0); PG8_BAR; PG8_MMA(1, 0, At, B0); PG8_MMA(1, 1, At, B1); PG8_BAR; PG8_SCHED;
            PG8_LDB(B0, 1, 0); PG8_LDB(B1, 1, 1); PG8_SCHED; PG8_LDA(At, 1, 0); PG8_STAGE(PG8_SA(0, 1), a2 + hstep, voffA);
            PG8_WAIT_V(8); PG8_WAIT_L(0); PG8_BAR; PG8_MMA(0, 0, At, B0); PG8_MMA(0, 1, At, B1); PG8_BAR; PG8_SCHED;
            PG8_LDA(At, 1, 1); PG8_STAGE(PG8_SB(1, 0), b3, voffB); PG8_STAGE(PG8_SB(1, 1), b3 + hstep, voffB); PG8_STAGE(PG8_SA(1, 0), a3, voffA);
            PG8_WAIT_V(8); PG8_WAIT_L(0); PG8_BAR; PG8_MMA(1, 0, At, B0); PG8_MMA(1, 1, At, B1); PG8_BAR; PG8_SCHED;
        }
        if (wr == 0) PG8_BAR;
        E(acc, cur, wr, wc, fr, fq, lds);
        if (!has_next) break;
#pragma unroll
        for (int a = 0; a < 2; ++a)
#pragma unroll
            for (int b = 0; b < 2; ++b)
#pragma unroll
                for (int m = 0; m < 4; ++m)
#pragma unroll
                    for (int n = 0; n < 2; ++n) acc[a][b][m][n] = (f32x4){0.f, 0.f, 0.f, 0.f};
        cur = nxt; cA = nA; cB = nB; ++ui;
        if (wr == 1) PG8_BAR;
    }
    PG8_WAIT_V(0);
    PG8_BAR;
#undef PG8_SA
#undef PG8_SB
#undef PG8_STAGE
#undef PG8_LDA
#undef PG8_LDB
#undef PG8_MMA
#undef PG8_WAIT_V
#undef PG8_WAIT_L
#undef PG8_SCHED
}
#define PG8_FOR_AM _Pragma("unroll") for (int ai = 0; ai < 2; ++ai) _Pragma("unroll") for (int m = 0; m < 4; ++m)
#define PG8_FOR_BJ _Pragma("unroll") for (int bj = 0; bj < 2; ++bj)

struct EpiInProj {
    static constexpr bool PERM = true, HAS_MID = false;
    Params p;
    __device__ __forceinline__ void operator()(f32x4 (&acc)[2][2][4][2], const Unit& u, int wr, int wc, int fr, int fq, PG8_LAS unsigned char* lds) const {
        const int pn = u.pn;
        const int sec = pn < 4 ? 0 : pn < 8 ? 1 : pn < 12 ? 2 : pn < 16 ? 3 : pn == 16 ? 4 : pn == 17 ? 5 : pn < 22 ? 6 : 7;
        const int head0 = (sec == 0 ? pn : sec == 1 ? pn - 4 : sec == 2 ? pn - 8 : sec == 3 ? pn - 12 : sec == 6 ? pn - 18 : sec == 7 ? pn - 22 : 0) * 2;
        const int cl = wc * 32 + fq * 8;
        if (sec == 3 || sec == 4) {
            PG8_LAS float* X = (PG8_LAS float*)(lds + STAGE_BYTES);
            PG8_FOR_AM { PG8_FOR_BJ { const f32x4 a = acc[ai][bj][m][0], b = acc[ai][bj][m][1];
                float ss = (a.x * a.x + a.y * a.y) + (a.z * a.z + a.w * a.w) + (b.x * b.x + b.y * b.y) + (b.z * b.z + b.w * b.w);
                ss += __shfl_xor(ss, 16); ss += __shfl_xor(ss, 32);
                if (fq == 0) X[((ai * 128 + wr * 64 + m * 16 + fr) * 2 + bj) * 4 + wc] = ss; } }
            asm volatile("s_waitcnt lgkmcnt(0)" ::: "memory"); __builtin_amdgcn_s_barrier(); asm volatile("" ::: "memory");
            const int g = wc * 4 + fq, j0 = (g & 7) * 4, e0 = (g >> 3) * 64 + j0;
            const float* gn = sec == 3 ? p.g_qnorm : p.g_knorm;
            const f32x4 g1 = *(const f32x4*)(gn + e0), g2 = *(const f32x4*)(gn + e0 + 32);
            const float sc = sec == 3 ? CB : 1.f;
            const float2* rope = (const float2*)(p.ws + OFF_ROPE);
            PG8_FOR_AM { const int rl = ai * 128 + wr * 64 + m * 16 + fr, grow = u.pm * BM + rl; const RowInfo ri = row_decode(grow);
                f32x4 c4 = (f32x4){1.f, 1.f, 1.f, 1.f}, s4 = (f32x4){0.f, 0.f, 0.f, 0.f};
                if (!ri.meta) { const int pos = (g >> 3) ? (ri.t & 63) : (ri.t >> 6); const f32x4 t0 = *(const f32x4*)(rope + pos * 32 + j0), t1 = *(const f32x4*)(rope + pos * 32 + j0 + 2);
                    c4 = (f32x4){t0.x, t0.z, t1.x, t1.z}; s4 = (f32x4){t0.y, t0.w, t1.y, t1.w}; }
                PG8_FOR_BJ { const f32x4 pq = *(const PG8_LAS f32x4*)(X + (rl * 2 + bj) * 4);
                    const float rstd = 1.0f / sqrtf(((pq.x + pq.y) + (pq.z + pq.w)) * (1.0f / 128.f) + EPS) * sc;
                    const f32x4 x1 = acc[ai][bj][m][0] * g1 * rstd, x2 = acc[ai][bj][m][1] * g2 * rstd;
                    const f32x4 y1 = x1 * c4 - x2 * s4, y2 = x2 * c4 + x1 * s4;
                    if (ri.valid) { const int head = head0 + bj;
                        bf16_t* dst = sec == 3 ? (bf16_t*)(p.ws + OFF_QB) + ((size_t)(ri.b * 8 + head) * QROWS + row_q(ri)) * 128 : (bf16_t*)(p.ws + OFF_KB) + ((size_t)(ri.b * 2 + head) * KEYS + row_key(ri)) * 128;
                        *(u32x2*)(dst + e0) = (u32x2){cvt_pk_bf16(y1.x, y1.y), cvt_pk_bf16(y1.z, y1.w)};
                        *(u32x2*)(dst + e0 + 32) = (u32x2){cvt_pk_bf16(y2.x, y2.y), cvt_pk_bf16(y2.z, y2.w)}; } } }
            return;
        }
        PG8_FOR_AM { const int grow = u.pm * BM + ai * 128 + wr * 64 + m * 16 + fr; const RowInfo ri = row_decode(grow);
            if (!ri.valid) continue;
            PG8_FOR_BJ { const int head = head0 + bj; f32x4 a = acc[ai][bj][m][0], b = acc[ai][bj][m][1]; bf16_t* dst;
                if (sec == 0) { dst = (bf16_t*)(p.ws + OFF_QA) + ((size_t)(ri.b * 8 + head) * QROWS + row_q(ri)) * 128; a = a * CA; b = b * CA; }
                else if (sec == 1) dst = (bf16_t*)(p.ws + OFF_KA) + ((size_t)(ri.b * 8 + head) * KEYS + row_key(ri)) * 128;
                else if (sec == 2) dst = (bf16_t*)(p.ws + OFF_VA) + ((size_t)(ri.b * 8 + head) * KEYS + row_key(ri)) * 128;
                else if (sec == 5) dst = (bf16_t*)(p.ws + OFF_VB) + ((size_t)(ri.b * 2 + head) * KEYS + row_key(ri)) * 128;
                else { dst = (grow < MREAL ? (bf16_t*)p.out + (size_t)grow * 2048 : (bf16_t*)(p.ws + OFF_SGM) + (size_t)(grow - MREAL) * 2048) + (sec == 7 ? 1024 : 0) + head * 128;
                    a.x = 1.0f / (1.0f + __expf(-a.x)); a.y = 1.0f / (1.0f + __expf(-a.y)); a.z = 1.0f / (1.0f + __expf(-a.z)); a.w = 1.0f / (1.0f + __expf(-a.w));
                    b.x = 1.0f / (1.0f + __expf(-b.x)); b.y = 1.0f / (1.0f + __expf(-b.y)); b.z = 1.0f / (1.0f + __expf(-b.z)); b.w = 1.0f / (1.0f + __expf(-b.w)); }
                *(u32x4*)(dst + cl) = (u32x4){cvt_pk_bf16(a.x, a.y), cvt_pk_bf16(a.z, a.w), cvt_pk_bf16(b.x, b.y), cvt_pk_bf16(b.z, b.w)}; } }
    }
};
__device__ __forceinline__ f32x4 bf4(u32x2 w) { return (f32x4){bf2f(w.x & 0xffffu), bf2f(w.x >> 16), bf2f(w.y & 0xffffu), bf2f(w.y >> 16)}; }
struct EpiMerge {
    static constexpr bool PERM = true, HAS_MID = true;
    Params p;
    __device__ __forceinline__ const bf16_t* sg(int grow) const { return grow < MREAL ? (const bf16_t*)p.out + (size_t)grow * 2048 : (const bf16_t*)(p.ws + OFF_SGM) + (size_t)(grow - MREAL) * 2048; }
    __device__ __forceinline__ void mid(f32x4 (&acc)[2][2][4][2], const Unit& u, int wr, int wc, int fr, int fq) const {
        PG8_FOR_AM { const int grow = u.pm * BM + ai * 128 + wr * 64 + m * 16 + fr; if (grow >= MROWS) continue; const bf16_t* s = sg(grow) + u.pn * BM + wc * 32 + fq * 8;
            PG8_FOR_BJ { const u32x4 wa = *(const u32x4*)(s + bj * 128), wb = *(const u32x4*)(s + 1024 + bj * 128);
                const f32x4 b0 = bf4((u32x2){wb.x, wb.y}), b1 = bf4((u32x2){wb.z, wb.w});
                const f32x4 r0 = (f32x4){__builtin_amdgcn_rcpf(b0.x), __builtin_amdgcn_rcpf(b0.y), __builtin_amdgcn_rcpf(b0.z), __builtin_amdgcn_rcpf(b0.w)};
                const f32x4 r1 = (f32x4){__builtin_amdgcn_rcpf(b1.x), __builtin_amdgcn_rcpf(b1.y), __builtin_amdgcn_rcpf(b1.z), __builtin_amdgcn_rcpf(b1.w)};
                acc[ai][bj][m][0] = acc[ai][bj][m][0] * bf4((u32x2){wa.x, wa.y}) * r0;
                acc[ai][bj][m][1] = acc[ai][bj][m][1] * bf4((u32x2){wa.z, wa.w}) * r1; } }
    }
    __device__ __forceinline__ void operator()(f32x4 (&acc)[2][2][4][2], const Unit& u, int wr, int wc, int fr, int fq, PG8_LAS unsigned char*) const {
        bf16_t* MG = (bf16_t*)(p.ws + OFF_MERGED);
        PG8_FOR_AM { const int grow = u.pm * BM + ai * 128 + wr * 64 + m * 16 + fr; if (grow >= MROWS) continue; const int col = u.pn * BM + wc * 32 + fq * 8; const bf16_t* s = sg(grow) + 1024 + col;
            PG8_FOR_BJ { const u32x4 wb = *(const u32x4*)(s + bj * 128);
                const f32x4 a = acc[ai][bj][m][0] * bf4((u32x2){wb.x, wb.y}), b = acc[ai][bj][m][1] * bf4((u32x2){wb.z, wb.w});
                *(u32x4*)(MG + (size_t)grow * DM + col + bj * 128) = (u32x4){cvt_pk_bf16(a.x, a.y), cvt_pk_bf16(a.z, a.w), cvt_pk_bf16(b.x, b.y), cvt_pk_bf16(b.z, b.w)}; } }
    }
};
struct EpiOut {
    static constexpr bool PERM = false, HAS_MID = false;
    Params p;
    __device__ __forceinline__ void operator()(f32x4 (&acc)[2][2][4][2], const Unit& u, int wr, int wc, int fr, int fq, PG8_LAS unsigned char*) const {
        PG8_FOR_AM { const int grow = u.pm * BM + ai * 128 + wr * 64 + m * 16 + fr; if (grow >= MROWS) continue; const int col = u.pn * BM + wc * 32 + fq * 4;
            const float* hr = h_row(p, grow) + col; float* o = h2_row(p, grow) + col;
            PG8_FOR_BJ {
#pragma unroll
                for (int n = 0; n < 2; ++n) *(f32x4*)(o + bj * 128 + n * 16) = *(const f32x4*)(hr + bj * 128 + n * 16) + acc[ai][bj][m][n]; } }
    }
};
struct EpiMoeUp {
    static constexpr bool PERM = true, HAS_MID = false;
    Params p;
    __device__ __forceinline__ void operator()(f32x4 (&acc)[2][2][4][2], const Unit& u, int wr, int wc, int fr, int fq, PG8_LAS unsigned char*) const {
        bf16_t* HID = (bf16_t*)(p.ws + OFF_HID);
        PG8_FOR_AM { const int s = u.pm * BM + ai * 128 + wr * 64 + m * 16 + fr; if (s >= ESLOTS) continue;
            PG8_FOR_BJ { const f32x4 gt = acc[ai][bj][m][0], up = acc[ai][bj][m][1]; const int f0 = (u.pn * BM + bj * 128 + wc * 32 + fq * 8) >> 1;
                const float h0 = gt.x / (1.0f + __expf(-gt.x)) * up.x, h1 = gt.y / (1.0f + __expf(-gt.y)) * up.y, h2 = gt.z / (1.0f + __expf(-gt.z)) * up.z, h3 = gt.w / (1.0f + __expf(-gt.w)) * up.w;
                *(u32x2*)(HID + ((size_t)u.e * ESLOTS + s) * EFF + f0) = (u32x2){cvt_pk_bf16(h0, h1), cvt_pk_bf16(h2, h3)}; } }
    }
};
struct EpiMoeDown {
    static constexpr bool PERM = true, HAS_MID = false;
    Params p;
    __device__ __forceinline__ void operator()(f32x4 (&acc)[2][2][4][2], const Unit& u, int wr, int wc, int fr, int fq, PG8_LAS unsigned char*) const {
        bf16_t* YB = (bf16_t*)(p.ws + OFF_YB); const float* SAFF = (const float*)(p.ws + OFF_SAFF);
        PG8_FOR_AM { const int s = u.pm * BM + ai * 128 + wr * 64 + m * 16 + fr; if (s >= ESLOTS) continue; const float af = SAFF[u.e * ESLOTS + s]; const int col = u.pn * BM + wc * 32 + fq * 8;
            PG8_FOR_BJ { const f32x4 a = acc[ai][bj][m][0] * af, b = acc[ai][bj][m][1] * af;
                *(u32x4*)(YB + ((size_t)u.e * ESLOTS + s) * DM + col + bj * 128) = (u32x4){cvt_pk_bf16(a.x, a.y), cvt_pk_bf16(a.z, a.w), cvt_pk_bf16(b.x, b.y), cvt_pk_bf16(b.z, b.w)}; } }
    }
};
#undef PG8_BAR
}

__device__ __forceinline__ void phase1_fast(const Params& p, unsigned char* lds_raw, int vb, int nvb) {
    pg8::Gemm g{(const bf16_t*)(p.ws + OFF_UN), (const bf16_t*)(p.ws + OFF_WIN), DM};
    pg8::GridOrder S; S.init(MPAD / 256, INW / 256, nvb, vb);
    pg8::EpiInProj E{p};
    pg8::gemm_phase(( __attribute__((address_space(3))) unsigned char*)lds_raw, g, S, E);
}
__device__ __forceinline__ void phase3a_fast(const Params& p, unsigned char* lds_raw, int vb, int nvb) {
    pg8::Gemm g{(const bf16_t*)(p.ws + OFF_AO), (const bf16_t*)(p.ws + OFF_WAB), 2048};
    pg8::GridOrder S; S.init(MPAD / 256, DM / 256, nvb, vb);
    pg8::EpiMerge E{p};
    pg8::gemm_phase(( __attribute__((address_space(3))) unsigned char*)lds_raw, g, S, E);
}
__device__ __forceinline__ void phase3b_fast(const Params& p, unsigned char* lds_raw, int vb, int nvb) {
    pg8::Gemm g{(const bf16_t*)(p.ws + OFF_MERGED), (const bf16_t*)(p.ws + OFF_WO), DM};
    pg8::GridOrder S; S.init(MPAD / 256, DM / 256, nvb, vb);
    pg8::EpiOut E{p};
    pg8::gemm_phase(( __attribute__((address_space(3))) unsigned char*)lds_raw, g, S, E);
}
__device__ __forceinline__ void phase5a_fast(const Params& p, unsigned char* lds_raw, int vb, int nvb) {
    pg8::Gemm g{(const bf16_t*)(p.ws + OFF_XS), (const bf16_t*)(p.ws + OFF_WGU), DM};
    pg8::MoeOrder S{nvb, vb};
    pg8::EpiMoeUp E{p};
    pg8::gemm_phase(( __attribute__((address_space(3))) unsigned char*)lds_raw, g, S, E);
}
__device__ __forceinline__ void phase5b_fast(const Params& p, unsigned char* lds_raw, int vb, int nvb) {
    pg8::Gemm g{(const bf16_t*)(p.ws + OFF_HID), (const bf16_t*)(p.ws + OFF_WD), EFF};
    pg8::MoeOrder S{nvb, vb};
    pg8::EpiMoeDown E{p};
    pg8::gemm_phase(( __attribute__((address_space(3))) unsigned char*)lds_raw, g, S, E);
}

__device__ __forceinline__ void phase4b_fast(const Params& p, float* lds, int vb, int nvb) {
    const int tid = TID(), lane = tid & 63, wave = tid >> 6;
    constexpr int NBE = NB * NEXP;
    if (vb >= NBE || nvb <= NBE) { const bool small = nvb <= NBE; transpose_moe(p, lds, small ? vb : vb - NBE, small ? nvb : nvb - NBE); if (!small) return; }
    const float* AFF = (const float*)(p.ws + OFF_AFF); int* IDX = (int*)(p.ws + OFF_IDX); int* SEL = (int*)(p.ws + OFF_SEL);
    unsigned* keys = (unsigned*)lds;
    unsigned* hist = keys + 8448;
    unsigned* sh = hist + 256;
    for (int be = vb; be < NBE; be += nvb) {
        const int b = be / NEXP, e = be % NEXP;
        __syncthreads();
        for (int i = tid; i < LTOT; i += NTHREADS) keys[i] = __float_as_uint(AFF[(size_t)be * LTOT + i]);
        if (tid == 0) { sh[0] = 0u; sh[1] = CAP; }
        __syncthreads();
        for (int pass = 0; pass < 4; ++pass) {
            const int shift = 24 - 8 * pass;
            if (tid < 256) hist[tid] = 0u;
            __syncthreads();
            const unsigned prefix = sh[0], pmask = pass == 0 ? 0u : (0xffffffffu << (shift + 8));
            for (int i = tid; i < LTOT; i += NTHREADS) { const unsigned k = keys[i]; if ((k & pmask) == prefix) atomicAdd(&hist[(k >> shift) & 255u], 1u); }
            __syncthreads();
            if (tid == 0) { unsigned rem = sh[1], d = 255u;
                for (;; --d) { const unsigned c = hist[d]; if (c >= rem || d == 0u) break; rem -= c; }
                sh[0] = prefix | (d << shift); sh[1] = rem; }
            __syncthreads();
        }
        const unsigned T = sh[0], need_eq = sh[1];
        const int t0 = tid * 17; int cnt_gt = 0, cnt_eq = 0;
        for (int i = 0; i < 17; ++i) { const int tok = t0 + i; if (tok < LTOT) { const unsigned k = keys[tok]; cnt_gt += k > T; cnt_eq += k == T; } }
        int incl = cnt_eq;
#pragma unroll
        for (int o = 1; o < 64; o <<= 1) { const int v = __shfl_up(incl, o); if (lane >= o) incl += v; }
        if (lane == 63) sh[8 + wave] = (unsigned)incl;
        __syncthreads();
        int eq_before = incl - cnt_eq; for (int w = 0; w < wave; ++w) eq_before += (int)sh[8 + w];
        __syncthreads();
        int take_eq = (int)need_eq - eq_before; take_eq = take_eq < 0 ? 0 : (take_eq > cnt_eq ? cnt_eq : take_eq);
        const int mysel = cnt_gt + take_eq;
        incl = mysel;
#pragma unroll
        for (int o = 1; o < 64; o <<= 1) { const int v = __shfl_up(incl, o); if (lane >= o) incl += v; }
        if (lane == 63) sh[8 + wave] = (unsigned)incl;
        __syncthreads();
        int slot = incl - mysel; for (int w = 0; w < wave; ++w) slot += (int)sh[8 + w];
        int eqi = eq_before;
        for (int i = 0; i < 17; ++i) { const int tok = t0 + i; if (tok < LTOT) { const unsigned k = keys[tok];
            bool take = k > T; if (k == T) { take = eqi < (int)need_eq; ++eqi; }
            if (take) { IDX[(size_t)be * CAP + slot] = tok; SEL[((size_t)b * LTOT + tok) * NEXP + e] = slot; ++slot; } else SEL[((size_t)b * LTOT + tok) * NEXP + e] = -1; } }
    }
    __syncthreads();
}
__device__ __forceinline__ void phase4c(const Params& p, int vb, int nvb) {
    const int tid = TID(), lane = tid & 63, wave = tid >> 6;
    const bf16_t* U2 = (const bf16_t*)(p.ws + OFF_UN); bf16_t* XS = (bf16_t*)(p.ws + OFF_XS); const int* IDX = (const int*)(p.ws + OFF_IDX);
    const float* AFF = (const float*)(p.ws + OFF_AFF); float* SAFF = (float*)(p.ws + OFF_SAFF);
    for (int r = vb * 8 + wave; r < NEXP * ESLOTS; r += nvb * 8) {
        const int e = r / ESLOTS, s = r % ESLOTS, b = s / CAP, c = s % CAP;
        const int tok = IDX[((size_t)b * NEXP + e) * CAP + c];
        const u32x4* src = (const u32x4*)(U2 + (size_t)pos_row(b, tok) * DM) + lane; u32x4* dst = (u32x4*)(XS + (size_t)r * DM) + lane;
        const u32x4 v0 = src[0], v1 = src[64]; dst[0] = v0; dst[64] = v1;
        if (lane == 0) SAFF[r] = AFF[((size_t)b * NEXP + e) * LTOT + tok];
    }
}

#define LAS __attribute__((address_space(3)))
#define XB_TMO      128
#define XB_XCNT(j)  (256  + 64 * (j))
#define XB_XSUB(j)  (1280 + 64 * (j))
#define XB_XGEN(j)  (2304 + 64 * (j))
#define XB_TOP      3328
#define XB_TOPGEN   3392
#define XCD_BAR_WORDS 3456
#define XB_SPIN_CAP (1u << 22)
__device__ __forceinline__ unsigned xb_ld(unsigned* p)              { return __hip_atomic_load(p, __ATOMIC_RELAXED, __HIP_MEMORY_SCOPE_AGENT); }
__device__ __forceinline__ unsigned xb_add(unsigned* p, unsigned v) { return __hip_atomic_fetch_add(p, v, __ATOMIC_RELAXED, __HIP_MEMORY_SCOPE_AGENT); }
__device__ __forceinline__ unsigned xb_xcc_id() { return (unsigned)__builtin_amdgcn_s_getreg((3 << 11) | 20) & 0xFu; }
#define XB_SPIN(cond, bar) do { unsigned _sp = 0; while (cond) { __builtin_amdgcn_s_sleep(1); \
    if ((++_sp & 255u) == 0u) { if (xb_ld(&(bar)[XB_TMO])) break; if (_sp > XB_SPIN_CAP) { atomicAdd(&(bar)[XB_TMO], 1u); break; } } } } while (0)
struct XcdBarrier { unsigned* bar; unsigned x; volatile LAS unsigned* st; };
__device__ __forceinline__ XcdBarrier xcd_barrier_post(unsigned* bar, volatile LAS unsigned* st) {
    XcdBarrier b; b.bar = bar; b.x = xb_xcc_id(); b.st = st;
    if (threadIdx.x == 0) (void)xb_add(&bar[XB_XCNT(b.x)], 1u);
    return b;
}
__device__ __forceinline__ void xcd_barrier_complete(unsigned* bar, unsigned x, unsigned& nloc, unsigned& nx) {
    const unsigned G = gridDim.x * gridDim.y * gridDim.z;
    unsigned sum, cnt, mine, sp = 0u;
    for (;;) {
        sum = 0u; cnt = 0u; mine = 0u;
#pragma unroll
        for (unsigned j = 0; j < 16; ++j) { const unsigned c = xb_ld(&bar[XB_XCNT(j)]); sum += c; cnt += (c > 0u) ? 1u : 0u; mine = (j == x) ? c : mine; }
        if (sum == G) break;
        __builtin_amdgcn_s_sleep(1);
        if ((++sp & 255u) == 0u) { if (xb_ld(&bar[XB_TMO])) break; if (sp > XB_SPIN_CAP) { atomicAdd(&bar[XB_TMO], 1u); break; } }
    }
    nloc = mine > 0u ? mine : 1u; nx = cnt > 0u ? cnt : 1u;
}
__device__ __forceinline__ void xcd_barrier(const XcdBarrier& b) {
    asm volatile("s_waitcnt vmcnt(0)" ::: "memory");
    __syncthreads();
    if (threadIdx.x == 0) {
        unsigned* bar = b.bar;
        __builtin_amdgcn_s_waitcnt(0);
        unsigned nloc = b.st[0], nx = b.st[1];
        if (nloc == 0u) { xcd_barrier_complete(bar, b.x, nloc, nx); b.st[0] = nloc; b.st[1] = nx; }
        const unsigned old = xb_add(&bar[XB_XSUB(b.x)], 1u);
        const unsigned gen = old / nloc;
        if (old + 1u == (gen + 1u) * nloc) {
            __builtin_amdgcn_fence(__ATOMIC_RELEASE, "agent");
            asm volatile("s_waitcnt vmcnt(0)" ::: "memory");
            const unsigned og = xb_add(&bar[XB_TOP], 1u);
            const unsigned tg = og / nx;
            if (og + 1u == (tg + 1u) * nx) xb_add(&bar[XB_TOPGEN], 1u);
            else XB_SPIN(xb_ld(&bar[XB_TOPGEN]) == tg, bar);
            __builtin_amdgcn_fence(__ATOMIC_ACQUIRE, "agent");
            xb_add(&bar[XB_XGEN(b.x)], 1u);
            asm volatile("s_waitcnt vmcnt(0)" ::: "memory");
        } else {
            XB_SPIN(xb_ld(&bar[XB_XGEN(b.x)]) == gen, bar);
            __builtin_amdgcn_fence(__ATOMIC_ACQUIRE, "agent");
            asm volatile("s_waitcnt vmcnt(0)" ::: "memory");
        }
    }
    __syncthreads();
}

constexpr int LDS_BYTES = 147456;
constexpr int LDS_BARST = LDS_BYTES - 64;
constexpr size_t OFF_CTL = 68 * 1024;
#if defined(__HIP_DEVICE_COMPILE__)
#define PHASE_PARAMS() ({ const __attribute__((address_space(4))) Params* q_ = (const __attribute__((address_space(4))) Params*)__builtin_amdgcn_kernarg_segment_ptr(); asm volatile("" : "+s"(q_)); *q_; })
#else
#define PHASE_PARAMS() (pk)
#endif
#define PHASE(call) do { const Params p = PHASE_PARAMS(); call; } while (0)
__global__ void __launch_bounds__(NTHREADS, 2) fwd_kernel(Params pk) {
    extern __shared__ __attribute__((aligned(16))) unsigned char lds_raw[];
    float* lds = (float*)lds_raw;
    cg::grid_group grid = cg::this_grid();
    const int vb = blockIdx.x, nvb = gridDim.x;
    if (threadIdx.x < 16) ((LAS unsigned*)(lds_raw + LDS_BARST))[threadIdx.x] = 0u;
    __syncthreads();
    const XcdBarrier bar = xcd_barrier_post((unsigned*)(pk.ws + OFF_CTL), (volatile LAS unsigned*)(lds_raw + LDS_BARST));
#define GRID_BAR() xcd_barrier(bar)
    PHASE(phase0(p, vb, nvb));
    PHASE(transpose_p0(p, lds, vb, nvb));
    grid.sync();
    PHASE(phase1_fast(p, lds_raw, vb, nvb));
    GRID_BAR();
    PHASE(phase2_fast(p, (char*)lds_raw, vb, nvb));
    GRID_BAR();
    PHASE(phase2b(p, vb, nvb));
    GRID_BAR();
    PHASE(phase3a_fast(p, lds_raw, vb, nvb));
    GRID_BAR();
    PHASE(phase3b_fast(p, lds_raw, vb, nvb));
    GRID_BAR();
    PHASE(phase4a(p, lds, vb, nvb));
    GRID_BAR();
    PHASE(phase4b_fast(p, lds, vb, nvb));
    GRID_BAR();
    PHASE(phase4c(p, vb, nvb));
    GRID_BAR();
    PHASE(phase5a_fast(p, lds_raw, vb, nvb));
    GRID_BAR();
    PHASE(phase5b_fast(p, lds_raw, vb, nvb));
    GRID_BAR();
    PHASE(phase6(p, vb, nvb));
}

extern "C" void kernel_launch(void* const* d_in, const int* in_sizes, int n_in, void* d_out, int out_size, void* d_ws, size_t ws_size, hipStream_t stream) {
    static int grid_blocks = 0;
    if (grid_blocks == 0) {
        if (n_in != 20 || in_sizes[0] != MREAL * DM || out_size != MREAL * DM || ws_size < 256 * MiB) {
            fprintf(stderr, "kernel_launch: unexpected shapes: n_in %d in0 %d out %d ws %zu\n", n_in, n_in > 0 ? in_sizes[0] : -1, out_size, ws_size); grid_blocks = -1; return; }
        int dev = 0, cus = 0, per_cu = 0;
        (void)hipGetDevice(&dev); (void)hipDeviceGetAttribute(&cus, hipDeviceAttributeMultiprocessorCount, dev);
        if (hipFuncSetAttribute((const void*)fwd_kernel, hipFuncAttributeMaxDynamicSharedMemorySize, LDS_BYTES) != hipSuccess) { fprintf(stderr, "kernel_launch: hipFuncSetAttribute failed\n"); grid_blocks = -1; return; }
        if (hipOccupancyMaxActiveBlocksPerMultiprocessor(&per_cu, (const void*)fwd_kernel, NTHREADS, LDS_BYTES) != hipSuccess || per_cu < 1) { fprintf(stderr, "kernel_launch: occupancy query failed (%d)\n", per_cu); grid_blocks = -1; return; }
        grid_blocks = cus * per_cu;
    }
    if (grid_blocks < 0) return;
    if (hipMemsetAsync((char*)d_ws + OFF_CTL, 0, XCD_BAR_WORDS * 4, stream) != hipSuccess) { fprintf(stderr, "kernel_launch: memset failed\n"); return; }
    Params p{};
    p.x = (const float*)d_in[0]; p.meta = (const float*)d_in[1]; p.g_mix = (const float*)d_in[2]; p.w_in = (const float*)d_in[3];
    p.lq1 = (const float*)d_in[4]; p.lk1 = (const float*)d_in[5]; p.lq2 = (const float*)d_in[6]; p.lk2 = (const float*)d_in[7];
    p.g_subln = (const float*)d_in[8]; p.g_qnorm = (const float*)d_in[9]; p.g_knorm = (const float*)d_in[10];
    p.w_ba = (const float*)d_in[11]; p.w_bb = (const float*)d_in[12]; p.w_out = (const float*)d_in[13]; p.g_ffn = (const float*)d_in[14];
    p.w_router = (const float*)d_in[15]; p.w_gate = (const float*)d_in[16]; p.w_up = (const float*)d_in[17]; p.w_down = (const float*)d_in[18]; p.g_final = (const float*)d_in[19];
    p.out = (float*)d_out; p.ws = (unsigned char*)d_ws;
    void* args[] = {&p};
    hipError_t e = hipLaunchCooperativeKernel((const void*)fwd_kernel, dim3(grid_blocks), dim3(NTHREADS), args, LDS_BYTES, stream);
    if (e != hipSuccess) fprintf(stderr, "kernel_launch: cooperative launch failed: %s (grid %d)\n", hipGetErrorString(e), grid_blocks);
}
```

```cpp
#include <hip/hip_runtime.h>
#include <hip/hip_cooperative_groups.h>
#include <cstdio>
#include <cstdint>
namespace cg = cooperative_groups;

typedef unsigned short bf16_t;
typedef float f32x4 __attribute__((ext_vector_type(4)));
typedef unsigned u32x2 __attribute__((ext_vector_type(2)));
typedef unsigned u32x4 __attribute__((ext_vector_type(4)));

constexpr int NB = 2, SEQ = 8192, DM = 1024, NMETA = 16, LTOT = SEQ + NMETA;
constexpr int MREAL = NB * SEQ;
constexpr int MROWS = MREAL + NB * NMETA;
constexpr int MPAD = 16640;
constexpr int INW = 6656;
constexpr int KEYS = 8256;
constexpr int QROWS = 8256;
constexpr int NEXP = 16, EFF = 512, CAP = 1026, ESLOTS = NB * CAP;
constexpr float EPS = 1e-6f;
constexpr float LOG2E = 1.4426950408889634f;
constexpr float CA = 0.125f * LOG2E;
constexpr float CB = 0.08838834764831845f * LOG2E;
constexpr float LAM_INIT = 0.2f;
constexpr int NTHREADS = 512;
constexpr int AOP = 2048;
__device__ const float INVF[32] = {1.000000000e+00f, 7.498942614e-01f, 5.623413324e-01f, 4.216965139e-01f, 3.162277639e-01f, 2.371373773e-01f, 1.778279394e-01f, 1.333521307e-01f,
    1.000000015e-01f, 7.498941571e-02f, 5.623413250e-02f, 4.216965288e-02f, 3.162277490e-02f, 2.371373773e-02f, 1.778279431e-02f, 1.333521493e-02f,
    9.999999776e-03f, 7.498941850e-03f, 5.623413250e-03f, 4.216964822e-03f, 3.162277630e-03f, 2.371373586e-03f, 1.778279431e-03f, 1.333521446e-03f,
    1.000000047e-03f, 7.498942432e-04f, 5.623413017e-04f, 4.216965172e-04f, 3.162277571e-04f, 2.371373703e-04f, 1.778279402e-04f, 1.333521504e-04f};

constexpr size_t MiB = 1u << 20;
constexpr size_t OFF_ROPE = 0;
constexpr size_t OFF_LAM = 64 * 1024;
constexpr size_t OFF_NRM = 64 * 1024 + 256;
constexpr int XCD_BAR_WORDS = 3456;
constexpr size_t OFF_CTL = 68 * 1024;
constexpr int CTL_WORDS = XCD_BAR_WORDS + 64;
constexpr size_t OFF_QCTR = OFF_CTL + (size_t)XCD_BAR_WORDS * 4;
constexpr size_t OFF_AFF = 128 * 1024;
constexpr size_t OFF_IDX = OFF_AFF + (size_t)NB * NEXP * LTOT * 4 + 256;
constexpr size_t OFF_SEL = OFF_IDX + (size_t)NB * NEXP * CAP * 4 + 256;
constexpr size_t OFF_SGM = OFF_SEL + (size_t)NB * LTOT * NEXP * 4 + 256;
constexpr size_t OFF_H2M = OFF_SGM + 32 * 2048 * 2;
constexpr size_t OFF_SAFF = OFF_H2M + 32 * 1024 * 4;
constexpr size_t OFF_MISC_END = OFF_SAFF + (size_t)NEXP * ESLOTS * 4;
static_assert(OFF_MISC_END <= 4 * MiB, "misc region");
constexpr size_t OFF_WIN = 4 * MiB;
constexpr size_t OFF_WAB = OFF_WIN + (size_t)INW * DM * 2;
constexpr size_t OFF_WO = OFF_WAB + (size_t)DM * 2048 * 2;
static_assert(OFF_WO + (size_t)DM * DM * 2 <= 24 * MiB, "weights region");
constexpr size_t OFF_AO = 24 * MiB;
constexpr size_t SZ_ROWS = (size_t)MPAD * DM * 2;
constexpr size_t OFF_UN = OFF_AO;
constexpr size_t OFF_HID = OFF_AO + SZ_ROWS;
static_assert((size_t)(NEXP * ESLOTS + 256) * EFF * 2 <= SZ_ROWS, "HID overlay");
constexpr size_t OFF_ATT = OFF_AO + 2 * SZ_ROWS;
constexpr size_t SZ_QH = (size_t)NB * 8 * QROWS * 128 * 2;
constexpr size_t SZ_KVB = (size_t)NB * 2 * KEYS * 128 * 2;
constexpr size_t OFF_QA = OFF_ATT, OFF_KA = OFF_QA + SZ_QH, OFF_VA = OFF_KA + SZ_QH, OFF_QB = OFF_VA + SZ_QH, OFF_KB = OFF_QB + SZ_QH, OFF_VB = OFF_KB + SZ_KVB;
constexpr size_t OFF_ATT_END = OFF_VB + SZ_KVB;
static_assert(OFF_ATT_END <= 256 * MiB, "workspace");
constexpr size_t OFF_MERGED = OFF_ATT;
constexpr size_t OFF_WGU = OFF_ATT + 33 * MiB;
constexpr size_t OFF_WD = OFF_WGU + 32 * MiB;
constexpr size_t OFF_XS = OFF_WD + 16 * MiB;
constexpr size_t OFF_YB = OFF_XS;
static_assert(SZ_ROWS <= 33 * MiB && OFF_XS + (size_t)(NEXP * ESLOTS + 256) * DM * 2 <= 256 * MiB, "overlay map");

struct Params {
    const float *x, *meta, *g_mix, *w_in, *lq1, *lk1, *lq2, *lk2, *g_subln, *g_qnorm, *g_knorm, *w_ba, *w_bb, *w_out, *g_ffn, *w_router, *w_gate, *w_up, *w_down, *g_final;
    float* out; unsigned char* ws;
};

__device__ __forceinline__ int TID() { int t = threadIdx.x; asm volatile("" : "+v"(t)); return t; }
__device__ __forceinline__ unsigned f2bf(float f) { unsigned u = __builtin_bit_cast(unsigned, f); return (u + 0x7fffu + ((u >> 16) & 1u)) >> 16; }
__device__ __forceinline__ float bf2f(unsigned h) { return __builtin_bit_cast(float, h << 16); }
__device__ __forceinline__ float wave_sum(float v) {
#pragma unroll
    for (int o = 1; o < 64; o <<= 1) v += __shfl_xor(v, o);
    return v;
}
__device__ __forceinline__ float wave_max(float v) {
#pragma unroll
    for (int o = 1; o < 64; o <<= 1) v = fmaxf(v, __shfl_xor(v, o));
    return v;
}
struct RowInfo { int b, t, meta, valid; };
__device__ __forceinline__ RowInfo row_decode(int r) {
    RowInfo ri;
    if (r < MREAL) { ri.b = r >> 13; ri.t = r & (SEQ - 1); ri.meta = 0; ri.valid = 1; }
    else if (r < MROWS) { ri.b = (r - MREAL) >> 4; ri.t = (r - MREAL) & 15; ri.meta = 1; ri.valid = 1; }
    else { ri.b = 0; ri.t = 0; ri.meta = 1; ri.valid = 0; }
    return ri;
}
__device__ __forceinline__ int row_key(const RowInfo& ri) { return ri.meta ? ri.t : 64 + ri.t; }
__device__ __forceinline__ int row_q(const RowInfo& ri) { return ri.meta ? SEQ + ri.t : ri.t; }
__device__ __forceinline__ int row_pos(const RowInfo& ri) { return ri.meta ? ri.t : NMETA + ri.t; }
__device__ __forceinline__ int pos_row(int b, int pos) { return pos < NMETA ? MREAL + b * NMETA + pos : b * SEQ + (pos - NMETA); }
__device__ __forceinline__ const float* h_row(const Params& p, int r) { RowInfo ri = row_decode(r); return ri.meta ? p.meta + (size_t)ri.t * DM : p.x + (size_t)r * DM; }

__device__ __forceinline__ void phase0(const Params& p, int vb, int nvb) {
    const int tid = TID(), lane = tid & 63, wave = tid >> 6;
    const int gt = vb * NTHREADS + tid;
    if (gt < 128 * 32) {
        const int pos = gt >> 5, j = gt & 31;
        const float ang = (float)pos * INVF[j];
        const double xd = (double)ang, kq = __builtin_rint(xd * 0.15915494309189535);
        const double rr = (xd - kq * 6.283185307179586) * 0.25, r2 = rr * rr;
        double sn = 1.0 / 1307674368000.0, cn = 1.0 / 87178291200.0;
        sn = sn * r2 * -1.0 + 1.0 / 6227020800.0; cn = cn * r2 * -1.0 + 1.0 / 479001600.0;
        sn = sn * r2 * -1.0 + 1.0 / 39916800.0;   cn = cn * r2 * -1.0 + 1.0 / 3628800.0;
        sn = sn * r2 * -1.0 + 1.0 / 362880.0;     cn = cn * r2 * -1.0 + 1.0 / 40320.0;
        sn = sn * r2 * -1.0 + 1.0 / 5040.0;       cn = cn * r2 * -1.0 + 1.0 / 720.0;
        sn = sn * r2 * -1.0 + 1.0 / 120.0;        cn = cn * r2 * -1.0 + 1.0 / 24.0;
        sn = sn * r2 * -1.0 + 1.0 / 6.0;          cn = cn * r2 * -1.0 + 0.5;
        sn = (sn * r2 * -1.0 + 1.0) * rr;         cn = cn * r2 * -1.0 + 1.0;
        double s2 = 2.0 * sn * cn, c2 = cn * cn - sn * sn;
        double s4 = 2.0 * s2 * c2, c4 = c2 * c2 - s2 * s2;
        float2 cs; cs.x = (float)c4; cs.y = (float)s4;
        ((float2*)(p.ws + OFF_ROPE))[gt] = cs;
    }
    if (vb == 0 && tid < 128) ((unsigned*)(p.ws + OFF_NRM))[tid] = 0u;
    if (vb == 0 && wave == 0) {
        float a = p.lq1[lane] * p.lk1[lane], c = p.lq2[lane] * p.lk2[lane];
        a = wave_sum(a); c = wave_sum(c);
        if (lane == 0) *(float*)(p.ws + OFF_LAM) = expf(a) - expf(c) + LAM_INIT;
    }
    bf16_t* UN = (bf16_t*)(p.ws + OFF_UN);
    for (int r = vb * 8 + wave; r < MPAD; r += nvb * 8) {
        u32x2* o = (u32x2*)(UN + (size_t)r * DM) + lane;
        if (r >= MROWS) {
#pragma unroll
            for (int j = 0; j < 4; ++j) o[64 * j] = (u32x2){0u, 0u};
            continue;
        }
        const f32x4* xr = (const f32x4*)h_row(p, r) + lane;
        f32x4 v[4]; float s = 0.f;
#pragma unroll
        for (int j = 0; j < 4; ++j) { v[j] = xr[64 * j]; s += (v[j].x * v[j].x + v[j].y * v[j].y) + (v[j].z * v[j].z + v[j].w * v[j].w); }
        const float rstd = 1.0f / sqrtf(wave_sum(s) * (1.0f / DM) + EPS);
#pragma unroll
        for (int j = 0; j < 4; ++j) {
            const f32x4 g = ((const f32x4*)p.g_mix)[lane + 64 * j];
            u32x2 w; w.x = f2bf(v[j].x * rstd * g.x) | (f2bf(v[j].y * rstd * g.y) << 16); w.y = f2bf(v[j].z * rstd * g.z) | (f2bf(v[j].w * rstd * g.w) << 16);
            o[64 * j] = w;
        }
    }
    {
        bf16_t* KA = (bf16_t*)(p.ws + OFF_KA); bf16_t* VA = (bf16_t*)(p.ws + OFF_VA); bf16_t* KB = (bf16_t*)(p.ws + OFF_KB); bf16_t* VB = (bf16_t*)(p.ws + OFF_VB);
        const int per = 48 * 128 / 8;
        for (int i = vb * NTHREADS + tid; i < (16 + 16 + 4 + 4) * per; i += nvb * NTHREADS) {
            const int bh = i / per, o = i % per; bf16_t* base;
            if (bh < 16) base = KA + (size_t)bh * KEYS * 128; else if (bh < 32) base = VA + (size_t)(bh - 16) * KEYS * 128;
            else if (bh < 36) base = KB + (size_t)(bh - 32) * KEYS * 128; else base = VB + (size_t)(bh - 36) * KEYS * 128;
            ((u32x4*)(base + 16 * 128))[o] = (u32x4){0u, 0u, 0u, 0u};
        }
    }
}

namespace fa {
using bf16x8 = __attribute__((ext_vector_type(8))) short;
using s16x4  = __attribute__((ext_vector_type(4))) short;
using f32x16 = __attribute__((ext_vector_type(16))) float;
constexpr int NT = KEYS / 64;
constexpr int SLOT = 16384;
constexpr int NSLOT = 4;
constexpr int L_V = 0, L_K = NSLOT * SLOT, L_WS = 2 * NSLOT * SLOT, L_X = 0;
constexpr int LDS_ATTN = L_WS + 8 * 64 * 4;
constexpr float THR = 8.f;
#define KSWZ(row, colB) ((row) * 256 + ((colB) ^ (((row) & 7) << 4)))
#define SBAR() __builtin_amdgcn_sched_barrier(0)
__device__ __forceinline__ int crow(int r, int hi) { return (r & 3) + 8 * (r >> 2) + 4 * hi; }
__device__ __forceinline__ unsigned cvtpk(float lo, float hi) { unsigned r; asm volatile("v_cvt_pk_bf16_f32 %0, %1, %2" : "=v"(r) : "v"(lo), "v"(hi)); return r; }
__device__ __forceinline__ void partialSM(f32x16& p0, f32x16& p1, float& m_reg, float& mn, float& alpha) {
    float pmax = p0[0];
#pragma unroll
    for (int r = 1; r < 16; ++r) pmax = fmaxf(pmax, p0[r]);
#pragma unroll
    for (int r = 0; r < 16; ++r) pmax = fmaxf(pmax, p1[r]);
    { auto rr = __builtin_amdgcn_permlane32_swap(__float_as_uint(pmax), __float_as_uint(pmax), false, false);
      pmax = fmaxf(__uint_as_float(rr[0]), __uint_as_float(rr[1])); }
    if (__builtin_expect(__all(pmax - m_reg <= THR), 1)) { mn = m_reg; alpha = 1.f; }
    else { mn = fmaxf(m_reg, pmax); alpha = __builtin_amdgcn_exp2f(m_reg - mn); m_reg = mn; }
#pragma unroll
    for (int r = 0; r < 16; ++r) { p0[r] -= mn; p1[r] -= mn; }
#pragma unroll
    for (int r = 0; r < 16; ++r) p0[r] = __builtin_amdgcn_exp2f(p0[r]);
}
__device__ __forceinline__ void finishSM(f32x16& p0, f32x16& p1, float alpha, float& l_reg, bf16x8& pa0, bf16x8& pa1, bf16x8& pa2, bf16x8& pa3) {
#pragma unroll
    for (int r = 0; r < 16; ++r) p1[r] = __builtin_amdgcn_exp2f(p1[r]);
    float ps = 0;
#pragma unroll
    for (int r = 0; r < 16; ++r) ps += p0[r];
#pragma unroll
    for (int r = 0; r < 16; ++r) ps += p1[r];
    { auto rr = __builtin_amdgcn_permlane32_swap(__float_as_uint(ps), __float_as_uint(ps), false, false);
      ps = __uint_as_float(rr[0]) + __uint_as_float(rr[1]); }
    l_reg = l_reg * alpha + ps;
#define PK4(P, BASE, OUT) do { unsigned a0 = cvtpk(P[BASE + 0], P[BASE + 1]), a1 = cvtpk(P[BASE + 2], P[BASE + 3]);   \
    unsigned b0 = cvtpk(P[BASE + 4], P[BASE + 5]), b1 = cvtpk(P[BASE + 6], P[BASE + 7]);                              \
    auto r0 = __builtin_amdgcn_permlane32_swap(a0, b0, false, false); auto r1 = __builtin_amdgcn_permlane32_swap(a1, b1, false, false); \
    u32x4 w = {r0[0], r1[0], r0[1], r1[1]}; OUT = *reinterpret_cast<bf16x8*>(&w); } while (0)
    PK4(p0, 0, pa0); PK4(p0, 8, pa1); PK4(p1, 0, pa2); PK4(p1, 8, pa3);
#undef PK4
}
template <int ND0>
__device__ __forceinline__ void qkt(f32x16& p0, f32x16& p1, const char* Ks, const bf16x8* qr, int d0b, int r32, int hi) {
    p0 = f32x16{}; p1 = f32x16{};
#pragma unroll
    for (int d0 = 0; d0 < ND0; ++d0) { const int cb = ((d0b + d0) * 16 + hi * 8) * 2;
        const bf16x8 b0 = *reinterpret_cast<const bf16x8*>(Ks + KSWZ(r32, cb));
        const bf16x8 b1 = *reinterpret_cast<const bf16x8*>(Ks + KSWZ(32 + r32, cb));
        p0 = __builtin_amdgcn_mfma_f32_32x32x16_bf16(b0, qr[d0], p0, 0, 0, 0);
        p1 = __builtin_amdgcn_mfma_f32_32x32x16_bf16(b1, qr[d0], p1, 0, 0, 0); }
}
__device__ __forceinline__ int v_st(int k, int c) { const int kk = (k & ~0xC) | ((k & 4) << 1) | ((k & 8) >> 1); return ((kk >> 3) * 4 + (c >> 5)) * 512 + ((kk & 7) * 32 + (c & 31)) * 2; }
__device__ __forceinline__ int v_rd_base(int lane) { return ((lane & 3) << 3) | (((lane >> 2) & 3) << 6) | (((lane >> 4) & 1) << 5) | (((lane >> 5) & 1) << 8); }
constexpr int v_rd_off(int d0, int ks, int half) { return d0 * 512 + ks * 4096 + half * 2048; }
template <int OFF> __device__ __forceinline__ s16x4 tr_read(int vb) {
    s16x4 r; asm volatile("ds_read_b64_tr_b16 %0, %1 offset:%2" : "=&v"(r) : "v"(vb), "i"(OFF) : "memory"); return r;
}
template <int D0> __device__ __forceinline__ void pv_one(f32x16& od, int vb, bf16x8 pa0, bf16x8 pa1, bf16x8 pa2, bf16x8 pa3) {
    const s16x4 l0 = tr_read<v_rd_off(D0, 0, 0)>(vb), h0 = tr_read<v_rd_off(D0, 0, 1)>(vb), l1 = tr_read<v_rd_off(D0, 1, 0)>(vb), h1 = tr_read<v_rd_off(D0, 1, 1)>(vb);
    const s16x4 l2 = tr_read<v_rd_off(D0, 2, 0)>(vb), h2 = tr_read<v_rd_off(D0, 2, 1)>(vb), l3 = tr_read<v_rd_off(D0, 3, 0)>(vb), h3 = tr_read<v_rd_off(D0, 3, 1)>(vb);
    asm volatile("s_waitcnt lgkmcnt(0)" ::: "memory"); SBAR();
#define PK(L, H) (bf16x8){L[0], L[1], L[2], L[3], H[0], H[1], H[2], H[3]}
    od = __builtin_amdgcn_mfma_f32_32x32x16_bf16(pa0, PK(l0, h0), od, 0, 0, 0);
    od = __builtin_amdgcn_mfma_f32_32x32x16_bf16(pa1, PK(l1, h1), od, 0, 0, 0);
    od = __builtin_amdgcn_mfma_f32_32x32x16_bf16(pa2, PK(l2, h2), od, 0, 0, 0);
    od = __builtin_amdgcn_mfma_f32_32x32x16_bf16(pa3, PK(l3, h3), od, 0, 0, 0);
#undef PK
}
__device__ __forceinline__ void pv_d0(f32x16* o, int vb, bf16x8 pa0, bf16x8 pa1, bf16x8 pa2, bf16x8 pa3) {
    pv_one<0>(o[0], vb, pa0, pa1, pa2, pa3); pv_one<1>(o[1], vb, pa0, pa1, pa2, pa3); pv_one<2>(o[2], vb, pa0, pa1, pa2, pa3); pv_one<3>(o[3], vb, pa0, pa1, pa2, pa3);
}

__device__ __forceinline__ void glds16(const void* gsrc, unsigned lds_dst) { unsigned keep;
    asm volatile("s_mov_b32 %0, m0\n\ts_mov_b32 m0, %2\n\ts_nop 0\n\tglobal_load_lds_dwordx4 %1, off\n\ts_mov_b32 m0, %0" : "=&s"(keep) : "v"(gsrc), "s"(lds_dst) : "memory"); }
#define WAIT_BAR() asm volatile("s_waitcnt vmcnt(0) lgkmcnt(0)\n\ts_barrier" ::: "memory")
#define WAIT_BAR4() asm volatile("s_waitcnt vmcnt(4) lgkmcnt(0)\n\ts_barrier" ::: "memory")
template <bool DIFF>
__device__ __forceinline__ void attn_unit(const bf16x8 (&qr)[DIFF ? 4 : 8], const bf16_t* __restrict__ Kh, const bf16_t* __restrict__ Vh, int tq, float slopeL, char* lds, int t0, int t1, bool active,
                                          f32x16 (&o)[4], float& l_reg, float& m_reg) {
    constexpr int ND0 = DIFF ? 4 : 8;
    const int tid = TID(), wid = __builtin_amdgcn_readfirstlane(tid >> 6), lane = tid & 63, r32 = lane & 31, hi = lane >> 5;
    char* V_lds = lds + L_V; char* K_lds = lds + L_K;
    float* al_l = (float*)(lds + L_WS) + wid * 64 + 32;
    const int d0b = DIFF ? (wid >> 2) * 4 : 0;
    m_reg = -1e30f; l_reg = 0.f;
#pragma unroll
    for (int d = 0; d < 4; ++d) o[d] = f32x16{};
    const char* ksrc; const char* vsrc;
    { const int row = 4 * wid + (lane >> 4), colB = ((lane & 15) * 16) ^ ((row & 7) << 4);
      ksrc = (const char*)Kh + row * 256 + colB;
      const int sub = 2 * wid + (lane >> 5), kk = (sub >> 2) * 8 + ((lane & 31) >> 2), col = (sub & 3) * 32 + (lane & 3) * 8, k = (kk & ~0xC) | ((kk & 4) << 1) | ((kk & 8) >> 1);
      vsrc = (const char*)Vh + k * 256 + col * 2; }
    const unsigned lds0 = (unsigned)(uintptr_t)lds;
    const unsigned kdst = lds0 + L_K + wid * 1024, vdst = lds0 + L_V + wid * 1024;
#define DMA_TILE(t, slot) do { const size_t to_ = (size_t)(t) * SLOT; const unsigned kd_ = (unsigned)__builtin_amdgcn_readfirstlane(kdst + (slot)), vd_ = (unsigned)__builtin_amdgcn_readfirstlane(vdst + (slot)); \
    glds16(ksrc + to_, kd_); glds16(ksrc + to_ + 8192, kd_ + 8192); glds16(vsrc + to_, vd_); glds16(vsrc + to_ + 8192, vd_ + 8192); } while (0)
    const int vb0 = (int)(uintptr_t)V_lds + v_rd_base(lane);
#define RESC(a) do { if (__any((a) < 1.f)) { if (hi == 0) al_l[r32] = (a); asm volatile("s_waitcnt lgkmcnt(0)" ::: "memory"); \
    _Pragma("unroll") for (int d = 0; d < 4; ++d) _Pragma("unroll") for (int r = 0; r < 16; ++r) o[d][r] *= al_l[crow(r, hi)]; } } while (0)
#define MASK0(P0, P1) do { _Pragma("unroll") for (int r = 8; r < 16; ++r) P0[r] = -1e30f; _Pragma("unroll") for (int r = 0; r < 16; ++r) P1[r] = -1e30f; } while (0)
#define FIXUP(P0, P1, j) do { if (DIFF) { const float base_ = (float)(tq - ((j) - 1) * 64 - 4 * hi); \
    _Pragma("unroll") for (int r = 0; r < 16; ++r) { const float d_ = base_ - (float)((r & 3) + 8 * (r >> 2)); \
        P0[r] = fmaf(-slopeL, fabsf(d_), P0[r]); P1[r] = fmaf(-slopeL, fabsf(d_ - 32.f), P1[r]); } } } while (0)
#define ROT() do { prv = cur; cur = nxt; nxt = nx2; nx2 = (nx2 == (NSLOT - 1) * SLOT) ? 0 : nx2 + SLOT; } while (0)
    f32x16 pA0, pA1, pB0, pB1; float mnA = 0.f, mnB = 0.f, alA = 1.f, alB = 1.f; bf16x8 pa0, pa1, pa2, pa3;
    int prv = 0, cur = 0, nxt = SLOT, nx2 = 2 * SLOT;
    DMA_TILE(t0, 0); DMA_TILE(t0 + 1, SLOT);
    WAIT_BAR4();
    DMA_TILE(t0 + 2, 2 * SLOT);
    if (active) { qkt<ND0>(pA0, pA1, K_lds, qr, d0b, r32, hi); if (t0 == 0) MASK0(pA0, pA1); else FIXUP(pA0, pA1, t0); partialSM(pA0, pA1, m_reg, mnA, alA); }
    WAIT_BAR4(); ROT();
    for (int j = t0 + 1; j + 1 < t1; j += 2) {
        if (j + 2 < t1) DMA_TILE(j + 2, nx2);
        if (active) { SBAR(); qkt<ND0>(pB0, pB1, K_lds + cur, qr, d0b, r32, hi); FIXUP(pB0, pB1, j);
            finishSM(pA0, pA1, alA, l_reg, pa0, pa1, pa2, pa3); SBAR();
            pv_d0(o, vb0 + prv, pa0, pa1, pa2, pa3); partialSM(pB0, pB1, m_reg, mnB, alB);
            RESC(alB); }
        if (j + 2 < t1) WAIT_BAR4(); else WAIT_BAR();
        ROT();
        if (j + 3 < t1) DMA_TILE(j + 3, nx2);
        if (active) { SBAR(); qkt<ND0>(pA0, pA1, K_lds + cur, qr, d0b, r32, hi); FIXUP(pA0, pA1, j + 1);
            finishSM(pB0, pB1, alB, l_reg, pa0, pa1, pa2, pa3); SBAR();
            pv_d0(o, vb0 + prv, pa0, pa1, pa2, pa3); partialSM(pA0, pA1, m_reg, mnA, alA);
            RESC(alA); }
        if (j + 3 < t1) WAIT_BAR4(); else WAIT_BAR();
        ROT();
    }
    if (active) {
        finishSM(pA0, pA1, alA, l_reg, pa0, pa1, pa2, pa3); SBAR();
        pv_d0(o, vb0 + prv, pa0, pa1, pa2, pa3);
    }
    WAIT_BAR();
#undef DMA_TILE
#undef RESC
#undef FIXUP
#undef MASK0
#undef ROT
}

namespace fb {
using fa::bf16x8; using fa::s16x4; using fa::f32x16; using fa::crow; using fa::cvtpk; using fa::glds16;
constexpr int SLOT = 16384, KSL = 4, VSL = 3;
constexpr int L_K = 0, L_V = KSL * SLOT, L_WS = L_V + VSL * SLOT, L_END = L_WS + 8 * 64 * 4;
constexpr float THR = 8.f;
constexpr int KPF = 2, VPF = 2;
typedef __attribute__((address_space(3))) const char* lds_cptr;
typedef short v4i16_t __attribute__((ext_vector_type(4)));
#define FB_SBAR() __builtin_amdgcn_sched_barrier(0)
#define FB_PIN(x) asm volatile("" : "+v"(x))
#define FB_MFMA(a, b, c) __builtin_amdgcn_mfma_f32_32x32x16_bf16(a, b, c, 0, 0, 0)
#define FB_WAIT_BAR(N) asm volatile("s_waitcnt vmcnt(" #N ") lgkmcnt(0)\n\ts_barrier" ::: "memory")
#define FB_MX3(a, b, c) __builtin_fmaxf(__builtin_fmaxf((a), (b)), (c))
__device__ __forceinline__ bf16x8 kfrag(lds_cptr kp, int f) { return *(const __attribute__((address_space(3))) bf16x8*)(kp + (f >> 1) * 2048 + (f & 1) * 512); }
__device__ __forceinline__ s16x4 vtr(lds_cptr p) { return __builtin_bit_cast(s16x4, __builtin_amdgcn_ds_read_tr16_b64_v4i16((__attribute__((address_space(3))) v4i16_t*)p)); }
__device__ __forceinline__ float rowmax(const f32x16& p0, const f32x16& p1) {
    float a = FB_MX3(p0[0], p0[1], p1[0]), b = FB_MX3(p0[2], p0[3], p1[1]); a = FB_MX3(a, p1[2], p1[3]);
#pragma unroll
    for (int r = 4; r < 16; r += 4) { a = FB_MX3(a, p0[r], p0[r + 1]); b = FB_MX3(b, p0[r + 2], p0[r + 3]); a = FB_MX3(a, p1[r], p1[r + 1]); b = FB_MX3(b, p1[r + 2], p1[r + 3]); }
    float m = __builtin_fmaxf(a, b); auto rr = __builtin_amdgcn_permlane32_swap(__float_as_uint(m), __float_as_uint(m), false, false);
    return __builtin_fmaxf(__uint_as_float(rr[0]), __uint_as_float(rr[1])); }
__device__ __forceinline__ void split3(float w, unsigned& h1, unsigned& h2, unsigned& h3) {
    h1 = __float_as_uint(w) & 0xffff0000u; const float r1 = w - __uint_as_float(h1);
    h2 = __float_as_uint(r1) & 0xffff0000u; const float r2 = r1 - __uint_as_float(h2);
    h3 = __float_as_uint(r2) & 0xffff0000u; }

template <bool DIFF, bool IDLE = false>
__device__ __forceinline__ void attn_unit(const bf16x8 (&qr)[DIFF ? 4 : 8], const bf16_t* __restrict__ Kh, const bf16_t* __restrict__ Vh, int tq, int wrow0, float slopeL, char* lds,
                                          int tfirst, int tbase, int n, f32x16 (&o)[4], float& l_reg, float& mhat) {
    constexpr bool active = !IDLE;
    constexpr int ND0 = DIFF ? 4 : 8, NQ = 2 * ND0;
    const int tid = TID(), lane = tid & 63, r32 = lane & 31, hi = lane >> 5; const int wid = __builtin_amdgcn_readfirstlane(tid >> 6);
    const unsigned lds0 = (unsigned)(uintptr_t)lds; float* wsf = (float*)(lds + L_WS) + wid * 64;
    const char* ksrc = (const char*)Kh + lane * 256 + wid * 16;
    const char* vsrc = (const char*)Vh + (16 * (wid & 3) + (lane >> 2)) * 256 + (wid >> 2) * 64 + (lane & 3) * 16;
    const unsigned kdst = lds0 + L_K + wid * 1024, vdst = lds0 + L_V + wid * 1024;
#define TILE_OF(i) ((i) == 0 ? tfirst : tbase + (i))
#define DMA_K(i, slot) do { const char* s_ = ksrc + (size_t)TILE_OF(i) * SLOT; const unsigned d_ = (unsigned)__builtin_amdgcn_readfirstlane(kdst + (slot)); glds16(s_, d_); glds16(s_ + 128, d_ + 8192); } while (0)
#define DMA_V(i, slot) do { const char* s_ = vsrc + (size_t)TILE_OF(i) * SLOT; const unsigned d_ = (unsigned)__builtin_amdgcn_readfirstlane(vdst + (slot)); glds16(s_, d_); glds16(s_ + 128, d_ + 8192); } while (0)
    const lds_cptr vp0 = (lds_cptr)lds + L_V + ((lane >> 4) & 1) * 32 + (lane & 3) * 8 + (4 * hi + ((lane & 15) >> 2)) * 64;
    const lds_cptr kp0 = (lds_cptr)lds + L_K + hi * 1024 + r32 * 16 + (DIFF ? (wid >> 2) * 8192 : 0);
    mhat = 0.f; l_reg = 0.f;
#pragma unroll
    for (int d = 0; d < 4; ++d) o[d] = f32x16{};
    const f32x16 zero16 = f32x16{};
    bool resc = false;
    f32x16 pA0, pA1, pB0, pB1; bf16x8 kf[KPF]; s16x4 vlo[VPF], vhi[VPF]; u32x4 pw0, pw1, pw2, pw3;
    bf16x8 kx0 = bf16x8{}, kx1 = bf16x8{}, qx = bf16x8{}; unsigned sl1 = 0, sl2 = 0, sl3 = 0;
    if (DIFF) { if (hi == 0) { const unsigned c0 = __float_as_uint((float)r32) >> 16, c1 = __float_as_uint((float)(32 + r32)) >> 16;
            u32x4 a = {0x3F803F80u, 0x3F80u | (c0 << 16), c0 | (c0 << 16), 0u}, b = {0x3F803F80u, 0x3F80u | (c1 << 16), c1 | (c1 << 16), 0u};
            kx0 = __builtin_bit_cast(bf16x8, a); kx1 = __builtin_bit_cast(bf16x8, b); }
        split3(slopeL, sl1, sl2, sl3); }
#define SIDE_OF(j) ((j) == 0 ? 0 : (64 * ((j) - 1) + 63 <= wrow0) ? 1 : (64 * ((j) - 1) >= wrow0 + 31) ? -1 : 0)
#define BUILD_QX(j) do { if (DIFF) { const int sd_ = SIDE_OF(j); float w_ = -mhat; unsigned sg_ = 0u, keep_ = 0u; \
        if (sd_ != 0) { const float lin_ = slopeL * (float)(tq - 64 * ((j) - 1)); w_ += sd_ > 0 ? -lin_ : lin_; sg_ = sd_ > 0 ? 0u : 0x80000000u; keep_ = 0xffffffffu; } \
        unsigned h1_, h2_, h3_; split3(w_, h1_, h2_, h3_); const unsigned a1_ = (sl1 ^ sg_) & keep_, a2_ = (sl2 ^ sg_) & keep_, a3_ = (sl3 ^ sg_) & keep_; \
        u32x4 q_ = {(h1_ >> 16) | h2_, (h3_ >> 16) | a1_, (a2_ >> 16) | a3_, 0u}; if (hi != 0) q_ = (u32x4){0u, 0u, 0u, 0u}; qx = __builtin_bit_cast(bf16x8, q_); } } while (0)
#define FIXUP(C0, C1, j) do { if ((j) == 0) { _Pragma("unroll") for (int r = 8; r < 16; ++r) C0[r] = -1e30f; _Pragma("unroll") for (int r = 0; r < 16; ++r) C1[r] = -1e30f; } \
        else if (DIFF && SIDE_OF(j) == 0) { const float base_ = (float)(tq - ((j) - 1) * 64 - 4 * hi); \
            _Pragma("unroll") for (int r = 0; r < 16; ++r) { const float d_ = base_ - (float)((r & 3) + 8 * (r >> 2)); \
                C0[r] = fmaf(-slopeL, fabsf(d_), C0[r]); C1[r] = fmaf(-slopeL, fabsf(d_ - 32.f), C1[r]); } } } while (0)
#define PFLAT(P0, P1, e) ((e) < 16 ? P0[(e) & 15] : P1[(e) & 15])
#define PWSET(u, v) do { if ((u) < 4) pw0[(u) & 3] = (v); else if ((u) < 8) pw1[(u) & 3] = (v); else if ((u) < 12) pw2[(u) & 3] = (v); else pw3[(u) & 3] = (v); } while (0)
#define PAF(k) __builtin_bit_cast(bf16x8, (k) == 0 ? pw0 : (k) == 1 ? pw1 : (k) == 2 ? pw2 : pw3)
#define VFR(i) (bf16x8){vlo[i][0], vlo[i][1], vlo[i][2], vlo[i][3], vhi[i][0], vhi[i][1], vhi[i][2], vhi[i][3]}
#define VRD(slotv, f, dst) do { const lds_cptr a_ = vp0 + (slotv) + ((f) >> 2) * 4096 + ((f) & 3) * 1024; vlo[dst] = vtr(a_); vhi[dst] = vtr(a_ + 512); } while (0)
#define AUNIT(P0, P1, u) do { sacc += PFLAT(P0, P1, 2 * (u)); sacc += PFLAT(P0, P1, 2 * (u) + 1); PWSET(u, cvtpk(PFLAT(P0, P1, 2 * (u)), PFLAT(P0, P1, 2 * (u) + 1))); } while (0)
#define EXPU(C0, C1, u) do { if ((u) < 8) { C0[2 * ((u) & 7)] = __builtin_amdgcn_exp2f(C0[2 * ((u) & 7)] - sub_); C0[2 * ((u) & 7) + 1] = __builtin_amdgcn_exp2f(C0[2 * ((u) & 7) + 1] - sub_); } \
        else { C1[2 * ((u) & 7)] = __builtin_amdgcn_exp2f(C1[2 * ((u) & 7)] - sub_); C1[2 * ((u) & 7) + 1] = __builtin_amdgcn_exp2f(C1[2 * ((u) & 7) + 1] - sub_); } } while (0)
#define STEP(C0, C1, P0, P1, i, GK, GV, GL) do { \
    const int j_ = TILE_OF(i); const lds_cptr kp_ = kp0 + kcur; const lds_cptr kn_ = kp0 + knxt; \
    if (active) { BUILD_QX(j_); FB_SBAR(); float sacc = 0.f; \
        if (DIFF) { C0 = FB_MFMA(kx0, qx, zero16); AUNIT(P0, P1, 0); FB_PIN(sacc); FB_PIN(pw0); FB_SBAR(); \
                    C1 = FB_MFMA(kx1, qx, zero16); AUNIT(P0, P1, 1); AUNIT(P0, P1, 2); FB_PIN(sacc); FB_PIN(pw0); FB_SBAR(); } \
        _Pragma("unroll") for (int g = 0; g < NQ; ++g) { \
            if (g & 1) C1 = FB_MFMA(kf[g % KPF], qr[g >> 1], (!DIFF && g < 2) ? zero16 : C1); else C0 = FB_MFMA(kf[g % KPF], qr[g >> 1], (!DIFF && g < 2) ? zero16 : C0); \
            if (g + KPF < NQ) kf[g % KPF] = kfrag(kp_, g + KPF); \
            if (DIFF) { if (g < 5) { AUNIT(P0, P1, 3 + 2 * g); AUNIT(P0, P1, 4 + 2 * g); } else AUNIT(P0, P1, 8 + g); } else AUNIT(P0, P1, g); \
            if (g >= NQ - VPF) VRD(vprv, g - (NQ - VPF), g - (NQ - VPF)); \
            FB_PIN(sacc); FB_PIN(pw0); FB_PIN(pw1); FB_PIN(pw2); FB_PIN(pw3); FB_SBAR(); } \
        l_reg += sacc; } \
    if (GK) DMA_K((i) + 3, kfree); if (GV) DMA_V((i) + 1, vnxt); \
    float sub_ = 0.f; \
    if (active) { FIXUP(C0, C1, j_); \
        { const float rm = rowmax(C0, C1) - (DIFF ? 0.f : mhat); resc = false; \
          if (__builtin_expect(__any(rm > THR), 0)) { const float dl = __builtin_fmaxf(rm, 0.f); mhat += dl; \
              if (DIFF) { _Pragma("unroll") for (int r = 0; r < 16; ++r) { C0[r] -= dl; C1[r] -= dl; } } \
              const float f = __builtin_amdgcn_exp2f(-dl); l_reg *= f; if (hi == 0) wsf[r32] = f; resc = true; } } \
        sub_ = DIFF ? 0.f : mhat; FB_SBAR(); \
        _Pragma("unroll") for (int g = 0; g < 16; ++g) { \
            o[g >> 2] = FB_MFMA(PAF(g & 3), VFR(g % VPF), o[g >> 2]); \
            if (g + VPF < 16) VRD(vprv, g + VPF, g % VPF); \
            EXPU(C0, C1, g); \
            if ((GL) && g >= 4 && g < 4 + KPF) kf[g - 4] = kfrag(kn_, g - 4); \
            FB_PIN(C0); FB_PIN(C1); FB_SBAR(); } } \
    } while (0)
#define RESC() do { if (active && resc) { _Pragma("unroll") for (int d_ = 0; d_ < 4; ++d_) _Pragma("unroll") for (int r = 0; r < 16; ++r) o[d_][r] *= wsf[crow(r, hi)]; } } while (0)
    int kcur = 0, knxt = SLOT, kfree = 3 * SLOT, vprv = 0, vnxt = SLOT;
#define ROT() do { kfree = kcur; kcur = knxt; knxt = (knxt == (KSL - 1) * SLOT) ? 0 : knxt + SLOT; vprv = (vnxt == 0) ? (VSL - 1) * SLOT : vnxt - SLOT; vnxt = (vnxt == (VSL - 1) * SLOT) ? 0 : vnxt + SLOT; } while (0)
    DMA_K(0, 0); DMA_V(0, 0); DMA_K(1, SLOT); DMA_K(2, 2 * SLOT);
    FB_WAIT_BAR(6);
    if (n > 3) DMA_K(3, 3 * SLOT);
    DMA_V(1, SLOT);
    if (active) { const int j0 = tfirst; BUILD_QX(j0);
        if (DIFF) { pA0 = FB_MFMA(kx0, qx, zero16); pA1 = FB_MFMA(kx1, qx, zero16); }
#pragma unroll
        for (int g = 0; g < NQ; ++g) { const bf16x8 kk = kfrag(kp0, g);
            if (g & 1) pA1 = FB_MFMA(kk, qr[g >> 1], (!DIFF && g < 2) ? zero16 : pA1); else pA0 = FB_MFMA(kk, qr[g >> 1], (!DIFF && g < 2) ? zero16 : pA0); }
        FIXUP(pA0, pA1, j0);
        const float rm = rowmax(pA0, pA1); mhat = rm;
#pragma unroll
        for (int r = 0; r < 16; ++r) { pA0[r] = __builtin_amdgcn_exp2f(pA0[r] - rm); pA1[r] = __builtin_amdgcn_exp2f(pA1[r] - rm); } }
    if (n > 3) FB_WAIT_BAR(4); else FB_WAIT_BAR(2);
    kcur = SLOT; knxt = 2 * SLOT; kfree = 0; vprv = 0; vnxt = 2 * SLOT;
    if (active) {
#pragma unroll
        for (int g = 0; g < KPF; ++g) kf[g] = kfrag(kp0 + kcur, g); }
    int i = 1;
    for (; i + 5 < n; i += 2) {
        STEP(pB0, pB1, pA0, pA1, i, true, true, true);
        FB_WAIT_BAR(4); RESC(); ROT();
        STEP(pA0, pA1, pB0, pB1, i + 1, true, true, true);
        FB_WAIT_BAR(4); RESC(); ROT();
    }
    for (; i + 1 < n; i += 2) {
        STEP(pB0, pB1, pA0, pA1, i, (i + 3 < n), (i + 1 < n), (i + 1 < n));
        if (i + 3 < n) FB_WAIT_BAR(4); else FB_WAIT_BAR(0);
        RESC(); ROT();
        STEP(pA0, pA1, pB0, pB1, i + 1, (i + 4 < n), (i + 2 < n), (i + 2 < n));
        if (i + 4 < n) FB_WAIT_BAR(4); else FB_WAIT_BAR(0);
        RESC(); ROT();
    }
    if (active) { float sacc = 0.f;
#pragma unroll
        for (int u = 0; u < 16; ++u) AUNIT(pA0, pA1, u);
        l_reg += sacc;
#pragma unroll
        for (int g = 0; g < 16; ++g) { VRD(vprv, g, 0); o[g >> 2] = FB_MFMA(PAF(g & 3), VFR(0), o[g >> 2]); } }
    FB_WAIT_BAR(0);
#undef TILE_OF
#undef DMA_K
#undef DMA_V
#undef SIDE_OF
#undef BUILD_QX
#undef FIXUP
#undef PFLAT
#undef PWSET
#undef PAF
#undef VFR
#undef VRD
#undef AUNIT
#undef EXPU
#undef STEP
#undef RESC
#undef ROT
}
}

template <class RowPtr>
__device__ __forceinline__ void store_tile(const f32x16 (&y)[4], char* stage, int lane, RowPtr rowptr) {
    const int r32 = lane & 31, hi = lane >> 5;
    bf16_t* stg = (bf16_t*)stage;
#pragma unroll
    for (int r = 0; r < 16; ++r) { const int orow = crow(r, hi);
#pragma unroll
        for (int d0 = 0; d0 < 4; ++d0) stg[orow * 136 + d0 * 32 + r32] = (bf16_t)f2bf(y[d0][r]); }
    asm volatile("s_waitcnt lgkmcnt(0)" ::: "memory");
#pragma unroll
    for (int i = 0; i < 8; ++i) { const int row = i * 4 + (lane >> 4), ch = lane & 15;
        const u32x4 v = *(const u32x4*)(stg + row * 136 + ch * 8);
        bf16_t* gp = rowptr(row); if (gp) *(u32x4*)(gp + ch * 8) = v; }
    asm volatile("s_waitcnt lgkmcnt(0)" ::: "memory");
}
}

constexpr int NPRB = 4 * 9 * 2 + 16 * 9;
constexpr size_t OFF_PART = (OFF_ATT_END + 255) / 256 * 256;
constexpr size_t OFF_PML = OFF_PART + (size_t)NPRB * 32 * 128 * 4;
static_assert(OFF_PML + NPRB * 32 * 2 * 4 <= 256 * MiB, "meta partials");
constexpr int NRANGE = 9;
__device__ __forceinline__ void meta_range(int r, int& t0, int& t1) { t0 = 15 * r; t1 = r == NRANGE - 1 ? fa::NT : 15 * (r + 1); }

__device__ __forceinline__ void phase2_fast(const Params& p, char* lds, int vb, int nvb) {
    using namespace fa;
    const int tid = TID(), wid = __builtin_amdgcn_readfirstlane(tid >> 6), lane0 = tid & 63;
#define WS_() ({ unsigned char* w_ = p.ws; asm volatile("" : "+s"(w_)); w_; })
#define LSUM2(l) do { auto rr_ = __builtin_amdgcn_permlane32_swap(__float_as_uint(l), __float_as_uint(l), false, false); l = __uint_as_float(rr_[0]) + __uint_as_float(rr_[1]); } while (0)
    for (int v = vb; v < 256; v += nvb) {
        const int xcd = v & 7, slot = v >> 3;
        if (v < 36 + 144) {
            f32x16 o[4]; float l_reg, m_reg; bf16x8 qr[8]; int t0, t1, rb; bool active;
            const int r32q = lane0 & 31, hiq = lane0 >> 5;
            if (v < 36) { const int g = v / NRANGE, rg = v % NRANGE, b = g >> 1, kvh = g & 1; meta_range(rg, t0, t1);
                active = wid < 2; const int h = kvh * 4 + (wid & 1) * 2 + (r32q >> 4);
                unsigned char* ws = WS_(); const bf16_t *QB = (const bf16_t*)(ws + OFF_QB), *KB = (const bf16_t*)(ws + OFF_KB), *VB = (const bf16_t*)(ws + OFF_VB);
                const bf16_t* q = QB + ((size_t)(b * 8 + h) * QROWS + SEQ + (r32q & 15)) * 128 + hiq * 8;
#pragma unroll
                for (int d0 = 0; d0 < 8; ++d0) qr[d0] = *reinterpret_cast<const bf16x8*>(q + d0 * 16);
                const size_t kvo = (size_t)(b * 2 + kvh) * KEYS * 128; rb = (g * NRANGE + rg) * 2 + (wid & 1);
                if (active) fb::attn_unit<false, false>(qr, KB + kvo, VB + kvo, 0, 0, 0.f, lds, t0, t0, t1 - t0, o, l_reg, m_reg); else fb::attn_unit<false, true>(qr, KB + kvo, VB + kvo, 0, 0, 0.f, lds, t0, t0, t1 - t0, o, l_reg, m_reg);
            } else { const int bh = (v - 36) / NRANGE, rg = (v - 36) % NRANGE; meta_range(rg, t0, t1);
                active = wid == 0; const int mp = r32q >> 4;
                unsigned char* ws = WS_(); const bf16_t *QA = (const bf16_t*)(ws + OFF_QA), *KA = (const bf16_t*)(ws + OFF_KA), *VA = (const bf16_t*)(ws + OFF_VA);
                const bf16_t* q = QA + ((size_t)bh * QROWS + SEQ + (r32q & 15)) * 128 + mp * 64 + hiq * 8;
#pragma unroll
                for (int d0 = 0; d0 < 8; ++d0) { const bf16x8 x = *reinterpret_cast<const bf16x8*>(q + (d0 & 3) * 16); qr[d0] = ((d0 >> 2) == mp) ? x : bf16x8{}; }
                const size_t kvo = (size_t)bh * KEYS * 128; rb = 72 + bh * NRANGE + rg;
                if (active) fb::attn_unit<false, false>(qr, KA + kvo, VA + kvo, 0, 0, 0.f, lds, t0, t0, t1 - t0, o, l_reg, m_reg); else fb::attn_unit<false, true>(qr, KA + kvo, VA + kvo, 0, 0, 0.f, lds, t0, t0, t1 - t0, o, l_reg, m_reg);
            }
            if (active) {
                int lane = lane0; asm volatile("" : "+v"(lane));
                const int r32 = lane & 31, hi = lane >> 5;
                LSUM2(l_reg);
                unsigned char* ws = WS_(); float* PART = (float*)(ws + OFF_PART); float* PML = (float*)(ws + OFF_PML);
                float* po = PART + (size_t)rb * 32 * 128;
#pragma unroll
                for (int r = 0; r < 16; ++r)
#pragma unroll
                    for (int d = 0; d < 4; ++d) po[crow(r, hi) * 128 + d * 32 + r32] = o[d][r];
                if (hi == 0) { PML[(rb * 32 + r32) * 2] = m_reg; PML[(rb * 32 + r32) * 2 + 1] = l_reg; }
            }
            __syncthreads();
        }
    }
    for (int v = vb; v < 256; v += nvb) {
        const int xcd = v & 7, slot = v >> 3;
        for (int k = 0; k < 2; ++k) {
            f32x16 o[4]; float l_reg, m_reg;
            {
                const int b = xcd >> 2, kvh = (xcd >> 1) & 1, h = kvh * 4 + (xcd & 1) * 2 + k, bh = b * 8 + h, qb = slot;
                { bf16x8 qr[8]; const int r32q = lane0 & 31, hiq = lane0 >> 5;
                  unsigned char* ws = WS_(); const bf16_t *QB = (const bf16_t*)(ws + OFF_QB), *KB = (const bf16_t*)(ws + OFF_KB), *VB = (const bf16_t*)(ws + OFF_VB);
                  const bf16_t* q = QB + ((size_t)bh * QROWS + qb * 256 + wid * 32 + r32q) * 128 + hiq * 8;
#pragma unroll
                  for (int d0 = 0; d0 < 8; ++d0) qr[d0] = *reinterpret_cast<const bf16x8*>(q + d0 * 16);
                  const size_t kvo = (size_t)(b * 2 + kvh) * KEYS * 128;
                  fb::attn_unit<false>(qr, KB + kvo, VB + kvo, 0, 0, 0.f, lds, 0, 0, NT, o, l_reg, m_reg); }
                int lane = lane0; asm volatile("" : "+v"(lane));
                const int r32 = lane & 31, hi = lane >> 5;
                LSUM2(l_reg);
                float* li_l = (float*)(lds + fb::L_WS) + wid * 64;
                if (hi == 0) li_l[r32] = l_reg;
                asm volatile("s_waitcnt lgkmcnt(0)" ::: "memory");
#pragma unroll
                for (int r = 0; r < 16; ++r) { const float rl = __builtin_amdgcn_rcpf(li_l[crow(r, hi)]);
#pragma unroll
                    for (int d = 0; d < 4; ++d) o[d][r] *= rl; }
                const int wave_row0 = qb * 256 + wid * 32;
                bf16_t* OB = (bf16_t*)(WS_() + OFF_AO) + 1024;
                store_tile(o, lds + wid * 8704, lane, [&](int row) -> bf16_t* { return OB + (size_t)(b * SEQ + wave_row0 + row) * AOP + h * 128; });
                __syncthreads();
            }
        }
    }
    for (;;) {
                f32x16 o[4]; float l_reg, m_reg;
                const int tid = TID(), lane0 = tid & 63;
                __syncthreads();
                if (tid == 0) ((volatile int*)(lds + fb::L_WS + 2048))[0] = (int)atomicAdd((unsigned*)(WS_() + OFF_QCTR), 1u);
                __syncthreads();
                const int uq = __builtin_amdgcn_readfirstlane(((volatile int*)(lds + fb::L_WS + 2048))[0]);
                if (uq >= 1024) break;
                const int h = 7 - (uq >> 7), b = (uq >> 6) & 1, qb = uq & 63, bh = b * 8 + h, mp = wid >> 2, wq = wid & 3;
                int jlo, nvis;
                { const float* nq = (const float*)(WS_() + OFF_NRM) + (b * 8 + h) * 4; const float* nk = nq + 64;
                  const float B0 = sqrtf(nq[0] * nk[0]) + sqrtf(nq[1] * nk[1]), B1 = sqrtf(nq[2] * nk[2]) + sqrtf(nq[3] * nk[3]);
                  const float Bm = 1.02f * fmaxf(B0, B1), slopeC = exp2f(-(float)(h + 1)) * LOG2E;
                  const float dc = fminf((2.f * Bm + 160.f) / slopeC, 16384.f); const int dcut = (int)dc;
                  int lo = qb * 128 - dcut; lo = lo < 0 ? 0 : lo; int hi_ = qb * 128 + 127 + dcut; hi_ = hi_ > SEQ - 1 ? SEQ - 1 : hi_;
                  jlo = 1 + (lo >> 6); int jhi = 1 + (hi_ >> 6); nvis = jhi - jlo + 2;
                  if ((nvis & 1) == 0) { if (jhi < NT - 1) ++jhi; else --jlo; ++nvis; }
                  if (nvis < 3) { jlo = jlo > 1 ? jlo - 1 : jlo; nvis = 3; } }
                { bf16x8 qr[4]; const int r32q = lane0 & 31, hiq = lane0 >> 5; const int qrow = qb * 128 + wq * 32 + r32q;
                  unsigned char* ws = WS_(); const bf16_t *QA = (const bf16_t*)(ws + OFF_QA), *KA = (const bf16_t*)(ws + OFF_KA), *VA = (const bf16_t*)(ws + OFF_VA);
                  const bf16_t* q = QA + ((size_t)bh * QROWS + qrow) * 128 + mp * 64 + hiq * 8;
#pragma unroll
                  for (int d0 = 0; d0 < 4; ++d0) qr[d0] = *reinterpret_cast<const bf16x8*>(q + d0 * 16);
                  const float slopeL = exp2f(-(float)(h + 1)) * LOG2E;
                  const size_t kvo = (size_t)bh * KEYS * 128;
                  fb::attn_unit<true>(qr, KA + kvo, VA + kvo, qrow, qb * 128 + wq * 32, slopeL, lds, 0, jlo - 1, nvis, o, l_reg, m_reg); }
                int lane = lane0; asm volatile("" : "+v"(lane));
                const int r32 = lane & 31, hi = lane >> 5;
                LSUM2(l_reg);
                float* li_l = (float*)(lds + fb::L_WS) + wid * 64;
                if (hi == 0) li_l[r32] = l_reg;
                asm volatile("s_waitcnt lgkmcnt(0)" ::: "memory");
#pragma unroll
                for (int r = 0; r < 16; ++r) { const float rl = __builtin_amdgcn_rcpf(li_l[crow(r, hi)]);
#pragma unroll
                    for (int d = 0; d < 4; ++d) o[d][r] *= rl; }
                float* X = (float*)lds + wq * 4096;
                if (mp == 1) {
#pragma unroll
                    for (int r = 0; r < 16; ++r)
#pragma unroll
                        for (int d = 0; d < 4; ++d) X[(r * 4 + d) * 64 + lane] = o[d][r];
                }
                __syncthreads();
                if (mp == 0) {
                    const float lam = *(const float*)(WS_() + OFF_LAM);
                    float ss[16];
#pragma unroll
                    for (int r = 0; r < 16; ++r) { float a = 0.f;
#pragma unroll
                        for (int d = 0; d < 4; ++d) { const float y = o[d][r] - lam * X[(r * 4 + d) * 64 + lane]; o[d][r] = y; a += y * y; }
                        ss[r] = a; }
#pragma unroll
                    for (int r = 0; r < 16; ++r) {
                        float a = ss[r];
                        a += __shfl_xor(a, 1); a += __shfl_xor(a, 2); a += __shfl_xor(a, 4); a += __shfl_xor(a, 8); a += __shfl_xor(a, 16);
                        ss[r] = 1.0f / sqrtf(a * (1.0f / 128.f) + EPS) * (1.0f - LAM_INIT);
                    }
                    float g[4];
#pragma unroll
                    for (int d = 0; d < 4; ++d) g[d] = p.g_subln[d * 32 + r32];
#pragma unroll
                    for (int r = 0; r < 16; ++r)
#pragma unroll
                        for (int d = 0; d < 4; ++d) o[d][r] *= ss[r] * g[d];
                }
                __syncthreads();
                if (mp == 0) {
                    const int wave_row0 = qb * 128 + wq * 32;
                    bf16_t* OA = (bf16_t*)(WS_() + OFF_AO);
                    store_tile(o, lds + wid * 8704, lane, [&](int row) -> bf16_t* { return OA + (size_t)(b * SEQ + wave_row0 + row) * AOP + h * 128; });
                }
                __syncthreads();
    }
#undef LSUM2
#undef WS_
}
__device__ __forceinline__ void phase2b(const Params& p, int vb, int nvb) {
    const int tid = TID(), lane = tid & 63, wave = tid >> 6;
    const float* PART = (const float*)(p.ws + OFF_PART); const float* PML = (const float*)(p.ws + OFF_PML);
    bf16_t* OA = (bf16_t*)(p.ws + OFF_AO); bf16_t* OB = OA + 1024;
    const float lam = *(const float*)(p.ws + OFF_LAM);
    for (int t = vb * 8 + wave; t < 512; t += nvb * 8) {
        const int type = t >> 8, b = (t >> 7) & 1, h = (t >> 4) & 7, i = t & 15;
        float y0 = 0.f, y1 = 0.f;
        for (int mp = 0; mp < (type == 0 ? 1 : 2); ++mp) {
            int rb0, row;
            if (type == 0) { const int kvh = h >> 2, w = (h & 3) >> 1; rb0 = ((b * 2 + kvh) * NRANGE) * 2 + w; row = (h & 1) * 16 + i; }
            else { rb0 = 72 + (b * 8 + h) * NRANGE; row = mp * 16 + i; }
            const int rbs = type == 0 ? 2 : 1;
            float M = -1e30f;
            for (int r = 0; r < NRANGE; ++r) M = fmaxf(M, PML[((rb0 + r * rbs) * 32 + row) * 2]);
            float L = 0.f, a0 = 0.f, a1 = 0.f;
            for (int r = 0; r < NRANGE; ++r) { const int rb = rb0 + r * rbs; const float w = exp2f(PML[(rb * 32 + row) * 2] - M);
                L += PML[(rb * 32 + row) * 2 + 1] * w; const float2 ov = *(const float2*)(PART + ((size_t)rb * 32 + row) * 128 + 2 * lane); a0 += ov.x * w; a1 += ov.y * w; }
            const float sgn = mp == 0 ? 1.f : -lam;
            y0 += sgn * a0 / L; y1 += sgn * a1 / L;
        }
        const size_t grow = (size_t)(MREAL + b * NMETA + i);
        if (type == 0) ((unsigned*)(OB + grow * AOP + h * 128))[lane] = f2bf(y0) | (f2bf(y1) << 16);
        else { const float ss = wave_sum(y0 * y0 + y1 * y1); const float rstd = 1.0f / sqrtf(ss * (1.0f / 128.f) + EPS) * (1.0f - LAM_INIT);
            ((unsigned*)(OA + grow * AOP + h * 128))[lane] = f2bf(y0 * rstd * p.g_subln[2 * lane]) | (f2bf(y1 * rstd * p.g_subln[2 * lane + 1]) << 16); }
    }
}

__device__ __forceinline__ float* h2_row(const Params& p, int grow) { return grow < MREAL ? p.out + (size_t)grow * DM : (float*)(p.ws + OFF_H2M) + (size_t)(grow - MREAL) * DM; }
__device__ __forceinline__ void phase4a(const Params& p, float* lds, int vb, int nvb) {
    const int tid = TID(), lane = tid & 63, wave = tid >> 6;
    for (int i = tid; i < DM * NEXP; i += NTHREADS) { const int k = i >> 4, e = i & 15; lds[e * DM + k] = p.w_router[i]; }
    __syncthreads();
    bf16_t* U2 = (bf16_t*)(p.ws + OFF_UN); float* AFF = (float*)(p.ws + OFF_AFF);
    for (int r = vb * 8 + wave; r < MROWS; r += nvb * 8) {
        const RowInfo ri = row_decode(r);
        const f32x4* xr = (const f32x4*)h2_row(p, r) + lane;
        f32x4 v[4]; float s = 0.f;
#pragma unroll
        for (int j = 0; j < 4; ++j) { v[j] = xr[64 * j]; s += (v[j].x * v[j].x + v[j].y * v[j].y) + (v[j].z * v[j].z + v[j].w * v[j].w); }
        const float rstd = 1.0f / sqrtf(wave_sum(s) * (1.0f / DM) + EPS);
        u32x2* o = (u32x2*)(U2 + (size_t)r * DM) + lane;
#pragma unroll
        for (int j = 0; j < 4; ++j) {
            const f32x4 g = ((const f32x4*)p.g_ffn)[lane + 64 * j];
            v[j].x *= rstd * g.x; v[j].y *= rstd * g.y; v[j].z *= rstd * g.z; v[j].w *= rstd * g.w;
            u32x2 w; w.x = f2bf(v[j].x) | (f2bf(v[j].y) << 16); w.y = f2bf(v[j].z) | (f2bf(v[j].w) << 16);
            o[64 * j] = w;
        }
        float mylg = -1e30f;
#pragma unroll 1
        for (int e = 0; e < NEXP; ++e) {
            float a = 0.f;
#pragma unroll
            for (int j = 0; j < 4; ++j) { const f32x4 w = *(const f32x4*)(lds + e * DM + 4 * (lane + 64 * j)); a += v[j].x * w.x + v[j].y * w.y + v[j].z * w.z + v[j].w * w.w; }
            a = wave_sum(a);
            if (lane == e) mylg = a;
        }
        const float mx = wave_max(mylg);
        const float ex = lane < NEXP ? expf(mylg - mx) : 0.f;
        const float mine = ex / wave_sum(ex);
        if (lane < NEXP) AFF[((size_t)ri.b * NEXP + lane) * LTOT + row_pos(ri)] = mine;
    }
    __syncthreads();
}

__device__ __forceinline__ void phase6(const Params& p, int vb, int nvb) {
    const int tid = TID(), lane = tid & 63, wave = tid >> 6;
    const int* SEL = (const int*)(p.ws + OFF_SEL); const bf16_t* YB = (const bf16_t*)(p.ws + OFF_YB);
    for (int r = vb * 8 + wave; r < MREAL; r += nvb * 8) {
        const int b = r >> 13, tok = NMETA + (r & (SEQ - 1));
        f32x4* xr = (f32x4*)(p.out + (size_t)r * DM) + lane;
        f32x4 v[4];
#pragma unroll
        for (int j = 0; j < 4; ++j) v[j] = xr[64 * j];
        const int sel = lane < NEXP ? SEL[((size_t)b * LTOT + tok) * NEXP + lane] : -1;
        for (int e = 0; e < NEXP; ++e) {
            const int c = __shfl(sel, e);
            if (c >= 0) {
                const u32x2* y = (const u32x2*)(YB + ((size_t)e * ESLOTS + b * CAP + c) * DM) + lane;
#pragma unroll
                for (int j = 0; j < 4; ++j) { const u32x2 w = y[64 * j]; v[j].x += bf2f(w.x & 0xffffu); v[j].y += bf2f(w.x >> 16); v[j].z += bf2f(w.y & 0xffffu); v[j].w += bf2f(w.y >> 16); }
            }
        }
        float s = 0.f;
#pragma unroll
        for (int j = 0; j < 4; ++j) s += (v[j].x * v[j].x + v[j].y * v[j].y) + (v[j].z * v[j].z + v[j].w * v[j].w);
        const float rstd = 1.0f / sqrtf(wave_sum(s) * (1.0f / DM) + EPS);
#pragma unroll
        for (int j = 0; j < 4; ++j) { const f32x4 g = ((const f32x4*)p.g_final)[lane + 64 * j]; xr[64 * j] = (f32x4){v[j].x * rstd * g.x, v[j].y * rstd * g.y, v[j].z * rstd * g.z, v[j].w * rstd * g.w}; }
    }
}

template <class DstRow>
__device__ __forceinline__ void transpose_item(const float* __restrict__ W, int N, bf16_t* __restrict__ WT, int ldk, int koff, float* scr, int k0, int n0, int lane, DstRow dst) {
#pragma unroll 8
    for (int i = 0; i < 32; ++i) { const int kk = 2 * i + (lane >> 5); scr[kk * 33 + (lane & 31)] = W[(size_t)(k0 + kk) * N + n0 + (lane & 31)]; }
    asm volatile("s_waitcnt vmcnt(0) lgkmcnt(0)" ::: "memory");
    const int c = lane & 7;
#pragma unroll
    for (int j = 0; j < 4; ++j) { const int n = (lane >> 3) + 8 * j; const float* sp = scr + (8 * c) * 33 + n;
        u32x4 o; o.x = f2bf(sp[0 * 33]) | (f2bf(sp[1 * 33]) << 16); o.y = f2bf(sp[2 * 33]) | (f2bf(sp[3 * 33]) << 16);
        o.z = f2bf(sp[4 * 33]) | (f2bf(sp[5 * 33]) << 16); o.w = f2bf(sp[6 * 33]) | (f2bf(sp[7 * 33]) << 16);
        *(u32x4*)(WT + (size_t)dst(n0 + n) * ldk + koff + k0 + 8 * c) = o; }
    asm volatile("s_waitcnt lgkmcnt(0)" ::: "memory");
}
__device__ __forceinline__ int rope_slot(int e) { const int half = e >> 6, el = e & 63, j = el & 31, n = el >> 5, g = half * 8 + (j >> 2); return 32 * (g >> 2) + 8 * (g & 3) + 4 * n + (j & 3); }
__device__ __forceinline__ void transpose_p0(const Params& p, float* lds, int vb, int nvb) {
    const int tid = TID(), lane = tid & 63, wave = tid >> 6;
    float* scr = lds + wave * (64 * 33);
    bf16_t* WIN = (bf16_t*)(p.ws + OFF_WIN); bf16_t* WAB = (bf16_t*)(p.ws + OFF_WAB); bf16_t* WO = (bf16_t*)(p.ws + OFF_WO);
    constexpr int I_IN = 16 * (INW / 32), I_SQ = 16 * 32;
    for (int it = vb * 8 + wave; it < I_IN + 3 * I_SQ; it += nvb * 8) {
        int r = it;
        if (r < I_IN) { const int kb = r / (INW / 32), nb = r % (INW / 32);
            transpose_item(p.w_in, INW, WIN, DM, 0, scr, kb * 64, nb * 32, lane, [](int n) { return (n >= 3072 && n < 4352) ? (n & ~127) + rope_slot(n & 127) : n; }); continue; }
        r -= I_IN; const int m = r / I_SQ, q = r % I_SQ, kb = q / 32, nb = q % 32;
        if (m == 0) transpose_item(p.w_ba, DM, WAB, 2048, 0, scr, kb * 64, nb * 32, lane, [](int n) { return n; });
        else if (m == 1) transpose_item(p.w_bb, DM, WAB, 2048, 1024, scr, kb * 64, nb * 32, lane, [](int n) { return n; });
        else transpose_item(p.w_out, DM, WO, DM, 0, scr, kb * 64, nb * 32, lane, [](int n) { return n; });
    }
}
__device__ __forceinline__ void transpose_moe(const Params& p, float* lds, int vbl, int nvbl) {
    const int tid = TID(), lane = tid & 63, wave = tid >> 6;
    float* scr = lds + wave * (64 * 33);
    bf16_t* WGU = (bf16_t*)(p.ws + OFF_WGU); bf16_t* WD = (bf16_t*)(p.ws + OFF_WD);
    constexpr int I_G = 16 * 16, I_D = 8 * 32, I_E = 2 * I_G + I_D;
    for (int it = vbl * 8 + wave; it < NEXP * I_E; it += nvbl * 8) {
        const int e = it / I_E; int r = it % I_E;
        if (r < 2 * I_G) { const int up = r / I_G, q = r % I_G, kb = q / 16, nb = q % 16;
            const float* W = (up ? p.w_up : p.w_gate) + (size_t)e * DM * EFF;
            transpose_item(W, EFF, WGU + (size_t)e * DM * DM, DM, 0, scr, kb * 64, nb * 32, lane, [up](int f) { return 8 * (f >> 2) + 4 * up + (f & 3); }); }
        else { r -= 2 * I_G; const int kb = r / 32, nb = r % 32;
            transpose_item(p.w_down + (size_t)e * EFF * DM, DM, WD + (size_t)e * DM * EFF, EFF, 0, scr, kb * 64, nb * 32, lane, [](int n) { return n; }); }
    }
}

namespace pg8 {
#define PG8_LAS __attribute__((address_space(3)))
typedef short bf16x8 __attribute__((ext_vector_type(8)));
constexpr int BM = 256, BK = 64, HALF = 128, HTB = HALF * BK * 2, STAGE_BYTES = 8 * HTB, NXCD = 8, WGM = 8;
__host__ __device__ __forceinline__ int lds_byte(int r, int c) { const int st = (r >> 4) * 2 + (c >> 5), rr = r & 15, cc = c & 31, ob = rr * 64 + cc * 2; return st * 1024 + (ob ^ (((ob >> 9) & 1) << 5)); }
__host__ __device__ __forceinline__ void stage_rc(int b, int& R, int& C) { const int st = b / 1024, sb = b % 1024, swz = sb ^ (((sb >> 9) & 1) << 5); R = (st >> 1) * 16 + swz / 64; C = (st & 1) * 32 + (swz % 64) / 2; }
__host__ __device__ __forceinline__ int perm32(int rho) { const int n = rho >> 4, i = rho & 15; return 8 * (i >> 2) + 4 * n + (i & 3); }
struct Unit { int arow0, brow0, pm, pn, e; };
struct Gemm { const bf16_t* A; const bf16_t* Bt; int K; };
struct GridOrder {
    int nM, nN, nwg, G, c;
    __device__ void init(int nM_, int nN_, int G_, int c_) { nM = nM_; nN = nN_; nwg = nM * nN; G = G_; c = c_; }
    __device__ bool next(int i, Unit& u) const {
        const long L = (long)i * G + c; if (L >= nwg) return false;
        int wgid = (int)L; { const int q = nwg / NXCD, r = nwg % NXCD, xcd = wgid % NXCD, off = wgid / NXCD; wgid = (xcd < r ? xcd * (q + 1) : r * (q + 1) + (xcd - r) * q) + off; }
        const int nig = WGM * nN, gid = wgid / nig, fm = gid * WGM, gsz = (nM - fm) < WGM ? (nM - fm) : WGM;
        u.pm = fm + ((wgid % nig) % gsz); u.pn = (wgid % nig) / gsz; u.e = 0; u.arow0 = u.pm * BM; u.brow0 = u.pn * BM; return true;
    }
};
struct MoeOrder {
    int G, c;
    __device__ bool next(int i, Unit& u) const {
        const int L = i * G + c; if (L >= NEXP * 36) return false;
        u.e = L / 36; const int r = L % 36; u.pm = r % 9; u.pn = r / 9; u.arow0 = u.e * ESLOTS + u.pm * BM; u.brow0 = u.e * DM + u.pn * BM; return true;
    }
};
__device__ __forceinline__ unsigned cvt_pk_bf16(float lo, float hi) { unsigned r; asm volatile("v_cvt_pk_bf16_f32 %0, %1, %2" : "=v"(r) : "v"(lo), "v"(hi)); return r; }

template <class Epi, class Sched>
__device__ __forceinline__ void gemm_phase(PG8_LAS unsigned char* lds, const Gemm g, const Sched& S, const Epi& E) {
    const int tid = TID(), wid = __builtin_amdgcn_readfirstlane(tid >> 6), lane = tid & 63, wr = wid >> 2, wc = wid & 3, fr = lane & 15, fq = lane >> 4;
    const int K = g.K, nt = K / BK;
    unsigned voffA[2], voffB[2];
#pragma unroll
    for (int i = 0; i < 2; ++i) { int R, C; stage_rc(tid * 16 + i * 8192, R, C); const int Rb = Epi::PERM ? ((R & ~31) + perm32(R & 31)) : R;
        voffA[i] = (unsigned)(R * K + C) * 2u; voffB[i] = (unsigned)(Rb * K + C) * 2u; }
    const size_t kstep = (size_t)(BK * 2);
    const size_t hstep = (size_t)HALF * K * 2;
    const size_t rstep = (size_t)K * 2;
    const unsigned ldsw = (unsigned)wid * 1024u;
    const int aoff = lds_byte(wr * 64 + fr, fq * 8), boff = lds_byte(wc * 32 + fr, fq * 8);
#define PG8_SA(b, h) (((b) * 2 + (h)) * HTB)
#define PG8_SB(b, h) ((4 + (b) * 2 + (h)) * HTB)
#define PG8_STAGE(bufoff, gbase, voff) do { _Pragma("unroll") for (int _i = 0; _i < 2; ++_i) \
        __builtin_amdgcn_global_load_lds((const unsigned*)((const char*)(gbase) + (voff)[_i]), (PG8_LAS unsigned*)(lds + (bufoff) + ldsw + _i * 8192), 16, 0, 0); } while (0)
#define PG8_LDA(dst, b, h) do { _Pragma("unroll") for (int m = 0; m < 4; ++m) _Pragma("unroll") for (int k = 0; k < 2; ++k) dst[m][k] = *(const PG8_LAS bf16x8*)(lds + PG8_SA(b, h) + aoff + m * 2048 + k * 1024); } while (0)
#define PG8_LDB(dst, b, h) do { _Pragma("unroll") for (int n = 0; n < 2; ++n) _Pragma("unroll") for (int k = 0; k < 2; ++k) dst[n][k] = *(const PG8_LAS bf16x8*)(lds + PG8_SB(b, h) + boff + n * 2048 + k * 1024); } while (0)
#define PG8_MMA(ai, bj, At, Bt) do { __builtin_amdgcn_s_setprio(1); _Pragma("unroll") for (int m = 0; m < 4; ++m) _Pragma("unroll") for (int n = 0; n < 2; ++n) _Pragma("unroll") for (int k = 0; k < 2; ++k) \
        acc[ai][bj][m][n] = __builtin_amdgcn_mfma_f32_16x16x32_bf16(Bt[n][k], At[m][k], acc[ai][bj][m][n], 0, 0, 0); __builtin_amdgcn_s_setprio(0); } while (0)
#define PG8_WAIT_V(n) asm volatile("s_waitcnt vmcnt(" #n ")" ::: "memory")
#define PG8_WAIT_L(n) asm volatile("s_waitcnt lgkmcnt(" #n ")" ::: "memory")
#define PG8_BAR __builtin_amdgcn_s_barrier()
#define PG8_SCHED __builtin_amdgcn_sched_barrier(0)
    Unit cur, nxt; int ui = 0;
    if (!S.next(0, cur)) return;
    f32x4 acc[2][2][4][2];
#pragma unroll
    for (int a = 0; a < 2; ++a)
#pragma unroll
        for (int b = 0; b < 2; ++b)
#pragma unroll
            for (int m = 0; m < 4; ++m)
#pragma unroll
                for (int n = 0; n < 2; ++n) acc[a][b][m][n] = (f32x4){0.f, 0.f, 0.f, 0.f};
    bf16x8 At[4][2], B0[2][2], B1[2][2];
    const char* cA = (const char*)g.A + (size_t)cur.arow0 * rstep; const char* cB = (const char*)g.Bt + (size_t)cur.brow0 * rstep;
    PG8_STAGE(PG8_SB(0, 0), cB, voffB); PG8_STAGE(PG8_SB(0, 1), cB + hstep, voffB); PG8_STAGE(PG8_SA(0, 0), cA, voffA); PG8_STAGE(PG8_SA(0, 1), cA + hstep, voffA);
    if (wr == 1) PG8_BAR;
    PG8_WAIT_V(2); PG8_BAR;
    PG8_STAGE(PG8_SB(1, 0), cB + kstep, voffB); PG8_STAGE(PG8_SA(1, 0), cA + kstep, voffA); PG8_STAGE(PG8_SB(1, 1), cB + hstep + kstep, voffB);
    PG8_WAIT_V(6); PG8_BAR;
    for (;;) {
        const bool has_next = S.next(ui + 1, nxt);
        const char* nA = has_next ? (const char*)g.A + (size_t)nxt.arow0 * rstep : cA; const char* nB = has_next ? (const char*)g.Bt + (size_t)nxt.brow0 * rstep : cB;
        for (int t = 0; t < nt; t += 2) {
            const bool last = (t == nt - 2);
            const char* a1 = cA + (size_t)(t + 1) * kstep;
            const char* a2 = last ? nA : cA + (size_t)(t + 2) * kstep; const char* b2 = last ? nB : cB + (size_t)(t + 2) * kstep;
            const char* a3 = a2 + kstep; const char* b3 = b2 + kstep;
            if constexpr (Epi::HAS_MID) { if (t == nt / 2) E.mid(acc, cur, wr, wc, fr, fq); }
            PG8_LDB(B0, 0, 0); PG8_LDB(B1, 0, 1); PG8_SCHED; PG8_LDA(At, 0, 0); PG8_STAGE(PG8_SA(1, 1), a1 + hstep, voffA);
            PG8_WAIT_V(8); PG8_WAIT_L(0); PG8_BAR; PG8_MMA(0, 0, At, B0); PG8_MMA(0, 1, At, B1); PG8_BAR; PG8_SCHED;
            PG8_LDA(At, 0, 1); PG8_STAGE(PG8_SB(0, 0), b2, voffB); PG8_STAGE(PG8_SB(0, 1), b2 + hstep, voffB); PG8_STAGE(PG8_SA(0, 0), a2, voffA);
            PG8_WAIT_V(8); PG8_WAIT_L(0); PG8_BAR; PG8_MMA(1, 0, At, B0); PG8_MMA(1, 1, At, B1); PG8_BAR; PG8_SCHED;
            PG8_LDB(B0, 1, 0); PG8_LDB(B1, 1, 1); PG8_SCHED; PG8_LDA(At, 1, 0); PG8_STAGE(PG8_SA(0, 1), a2 + hstep, voffA);
            PG8_WAIT_V(8); PG8_WAIT_L(0); PG8_BAR; PG8_MMA(0, 0, At, B0); PG8_MMA(0, 1, At, B1); PG8_BAR; PG8_SCHED;
            PG8_LDA(At, 1, 1); PG8_STAGE(PG8_SB(1, 0), b3, voffB); PG8_STAGE(PG8_SB(1, 1), b3 + hstep, voffB); PG8_STAGE(PG8_SA(1, 0), a3, voffA);
            PG8_WAIT_V(8); PG8_WAIT_L(0); PG8_BAR; PG8_MMA(1, 0, At, B0); PG8_MMA(1, 1, At, B1); PG8_BAR; PG8_SCHED;
        }
        if (wr == 0) PG8_BAR;
        E(acc, cur, wr, wc, fr, fq, lds);
        if (!has_next) break;
#pragma unroll
        for (int a = 0; a < 2; ++a)
#pragma unroll
            for (int b = 0; b < 2; ++b)
#pragma unroll
                for (int m = 0; m < 4; ++m)
#pragma unroll
                    for (int n = 0; n < 2; ++n) acc[a][b][m][n] = (f32x4){0.f, 0.f, 0.f, 0.f};
        cur = nxt; cA = nA; cB = nB; ++ui;
        if (wr == 1) PG8_BAR;
    }
    PG8_WAIT_V(0);
    PG8_BAR;
#undef PG8_SA
#undef PG8_SB
#undef PG8_STAGE
#undef PG8_LDA
#undef PG8_LDB
#undef PG8_MMA
#undef PG8_WAIT_V
#undef PG8_WAIT_L
#undef PG8_SCHED
}
#define PG8_FOR_AM _Pragma("unroll") for (int ai = 0; ai < 2; ++ai) _Pragma("unroll") for (int m = 0; m < 4; ++m)
#define PG8_FOR_BJ _Pragma("unroll") for (int bj = 0; bj < 2; ++bj)

struct EpiInProj {
    static constexpr bool PERM = true, HAS_MID = false;
    Params p;
    __device__ __forceinline__ void operator()(f32x4 (&acc)[2][2][4][2], const Unit& u, int wr, int wc, int fr, int fq, PG8_LAS unsigned char* lds) const {
        const int pn = u.pn;
        const int sec = pn < 4 ? 0 : pn < 8 ? 1 : pn < 12 ? 2 : pn < 16 ? 3 : pn == 16 ? 4 : pn == 17 ? 5 : pn < 22 ? 6 : 7;
        const int head0 = (sec == 0 ? pn : sec == 1 ? pn - 4 : sec == 2 ? pn - 8 : sec == 3 ? pn - 12 : sec == 6 ? pn - 18 : sec == 7 ? pn - 22 : 0) * 2;
        const int cl = wc * 32 + fq * 8;
        if (sec == 3 || sec == 4) {
            PG8_LAS float* X = (PG8_LAS float*)(lds + STAGE_BYTES);
            PG8_FOR_AM { PG8_FOR_BJ { const f32x4 a = acc[ai][bj][m][0], b = acc[ai][bj][m][1];
                float ss = (a.x * a.x + a.y * a.y) + (a.z * a.z + a.w * a.w) + (b.x * b.x + b.y * b.y) + (b.z * b.z + b.w * b.w);
                ss += __shfl_xor(ss, 16); ss += __shfl_xor(ss, 32);
                if (fq == 0) X[((ai * 128 + wr * 64 + m * 16 + fr) * 2 + bj) * 4 + wc] = ss; } }
            asm volatile("s_waitcnt lgkmcnt(0)" ::: "memory"); __builtin_amdgcn_s_barrier(); asm volatile("" ::: "memory");
            const int g = wc * 4 + fq, j0 = (g & 7) * 4, e0 = (g >> 3) * 64 + j0;
            const float* gn = sec == 3 ? p.g_qnorm : p.g_knorm;
            const f32x4 g1 = *(const f32x4*)(gn + e0), g2 = *(const f32x4*)(gn + e0 + 32);
            const float sc = sec == 3 ? CB : 1.f;
            const float2* rope = (const float2*)(p.ws + OFF_ROPE);
            PG8_FOR_AM { const int rl = ai * 128 + wr * 64 + m * 16 + fr, grow = u.pm * BM + rl; const RowInfo ri = row_decode(grow);
                f32x4 c4 = (f32x4){1.f, 1.f, 1.f, 1.f}, s4 = (f32x4){0.f, 0.f, 0.f, 0.f};
                if (!ri.meta) { const int pos = (g >> 3) ? (ri.t & 63) : (ri.t >> 6); const f32x4 t0 = *(const f32x4*)(rope + pos * 32 + j0), t1 = *(const f32x4*)(rope + pos * 32 + j0 + 2);
                    c4 = (f32x4){t0.x, t0.z, t1.x, t1.z}; s4 = (f32x4){t0.y, t0.w, t1.y, t1.w}; }
                PG8_FOR_BJ { const f32x4 pq = *(const PG8_LAS f32x4*)(X + (rl * 2 + bj) * 4);
                    const float rstd = 1.0f / sqrtf(((pq.x + pq.y) + (pq.z + pq.w)) * (1.0f / 128.f) + EPS) * sc;
                    const f32x4 x1 = acc[ai][bj][m][0] * g1 * rstd, x2 = acc[ai][bj][m][1] * g2 * rstd;
                    const f32x4 y1 = x1 * c4 - x2 * s4, y2 = x2 * c4 + x1 * s4;
                    if (ri.valid) { const int head = head0 + bj;
                        bf16_t* dst = sec == 3 ? (bf16_t*)(p.ws + OFF_QB) + ((size_t)(ri.b * 8 + head) * QROWS + row_q(ri)) * 128 : (bf16_t*)(p.ws + OFF_KB) + ((size_t)(ri.b * 2 + head) * KEYS + row_key(ri)) * 128;
                        *(u32x2*)(dst + e0) = (u32x2){cvt_pk_bf16(y1.x, y1.y), cvt_pk_bf16(y1.z, y1.w)};
                        *(u32x2*)(dst + e0 + 32) = (u32x2){cvt_pk_bf16(y2.x, y2.y), cvt_pk_bf16(y2.z, y2.w)}; } } }
            return;
        }
        if (sec <= 1 && u.pm < MREAL / BM) {
            const float sc2 = sec == 0 ? CA * CA : 1.f; float mx[2] = {0.f, 0.f};
            PG8_FOR_AM { PG8_FOR_BJ { const f32x4 a = acc[ai][bj][m][0], b = acc[ai][bj][m][1];
                float ss = (a.x * a.x + a.y * a.y) + (a.z * a.z + a.w * a.w) + (b.x * b.x + b.y * b.y) + (b.z * b.z + b.w * b.w);
                ss += __shfl_xor(ss, 16); ss += __shfl_xor(ss, 32); mx[bj] = fmaxf(mx[bj], ss * sc2); } }
            PG8_FOR_BJ { float v = mx[bj]; v = fmaxf(v, __shfl_xor(v, 1)); v = fmaxf(v, __shfl_xor(v, 2)); v = fmaxf(v, __shfl_xor(v, 4)); v = fmaxf(v, __shfl_xor(v, 8));
                if (fr == 0 && fq == 0) atomicMax((unsigned*)(p.ws + OFF_NRM) + ((sec * 2 + (u.pm >> 5)) * 8 + head0 + bj) * 4 + wc, __float_as_uint(v)); }
        }
        PG8_FOR_AM { const int grow = u.pm * BM + ai * 128 + wr * 64 + m * 16 + fr; const RowInfo ri = row_decode(grow);
            if (!ri.valid) continue;
            PG8_FOR_BJ { const int head = head0 + bj; f32x4 a = acc[ai][bj][m][0], b = acc[ai][bj][m][1]; bf16_t* dst;
                if (sec == 0) { dst = (bf16_t*)(p.ws + OFF_QA) + ((size_t)(ri.b * 8 + head) * QROWS + row_q(ri)) * 128; a = a * CA; b = b * CA; }
                else if (sec == 1) dst = (bf16_t*)(p.ws + OFF_KA) + ((size_t)(ri.b * 8 + head) * KEYS + row_key(ri)) * 128;
                else if (sec == 2) dst = (bf16_t*)(p.ws + OFF_VA) + ((size_t)(ri.b * 8 + head) * KEYS + row_key(ri)) * 128;
                else if (sec == 5) dst = (bf16_t*)(p.ws + OFF_VB) + ((size_t)(ri.b * 2 + head) * KEYS + row_key(ri)) * 128;
                else { dst = (grow < MREAL ? (bf16_t*)p.out + (size_t)grow * 2048 : (bf16_t*)(p.ws + OFF_SGM) + (size_t)(grow - MREAL) * 2048) + (sec == 7 ? 1024 : 0) + head * 128;
                    a.x = 1.0f / (1.0f + __expf(-a.x)); a.y = 1.0f / (1.0f + __expf(-a.y)); a.z = 1.0f / (1.0f + __expf(-a.z)); a.w = 1.0f / (1.0f + __expf(-a.w));
                    b.x = 1.0f / (1.0f + __expf(-b.x)); b.y = 1.0f / (1.0f + __expf(-b.y)); b.z = 1.0f / (1.0f + __expf(-b.z)); b.w = 1.0f / (1.0f + __expf(-b.w)); }
                *(u32x4*)(dst + cl) = (u32x4){cvt_pk_bf16(a.x, a.y), cvt_pk_bf16(a.z, a.w), cvt_pk_bf16(b.x, b.y), cvt_pk_bf16(b.z, b.w)}; } }
    }
};
__device__ __forceinline__ f32x4 bf4(u32x2 w) { return (f32x4){bf2f(w.x & 0xffffu), bf2f(w.x >> 16), bf2f(w.y & 0xffffu), bf2f(w.y >> 16)}; }
struct EpiMerge {
    static constexpr bool PERM = true, HAS_MID = true;
    Params p;
    __device__ __forceinline__ const bf16_t* sg(int grow) const { return grow < MREAL ? (const bf16_t*)p.out + (size_t)grow * 2048 : (const bf16_t*)(p.ws + OFF_SGM) + (size_t)(grow - MREAL) * 2048; }
    __device__ __forceinline__ void mid(f32x4 (&acc)[2][2][4][2], const Unit& u, int wr, int wc, int fr, int fq) const {
        PG8_FOR_AM { const int grow = u.pm * BM + ai * 128 + wr * 64 + m * 16 + fr; if (grow >= MROWS) continue; const bf16_t* s = sg(grow) + u.pn * BM + wc * 32 + fq * 8;
            PG8_FOR_BJ { const u32x4 wa = *(const u32x4*)(s + bj * 128), wb = *(const u32x4*)(s + 1024 + bj * 128);
                const f32x4 b0 = bf4((u32x2){wb.x, wb.y}), b1 = bf4((u32x2){wb.z, wb.w});
                const f32x4 r0 = (f32x4){__builtin_amdgcn_rcpf(b0.x), __builtin_amdgcn_rcpf(b0.y), __builtin_amdgcn_rcpf(b0.z), __builtin_amdgcn_rcpf(b0.w)};
                const f32x4 r1 = (f32x4){__builtin_amdgcn_rcpf(b1.x), __builtin_amdgcn_rcpf(b1.y), __builtin_amdgcn_rcpf(b1.z), __builtin_amdgcn_rcpf(b1.w)};
                acc[ai][bj][m][0] = acc[ai][bj][m][0] * bf4((u32x2){wa.x, wa.y}) * r0;
                acc[ai][bj][m][1] = acc[ai][bj][m][1] * bf4((u32x2){wa.z, wa.w}) * r1; } }
    }
    __device__ __forceinline__ void operator()(f32x4 (&acc)[2][2][4][2], const Unit& u, int wr, int wc, int fr, int fq, PG8_LAS unsigned char*) const {
        bf16_t* MG = (bf16_t*)(p.ws + OFF_MERGED);
        PG8_FOR_AM { const int grow = u.pm * BM + ai * 128 + wr * 64 + m * 16 + fr; if (grow >= MROWS) continue; const int col = u.pn * BM + wc * 32 + fq * 8; const bf16_t* s = sg(grow) + 1024 + col;
            PG8_FOR_BJ { const u32x4 wb = *(const u32x4*)(s + bj * 128);
                const f32x4 a = acc[ai][bj][m][0] * bf4((u32x2){wb.x, wb.y}), b = acc[ai][bj][m][1] * bf4((u32x2){wb.z, wb.w});
                *(u32x4*)(MG + (size_t)grow * DM + col + bj * 128) = (u32x4){cvt_pk_bf16(a.x, a.y), cvt_pk_bf16(a.z, a.w), cvt_pk_bf16(b.x, b.y), cvt_pk_bf16(b.z, b.w)}; } }
    }
};
struct EpiOut {
    static constexpr bool PERM = false, HAS_MID = false;
    Params p;
    __device__ __forceinline__ void operator()(f32x4 (&acc)[2][2][4][2], const Unit& u, int wr, int wc, int fr, int fq, PG8_LAS unsigned char*) const {
        PG8_FOR_AM { const int grow = u.pm * BM + ai * 128 + wr * 64 + m * 16 + fr; if (grow >= MROWS) continue; const int col = u.pn * BM + wc * 32 + fq * 4;
            const float* hr = h_row(p, grow) + col; float* o = h2_row(p, grow) + col;
            PG8_FOR_BJ {
#pragma unroll
                for (int n = 0; n < 2; ++n) *(f32x4*)(o + bj * 128 + n * 16) = *(const f32x4*)(hr + bj * 128 + n * 16) + acc[ai][bj][m][n]; } }
    }
};
struct EpiMoeUp {
    static constexpr bool PERM = true, HAS_MID = false;
    Params p;
    __device__ __forceinline__ void operator()(f32x4 (&acc)[2][2][4][2], const Unit& u, int wr, int wc, int fr, int fq, PG8_LAS unsigned char*) const {
        bf16_t* HID = (bf16_t*)(p.ws + OFF_HID);
        PG8_FOR_AM { const int s = u.pm * BM + ai * 128 + wr * 64 + m * 16 + fr; if (s >= ESLOTS) continue;
            PG8_FOR_BJ { const f32x4 gt = acc[ai][bj][m][0], up = acc[ai][bj][m][1]; const int f0 = (u.pn * BM + bj * 128 + wc * 32 + fq * 8) >> 1;
                const float h0 = gt.x / (1.0f + __expf(-gt.x)) * up.x, h1 = gt.y / (1.0f + __expf(-gt.y)) * up.y, h2 = gt.z / (1.0f + __expf(-gt.z)) * up.z, h3 = gt.w / (1.0f + __expf(-gt.w)) * up.w;
                *(u32x2*)(HID + ((size_t)u.e * ESLOTS + s) * EFF + f0) = (u32x2){cvt_pk_bf16(h0, h1), cvt_pk_bf16(h2, h3)}; } }
    }
};
struct EpiMoeDown {
    static constexpr bool PERM = true, HAS_MID = false;
    Params p;
    __device__ __forceinline__ void operator()(f32x4 (&acc)[2][2][4][2], const Unit& u, int wr, int wc, int fr, int fq, PG8_LAS unsigned char*) const {
        bf16_t* YB = (bf16_t*)(p.ws + OFF_YB); const float* SAFF = (const float*)(p.ws + OFF_SAFF);
        PG8_FOR_AM { const int s = u.pm * BM + ai * 128 + wr * 64 + m * 16 + fr; if (s >= ESLOTS) continue; const float af = SAFF[u.e * ESLOTS + s]; const int col = u.pn * BM + wc * 32 + fq * 8;
            PG8_FOR_BJ { const f32x4 a = acc[ai][bj][m][0] * af, b = acc[ai][bj][m][1] * af;
                *(u32x4*)(YB + ((size_t)u.e * ESLOTS + s) * DM + col + bj * 128) = (u32x4){cvt_pk_bf16(a.x, a.y), cvt_pk_bf16(a.z, a.w), cvt_pk_bf16(b.x, b.y), cvt_pk_bf16(b.z, b.w)}; } }
    }
};
#undef PG8_BAR
}

__device__ __forceinline__ void phase1_fast(const Params& p, unsigned char* lds_raw, int vb, int nvb) {
    pg8::Gemm g{(const bf16_t*)(p.ws + OFF_UN), (const bf16_t*)(p.ws + OFF_WIN), DM};
    pg8::GridOrder S; S.init(MPAD / 256, INW / 256, nvb, vb);
    pg8::EpiInProj E{p};
    pg8::gemm_phase(( __attribute__((address_space(3))) unsigned char*)lds_raw, g, S, E);
}
__device__ __forceinline__ void phase3a_fast(const Params& p, unsigned char* lds_raw, int vb, int nvb) {
    pg8::Gemm g{(const bf16_t*)(p.ws + OFF_AO), (const bf16_t*)(p.ws + OFF_WAB), 2048};
    pg8::GridOrder S; S.init(MPAD / 256, DM / 256, nvb, vb);
    pg8::EpiMerge E{p};
    pg8::gemm_phase(( __attribute__((address_space(3))) unsigned char*)lds_raw, g, S, E);
}
__device__ __forceinline__ void phase3b_fast(const Params& p, unsigned char* lds_raw, int vb, int nvb) {
    pg8::Gemm g{(const bf16_t*)(p.ws + OFF_MERGED), (const bf16_t*)(p.ws + OFF_WO), DM};
    pg8::GridOrder S; S.init(MPAD / 256, DM / 256, nvb, vb);
    pg8::EpiOut E{p};
    pg8::gemm_phase(( __attribute__((address_space(3))) unsigned char*)lds_raw, g, S, E);
}
__device__ __forceinline__ void phase5a_fast(const Params& p, unsigned char* lds_raw, int vb, int nvb) {
    pg8::Gemm g{(const bf16_t*)(p.ws + OFF_XS), (const bf16_t*)(p.ws + OFF_WGU), DM};
    pg8::MoeOrder S{nvb, vb};
    pg8::EpiMoeUp E{p};
    pg8::gemm_phase(( __attribute__((address_space(3))) unsigned char*)lds_raw, g, S, E);
}
__device__ __forceinline__ void phase5b_fast(const Params& p, unsigned char* lds_raw, int vb, int nvb) {
    pg8::Gemm g{(const bf16_t*)(p.ws + OFF_HID), (const bf16_t*)(p.ws + OFF_WD), EFF};
    pg8::MoeOrder S{nvb, vb};
    pg8::EpiMoeDown E{p};
    pg8::gemm_phase(( __attribute__((address_space(3))) unsigned char*)lds_raw, g, S, E);
}

__device__ __forceinline__ void phase4b_fast(const Params& p, float* lds, int vb, int nvb) {
    const int tid = TID(), lane = tid & 63, wave = tid >> 6;
    constexpr int NBE = NB * NEXP;
    if (vb >= NBE || nvb <= NBE) { const bool small = nvb <= NBE; transpose_moe(p, lds, small ? vb : vb - NBE, small ? nvb : nvb - NBE); if (!small) return; }
    const float* AFF = (const float*)(p.ws + OFF_AFF); int* IDX = (int*)(p.ws + OFF_IDX); int* SEL = (int*)(p.ws + OFF_SEL);
    unsigned* keys = (unsigned*)lds;
    unsigned* hist = keys + 8448;
    unsigned* sh = hist + 256;
    for (int be = vb; be < NBE; be += nvb) {
        const int b = be / NEXP, e = be % NEXP;
        __syncthreads();
        for (int i = tid; i < LTOT; i += NTHREADS) keys[i] = __float_as_uint(AFF[(size_t)be * LTOT + i]);
        if (tid == 0) { sh[0] = 0u; sh[1] = CAP; }
        __syncthreads();
        for (int pass = 0; pass < 4; ++pass) {
            const int shift = 24 - 8 * pass;
            if (tid < 256) hist[tid] = 0u;
            __syncthreads();
            const unsigned prefix = sh[0], pmask = pass == 0 ? 0u : (0xffffffffu << (shift + 8));
            for (int i = tid; i < LTOT; i += NTHREADS) { const unsigned k = keys[i]; if ((k & pmask) == prefix) atomicAdd(&hist[(k >> shift) & 255u], 1u); }
            __syncthreads();
            if (tid == 0) { unsigned rem = sh[1], d = 255u;
                for (;; --d) { const unsigned c = hist[d]; if (c >= rem || d == 0u) break; rem -= c; }
                sh[0] = prefix | (d << shift); sh[1] = rem; }
            __syncthreads();
        }
        const unsigned T = sh[0], need_eq = sh[1];
        const int t0 = tid * 17; int cnt_gt = 0, cnt_eq = 0;
        for (int i = 0; i < 17; ++i) { const int tok = t0 + i; if (tok < LTOT) { const unsigned k = keys[tok]; cnt_gt += k > T; cnt_eq += k == T; } }
        int incl = cnt_eq;
#pragma unroll
        for (int o = 1; o < 64; o <<= 1) { const int v = __shfl_up(incl, o); if (lane >= o) incl += v; }
        if (lane == 63) sh[8 + wave] = (unsigned)incl;
        __syncthreads();
        int eq_before = incl - cnt_eq; for (int w = 0; w < wave; ++w) eq_before += (int)sh[8 + w];
        __syncthreads();
        int take_eq = (int)need_eq - eq_before; take_eq = take_eq < 0 ? 0 : (take_eq > cnt_eq ? cnt_eq : take_eq);
        const int mysel = cnt_gt + take_eq;
        incl = mysel;
#pragma unroll
        for (int o = 1; o < 64; o <<= 1) { const int v = __shfl_up(incl, o); if (lane >= o) incl += v; }
        if (lane == 63) sh[8 + wave] = (unsigned)incl;
        __syncthreads();
        int slot = incl - mysel; for (int w = 0; w < wave; ++w) slot += (int)sh[8 + w];
        int eqi = eq_before;
        for (int i = 0; i < 17; ++i) { const int tok = t0 + i; if (tok < LTOT) { const unsigned k = keys[tok];
            bool take = k > T; if (k == T) { take = eqi < (int)need_eq; ++eqi; }
            if (take) { IDX[(size_t)be * CAP + slot] = tok; SEL[((size_t)b * LTOT + tok) * NEXP + e] = slot; ++slot; } else SEL[((size_t)b * LTOT + tok) * NEXP + e] = -1; } }
    }
    __syncthreads();
}
__device__ __forceinline__ void phase4c(const Params& p, int vb, int nvb) {
    const int tid = TID(), lane = tid & 63, wave = tid >> 6;
    const bf16_t* U2 = (const bf16_t*)(p.ws + OFF_UN); bf16_t* XS = (bf16_t*)(p.ws + OFF_XS); const int* IDX = (const int*)(p.ws + OFF_IDX);
    const float* AFF = (const float*)(p.ws + OFF_AFF); float* SAFF = (float*)(p.ws + OFF_SAFF);
    for (int r = vb * 8 + wave; r < NEXP * ESLOTS; r += nvb * 8) {
        const int e = r / ESLOTS, s = r % ESLOTS, b = s / CAP, c = s % CAP;
        const int tok = IDX[((size_t)b * NEXP + e) * CAP + c];
        const u32x4* src = (const u32x4*)(U2 + (size_t)pos_row(b, tok) * DM) + lane; u32x4* dst = (u32x4*)(XS + (size_t)r * DM) + lane;
        const u32x4 v0 = src[0], v1 = src[64]; dst[0] = v0; dst[64] = v1;
        if (lane == 0) SAFF[r] = AFF[((size_t)b * NEXP + e) * LTOT + tok];
    }
}

#define LAS __attribute__((address_space(3)))
#define XB_TMO      128
#define XB_XCNT(j)  (256  + 64 * (j))
#define XB_XSUB(j)  (1280 + 64 * (j))
#define XB_XGEN(j)  (2304 + 64 * (j))
#define XB_TOP      3328
#define XB_TOPGEN   3392
#define XB_SPIN_CAP (1u << 22)
__device__ __forceinline__ unsigned xb_ld(unsigned* p)              { return __hip_atomic_load(p, __ATOMIC_RELAXED, __HIP_MEMORY_SCOPE_AGENT); }
__device__ __forceinline__ unsigned xb_add(unsigned* p, unsigned v) { return __hip_atomic_fetch_add(p, v, __ATOMIC_RELAXED, __HIP_MEMORY_SCOPE_AGENT); }
__device__ __forceinline__ unsigned xb_xcc_id() { return (unsigned)__builtin_amdgcn_s_getreg((3 << 11) | 20) & 0xFu; }
#define XB_SPIN(cond, bar) do { unsigned _sp = 0; while (cond) { __builtin_amdgcn_s_sleep(1); \
    if ((++_sp & 255u) == 0u) { if (xb_ld(&(bar)[XB_TMO])) break; if (_sp > XB_SPIN_CAP) { atomicAdd(&(bar)[XB_TMO], 1u); break; } } } } while (0)
struct XcdBarrier { unsigned* bar; unsigned x; volatile LAS unsigned* st; };
__device__ __forceinline__ XcdBarrier xcd_barrier_post(unsigned* bar, volatile LAS unsigned* st) {
    XcdBarrier b; b.bar = bar; b.x = xb_xcc_id(); b.st = st;
    if (threadIdx.x == 0) (void)xb_add(&bar[XB_XCNT(b.x)], 1u);
    return b;
}
__device__ __forceinline__ void xcd_barrier_complete(unsigned* bar, unsigned x, unsigned& nloc, unsigned& nx) {
    const unsigned G = gridDim.x * gridDim.y * gridDim.z;
    unsigned sum, cnt, mine, sp = 0u;
    for (;;) {
        sum = 0u; cnt = 0u; mine = 0u;
#pragma unroll
        for (unsigned j = 0; j < 16; ++j) { const unsigned c = xb_ld(&bar[XB_XCNT(j)]); sum += c; cnt += (c > 0u) ? 1u : 0u; mine = (j == x) ? c : mine; }
        if (sum == G) break;
        __builtin_amdgcn_s_sleep(1);
        if ((++sp & 255u) == 0u) { if (xb_ld(&bar[XB_TMO])) break; if (sp > XB_SPIN_CAP) { atomicAdd(&bar[XB_TMO], 1u); break; } }
    }
    nloc = mine > 0u ? mine : 1u; nx = cnt > 0u ? cnt : 1u;
}
__device__ __forceinline__ void xcd_barrier(const XcdBarrier& b) {
    asm volatile("s_waitcnt vmcnt(0)" ::: "memory");
    __syncthreads();
    if (threadIdx.x == 0) {
        unsigned* bar = b.bar;
        __builtin_amdgcn_s_waitcnt(0);
        unsigned nloc = b.st[0], nx = b.st[1];
        if (nloc == 0u) { xcd_barrier_complete(bar, b.x, nloc, nx); b.st[0] = nloc; b.st[1] = nx; }
        const unsigned old = xb_add(&bar[XB_XSUB(b.x)], 1u);
        const unsigned gen = old / nloc;
        if (old + 1u == (gen + 1u) * nloc) {
            __builtin_amdgcn_fence(__ATOMIC_RELEASE, "agent");
            asm volatile("s_waitcnt vmcnt(0)" ::: "memory");
            const unsigned og = xb_add(&bar[XB_TOP], 1u);
            const unsigned tg = og / nx;
            if (og + 1u == (tg + 1u) * nx) xb_add(&bar[XB_TOPGEN], 1u);
            else XB_SPIN(xb_ld(&bar[XB_TOPGEN]) == tg, bar);
            __builtin_amdgcn_fence(__ATOMIC_ACQUIRE, "agent");
            xb_add(&bar[XB_XGEN(b.x)], 1u);
            asm volatile("s_waitcnt vmcnt(0)" ::: "memory");
        } else {
            XB_SPIN(xb_ld(&bar[XB_XGEN(b.x)]) == gen, bar);
            __builtin_amdgcn_fence(__ATOMIC_ACQUIRE, "agent");
            asm volatile("s_waitcnt vmcnt(0)" ::: "memory");
        }
    }
    __syncthreads();
}

constexpr int LDS_BYTES = 147456;
constexpr int LDS_BARST = LDS_BYTES - 64;
#if defined(__HIP_DEVICE_COMPILE__)
#define PHASE_PARAMS() ({ const __attribute__((address_space(4))) Params* q_ = (const __attribute__((address_space(4))) Params*)__builtin_amdgcn_kernarg_segment_ptr(); asm volatile("" : "+s"(q_)); *q_; })
#else
#define PHASE_PARAMS() (pk)
#endif
#define PHASE(call) do { const Params p = PHASE_PARAMS(); call; } while (0)
__global__ void __launch_bounds__(NTHREADS, 2) fwd_kernel(Params pk) {
    extern __shared__ __attribute__((aligned(16))) unsigned char lds_raw[];
    float* lds = (float*)lds_raw;
    cg::grid_group grid = cg::this_grid();
    const int vb = blockIdx.x, nvb = gridDim.x;
    if (threadIdx.x < 16) ((LAS unsigned*)(lds_raw + LDS_BARST))[threadIdx.x] = 0u;
    __syncthreads();
    const XcdBarrier bar = xcd_barrier_post((unsigned*)(pk.ws + OFF_CTL), (volatile LAS unsigned*)(lds_raw + LDS_BARST));
#define GRID_BAR() xcd_barrier(bar)
    PHASE(phase0(p, vb, nvb));
    PHASE(transpose_p0(p, lds, vb, nvb));
    grid.sync();
    PHASE(phase1_fast(p, lds_raw, vb, nvb));
    GRID_BAR();
    PHASE(phase2_fast(p, (char*)lds_raw, vb, nvb));
    GRID_BAR();
    PHASE(phase2b(p, vb, nvb));
    GRID_BAR();
    PHASE(phase3a_fast(p, lds_raw, vb, nvb));
    GRID_BAR();
    PHASE(phase3b_fast(p, lds_raw, vb, nvb));
    GRID_BAR();
    PHASE(phase4a(p, lds, vb, nvb));
    GRID_BAR();
    PHASE(phase4b_fast(p, lds, vb, nvb));
    GRID_BAR();
    PHASE(phase4c(p, vb, nvb));
    GRID_BAR();
    PHASE(phase5a_fast(p, lds_raw, vb, nvb));
    GRID_BAR();
    PHASE(phase5b_fast(p, lds_raw, vb, nvb));
    GRID_BAR();
    PHASE(phase6(p, vb, nvb));
}

extern "C" void kernel_launch(void* const* d_in, const int* in_sizes, int n_in, void* d_out, int out_size, void* d_ws, size_t ws_size, hipStream_t stream) {
    static int grid_blocks = 0;
    if (grid_blocks == 0) {
        if (n_in != 20 || in_sizes[0] != MREAL * DM || out_size != MREAL * DM || ws_size < 256 * MiB) {
            fprintf(stderr, "kernel_launch: unexpected shapes: n_in %d in0 %d out %d ws %zu\n", n_in, n_in > 0 ? in_sizes[0] : -1, out_size, ws_size); grid_blocks = -1; return; }
        int dev = 0, cus = 0, per_cu = 0;
        (void)hipGetDevice(&dev); (void)hipDeviceGetAttribute(&cus, hipDeviceAttributeMultiprocessorCount, dev);
        if (hipFuncSetAttribute((const void*)fwd_kernel, hipFuncAttributeMaxDynamicSharedMemorySize, LDS_BYTES) != hipSuccess) { fprintf(stderr, "kernel_launch: hipFuncSetAttribute failed\n"); grid_blocks = -1; return; }
        if (hipOccupancyMaxActiveBlocksPerMultiprocessor(&per_cu, (const void*)fwd_kernel, NTHREADS, LDS_BYTES) != hipSuccess || per_cu < 1) { fprintf(stderr, "kernel_launch: occupancy query failed (%d)\n", per_cu); grid_blocks = -1; return; }
        grid_blocks = cus * per_cu;
    }
    if (grid_blocks < 0) return;
    if (hipMemsetAsync((char*)d_ws + OFF_CTL, 0, CTL_WORDS * 4, stream) != hipSuccess) { fprintf(stderr, "kernel_launch: memset failed\n"); return; }
    Params p{};
    p.x = (const float*)d_in[0]; p.meta = (const float*)d_in[1]; p.g_mix = (const float*)d_in[2]; p.w_in = (const float*)d_in[3];
    p.lq1 = (const float*)d_in[4]; p.lk1 = (const float*)d_in[5]; p.lq2 = (const float*)d_in[6]; p.lk2 = (const float*)d_in[7];
    p.g_subln = (const float*)d_in[8]; p.g_qnorm = (const float*)d_in[9]; p.g_knorm = (const float*)d_in[10];
    p.w_ba = (const float*)d_in[11]; p.w_bb = (const float*)d_in[12]; p.w_out = (const float*)d_in[13]; p.g_ffn = (const float*)d_in[14];
    p.w_router = (const float*)d_in[15]; p.w_gate = (const float*)d_in[16]; p.w_up = (const float*)d_in[17]; p.w_down = (const float*)d_in[18]; p.g_final = (const float*)d_in[19];
    p.out = (float*)d_out; p.ws = (unsigned char*)d_ws;
    void* args[] = {&p};
    hipError_t e = hipLaunchCooperativeKernel((const void*)fwd_kernel, dim3(grid_blocks), dim3(NTHREADS), args, LDS_BYTES, stream);
    if (e != hipSuccess) fprintf(stderr, "kernel_launch: cooperative launch failed: %s (grid %d)\n", hipGetErrorString(e), grid_blocks);
}
```

```cpp
#include <hip/hip_runtime.h>
#include <hip/hip_cooperative_groups.h>
#include <cstdio>
#include <cstdint>
namespace cg = cooperative_groups;

typedef unsigned short bf16_t;
typedef float f32x4 __attribute__((ext_vector_type(4)));
typedef unsigned u32x2 __attribute__((ext_vector_type(2)));
typedef unsigned u32x4 __attribute__((ext_vector_type(4)));

constexpr int NB = 2, SEQ = 8192, DM = 1024, NMETA = 16, LTOT = SEQ + NMETA;
constexpr int MREAL = NB * SEQ;
constexpr int MROWS = MREAL + NB * NMETA;
constexpr int MPAD = 16640;
constexpr int INW = 6656;
constexpr int KEYS = 8256;
constexpr int QROWS = 8256;
constexpr int NEXP = 16, EFF = 512, CAP = 1026, ESLOTS = NB * CAP;
constexpr float EPS = 1e-6f;
constexpr float LOG2E = 1.4426950408889634f;
constexpr float CA = 0.125f * LOG2E;
constexpr float CB = 0.08838834764831845f * LOG2E;
constexpr float LAM_INIT = 0.2f;
constexpr int NTHREADS = 512;
constexpr int AOP = 2048;
__device__ const float INVF[32] = {1.000000000e+00f, 7.498942614e-01f, 5.623413324e-01f, 4.216965139e-01f, 3.162277639e-01f, 2.371373773e-01f, 1.778279394e-01f, 1.333521307e-01f,
    1.000000015e-01f, 7.498941571e-02f, 5.623413250e-02f, 4.216965288e-02f, 3.162277490e-02f, 2.371373773e-02f, 1.778279431e-02f, 1.333521493e-02f,
    9.999999776e-03f, 7.498941850e-03f, 5.623413250e-03f, 4.216964822e-03f, 3.162277630e-03f, 2.371373586e-03f, 1.778279431e-03f, 1.333521446e-03f,
    1.000000047e-03f, 7.498942432e-04f, 5.623413017e-04f, 4.216965172e-04f, 3.162277571e-04f, 2.371373703e-04f, 1.778279402e-04f, 1.333521504e-04f};

constexpr size_t MiB = 1u << 20;
constexpr size_t OFF_ROPE = 0;
constexpr size_t OFF_LAM = 64 * 1024;
constexpr size_t OFF_NRM = 64 * 1024 + 256;
constexpr int XCD_BAR_WORDS = 3456;
constexpr size_t OFF_CTL = 68 * 1024;
constexpr int CTL_WORDS = XCD_BAR_WORDS + 64;
constexpr size_t OFF_QCTR = OFF_CTL + (size_t)XCD_BAR_WORDS * 4;
constexpr size_t OFF_AFF = 128 * 1024;
constexpr size_t OFF_IDX = OFF_AFF + (size_t)NB * NEXP * LTOT * 4 + 256;
constexpr size_t OFF_SEL = OFF_IDX + (size_t)NB * NEXP * CAP * 4 + 256;
constexpr size_t OFF_SGM = OFF_SEL + (size_t)NB * LTOT * NEXP * 4 + 256;
constexpr size_t OFF_H2M = OFF_SGM + 32 * 2048 * 2;
constexpr size_t OFF_SAFF = OFF_H2M + 32 * 1024 * 4;
constexpr size_t OFF_MISC_END = OFF_SAFF + (size_t)NEXP * ESLOTS * 4;
static_assert(OFF_MISC_END <= 4 * MiB, "misc region");
constexpr size_t OFF_WIN = 4 * MiB;
constexpr size_t OFF_WAB = OFF_WIN + (size_t)INW * DM * 2;
constexpr size_t OFF_WO = OFF_WAB + (size_t)DM * 2048 * 2;
static_assert(OFF_WO + (size_t)DM * DM * 2 <= 24 * MiB, "weights region");
constexpr size_t OFF_AO = 24 * MiB;
constexpr size_t SZ_ROWS = (size_t)MPAD * DM * 2;
constexpr size_t OFF_UN = OFF_AO;
constexpr size_t OFF_HID = OFF_AO + SZ_ROWS;
static_assert((size_t)(NEXP * ESLOTS + 256) * EFF * 2 <= SZ_ROWS, "HID overlay");
constexpr size_t OFF_ATT = OFF_AO + 2 * SZ_ROWS;
constexpr size_t SZ_QH = (size_t)NB * 8 * QROWS * 128 * 2;
constexpr size_t SZ_KVB = (size_t)NB * 2 * KEYS * 128 * 2;
constexpr size_t OFF_QA = OFF_ATT, OFF_KA = OFF_QA + SZ_QH, OFF_VA = OFF_KA + SZ_QH, OFF_QB = OFF_VA + SZ_QH, OFF_KB = OFF_QB + SZ_QH, OFF_VB = OFF_KB + SZ_KVB;
constexpr size_t OFF_ATT_END = OFF_VB + SZ_KVB;
static_assert(OFF_ATT_END <= 256 * MiB, "workspace");
constexpr size_t OFF_MERGED = OFF_ATT;
constexpr size_t OFF_WGU = OFF_ATT + 33 * MiB;
constexpr size_t OFF_WD = OFF_WGU + 32 * MiB;
constexpr size_t OFF_XS = OFF_WD + 16 * MiB;
constexpr size_t OFF_YB = OFF_XS;
static_assert(SZ_ROWS <= 33 * MiB && OFF_XS + (size_t)(NEXP * ESLOTS + 256) * DM * 2 <= 256 * MiB, "overlay map");

struct Params {
    const float *x, *meta, *g_mix, *w_in, *lq1, *lk1, *lq2, *lk2, *g_subln, *g_qnorm, *g_knorm, *w_ba, *w_bb, *w_out, *g_ffn, *w_router, *w_gate, *w_up, *w_down, *g_final;
    float* out; unsigned char* ws;
};

__device__ __forceinline__ int TID() { int t = threadIdx.x; asm volatile("" : "+v"(t)); return t; }
__device__ __forceinline__ unsigned f2bf(float f) { unsigned u = __builtin_bit_cast(unsigned, f); return (u + 0x7fffu + ((u >> 16) & 1u)) >> 16; }
__device__ __forceinline__ float bf2f(unsigned h) { return __builtin_bit_cast(float, h << 16); }
__device__ __forceinline__ float wave_sum(float v) {
#pragma unroll
    for (int o = 1; o < 64; o <<= 1) v += __shfl_xor(v, o);
    return v;
}
__device__ __forceinline__ float wave_max(float v) {
#pragma unroll
    for (int o = 1; o < 64; o <<= 1) v = fmaxf(v, __shfl_xor(v, o));
    return v;
}
struct RowInfo { int b, t, meta, valid; };
__device__ __forceinline__ RowInfo row_decode(int r) {
    RowInfo ri;
    if (r < MREAL) { ri.b = r >> 13; ri.t = r & (SEQ - 1); ri.meta = 0; ri.valid = 1; }
    else if (r < MROWS) { ri.b = (r - MREAL) >> 4; ri.t = (r - MREAL) & 15; ri.meta = 1; ri.valid = 1; }
    else { ri.b = 0; ri.t = 0; ri.meta = 1; ri.valid = 0; }
    return ri;
}
__device__ __forceinline__ int row_key(const RowInfo& ri) { return ri.meta ? ri.t : 64 + ri.t; }
__device__ __forceinline__ int row_q(const RowInfo& ri) { return ri.meta ? SEQ + ri.t : ri.t; }
__device__ __forceinline__ int row_pos(const RowInfo& ri) { return ri.meta ? ri.t : NMETA + ri.t; }
__device__ __forceinline__ int pos_row(int b, int pos) { return pos < NMETA ? MREAL + b * NMETA + pos : b * SEQ + (pos - NMETA); }
__device__ __forceinline__ const float* h_row(const Params& p, int r) { RowInfo ri = row_decode(r); return ri.meta ? p.meta + (size_t)ri.t * DM : p.x + (size_t)r * DM; }

__device__ __forceinline__ void phase0(const Params& p, int vb, int nvb) {
    const int tid = TID(), lane = tid & 63, wave = tid >> 6;
    const int gt = vb * NTHREADS + tid;
    if (gt < 128 * 32) {
        const int pos = gt >> 5, j = gt & 31;
        const float ang = (float)pos * INVF[j];
        const double xd = (double)ang, kq = __builtin_rint(xd * 0.15915494309189535);
        const double rr = (xd - kq * 6.283185307179586) * 0.25, r2 = rr * rr;
        double sn = 1.0 / 1307674368000.0, cn = 1.0 / 87178291200.0;
        sn = sn * r2 * -1.0 + 1.0 / 6227020800.0; cn = cn * r2 * -1.0 + 1.0 / 479001600.0;
        sn = sn * r2 * -1.0 + 1.0 / 39916800.0;   cn = cn * r2 * -1.0 + 1.0 / 3628800.0;
        sn = sn * r2 * -1.0 + 1.0 / 362880.0;     cn = cn * r2 * -1.0 + 1.0 / 40320.0;
        sn = sn * r2 * -1.0 + 1.0 / 5040.0;       cn = cn * r2 * -1.0 + 1.0 / 720.0;
        sn = sn * r2 * -1.0 + 1.0 / 120.0;        cn = cn * r2 * -1.0 + 1.0 / 24.0;
        sn = sn * r2 * -1.0 + 1.0 / 6.0;          cn = cn * r2 * -1.0 + 0.5;
        sn = (sn * r2 * -1.0 + 1.0) * rr;         cn = cn * r2 * -1.0 + 1.0;
        double s2 = 2.0 * sn * cn, c2 = cn * cn - sn * sn;
        double s4 = 2.0 * s2 * c2, c4 = c2 * c2 - s2 * s2;
        float2 cs; cs.x = (float)c4; cs.y = (float)s4;
        ((float2*)(p.ws + OFF_ROPE))[gt] = cs;
    }
    if (vb == 0 && tid < 128) ((unsigned*)(p.ws + OFF_NRM))[tid] = 0u;
    if (vb == 0 && wave == 0) {
        float a = p.lq1[lane] * p.lk1[lane], c = p.lq2[lane] * p.lk2[lane];
        a = wave_sum(a); c = wave_sum(c);
        if (lane == 0) *(float*)(p.ws + OFF_LAM) = expf(a) - expf(c) + LAM_INIT;
    }
    bf16_t* UN = (bf16_t*)(p.ws + OFF_UN);
    for (int r = vb * 8 + wave; r < MPAD; r += nvb * 8) {
        u32x2* o = (u32x2*)(UN + (size_t)r * DM) + lane;
        if (r >= MROWS) {
#pragma unroll
            for (int j = 0; j < 4; ++j) o[64 * j] = (u32x2){0u, 0u};
            continue;
        }
        const f32x4* xr = (const f32x4*)h_row(p, r) + lane;
        f32x4 v[4]; float s = 0.f;
#pragma unroll
        for (int j = 0; j < 4; ++j) { v[j] = xr[64 * j]; s += (v[j].x * v[j].x + v[j].y * v[j].y) + (v[j].z * v[j].z + v[j].w * v[j].w); }
        const float rstd = 1.0f / sqrtf(wave_sum(s) * (1.0f / DM) + EPS);
#pragma unroll
        for (int j = 0; j < 4; ++j) {
            const f32x4 g = ((const f32x4*)p.g_mix)[lane + 64 * j];
            u32x2 w; w.x = f2bf(v[j].x * rstd * g.x) | (f2bf(v[j].y * rstd * g.y) << 16); w.y = f2bf(v[j].z * rstd * g.z) | (f2bf(v[j].w * rstd * g.w) << 16);
            o[64 * j] = w;
        }
    }
    {
        bf16_t* KA = (bf16_t*)(p.ws + OFF_KA); bf16_t* VA = (bf16_t*)(p.ws + OFF_VA); bf16_t* KB = (bf16_t*)(p.ws + OFF_KB); bf16_t* VB = (bf16_t*)(p.ws + OFF_VB);
        const int per = 48 * 128 / 8;
        for (int i = vb * NTHREADS + tid; i < (16 + 16 + 4 + 4) * per; i += nvb * NTHREADS) {
            const int bh = i / per, o = i % per; bf16_t* base;
            if (bh < 16) base = KA + (size_t)bh * KEYS * 128; else if (bh < 32) base = VA + (size_t)(bh - 16) * KEYS * 128;
            else if (bh < 36) base = KB + (size_t)(bh - 32) * KEYS * 128; else base = VB + (size_t)(bh - 36) * KEYS * 128;
            ((u32x4*)(base + 16 * 128))[o] = (u32x4){0u, 0u, 0u, 0u};
        }
    }
}

namespace fa {
using bf16x8 = __attribute__((ext_vector_type(8))) short;
using s16x4  = __attribute__((ext_vector_type(4))) short;
using f32x16 = __attribute__((ext_vector_type(16))) float;
constexpr int NT = KEYS / 64;
constexpr int SLOT = 16384;
constexpr int NSLOT = 4;
constexpr int L_V = 0, L_K = NSLOT * SLOT, L_WS = 2 * NSLOT * SLOT, L_X = 0;
constexpr int LDS_ATTN = L_WS + 8 * 64 * 4;
constexpr float THR = 8.f;
#define KSWZ(row, colB) ((row) * 256 + ((colB) ^ (((row) & 7) << 4)))
#define SBAR() __builtin_amdgcn_sched_barrier(0)
__device__ __forceinline__ int crow(int r, int hi) { return (r & 3) + 8 * (r >> 2) + 4 * hi; }
__device__ __forceinline__ unsigned cvtpk(float lo, float hi) { unsigned r; asm volatile("v_cvt_pk_bf16_f32 %0, %1, %2" : "=v"(r) : "v"(lo), "v"(hi)); return r; }
__device__ __forceinline__ void partialSM(f32x16& p0, f32x16& p1, float& m_reg, float& mn, float& alpha) {
    float pmax = p0[0];
#pragma unroll
    for (int r = 1; r < 16; ++r) pmax = fmaxf(pmax, p0[r]);
#pragma unroll
    for (int r = 0; r < 16; ++r) pmax = fmaxf(pmax, p1[r]);
    { auto rr = __builtin_amdgcn_permlane32_swap(__float_as_uint(pmax), __float_as_uint(pmax), false, false);
      pmax = fmaxf(__uint_as_float(rr[0]), __uint_as_float(rr[1])); }
    if (__builtin_expect(__all(pmax - m_reg <= THR), 1)) { mn = m_reg; alpha = 1.f; }
    else { mn = fmaxf(m_reg, pmax); alpha = __builtin_amdgcn_exp2f(m_reg - mn); m_reg = mn; }
#pragma unroll
    for (int r = 0; r < 16; ++r) { p0[r] -= mn; p1[r] -= mn; }
#pragma unroll
    for (int r = 0; r < 16; ++r) p0[r] = __builtin_amdgcn_exp2f(p0[r]);
}
__device__ __forceinline__ void finishSM(f32x16& p0, f32x16& p1, float alpha, float& l_reg, bf16x8& pa0, bf16x8& pa1, bf16x8& pa2, bf16x8& pa3) {
#pragma unroll
    for (int r = 0; r < 16; ++r) p1[r] = __builtin_amdgcn_exp2f(p1[r]);
    float ps = 0;
#pragma unroll
    for (int r = 0; r < 16; ++r) ps += p0[r];
#pragma unroll
    for (int r = 0; r < 16; ++r) ps += p1[r];
    { auto rr = __builtin_amdgcn_permlane32_swap(__float_as_uint(ps), __float_as_uint(ps), false, false);
      ps = __uint_as_float(rr[0]) + __uint_as_float(rr[1]); }
    l_reg = l_reg * alpha + ps;
#define PK4(P, BASE, OUT) do { unsigned a0 = cvtpk(P[BASE + 0], P[BASE + 1]), a1 = cvtpk(P[BASE + 2], P[BASE + 3]);   \
    unsigned b0 = cvtpk(P[BASE + 4], P[BASE + 5]), b1 = cvtpk(P[BASE + 6], P[BASE + 7]);                              \
    auto r0 = __builtin_amdgcn_permlane32_swap(a0, b0, false, false); auto r1 = __builtin_amdgcn_permlane32_swap(a1, b1, false, false); \
    u32x4 w = {r0[0], r1[0], r0[1], r1[1]}; OUT = *reinterpret_cast<bf16x8*>(&w); } while (0)
    PK4(p0, 0, pa0); PK4(p0, 8, pa1); PK4(p1, 0, pa2); PK4(p1, 8, pa3);
#undef PK4
}
template <int ND0>
__device__ __forceinline__ void qkt(f32x16& p0, f32x16& p1, const char* Ks, const bf16x8* qr, int d0b, int r32, int hi) {
    p0 = f32x16{}; p1 = f32x16{};
#pragma unroll
    for (int d0 = 0; d0 < ND0; ++d0) { const int cb = ((d0b + d0) * 16 + hi * 8) * 2;
        const bf16x8 b0 = *reinterpret_cast<const bf16x8*>(Ks + KSWZ(r32, cb));
        const bf16x8 b1 = *reinterpret_cast<const bf16x8*>(Ks + KSWZ(32 + r32, cb));
        p0 = __builtin_amdgcn_mfma_f32_32x32x16_bf16(b0, qr[d0], p0, 0, 0, 0);
        p1 = __builtin_amdgcn_mfma_f32_32x32x16_bf16(b1, qr[d0], p1, 0, 0, 0); }
}
__device__ __forceinline__ int v_st(int k, int c) { const int kk = (k & ~0xC) | ((k & 4) << 1) | ((k & 8) >> 1); return ((kk >> 3) * 4 + (c >> 5)) * 512 + ((kk & 7) * 32 + (c & 31)) * 2; }
__device__ __forceinline__ int v_rd_base(int lane) { return ((lane & 3) << 3) | (((lane >> 2) & 3) << 6) | (((lane >> 4) & 1) << 5) | (((lane >> 5) & 1) << 8); }
constexpr int v_rd_off(int d0, int ks, int half) { return d0 * 512 + ks * 4096 + half * 2048; }
template <int OFF> __device__ __forceinline__ s16x4 tr_read(int vb) {
    s16x4 r; asm volatile("ds_read_b64_tr_b16 %0, %1 offset:%2" : "=&v"(r) : "v"(vb), "i"(OFF) : "memory"); return r;
}
template <int D0> __device__ __forceinline__ void pv_one(f32x16& od, int vb, bf16x8 pa0, bf16x8 pa1, bf16x8 pa2, bf16x8 pa3) {
    const s16x4 l0 = tr_read<v_rd_off(D0, 0, 0)>(vb), h0 = tr_read<v_rd_off(D0, 0, 1)>(vb), l1 = tr_read<v_rd_off(D0, 1, 0)>(vb), h1 = tr_read<v_rd_off(D0, 1, 1)>(vb);
    const s16x4 l2 = tr_read<v_rd_off(D0, 2, 0)>(vb), h2 = tr_read<v_rd_off(D0, 2, 1)>(vb), l3 = tr_read<v_rd_off(D0, 3, 0)>(vb), h3 = tr_read<v_rd_off(D0, 3, 1)>(vb);
    asm volatile("s_waitcnt lgkmcnt(0)" ::: "memory"); SBAR();
#define PK(L, H) (bf16x8){L[0], L[1], L[2], L[3], H[0], H[1], H[2], H[3]}
    od = __builtin_amdgcn_mfma_f32_32x32x16_bf16(pa0, PK(l0, h0), od, 0, 0, 0);
    od = __builtin_amdgcn_mfma_f32_32x32x16_bf16(pa1, PK(l1, h1), od, 0, 0, 0);
    od = __builtin_amdgcn_mfma_f32_32x32x16_bf16(pa2, PK(l2, h2), od, 0, 0, 0);
    od = __builtin_amdgcn_mfma_f32_32x32x16_bf16(pa3, PK(l3, h3), od, 0, 0, 0);
#undef PK
}
__device__ __forceinline__ void pv_d0(f32x16* o, int vb, bf16x8 pa0, bf16x8 pa1, bf16x8 pa2, bf16x8 pa3) {
    pv_one<0>(o[0], vb, pa0, pa1, pa2, pa3); pv_one<1>(o[1], vb, pa0, pa1, pa2, pa3); pv_one<2>(o[2], vb, pa0, pa1, pa2, pa3); pv_one<3>(o[3], vb, pa0, pa1, pa2, pa3);
}

__device__ __forceinline__ void glds16(const void* gsrc, unsigned lds_dst) { unsigned keep;
    asm volatile("s_mov_b32 %0, m0\n\ts_mov_b32 m0, %2\n\ts_nop 0\n\tglobal_load_lds_dwordx4 %1, off\n\ts_mov_b32 m0, %0" : "=&s"(keep) : "v"(gsrc), "s"(lds_dst) : "memory"); }
#define WAIT_BAR() asm volatile("s_waitcnt vmcnt(0) lgkmcnt(0)\n\ts_barrier" ::: "memory")
#define WAIT_BAR4() asm volatile("s_waitcnt vmcnt(4) lgkmcnt(0)\n\ts_barrier" ::: "memory")
template <bool DIFF>
__device__ __forceinline__ void attn_unit(const bf16x8 (&qr)[DIFF ? 4 : 8], const bf16_t* __restrict__ Kh, const bf16_t* __restrict__ Vh, int tq, float slopeL, char* lds, int t0, int t1, bool active,
                                          f32x16 (&o)[4], float& l_reg, float& m_reg) {
    constexpr int ND0 = DIFF ? 4 : 8;
    const int tid = TID(), wid = __builtin_amdgcn_readfirstlane(tid >> 6), lane = tid & 63, r32 = lane & 31, hi = lane >> 5;
    char* V_lds = lds + L_V; char* K_lds = lds + L_K;
    float* al_l = (float*)(lds + L_WS) + wid * 64 + 32;
    const int d0b = DIFF ? (wid >> 2) * 4 : 0;
    m_reg = -1e30f; l_reg = 0.f;
#pragma unroll
    for (int d = 0; d < 4; ++d) o[d] = f32x16{};
    const char* ksrc; const char* vsrc;
    { const int row = 4 * wid + (lane >> 4), colB = ((lane & 15) * 16) ^ ((row & 7) << 4);
      ksrc = (const char*)Kh + row * 256 + colB;
      const int sub = 2 * wid + (lane >> 5), kk = (sub >> 2) * 8 + ((lane & 31) >> 2), col = (sub & 3) * 32 + (lane & 3) * 8, k = (kk & ~0xC) | ((kk & 4) << 1) | ((kk & 8) >> 1);
      vsrc = (const char*)Vh + k * 256 + col * 2; }
    const unsigned lds0 = (unsigned)(uintptr_t)lds;
    const unsigned kdst = lds0 + L_K + wid * 1024, vdst = lds0 + L_V + wid * 1024;
#define DMA_TILE(t, slot) do { const size_t to_ = (size_t)(t) * SLOT; const unsigned kd_ = (unsigned)__builtin_amdgcn_readfirstlane(kdst + (slot)), vd_ = (unsigned)__builtin_amdgcn_readfirstlane(vdst + (slot)); \
    glds16(ksrc + to_, kd_); glds16(ksrc + to_ + 8192, kd_ + 8192); glds16(vsrc + to_, vd_); glds16(vsrc + to_ + 8192, vd_ + 8192); } while (0)
    const int vb0 = (int)(uintptr_t)V_lds + v_rd_base(lane);
#define RESC(a) do { if (__any((a) < 1.f)) { if (hi == 0) al_l[r32] = (a); asm volatile("s_waitcnt lgkmcnt(0)" ::: "memory"); \
    _Pragma("unroll") for (int d = 0; d < 4; ++d) _Pragma("unroll") for (int r = 0; r < 16; ++r) o[d][r] *= al_l[crow(r, hi)]; } } while (0)
#define MASK0(P0, P1) do { _Pragma("unroll") for (int r = 8; r < 16; ++r) P0[r] = -1e30f; _Pragma("unroll") for (int r = 0; r < 16; ++r) P1[r] = -1e30f; } while (0)
#define FIXUP(P0, P1, j) do { if (DIFF) { const float base_ = (float)(tq - ((j) - 1) * 64 - 4 * hi); \
    _Pragma("unroll") for (int r = 0; r < 16; ++r) { const float d_ = base_ - (float)((r & 3) + 8 * (r >> 2)); \
        P0[r] = fmaf(-slopeL, fabsf(d_), P0[r]); P1[r] = fmaf(-slopeL, fabsf(d_ - 32.f), P1[r]); } } } while (0)
#define ROT() do { prv = cur; cur = nxt; nxt = nx2; nx2 = (nx2 == (NSLOT - 1) * SLOT) ? 0 : nx2 + SLOT; } while (0)
    f32x16 pA0, pA1, pB0, pB1; float mnA = 0.f, mnB = 0.f, alA = 1.f, alB = 1.f; bf16x8 pa0, pa1, pa2, pa3;
    int prv = 0, cur = 0, nxt = SLOT, nx2 = 2 * SLOT;
    DMA_TILE(t0, 0); DMA_TILE(t0 + 1, SLOT);
    WAIT_BAR4();
    DMA_TILE(t0 + 2, 2 * SLOT);
    if (active) { qkt<ND0>(pA0, pA1, K_lds, qr, d0b, r32, hi); if (t0 == 0) MASK0(pA0, pA1); else FIXUP(pA0, pA1, t0); partialSM(pA0, pA1, m_reg, mnA, alA); }
    WAIT_BAR4(); ROT();
    for (int j = t0 + 1; j + 1 < t1; j += 2) {
        if (j + 2 < t1) DMA_TILE(j + 2, nx2);
        if (active) { SBAR(); qkt<ND0>(pB0, pB1, K_lds + cur, qr, d0b, r32, hi); FIXUP(pB0, pB1, j);
            finishSM(pA0, pA1, alA, l_reg, pa0, pa1, pa2, pa3); SBAR();
            pv_d0(o, vb0 + prv, pa0, pa1, pa2, pa3); partialSM(pB0, pB1, m_reg, mnB, alB);
            RESC(alB); }
        if (j + 2 < t1) WAIT_BAR4(); else WAIT_BAR();
        ROT();
        if (j + 3 < t1) DMA_TILE(j + 3, nx2);
        if (active) { SBAR(); qkt<ND0>(pA0, pA1, K_lds + cur, qr, d0b, r32, hi); FIXUP(pA0, pA1, j + 1);
            finishSM(pB0, pB1, alB, l_reg, pa0, pa1, pa2, pa3); SBAR();
            pv_d0(o, vb0 + prv, pa0, pa1, pa2, pa3); partialSM(pA0, pA1, m_reg, mnA, alA);
            RESC(alA); }
        if (j + 3 < t1) WAIT_BAR4(); else WAIT_BAR();
        ROT();
    }
    if (active) {
        finishSM(pA0, pA1, alA, l_reg, pa0, pa1, pa2, pa3); SBAR();
        pv_d0(o, vb0 + prv, pa0, pa1, pa2, pa3);
    }
    WAIT_BAR();
#undef DMA_TILE
#undef RESC
#undef FIXUP
#undef MASK0
#undef ROT
}

namespace fb {
using fa::bf16x8; using fa::s16x4; using fa::f32x16; using fa::crow; using fa::cvtpk; using fa::glds16;
constexpr int SLOT = 16384, KSL = 4, VSL = 3;
constexpr int L_K = 0, L_V = KSL * SLOT, L_WS = L_V + VSL * SLOT, L_END = L_WS + 8 * 64 * 4;
constexpr float THR = 8.f;
constexpr int KPF = 2, VPF = 2;
typedef __attribute__((address_space(3))) const char* lds_cptr;
typedef short v4i16_t __attribute__((ext_vector_type(4)));
#define FB_SBAR() __builtin_amdgcn_sched_barrier(0)
#define FB_PIN(x) asm volatile("" : "+v"(x))
#define FB_MFMA(a, b, c) __builtin_amdgcn_mfma_f32_32x32x16_bf16(a, b, c, 0, 0, 0)
#define FB_WAIT_BAR(N) asm volatile("s_waitcnt vmcnt(" #N ") lgkmcnt(0)\n\ts_barrier" ::: "memory")
#define FB_MX3(a, b, c) __builtin_fmaxf(__builtin_fmaxf((a), (b)), (c))
__device__ __forceinline__ bf16x8 kfrag(lds_cptr kp, int f) { return *(const __attribute__((address_space(3))) bf16x8*)(kp + (f >> 1) * 2048 + (f & 1) * 512); }
__device__ __forceinline__ s16x4 vtr(lds_cptr p) { return __builtin_bit_cast(s16x4, __builtin_amdgcn_ds_read_tr16_b64_v4i16((__attribute__((address_space(3))) v4i16_t*)p)); }
__device__ __forceinline__ float rowmax(const f32x16& p0, const f32x16& p1) {
    float a = FB_MX3(p0[0], p0[1], p1[0]), b = FB_MX3(p0[2], p0[3], p1[1]); a = FB_MX3(a, p1[2], p1[3]);
#pragma unroll
    for (int r = 4; r < 16; r += 4) { a = FB_MX3(a, p0[r], p0[r + 1]); b = FB_MX3(b, p0[r + 2], p0[r + 3]); a = FB_MX3(a, p1[r], p1[r + 1]); b = FB_MX3(b, p1[r + 2], p1[r + 3]); }
    float m = __builtin_fmaxf(a, b); auto rr = __builtin_amdgcn_permlane32_swap(__float_as_uint(m), __float_as_uint(m), false, false);
    return __builtin_fmaxf(__uint_as_float(rr[0]), __uint_as_float(rr[1])); }
__device__ __forceinline__ void split3(float w, unsigned& h1, unsigned& h2, unsigned& h3) {
    h1 = __float_as_uint(w) & 0xffff0000u; const float r1 = w - __uint_as_float(h1);
    h2 = __float_as_uint(r1) & 0xffff0000u; const float r2 = r1 - __uint_as_float(h2);
    h3 = __float_as_uint(r2) & 0xffff0000u; }

template <bool DIFF, bool IDLE = false>
__device__ __forceinline__ void attn_unit(const bf16x8 (&qr)[DIFF ? 4 : 8], const bf16_t* __restrict__ Kh, const bf16_t* __restrict__ Vh, int tq, int wrow0, float slopeL, char* lds,
                                          int tfirst, int tbase, int n, f32x16 (&o)[4], float& l_reg, float& mhat) {
    constexpr bool active = !IDLE;
    constexpr int ND0 = DIFF ? 4 : 8, NQ = 2 * ND0;
    const int tid = TID(), lane = tid & 63, r32 = lane & 31, hi = lane >> 5; const int wid = __builtin_amdgcn_readfirstlane(tid >> 6);
    const unsigned lds0 = (unsigned)(uintptr_t)lds; float* wsf = (float*)(lds + L_WS) + wid * 64;
    const char* ksrc = (const char*)Kh + lane * 256 + wid * 16;
    const char* vsrc = (const char*)Vh + (16 * (wid & 3) + (lane >> 2)) * 256 + (wid >> 2) * 64 + (lane & 3) * 16;
    const unsigned kdst = lds0 + L_K + wid * 1024, vdst = lds0 + L_V + wid * 1024;
#define TILE_OF(i) ((i) == 0 ? tfirst : tbase + (i))
#define DMA_K(i, slot) do { const char* s_ = ksrc + (size_t)TILE_OF(i) * SLOT; const unsigned d_ = (unsigned)__builtin_amdgcn_readfirstlane(kdst + (slot)); glds16(s_, d_); glds16(s_ + 128, d_ + 8192); } while (0)
#define DMA_V(i, slot) do { const char* s_ = vsrc + (size_t)TILE_OF(i) * SLOT; const unsigned d_ = (unsigned)__builtin_amdgcn_readfirstlane(vdst + (slot)); glds16(s_, d_); glds16(s_ + 128, d_ + 8192); } while (0)
    const lds_cptr vp0 = (lds_cptr)lds + L_V + ((lane >> 4) & 1) * 32 + (lane & 3) * 8 + (4 * hi + ((lane & 15) >> 2)) * 64;
    const lds_cptr kp0 = (lds_cptr)lds + L_K + hi * 1024 + r32 * 16 + (DIFF ? (wid >> 2) * 8192 : 0);
    mhat = 0.f; l_reg = 0.f;
#pragma unroll
    for (int d = 0; d < 4; ++d) o[d] = f32x16{};
    const f32x16 zero16 = f32x16{};
    bool resc = false;
    f32x16 pA0, pA1, pB0, pB1; bf16x8 kf[KPF]; s16x4 vlo[VPF], vhi[VPF]; u32x4 pw0, pw1, pw2, pw3;
    bf16x8 kx0 = bf16x8{}, kx1 = bf16x8{}, qx = bf16x8{}; unsigned sl1 = 0, sl2 = 0, sl3 = 0;
    if (DIFF) { if (hi == 0) { const unsigned c0 = __float_as_uint((float)r32) >> 16, c1 = __float_as_uint((float)(32 + r32)) >> 16;
            u32x4 a = {0x3F803F80u, 0x3F80u | (c0 << 16), c0 | (c0 << 16), 0u}, b = {0x3F803F80u, 0x3F80u | (c1 << 16), c1 | (c1 << 16), 0u};
            kx0 = __builtin_bit_cast(bf16x8, a); kx1 = __builtin_bit_cast(bf16x8, b); }
        split3(slopeL, sl1, sl2, sl3); }
#define SIDE_OF(j) ((j) == 0 ? 0 : (64 * ((j) - 1) + 63 <= wrow0) ? 1 : (64 * ((j) - 1) >= wrow0 + 31) ? -1 : 0)
#define BUILD_QX(j) do { if (DIFF) { const int sd_ = SIDE_OF(j); float w_ = -mhat; unsigned sg_ = 0u, keep_ = 0u; \
        if (sd_ != 0) { const float lin_ = slopeL * (float)(tq - 64 * ((j) - 1)); w_ += sd_ > 0 ? -lin_ : lin_; sg_ = sd_ > 0 ? 0u : 0x80000000u; keep_ = 0xffffffffu; } \
        unsigned h1_, h2_, h3_; split3(w_, h1_, h2_, h3_); const unsigned a1_ = (sl1 ^ sg_) & keep_, a2_ = (sl2 ^ sg_) & keep_, a3_ = (sl3 ^ sg_) & keep_; \
        u32x4 q_ = {(h1_ >> 16) | h2_, (h3_ >> 16) | a1_, (a2_ >> 16) | a3_, 0u}; if (hi != 0) q_ = (u32x4){0u, 0u, 0u, 0u}; qx = __builtin_bit_cast(bf16x8, q_); } } while (0)
#define FIXUP(C0, C1, j) do { if ((j) == 0) { _Pragma("unroll") for (int r = 8; r < 16; ++r) C0[r] = -1e30f; _Pragma("unroll") for (int r = 0; r < 16; ++r) C1[r] = -1e30f; } \
        else if (DIFF && SIDE_OF(j) == 0) { const float base_ = (float)(tq - ((j) - 1) * 64 - 4 * hi); \
            _Pragma("unroll") for (int r = 0; r < 16; ++r) { const float d_ = base_ - (float)((r & 3) + 8 * (r >> 2)); \
                C0[r] = fmaf(-slopeL, fabsf(d_), C0[r]); C1[r] = fmaf(-slopeL, fabsf(d_ - 32.f), C1[r]); } } } while (0)
#define PFLAT(P0, P1, e) ((e) < 16 ? P0[(e) & 15] : P1[(e) & 15])
#define PWSET(u, v) do { if ((u) < 4) pw0[(u) & 3] = (v); else if ((u) < 8) pw1[(u) & 3] = (v); else if ((u) < 12) pw2[(u) & 3] = (v); else pw3[(u) & 3] = (v); } while (0)
#define PAF(k) __builtin_bit_cast(bf16x8, (k) == 0 ? pw0 : (k) == 1 ? pw1 : (k) == 2 ? pw2 : pw3)
#define VFR(i) (bf16x8){vlo[i][0], vlo[i][1], vlo[i][2], vlo[i][3], vhi[i][0], vhi[i][1], vhi[i][2], vhi[i][3]}
#define VRD(slotv, f, dst) do { const lds_cptr a_ = vp0 + (slotv) + ((f) >> 2) * 4096 + ((f) & 3) * 1024; vlo[dst] = vtr(a_); vhi[dst] = vtr(a_ + 512); } while (0)
#define AUNIT(P0, P1, u) do { sacc += PFLAT(P0, P1, 2 * (u)); sacc += PFLAT(P0, P1, 2 * (u) + 1); PWSET(u, cvtpk(PFLAT(P0, P1, 2 * (u)), PFLAT(P0, P1, 2 * (u) + 1))); } while (0)
#define EXPU(C0, C1, u) do { if ((u) < 8) { C0[2 * ((u) & 7)] = __builtin_amdgcn_exp2f(C0[2 * ((u) & 7)] - sub_); C0[2 * ((u) & 7) + 1] = __builtin_amdgcn_exp2f(C0[2 * ((u) & 7) + 1] - sub_); } \
        else { C1[2 * ((u) & 7)] = __builtin_amdgcn_exp2f(C1[2 * ((u) & 7)] - sub_); C1[2 * ((u) & 7) + 1] = __builtin_amdgcn_exp2f(C1[2 * ((u) & 7) + 1] - sub_); } } while (0)
#define STEP(C0, C1, P0, P1, i, GK, GV, GL) do { \
    const int j_ = TILE_OF(i); const lds_cptr kp_ = kp0 + kcur; const lds_cptr kn_ = kp0 + knxt; \
    if (active) { BUILD_QX(j_); FB_SBAR(); float sacc = 0.f; \
        if (DIFF) { C0 = FB_MFMA(kx0, qx, zero16); AUNIT(P0, P1, 0); FB_PIN(sacc); FB_PIN(pw0); FB_SBAR(); \
                    C1 = FB_MFMA(kx1, qx, zero16); AUNIT(P0, P1, 1); AUNIT(P0, P1, 2); FB_PIN(sacc); FB_PIN(pw0); FB_SBAR(); } \
        _Pragma("unroll") for (int g = 0; g < NQ; ++g) { \
            if (g & 1) C1 = FB_MFMA(kf[g % KPF], qr[g >> 1], (!DIFF && g < 2) ? zero16 : C1); else C0 = FB_MFMA(kf[g % KPF], qr[g >> 1], (!DIFF && g < 2) ? zero16 : C0); \
            if (g + KPF < NQ) kf[g % KPF] = kfrag(kp_, g + KPF); \
            if (DIFF) { if (g < 5) { AUNIT(P0, P1, 3 + 2 * g); AUNIT(P0, P1, 4 + 2 * g); } else AUNIT(P0, P1, 8 + g); } else AUNIT(P0, P1, g); \
            if (g >= NQ - VPF) VRD(vprv, g - (NQ - VPF), g - (NQ - VPF)); \
            FB_PIN(sacc); FB_PIN(pw0); FB_PIN(pw1); FB_PIN(pw2); FB_PIN(pw3); FB_SBAR(); } \
        l_reg += sacc; } \
    if (GK) DMA_K((i) + 3, kfree); if (GV) DMA_V((i) + 1, vnxt); \
    float sub_ = 0.f; \
    if (active) { FIXUP(C0, C1, j_); \
        { const float rm = rowmax(C0, C1) - (DIFF ? 0.f : mhat); resc = false; \
          if (__builtin_expect(__any(rm > THR), 0)) { const float dl = __builtin_fmaxf(rm, 0.f); mhat += dl; \
              if (DIFF) { _Pragma("unroll") for (int r = 0; r < 16; ++r) { C0[r] -= dl; C1[r] -= dl; } } \
              const float f = __builtin_amdgcn_exp2f(-dl); l_reg *= f; if (hi == 0) wsf[r32] = f; resc = true; } } \
        sub_ = DIFF ? 0.f : mhat; FB_SBAR(); \
        _Pragma("unroll") for (int g = 0; g < 16; ++g) { \
            o[g >> 2] = FB_MFMA(PAF(g & 3), VFR(g % VPF), o[g >> 2]); \
            if (g + VPF < 16) VRD(vprv, g + VPF, g % VPF); \
            EXPU(C0, C1, g); \
            if ((GL) && g >= 4 && g < 4 + KPF) kf[g - 4] = kfrag(kn_, g - 4); \
            FB_PIN(C0); FB_PIN(C1); FB_SBAR(); } } \
    } while (0)
#define RESC() do { if (active && resc) { _Pragma("unroll") for (int d_ = 0; d_ < 4; ++d_) _Pragma("unroll") for (int r = 0; r < 16; ++r) o[d_][r] *= wsf[crow(r, hi)]; } } while (0)
    int kcur = 0, knxt = SLOT, kfree = 3 * SLOT, vprv = 0, vnxt = SLOT;
#define ROT() do { kfree = kcur; kcur = knxt; knxt = (knxt == (KSL - 1) * SLOT) ? 0 : knxt + SLOT; vprv = (vnxt == 0) ? (VSL - 1) * SLOT : vnxt - SLOT; vnxt = (vnxt == (VSL - 1) * SLOT) ? 0 : vnxt + SLOT; } while (0)
    DMA_K(0, 0); DMA_V(0, 0); DMA_K(1, SLOT); DMA_K(2, 2 * SLOT);
    FB_WAIT_BAR(6);
    if (n > 3) DMA_K(3, 3 * SLOT);
    DMA_V(1, SLOT);
    if (active) { const int j0 = tfirst; BUILD_QX(j0);
        if (DIFF) { pA0 = FB_MFMA(kx0, qx, zero16); pA1 = FB_MFMA(kx1, qx, zero16); }
#pragma unroll
        for (int g = 0; g < NQ; ++g) { const bf16x8 kk = kfrag(kp0, g);
            if (g & 1) pA1 = FB_MFMA(kk, qr[g >> 1], (!DIFF && g < 2) ? zero16 : pA1); else pA0 = FB_MFMA(kk, qr[g >> 1], (!DIFF && g < 2) ? zero16 : pA0); }
        FIXUP(pA0, pA1, j0);
        const float rm = rowmax(pA0, pA1); mhat = rm;
#pragma unroll
        for (int r = 0; r < 16; ++r) { pA0[r] = __builtin_amdgcn_exp2f(pA0[r] - rm); pA1[r] = __builtin_amdgcn_exp2f(pA1[r] - rm); } }
    if (n > 3) FB_WAIT_BAR(4); else FB_WAIT_BAR(2);
    kcur = SLOT; knxt = 2 * SLOT; kfree = 0; vprv = 0; vnxt = 2 * SLOT;
    if (active) {
#pragma unroll
        for (int g = 0; g < KPF; ++g) kf[g] = kfrag(kp0 + kcur, g); }
    int i = 1;
    for (; i + 5 < n; i += 2) {
        STEP(pB0, pB1, pA0, pA1, i, true, true, true);
        FB_WAIT_BAR(4); RESC(); ROT();
        STEP(pA0, pA1, pB0, pB1, i + 1, true, true, true);
        FB_WAIT_BAR(4); RESC(); ROT();
    }
    for (; i + 1 < n; i += 2) {
        STEP(pB0, pB1, pA0, pA1, i, (i + 3 < n), (i + 1 < n), (i + 1 < n));
        if (i + 3 < n) FB_WAIT_BAR(4); else FB_WAIT_BAR(0);
        RESC(); ROT();
        STEP(pA0, pA1, pB0, pB1, i + 1, (i + 4 < n), (i + 2 < n), (i + 2 < n));
        if (i + 4 < n) FB_WAIT_BAR(4); else FB_WAIT_BAR(0);
        RESC(); ROT();
    }
    if (active) { float sacc = 0.f;
#pragma unroll
        for (int u = 0; u < 16; ++u) AUNIT(pA0, pA1, u);
        l_reg += sacc;
#pragma unroll
        for (int g = 0; g < 16; ++g) { VRD(vprv, g, 0); o[g >> 2] = FB_MFMA(PAF(g & 3), VFR(0), o[g >> 2]); } }
    FB_WAIT_BAR(0);
#undef TILE_OF
#undef DMA_K
#undef DMA_V
#undef SIDE_OF
#undef BUILD_QX
#undef FIXUP
#undef PFLAT
#undef PWSET
#undef PAF
#undef VFR
#undef VRD
#undef AUNIT
#undef EXPU
#undef STEP
#undef RESC
#undef ROT
}
}

template <class RowPtr>
__device__ __forceinline__ void store_tile(const f32x16 (&y)[4], char* stage, int lane, RowPtr rowptr) {
    const int r32 = lane & 31, hi = lane >> 5;
    bf16_t* stg = (bf16_t*)stage;
#pragma unroll
    for (int r = 0; r < 16; ++r) { const int orow = crow(r, hi);
#pragma unroll
        for (int d0 = 0; d0 < 4; ++d0) stg[orow * 136 + d0 * 32 + r32] = (bf16_t)f2bf(y[d0][r]); }
    asm volatile("s_waitcnt lgkmcnt(0)" ::: "memory");
#pragma unroll
    for (int i = 0; i < 8; ++i) { const int row = i * 4 + (lane >> 4), ch = lane & 15;
        const u32x4 v = *(const u32x4*)(stg + row * 136 + ch * 8);
        bf16_t* gp = rowptr(row); if (gp) *(u32x4*)(gp + ch * 8) = v; }
    asm volatile("s_waitcnt lgkmcnt(0)" ::: "memory");
}
}

constexpr int NPRB = 4 * 9 * 2 + 16 * 9;
constexpr size_t OFF_PART = (OFF_ATT_END + 255) / 256 * 256;
constexpr size_t OFF_PML = OFF_PART + (size_t)NPRB * 32 * 128 * 4;
static_assert(OFF_PML + NPRB * 32 * 2 * 4 <= 256 * MiB, "meta partials");
constexpr int NRANGE = 9;
__device__ __forceinline__ void meta_range(int r, int& t0, int& t1) { t0 = 15 * r; t1 = r == NRANGE - 1 ? fa::NT : 15 * (r + 1); }

__device__ __forceinline__ void phase2_fast(const Params& p, char* lds, int vb, int nvb) {
    using namespace fa;
    const int tid = TID(), wid = __builtin_amdgcn_readfirstlane(tid >> 6), lane0 = tid & 63;
#define WS_() ({ unsigned char* w_ = p.ws; asm volatile("" : "+s"(w_)); w_; })
#define LSUM2(l) do { auto rr_ = __builtin_amdgcn_permlane32_swap(__float_as_uint(l), __float_as_uint(l), false, false); l = __uint_as_float(rr_[0]) + __uint_as_float(rr_[1]); } while (0)
    for (int v = vb; v < 256; v += nvb) {
        const int xcd = v & 7, slot = v >> 3;
        if (v < 36 + 144) {
            f32x16 o[4]; float l_reg, m_reg; bf16x8 qr[8]; int t0, t1, rb; bool active;
            const int r32q = lane0 & 31, hiq = lane0 >> 5;
            if (v < 36) { const int g = v / NRANGE, rg = v % NRANGE, b = g >> 1, kvh = g & 1; meta_range(rg, t0, t1);
                active = wid < 2; const int h = kvh * 4 + (wid & 1) * 2 + (r32q >> 4);
                unsigned char* ws = WS_(); const bf16_t *QB = (const bf16_t*)(ws + OFF_QB), *KB = (const bf16_t*)(ws + OFF_KB), *VB = (const bf16_t*)(ws + OFF_VB);
                const bf16_t* q = QB + ((size_t)(b * 8 + h) * QROWS + SEQ + (r32q & 15)) * 128 + hiq * 8;
#pragma unroll
                for (int d0 = 0; d0 < 8; ++d0) qr[d0] = *reinterpret_cast<const bf16x8*>(q + d0 * 16);
                const size_t kvo = (size_t)(b * 2 + kvh) * KEYS * 128; rb = (g * NRANGE + rg) * 2 + (wid & 1);
                if (active) fb::attn_unit<false, false>(qr, KB + kvo, VB + kvo, 0, 0, 0.f, lds, t0, t0, t1 - t0, o, l_reg, m_reg); else fb::attn_unit<false, true>(qr, KB + kvo, VB + kvo, 0, 0, 0.f, lds, t0, t0, t1 - t0, o, l_reg, m_reg);
            } else { const int bh = (v - 36) / NRANGE, rg = (v - 36) % NRANGE; meta_range(rg, t0, t1);
                active = wid == 0; const int mp = r32q >> 4;
                unsigned char* ws = WS_(); const bf16_t *QA = (const bf16_t*)(ws + OFF_QA), *KA = (const bf16_t*)(ws + OFF_KA), *VA = (const bf16_t*)(ws + OFF_VA);
                const bf16_t* q = QA + ((size_t)bh * QROWS + SEQ + (r32q & 15)) * 128 + mp * 64 + hiq * 8;
#pragma unroll
                for (int d0 = 0; d0 < 8; ++d0) { const bf16x8 x = *reinterpret_cast<const bf16x8*>(q + (d0 & 3) * 16); qr[d0] = ((d0 >> 2) == mp) ? x : bf16x8{}; }
                const size_t kvo = (size_t)bh * KEYS * 128; rb = 72 + bh * NRANGE + rg;
                if (active) fb::attn_unit<false, false>(qr, KA + kvo, VA + kvo, 0, 0, 0.f, lds, t0, t0, t1 - t0, o, l_reg, m_reg); else fb::attn_unit<false, true>(qr, KA + kvo, VA + kvo, 0, 0, 0.f, lds, t0, t0, t1 - t0, o, l_reg, m_reg);
            }
            if (active) {
                int lane = lane0; asm volatile("" : "+v"(lane));
                const int r32 = lane & 31, hi = lane >> 5;
                LSUM2(l_reg);
                unsigned char* ws = WS_(); float* PART = (float*)(ws + OFF_PART); float* PML = (float*)(ws + OFF_PML);
                float* po = PART + (size_t)rb * 32 * 128;
#pragma unroll
                for (int r = 0; r < 16; ++r)
#pragma unroll
                    for (int d = 0; d < 4; ++d) po[crow(r, hi) * 128 + d * 32 + r32] = o[d][r];
                if (hi == 0) { PML[(rb * 32 + r32) * 2] = m_reg; PML[(rb * 32 + r32) * 2 + 1] = l_reg; }
            }
            __syncthreads();
        }
    }
    for (int v = vb; v < 256; v += nvb) {
        const int xcd = v & 7, slot = v >> 3;
        for (int k = 0; k < 2; ++k) {
            f32x16 o[4]; float l_reg, m_reg;
            {
                const int b = xcd >> 2, kvh = (xcd >> 1) & 1, h = kvh * 4 + (xcd & 1) * 2 + k, bh = b * 8 + h, qb = slot;
                { bf16x8 qr[8]; const int r32q = lane0 & 31, hiq = lane0 >> 5;
                  unsigned char* ws = WS_(); const bf16_t *QB = (const bf16_t*)(ws + OFF_QB), *KB = (const bf16_t*)(ws + OFF_KB), *VB = (const bf16_t*)(ws + OFF_VB);
                  const bf16_t* q = QB + ((size_t)bh * QROWS + qb * 256 + wid * 32 + r32q) * 128 + hiq * 8;
#pragma unroll
                  for (int d0 = 0; d0 < 8; ++d0) qr[d0] = *reinterpret_cast<const bf16x8*>(q + d0 * 16);
                  const size_t kvo = (size_t)(b * 2 + kvh) * KEYS * 128;
                  fb::attn_unit<false>(qr, KB + kvo, VB + kvo, 0, 0, 0.f, lds, 0, 0, NT, o, l_reg, m_reg); }
                int lane = lane0; asm volatile("" : "+v"(lane));
                const int r32 = lane & 31, hi = lane >> 5;
                LSUM2(l_reg);
                float* li_l = (float*)(lds + fb::L_WS) + wid * 64;
                if (hi == 0) li_l[r32] = l_reg;
                asm volatile("s_waitcnt lgkmcnt(0)" ::: "memory");
#pragma unroll
                for (int r = 0; r < 16; ++r) { const float rl = __builtin_amdgcn_rcpf(li_l[crow(r, hi)]);
#pragma unroll
                    for (int d = 0; d < 4; ++d) o[d][r] *= rl; }
                const int wave_row0 = qb * 256 + wid * 32;
                bf16_t* OB = (bf16_t*)(WS_() + OFF_AO) + 1024;
                store_tile(o, lds + wid * 8704, lane, [&](int row) -> bf16_t* { return OB + (size_t)(b * SEQ + wave_row0 + row) * AOP + h * 128; });
                __syncthreads();
            }
        }
    }
    for (;;) {
                f32x16 o[4]; float l_reg, m_reg;
                const int tid = TID(), lane0 = tid & 63;
                __syncthreads();
                if (tid == 0) ((volatile int*)(lds + fb::L_WS + 2048))[0] = (int)atomicAdd((unsigned*)(WS_() + OFF_QCTR), 1u);
                __syncthreads();
                const int uq = __builtin_amdgcn_readfirstlane(((volatile int*)(lds + fb::L_WS + 2048))[0]);
                if (uq >= 1024) break;
                const int h = 7 - (uq >> 7), b = (uq >> 6) & 1, qb = uq & 63, bh = b * 8 + h, mp = wid >> 2, wq = wid & 3;
                int jlo, nvis;
                { const float* nq = (const float*)(WS_() + OFF_NRM) + (b * 8 + h) * 4; const float* nk = nq + 64;
                  const float B0 = sqrtf(nq[0] * nk[0]) + sqrtf(nq[1] * nk[1]), B1 = sqrtf(nq[2] * nk[2]) + sqrtf(nq[3] * nk[3]);
                  const float Bm = 1.02f * fmaxf(B0, B1), slopeC = exp2f(-(float)(h + 1)) * LOG2E;
                  const float dc = fminf((2.f * Bm + 160.f) / slopeC, 16384.f); const int dcut = (int)dc;
                  int lo = qb * 128 - dcut; lo = lo < 0 ? 0 : lo; int hi_ = qb * 128 + 127 + dcut; hi_ = hi_ > SEQ - 1 ? SEQ - 1 : hi_;
                  jlo = 1 + (lo >> 6); int jhi = 1 + (hi_ >> 6); nvis = jhi - jlo + 2;
                  if ((nvis & 1) == 0) { if (jhi < NT - 1) ++jhi; else --jlo; ++nvis; }
                  if (nvis < 3) { jlo = jlo > 1 ? jlo - 1 : jlo; nvis = 3; } }
                { bf16x8 qr[4]; const int r32q = lane0 & 31, hiq = lane0 >> 5; const int qrow = qb * 128 + wq * 32 + r32q;
                  unsigned char* ws = WS_(); const bf16_t *QA = (const bf16_t*)(ws + OFF_QA), *KA = (const bf16_t*)(ws + OFF_KA), *VA = (const bf16_t*)(ws + OFF_VA);
                  const bf16_t* q = QA + ((size_t)bh * QROWS + qrow) * 128 + mp * 64 + hiq * 8;
#pragma unroll
                  for (int d0 = 0; d0 < 4; ++d0) qr[d0] = *reinterpret_cast<const bf16x8*>(q + d0 * 16);
                  const float slopeL = exp2f(-(float)(h + 1)) * LOG2E;
                  const size_t kvo = (size_t)bh * KEYS * 128;
                  fb::attn_unit<true>(qr, KA + kvo, VA + kvo, qrow, qb * 128 + wq * 32, slopeL, lds, 0, jlo - 1, nvis, o, l_reg, m_reg); }
                int lane = lane0; asm volatile("" : "+v"(lane));
                const int r32 = lane & 31, hi = lane >> 5;
                LSUM2(l_reg);
                float* li_l = (float*)(lds + fb::L_WS) + wid * 64;
                if (hi == 0) li_l[r32] = l_reg;
                asm volatile("s_waitcnt lgkmcnt(0)" ::: "memory");
#pragma unroll
                for (int r = 0; r < 16; ++r) { const float rl = __builtin_amdgcn_rcpf(li_l[crow(r, hi)]);
#pragma unroll
                    for (int d = 0; d < 4; ++d) o[d][r] *= rl; }
                float* X = (float*)lds + wq * 4096;
                if (mp == 1) {
#pragma unroll
                    for (int r = 0; r < 16; ++r)
#pragma unroll
                        for (int d = 0; d < 4; ++d) X[(r * 4 + d) * 64 + lane] = o[d][r];
                }
                __syncthreads();
                if (mp == 0) {
                    const float lam = *(const float*)(WS_() + OFF_LAM);
                    float ss[16];
#pragma unroll
                    for (int r = 0; r < 16; ++r) { float a = 0.f;
#pragma unroll
                        for (int d = 0; d < 4; ++d) { const float y = o[d][r] - lam * X[(r * 4 + d) * 64 + lane]; o[d][r] = y; a += y * y; }
                        ss[r] = a; }
#pragma unroll
                    for (int r = 0; r < 16; ++r) {
                        float a = ss[r];
                        a += __shfl_xor(a, 1); a += __shfl_xor(a, 2); a += __shfl_xor(a, 4); a += __shfl_xor(a, 8); a += __shfl_xor(a, 16);
                        ss[r] = 1.0f / sqrtf(a * (1.0f / 128.f) + EPS) * (1.0f - LAM_INIT);
                    }
                    float g[4];
#pragma unroll
                    for (int d = 0; d < 4; ++d) g[d] = p.g_subln[d * 32 + r32];
#pragma unroll
                    for (int r = 0; r < 16; ++r)
#pragma unroll
                        for (int d = 0; d < 4; ++d) o[d][r] *= ss[r] * g[d];
                }
                __syncthreads();
                if (mp == 0) {
                    const int wave_row0 = qb * 128 + wq * 32;
                    bf16_t* OA = (bf16_t*)(WS_() + OFF_AO);
                    store_tile(o, lds + wid * 8704, lane, [&](int row) -> bf16_t* { return OA + (size_t)(b * SEQ + wave_row0 + row) * AOP + h * 128; });
                }
                __syncthreads();
    }
#undef LSUM2
#undef WS_
}
__device__ __forceinline__ void phase2b(const Params& p, int vb, int nvb) {
    const int tid = TID(), lane = tid & 63, wave = tid >> 6;
    const float* PART = (const float*)(p.ws + OFF_PART); const float* PML = (const float*)(p.ws + OFF_PML);
    bf16_t* OA = (bf16_t*)(p.ws + OFF_AO); bf16_t* OB = OA + 1024;
    const float lam = *(const float*)(p.ws + OFF_LAM);
    for (int t = vb * 8 + wave; t < 512; t += nvb * 8) {
        const int type = t >> 8, b = (t >> 7) & 1, h = (t >> 4) & 7, i = t & 15;
        float y0 = 0.f, y1 = 0.f;
        for (int mp = 0; mp < (type == 0 ? 1 : 2); ++mp) {
            int rb0, row;
            if (type == 0) { const int kvh = h >> 2, w = (h & 3) >> 1; rb0 = ((b * 2 + kvh) * NRANGE) * 2 + w; row = (h & 1) * 16 + i; }
            else { rb0 = 72 + (b * 8 + h) * NRANGE; row = mp * 16 + i; }
            const int rbs = type == 0 ? 2 : 1;
            float M = -1e30f;
            for (int r = 0; r < NRANGE; ++r) M = fmaxf(M, PML[((rb0 + r * rbs) * 32 + row) * 2]);
            float L = 0.f, a0 = 0.f, a1 = 0.f;
            for (int r = 0; r < NRANGE; ++r) { const int rb = rb0 + r * rbs; const float w = exp2f(PML[(rb * 32 + row) * 2] - M);
                L += PML[(rb * 32 + row) * 2 + 1] * w; const float2 ov = *(const float2*)(PART + ((size_t)rb * 32 + row) * 128 + 2 * lane); a0 += ov.x * w; a1 += ov.y * w; }
            const float sgn = mp == 0 ? 1.f : -lam;
            y0 += sgn * a0 / L; y1 += sgn * a1 / L;
        }
        const size_t grow = (size_t)(MREAL + b * NMETA + i);
        if (type == 0) ((unsigned*)(OB + grow * AOP + h * 128))[lane] = f2bf(y0) | (f2bf(y1) << 16);
        else { const float ss = wave_sum(y0 * y0 + y1 * y1); const float rstd = 1.0f / sqrtf(ss * (1.0f / 128.f) + EPS) * (1.0f - LAM_INIT);
            ((unsigned*)(OA + grow * AOP + h * 128))[lane] = f2bf(y0 * rstd * p.g_subln[2 * lane]) | (f2bf(y1 * rstd * p.g_subln[2 * lane + 1]) << 16); }
    }
}

__device__ __forceinline__ float* h2_row(const Params& p, int grow) { return grow < MREAL ? p.out + (size_t)grow * DM : (float*)(p.ws + OFF_H2M) + (size_t)(grow - MREAL) * DM; }
__device__ __forceinline__ void phase4a(const Params& p, float* lds, int vb, int nvb) {
    const int tid = TID(), lane = tid & 63, wave = tid >> 6;
    for (int i = tid; i < DM * NEXP; i += NTHREADS) { const int k = i >> 4, e = i & 15; lds[e * DM + k] = p.w_router[i]; }
    __syncthreads();
    bf16_t* U2 = (bf16_t*)(p.ws + OFF_UN); float* AFF = (float*)(p.ws + OFF_AFF);
    for (int r = vb * 8 + wave; r < MROWS; r += nvb * 8) {
        const RowInfo ri = row_decode(r);
        const f32x4* xr = (const f32x4*)h2_row(p, r) + lane;
        f32x4 v[4]; float s = 0.f;
#pragma unroll
        for (int j = 0; j < 4; ++j) { v[j] = xr[64 * j]; s += (v[j].x * v[j].x + v[j].y * v[j].y) + (v[j].z * v[j].z + v[j].w * v[j].w); }
        const float rstd = 1.0f / sqrtf(wave_sum(s) * (1.0f / DM) + EPS);
        u32x2* o = (u32x2*)(U2 + (size_t)r * DM) + lane;
#pragma unroll
        for (int j = 0; j < 4; ++j) {
            const f32x4 g = ((const f32x4*)p.g_ffn)[lane + 64 * j];
            v[j].x *= rstd * g.x; v[j].y *= rstd * g.y; v[j].z *= rstd * g.z; v[j].w *= rstd * g.w;
            u32x2 w; w.x = f2bf(v[j].x) | (f2bf(v[j].y) << 16); w.y = f2bf(v[j].z) | (f2bf(v[j].w) << 16);
            o[64 * j] = w;
        }
        float mylg = -1e30f;
#pragma unroll 1
        for (int e = 0; e < NEXP; ++e) {
            float a = 0.f;
#pragma unroll
            for (int j = 0; j < 4; ++j) { const f32x4 w = *(const f32x4*)(lds + e * DM + 4 * (lane + 64 * j)); a += v[j].x * w.x + v[j].y * w.y + v[j].z * w.z + v[j].w * w.w; }
            a = wave_sum(a);
            if (lane == e) mylg = a;
        }
        const float mx = wave_max(mylg);
        const float ex = lane < NEXP ? expf(mylg - mx) : 0.f;
        const float mine = ex / wave_sum(ex);
        if (lane < NEXP) AFF[((size_t)ri.b * NEXP + lane) * LTOT + row_pos(ri)] = mine;
    }
    __syncthreads();
}

__device__ __forceinline__ void phase6(const Params& p, int vb, int nvb) {
    const int tid = TID(), lane = tid & 63, wave = tid >> 6;
    const int* SEL = (const int*)(p.ws + OFF_SEL); const bf16_t* YB = (const bf16_t*)(p.ws + OFF_YB);
    for (int r = vb * 8 + wave; r < MREAL; r += nvb * 8) {
        const int b = r >> 13, tok = NMETA + (r & (SEQ - 1));
        f32x4* xr = (f32x4*)(p.out + (size_t)r * DM) + lane;
        f32x4 v[4];
#pragma unroll
        for (int j = 0; j < 4; ++j) v[j] = xr[64 * j];
        const int sel = lane < NEXP ? SEL[((size_t)b * LTOT + tok) * NEXP + lane] : -1;
        for (int e = 0; e < NEXP; ++e) {
            const int c = __shfl(sel, e);
            if (c >= 0) {
                const u32x2* y = (const u32x2*)(YB + ((size_t)e * ESLOTS + b * CAP + c) * DM) + lane;
#pragma unroll
                for (int j = 0; j < 4; ++j) { const u32x2 w = y[64 * j]; v[j].x += bf2f(w.x & 0xffffu); v[j].y += bf2f(w.x >> 16); v[j].z += bf2f(w.y & 0xffffu); v[j].w += bf2f(w.y >> 16); }
            }
        }
        float s = 0.f;
#pragma unroll
        for (int j = 0; j < 4; ++j) s += (v[j].x * v[j].x + v[j].y * v[j].y) + (v[j].z * v[j].z + v[j].w * v[j].w);
        const float rstd = 1.0f / sqrtf(wave_sum(s) * (1.0f / DM) + EPS);
#pragma unroll
        for (int j = 0; j < 4; ++j) { const f32x4 g = ((const f32x4*)p.g_final)[lane + 64 * j]; xr[64 * j] = (f32x4){v[j].x * rstd * g.x, v[j].y * rstd * g.y, v[j].z * rstd * g.z, v[j].w * rstd * g.w}; }
    }
}

template <class DstRow>
__device__ __forceinline__ void transpose_item(const float* __restrict__ W, int N, bf16_t* __restrict__ WT, int ldk, int koff, float* scr, int k0, int n0, int lane, DstRow dst) {
#pragma unroll 8
    for (int i = 0; i < 32; ++i) { const int kk = 2 * i + (lane >> 5); scr[kk * 33 + (lane & 31)] = W[(size_t)(k0 + kk) * N + n0 + (lane & 31)]; }
    asm volatile("s_waitcnt vmcnt(0) lgkmcnt(0)" ::: "memory");
    const int c = lane & 7;
#pragma unroll
    for (int j = 0; j < 4; ++j) { const int n = (lane >> 3) + 8 * j; const float* sp = scr + (8 * c) * 33 + n;
        u32x4 o; o.x = f2bf(sp[0 * 33]) | (f2bf(sp[1 * 33]) << 16); o.y = f2bf(sp[2 * 33]) | (f2bf(sp[3 * 33]) << 16);
        o.z = f2bf(sp[4 * 33]) | (f2bf(sp[5 * 33]) << 16); o.w = f2bf(sp[6 * 33]) | (f2bf(sp[7 * 33]) << 16);
        *(u32x4*)(WT + (size_t)dst(n0 + n) * ldk + koff + k0 + 8 * c) = o; }
    asm volatile("s_waitcnt lgkmcnt(0)" ::: "memory");
}
__device__ __forceinline__ int rope_slot(int e) { const int half = e >> 6, el = e & 63, j = el & 31, n = el >> 5, g = half * 8 + (j >> 2); return 32 * (g >> 2) + 8 * (g & 3) + 4 * n + (j & 3); }
__device__ __forceinline__ void transpose_p0(const Params& p, float* lds, int vb, int nvb) {
    const int tid = TID(), lane = tid & 63, wave = tid >> 6;
    float* scr = lds + wave * (64 * 33);
    bf16_t* WIN = (bf16_t*)(p.ws + OFF_WIN); bf16_t* WAB = (bf16_t*)(p.ws + OFF_WAB); bf16_t* WO = (bf16_t*)(p.ws + OFF_WO);
    constexpr int I_IN = 16 * (INW / 32), I_SQ = 16 * 32;
    for (int it = vb * 8 + wave; it < I_IN + 3 * I_SQ; it += nvb * 8) {
        int r = it;
        if (r < I_IN) { const int kb = r / (INW / 32), nb = r % (INW / 32);
            transpose_item(p.w_in, INW, WIN, DM, 0, scr, kb * 64, nb * 32, lane, [](int n) { return (n >= 3072 && n < 4352) ? (n & ~127) + rope_slot(n & 127) : n; }); continue; }
        r -= I_IN; const int m = r / I_SQ, q = r % I_SQ, kb = q / 32, nb = q % 32;
        if (m == 0) transpose_item(p.w_ba, DM, WAB, 2048, 0, scr, kb * 64, nb * 32, lane, [](int n) { return n; });
        else if (m == 1) transpose_item(p.w_bb, DM, WAB, 2048, 1024, scr, kb * 64, nb * 32, lane, [](int n) { return n; });
        else transpose_item(p.w_out, DM, WO, DM, 0, scr, kb * 64, nb * 32, lane, [](int n) { return n; });
    }
}
__device__ __forceinline__ void transpose_moe(const Params& p, float* lds, int vbl, int nvbl) {
    const int tid = TID(), lane = tid & 63, wave = tid >> 6;
    float* scr = lds + wave * (64 * 33);
    bf16_t* WGU = (bf16_t*)(p.ws + OFF_WGU); bf16_t* WD = (bf16_t*)(p.ws + OFF_WD);
    constexpr int I_G = 16 * 16, I_D = 8 * 32, I_E = 2 * I_G + I_D;
    for (int it = vbl * 8 + wave; it < NEXP * I_E; it += nvbl * 8) {
        const int e = it / I_E; int r = it % I_E;
        if (r < 2 * I_G) { const int up = r / I_G, q = r % I_G, kb = q / 16, nb = q % 16;
            const float* W = (up ? p.w_up : p.w_gate) + (size_t)e * DM * EFF;
            transpose_item(W, EFF, WGU + (size_t)e * DM * DM, DM, 0, scr, kb * 64, nb * 32, lane, [up](int f) { return 8 * (f >> 2) + 4 * up + (f & 3); }); }
        else { r -= 2 * I_G; const int kb = r / 32, nb = r % 32;
            transpose_item(p.w_down + (size_t)e * EFF * DM, DM, WD + (size_t)e * DM * EFF, EFF, 0, scr, kb * 64, nb * 32, lane, [](int n) { return n; }); }
    }
}

namespace pg8 {
#define PG8_LAS __attribute__((address_space(3)))
typedef short bf16x8 __attribute__((ext_vector_type(8)));
constexpr int BM = 256, BK = 64, HALF = 128, HTB = HALF * BK * 2, STAGE_BYTES = 8 * HTB, NXCD = 8, WGM = 8;
__host__ __device__ __forceinline__ int lds_byte(int r, int c) { const int st = (r >> 4) * 2 + (c >> 5), rr = r & 15, cc = c & 31, ob = rr * 64 + cc * 2; return st * 1024 + (ob ^ (((ob >> 9) & 1) << 5)); }
__host__ __device__ __forceinline__ void stage_rc(int b, int& R, int& C) { const int st = b / 1024, sb = b % 1024, swz = sb ^ (((sb >> 9) & 1) << 5); R = (st >> 1) * 16 + swz / 64; C = (st & 1) * 32 + (swz % 64) / 2; }
__host__ __device__ __forceinline__ int perm32(int rho) { const int n = rho >> 4, i = rho & 15; return 8 * (i >> 2) + 4 * n + (i & 3); }
struct Unit { int arow0, brow0, pm, pn, e; };
struct Gemm { const bf16_t* A; const bf16_t* Bt; int K; };
struct GridOrder {
    int nM, nN, nwg, G, c;
    __device__ void init(int nM_, int nN_, int G_, int c_) { nM = nM_; nN = nN_; nwg = nM * nN; G = G_; c = c_; }
    __device__ bool next(int i, Unit& u) const {
        const long L = (long)i * G + c; if (L >= nwg) return false;
        int wgid = (int)L; { const int q = nwg / NXCD, r = nwg % NXCD, xcd = wgid % NXCD, off = wgid / NXCD; wgid = (xcd < r ? xcd * (q + 1) : r * (q + 1) + (xcd - r) * q) + off; }
        const int nig = WGM * nN, gid = wgid / nig, fm = gid * WGM, gsz = (nM - fm) < WGM ? (nM - fm) : WGM;
        u.pm = fm + ((wgid % nig) % gsz); u.pn = (wgid % nig) / gsz; u.e = 0; u.arow0 = u.pm * BM; u.brow0 = u.pn * BM; return true;
    }
};
struct MoeOrder {
    int G, c;
    __device__ bool next(int i, Unit& u) const {
        const int L = i * G + c; if (L >= NEXP * 32) return false;
        u.e = L >> 5; const int r = L & 31; u.pm = r & 7; u.pn = r >> 3; u.arow0 = u.e * ESLOTS + u.pm * BM; u.brow0 = u.e * DM + u.pn * BM; return true;
    }
};
__device__ __forceinline__ unsigned cvt_pk_bf16(float lo, float hi) { unsigned r; asm volatile("v_cvt_pk_bf16_f32 %0, %1, %2" : "=v"(r) : "v"(lo), "v"(hi)); return r; }

template <class Epi, class Sched>
__device__ __forceinline__ void gemm_phase(PG8_LAS unsigned char* lds, const Gemm g, const Sched& S, const Epi& E) {
    const int tid = TID(), wid = __builtin_amdgcn_readfirstlane(tid >> 6), lane = tid & 63, wr = wid >> 2, wc = wid & 3, fr = lane & 15, fq = lane >> 4;
    const int K = g.K, nt = K / BK;
    unsigned voffA[2], voffB[2];
#pragma unroll
    for (int i = 0; i < 2; ++i) { int R, C; stage_rc(tid * 16 + i * 8192, R, C); const int Rb = Epi::PERM ? ((R & ~31) + perm32(R & 31)) : R;
        voffA[i] = (unsigned)(R * K + C) * 2u; voffB[i] = (unsigned)(Rb * K + C) * 2u; }
    const size_t kstep = (size_t)(BK * 2);
    const size_t hstep = (size_t)HALF * K * 2;
    const size_t rstep = (size_t)K * 2;
    const unsigned ldsw = (unsigned)wid * 1024u;
    const int aoff = lds_byte(wr * 64 + fr, fq * 8), boff = lds_byte(wc * 32 + fr, fq * 8);
#define PG8_SA(b, h) (((b) * 2 + (h)) * HTB)
#define PG8_SB(b, h) ((4 + (b) * 2 + (h)) * HTB)
#define PG8_STAGE(bufoff, gbase, voff) do { _Pragma("unroll") for (int _i = 0; _i < 2; ++_i) \
        __builtin_amdgcn_global_load_lds((const unsigned*)((const char*)(gbase) + (voff)[_i]), (PG8_LAS unsigned*)(lds + (bufoff) + ldsw + _i * 8192), 16, 0, 0); } while (0)
#define PG8_LDA(dst, b, h) do { _Pragma("unroll") for (int m = 0; m < 4; ++m) _Pragma("unroll") for (int k = 0; k < 2; ++k) dst[m][k] = *(const PG8_LAS bf16x8*)(lds + PG8_SA(b, h) + aoff + m * 2048 + k * 1024); } while (0)
#define PG8_LDB(dst, b, h) do { _Pragma("unroll") for (int n = 0; n < 2; ++n) _Pragma("unroll") for (int k = 0; k < 2; ++k) dst[n][k] = *(const PG8_LAS bf16x8*)(lds + PG8_SB(b, h) + boff + n * 2048 + k * 1024); } while (0)
#define PG8_MMA(ai, bj, At, Bt) do { __builtin_amdgcn_s_setprio(1); _Pragma("unroll") for (int m = 0; m < 4; ++m) _Pragma("unroll") for (int n = 0; n < 2; ++n) _Pragma("unroll") for (int k = 0; k < 2; ++k) \
        acc[ai][bj][m][n] = __builtin_amdgcn_mfma_f32_16x16x32_bf16(Bt[n][k], At[m][k], acc[ai][bj][m][n], 0, 0, 0); __builtin_amdgcn_s_setprio(0); } while (0)
#define PG8_WAIT_V(n) asm volatile("s_waitcnt vmcnt(" #n ")" ::: "memory")
#define PG8_WAIT_L(n) asm volatile("s_waitcnt lgkmcnt(" #n ")" ::: "memory")
#define PG8_BAR __builtin_amdgcn_s_barrier()
#define PG8_SCHED __builtin_amdgcn_sched_barrier(0)
    Unit cur, nxt; int ui = 0;
    if (!S.next(0, cur)) return;
    f32x4 acc[2][2][4][2];
#pragma unroll
    for (int a = 0; a < 2; ++a)
#pragma unroll
        for (int b = 0; b < 2; ++b)
#pragma unroll
            for (int m = 0; m < 4; ++m)
#pragma unroll
                for (int n = 0; n < 2; ++n) acc[a][b][m][n] = (f32x4){0.f, 0.f, 0.f, 0.f};
    bf16x8 At[4][2], B0[2][2], B1[2][2];
    const char* cA = (const char*)g.A + (size_t)cur.arow0 * rstep; const char* cB = (const char*)g.Bt + (size_t)cur.brow0 * rstep;
    PG8_STAGE(PG8_SB(0, 0), cB, voffB); PG8_STAGE(PG8_SB(0, 1), cB + hstep, voffB); PG8_STAGE(PG8_SA(0, 0), cA, voffA); PG8_STAGE(PG8_SA(0, 1), cA + hstep, voffA);
    if (wr == 1) PG8_BAR;
    PG8_WAIT_V(2); PG8_BAR;
    PG8_STAGE(PG8_SB(1, 0), cB + kstep, voffB); PG8_STAGE(PG8_SA(1, 0), cA + kstep, voffA); PG8_STAGE(PG8_SB(1, 1), cB + hstep + kstep, voffB);
    PG8_WAIT_V(6); PG8_BAR;
    for (;;) {
        const bool has_next = S.next(ui + 1, nxt);
        const char* nA = has_next ? (const char*)g.A + (size_t)nxt.arow0 * rstep : cA; const char* nB = has_next ? (const char*)g.Bt + (size_t)nxt.brow0 * rstep : cB;
        for (int t = 0; t < nt; t += 2) {
            const bool last = (t == nt - 2);
            const char* a1 = cA + (size_t)(t + 1) * kstep;
            const char* a2 = last ? nA : cA + (size_t)(t + 2) * kstep; const char* b2 = last ? nB : cB + (size_t)(t + 2) * kstep;
            const char* a3 = a2 + kstep; const char* b3 = b2 + kstep;
            if constexpr (Epi::HAS_MID) { if (t == nt / 2) E.mid(acc, cur, wr, wc, fr, fq); }
            PG8_LDB(B0, 0, 0); PG8_LDB(B1, 0, 1); PG8_SCHED; PG8_LDA(At, 0, 0); PG8_STAGE(PG8_SA(1, 1), a1 + hstep, voffA);
            PG8_WAIT_V(8); PG8_WAIT_L(0); PG8_BAR; PG8_MMA(0, 0, At, B0); PG8_MMA(0, 1, At, B1); PG8_BAR; PG8_SCHED;
            PG8_LDA(At, 0, 1); PG8_STAGE(PG8_SB(0, 0), b2, voffB); PG8_STAGE(PG8_SB(0, 1), b2 + hstep, voffB); PG8_STAGE(PG8_SA(0, 0), a2, voffA);
            PG8_WAIT_V(8); PG8_WAIT_L(0); PG8_BAR; PG8_MMA(1, 0, At, B0); PG8_MMA(1, 1, At, B1); PG8_BAR; PG8_SCHED;
            PG8_LDB(B0, 1, 0); PG8_LDB(B1, 1, 1); PG8_SCHED; PG8_LDA(At, 1, 0); PG8_STAGE(PG8_SA(0, 1), a2 + hstep, voffA);
            PG8_WAIT_V(8); PG8_WAIT_L(0); PG8_BAR; PG8_MMA(0, 0, At, B0); PG8_MMA(0, 1, At, B1); PG8_BAR; PG8_SCHED;
            PG8_LDA(At, 1, 1); PG8_STAGE(PG8_SB(1, 0), b3, voffB); PG8_STAGE(PG8_SB(1, 1), b3 + hstep, voffB); PG8_STAGE(PG8_SA(1, 0), a3, voffA);
            PG8_WAIT_V(8); PG8_WAIT_L(0); PG8_BAR; PG8_MMA(1, 0, At, B0); PG8_MMA(1, 1, At, B1); PG8_BAR; PG8_SCHED;
        }
        if (wr == 0) PG8_BAR;
        E(acc, cur, wr, wc, fr, fq, lds);
        if (!has_next) break;
#pragma unroll
        for (int a = 0; a < 2; ++a)
#pragma unroll
            for (int b = 0; b < 2; ++b)
#pragma unroll
                for (int m = 0; m < 4; ++m)
#pragma unroll
                    for (int n = 0; n < 2; ++n) acc[a][b][m][n] = (f32x4){0.f, 0.f, 0.f, 0.f};
        cur = nxt; cA = nA; cB = nB; ++ui;
        if (wr == 1) PG8_BAR;
    }
    PG8_WAIT_V(0);
    PG8_BAR;
#undef PG8_SA
#undef PG8_SB
#undef PG8_STAGE
#undef PG8_LDA
#undef PG8_LDB
#undef PG8_MMA
#undef PG8_WAIT_V
#undef PG8_WAIT_L
#undef PG8_SCHED
}
#define PG8_FOR_AM _Pragma("unroll") for (int ai = 0; ai < 2; ++ai) _Pragma("unroll") for (int m = 0; m < 4; ++m)
#define PG8_FOR_BJ _Pragma("unroll") for (int bj = 0; bj < 2; ++bj)

struct EpiInProj {
    static constexpr bool PERM = true, HAS_MID = false;
    Params p;
    __device__ __forceinline__ void operator()(f32x4 (&acc)[2][2][4][2], const Unit& u, int wr, int wc, int fr, int fq, PG8_LAS unsigned char* lds) const {
        const int pn = u.pn;
        const int sec = pn < 4 ? 0 : pn < 8 ? 1 : pn < 12 ? 2 : pn < 16 ? 3 : pn == 16 ? 4 : pn == 17 ? 5 : pn < 22 ? 6 : 7;
        const int head0 = (sec == 0 ? pn : sec == 1 ? pn - 4 : sec == 2 ? pn - 8 : sec == 3 ? pn - 12 : sec == 6 ? pn - 18 : sec == 7 ? pn - 22 : 0) * 2;
        const int cl = wc * 32 + fq * 8;
        if (sec == 3 || sec == 4) {
            PG8_LAS float* X = (PG8_LAS float*)(lds + STAGE_BYTES);
            PG8_FOR_AM { PG8_FOR_BJ { const f32x4 a = acc[ai][bj][m][0], b = acc[ai][bj][m][1];
                float ss = (a.x * a.x + a.y * a.y) + (a.z * a.z + a.w * a.w) + (b.x * b.x + b.y * b.y) + (b.z * b.z + b.w * b.w);
                ss += __shfl_xor(ss, 16); ss += __shfl_xor(ss, 32);
                if (fq == 0) X[((ai * 128 + wr * 64 + m * 16 + fr) * 2 + bj) * 4 + wc] = ss; } }
            asm volatile("s_waitcnt lgkmcnt(0)" ::: "memory"); __builtin_amdgcn_s_barrier(); asm volatile("" ::: "memory");
            const int g = wc * 4 + fq, j0 = (g & 7) * 4, e0 = (g >> 3) * 64 + j0;
            const float* gn = sec == 3 ? p.g_qnorm : p.g_knorm;
            const f32x4 g1 = *(const f32x4*)(gn + e0), g2 = *(const f32x4*)(gn + e0 + 32);
            const float sc = sec == 3 ? CB : 1.f;
            const float2* rope = (const float2*)(p.ws + OFF_ROPE);
            PG8_FOR_AM { const int rl = ai * 128 + wr * 64 + m * 16 + fr, grow = u.pm * BM + rl; const RowInfo ri = row_decode(grow);
                f32x4 c4 = (f32x4){1.f, 1.f, 1.f, 1.f}, s4 = (f32x4){0.f, 0.f, 0.f, 0.f};
                if (!ri.meta) { const int pos = (g >> 3) ? (ri.t & 63) : (ri.t >> 6); const f32x4 t0 = *(const f32x4*)(rope + pos * 32 + j0), t1 = *(const f32x4*)(rope + pos * 32 + j0 + 2);
                    c4 = (f32x4){t0.x, t0.z, t1.x, t1.z}; s4 = (f32x4){t0.y, t0.w, t1.y, t1.w}; }
                PG8_FOR_BJ { const f32x4 pq = *(const PG8_LAS f32x4*)(X + (rl * 2 + bj) * 4);
                    const float rstd = 1.0f / sqrtf(((pq.x + pq.y) + (pq.z + pq.w)) * (1.0f / 128.f) + EPS) * sc;
                    const f32x4 x1 = acc[ai][bj][m][0] * g1 * rstd, x2 = acc[ai][bj][m][1] * g2 * rstd;
                    const f32x4 y1 = x1 * c4 - x2 * s4, y2 = x2 * c4 + x1 * s4;
                    if (ri.valid) { const int head = head0 + bj;
                        bf16_t* dst = sec == 3 ? (bf16_t*)(p.ws + OFF_QB) + ((size_t)(ri.b * 8 + head) * QROWS + row_q(ri)) * 128 : (bf16_t*)(p.ws + OFF_KB) + ((size_t)(ri.b * 2 + head) * KEYS + row_key(ri)) * 128;
                        *(u32x2*)(dst + e0) = (u32x2){cvt_pk_bf16(y1.x, y1.y), cvt_pk_bf16(y1.z, y1.w)};
                        *(u32x2*)(dst + e0 + 32) = (u32x2){cvt_pk_bf16(y2.x, y2.y), cvt_pk_bf16(y2.z, y2.w)}; } } }
            return;
        }
        if (sec <= 1 && u.pm < MREAL / BM) {
            const float sc2 = sec == 0 ? CA * CA : 1.f; float mx[2] = {0.f, 0.f};
            PG8_FOR_AM { PG8_FOR_BJ { const f32x4 a = acc[ai][bj][m][0], b = acc[ai][bj][m][1];
                float ss = (a.x * a.x + a.y * a.y) + (a.z * a.z + a.w * a.w) + (b.x * b.x + b.y * b.y) + (b.z * b.z + b.w * b.w);
                ss += __shfl_xor(ss, 16); ss += __shfl_xor(ss, 32); mx[bj] = fmaxf(mx[bj], ss * sc2); } }
            PG8_FOR_BJ { float v = mx[bj]; v = fmaxf(v, __shfl_xor(v, 1)); v = fmaxf(v, __shfl_xor(v, 2)); v = fmaxf(v, __shfl_xor(v, 4)); v = fmaxf(v, __shfl_xor(v, 8));
                if (fr == 0 && fq == 0) atomicMax((unsigned*)(p.ws + OFF_NRM) + ((sec * 2 + (u.pm >> 5)) * 8 + head0 + bj) * 4 + wc, __float_as_uint(v)); }
        }
        PG8_FOR_AM { const int grow = u.pm * BM + ai * 128 + wr * 64 + m * 16 + fr; const RowInfo ri = row_decode(grow);
            if (!ri.valid) continue;
            PG8_FOR_BJ { const int head = head0 + bj; f32x4 a = acc[ai][bj][m][0], b = acc[ai][bj][m][1]; bf16_t* dst;
                if (sec == 0) { dst = (bf16_t*)(p.ws + OFF_QA) + ((size_t)(ri.b * 8 + head) * QROWS + row_q(ri)) * 128; a = a * CA; b = b * CA; }
                else if (sec == 1) dst = (bf16_t*)(p.ws + OFF_KA) + ((size_t)(ri.b * 8 + head) * KEYS + row_key(ri)) * 128;
                else if (sec == 2) dst = (bf16_t*)(p.ws + OFF_VA) + ((size_t)(ri.b * 8 + head) * KEYS + row_key(ri)) * 128;
                else if (sec == 5) dst = (bf16_t*)(p.ws + OFF_VB) + ((size_t)(ri.b * 2 + head) * KEYS + row_key(ri)) * 128;
                else { dst = (grow < MREAL ? (bf16_t*)p.out + (size_t)grow * 2048 : (bf16_t*)(p.ws + OFF_SGM) + (size_t)(grow - MREAL) * 2048) + (sec == 7 ? 1024 : 0) + head * 128;
                    a.x = 1.0f / (1.0f + __expf(-a.x)); a.y = 1.0f / (1.0f + __expf(-a.y)); a.z = 1.0f / (1.0f + __expf(-a.z)); a.w = 1.0f / (1.0f + __expf(-a.w));
                    b.x = 1.0f / (1.0f + __expf(-b.x)); b.y = 1.0f / (1.0f + __expf(-b.y)); b.z = 1.0f / (1.0f + __expf(-b.z)); b.w = 1.0f / (1.0f + __expf(-b.w)); }
                *(u32x4*)(dst + cl) = (u32x4){cvt_pk_bf16(a.x, a.y), cvt_pk_bf16(a.z, a.w), cvt_pk_bf16(b.x, b.y), cvt_pk_bf16(b.z, b.w)}; } }
    }
};
__device__ __forceinline__ f32x4 bf4(u32x2 w) { return (f32x4){bf2f(w.x & 0xffffu), bf2f(w.x >> 16), bf2f(w.y & 0xffffu), bf2f(w.y >> 16)}; }
struct EpiMerge {
    static constexpr bool PERM = true, HAS_MID = true;
    Params p;
    __device__ __forceinline__ const bf16_t* sg(int grow) const { return grow < MREAL ? (const bf16_t*)p.out + (size_t)grow * 2048 : (const bf16_t*)(p.ws + OFF_SGM) + (size_t)(grow - MREAL) * 2048; }
    __device__ __forceinline__ void mid(f32x4 (&acc)[2][2][4][2], const Unit& u, int wr, int wc, int fr, int fq) const {
        PG8_FOR_AM { const int grow = u.pm * BM + ai * 128 + wr * 64 + m * 16 + fr; if (grow >= MROWS) continue; const bf16_t* s = sg(grow) + u.pn * BM + wc * 32 + fq * 8;
            PG8_FOR_BJ { const u32x4 wa = *(const u32x4*)(s + bj * 128), wb = *(const u32x4*)(s + 1024 + bj * 128);
                const f32x4 b0 = bf4((u32x2){wb.x, wb.y}), b1 = bf4((u32x2){wb.z, wb.w});
                const f32x4 r0 = (f32x4){__builtin_amdgcn_rcpf(b0.x), __builtin_amdgcn_rcpf(b0.y), __builtin_amdgcn_rcpf(b0.z), __builtin_amdgcn_rcpf(b0.w)};
                const f32x4 r1 = (f32x4){__builtin_amdgcn_rcpf(b1.x), __builtin_amdgcn_rcpf(b1.y), __builtin_amdgcn_rcpf(b1.z), __builtin_amdgcn_rcpf(b1.w)};
                acc[ai][bj][m][0] = acc[ai][bj][m][0] * bf4((u32x2){wa.x, wa.y}) * r0;
                acc[ai][bj][m][1] = acc[ai][bj][m][1] * bf4((u32x2){wa.z, wa.w}) * r1; } }
    }
    __device__ __forceinline__ void operator()(f32x4 (&acc)[2][2][4][2], const Unit& u, int wr, int wc, int fr, int fq, PG8_LAS unsigned char*) const {
        bf16_t* MG = (bf16_t*)(p.ws + OFF_MERGED);
        PG8_FOR_AM { const int grow = u.pm * BM + ai * 128 + wr * 64 + m * 16 + fr; if (grow >= MROWS) continue; const int col = u.pn * BM + wc * 32 + fq * 8; const bf16_t* s = sg(grow) + 1024 + col;
            PG8_FOR_BJ { const u32x4 wb = *(const u32x4*)(s + bj * 128);
                const f32x4 a = acc[ai][bj][m][0] * bf4((u32x2){wb.x, wb.y}), b = acc[ai][bj][m][1] * bf4((u32x2){wb.z, wb.w});
                *(u32x4*)(MG + (size_t)grow * DM + col + bj * 128) = (u32x4){cvt_pk_bf16(a.x, a.y), cvt_pk_bf16(a.z, a.w), cvt_pk_bf16(b.x, b.y), cvt_pk_bf16(b.z, b.w)}; } }
    }
};
struct EpiOut {
    static constexpr bool PERM = false, HAS_MID = false;
    Params p;
    __device__ __forceinline__ void operator()(f32x4 (&acc)[2][2][4][2], const Unit& u, int wr, int wc, int fr, int fq, PG8_LAS unsigned char*) const {
        PG8_FOR_AM { const int grow = u.pm * BM + ai * 128 + wr * 64 + m * 16 + fr; if (grow >= MROWS) continue; const int col = u.pn * BM + wc * 32 + fq * 4;
            const float* hr = h_row(p, grow) + col; float* o = h2_row(p, grow) + col;
            PG8_FOR_BJ {
#pragma unroll
                for (int n = 0; n < 2; ++n) *(f32x4*)(o + bj * 128 + n * 16) = *(const f32x4*)(hr + bj * 128 + n * 16) + acc[ai][bj][m][n]; } }
    }
};
struct EpiMoeUp {
    static constexpr bool PERM = true, HAS_MID = false;
    Params p;
    __device__ __forceinline__ void operator()(f32x4 (&acc)[2][2][4][2], const Unit& u, int wr, int wc, int fr, int fq, PG8_LAS unsigned char*) const {
        bf16_t* HID = (bf16_t*)(p.ws + OFF_HID);
        PG8_FOR_AM { const int s = u.pm * BM + ai * 128 + wr * 64 + m * 16 + fr; if (s >= ESLOTS) continue;
            PG8_FOR_BJ { const f32x4 gt = acc[ai][bj][m][0], up = acc[ai][bj][m][1]; const int f0 = (u.pn * BM + bj * 128 + wc * 32 + fq * 8) >> 1;
                const float h0 = gt.x / (1.0f + __expf(-gt.x)) * up.x, h1 = gt.y / (1.0f + __expf(-gt.y)) * up.y, h2 = gt.z / (1.0f + __expf(-gt.z)) * up.z, h3 = gt.w / (1.0f + __expf(-gt.w)) * up.w;
                *(u32x2*)(HID + ((size_t)u.e * ESLOTS + s) * EFF + f0) = (u32x2){cvt_pk_bf16(h0, h1), cvt_pk_bf16(h2, h3)}; } }
    }
};
struct EpiMoeDown {
    static constexpr bool PERM = true, HAS_MID = false;
    Params p;
    __device__ __forceinline__ void operator()(f32x4 (&acc)[2][2][4][2], const Unit& u, int wr, int wc, int fr, int fq, PG8_LAS unsigned char*) const {
        bf16_t* YB = (bf16_t*)(p.ws + OFF_YB); const float* SAFF = (const float*)(p.ws + OFF_SAFF);
        PG8_FOR_AM { const int s = u.pm * BM + ai * 128 + wr * 64 + m * 16 + fr; if (s >= ESLOTS) continue; const float af = SAFF[u.e * ESLOTS + s]; const int col = u.pn * BM + wc * 32 + fq * 8;
            PG8_FOR_BJ { const f32x4 a = acc[ai][bj][m][0] * af, b = acc[ai][bj][m][1] * af;
                *(u32x4*)(YB + ((size_t)u.e * ESLOTS + s) * DM + col + bj * 128) = (u32x4){cvt_pk_bf16(a.x, a.y), cvt_pk_bf16(a.z, a.w), cvt_pk_bf16(b.x, b.y), cvt_pk_bf16(b.z, b.w)}; } }
    }
};
#undef PG8_BAR
}

__device__ __forceinline__ void dot8(const u32x4 w, const u32x4 a, float& acc) {
    acc = fmaf(bf2f(w.x & 0xffffu), bf2f(a.x & 0xffffu), acc); acc = fmaf(bf2f(w.x >> 16), bf2f(a.x >> 16), acc);
    acc = fmaf(bf2f(w.y & 0xffffu), bf2f(a.y & 0xffffu), acc); acc = fmaf(bf2f(w.y >> 16), bf2f(a.y >> 16), acc);
    acc = fmaf(bf2f(w.z & 0xffffu), bf2f(a.z & 0xffffu), acc); acc = fmaf(bf2f(w.z >> 16), bf2f(a.z >> 16), acc);
    acc = fmaf(bf2f(w.w & 0xffffu), bf2f(a.w & 0xffffu), acc); acc = fmaf(bf2f(w.w >> 16), bf2f(a.w >> 16), acc);
}
template <int NI>
__device__ __forceinline__ void dots4(const bf16_t* w, const bf16_t* a0, size_t apitch, int lane, float (&acc)[4]) {
#pragma unroll
    for (int i = 0; i < NI; ++i) { const int k = i * 512 + lane * 8; const u32x4 wv = *(const u32x4*)(w + k);
#pragma unroll
        for (int r = 0; r < 4; ++r) dot8(wv, *(const u32x4*)(a0 + r * apitch + k), acc[r]); }
}
__device__ __forceinline__ void phase3a_meta(const Params& p, int vb, int nvb) {
    const int tid = TID(), lane = tid & 63, wave = tid >> 6;
    const bf16_t* AO = (const bf16_t*)(p.ws + OFF_AO) + (size_t)MREAL * AOP; const bf16_t* WAB = (const bf16_t*)(p.ws + OFF_WAB);
    const bf16_t* SGM = (const bf16_t*)(p.ws + OFF_SGM); bf16_t* MG = (bf16_t*)(p.ws + OFF_MERGED) + (size_t)MREAL * DM;
    for (int t = vb * 8 + wave; t < 1024 * 8; t += nvb * 8) {
        const int c = t >> 3, r0 = (t & 7) * 4;
        float pa[4] = {0.f, 0.f, 0.f, 0.f}, pb[4] = {0.f, 0.f, 0.f, 0.f};
        dots4<2>(WAB + (size_t)c * 2048, AO + (size_t)r0 * AOP, AOP, lane, pa);
        dots4<2>(WAB + (size_t)c * 2048 + 1024, AO + (size_t)r0 * AOP + 1024, AOP, lane, pb);
#pragma unroll
        for (int r = 0; r < 4; ++r) { const float sa = bf2f(SGM[(size_t)(r0 + r) * 2048 + c]), sb = bf2f(SGM[(size_t)(r0 + r) * 2048 + 1024 + c]);
            const float y = wave_sum(sa * pa[r] + sb * pb[r]); if (lane == 0) MG[(size_t)(r0 + r) * DM + c] = (bf16_t)f2bf(y); }
    }
}
__device__ __forceinline__ void phase3b_meta(const Params& p, int vb, int nvb) {
    const int tid = TID(), lane = tid & 63, wave = tid >> 6;
    const bf16_t* MG = (const bf16_t*)(p.ws + OFF_MERGED) + (size_t)MREAL * DM; const bf16_t* WO = (const bf16_t*)(p.ws + OFF_WO); float* H2M = (float*)(p.ws + OFF_H2M);
    for (int t = vb * 8 + wave; t < 1024 * 8; t += nvb * 8) {
        const int c = t >> 3, r0 = (t & 7) * 4;
        float pa[4] = {0.f, 0.f, 0.f, 0.f};
        dots4<2>(WO + (size_t)c * DM, MG + (size_t)r0 * DM, DM, lane, pa);
#pragma unroll
        for (int r = 0; r < 4; ++r) { const float y = wave_sum(pa[r]); if (lane == 0) H2M[(size_t)(r0 + r) * DM + c] = p.meta[(size_t)((r0 + r) & 15) * DM + c] + y; }
    }
}
__device__ __forceinline__ void phase5a_tail(const Params& p, int vb, int nvb) {
    const int tid = TID(), lane = tid & 63, wave = tid >> 6;
    const bf16_t* XS = (const bf16_t*)(p.ws + OFF_XS); const bf16_t* WGU = (const bf16_t*)(p.ws + OFF_WGU); bf16_t* HID = (bf16_t*)(p.ws + OFF_HID);
    for (int t = vb * 8 + wave; t < NEXP * EFF; t += nvb * 8) {
        const int e = t >> 9, f = t & 511; const size_t s0 = (size_t)e * ESLOTS + 2048;
        const bf16_t* wg = WGU + ((size_t)e * DM + 8 * (f >> 2) + (f & 3)) * DM;
        float pg[4] = {0.f, 0.f, 0.f, 0.f}, pu[4] = {0.f, 0.f, 0.f, 0.f};
        dots4<2>(wg, XS + s0 * DM, DM, lane, pg); dots4<2>(wg + 4 * DM, XS + s0 * DM, DM, lane, pu);
#pragma unroll
        for (int r = 0; r < 4; ++r) { const float g = wave_sum(pg[r]), u = wave_sum(pu[r]); if (lane == 0) HID[(s0 + r) * EFF + f] = (bf16_t)f2bf(g / (1.0f + __expf(-g)) * u); }
    }
}
__device__ __forceinline__ void phase5b_tail(const Params& p, int vb, int nvb) {
    const int tid = TID(), lane = tid & 63, wave = tid >> 6;
    const bf16_t* HID = (const bf16_t*)(p.ws + OFF_HID); const bf16_t* WD = (const bf16_t*)(p.ws + OFF_WD); bf16_t* YB = (bf16_t*)(p.ws + OFF_YB); const float* SAFF = (const float*)(p.ws + OFF_SAFF);
    for (int t = vb * 8 + wave; t < NEXP * DM; t += nvb * 8) {
        const int e = t >> 10, c = t & 1023; const size_t s0 = (size_t)e * ESLOTS + 2048;
        float pa[4] = {0.f, 0.f, 0.f, 0.f};
        dots4<1>(WD + ((size_t)e * DM + c) * EFF, HID + s0 * EFF, EFF, lane, pa);
#pragma unroll
        for (int r = 0; r < 4; ++r) { const float y = wave_sum(pa[r]); if (lane == 0) YB[(s0 + r) * DM + c] = (bf16_t)f2bf(y * SAFF[s0 + r]); }
    }
}

__device__ __forceinline__ void phase1_fast(const Params& p, unsigned char* lds_raw, int vb, int nvb) {
    pg8::Gemm g{(const bf16_t*)(p.ws + OFF_UN), (const bf16_t*)(p.ws + OFF_WIN), DM};
    pg8::GridOrder S; S.init(MPAD / 256, INW / 256, nvb, vb);
    pg8::EpiInProj E{p};
    pg8::gemm_phase(( __attribute__((address_space(3))) unsigned char*)lds_raw, g, S, E);
}
__device__ __forceinline__ void phase3a_fast(const Params& p, unsigned char* lds_raw, int vb, int nvb) {
    phase3a_meta(p, vb, nvb);
    pg8::Gemm g{(const bf16_t*)(p.ws + OFF_AO), (const bf16_t*)(p.ws + OFF_WAB), 2048};
    pg8::GridOrder S; S.init(MREAL / 256, DM / 256, nvb, vb);
    pg8::EpiMerge E{p};
    pg8::gemm_phase(( __attribute__((address_space(3))) unsigned char*)lds_raw, g, S, E);
}
__device__ __forceinline__ void phase3b_fast(const Params& p, unsigned char* lds_raw, int vb, int nvb) {
    phase3b_meta(p, vb, nvb);
    pg8::Gemm g{(const bf16_t*)(p.ws + OFF_MERGED), (const bf16_t*)(p.ws + OFF_WO), DM};
    pg8::GridOrder S; S.init(MREAL / 256, DM / 256, nvb, vb);
    pg8::EpiOut E{p};
    pg8::gemm_phase(( __attribute__((address_space(3))) unsigned char*)lds_raw, g, S, E);
}
__device__ __forceinline__ void phase5a_fast(const Params& p, unsigned char* lds_raw, int vb, int nvb) {
    phase5a_tail(p, vb, nvb);
    pg8::Gemm g{(const bf16_t*)(p.ws + OFF_XS), (const bf16_t*)(p.ws + OFF_WGU), DM};
    pg8::MoeOrder S{nvb, vb};
    pg8::EpiMoeUp E{p};
    pg8::gemm_phase(( __attribute__((address_space(3))) unsigned char*)lds_raw, g, S, E);
}
__device__ __forceinline__ void phase5b_fast(const Params& p, unsigned char* lds_raw, int vb, int nvb) {
    phase5b_tail(p, vb, nvb);
    pg8::Gemm g{(const bf16_t*)(p.ws + OFF_HID), (const bf16_t*)(p.ws + OFF_WD), EFF};
    pg8::MoeOrder S{nvb, vb};
    pg8::EpiMoeDown E{p};
    pg8::gemm_phase(( __attribute__((address_space(3))) unsigned char*)lds_raw, g, S, E);
}

__device__ __forceinline__ void phase4b_fast(const Params& p, float* lds, int vb, int nvb) {
    const int tid = TID(), lane = tid & 63, wave = tid >> 6;
    constexpr int NBE = NB * NEXP;
    if (vb >= NBE || nvb <= NBE) { const bool small = nvb <= NBE; transpose_moe(p, lds, small ? vb : vb - NBE, small ? nvb : nvb - NBE); if (!small) return; }
    const float* AFF = (const float*)(p.ws + OFF_AFF); int* IDX = (int*)(p.ws + OFF_IDX); int* SEL = (int*)(p.ws + OFF_SEL);
    unsigned* keys = (unsigned*)lds;
    unsigned* hist = keys + 8448;
    unsigned* sh = hist + 256;
    for (int be = vb; be < NBE; be += nvb) {
        const int b = be / NEXP, e = be % NEXP;
        __syncthreads();
        for (int i = tid; i < LTOT; i += NTHREADS) keys[i] = __float_as_uint(AFF[(size_t)be * LTOT + i]);
        if (tid == 0) { sh[0] = 0u; sh[1] = CAP; }
        __syncthreads();
        for (int pass = 0; pass < 4; ++pass) {
            const int shift = 24 - 8 * pass;
            if (tid < 256) hist[tid] = 0u;
            __syncthreads();
            const unsigned prefix = sh[0], pmask = pass == 0 ? 0u : (0xffffffffu << (shift + 8));
            for (int i = tid; i < LTOT; i += NTHREADS) { const unsigned k = keys[i]; if ((k & pmask) == prefix) atomicAdd(&hist[(k >> shift) & 255u], 1u); }
            __syncthreads();
            if (tid == 0) { unsigned rem = sh[1], d = 255u;
                for (;; --d) { const unsigned c = hist[d]; if (c >= rem || d == 0u) break; rem -= c; }
                sh[0] = prefix | (d << shift); sh[1] = rem; }
            __syncthreads();
        }
        const unsigned T = sh[0], need_eq = sh[1];
        const int t0 = tid * 17; int cnt_gt = 0, cnt_eq = 0;
        for (int i = 0; i < 17; ++i) { const int tok = t0 + i; if (tok < LTOT) { const unsigned k = keys[tok]; cnt_gt += k > T; cnt_eq += k == T; } }
        int incl = cnt_eq;
#pragma unroll
        for (int o = 1; o < 64; o <<= 1) { const int v = __shfl_up(incl, o); if (lane >= o) incl += v; }
        if (lane == 63) sh[8 + wave] = (unsigned)incl;
        __syncthreads();
        int eq_before = incl - cnt_eq; for (int w = 0; w < wave; ++w) eq_before += (int)sh[8 + w];
        __syncthreads();
        int take_eq = (int)need_eq - eq_before; take_eq = take_eq < 0 ? 0 : (take_eq > cnt_eq ? cnt_eq : take_eq);
        const int mysel = cnt_gt + take_eq;
        incl = mysel;
#pragma unroll
        for (int o = 1; o < 64; o <<= 1) { const int v = __shfl_up(incl, o); if (lane >= o) incl += v; }
        if (lane == 63) sh[8 + wave] = (unsigned)incl;
        __syncthreads();
        int slot = incl - mysel; for (int w = 0; w < wave; ++w) slot += (int)sh[8 + w];
        int eqi = eq_before;
        for (int i = 0; i < 17; ++i) { const int tok = t0 + i; if (tok < LTOT) { const unsigned k = keys[tok];
            bool take = k > T; if (k == T) { take = eqi < (int)need_eq; ++eqi; }
            if (take) { IDX[(size_t)be * CAP + slot] = tok; SEL[((size_t)b * LTOT + tok) * NEXP + e] = slot; ++slot; } else SEL[((size_t)b * LTOT + tok) * NEXP + e] = -1; } }
    }
    __syncthreads();
}
__device__ __forceinline__ void phase4c(const Params& p, int vb, int nvb) {
    const int tid = TID(), lane = tid & 63, wave = tid >> 6;
    const bf16_t* U2 = (const bf16_t*)(p.ws + OFF_UN); bf16_t* XS = (bf16_t*)(p.ws + OFF_XS); const int* IDX = (const int*)(p.ws + OFF_IDX);
    const float* AFF = (const float*)(p.ws + OFF_AFF); float* SAFF = (float*)(p.ws + OFF_SAFF);
    for (int r = vb * 8 + wave; r < NEXP * ESLOTS; r += nvb * 8) {
        const int e = r / ESLOTS, s = r % ESLOTS, b = s / CAP, c = s % CAP;
        const int tok = IDX[((size_t)b * NEXP + e) * CAP + c];
        const u32x4* src = (const u32x4*)(U2 + (size_t)pos_row(b, tok) * DM) + lane; u32x4* dst = (u32x4*)(XS + (size_t)r * DM) + lane;
        const u32x4 v0 = src[0], v1 = src[64]; dst[0] = v0; dst[64] = v1;
        if (lane == 0) SAFF[r] = AFF[((size_t)b * NEXP + e) * LTOT + tok];
    }
}

#define LAS __attribute__((address_space(3)))
#define XB_TMO      128
#define XB_XCNT(j)  (256  + 64 * (j))
#define XB_XSUB(j)  (1280 + 64 * (j))
#define XB_XGEN(j)  (2304 + 64 * (j))
#define XB_TOP      3328
#define XB_TOPGEN   3392
#define XB_SPIN_CAP (1u << 22)
__device__ __forceinline__ unsigned xb_ld(unsigned* p)              { return __hip_atomic_load(p, __ATOMIC_RELAXED, __HIP_MEMORY_SCOPE_AGENT); }
__device__ __forceinline__ unsigned xb_add(unsigned* p, unsigned v) { return __hip_atomic_fetch_add(p, v, __ATOMIC_RELAXED, __HIP_MEMORY_SCOPE_AGENT); }
__device__ __forceinline__ unsigned xb_xcc_id() { return (unsigned)__builtin_amdgcn_s_getreg((3 << 11) | 20) & 0xFu; }
#define XB_SPIN(cond, bar) do { unsigned _sp = 0; while (cond) { __builtin_amdgcn_s_sleep(1); \
    if ((++_sp & 255u) == 0u) { if (xb_ld(&(bar)[XB_TMO])) break; if (_sp > XB_SPIN_CAP) { atomicAdd(&(bar)[XB_TMO], 1u); break; } } } } while (0)
struct XcdBarrier { unsigned* bar; unsigned x; volatile LAS unsigned* st; };
__device__ __forceinline__ XcdBarrier xcd_barrier_post(unsigned* bar, volatile LAS unsigned* st) {
    XcdBarrier b; b.bar = bar; b.x = xb_xcc_id(); b.st = st;
    if (threadIdx.x == 0) (void)xb_add(&bar[XB_XCNT(b.x)], 1u);
    return b;
}
__device__ __forceinline__ void xcd_barrier_complete(unsigned* bar, unsigned x, unsigned& nloc, unsigned& nx) {
    const unsigned G = gridDim.x * gridDim.y * gridDim.z;
    unsigned sum, cnt, mine, sp = 0u;
    for (;;) {
        sum = 0u; cnt = 0u; mine = 0u;
#pragma unroll
        for (unsigned j = 0; j < 16; ++j) { const unsigned c = xb_ld(&bar[XB_XCNT(j)]); sum += c; cnt += (c > 0u) ? 1u : 0u; mine = (j == x) ? c : mine; }
        if (sum == G) break;
        __builtin_amdgcn_s_sleep(1);
        if ((++sp & 255u) == 0u) { if (xb_ld(&bar[XB_TMO])) break; if (sp > XB_SPIN_CAP) { atomicAdd(&bar[XB_TMO], 1u); break; } }
    }
    nloc = mine > 0u ? mine : 1u; nx = cnt > 0u ? cnt : 1u;
}
__device__ __forceinline__ void xcd_barrier(const XcdBarrier& b) {
    asm volatile("s_waitcnt vmcnt(0)" ::: "memory");
    __syncthreads();
    if (threadIdx.x == 0) {
        unsigned* bar = b.bar;
        __builtin_amdgcn_s_waitcnt(0);
        unsigned nloc = b.st[0], nx = b.st[1];
        if (nloc == 0u) { xcd_barrier_complete(bar, b.x, nloc, nx); b.st[0] = nloc; b.st[1] = nx; }
        const unsigned old = xb_add(&bar[XB_XSUB(b.x)], 1u);
        const unsigned gen = old / nloc;
        if (old + 1u == (gen + 1u) * nloc) {
            __builtin_amdgcn_fence(__ATOMIC_RELEASE, "agent");
            asm volatile("s_waitcnt vmcnt(0)" ::: "memory");
            const unsigned og = xb_add(&bar[XB_TOP], 1u);
            const unsigned tg = og / nx;
            if (og + 1u == (tg + 1u) * nx) xb_add(&bar[XB_TOPGEN], 1u);
            else XB_SPIN(xb_ld(&bar[XB_TOPGEN]) == tg, bar);
            __builtin_amdgcn_fence(__ATOMIC_ACQUIRE, "agent");
            xb_add(&bar[XB_XGEN(b.x)], 1u);
            asm volatile("s_waitcnt vmcnt(0)" ::: "memory");
        } else {
            XB_SPIN(xb_ld(&bar[XB_XGEN(b.x)]) == gen, bar);
            __builtin_amdgcn_fence(__ATOMIC_ACQUIRE, "agent");
            asm volatile("s_waitcnt vmcnt(0)" ::: "memory");
        }
    }
    __syncthreads();
}

constexpr int LDS_BYTES = 147456;
constexpr int LDS_BARST = LDS_BYTES - 64;
#if defined(__HIP_DEVICE_COMPILE__)
#define PHASE_PARAMS() ({ const __attribute__((address_space(4))) Params* q_ = (const __attribute__((address_space(4))) Params*)__builtin_amdgcn_kernarg_segment_ptr(); asm volatile("" : "+s"(q_)); *q_; })
#else
#define PHASE_PARAMS() (pk)
#endif
#define PHASE(call) do { const Params p = PHASE_PARAMS(); call; } while (0)
__global__ void __launch_bounds__(NTHREADS, 2) fwd_kernel(Params pk) {
    extern __shared__ __attribute__((aligned(16))) unsigned char lds_raw[];
    float* lds = (float*)lds_raw;
    cg::grid_group grid = cg::this_grid();
    const int vb = blockIdx.x, nvb = gridDim.x;
    if (threadIdx.x < 16) ((LAS unsigned*)(lds_raw + LDS_BARST))[threadIdx.x] = 0u;
    __syncthreads();
    const XcdBarrier bar = xcd_barrier_post((unsigned*)(pk.ws + OFF_CTL), (volatile LAS unsigned*)(lds_raw + LDS_BARST));
#define GRID_BAR() xcd_barrier(bar)
    PHASE(phase0(p, vb, nvb));
    PHASE(transpose_p0(p, lds, vb, nvb));
    grid.sync();
    PHASE(phase1_fast(p, lds_raw, vb, nvb));
    GRID_BAR();
    PHASE(phase2_fast(p, (char*)lds_raw, vb, nvb));
    GRID_BAR();
    PHASE(phase2b(p, vb, nvb));
    GRID_BAR();
    PHASE(phase3a_fast(p, lds_raw, vb, nvb));
    GRID_BAR();
    PHASE(phase3b_fast(p, lds_raw, vb, nvb));
    GRID_BAR();
    PHASE(phase4a(p, lds, vb, nvb));
    GRID_BAR();
    PHASE(phase4b_fast(p, lds, vb, nvb));
    GRID_BAR();
    PHASE(phase4c(p, vb, nvb));
    GRID_BAR();
    PHASE(phase5a_fast(p, lds_raw, vb, nvb));
    GRID_BAR();
    PHASE(phase5b_fast(p, lds_raw, vb, nvb));
    GRID_BAR();
    PHASE(phase6(p, vb, nvb));
}

extern "C" void kernel_launch(void* const* d_in, const int* in_sizes, int n_in, void* d_out, int out_size, void* d_ws, size_t ws_size, hipStream_t stream) {
    static int grid_blocks = 0;
    if (grid_blocks == 0) {
        if (n_in != 20 || in_sizes[0] != MREAL * DM || out_size != MREAL * DM || ws_size < 256 * MiB) {
            fprintf(stderr, "kernel_launch: unexpected shapes: n_in %d in0 %d out %d ws %zu\n", n_in, n_in > 0 ? in_sizes[0] : -1, out_size, ws_size); grid_blocks = -1; return; }
        int dev = 0, cus = 0, per_cu = 0;
        (void)hipGetDevice(&dev); (void)hipDeviceGetAttribute(&cus, hipDeviceAttributeMultiprocessorCount, dev);
        if (hipFuncSetAttribute((const void*)fwd_kernel, hipFuncAttributeMaxDynamicSharedMemorySize, LDS_BYTES) != hipSuccess) { fprintf(stderr, "kernel_launch: hipFuncSetAttribute failed\n"); grid_blocks = -1; return; }
        if (hipOccupancyMaxActiveBlocksPerMultiprocessor(&per_cu, (const void*)fwd_kernel, NTHREADS, LDS_BYTES) != hipSuccess || per_cu < 1) { fprintf(stderr, "kernel_launch: occupancy query failed (%d)\n", per_cu); grid_blocks = -1; return; }
        grid_blocks = cus * per_cu;
    }
    if (grid_blocks < 0) return;
    if (hipMemsetAsync((char*)d_ws + OFF_CTL, 0, CTL_WORDS * 4, stream) != hipSuccess) { fprintf(stderr, "kernel_launch: memset failed\n"); return; }
    Params p{};
    p.x = (const float*)d_in[0]; p.meta = (const float*)d_in[1]; p.g_mix = (const float*)d_in[2]; p.w_in = (const float*)d_in[3];
    p.lq1 = (const float*)d_in[4]; p.lk1 = (const float*)d_in[5]; p.lq2 = (const float*)d_in[6]; p.lk2 = (const float*)d_in[7];
    p.g_subln = (const float*)d_in[8]; p.g_qnorm = (const float*)d_in[9]; p.g_knorm = (const float*)d_in[10];
    p.w_ba = (const float*)d_in[11]; p.w_bb = (const float*)d_in[12]; p.w_out = (const float*)d_in[13]; p.g_ffn = (const float*)d_in[14];
    p.w_router = (const float*)d_in[15]; p.w_gate = (const float*)d_in[16]; p.w_up = (const float*)d_in[17]; p.w_down = (const float*)d_in[18]; p.g_final = (const float*)d_in[19];
    p.out = (float*)d_out; p.ws = (unsigned char*)d_ws;
    void* args[] = {&p};
    hipError_t e = hipLaunchCooperativeKernel((const void*)fwd_kernel, dim3(grid_blocks), dim3(NTHREADS), args, LDS_BYTES, stream);
    if (e != hipSuccess) fprintf(stderr, "kernel_launch: cooperative launch failed: %s (grid %d)\n", hipGetErrorString(e), grid_blocks);
}
```

```cpp
#include <hip/hip_runtime.h>
#include <hip/hip_cooperative_groups.h>
#include <cstdio>
#include <cstdint>
namespace cg = cooperative_groups;

typedef unsigned short bf16_t;
typedef float f32x4 __attribute__((ext_vector_type(4)));
typedef unsigned u32x2 __attribute__((ext_vector_type(2)));
typedef unsigned u32x4 __attribute__((ext_vector_type(4)));

constexpr int NB = 2, SEQ = 8192, DM = 1024, NMETA = 16, LTOT = SEQ + NMETA;
constexpr int MREAL = NB * SEQ;
constexpr int MROWS = MREAL + NB * NMETA;
constexpr int MPAD = 16640;
constexpr int INW = 6656;
constexpr int KEYS = 8256;
constexpr int QROWS = 8256;
constexpr int NEXP = 16, EFF = 512, CAP = 1026, ESLOTS = NB * CAP;
constexpr float EPS = 1e-6f;
constexpr float LOG2E = 1.4426950408889634f;
constexpr float CA = 0.125f * LOG2E;
constexpr float CB = 0.08838834764831845f * LOG2E;
constexpr float LAM_INIT = 0.2f;
constexpr int NTHREADS = 512;
constexpr int AOP = 2048;
__device__ const float INVF[32] = {1.000000000e+00f, 7.498942614e-01f, 5.623413324e-01f, 4.216965139e-01f, 3.162277639e-01f, 2.371373773e-01f, 1.778279394e-01f, 1.333521307e-01f,
    1.000000015e-01f, 7.498941571e-02f, 5.623413250e-02f, 4.216965288e-02f, 3.162277490e-02f, 2.371373773e-02f, 1.778279431e-02f, 1.333521493e-02f,
    9.999999776e-03f, 7.498941850e-03f, 5.623413250e-03f, 4.216964822e-03f, 3.162277630e-03f, 2.371373586e-03f, 1.778279431e-03f, 1.333521446e-03f,
    1.000000047e-03f, 7.498942432e-04f, 5.623413017e-04f, 4.216965172e-04f, 3.162277571e-04f, 2.371373703e-04f, 1.778279402e-04f, 1.333521504e-04f};

constexpr size_t MiB = 1u << 20;
constexpr size_t OFF_ROPE = 0;
constexpr size_t OFF_LAM = 64 * 1024;
constexpr size_t OFF_NRM = 64 * 1024 + 256;
constexpr int XCD_BAR_WORDS = 3456;
constexpr size_t OFF_CTL = 68 * 1024;
constexpr int CTL_WORDS = XCD_BAR_WORDS + 64;
constexpr size_t OFF_QCTR = OFF_CTL + (size_t)XCD_BAR_WORDS * 4;
constexpr size_t OFF_AFF = 128 * 1024;
constexpr size_t OFF_IDX = OFF_AFF + (size_t)NB * NEXP * LTOT * 4 + 256;
constexpr size_t OFF_SEL = OFF_IDX + (size_t)NB * NEXP * CAP * 4 + 256;
constexpr size_t OFF_SGM = OFF_SEL + (size_t)NB * LTOT * NEXP * 4 + 256;
constexpr size_t OFF_H2M = OFF_SGM + 32 * 2048 * 2;
constexpr size_t OFF_SAFF = OFF_H2M + 32 * 1024 * 4;
constexpr size_t OFF_MISC_END = OFF_SAFF + (size_t)NEXP * ESLOTS * 4;
static_assert(OFF_MISC_END <= 4 * MiB, "misc region");
constexpr size_t OFF_WIN = 4 * MiB;
constexpr size_t OFF_WAB = OFF_WIN + (size_t)INW * DM * 2;
constexpr size_t OFF_WO = OFF_WAB + (size_t)DM * 2048 * 2;
static_assert(OFF_WO + (size_t)DM * DM * 2 <= 24 * MiB, "weights region");
constexpr size_t OFF_AO = 24 * MiB;
constexpr size_t SZ_ROWS = (size_t)MPAD * DM * 2;
constexpr size_t OFF_UN = OFF_AO;
constexpr size_t OFF_HID = OFF_AO + SZ_ROWS;
static_assert((size_t)(NEXP * ESLOTS + 256) * EFF * 2 <= SZ_ROWS, "HID overlay");
constexpr size_t OFF_ATT = OFF_AO + 2 * SZ_ROWS;
constexpr size_t SZ_QH = (size_t)NB * 8 * QROWS * 128 * 2;
constexpr size_t SZ_KVB = (size_t)NB * 2 * KEYS * 128 * 2;
constexpr size_t OFF_QA = OFF_ATT, OFF_KA = OFF_QA + SZ_QH, OFF_VA = OFF_KA + SZ_QH, OFF_QB = OFF_VA + SZ_QH, OFF_KB = OFF_QB + SZ_QH, OFF_VB = OFF_KB + SZ_KVB;
constexpr size_t OFF_ATT_END = OFF_VB + SZ_KVB;
static_assert(OFF_ATT_END <= 256 * MiB, "workspace");
constexpr size_t OFF_MERGED = OFF_ATT;
constexpr size_t OFF_WGU = OFF_ATT + 33 * MiB;
constexpr size_t OFF_WD = OFF_WGU + 32 * MiB;
constexpr size_t OFF_XS = OFF_WD + 16 * MiB;
constexpr size_t OFF_YB = OFF_XS;
static_assert(SZ_ROWS <= 33 * MiB && OFF_XS + (size_t)(NEXP * ESLOTS + 256) * DM * 2 <= 256 * MiB, "overlay map");

struct Params {
    const float *x, *meta, *g_mix, *w_in, *lq1, *lk1, *lq2, *lk2, *g_subln, *g_qnorm, *g_knorm, *w_ba, *w_bb, *w_out, *g_ffn, *w_router, *w_gate, *w_up, *w_down, *g_final;
    float* out; unsigned char* ws;
};

__device__ __forceinline__ int TID() { int t = threadIdx.x; asm volatile("" : "+v"(t)); return t; }
__device__ __forceinline__ unsigned f2bf(float f) { unsigned u = __builtin_bit_cast(unsigned, f); return (u + 0x7fffu + ((u >> 16) & 1u)) >> 16; }
__device__ __forceinline__ float bf2f(unsigned h) { return __builtin_bit_cast(float, h << 16); }
__device__ __forceinline__ float wave_sum(float v) {
#pragma unroll
    for (int o = 1; o < 64; o <<= 1) v += __shfl_xor(v, o);
    return v;
}
__device__ __forceinline__ float wave_max(float v) {
#pragma unroll
    for (int o = 1; o < 64; o <<= 1) v = fmaxf(v, __shfl_xor(v, o));
    return v;
}
struct RowInfo { int b, t, meta, valid; };
__device__ __forceinline__ RowInfo row_decode(int r) {
    RowInfo ri;
    if (r < MREAL) { ri.b = r >> 13; ri.t = r & (SEQ - 1); ri.meta = 0; ri.valid = 1; }
    else if (r < MROWS) { ri.b = (r - MREAL) >> 4; ri.t = (r - MREAL) & 15; ri.meta = 1; ri.valid = 1; }
    else { ri.b = 0; ri.t = 0; ri.meta = 1; ri.valid = 0; }
    return ri;
}
__device__ __forceinline__ int row_key(const RowInfo& ri) { return ri.meta ? ri.t : 64 + ri.t; }
__device__ __forceinline__ int row_q(const RowInfo& ri) { return ri.meta ? SEQ + ri.t : ri.t; }
__device__ __forceinline__ int row_pos(const RowInfo& ri) { return ri.meta ? ri.t : NMETA + ri.t; }
__device__ __forceinline__ int pos_row(int b, int pos) { return pos < NMETA ? MREAL + b * NMETA + pos : b * SEQ + (pos - NMETA); }
__device__ __forceinline__ const float* h_row(const Params& p, int r) { RowInfo ri = row_decode(r); return ri.meta ? p.meta + (size_t)ri.t * DM : p.x + (size_t)r * DM; }

__device__ __forceinline__ void phase0(const Params& p, int vb, int nvb) {
    const int tid = TID(), lane = tid & 63, wave = tid >> 6;
    const int gt = vb * NTHREADS + tid;
    if (gt < 128 * 32) {
        const int pos = gt >> 5, j = gt & 31;
        const float ang = (float)pos * INVF[j];
        const double xd = (double)ang, kq = __builtin_rint(xd * 0.15915494309189535);
        const double rr = (xd - kq * 6.283185307179586) * 0.25, r2 = rr * rr;
        double sn = 1.0 / 1307674368000.0, cn = 1.0 / 87178291200.0;
        sn = sn * r2 * -1.0 + 1.0 / 6227020800.0; cn = cn * r2 * -1.0 + 1.0 / 479001600.0;
        sn = sn * r2 * -1.0 + 1.0 / 39916800.0;   cn = cn * r2 * -1.0 + 1.0 / 3628800.0;
        sn = sn * r2 * -1.0 + 1.0 / 362880.0;     cn = cn * r2 * -1.0 + 1.0 / 40320.0;
        sn = sn * r2 * -1.0 + 1.0 / 5040.0;       cn = cn * r2 * -1.0 + 1.0 / 720.0;
        sn = sn * r2 * -1.0 + 1.0 / 120.0;        cn = cn * r2 * -1.0 + 1.0 / 24.0;
        sn = sn * r2 * -1.0 + 1.0 / 6.0;          cn = cn * r2 * -1.0 + 0.5;
        sn = (sn * r2 * -1.0 + 1.0) * rr;         cn = cn * r2 * -1.0 + 1.0;
        double s2 = 2.0 * sn * cn, c2 = cn * cn - sn * sn;
        double s4 = 2.0 * s2 * c2, c4 = c2 * c2 - s2 * s2;
        float2 cs; cs.x = (float)c4; cs.y = (float)s4;
        ((float2*)(p.ws + OFF_ROPE))[gt] = cs;
    }
    if (vb == 0 && tid < 128) ((unsigned*)(p.ws + OFF_NRM))[tid] = 0u;
    if (vb == 0 && wave == 0) {
        float a = p.lq1[lane] * p.lk1[lane], c = p.lq2[lane] * p.lk2[lane];
        a = wave_sum(a); c = wave_sum(c);
        if (lane == 0) *(float*)(p.ws + OFF_LAM) = expf(a) - expf(c) + LAM_INIT;
    }
    bf16_t* UN = (bf16_t*)(p.ws + OFF_UN);
    for (int r0 = vb * 8 + wave; r0 < MPAD; r0 += nvb * 8 * 2) {
        f32x4 v[2][4];
#pragma unroll
        for (int h = 0; h < 2; ++h) { const int r = r0 + h * nvb * 8;
            if (r < MROWS) { const f32x4* xr = (const f32x4*)h_row(p, r) + lane;
#pragma unroll
                for (int j = 0; j < 4; ++j) v[h][j] = xr[64 * j]; }
            else {
#pragma unroll
                for (int j = 0; j < 4; ++j) v[h][j] = (f32x4){0.f, 0.f, 0.f, 0.f}; } }
#pragma unroll
        for (int h = 0; h < 2; ++h) { const int r = r0 + h * nvb * 8; if (r >= MPAD) continue;
            float s = 0.f;
#pragma unroll
            for (int j = 0; j < 4; ++j) s += (v[h][j].x * v[h][j].x + v[h][j].y * v[h][j].y) + (v[h][j].z * v[h][j].z + v[h][j].w * v[h][j].w);
            const float rstd = 1.0f / sqrtf(wave_sum(s) * (1.0f / DM) + EPS);
            u32x2* o = (u32x2*)(UN + (size_t)r * DM) + lane;
#pragma unroll
            for (int j = 0; j < 4; ++j) { const f32x4 g = ((const f32x4*)p.g_mix)[lane + 64 * j];
                u32x2 w; w.x = f2bf(v[h][j].x * rstd * g.x) | (f2bf(v[h][j].y * rstd * g.y) << 16); w.y = f2bf(v[h][j].z * rstd * g.z) | (f2bf(v[h][j].w * rstd * g.w) << 16);
                o[64 * j] = w; } }
    }
    {
        bf16_t* KA = (bf16_t*)(p.ws + OFF_KA); bf16_t* VA = (bf16_t*)(p.ws + OFF_VA); bf16_t* KB = (bf16_t*)(p.ws + OFF_KB); bf16_t* VB = (bf16_t*)(p.ws + OFF_VB);
        const int per = 48 * 128 / 8;
        for (int i = vb * NTHREADS + tid; i < (16 + 16 + 4 + 4) * per; i += nvb * NTHREADS) {
            const int bh = i / per, o = i % per; bf16_t* base;
            if (bh < 16) base = KA + (size_t)bh * KEYS * 128; else if (bh < 32) base = VA + (size_t)(bh - 16) * KEYS * 128;
            else if (bh < 36) base = KB + (size_t)(bh - 32) * KEYS * 128; else base = VB + (size_t)(bh - 36) * KEYS * 128;
            ((u32x4*)(base + 16 * 128))[o] = (u32x4){0u, 0u, 0u, 0u};
        }
    }
}

namespace fa {
using bf16x8 = __attribute__((ext_vector_type(8))) short;
using s16x4  = __attribute__((ext_vector_type(4))) short;
using f32x16 = __attribute__((ext_vector_type(16))) float;
constexpr int NT = KEYS / 64;
constexpr int SLOT = 16384;
constexpr int NSLOT = 4;
constexpr int L_V = 0, L_K = NSLOT * SLOT, L_WS = 2 * NSLOT * SLOT, L_X = 0;
constexpr int LDS_ATTN = L_WS + 8 * 64 * 4;
constexpr float THR = 8.f;
#define KSWZ(row, colB) ((row) * 256 + ((colB) ^ (((row) & 7) << 4)))
#define SBAR() __builtin_amdgcn_sched_barrier(0)
__device__ __forceinline__ int crow(int r, int hi) { return (r & 3) + 8 * (r >> 2) + 4 * hi; }
__device__ __forceinline__ unsigned cvtpk(float lo, float hi) { unsigned r; asm volatile("v_cvt_pk_bf16_f32 %0, %1, %2" : "=v"(r) : "v"(lo), "v"(hi)); return r; }
__device__ __forceinline__ void partialSM(f32x16& p0, f32x16& p1, float& m_reg, float& mn, float& alpha) {
    float pmax = p0[0];
#pragma unroll
    for (int r = 1; r < 16; ++r) pmax = fmaxf(pmax, p0[r]);
#pragma unroll
    for (int r = 0; r < 16; ++r) pmax = fmaxf(pmax, p1[r]);
    { auto rr = __builtin_amdgcn_permlane32_swap(__float_as_uint(pmax), __float_as_uint(pmax), false, false);
      pmax = fmaxf(__uint_as_float(rr[0]), __uint_as_float(rr[1])); }
    if (__builtin_expect(__all(pmax - m_reg <= THR), 1)) { mn = m_reg; alpha = 1.f; }
    else { mn = fmaxf(m_reg, pmax); alpha = __builtin_amdgcn_exp2f(m_reg - mn); m_reg = mn; }
#pragma unroll
    for (int r = 0; r < 16; ++r) { p0[r] -= mn; p1[r] -= mn; }
#pragma unroll
    for (int r = 0; r < 16; ++r) p0[r] = __builtin_amdgcn_exp2f(p0[r]);
}
__device__ __forceinline__ void finishSM(f32x16& p0, f32x16& p1, float alpha, float& l_reg, bf16x8& pa0, bf16x8& pa1, bf16x8& pa2, bf16x8& pa3) {
#pragma unroll
    for (int r = 0; r < 16; ++r) p1[r] = __builtin_amdgcn_exp2f(p1[r]);
    float ps = 0;
#pragma unroll
    for (int r = 0; r < 16; ++r) ps += p0[r];
#pragma unroll
    for (int r = 0; r < 16; ++r) ps += p1[r];
    { auto rr = __builtin_amdgcn_permlane32_swap(__float_as_uint(ps), __float_as_uint(ps), false, false);
      ps = __uint_as_float(rr[0]) + __uint_as_float(rr[1]); }
    l_reg = l_reg * alpha + ps;
#define PK4(P, BASE, OUT) do { unsigned a0 = cvtpk(P[BASE + 0], P[BASE + 1]), a1 = cvtpk(P[BASE + 2], P[BASE + 3]);   \
    unsigned b0 = cvtpk(P[BASE + 4], P[BASE + 5]), b1 = cvtpk(P[BASE + 6], P[BASE + 7]);                              \
    auto r0 = __builtin_amdgcn_permlane32_swap(a0, b0, false, false); auto r1 = __builtin_amdgcn_permlane32_swap(a1, b1, false, false); \
    u32x4 w = {r0[0], r1[0], r0[1], r1[1]}; OUT = *reinterpret_cast<bf16x8*>(&w); } while (0)
    PK4(p0, 0, pa0); PK4(p0, 8, pa1); PK4(p1, 0, pa2); PK4(p1, 8, pa3);
#undef PK4
}
template <int ND0>
__device__ __forceinline__ void qkt(f32x16& p0, f32x16& p1, const char* Ks, const bf16x8* qr, int d0b, int r32, int hi) {
    p0 = f32x16{}; p1 = f32x16{};
#pragma unroll
    for (int d0 = 0; d0 < ND0; ++d0) { const int cb = ((d0b + d0) * 16 + hi * 8) * 2;
        const bf16x8 b0 = *reinterpret_cast<const bf16x8*>(Ks + KSWZ(r32, cb));
        const bf16x8 b1 = *reinterpret_cast<const bf16x8*>(Ks + KSWZ(32 + r32, cb));
        p0 = __builtin_amdgcn_mfma_f32_32x32x16_bf16(b0, qr[d0], p0, 0, 0, 0);
        p1 = __builtin_amdgcn_mfma_f32_32x32x16_bf16(b1, qr[d0], p1, 0, 0, 0); }
}
__device__ __forceinline__ int v_st(int k, int c) { const int kk = (k & ~0xC) | ((k & 4) << 1) | ((k & 8) >> 1); return ((kk >> 3) * 4 + (c >> 5)) * 512 + ((kk & 7) * 32 + (c & 31)) * 2; }
__device__ __forceinline__ int v_rd_base(int lane) { return ((lane & 3) << 3) | (((lane >> 2) & 3) << 6) | (((lane >> 4) & 1) << 5) | (((lane >> 5) & 1) << 8); }
constexpr int v_rd_off(int d0, int ks, int half) { return d0 * 512 + ks * 4096 + half * 2048; }
template <int OFF> __device__ __forceinline__ s16x4 tr_read(int vb) {
    s16x4 r; asm volatile("ds_read_b64_tr_b16 %0, %1 offset:%2" : "=&v"(r) : "v"(vb), "i"(OFF) : "memory"); return r;
}
template <int D0> __device__ __forceinline__ void pv_one(f32x16& od, int vb, bf16x8 pa0, bf16x8 pa1, bf16x8 pa2, bf16x8 pa3) {
    const s16x4 l0 = tr_read<v_rd_off(D0, 0, 0)>(vb), h0 = tr_read<v_rd_off(D0, 0, 1)>(vb), l1 = tr_read<v_rd_off(D0, 1, 0)>(vb), h1 = tr_read<v_rd_off(D0, 1, 1)>(vb);
    const s16x4 l2 = tr_read<v_rd_off(D0, 2, 0)>(vb), h2 = tr_read<v_rd_off(D0, 2, 1)>(vb), l3 = tr_read<v_rd_off(D0, 3, 0)>(vb), h3 = tr_read<v_rd_off(D0, 3, 1)>(vb);
    asm volatile("s_waitcnt lgkmcnt(0)" ::: "memory"); SBAR();
#define PK(L, H) (bf16x8){L[0], L[1], L[2], L[3], H[0], H[1], H[2], H[3]}
    od = __builtin_amdgcn_mfma_f32_32x32x16_bf16(pa0, PK(l0, h0), od, 0, 0, 0);
    od = __builtin_amdgcn_mfma_f32_32x32x16_bf16(pa1, PK(l1, h1), od, 0, 0, 0);
    od = __builtin_amdgcn_mfma_f32_32x32x16_bf16(pa2, PK(l2, h2), od, 0, 0, 0);
    od = __builtin_amdgcn_mfma_f32_32x32x16_bf16(pa3, PK(l3, h3), od, 0, 0, 0);
#undef PK
}
__device__ __forceinline__ void pv_d0(f32x16* o, int vb, bf16x8 pa0, bf16x8 pa1, bf16x8 pa2, bf16x8 pa3) {
    pv_one<0>(o[0], vb, pa0, pa1, pa2, pa3); pv_one<1>(o[1], vb, pa0, pa1, pa2, pa3); pv_one<2>(o[2], vb, pa0, pa1, pa2, pa3); pv_one<3>(o[3], vb, pa0, pa1, pa2, pa3);
}

__device__ __forceinline__ void glds16(const void* gsrc, unsigned lds_dst) { unsigned keep;
    asm volatile("s_mov_b32 %0, m0\n\ts_mov_b32 m0, %2\n\ts_nop 0\n\tglobal_load_lds_dwordx4 %1, off\n\ts_mov_b32 m0, %0" : "=&s"(keep) : "v"(gsrc), "s"(lds_dst) : "memory"); }
#define WAIT_BAR() asm volatile("s_waitcnt vmcnt(0) lgkmcnt(0)\n\ts_barrier" ::: "memory")
#define WAIT_BAR4() asm volatile("s_waitcnt vmcnt(4) lgkmcnt(0)\n\ts_barrier" ::: "memory")
template <bool DIFF>
__device__ __forceinline__ void attn_unit(const bf16x8 (&qr)[DIFF ? 4 : 8], const bf16_t* __restrict__ Kh, const bf16_t* __restrict__ Vh, int tq, float slopeL, char* lds, int t0, int t1, bool active,
                                          f32x16 (&o)[4], float& l_reg, float& m_reg) {
    constexpr int ND0 = DIFF ? 4 : 8;
    const int tid = TID(), wid = __builtin_amdgcn_readfirstlane(tid >> 6), lane = tid & 63, r32 = lane & 31, hi = lane >> 5;
    char* V_lds = lds + L_V; char* K_lds = lds + L_K;
    float* al_l = (float*)(lds + L_WS) + wid * 64 + 32;
    const int d0b = DIFF ? (wid >> 2) * 4 : 0;
    m_reg = -1e30f; l_reg = 0.f;
#pragma unroll
    for (int d = 0; d < 4; ++d) o[d] = f32x16{};
    const char* ksrc; const char* vsrc;
    { const int row = 4 * wid + (lane >> 4), colB = ((lane & 15) * 16) ^ ((row & 7) << 4);
      ksrc = (const char*)Kh + row * 256 + colB;
      const int sub = 2 * wid + (lane >> 5), kk = (sub >> 2) * 8 + ((lane & 31) >> 2), col = (sub & 3) * 32 + (lane & 3) * 8, k = (kk & ~0xC) | ((kk & 4) << 1) | ((kk & 8) >> 1);
      vsrc = (const char*)Vh + k * 256 + col * 2; }
    const unsigned lds0 = (unsigned)(uintptr_t)lds;
    const unsigned kdst = lds0 + L_K + wid * 1024, vdst = lds0 + L_V + wid * 1024;
#define DMA_TILE(t, slot) do { const size_t to_ = (size_t)(t) * SLOT; const unsigned kd_ = (unsigned)__builtin_amdgcn_readfirstlane(kdst + (slot)), vd_ = (unsigned)__builtin_amdgcn_readfirstlane(vdst + (slot)); \
    glds16(ksrc + to_, kd_); glds16(ksrc + to_ + 8192, kd_ + 8192); glds16(vsrc + to_, vd_); glds16(vsrc + to_ + 8192, vd_ + 8192); } while (0)
    const int vb0 = (int)(uintptr_t)V_lds + v_rd_base(lane);
#define RESC(a) do { if (__any((a) < 1.f)) { if (hi == 0) al_l[r32] = (a); asm volatile("s_waitcnt lgkmcnt(0)" ::: "memory"); \
    _Pragma("unroll") for (int d = 0; d < 4; ++d) _Pragma("unroll") for (int r = 0; r < 16; ++r) o[d][r] *= al_l[crow(r, hi)]; } } while (0)
#define MASK0(P0, P1) do { _Pragma("unroll") for (int r = 8; r < 16; ++r) P0[r] = -1e30f; _Pragma("unroll") for (int r = 0; r < 16; ++r) P1[r] = -1e30f; } while (0)
#define FIXUP(P0, P1, j) do { if (DIFF) { const float base_ = (float)(tq - ((j) - 1) * 64 - 4 * hi); \
    _Pragma("unroll") for (int r = 0; r < 16; ++r) { const float d_ = base_ - (float)((r & 3) + 8 * (r >> 2)); \
        P0[r] = fmaf(-slopeL, fabsf(d_), P0[r]); P1[r] = fmaf(-slopeL, fabsf(d_ - 32.f), P1[r]); } } } while (0)
#define ROT() do { prv = cur; cur = nxt; nxt = nx2; nx2 = (nx2 == (NSLOT - 1) * SLOT) ? 0 : nx2 + SLOT; } while (0)
    f32x16 pA0, pA1, pB0, pB1; float mnA = 0.f, mnB = 0.f, alA = 1.f, alB = 1.f; bf16x8 pa0, pa1, pa2, pa3;
    int prv = 0, cur = 0, nxt = SLOT, nx2 = 2 * SLOT;
    DMA_TILE(t0, 0); DMA_TILE(t0 + 1, SLOT);
    WAIT_BAR4();
    DMA_TILE(t0 + 2, 2 * SLOT);
    if (active) { qkt<ND0>(pA0, pA1, K_lds, qr, d0b, r32, hi); if (t0 == 0) MASK0(pA0, pA1); else FIXUP(pA0, pA1, t0); partialSM(pA0, pA1, m_reg, mnA, alA); }
    WAIT_BAR4(); ROT();
    for (int j = t0 + 1; j + 1 < t1; j += 2) {
        if (j + 2 < t1) DMA_TILE(j + 2, nx2);
        if (active) { SBAR(); qkt<ND0>(pB0, pB1, K_lds + cur, qr, d0b, r32, hi); FIXUP(pB0, pB1, j);
            finishSM(pA0, pA1, alA, l_reg, pa0, pa1, pa2, pa3); SBAR();
            pv_d0(o, vb0 + prv, pa0, pa1, pa2, pa3); partialSM(pB0, pB1, m_reg, mnB, alB);
            RESC(alB); }
        if (j + 2 < t1) WAIT_BAR4(); else WAIT_BAR();
        ROT();
        if (j + 3 < t1) DMA_TILE(j + 3, nx2);
        if (active) { SBAR(); qkt<ND0>(pA0, pA1, K_lds + cur, qr, d0b, r32, hi); FIXUP(pA0, pA1, j + 1);
            finishSM(pB0, pB1, alB, l_reg, pa0, pa1, pa2, pa3); SBAR();
            pv_d0(o, vb0 + prv, pa0, pa1, pa2, pa3); partialSM(pA0, pA1, m_reg, mnA, alA);
            RESC(alA); }
        if (j + 3 < t1) WAIT_BAR4(); else WAIT_BAR();
        ROT();
    }
    if (active) {
        finishSM(pA0, pA1, alA, l_reg, pa0, pa1, pa2, pa3); SBAR();
        pv_d0(o, vb0 + prv, pa0, pa1, pa2, pa3);
    }
    WAIT_BAR();
#undef DMA_TILE
#undef RESC
#undef FIXUP
#undef MASK0
#undef ROT
}

namespace fb {
using fa::bf16x8; using fa::s16x4; using fa::f32x16; using fa::crow; using fa::cvtpk; using fa::glds16;
constexpr int SLOT = 16384, KSL = 4, VSL = 3;
constexpr int L_K = 0, L_V = KSL * SLOT, L_WS = L_V + VSL * SLOT, L_END = L_WS + 8 * 64 * 4;
constexpr float THR = 8.f;
constexpr int KPF = 2, VPF = 2;
typedef __attribute__((address_space(3))) const char* lds_cptr;
typedef short v4i16_t __attribute__((ext_vector_type(4)));
#define FB_SBAR() __builtin_amdgcn_sched_barrier(0)
#define FB_PIN(x) asm volatile("" : "+v"(x))
#define FB_MFMA(a, b, c) __builtin_amdgcn_mfma_f32_32x32x16_bf16(a, b, c, 0, 0, 0)
#define FB_WAIT_BAR(N) asm volatile("s_waitcnt vmcnt(" #N ") lgkmcnt(0)\n\ts_barrier" ::: "memory")
#define FB_MX3(a, b, c) __builtin_fmaxf(__builtin_fmaxf((a), (b)), (c))
__device__ __forceinline__ bf16x8 kfrag(lds_cptr kp, int f) { return *(const __attribute__((address_space(3))) bf16x8*)(kp + (f >> 1) * 2048 + (f & 1) * 512); }
__device__ __forceinline__ s16x4 vtr(lds_cptr p) { return __builtin_bit_cast(s16x4, __builtin_amdgcn_ds_read_tr16_b64_v4i16((__attribute__((address_space(3))) v4i16_t*)p)); }
__device__ __forceinline__ float rowmax(const f32x16& p0, const f32x16& p1) {
    float a = FB_MX3(p0[0], p0[1], p1[0]), b = FB_MX3(p0[2], p0[3], p1[1]); a = FB_MX3(a, p1[2], p1[3]);
#pragma unroll
    for (int r = 4; r < 16; r += 4) { a = FB_MX3(a, p0[r], p0[r + 1]); b = FB_MX3(b, p0[r + 2], p0[r + 3]); a = FB_MX3(a, p1[r], p1[r + 1]); b = FB_MX3(b, p1[r + 2], p1[r + 3]); }
    float m = __builtin_fmaxf(a, b); auto rr = __builtin_amdgcn_permlane32_swap(__float_as_uint(m), __float_as_uint(m), false, false);
    return __builtin_fmaxf(__uint_as_float(rr[0]), __uint_as_float(rr[1])); }
__device__ __forceinline__ void split3(float w, unsigned& h1, unsigned& h2, unsigned& h3) {
    h1 = __float_as_uint(w) & 0xffff0000u; const float r1 = w - __uint_as_float(h1);
    h2 = __float_as_uint(r1) & 0xffff0000u; const float r2 = r1 - __uint_as_float(h2);
    h3 = __float_as_uint(r2) & 0xffff0000u; }

template <bool DIFF, bool IDLE = false>
__device__ __forceinline__ void attn_unit(const bf16x8 (&qr)[DIFF ? 4 : 8], const bf16_t* __restrict__ Kh, const bf16_t* __restrict__ Vh, int tq, int wrow0, float slopeL, char* lds,
                                          int tfirst, int tbase, int n, f32x16 (&o)[4], float& l_reg, float& mhat) {
    constexpr bool active = !IDLE;
    constexpr int ND0 = DIFF ? 4 : 8, NQ = 2 * ND0;
    const int tid = TID(), lane = tid & 63, r32 = lane & 31, hi = lane >> 5; const int wid = __builtin_amdgcn_readfirstlane(tid >> 6);
    const unsigned lds0 = (unsigned)(uintptr_t)lds; float* wsf = (float*)(lds + L_WS) + wid * 64;
    const char* ksrc = (const char*)Kh + lane * 256 + wid * 16;
    const char* vsrc = (const char*)Vh + (16 * (wid & 3) + (lane >> 2)) * 256 + (wid >> 2) * 64 + (lane & 3) * 16;
    const unsigned kdst = lds0 + L_K + wid * 1024, vdst = lds0 + L_V + wid * 1024;
#define TILE_OF(i) ((i) == 0 ? tfirst : tbase + (i))
#define DMA_K(i, slot) do { const char* s_ = ksrc + (size_t)TILE_OF(i) * SLOT; const unsigned d_ = (unsigned)__builtin_amdgcn_readfirstlane(kdst + (slot)); glds16(s_, d_); glds16(s_ + 128, d_ + 8192); } while (0)
#define DMA_V(i, slot) do { const char* s_ = vsrc + (size_t)TILE_OF(i) * SLOT; const unsigned d_ = (unsigned)__builtin_amdgcn_readfirstlane(vdst + (slot)); glds16(s_, d_); glds16(s_ + 128, d_ + 8192); } while (0)
    const lds_cptr vp0 = (lds_cptr)lds + L_V + ((lane >> 4) & 1) * 32 + (lane & 3) * 8 + (4 * hi + ((lane & 15) >> 2)) * 64;
    const lds_cptr kp0 = (lds_cptr)lds + L_K + hi * 1024 + r32 * 16 + (DIFF ? (wid >> 2) * 8192 : 0);
    mhat = 0.f; l_reg = 0.f;
#pragma unroll
    for (int d = 0; d < 4; ++d) o[d] = f32x16{};
    const f32x16 zero16 = f32x16{};
    bool resc = false;
    f32x16 pA0, pA1, pB0, pB1; bf16x8 kf[KPF]; s16x4 vlo[VPF], vhi[VPF]; u32x4 pw0, pw1, pw2, pw3;
    bf16x8 kx0 = bf16x8{}, kx1 = bf16x8{}, qx = bf16x8{}; unsigned sl1 = 0, sl2 = 0, sl3 = 0;
    if (DIFF) { if (hi == 0) { const unsigned c0 = __float_as_uint((float)r32) >> 16, c1 = __float_as_uint((float)(32 + r32)) >> 16;
            u32x4 a = {0x3F803F80u, 0x3F80u | (c0 << 16), c0 | (c0 << 16), 0u}, b = {0x3F803F80u, 0x3F80u | (c1 << 16), c1 | (c1 << 16), 0u};
            kx0 = __builtin_bit_cast(bf16x8, a); kx1 = __builtin_bit_cast(bf16x8, b); }
        split3(slopeL, sl1, sl2, sl3); }
#define SIDE_OF(j) ((j) == 0 ? 0 : (64 * ((j) - 1) + 63 <= wrow0) ? 1 : (64 * ((j) - 1) >= wrow0 + 31) ? -1 : 0)
#define BUILD_QX(j) do { if (DIFF) { const int sd_ = SIDE_OF(j); float w_ = -mhat; unsigned sg_ = 0u, keep_ = 0u; \
        if (sd_ != 0) { const float lin_ = slopeL * (float)(tq - 64 * ((j) - 1)); w_ += sd_ > 0 ? -lin_ : lin_; sg_ = sd_ > 0 ? 0u : 0x80000000u; keep_ = 0xffffffffu; } \
        unsigned h1_, h2_, h3_; split3(w_, h1_, h2_, h3_); const unsigned a1_ = (sl1 ^ sg_) & keep_, a2_ = (sl2 ^ sg_) & keep_, a3_ = (sl3 ^ sg_) & keep_; \
        u32x4 q_ = {(h1_ >> 16) | h2_, (h3_ >> 16) | a1_, (a2_ >> 16) | a3_, 0u}; if (hi != 0) q_ = (u32x4){0u, 0u, 0u, 0u}; qx = __builtin_bit_cast(bf16x8, q_); } } while (0)
#define FIXUP(C0, C1, j) do { if ((j) == 0) { _Pragma("unroll") for (int r = 8; r < 16; ++r) C0[r] = -1e30f; _Pragma("unroll") for (int r = 0; r < 16; ++r) C1[r] = -1e30f; } \
        else if (DIFF && SIDE_OF(j) == 0) { const float base_ = (float)(tq - ((j) - 1) * 64 - 4 * hi); \
            _Pragma("unroll") for (int r = 0; r < 16; ++r) { const float d_ = base_ - (float)((r & 3) + 8 * (r >> 2)); \
                C0[r] = fmaf(-slopeL, fabsf(d_), C0[r]); C1[r] = fmaf(-slopeL, fabsf(d_ - 32.f), C1[r]); } } } while (0)
#define PFLAT(P0, P1, e) ((e) < 16 ? P0[(e) & 15] : P1[(e) & 15])
#define PWSET(u, v) do { if ((u) < 4) pw0[(u) & 3] = (v); else if ((u) < 8) pw1[(u) & 3] = (v); else if ((u) < 12) pw2[(u) & 3] = (v); else pw3[(u) & 3] = (v); } while (0)
#define PAF(k) __builtin_bit_cast(bf16x8, (k) == 0 ? pw0 : (k) == 1 ? pw1 : (k) == 2 ? pw2 : pw3)
#define VFR(i) (bf16x8){vlo[i][0], vlo[i][1], vlo[i][2], vlo[i][3], vhi[i][0], vhi[i][1], vhi[i][2], vhi[i][3]}
#define VRD(slotv, f, dst) do { const lds_cptr a_ = vp0 + (slotv) + ((f) >> 2) * 4096 + ((f) & 3) * 1024; vlo[dst] = vtr(a_); vhi[dst] = vtr(a_ + 512); } while (0)
#define AUNIT(P0, P1, u) do { sacc += PFLAT(P0, P1, 2 * (u)); sacc += PFLAT(P0, P1, 2 * (u) + 1); PWSET(u, cvtpk(PFLAT(P0, P1, 2 * (u)), PFLAT(P0, P1, 2 * (u) + 1))); } while (0)
#define EXPU(C0, C1, u) do { if ((u) < 8) { C0[2 * ((u) & 7)] = __builtin_amdgcn_exp2f(C0[2 * ((u) & 7)] - sub_); C0[2 * ((u) & 7) + 1] = __builtin_amdgcn_exp2f(C0[2 * ((u) & 7) + 1] - sub_); } \
        else { C1[2 * ((u) & 7)] = __builtin_amdgcn_exp2f(C1[2 * ((u) & 7)] - sub_); C1[2 * ((u) & 7) + 1] = __builtin_amdgcn_exp2f(C1[2 * ((u) & 7) + 1] - sub_); } } while (0)
#define STEP(C0, C1, P0, P1, i, GK, GV, GL) do { \
    const int j_ = TILE_OF(i); const lds_cptr kp_ = kp0 + kcur; const lds_cptr kn_ = kp0 + knxt; \
    if (active) { BUILD_QX(j_); FB_SBAR(); float sacc = 0.f; \
        if (DIFF) { C0 = FB_MFMA(kx0, qx, zero16); AUNIT(P0, P1, 0); FB_PIN(sacc); FB_PIN(pw0); FB_SBAR(); \
                    C1 = FB_MFMA(kx1, qx, zero16); AUNIT(P0, P1, 1); AUNIT(P0, P1, 2); FB_PIN(sacc); FB_PIN(pw0); FB_SBAR(); } \
        _Pragma("unroll") for (int g = 0; g < NQ; ++g) { \
            if (g & 1) C1 = FB_MFMA(kf[g % KPF], qr[g >> 1], (!DIFF && g < 2) ? zero16 : C1); else C0 = FB_MFMA(kf[g % KPF], qr[g >> 1], (!DIFF && g < 2) ? zero16 : C0); \
            if (g + KPF < NQ) kf[g % KPF] = kfrag(kp_, g + KPF); \
            if (DIFF) { if (g < 5) { AUNIT(P0, P1, 3 + 2 * g); AUNIT(P0, P1, 4 + 2 * g); } else AUNIT(P0, P1, 8 + g); } else AUNIT(P0, P1, g); \
            if (g >= NQ - VPF) VRD(vprv, g - (NQ - VPF), g - (NQ - VPF)); \
            FB_PIN(sacc); FB_PIN(pw0); FB_PIN(pw1); FB_PIN(pw2); FB_PIN(pw3); FB_SBAR(); } \
        l_reg += sacc; } \
    if (GK) DMA_K((i) + 3, kfree); if (GV) DMA_V((i) + 1, vnxt); \
    float sub_ = 0.f; \
    if (active) { FIXUP(C0, C1, j_); \
        { const float rm = rowmax(C0, C1) - (DIFF ? 0.f : mhat); resc = false; \
          if (__builtin_expect(__any(rm > THR), 0)) { const float dl = __builtin_fmaxf(rm, 0.f); mhat += dl; \
              if (DIFF) { _Pragma("unroll") for (int r = 0; r < 16; ++r) { C0[r] -= dl; C1[r] -= dl; } } \
              const float f = __builtin_amdgcn_exp2f(-dl); l_reg *= f; if (hi == 0) wsf[r32] = f; resc = true; } } \
        sub_ = DIFF ? 0.f : mhat; FB_SBAR(); \
        _Pragma("unroll") for (int g = 0; g < 16; ++g) { \
            o[g >> 2] = FB_MFMA(PAF(g & 3), VFR(g % VPF), o[g >> 2]); \
            if (g + VPF < 16) VRD(vprv, g + VPF, g % VPF); \
            EXPU(C0, C1, g); \
            if ((GL) && g >= 4 && g < 4 + KPF) kf[g - 4] = kfrag(kn_, g - 4); \
            FB_PIN(C0); FB_PIN(C1); FB_SBAR(); } } \
    } while (0)
#define RESC() do { if (active && resc) { _Pragma("unroll") for (int d_ = 0; d_ < 4; ++d_) _Pragma("unroll") for (int r = 0; r < 16; ++r) o[d_][r] *= wsf[crow(r, hi)]; } } while (0)
    int kcur = 0, knxt = SLOT, kfree = 3 * SLOT, vprv = 0, vnxt = SLOT;
#define ROT() do { kfree = kcur; kcur = knxt; knxt = (knxt == (KSL - 1) * SLOT) ? 0 : knxt + SLOT; vprv = (vnxt == 0) ? (VSL - 1) * SLOT : vnxt - SLOT; vnxt = (vnxt == (VSL - 1) * SLOT) ? 0 : vnxt + SLOT; } while (0)
    DMA_K(0, 0); DMA_V(0, 0); DMA_K(1, SLOT); DMA_K(2, 2 * SLOT);
    FB_WAIT_BAR(6);
    if (n > 3) DMA_K(3, 3 * SLOT);
    DMA_V(1, SLOT);
    if (active) { const int j0 = tfirst; BUILD_QX(j0);
        if (DIFF) { pA0 = FB_MFMA(kx0, qx, zero16); pA1 = FB_MFMA(kx1, qx, zero16); }
#pragma unroll
        for (int g = 0; g < NQ; ++g) { const bf16x8 kk = kfrag(kp0, g);
            if (g & 1) pA1 = FB_MFMA(kk, qr[g >> 1], (!DIFF && g < 2) ? zero16 : pA1); else pA0 = FB_MFMA(kk, qr[g >> 1], (!DIFF && g < 2) ? zero16 : pA0); }
        FIXUP(pA0, pA1, j0);
        const float rm = rowmax(pA0, pA1); mhat = rm;
#pragma unroll
        for (int r = 0; r < 16; ++r) { pA0[r] = __builtin_amdgcn_exp2f(pA0[r] - rm); pA1[r] = __builtin_amdgcn_exp2f(pA1[r] - rm); } }
    if (n > 3) FB_WAIT_BAR(4); else FB_WAIT_BAR(2);
    kcur = SLOT; knxt = 2 * SLOT; kfree = 0; vprv = 0; vnxt = 2 * SLOT;
    if (active) {
#pragma unroll
        for (int g = 0; g < KPF; ++g) kf[g] = kfrag(kp0 + kcur, g); }
    int i = 1;
    for (; i + 5 < n; i += 2) {
        STEP(pB0, pB1, pA0, pA1, i, true, true, true);
        FB_WAIT_BAR(4); RESC(); ROT();
        STEP(pA0, pA1, pB0, pB1, i + 1, true, true, true);
        FB_WAIT_BAR(4); RESC(); ROT();
    }
    for (; i + 1 < n; i += 2) {
        STEP(pB0, pB1, pA0, pA1, i, (i + 3 < n), (i + 1 < n), (i + 1 < n));
        if (i + 3 < n) FB_WAIT_BAR(4); else FB_WAIT_BAR(0);
        RESC(); ROT();
        STEP(pA0, pA1, pB0, pB1, i + 1, (i + 4 < n), (i + 2 < n), (i + 2 < n));
        if (i + 4 < n) FB_WAIT_BAR(4); else FB_WAIT_BAR(0);
        RESC(); ROT();
    }
    if (active) { float sacc = 0.f;
#pragma unroll
        for (int u = 0; u < 16; ++u) AUNIT(pA0, pA1, u);
        l_reg += sacc;
#pragma unroll
        for (int g = 0; g < 16; ++g) { VRD(vprv, g, 0); o[g >> 2] = FB_MFMA(PAF(g & 3), VFR(0), o[g >> 2]); } }
    FB_WAIT_BAR(0);
#undef TILE_OF
#undef DMA_K
#undef DMA_V
#undef SIDE_OF
#undef BUILD_QX
#undef FIXUP
#undef PFLAT
#undef PWSET
#undef PAF
#undef VFR
#undef VRD
#undef AUNIT
#undef EXPU
#undef STEP
#undef RESC
#undef ROT
}
}

template <class RowPtr>
__device__ __forceinline__ void store_tile(const f32x16 (&y)[4], char* stage, int lane, RowPtr rowptr) {
    const int r32 = lane & 31, hi = lane >> 5;
    bf16_t* stg = (bf16_t*)stage;
#pragma unroll
    for (int r = 0; r < 16; ++r) { const int orow = crow(r, hi);
#pragma unroll
        for (int d0 = 0; d0 < 4; ++d0) stg[orow * 136 + d0 * 32 + r32] = (bf16_t)f2bf(y[d0][r]); }
    asm volatile("s_waitcnt lgkmcnt(0)" ::: "memory");
#pragma unroll
    for (int i = 0; i < 8; ++i) { const int row = i * 4 + (lane >> 4), ch = lane & 15;
        const u32x4 v = *(const u32x4*)(stg + row * 136 + ch * 8);
        bf16_t* gp = rowptr(row); if (gp) *(u32x4*)(gp + ch * 8) = v; }
    asm volatile("s_waitcnt lgkmcnt(0)" ::: "memory");
}
}

constexpr int NPRB = 4 * 9 * 2 + 16 * 9;
constexpr size_t OFF_PART = (OFF_ATT_END + 255) / 256 * 256;
constexpr size_t OFF_PML = OFF_PART + (size_t)NPRB * 32 * 128 * 4;
static_assert(OFF_PML + NPRB * 32 * 2 * 4 <= 256 * MiB, "meta partials");
constexpr int NRANGE = 9;
__device__ __forceinline__ void meta_range(int r, int& t0, int& t1) { t0 = 15 * r; t1 = r == NRANGE - 1 ? fa::NT : 15 * (r + 1); }

__device__ __forceinline__ void phase2_fast(const Params& p, char* lds, int vb, int nvb) {
    using namespace fa;
    const int tid = TID(), wid = __builtin_amdgcn_readfirstlane(tid >> 6), lane0 = tid & 63;
#define WS_() ({ unsigned char* w_ = p.ws; asm volatile("" : "+s"(w_)); w_; })
#define LSUM2(l) do { auto rr_ = __builtin_amdgcn_permlane32_swap(__float_as_uint(l), __float_as_uint(l), false, false); l = __uint_as_float(rr_[0]) + __uint_as_float(rr_[1]); } while (0)
    for (int v = vb; v < 256; v += nvb) {
        const int xcd = v & 7, slot = v >> 3;
        if (v < 36 + 144) {
            f32x16 o[4]; float l_reg, m_reg; bf16x8 qr[8]; int t0, t1, rb; bool active;
            const int r32q = lane0 & 31, hiq = lane0 >> 5;
            if (v < 36) { const int g = v / NRANGE, rg = v % NRANGE, b = g >> 1, kvh = g & 1; meta_range(rg, t0, t1);
                active = wid < 2; const int h = kvh * 4 + (wid & 1) * 2 + (r32q >> 4);
                unsigned char* ws = WS_(); const bf16_t *QB = (const bf16_t*)(ws + OFF_QB), *KB = (const bf16_t*)(ws + OFF_KB), *VB = (const bf16_t*)(ws + OFF_VB);
                const bf16_t* q = QB + ((size_t)(b * 8 + h) * QROWS + SEQ + (r32q & 15)) * 128 + hiq * 8;
#pragma unroll
                for (int d0 = 0; d0 < 8; ++d0) qr[d0] = *reinterpret_cast<const bf16x8*>(q + d0 * 16);
                const size_t kvo = (size_t)(b * 2 + kvh) * KEYS * 128; rb = (g * NRANGE + rg) * 2 + (wid & 1);
                if (active) fb::attn_unit<false, false>(qr, KB + kvo, VB + kvo, 0, 0, 0.f, lds, t0, t0, t1 - t0, o, l_reg, m_reg); else fb::attn_unit<false, true>(qr, KB + kvo, VB + kvo, 0, 0, 0.f, lds, t0, t0, t1 - t0, o, l_reg, m_reg);
            } else { const int bh = (v - 36) / NRANGE, rg = (v - 36) % NRANGE; meta_range(rg, t0, t1);
                active = wid == 0; const int mp = r32q >> 4;
                unsigned char* ws = WS_(); const bf16_t *QA = (const bf16_t*)(ws + OFF_QA), *KA = (const bf16_t*)(ws + OFF_KA), *VA = (const bf16_t*)(ws + OFF_VA);
                const bf16_t* q = QA + ((size_t)bh * QROWS + SEQ + (r32q & 15)) * 128 + mp * 64 + hiq * 8;
#pragma unroll
                for (int d0 = 0; d0 < 8; ++d0) { const bf16x8 x = *reinterpret_cast<const bf16x8*>(q + (d0 & 3) * 16); qr[d0] = ((d0 >> 2) == mp) ? x : bf16x8{}; }
                const size_t kvo = (size_t)bh * KEYS * 128; rb = 72 + bh * NRANGE + rg;
                if (active) fb::attn_unit<false, false>(qr, KA + kvo, VA + kvo, 0, 0, 0.f, lds, t0, t0, t1 - t0, o, l_reg, m_reg); else fb::attn_unit<false, true>(qr, KA + kvo, VA + kvo, 0, 0, 0.f, lds, t0, t0, t1 - t0, o, l_reg, m_reg);
            }
            if (active) {
                int lane = lane0; asm volatile("" : "+v"(lane));
                const int r32 = lane & 31, hi = lane >> 5;
                LSUM2(l_reg);
                unsigned char* ws = WS_(); float* PART = (float*)(ws + OFF_PART); float* PML = (float*)(ws + OFF_PML);
                float* po = PART + (size_t)rb * 32 * 128;
#pragma unroll
                for (int r = 0; r < 16; ++r)
#pragma unroll
                    for (int d = 0; d < 4; ++d) po[crow(r, hi) * 128 + d * 32 + r32] = o[d][r];
                if (hi == 0) { PML[(rb * 32 + r32) * 2] = m_reg; PML[(rb * 32 + r32) * 2 + 1] = l_reg; }
            }
            __syncthreads();
        }
    }
    for (int v = vb; v < 256; v += nvb) {
        const int xcd = v & 7, slot = v >> 3;
        for (int k = 0; k < 2; ++k) {
            f32x16 o[4]; float l_reg, m_reg;
            {
                const int b = xcd >> 2, kvh = (xcd >> 1) & 1, h = kvh * 4 + (xcd & 1) * 2 + k, bh = b * 8 + h, qb = slot;
                { bf16x8 qr[8]; const int r32q = lane0 & 31, hiq = lane0 >> 5;
                  unsigned char* ws = WS_(); const bf16_t *QB = (const bf16_t*)(ws + OFF_QB), *KB = (const bf16_t*)(ws + OFF_KB), *VB = (const bf16_t*)(ws + OFF_VB);
                  const bf16_t* q = QB + ((size_t)bh * QROWS + qb * 256 + wid * 32 + r32q) * 128 + hiq * 8;
#pragma unroll
                  for (int d0 = 0; d0 < 8; ++d0) qr[d0] = *reinterpret_cast<const bf16x8*>(q + d0 * 16);
                  const size_t kvo = (size_t)(b * 2 + kvh) * KEYS * 128;
                  fb::attn_unit<false>(qr, KB + kvo, VB + kvo, 0, 0, 0.f, lds, 0, 0, NT, o, l_reg, m_reg); }
                int lane = lane0; asm volatile("" : "+v"(lane));
                const int r32 = lane & 31, hi = lane >> 5;
                LSUM2(l_reg);
                float* li_l = (float*)(lds + fb::L_WS) + wid * 64;
                if (hi == 0) li_l[r32] = l_reg;
                asm volatile("s_waitcnt lgkmcnt(0)" ::: "memory");
#pragma unroll
                for (int r = 0; r < 16; ++r) { const float rl = __builtin_amdgcn_rcpf(li_l[crow(r, hi)]);
#pragma unroll
                    for (int d = 0; d < 4; ++d) o[d][r] *= rl; }
                const int wave_row0 = qb * 256 + wid * 32;
                bf16_t* OB = (bf16_t*)(WS_() + OFF_AO) + 1024;
                store_tile(o, lds + wid * 8704, lane, [&](int row) -> bf16_t* { return OB + (size_t)(b * SEQ + wave_row0 + row) * AOP + h * 128; });
                __syncthreads();
            }
        }
    }
    for (;;) {
                f32x16 o[4]; float l_reg, m_reg;
                const int tid = TID(), lane0 = tid & 63;
                __syncthreads();
                if (tid == 0) ((volatile int*)(lds + fb::L_WS + 2048))[0] = (int)atomicAdd((unsigned*)(WS_() + OFF_QCTR), 1u);
                __syncthreads();
                const int uq = __builtin_amdgcn_readfirstlane(((volatile int*)(lds + fb::L_WS + 2048))[0]);
                if (uq >= 1024) break;
                const int h = 7 - (uq >> 7), b = (uq >> 6) & 1, qb = uq & 63, bh = b * 8 + h, mp = wid >> 2, wq = wid & 3;
                int jlo, nvis;
                { const float* nq = (const float*)(WS_() + OFF_NRM) + (b * 8 + h) * 4; const float* nk = nq + 64;
                  const float B0 = sqrtf(nq[0] * nk[0]) + sqrtf(nq[1] * nk[1]), B1 = sqrtf(nq[2] * nk[2]) + sqrtf(nq[3] * nk[3]);
                  const float Bm = 1.02f * fmaxf(B0, B1), slopeC = exp2f(-(float)(h + 1)) * LOG2E;
                  const float dc = fminf((2.f * Bm + 160.f) / slopeC, 16384.f); const int dcut = (int)dc;
                  int lo = qb * 128 - dcut; lo = lo < 0 ? 0 : lo; int hi_ = qb * 128 + 127 + dcut; hi_ = hi_ > SEQ - 1 ? SEQ - 1 : hi_;
                  jlo = 1 + (lo >> 6); int jhi = 1 + (hi_ >> 6); nvis = jhi - jlo + 2;
                  if ((nvis & 1) == 0) { if (jhi < NT - 1) ++jhi; else --jlo; ++nvis; }
                  if (nvis < 3) { jlo = jlo > 1 ? jlo - 1 : jlo; nvis = 3; } }
                { bf16x8 qr[4]; const int r32q = lane0 & 31, hiq = lane0 >> 5; const int qrow = qb * 128 + wq * 32 + r32q;
                  unsigned char* ws = WS_(); const bf16_t *QA = (const bf16_t*)(ws + OFF_QA), *KA = (const bf16_t*)(ws + OFF_KA), *VA = (const bf16_t*)(ws + OFF_VA);
                  const bf16_t* q = QA + ((size_t)bh * QROWS + qrow) * 128 + mp * 64 + hiq * 8;
#pragma unroll
                  for (int d0 = 0; d0 < 4; ++d0) qr[d0] = *reinterpret_cast<const bf16x8*>(q + d0 * 16);
                  const float slopeL = exp2f(-(float)(h + 1)) * LOG2E;
                  const size_t kvo = (size_t)bh * KEYS * 128;
                  fb::attn_unit<true>(qr, KA + kvo, VA + kvo, qrow, qb * 128 + wq * 32, slopeL, lds, 0, jlo - 1, nvis, o, l_reg, m_reg); }
                int lane = lane0; asm volatile("" : "+v"(lane));
                const int r32 = lane & 31, hi = lane >> 5;
                LSUM2(l_reg);
                float* li_l = (float*)(lds + fb::L_WS) + wid * 64;
                if (hi == 0) li_l[r32] = l_reg;
                asm volatile("s_waitcnt lgkmcnt(0)" ::: "memory");
#pragma unroll
                for (int r = 0; r < 16; ++r) { const float rl = __builtin_amdgcn_rcpf(li_l[crow(r, hi)]);
#pragma unroll
                    for (int d = 0; d < 4; ++d) o[d][r] *= rl; }
                float* X = (float*)lds + wq * 4096;
                if (mp == 1) {
#pragma unroll
                    for (int r = 0; r < 16; ++r)
#pragma unroll
                        for (int d = 0; d < 4; ++d) X[(r * 4 + d) * 64 + lane] = o[d][r];
                }
                __syncthreads();
                if (mp == 0) {
                    const float lam = *(const float*)(WS_() + OFF_LAM);
                    float ss[16];
#pragma unroll
                    for (int r = 0; r < 16; ++r) { float a = 0.f;
#pragma unroll
                        for (int d = 0; d < 4; ++d) { const float y = o[d][r] - lam * X[(r * 4 + d) * 64 + lane]; o[d][r] = y; a += y * y; }
                        ss[r] = a; }
#pragma unroll
                    for (int r = 0; r < 16; ++r) {
                        float a = ss[r];
                        a += __shfl_xor(a, 1); a += __shfl_xor(a, 2); a += __shfl_xor(a, 4); a += __shfl_xor(a, 8); a += __shfl_xor(a, 16);
                        ss[r] = 1.0f / sqrtf(a * (1.0f / 128.f) + EPS) * (1.0f - LAM_INIT);
                    }
                    float g[4];
#pragma unroll
                    for (int d = 0; d < 4; ++d) g[d] = p.g_subln[d * 32 + r32];
#pragma unroll
                    for (int r = 0; r < 16; ++r)
#pragma unroll
                        for (int d = 0; d < 4; ++d) o[d][r] *= ss[r] * g[d];
                }
                __syncthreads();
                if (mp == 0) {
                    const int wave_row0 = qb * 128 + wq * 32;
                    bf16_t* OA = (bf16_t*)(WS_() + OFF_AO);
                    store_tile(o, lds + wid * 8704, lane, [&](int row) -> bf16_t* { return OA + (size_t)(b * SEQ + wave_row0 + row) * AOP + h * 128; });
                }
                __syncthreads();
    }
#undef LSUM2
#undef WS_
}
__device__ __forceinline__ void phase2b(const Params& p, int vb, int nvb) {
    const int tid = TID(), lane = tid & 63, wave = tid >> 6;
    const float* PART = (const float*)(p.ws + OFF_PART); const float* PML = (const float*)(p.ws + OFF_PML);
    bf16_t* OA = (bf16_t*)(p.ws + OFF_AO); bf16_t* OB = OA + 1024;
    const float lam = *(const float*)(p.ws + OFF_LAM);
    for (int t = vb * 8 + wave; t < 512; t += nvb * 8) {
        const int type = t >> 8, b = (t >> 7) & 1, h = (t >> 4) & 7, i = t & 15;
        float y0 = 0.f, y1 = 0.f;
        for (int mp = 0; mp < (type == 0 ? 1 : 2); ++mp) {
            int rb0, row;
            if (type == 0) { const int kvh = h >> 2, w = (h & 3) >> 1; rb0 = ((b * 2 + kvh) * NRANGE) * 2 + w; row = (h & 1) * 16 + i; }
            else { rb0 = 72 + (b * 8 + h) * NRANGE; row = mp * 16 + i; }
            const int rbs = type == 0 ? 2 : 1;
            float M = -1e30f;
            for (int r = 0; r < NRANGE; ++r) M = fmaxf(M, PML[((rb0 + r * rbs) * 32 + row) * 2]);
            float L = 0.f, a0 = 0.f, a1 = 0.f;
            for (int r = 0; r < NRANGE; ++r) { const int rb = rb0 + r * rbs; const float w = exp2f(PML[(rb * 32 + row) * 2] - M);
                L += PML[(rb * 32 + row) * 2 + 1] * w; const float2 ov = *(const float2*)(PART + ((size_t)rb * 32 + row) * 128 + 2 * lane); a0 += ov.x * w; a1 += ov.y * w; }
            const float sgn = mp == 0 ? 1.f : -lam;
            y0 += sgn * a0 / L; y1 += sgn * a1 / L;
        }
        const size_t grow = (size_t)(MREAL + b * NMETA + i);
        if (type == 0) ((unsigned*)(OB + grow * AOP + h * 128))[lane] = f2bf(y0) | (f2bf(y1) << 16);
        else { const float ss = wave_sum(y0 * y0 + y1 * y1); const float rstd = 1.0f / sqrtf(ss * (1.0f / 128.f) + EPS) * (1.0f - LAM_INIT);
            ((unsigned*)(OA + grow * AOP + h * 128))[lane] = f2bf(y0 * rstd * p.g_subln[2 * lane]) | (f2bf(y1 * rstd * p.g_subln[2 * lane + 1]) << 16); }
    }
}

__device__ __forceinline__ float* h2_row(const Params& p, int grow) { return grow < MREAL ? p.out + (size_t)grow * DM : (float*)(p.ws + OFF_H2M) + (size_t)(grow - MREAL) * DM; }
__device__ __forceinline__ void phase4a(const Params& p, float* lds, int vb, int nvb) {
    const int tid = TID(), lane = tid & 63, wave = tid >> 6;
    for (int idx = tid; idx < DM * NEXP; idx += NTHREADS) { const int k = idx >> 4, e = idx & 15; lds[(((k >> 4) * 4 + ((k >> 2) & 3)) * 16 + e) * 4 + (k & 3)] = p.g_ffn[k] * p.w_router[idx]; }
    __syncthreads();
    bf16_t* U2 = (bf16_t*)(p.ws + OFF_UN); float* AFF = (float*)(p.ws + OFF_AFF);
    const int ri_ = lane & 15, q = lane >> 4;
    f32x4 gl[4];
#pragma unroll
    for (int c = 0; c < 4; ++c) gl[c] = *(const f32x4*)(p.g_ffn + 16 * lane + 4 * c);
    for (int t = wave * nvb + vb; t < MROWS / 16; t += 8 * nvb) {
        const int R0 = t * 16;
        const float* xrow = h2_row(p, R0 + ri_) + 4 * q;
        f32x4 acc = (f32x4){0.f, 0.f, 0.f, 0.f}; float ss = 0.f;
#pragma unroll 8
        for (int it = 0; it < 64; ++it) {
            const f32x4 x = *(const f32x4*)(xrow + 16 * it); const f32x4 w = *(const f32x4*)(lds + ((it * 4 + q) * 16 + ri_) * 4);
            acc = __builtin_amdgcn_mfma_f32_16x16x4f32(x.x, w.x, acc, 0, 0, 0); acc = __builtin_amdgcn_mfma_f32_16x16x4f32(x.y, w.y, acc, 0, 0, 0);
            acc = __builtin_amdgcn_mfma_f32_16x16x4f32(x.z, w.z, acc, 0, 0, 0); acc = __builtin_amdgcn_mfma_f32_16x16x4f32(x.w, w.w, acc, 0, 0, 0);
            ss += (x.x * x.x + x.y * x.y) + (x.z * x.z + x.w * x.w);
        }
        ss += __shfl_xor(ss, 16); ss += __shfl_xor(ss, 32);
        const float rstd_i = 1.0f / sqrtf(ss * (1.0f / DM) + EPS);
#pragma unroll
        for (int reg = 0; reg < 4; ++reg) {
            const int row = R0 + 4 * q + reg; const float lg = acc[reg] * __shfl(rstd_i, 4 * q + reg);
            float mx = lg; mx = fmaxf(mx, __shfl_xor(mx, 1)); mx = fmaxf(mx, __shfl_xor(mx, 2)); mx = fmaxf(mx, __shfl_xor(mx, 4)); mx = fmaxf(mx, __shfl_xor(mx, 8));
            const float ex = expf(lg - mx); float den = ex; den += __shfl_xor(den, 1); den += __shfl_xor(den, 2); den += __shfl_xor(den, 4); den += __shfl_xor(den, 8);
            const RowInfo ri = row_decode(row);
            AFF[((size_t)ri.b * NEXP + ri_) * LTOT + row_pos(ri)] = ex / den;
        }
        for (int rr = 0; rr < 16; ++rr) {
            const float rs = __shfl(rstd_i, rr); const float* xr = h2_row(p, R0 + rr) + 16 * lane;
            const f32x4 x0 = *(const f32x4*)xr * gl[0] * rs, x1 = *(const f32x4*)(xr + 4) * gl[1] * rs, x2 = *(const f32x4*)(xr + 8) * gl[2] * rs, x3 = *(const f32x4*)(xr + 12) * gl[3] * rs;
            u32x4* o = (u32x4*)(U2 + (size_t)(R0 + rr) * DM + 16 * lane);
            o[0] = (u32x4){f2bf(x0.x) | (f2bf(x0.y) << 16), f2bf(x0.z) | (f2bf(x0.w) << 16), f2bf(x1.x) | (f2bf(x1.y) << 16), f2bf(x1.z) | (f2bf(x1.w) << 16)};
            o[1] = (u32x4){f2bf(x2.x) | (f2bf(x2.y) << 16), f2bf(x2.z) | (f2bf(x2.w) << 16), f2bf(x3.x) | (f2bf(x3.y) << 16), f2bf(x3.z) | (f2bf(x3.w) << 16)};
        }
    }
    __syncthreads();
}

__device__ __forceinline__ void phase6(const Params& p, int vb, int nvb) {
    const int tid = TID(), lane = tid & 63, wave = tid >> 6;
    const int* SEL = (const int*)(p.ws + OFF_SEL); const bf16_t* YB = (const bf16_t*)(p.ws + OFF_YB);
    for (int r = vb * 8 + wave; r < MREAL; r += nvb * 8) {
        const int b = r >> 13, tok = NMETA + (r & (SEQ - 1));
        f32x4* xr = (f32x4*)(p.out + (size_t)r * DM) + lane;
        f32x4 v[4];
#pragma unroll
        for (int j = 0; j < 4; ++j) v[j] = xr[64 * j];
        const int sel = lane < NEXP ? SEL[((size_t)b * LTOT + tok) * NEXP + lane] : -1;
        for (int e = 0; e < NEXP; ++e) {
            const int c = __shfl(sel, e);
            if (c >= 0) {
                const u32x2* y = (const u32x2*)(YB + ((size_t)e * ESLOTS + b * CAP + c) * DM) + lane;
#pragma unroll
                for (int j = 0; j < 4; ++j) { const u32x2 w = y[64 * j]; v[j].x += bf2f(w.x & 0xffffu); v[j].y += bf2f(w.x >> 16); v[j].z += bf2f(w.y & 0xffffu); v[j].w += bf2f(w.y >> 16); }
            }
        }
        float s = 0.f;
#pragma unroll
        for (int j = 0; j < 4; ++j) s += (v[j].x * v[j].x + v[j].y * v[j].y) + (v[j].z * v[j].z + v[j].w * v[j].w);
        const float rstd = 1.0f / sqrtf(wave_sum(s) * (1.0f / DM) + EPS);
#pragma unroll
        for (int j = 0; j < 4; ++j) { const f32x4 g = ((const f32x4*)p.g_final)[lane + 64 * j]; xr[64 * j] = (f32x4){v[j].x * rstd * g.x, v[j].y * rstd * g.y, v[j].z * rstd * g.z, v[j].w * rstd * g.w}; }
    }
}

template <class DstRow>
__device__ __forceinline__ void transpose_item(const float* __restrict__ W, int N, bf16_t* __restrict__ WT, int ldk, int koff, float* scr, int k0, int n0, int lane, DstRow dst) {
#pragma unroll 8
    for (int i = 0; i < 32; ++i) { const int kk = 2 * i + (lane >> 5); scr[kk * 33 + (lane & 31)] = W[(size_t)(k0 + kk) * N + n0 + (lane & 31)]; }
    asm volatile("s_waitcnt vmcnt(0) lgkmcnt(0)" ::: "memory");
    const int c = lane & 7;
#pragma unroll
    for (int j = 0; j < 4; ++j) { const int n = (lane >> 3) + 8 * j; const float* sp = scr + (8 * c) * 33 + n;
        u32x4 o; o.x = f2bf(sp[0 * 33]) | (f2bf(sp[1 * 33]) << 16); o.y = f2bf(sp[2 * 33]) | (f2bf(sp[3 * 33]) << 16);
        o.z = f2bf(sp[4 * 33]) | (f2bf(sp[5 * 33]) << 16); o.w = f2bf(sp[6 * 33]) | (f2bf(sp[7 * 33]) << 16);
        *(u32x4*)(WT + (size_t)dst(n0 + n) * ldk + koff + k0 + 8 * c) = o; }
    asm volatile("s_waitcnt lgkmcnt(0)" ::: "memory");
}
__device__ __forceinline__ int rope_slot(int e) { const int half = e >> 6, el = e & 63, j = el & 31, n = el >> 5, g = half * 8 + (j >> 2); return 32 * (g >> 2) + 8 * (g & 3) + 4 * n + (j & 3); }
__device__ __forceinline__ void transpose_p0(const Params& p, float* lds, int vb, int nvb) {
    const int tid = TID(), lane = tid & 63, wave = tid >> 6;
    float* scr = lds + wave * (64 * 33);
    bf16_t* WIN = (bf16_t*)(p.ws + OFF_WIN); bf16_t* WAB = (bf16_t*)(p.ws + OFF_WAB); bf16_t* WO = (bf16_t*)(p.ws + OFF_WO);
    constexpr int I_IN = 16 * (INW / 32), I_SQ = 16 * 32;
    for (int it = vb * 8 + wave; it < I_IN + 3 * I_SQ; it += nvb * 8) {
        int r = it;
        if (r < I_IN) { const int kb = r / (INW / 32), nb = r % (INW / 32);
            transpose_item(p.w_in, INW, WIN, DM, 0, scr, kb * 64, nb * 32, lane, [](int n) { return (n >= 3072 && n < 4352) ? (n & ~127) + rope_slot(n & 127) : n; }); continue; }
        r -= I_IN; const int m = r / I_SQ, q = r % I_SQ, kb = q / 32, nb = q % 32;
        if (m == 0) transpose_item(p.w_ba, DM, WAB, 2048, 0, scr, kb * 64, nb * 32, lane, [](int n) { return n; });
        else if (m == 1) transpose_item(p.w_bb, DM, WAB, 2048, 1024, scr, kb * 64, nb * 32, lane, [](int n) { return n; });
        else transpose_item(p.w_out, DM, WO, DM, 0, scr, kb * 64, nb * 32, lane, [](int n) { return n; });
    }
}
__device__ __forceinline__ void transpose_moe(const Params& p, float* lds, int vbl, int nvbl) {
    const int tid = TID(), lane = tid & 63, wave = tid >> 6;
    float* scr = lds + wave * (64 * 33);
    bf16_t* WGU = (bf16_t*)(p.ws + OFF_WGU); bf16_t* WD = (bf16_t*)(p.ws + OFF_WD);
    constexpr int I_G = 16 * 16, I_D = 8 * 32, I_E = 2 * I_G + I_D;
    for (int it = vbl * 8 + wave; it < NEXP * I_E; it += nvbl * 8) {
        const int e = it / I_E; int r = it % I_E;
        if (r < 2 * I_G) { const int up = r / I_G, q = r % I_G, kb = q / 16, nb = q % 16;
            const float* W = (up ? p.w_up : p.w_gate) + (size_t)e * DM * EFF;
            transpose_item(W, EFF, WGU + (size_t)e * DM * DM, DM, 0, scr, kb * 64, nb * 32, lane, [up](int f) { return 8 * (f >> 2) + 4 * up + (f & 3); }); }
        else { r -= 2 * I_G; const int kb = r / 32, nb = r % 32;
            transpose_item(p.w_down + (size_t)e * EFF * DM, DM, WD + (size_t)e * DM * EFF, EFF, 0, scr, kb * 64, nb * 32, lane, [](int n) { return n; }); }
    }
}

namespace pg8 {
#define PG8_LAS __attribute__((address_space(3)))
typedef short bf16x8 __attribute__((ext_vector_type(8)));
constexpr int BM = 256, BK = 64, HALF = 128, HTB = HALF * BK * 2, STAGE_BYTES = 8 * HTB, NXCD = 8, WGM = 8;
__host__ __device__ __forceinline__ int lds_byte(int r, int c) { const int st = (r >> 4) * 2 + (c >> 5), rr = r & 15, cc = c & 31, ob = rr * 64 + cc * 2; return st * 1024 + (ob ^ (((ob >> 9) & 1) << 5)); }
__host__ __device__ __forceinline__ void stage_rc(int b, int& R, int& C) { const int st = b / 1024, sb = b % 1024, swz = sb ^ (((sb >> 9) & 1) << 5); R = (st >> 1) * 16 + swz / 64; C = (st & 1) * 32 + (swz % 64) / 2; }
__host__ __device__ __forceinline__ int perm32(int rho) { const int n = rho >> 4, i = rho & 15; return 8 * (i >> 2) + 4 * n + (i & 3); }
struct Unit { int arow0, brow0, pm, pn, e; };
struct Gemm { const bf16_t* A; const bf16_t* Bt; int K; };
struct GridOrder {
    int nM, nN, nwg, G, c;
    __device__ void init(int nM_, int nN_, int G_, int c_) { nM = nM_; nN = nN_; nwg = nM * nN; G = G_; c = c_; }
    __device__ bool next(int i, Unit& u) const {
        const long L = (long)i * G + c; if (L >= nwg) return false;
        int wgid = (int)L; { const int q = nwg / NXCD, r = nwg % NXCD, xcd = wgid % NXCD, off = wgid / NXCD; wgid = (xcd < r ? xcd * (q + 1) : r * (q + 1) + (xcd - r) * q) + off; }
        const int nig = WGM * nN, gid = wgid / nig, fm = gid * WGM, gsz = (nM - fm) < WGM ? (nM - fm) : WGM;
        u.pm = fm + ((wgid % nig) % gsz); u.pn = (wgid % nig) / gsz; u.e = 0; u.arow0 = u.pm * BM; u.brow0 = u.pn * BM; return true;
    }
};
struct MoeOrder {
    int G, c;
    __device__ bool next(int i, Unit& u) const {
        const int L = i * G + c; if (L >= NEXP * 32) return false;
        u.e = L >> 5; const int r = L & 31; u.pm = r & 7; u.pn = r >> 3; u.arow0 = u.e * ESLOTS + u.pm * BM; u.brow0 = u.e * DM + u.pn * BM; return true;
    }
};
__device__ __forceinline__ unsigned cvt_pk_bf16(float lo, float hi) { unsigned r; asm volatile("v_cvt_pk_bf16_f32 %0, %1, %2" : "=v"(r) : "v"(lo), "v"(hi)); return r; }

template <class Epi, class Sched>
__device__ __forceinline__ void gemm_phase(PG8_LAS unsigned char* lds, const Gemm g, const Sched& S, const Epi& E) {
    const int tid = TID(), wid = __builtin_amdgcn_readfirstlane(tid >> 6), lane = tid & 63, wr = wid >> 2, wc = wid & 3, fr = lane & 15, fq = lane >> 4;
    const int K = g.K, nt = K / BK;
    unsigned voffA[2], voffB[2];
#pragma unroll
    for (int i = 0; i < 2; ++i) { int R, C; stage_rc(tid * 16 + i * 8192, R, C); const int Rb = Epi::PERM ? ((R & ~31) + perm32(R & 31)) : R;
        voffA[i] = (unsigned)(R * K + C) * 2u; voffB[i] = (unsigned)(Rb * K + C) * 2u; }
    const size_t kstep = (size_t)(BK * 2);
    const size_t hstep = (size_t)HALF * K * 2;
    const size_t rstep = (size_t)K * 2;
    const unsigned ldsw = (unsigned)wid * 1024u;
    const int aoff = lds_byte(wr * 64 + fr, fq * 8), boff = lds_byte(wc * 32 + fr, fq * 8);
#define PG8_SA(b, h) (((b) * 2 + (h)) * HTB)
#define PG8_SB(b, h) ((4 + (b) * 2 + (h)) * HTB)
#define PG8_STAGE(bufoff, gbase, voff) do { _Pragma("unroll") for (int _i = 0; _i < 2; ++_i) \
        __builtin_amdgcn_global_load_lds((const unsigned*)((const char*)(gbase) + (voff)[_i]), (PG8_LAS unsigned*)(lds + (bufoff) + ldsw + _i * 8192), 16, 0, 0); } while (0)
#define PG8_LDA(dst, b, h) do { _Pragma("unroll") for (int m = 0; m < 4; ++m) _Pragma("unroll") for (int k = 0; k < 2; ++k) dst[m][k] = *(const PG8_LAS bf16x8*)(lds + PG8_SA(b, h) + aoff + m * 2048 + k * 1024); } while (0)
#define PG8_LDB(dst, b, h) do { _Pragma("unroll") for (int n = 0; n < 2; ++n) _Pragma("unroll") for (int k = 0; k < 2; ++k) dst[n][k] = *(const PG8_LAS bf16x8*)(lds + PG8_SB(b, h) + boff + n * 2048 + k * 1024); } while (0)
#define PG8_MMA(ai, bj, At, Bt) do { __builtin_amdgcn_s_setprio(1); _Pragma("unroll") for (int m = 0; m < 4; ++m) _Pragma("unroll") for (int n = 0; n < 2; ++n) _Pragma("unroll") for (int k = 0; k < 2; ++k) \
        acc[ai][bj][m][n] = __builtin_amdgcn_mfma_f32_16x16x32_bf16(Bt[n][k], At[m][k], acc[ai][bj][m][n], 0, 0, 0); __builtin_amdgcn_s_setprio(0); } while (0)
#define PG8_WAIT_V(n) asm volatile("s_waitcnt vmcnt(" #n ")" ::: "memory")
#define PG8_WAIT_L(n) asm volatile("s_waitcnt lgkmcnt(" #n ")" ::: "memory")
#define PG8_BAR __builtin_amdgcn_s_barrier()
#define PG8_SCHED __builtin_amdgcn_sched_barrier(0)
    Unit cur, nxt; int ui = 0;
    if (!S.next(0, cur)) return;
    f32x4 acc[2][2][4][2];
#pragma unroll
    for (int a = 0; a < 2; ++a)
#pragma unroll
        for (int b = 0; b < 2; ++b)
#pragma unroll
            for (int m = 0; m < 4; ++m)
#pragma unroll
                for (int n = 0; n < 2; ++n) acc[a][b][m][n] = (f32x4){0.f, 0.f, 0.f, 0.f};
    bf16x8 At[4][2], B0[2][2], B1[2][2];
    const char* cA = (const char*)g.A + (size_t)cur.arow0 * rstep; const char* cB = (const char*)g.Bt + (size_t)cur.brow0 * rstep;
    PG8_STAGE(PG8_SB(0, 0), cB, voffB); PG8_STAGE(PG8_SB(0, 1), cB + hstep, voffB); PG8_STAGE(PG8_SA(0, 0), cA, voffA); PG8_STAGE(PG8_SA(0, 1), cA + hstep, voffA);
    if (wr == 1) PG8_BAR;
    PG8_WAIT_V(2); PG8_BAR;
    PG8_STAGE(PG8_SB(1, 0), cB + kstep, voffB); PG8_STAGE(PG8_SA(1, 0), cA + kstep, voffA); PG8_STAGE(PG8_SB(1, 1), cB + hstep + kstep, voffB);
    PG8_WAIT_V(6); PG8_BAR;
    for (;;) {
        const bool has_next = S.next(ui + 1, nxt);
        const char* nA = has_next ? (const char*)g.A + (size_t)nxt.arow0 * rstep : cA; const char* nB = has_next ? (const char*)g.Bt + (size_t)nxt.brow0 * rstep : cB;
        for (int t = 0; t < nt; t += 2) {
            const bool last = (t == nt - 2);
            const char* a1 = cA + (size_t)(t + 1) * kstep;
            const char* a2 = last ? nA : cA + (size_t)(t + 2) * kstep; const char* b2 = last ? nB : cB + (size_t)(t + 2) * kstep;
            const char* a3 = a2 + kstep; const char* b3 = b2 + kstep;
            if constexpr (Epi::HAS_MID) { if (t == nt / 2) E.mid(acc, cur, wr, wc, fr, fq); }
            PG8_LDB(B0, 0, 0); PG8_LDB(B1, 0, 1); PG8_SCHED; PG8_LDA(At, 0, 0); PG8_STAGE(PG8_SA(1, 1), a1 + hstep, voffA);
            PG8_WAIT_V(8); PG8_WAIT_L(0); PG8_BAR; PG8_MMA(0, 0, At, B0); PG8_MMA(0, 1, At, B1); PG8_BAR; PG8_SCHED;
            PG8_LDA(At, 0, 1); PG8_STAGE(PG8_SB(0, 0), b2, voffB); PG8_STAGE(PG8_SB(0, 1), b2 + hstep, voffB); PG8_STAGE(PG8_SA(0, 0), a2, voffA);
            PG8_WAIT_V(8); PG8_WAIT_L(0); PG8_BAR; PG8_MMA(1, 0, At, B0); PG8_MMA(1, 1, At, B1); PG8_BAR; PG8_SCHED;
            PG8_LDB(B0, 1, 0); PG8_LDB(B1, 1, 1); PG8_SCHED; PG8_LDA(At, 1, 0); PG8_STAGE(PG8_SA(0, 1), a2 + hstep, voffA);
            PG8_WAIT_V(8); PG8_WAIT_L(0); PG8_BAR; PG8_MMA(0, 0, At, B0); PG8_MMA(0, 1, At, B1); PG8_BAR; PG8_SCHED;
            PG8_LDA(At, 1, 1); PG8_STAGE(PG8_SB(1, 0), b3, voffB); PG8_STAGE(PG8_SB(1, 1), b3 + hstep, voffB); PG8_STAGE(PG8_SA(1, 0), a3, voffA);
            PG8_WAIT_V(8); PG8_WAIT_L(0); PG8_BAR; PG8_MMA(1, 0, At, B0); PG8_MMA(1, 1, At, B1); PG8_BAR; PG8_SCHED;
        }
        if (wr == 0) PG8_BAR;
        E(acc, cur, wr, wc, fr, fq, lds);
        if (!has_next) break;
#pragma unroll
        for (int a = 0; a < 2; ++a)
#pragma unroll
            for (int b = 0; b < 2; ++b)
#pragma unroll
                for (int m = 0; m < 4; ++m)
#pragma unroll
                    for (int n = 0; n < 2; ++n) acc[a][b][m][n] = (f32x4){0.f, 0.f, 0.f, 0.f};
        cur = nxt; cA = nA; cB = nB; ++ui;
        if (wr == 1) PG8_BAR;
    }
    PG8_WAIT_V(0);
    PG8_BAR;
#undef PG8_SA
#undef PG8_SB
#undef PG8_STAGE
#undef PG8_LDA
#undef PG8_LDB
#undef PG8_MMA
#undef PG8_WAIT_V
#undef PG8_WAIT_L
#undef PG8_SCHED
}
#define PG8_FOR_AM _Pragma("unroll") for (int ai = 0; ai < 2; ++ai) _Pragma("unroll") for (int m = 0; m < 4; ++m)
#define PG8_FOR_BJ _Pragma("unroll") for (int bj = 0; bj < 2; ++bj)

struct EpiInProj {
    static constexpr bool PERM = true, HAS_MID = false;
    Params p;
    __device__ __forceinline__ void operator()(f32x4 (&acc)[2][2][4][2], const Unit& u, int wr, int wc, int fr, int fq, PG8_LAS unsigned char* lds) const {
        const int pn = u.pn;
        const int sec = pn < 4 ? 0 : pn < 8 ? 1 : pn < 12 ? 2 : pn < 16 ? 3 : pn == 16 ? 4 : pn == 17 ? 5 : pn < 22 ? 6 : 7;
        const int head0 = (sec == 0 ? pn : sec == 1 ? pn - 4 : sec == 2 ? pn - 8 : sec == 3 ? pn - 12 : sec == 6 ? pn - 18 : sec == 7 ? pn - 22 : 0) * 2;
        const int cl = wc * 32 + fq * 8;
        if (sec == 3 || sec == 4) {
            PG8_LAS float* X = (PG8_LAS float*)(lds + STAGE_BYTES);
            PG8_FOR_AM { PG8_FOR_BJ { const f32x4 a = acc[ai][bj][m][0], b = acc[ai][bj][m][1];
                float ss = (a.x * a.x + a.y * a.y) + (a.z * a.z + a.w * a.w) + (b.x * b.x + b.y * b.y) + (b.z * b.z + b.w * b.w);
                ss += __shfl_xor(ss, 16); ss += __shfl_xor(ss, 32);
                if (fq == 0) X[((ai * 128 + wr * 64 + m * 16 + fr) * 2 + bj) * 4 + wc] = ss; } }
            asm volatile("s_waitcnt lgkmcnt(0)" ::: "memory"); __builtin_amdgcn_s_barrier(); asm volatile("" ::: "memory");
            const int g = wc * 4 + fq, j0 = (g & 7) * 4, e0 = (g >> 3) * 64 + j0;
            const float* gn = sec == 3 ? p.g_qnorm : p.g_knorm;
            const f32x4 g1 = *(const f32x4*)(gn + e0), g2 = *(const f32x4*)(gn + e0 + 32);
            const float sc = sec == 3 ? CB : 1.f;
            const float2* rope = (const float2*)(p.ws + OFF_ROPE);
            PG8_FOR_AM { const int rl = ai * 128 + wr * 64 + m * 16 + fr, grow = u.pm * BM + rl; const RowInfo ri = row_decode(grow);
                f32x4 c4 = (f32x4){1.f, 1.f, 1.f, 1.f}, s4 = (f32x4){0.f, 0.f, 0.f, 0.f};
                if (!ri.meta) { const int pos = (g >> 3) ? (ri.t & 63) : (ri.t >> 6); const f32x4 t0 = *(const f32x4*)(rope + pos * 32 + j0), t1 = *(const f32x4*)(rope + pos * 32 + j0 + 2);
                    c4 = (f32x4){t0.x, t0.z, t1.x, t1.z}; s4 = (f32x4){t0.y, t0.w, t1.y, t1.w}; }
                PG8_FOR_BJ { const f32x4 pq = *(const PG8_LAS f32x4*)(X + (rl * 2 + bj) * 4);
                    const float rstd = 1.0f / sqrtf(((pq.x + pq.y) + (pq.z + pq.w)) * (1.0f / 128.f) + EPS) * sc;
                    const f32x4 x1 = acc[ai][bj][m][0] * g1 * rstd, x2 = acc[ai][bj][m][1] * g2 * rstd;
                    const f32x4 y1 = x1 * c4 - x2 * s4, y2 = x2 * c4 + x1 * s4;
                    if (ri.valid) { const int head = head0 + bj;
                        bf16_t* dst = sec == 3 ? (bf16_t*)(p.ws + OFF_QB) + ((size_t)(ri.b * 8 + head) * QROWS + row_q(ri)) * 128 : (bf16_t*)(p.ws + OFF_KB) + ((size_t)(ri.b * 2 + head) * KEYS + row_key(ri)) * 128;
                        *(u32x2*)(dst + e0) = (u32x2){cvt_pk_bf16(y1.x, y1.y), cvt_pk_bf16(y1.z, y1.w)};
                        *(u32x2*)(dst + e0 + 32) = (u32x2){cvt_pk_bf16(y2.x, y2.y), cvt_pk_bf16(y2.z, y2.w)}; } } }
            return;
        }
        if (sec <= 1 && u.pm < MREAL / BM) {
            const float sc2 = sec == 0 ? CA * CA : 1.f; float mx[2] = {0.f, 0.f};
            PG8_FOR_AM { PG8_FOR_BJ { const f32x4 a = acc[ai][bj][m][0], b = acc[ai][bj][m][1];
                float ss = (a.x * a.x + a.y * a.y) + (a.z * a.z + a.w * a.w) + (b.x * b.x + b.y * b.y) + (b.z * b.z + b.w * b.w);
                ss += __shfl_xor(ss, 16); ss += __shfl_xor(ss, 32); mx[bj] = fmaxf(mx[bj], ss * sc2); } }
            PG8_FOR_BJ { float v = mx[bj]; v = fmaxf(v, __shfl_xor(v, 1)); v = fmaxf(v, __shfl_xor(v, 2)); v = fmaxf(v, __shfl_xor(v, 4)); v = fmaxf(v, __shfl_xor(v, 8));
                if (fr == 0 && fq == 0) atomicMax((unsigned*)(p.ws + OFF_NRM) + ((sec * 2 + (u.pm >> 5)) * 8 + head0 + bj) * 4 + wc, __float_as_uint(v)); }
        }
        PG8_FOR_AM { const int grow = u.pm * BM + ai * 128 + wr * 64 + m * 16 + fr; const RowInfo ri = row_decode(grow);
            if (!ri.valid) continue;
            PG8_FOR_BJ { const int head = head0 + bj; f32x4 a = acc[ai][bj][m][0], b = acc[ai][bj][m][1]; bf16_t* dst;
                if (sec == 0) { dst = (bf16_t*)(p.ws + OFF_QA) + ((size_t)(ri.b * 8 + head) * QROWS + row_q(ri)) * 128; a = a * CA; b = b * CA; }
                else if (sec == 1) dst = (bf16_t*)(p.ws + OFF_KA) + ((size_t)(ri.b * 8 + head) * KEYS + row_key(ri)) * 128;
                else if (sec == 2) dst = (bf16_t*)(p.ws + OFF_VA) + ((size_t)(ri.b * 8 + head) * KEYS + row_key(ri)) * 128;
                else if (sec == 5) dst = (bf16_t*)(p.ws + OFF_VB) + ((size_t)(ri.b * 2 + head) * KEYS + row_key(ri)) * 128;
                else { dst = (grow < MREAL ? (bf16_t*)p.out + (size_t)grow * 2048 : (bf16_t*)(p.ws + OFF_SGM) + (size_t)(grow - MREAL) * 2048) + (sec == 7 ? 1024 : 0) + head * 128;
                    a.x = 1.0f / (1.0f + __expf(-a.x)); a.y = 1.0f / (1.0f + __expf(-a.y)); a.z = 1.0f / (1.0f + __expf(-a.z)); a.w = 1.0f / (1.0f + __expf(-a.w));
                    b.x = 1.0f / (1.0f + __expf(-b.x)); b.y = 1.0f / (1.0f + __expf(-b.y)); b.z = 1.0f / (1.0f + __expf(-b.z)); b.w = 1.0f / (1.0f + __expf(-b.w)); }
                *(u32x4*)(dst + cl) = (u32x4){cvt_pk_bf16(a.x, a.y), cvt_pk_bf16(a.z, a.w), cvt_pk_bf16(b.x, b.y), cvt_pk_bf16(b.z, b.w)}; } }
    }
};
__device__ __forceinline__ f32x4 bf4(u32x2 w) { return (f32x4){bf2f(w.x & 0xffffu), bf2f(w.x >> 16), bf2f(w.y & 0xffffu), bf2f(w.y >> 16)}; }
struct EpiMerge {
    static constexpr bool PERM = true, HAS_MID = true;
    Params p;
    __device__ __forceinline__ const bf16_t* sg(int grow) const { return grow < MREAL ? (const bf16_t*)p.out + (size_t)grow * 2048 : (const bf16_t*)(p.ws + OFF_SGM) + (size_t)(grow - MREAL) * 2048; }
    __device__ __forceinline__ void mid(f32x4 (&acc)[2][2][4][2], const Unit& u, int wr, int wc, int fr, int fq) const {
        PG8_FOR_AM { const int grow = u.pm * BM + ai * 128 + wr * 64 + m * 16 + fr; if (grow >= MROWS) continue; const bf16_t* s = sg(grow) + u.pn * BM + wc * 32 + fq * 8;
            PG8_FOR_BJ { const u32x4 wa = *(const u32x4*)(s + bj * 128), wb = *(const u32x4*)(s + 1024 + bj * 128);
                const f32x4 b0 = bf4((u32x2){wb.x, wb.y}), b1 = bf4((u32x2){wb.z, wb.w});
                const f32x4 r0 = (f32x4){__builtin_amdgcn_rcpf(b0.x), __builtin_amdgcn_rcpf(b0.y), __builtin_amdgcn_rcpf(b0.z), __builtin_amdgcn_rcpf(b0.w)};
                const f32x4 r1 = (f32x4){__builtin_amdgcn_rcpf(b1.x), __builtin_amdgcn_rcpf(b1.y), __builtin_amdgcn_rcpf(b1.z), __builtin_amdgcn_rcpf(b1.w)};
                acc[ai][bj][m][0] = acc[ai][bj][m][0] * bf4((u32x2){wa.x, wa.y}) * r0;
                acc[ai][bj][m][1] = acc[ai][bj][m][1] * bf4((u32x2){wa.z, wa.w}) * r1; } }
    }
    __device__ __forceinline__ void operator()(f32x4 (&acc)[2][2][4][2], const Unit& u, int wr, int wc, int fr, int fq, PG8_LAS unsigned char*) const {
        bf16_t* MG = (bf16_t*)(p.ws + OFF_MERGED);
        PG8_FOR_AM { const int grow = u.pm * BM + ai * 128 + wr * 64 + m * 16 + fr; if (grow >= MROWS) continue; const int col = u.pn * BM + wc * 32 + fq * 8; const bf16_t* s = sg(grow) + 1024 + col;
            PG8_FOR_BJ { const u32x4 wb = *(const u32x4*)(s + bj * 128);
                const f32x4 a = acc[ai][bj][m][0] * bf4((u32x2){wb.x, wb.y}), b = acc[ai][bj][m][1] * bf4((u32x2){wb.z, wb.w});
                *(u32x4*)(MG + (size_t)grow * DM + col + bj * 128) = (u32x4){cvt_pk_bf16(a.x, a.y), cvt_pk_bf16(a.z, a.w), cvt_pk_bf16(b.x, b.y), cvt_pk_bf16(b.z, b.w)}; } }
    }
};
struct EpiOut {
    static constexpr bool PERM = false, HAS_MID = false;
    Params p;
    __device__ __forceinline__ void operator()(f32x4 (&acc)[2][2][4][2], const Unit& u, int wr, int wc, int fr, int fq, PG8_LAS unsigned char*) const {
        PG8_FOR_AM { const int grow = u.pm * BM + ai * 128 + wr * 64 + m * 16 + fr; if (grow >= MROWS) continue; const int col = u.pn * BM + wc * 32 + fq * 4;
            const float* hr = h_row(p, grow) + col; float* o = h2_row(p, grow) + col;
            PG8_FOR_BJ {
#pragma unroll
                for (int n = 0; n < 2; ++n) *(f32x4*)(o + bj * 128 + n * 16) = *(const f32x4*)(hr + bj * 128 + n * 16) + acc[ai][bj][m][n]; } }
    }
};
struct EpiMoeUp {
    static constexpr bool PERM = true, HAS_MID = false;
    Params p;
    __device__ __forceinline__ void operator()(f32x4 (&acc)[2][2][4][2], const Unit& u, int wr, int wc, int fr, int fq, PG8_LAS unsigned char*) const {
        bf16_t* HID = (bf16_t*)(p.ws + OFF_HID);
        PG8_FOR_AM { const int s = u.pm * BM + ai * 128 + wr * 64 + m * 16 + fr; if (s >= ESLOTS) continue;
            PG8_FOR_BJ { const f32x4 gt = acc[ai][bj][m][0], up = acc[ai][bj][m][1]; const int f0 = (u.pn * BM + bj * 128 + wc * 32 + fq * 8) >> 1;
                const float h0 = gt.x / (1.0f + __expf(-gt.x)) * up.x, h1 = gt.y / (1.0f + __expf(-gt.y)) * up.y, h2 = gt.z / (1.0f + __expf(-gt.z)) * up.z, h3 = gt.w / (1.0f + __expf(-gt.w)) * up.w;
                *(u32x2*)(HID + ((size_t)u.e * ESLOTS + s) * EFF + f0) = (u32x2){cvt_pk_bf16(h0, h1), cvt_pk_bf16(h2, h3)}; } }
    }
};
struct EpiMoeDown {
    static constexpr bool PERM = true, HAS_MID = false;
    Params p;
    __device__ __forceinline__ void operator()(f32x4 (&acc)[2][2][4][2], const Unit& u, int wr, int wc, int fr, int fq, PG8_LAS unsigned char*) const {
        bf16_t* YB = (bf16_t*)(p.ws + OFF_YB); const float* SAFF = (const float*)(p.ws + OFF_SAFF);
        PG8_FOR_AM { const int s = u.pm * BM + ai * 128 + wr * 64 + m * 16 + fr; if (s >= ESLOTS) continue; const float af = SAFF[u.e * ESLOTS + s]; const int col = u.pn * BM + wc * 32 + fq * 8;
            PG8_FOR_BJ { const f32x4 a = acc[ai][bj][m][0] * af, b = acc[ai][bj][m][1] * af;
                *(u32x4*)(YB + ((size_t)u.e * ESLOTS + s) * DM + col + bj * 128) = (u32x4){cvt_pk_bf16(a.x, a.y), cvt_pk_bf16(a.z, a.w), cvt_pk_bf16(b.x, b.y), cvt_pk_bf16(b.z, b.w)}; } }
    }
};
#undef PG8_BAR
}

__device__ __forceinline__ void dot8(const u32x4 w, const u32x4 a, float& acc) {
    acc = fmaf(bf2f(w.x & 0xffffu), bf2f(a.x & 0xffffu), acc); acc = fmaf(bf2f(w.x >> 16), bf2f(a.x >> 16), acc);
    acc = fmaf(bf2f(w.y & 0xffffu), bf2f(a.y & 0xffffu), acc); acc = fmaf(bf2f(w.y >> 16), bf2f(a.y >> 16), acc);
    acc = fmaf(bf2f(w.z & 0xffffu), bf2f(a.z & 0xffffu), acc); acc = fmaf(bf2f(w.z >> 16), bf2f(a.z >> 16), acc);
    acc = fmaf(bf2f(w.w & 0xffffu), bf2f(a.w & 0xffffu), acc); acc = fmaf(bf2f(w.w >> 16), bf2f(a.w >> 16), acc);
}
template <int NI>
__device__ __forceinline__ void dots4(const bf16_t* w, const bf16_t* a0, size_t apitch, int lane, float (&acc)[4]) {
#pragma unroll
    for (int i = 0; i < NI; ++i) { const int k = i * 512 + lane * 8; const u32x4 wv = *(const u32x4*)(w + k);
#pragma unroll
        for (int r = 0; r < 4; ++r) dot8(wv, *(const u32x4*)(a0 + r * apitch + k), acc[r]); }
}
__device__ __forceinline__ void phase3a_meta(const Params& p, int vb, int nvb) {
    const int tid = TID(), lane = tid & 63, wave = tid >> 6;
    const bf16_t* AO = (const bf16_t*)(p.ws + OFF_AO) + (size_t)MREAL * AOP; const bf16_t* WAB = (const bf16_t*)(p.ws + OFF_WAB);
    const bf16_t* SGM = (const bf16_t*)(p.ws + OFF_SGM); bf16_t* MG = (bf16_t*)(p.ws + OFF_MERGED) + (size_t)MREAL * DM;
    for (int t = vb * 8 + wave; t < 1024 * 8; t += nvb * 8) {
        const int c = t >> 3, r0 = (t & 7) * 4;
        float pa[4] = {0.f, 0.f, 0.f, 0.f}, pb[4] = {0.f, 0.f, 0.f, 0.f};
        dots4<2>(WAB + (size_t)c * 2048, AO + (size_t)r0 * AOP, AOP, lane, pa);
        dots4<2>(WAB + (size_t)c * 2048 + 1024, AO + (size_t)r0 * AOP + 1024, AOP, lane, pb);
#pragma unroll
        for (int r = 0; r < 4; ++r) { const float sa = bf2f(SGM[(size_t)(r0 + r) * 2048 + c]), sb = bf2f(SGM[(size_t)(r0 + r) * 2048 + 1024 + c]);
            const float y = wave_sum(sa * pa[r] + sb * pb[r]); if (lane == 0) MG[(size_t)(r0 + r) * DM + c] = (bf16_t)f2bf(y); }
    }
}
__device__ __forceinline__ void phase3b_meta(const Params& p, int vb, int nvb) {
    const int tid = TID(), lane = tid & 63, wave = tid >> 6;
    const bf16_t* MG = (const bf16_t*)(p.ws + OFF_MERGED) + (size_t)MREAL * DM; const bf16_t* WO = (const bf16_t*)(p.ws + OFF_WO); float* H2M = (float*)(p.ws + OFF_H2M);
    for (int t = vb * 8 + wave; t < 1024 * 8; t += nvb * 8) {
        const int c = t >> 3, r0 = (t & 7) * 4;
        float pa[4] = {0.f, 0.f, 0.f, 0.f};
        dots4<2>(WO + (size_t)c * DM, MG + (size_t)r0 * DM, DM, lane, pa);
#pragma unroll
        for (int r = 0; r < 4; ++r) { const float y = wave_sum(pa[r]); if (lane == 0) H2M[(size_t)(r0 + r) * DM + c] = p.meta[(size_t)((r0 + r) & 15) * DM + c] + y; }
    }
}
__device__ __forceinline__ void phase5a_tail(const Params& p, int vb, int nvb) {
    const int tid = TID(), lane = tid & 63, wave = tid >> 6;
    const bf16_t* XS = (const bf16_t*)(p.ws + OFF_XS); const bf16_t* WGU = (const bf16_t*)(p.ws + OFF_WGU); bf16_t* HID = (bf16_t*)(p.ws + OFF_HID);
    for (int t = vb * 8 + wave; t < NEXP * EFF; t += nvb * 8) {
        const int e = t >> 9, f = t & 511; const size_t s0 = (size_t)e * ESLOTS + 2048;
        const bf16_t* wg = WGU + ((size_t)e * DM + 8 * (f >> 2) + (f & 3)) * DM;
        float pg[4] = {0.f, 0.f, 0.f, 0.f}, pu[4] = {0.f, 0.f, 0.f, 0.f};
        dots4<2>(wg, XS + s0 * DM, DM, lane, pg); dots4<2>(wg + 4 * DM, XS + s0 * DM, DM, lane, pu);
#pragma unroll
        for (int r = 0; r < 4; ++r) { const float g = wave_sum(pg[r]), u = wave_sum(pu[r]); if (lane == 0) HID[(s0 + r) * EFF + f] = (bf16_t)f2bf(g / (1.0f + __expf(-g)) * u); }
    }
}
__device__ __forceinline__ void phase5b_tail(const Params& p, int vb, int nvb) {
    const int tid = TID(), lane = tid & 63, wave = tid >> 6;
    const bf16_t* HID = (const bf16_t*)(p.ws + OFF_HID); const bf16_t* WD = (const bf16_t*)(p.ws + OFF_WD); bf16_t* YB = (bf16_t*)(p.ws + OFF_YB); const float* SAFF = (const float*)(p.ws + OFF_SAFF);
    for (int t = vb * 8 + wave; t < NEXP * DM; t += nvb * 8) {
        const int e = t >> 10, c = t & 1023; const size_t s0 = (size_t)e * ESLOTS + 2048;
        float pa[4] = {0.f, 0.f, 0.f, 0.f};
        dots4<1>(WD + ((size_t)e * DM + c) * EFF, HID + s0 * EFF, EFF, lane, pa);
#pragma unroll
        for (int r = 0; r < 4; ++r) { const float y = wave_sum(pa[r]); if (lane == 0) YB[(s0 + r) * DM + c] = (bf16_t)f2bf(y * SAFF[s0 + r]); }
    }
}

__device__ __forceinline__ void phase1_fast(const Params& p, unsigned char* lds_raw, int vb, int nvb) {
    pg8::Gemm g{(const bf16_t*)(p.ws + OFF_UN), (const bf16_t*)(p.ws + OFF_WIN), DM};
    pg8::GridOrder S; S.init(MPAD / 256, INW / 256, nvb, vb);
    pg8::EpiInProj E{p};
    pg8::gemm_phase(( __attribute__((address_space(3))) unsigned char*)lds_raw, g, S, E);
}
__device__ __forceinline__ void phase3a_fast(const Params& p, unsigned char* lds_raw, int vb, int nvb) {
    phase3a_meta(p, vb, nvb);
    pg8::Gemm g{(const bf16_t*)(p.ws + OFF_AO), (const bf16_t*)(p.ws + OFF_WAB), 2048};
    pg8::GridOrder S; S.init(MREAL / 256, DM / 256, nvb, vb);
    pg8::EpiMerge E{p};
    pg8::gemm_phase(( __attribute__((address_space(3))) unsigned char*)lds_raw, g, S, E);
}
__device__ __forceinline__ void phase3b_fast(const Params& p, unsigned char* lds_raw, int vb, int nvb) {
    phase3b_meta(p, vb, nvb);
    pg8::Gemm g{(const bf16_t*)(p.ws + OFF_MERGED), (const bf16_t*)(p.ws + OFF_WO), DM};
    pg8::GridOrder S; S.init(MREAL / 256, DM / 256, nvb, vb);
    pg8::EpiOut E{p};
    pg8::gemm_phase(( __attribute__((address_space(3))) unsigned char*)lds_raw, g, S, E);
}
__device__ __forceinline__ void phase5a_fast(const Params& p, unsigned char* lds_raw, int vb, int nvb) {
    phase5a_tail(p, vb, nvb);
    pg8::Gemm g{(const bf16_t*)(p.ws + OFF_XS), (const bf16_t*)(p.ws + OFF_WGU), DM};
    pg8::MoeOrder S{nvb, vb};
    pg8::EpiMoeUp E{p};
    pg8::gemm_phase(( __attribute__((address_space(3))) unsigned char*)lds_raw, g, S, E);
}
__device__ __forceinline__ void phase5b_fast(const Params& p, unsigned char* lds_raw, int vb, int nvb) {
    phase5b_tail(p, vb, nvb);
    pg8::Gemm g{(const bf16_t*)(p.ws + OFF_HID), (const bf16_t*)(p.ws + OFF_WD), EFF};
    pg8::MoeOrder S{nvb, vb};
    pg8::EpiMoeDown E{p};
    pg8::gemm_phase(( __attribute__((address_space(3))) unsigned char*)lds_raw, g, S, E);
}

__device__ __forceinline__ void phase4b_fast(const Params& p, float* lds, int vb, int nvb) {
    const int tid = TID(), lane = tid & 63, wave = tid >> 6;
    constexpr int NBE = NB * NEXP;
    if (vb >= NBE || nvb <= NBE) { const bool small = nvb <= NBE; transpose_moe(p, lds, small ? vb : vb - NBE, small ? nvb : nvb - NBE); if (!small) return; }
    const float* AFF = (const float*)(p.ws + OFF_AFF); int* IDX = (int*)(p.ws + OFF_IDX); int* SEL = (int*)(p.ws + OFF_SEL);
    unsigned* keys = (unsigned*)lds;
    unsigned* hist = keys + 8448;
    unsigned* sh = hist + 256;
    for (int be = vb; be < NBE; be += nvb) {
        const int b = be / NEXP, e = be % NEXP;
        __syncthreads();
        for (int i = tid; i < LTOT; i += NTHREADS) keys[i] = __float_as_uint(AFF[(size_t)be * LTOT + i]);
        if (tid == 0) { sh[0] = 0u; sh[1] = CAP; }
        __syncthreads();
        for (int pass = 0; pass < 4; ++pass) {
            const int shift = 24 - 8 * pass;
            if (tid < 256) hist[tid] = 0u;
            __syncthreads();
            const unsigned prefix = sh[0], pmask = pass == 0 ? 0u : (0xffffffffu << (shift + 8));
            for (int i = tid; i < LTOT; i += NTHREADS) { const unsigned k = keys[i]; if ((k & pmask) == prefix) atomicAdd(&hist[(k >> shift) & 255u], 1u); }
            __syncthreads();
            if (wave == 0) {
                const unsigned rem = sh[1]; const unsigned c0 = hist[4 * lane], c1 = hist[4 * lane + 1], c2 = hist[4 * lane + 2], c3 = hist[4 * lane + 3];
                const unsigned t = c0 + c1 + c2 + c3; unsigned S = t;
#pragma unroll
                for (int o = 1; o < 64; o <<= 1) { const unsigned v = __shfl_down(S, o); if (lane + o < 64) S += v; }
                const unsigned above = S - t;
                if (S >= rem && above < rem) { unsigned d, r = rem - above;
                    if (c3 >= r) d = 3; else { r -= c3; if (c2 >= r) d = 2; else { r -= c2; if (c1 >= r) d = 1; else { r -= c1; d = 0; } } }
                    sh[0] = prefix | ((4u * lane + d) << shift); sh[1] = r; }
            }
            __syncthreads();
        }
        const unsigned T = sh[0], need_eq = sh[1];
        const int t0 = tid * 17; int cnt_gt = 0, cnt_eq = 0;
        for (int i = 0; i < 17; ++i) { const int tok = t0 + i; if (tok < LTOT) { const unsigned k = keys[tok]; cnt_gt += k > T; cnt_eq += k == T; } }
        int incl = cnt_eq;
#pragma unroll
        for (int o = 1; o < 64; o <<= 1) { const int v = __shfl_up(incl, o); if (lane >= o) incl += v; }
        if (lane == 63) sh[8 + wave] = (unsigned)incl;
        __syncthreads();
        int eq_before = incl - cnt_eq; for (int w = 0; w < wave; ++w) eq_before += (int)sh[8 + w];
        __syncthreads();
        int take_eq = (int)need_eq - eq_before; take_eq = take_eq < 0 ? 0 : (take_eq > cnt_eq ? cnt_eq : take_eq);
        const int mysel = cnt_gt + take_eq;
        incl = mysel;
#pragma unroll
        for (int o = 1; o < 64; o <<= 1) { const int v = __shfl_up(incl, o); if (lane >= o) incl += v; }
        if (lane == 63) sh[8 + wave] = (unsigned)incl;
        __syncthreads();
        int slot = incl - mysel; for (int w = 0; w < wave; ++w) slot += (int)sh[8 + w];
        int eqi = eq_before;
        for (int i = 0; i < 17; ++i) { const int tok = t0 + i; if (tok < LTOT) { const unsigned k = keys[tok];
            bool take = k > T; if (k == T) { take = eqi < (int)need_eq; ++eqi; }
            if (take) { IDX[(size_t)be * CAP + slot] = tok; SEL[((size_t)b * LTOT + tok) * NEXP + e] = slot; ++slot; } else SEL[((size_t)b * LTOT + tok) * NEXP + e] = -1; } }
    }
    __syncthreads();
}
__device__ __forceinline__ void phase4c(const Params& p, int vb, int nvb) {
    const int tid = TID(), lane = tid & 63, wave = tid >> 6;
    const bf16_t* U2 = (const bf16_t*)(p.ws + OFF_UN); bf16_t* XS = (bf16_t*)(p.ws + OFF_XS); const int* IDX = (const int*)(p.ws + OFF_IDX);
    const float* AFF = (const float*)(p.ws + OFF_AFF); float* SAFF = (float*)(p.ws + OFF_SAFF);
    constexpr int NR = NEXP * ESLOTS;
    for (int r0 = (vb * 8 + wave) * 4; r0 < NR; r0 += nvb * 8 * 4) {
        int tok[4], bb[4]; u32x4 v0[4], v1[4];
#pragma unroll
        for (int i = 0; i < 4; ++i) { const int r = r0 + i < NR ? r0 + i : NR - 1; const int e = r / ESLOTS, s = r % ESLOTS; bb[i] = s / CAP; tok[i] = IDX[((size_t)bb[i] * NEXP + e) * CAP + s % CAP]; }
#pragma unroll
        for (int i = 0; i < 4; ++i) { const u32x4* src = (const u32x4*)(U2 + (size_t)pos_row(bb[i], tok[i]) * DM) + lane; v0[i] = src[0]; v1[i] = src[64]; }
#pragma unroll
        for (int i = 0; i < 4; ++i) { const int r = r0 + i; if (r < NR) { u32x4* dst = (u32x4*)(XS + (size_t)r * DM) + lane; dst[0] = v0[i]; dst[64] = v1[i];
            if (lane == 0) SAFF[r] = AFF[((size_t)bb[i] * NEXP + r / ESLOTS) * LTOT + tok[i]]; } }
    }
}

#define LAS __attribute__((address_space(3)))
#define XB_TMO      128
#define XB_XCNT(j)  (256  + 64 * (j))
#define XB_XSUB(j)  (1280 + 64 * (j))
#define XB_XGEN(j)  (2304 + 64 * (j))
#define XB_TOP      3328
#define XB_TOPGEN   3392
#define XB_SPIN_CAP (1u << 22)
__device__ __forceinline__ unsigned xb_ld(unsigned* p)              { return __hip_atomic_load(p, __ATOMIC_RELAXED, __HIP_MEMORY_SCOPE_AGENT); }
__device__ __forceinline__ unsigned xb_add(unsigned* p, unsigned v) { return __hip_atomic_fetch_add(p, v, __ATOMIC_RELAXED, __HIP_MEMORY_SCOPE_AGENT); }
__device__ __forceinline__ unsigned xb_xcc_id() { return (unsigned)__builtin_amdgcn_s_getreg((3 << 11) | 20) & 0xFu; }
#define XB_SPIN(cond, bar) do { unsigned _sp = 0; while (cond) { __builtin_amdgcn_s_sleep(1); \
    if ((++_sp & 255u) == 0u) { if (xb_ld(&(bar)[XB_TMO])) break; if (_sp > XB_SPIN_CAP) { atomicAdd(&(bar)[XB_TMO], 1u); break; } } } } while (0)
struct XcdBarrier { unsigned* bar; unsigned x; volatile LAS unsigned* st; };
__device__ __forceinline__ XcdBarrier xcd_barrier_post(unsigned* bar, volatile LAS unsigned* st) {
    XcdBarrier b; b.bar = bar; b.x = xb_xcc_id(); b.st = st;
    if (threadIdx.x == 0) (void)xb_add(&bar[XB_XCNT(b.x)], 1u);
    return b;
}
__device__ __forceinline__ void xcd_barrier_complete(unsigned* bar, unsigned x, unsigned& nloc, unsigned& nx) {
    const unsigned G = gridDim.x * gridDim.y * gridDim.z;
    unsigned sum, cnt, mine, sp = 0u;
    for (;;) {
        sum = 0u; cnt = 0u; mine = 0u;
#pragma unroll
        for (unsigned j = 0; j < 16; ++j) { const unsigned c = xb_ld(&bar[XB_XCNT(j)]); sum += c; cnt += (c > 0u) ? 1u : 0u; mine = (j == x) ? c : mine; }
        if (sum == G) break;
        __builtin_amdgcn_s_sleep(1);
        if ((++sp & 255u) == 0u) { if (xb_ld(&bar[XB_TMO])) break; if (sp > XB_SPIN_CAP) { atomicAdd(&bar[XB_TMO], 1u); break; } }
    }
    nloc = mine > 0u ? mine : 1u; nx = cnt > 0u ? cnt : 1u;
}
__device__ __forceinline__ void xcd_barrier(const XcdBarrier& b) {
    asm volatile("s_waitcnt vmcnt(0)" ::: "memory");
    __syncthreads();
    if (threadIdx.x == 0) {
        unsigned* bar = b.bar;
        __builtin_amdgcn_s_waitcnt(0);
        unsigned nloc = b.st[0], nx = b.st[1];
        if (nloc == 0u) { xcd_barrier_complete(bar, b.x, nloc, nx); b.st[0] = nloc; b.st[1] = nx; }
        const unsigned old = xb_add(&bar[XB_XSUB(b.x)], 1u);
        const unsigned gen = old / nloc;
        if (old + 1u == (gen + 1u) * nloc) {
            __builtin_amdgcn_fence(__ATOMIC_RELEASE, "agent");
            asm volatile("s_waitcnt vmcnt(0)" ::: "memory");
            const unsigned og = xb_add(&bar[XB_TOP], 1u);
            const unsigned tg = og / nx;
            if (og + 1u == (tg + 1u) * nx) xb_add(&bar[XB_TOPGEN], 1u);
            else XB_SPIN(xb_ld(&bar[XB_TOPGEN]) == tg, bar);
            __builtin_amdgcn_fence(__ATOMIC_ACQUIRE, "agent");
            xb_add(&bar[XB_XGEN(b.x)], 1u);
            asm volatile("s_waitcnt vmcnt(0)" ::: "memory");
        } else {
            XB_SPIN(xb_ld(&bar[XB_XGEN(b.x)]) == gen, bar);
            __builtin_amdgcn_fence(__ATOMIC_ACQUIRE, "agent");
            asm volatile("s_waitcnt vmcnt(0)" ::: "memory");
        }
    }
    __syncthreads();
}

constexpr int LDS_BYTES = 147456;
constexpr int LDS_BARST = LDS_BYTES - 64;
#if defined(__HIP_DEVICE_COMPILE__)
#define PHASE_PARAMS() ({ const __attribute__((address_space(4))) Params* q_ = (const __attribute__((address_space(4))) Params*)__builtin_amdgcn_kernarg_segment_ptr(); asm volatile("" : "+s"(q_)); *q_; })
#else
#define PHASE_PARAMS() (pk)
#endif
#define PHASE(call) do { const Params p = PHASE_PARAMS(); call; } while (0)
__global__ void __launch_bounds__(NTHREADS, 2) fwd_kernel(Params pk) {
    extern __shared__ __attribute__((aligned(16))) unsigned char lds_raw[];
    float* lds = (float*)lds_raw;
    cg::grid_group grid = cg::this_grid();
    const int vb = blockIdx.x, nvb = gridDim.x;
    if (threadIdx.x < 16) ((LAS unsigned*)(lds_raw + LDS_BARST))[threadIdx.x] = 0u;
    __syncthreads();
    const XcdBarrier bar = xcd_barrier_post((unsigned*)(pk.ws + OFF_CTL), (volatile LAS unsigned*)(lds_raw + LDS_BARST));
#define GRID_BAR() xcd_barrier(bar)
    PHASE(phase0(p, vb, nvb));
    PHASE(transpose_p0(p, lds, vb, nvb));
    grid.sync();
    PHASE(phase1_fast(p, lds_raw, vb, nvb));
    GRID_BAR();
    PHASE(phase2_fast(p, (char*)lds_raw, vb, nvb));
    GRID_BAR();
    PHASE(phase2b(p, vb, nvb));
    GRID_BAR();
    PHASE(phase3a_fast(p, lds_raw, vb, nvb));
    GRID_BAR();
    PHASE(phase3b_fast(p, lds_raw, vb, nvb));
    GRID_BAR();
    PHASE(phase4a(p, lds, vb, nvb));
    GRID_BAR();
    PHASE(phase4b_fast(p, lds, vb, nvb));
    GRID_BAR();
    PHASE(phase4c(p, vb, nvb));
    GRID_BAR();
    PHASE(phase5a_fast(p, lds_raw, vb, nvb));
    GRID_BAR();
    PHASE(phase5b_fast(p, lds_raw, vb, nvb));
    GRID_BAR();
    PHASE(phase6(p, vb, nvb));
}

extern "C" void kernel_launch(void* const* d_in, const int* in_sizes, int n_in, void* d_out, int out_size, void* d_ws, size_t ws_size, hipStream_t stream) {
    static int grid_blocks = 0;
    if (grid_blocks == 0) {
        if (n_in != 20 || in_sizes[0] != MREAL * DM || out_size != MREAL * DM || ws_size < 256 * MiB) {
            fprintf(stderr, "kernel_launch: unexpected shapes: n_in %d in0 %d out %d ws %zu\n", n_in, n_in > 0 ? in_sizes[0] : -1, out_size, ws_size); grid_blocks = -1; return; }
        int dev = 0, cus = 0, per_cu = 0;
        (void)hipGetDevice(&dev); (void)hipDeviceGetAttribute(&cus, hipDeviceAttributeMultiprocessorCount, dev);
        if (hipFuncSetAttribute((const void*)fwd_kernel, hipFuncAttributeMaxDynamicSharedMemorySize, LDS_BYTES) != hipSuccess) { fprintf(stderr, "kernel_launch: hipFuncSetAttribute failed\n"); grid_blocks = -1; return; }
        if (hipOccupancyMaxActiveBlocksPerMultiprocessor(&per_cu, (const void*)fwd_kernel, NTHREADS, LDS_BYTES) != hipSuccess || per_cu < 1) { fprintf(stderr, "kernel_launch: occupancy query failed (%d)\n", per_cu); grid_blocks = -1; return; }
        grid_blocks = cus * per_cu;
    }
    if (grid_blocks < 0) return;
    if (hipMemsetAsync((char*)d_ws + OFF_CTL, 0, CTL_WORDS * 4, stream) != hipSuccess) { fprintf(stderr, "kernel_launch: memset failed\n"); return; }
    Params p{};
    p.x = (const float*)d_in[0]; p.meta = (const float*)d_in[1]; p.g_mix = (const float*)d_in[2]; p.w_in = (const float*)d_in[3];
    p.lq1 = (const float*)d_in[4]; p.lk1 = (const float*)d_in[5]; p.lq2 = (const float*)d_in[6]; p.lk2 = (const float*)d_in[7];
    p.g_subln = (const float*)d_in[8]; p.g_qnorm = (const float*)d_in[9]; p.g_knorm = (const float*)d_in[10];
    p.w_ba = (const float*)d_in[11]; p.w_bb = (const float*)d_in[12]; p.w_out = (const float*)d_in[13]; p.g_ffn = (const float*)d_in[14];
    p.w_router = (const float*)d_in[15]; p.w_gate = (const float*)d_in[16]; p.w_up = (const float*)d_in[17]; p.w_down = (const float*)d_in[18]; p.g_final = (const float*)d_in[19];
    p.out = (float*)d_out; p.ws = (unsigned char*)d_ws;
    void* args[] = {&p};
    hipError_t e = hipLaunchCooperativeKernel((const void*)fwd_kernel, dim3(grid_blocks), dim3(NTHREADS), args, LDS_BYTES, stream);
    if (e != hipSuccess) fprintf(stderr, "kernel_launch: cooperative launch failed: %s (grid %d)\n", hipGetErrorString(e), grid_blocks);
}
```

```cpp
#include <hip/hip_runtime.h>
#include <hip/hip_cooperative_groups.h>
#include <cstdio>
#include <cstdint>
namespace cg = cooperative_groups;

typedef unsigned short bf16_t;
typedef float f32x4 __attribute__((ext_vector_type(4)));
typedef unsigned u32x2 __attribute__((ext_vector_type(2)));
typedef unsigned u32x4 __attribute__((ext_vector_type(4)));

constexpr int NB = 2, SEQ = 8192, DM = 1024, NMETA = 16, LTOT = SEQ + NMETA;
constexpr int MREAL = NB * SEQ;
constexpr int MROWS = MREAL + NB * NMETA;
constexpr int MPAD = 16640;
constexpr int INW = 6656;
constexpr int KEYS = 8256;
constexpr int QROWS = 8256;
constexpr int NEXP = 16, EFF = 512, CAP = 1026, ESLOTS = NB * CAP;
constexpr float EPS = 1e-6f;
constexpr float LOG2E = 1.4426950408889634f;
constexpr float CA = 0.125f * LOG2E;
constexpr float CB = 0.08838834764831845f * LOG2E;
constexpr float LAM_INIT = 0.2f;
constexpr int NTHREADS = 512;
constexpr int AOP = 2048;
__device__ const float INVF[32] = {1.000000000e+00f, 7.498942614e-01f, 5.623413324e-01f, 4.216965139e-01f, 3.162277639e-01f, 2.371373773e-01f, 1.778279394e-01f, 1.333521307e-01f,
    1.000000015e-01f, 7.498941571e-02f, 5.623413250e-02f, 4.216965288e-02f, 3.162277490e-02f, 2.371373773e-02f, 1.778279431e-02f, 1.333521493e-02f,
    9.999999776e-03f, 7.498941850e-03f, 5.623413250e-03f, 4.216964822e-03f, 3.162277630e-03f, 2.371373586e-03f, 1.778279431e-03f, 1.333521446e-03f,
    1.000000047e-03f, 7.498942432e-04f, 5.623413017e-04f, 4.216965172e-04f, 3.162277571e-04f, 2.371373703e-04f, 1.778279402e-04f, 1.333521504e-04f};

constexpr size_t MiB = 1u << 20;
constexpr size_t OFF_ROPE = 0;
constexpr size_t OFF_LAM = 64 * 1024;
constexpr size_t OFF_NRM = 64 * 1024 + 256;
constexpr int XCD_BAR_WORDS = 3456;
constexpr size_t OFF_CTL = 68 * 1024;
constexpr int CTL_WORDS = XCD_BAR_WORDS + 64;
constexpr size_t OFF_QCTR = OFF_CTL + (size_t)XCD_BAR_WORDS * 4;
constexpr size_t OFF_MINIDONE = OFF_QCTR + 64;
constexpr size_t OFF_AFF = 128 * 1024;
constexpr size_t OFF_IDX = OFF_AFF + (size_t)NB * NEXP * LTOT * 4 + 256;
constexpr size_t OFF_SEL = OFF_IDX + (size_t)NB * NEXP * CAP * 4 + 256;
constexpr size_t OFF_SGM = OFF_SEL + (size_t)NB * LTOT * NEXP * 4 + 256;
constexpr size_t OFF_H2M = OFF_SGM + 32 * 2048 * 2;
constexpr size_t OFF_SAFF = OFF_H2M + 32 * 1024 * 4;
constexpr size_t OFF_MISC_END = OFF_SAFF + (size_t)NEXP * ESLOTS * 4;
static_assert(OFF_MISC_END <= 4 * MiB, "misc region");
constexpr size_t OFF_WIN = 4 * MiB;
constexpr size_t OFF_WAB = OFF_WIN + (size_t)INW * DM * 2;
constexpr size_t OFF_WO = OFF_WAB + (size_t)DM * 2048 * 2;
static_assert(OFF_WO + (size_t)DM * DM * 2 <= 24 * MiB, "weights region");
constexpr size_t OFF_AO = 24 * MiB;
constexpr size_t SZ_ROWS = (size_t)MPAD * DM * 2;
constexpr size_t OFF_UN = OFF_AO;
constexpr size_t OFF_HID = OFF_AO + SZ_ROWS;
static_assert((size_t)(NEXP * ESLOTS + 256) * EFF * 2 <= SZ_ROWS, "HID overlay");
constexpr size_t OFF_ATT = OFF_AO + 2 * SZ_ROWS;
constexpr size_t SZ_QH = (size_t)NB * 8 * QROWS * 128 * 2;
constexpr size_t SZ_KVB = (size_t)NB * 2 * KEYS * 128 * 2;
constexpr size_t OFF_QA = OFF_ATT, OFF_KA = OFF_QA + SZ_QH, OFF_VA = OFF_KA + SZ_QH, OFF_QB = OFF_VA + SZ_QH, OFF_KB = OFF_QB + SZ_QH, OFF_VB = OFF_KB + SZ_KVB;
constexpr size_t OFF_ATT_END = OFF_VB + SZ_KVB;
static_assert(OFF_ATT_END <= 256 * MiB, "workspace");
constexpr size_t OFF_MERGED = OFF_ATT;
constexpr size_t OFF_WGU = OFF_ATT + 33 * MiB;
constexpr size_t OFF_WD = OFF_WGU + 32 * MiB;
constexpr size_t OFF_XS = OFF_WD + 16 * MiB;
constexpr size_t OFF_YB = OFF_XS;
static_assert(SZ_ROWS <= 33 * MiB && OFF_XS + (size_t)(NEXP * ESLOTS + 256) * DM * 2 <= 256 * MiB, "overlay map");

struct Params {
    const float *x, *meta, *g_mix, *w_in, *lq1, *lk1, *lq2, *lk2, *g_subln, *g_qnorm, *g_knorm, *w_ba, *w_bb, *w_out, *g_ffn, *w_router, *w_gate, *w_up, *w_down, *g_final;
    float* out; unsigned char* ws;
};

__device__ __forceinline__ int TID() { int t = threadIdx.x; asm volatile("" : "+v"(t)); return t; }
__device__ __forceinline__ unsigned f2bf(float f) { unsigned u = __builtin_bit_cast(unsigned, f); return (u + 0x7fffu + ((u >> 16) & 1u)) >> 16; }
__device__ __forceinline__ float bf2f(unsigned h) { return __builtin_bit_cast(float, h << 16); }
#define DPP_F(x, ctrl, rmask) __builtin_bit_cast(float, __builtin_amdgcn_update_dpp(0, __builtin_bit_cast(int, (x)), (ctrl), (rmask), 0xf, true))
__device__ __forceinline__ float wave_sum(float v) {
    v += DPP_F(v, 0xB1, 0xf);
    v += DPP_F(v, 0x4E, 0xf);
    v += DPP_F(v, 0x141, 0xf);
    v += DPP_F(v, 0x140, 0xf);
    float t = __builtin_bit_cast(float, __builtin_amdgcn_update_dpp(0, __builtin_bit_cast(int, v), 0x142, 0xa, 0xf, false)); v += t;
    t = __builtin_bit_cast(float, __builtin_amdgcn_update_dpp(0, __builtin_bit_cast(int, v), 0x143, 0xc, 0xf, false)); v += t;
    return __builtin_bit_cast(float, __builtin_amdgcn_readlane(__builtin_bit_cast(int, v), 63));
}
__device__ __forceinline__ float wave_max(float v) {
    v = fmaxf(v, DPP_F(v, 0xB1, 0xf)); v = fmaxf(v, DPP_F(v, 0x4E, 0xf)); v = fmaxf(v, DPP_F(v, 0x141, 0xf)); v = fmaxf(v, DPP_F(v, 0x140, 0xf));
    const float a = __builtin_bit_cast(float, __builtin_amdgcn_readlane(__builtin_bit_cast(int, v), 15)), b = __builtin_bit_cast(float, __builtin_amdgcn_readlane(__builtin_bit_cast(int, v), 31));
    const float c = __builtin_bit_cast(float, __builtin_amdgcn_readlane(__builtin_bit_cast(int, v), 47)), d = __builtin_bit_cast(float, __builtin_amdgcn_readlane(__builtin_bit_cast(int, v), 63));
    return fmaxf(fmaxf(a, b), fmaxf(c, d));
}
__device__ __forceinline__ size_t k_img(int kk, int col) { return (size_t)(kk >> 6) * 8192 + (col >> 3) * 512 + (kk & 63) * 8 + (col & 7); }
__device__ __forceinline__ size_t v_img(int kk, int col) { const int db = col >> 4; return (size_t)(kk >> 6) * 8192 + db * 1024 + ((((kk & 63) * 16) ^ ((db & 1) << 6)) + (col & 15)); }
struct RowInfo { int b, t, meta, valid; };
__device__ __forceinline__ RowInfo row_decode(int r) {
    RowInfo ri;
    if (r < MREAL) { ri.b = r >> 13; ri.t = r & (SEQ - 1); ri.meta = 0; ri.valid = 1; }
    else if (r < MROWS) { ri.b = (r - MREAL) >> 4; ri.t = (r - MREAL) & 15; ri.meta = 1; ri.valid = 1; }
    else { ri.b = 0; ri.t = 0; ri.meta = 1; ri.valid = 0; }
    return ri;
}
__device__ __forceinline__ int row_key(const RowInfo& ri) { return ri.meta ? ri.t : 64 + ri.t; }
__device__ __forceinline__ int row_q(const RowInfo& ri) { return ri.meta ? SEQ + ri.t : ri.t; }
__device__ __forceinline__ int row_pos(const RowInfo& ri) { return ri.meta ? ri.t : NMETA + ri.t; }
__device__ __forceinline__ int pos_row(int b, int pos) { return pos < NMETA ? MREAL + b * NMETA + pos : b * SEQ + (pos - NMETA); }
__device__ __forceinline__ const float* h_row(const Params& p, int r) { RowInfo ri = row_decode(r); return ri.meta ? p.meta + (size_t)ri.t * DM : p.x + (size_t)r * DM; }

__device__ __forceinline__ void phase0(const Params& p, int vb, int nvb) {
    const int tid = TID(), lane = tid & 63, wave = tid >> 6;
    const int gt = vb * NTHREADS + tid;
    if (gt < 128 * 32) {
        const int pos = gt >> 5, j = gt & 31;
        const float ang = (float)pos * INVF[j];
        const double xd = (double)ang, kq = __builtin_rint(xd * 0.15915494309189535);
        const double rr = (xd - kq * 6.283185307179586) * 0.25, r2 = rr * rr;
        double sn = 1.0 / 1307674368000.0, cn = 1.0 / 87178291200.0;
        sn = sn * r2 * -1.0 + 1.0 / 6227020800.0; cn = cn * r2 * -1.0 + 1.0 / 479001600.0;
        sn = sn * r2 * -1.0 + 1.0 / 39916800.0;   cn = cn * r2 * -1.0 + 1.0 / 3628800.0;
        sn = sn * r2 * -1.0 + 1.0 / 362880.0;     cn = cn * r2 * -1.0 + 1.0 / 40320.0;
        sn = sn * r2 * -1.0 + 1.0 / 5040.0;       cn = cn * r2 * -1.0 + 1.0 / 720.0;
        sn = sn * r2 * -1.0 + 1.0 / 120.0;        cn = cn * r2 * -1.0 + 1.0 / 24.0;
        sn = sn * r2 * -1.0 + 1.0 / 6.0;          cn = cn * r2 * -1.0 + 0.5;
        sn = (sn * r2 * -1.0 + 1.0) * rr;         cn = cn * r2 * -1.0 + 1.0;
        double s2 = 2.0 * sn * cn, c2 = cn * cn - sn * sn;
        double s4 = 2.0 * s2 * c2, c4 = c2 * c2 - s2 * s2;
        float2 cs; cs.x = (float)c4; cs.y = (float)s4;
        ((float2*)(p.ws + OFF_ROPE))[gt] = cs;
    }
    if (vb == 0 && tid < 256) ((unsigned*)(p.ws + OFF_NRM))[tid] = 0u;
    if (vb == 0 && wave == 0) {
        float a = p.lq1[lane] * p.lk1[lane], c = p.lq2[lane] * p.lk2[lane];
        a = wave_sum(a); c = wave_sum(c);
        if (lane == 0) *(float*)(p.ws + OFF_LAM) = expf(a) - expf(c) + LAM_INIT;
    }
    bf16_t* UN = (bf16_t*)(p.ws + OFF_UN);
    for (int r0 = vb * 8 + wave; r0 < MPAD; r0 += nvb * 8 * 2) {
        f32x4 v[2][4];
#pragma unroll
        for (int h = 0; h < 2; ++h) { const int r = r0 + h * nvb * 8;
            if (r < MROWS) { const f32x4* xr = (const f32x4*)h_row(p, r) + lane;
#pragma unroll
                for (int j = 0; j < 4; ++j) v[h][j] = xr[64 * j]; }
            else {
#pragma unroll
                for (int j = 0; j < 4; ++j) v[h][j] = (f32x4){0.f, 0.f, 0.f, 0.f}; } }
#pragma unroll
        for (int h = 0; h < 2; ++h) { const int r = r0 + h * nvb * 8; if (r >= MPAD) continue;
            float s = 0.f;
#pragma unroll
            for (int j = 0; j < 4; ++j) s += (v[h][j].x * v[h][j].x + v[h][j].y * v[h][j].y) + (v[h][j].z * v[h][j].z + v[h][j].w * v[h][j].w);
            const float rstd = 1.0f / sqrtf(wave_sum(s) * (1.0f / DM) + EPS);
            u32x2* o = (u32x2*)(UN + (size_t)r * DM) + lane;
#pragma unroll
            for (int j = 0; j < 4; ++j) { const f32x4 g = ((const f32x4*)p.g_mix)[lane + 64 * j];
                u32x2 w; w.x = f2bf(v[h][j].x * rstd * g.x) | (f2bf(v[h][j].y * rstd * g.y) << 16); w.y = f2bf(v[h][j].z * rstd * g.z) | (f2bf(v[h][j].w * rstd * g.w) << 16);
                o[64 * j] = w; } }
    }
    {
        bf16_t* KA = (bf16_t*)(p.ws + OFF_KA); bf16_t* VA = (bf16_t*)(p.ws + OFF_VA); bf16_t* KB = (bf16_t*)(p.ws + OFF_KB); bf16_t* VB = (bf16_t*)(p.ws + OFF_VB);
        const int per = 16384 / 16;
        for (int i = vb * NTHREADS + tid; i < (16 + 16 + 4 + 4) * per; i += nvb * NTHREADS) {
            const int bh = i / per, o = i % per; bf16_t* base;
            if (bh < 16) base = KA + (size_t)bh * KEYS * 128; else if (bh < 32) base = VA + (size_t)(bh - 16) * KEYS * 128;
            else if (bh < 36) base = KB + (size_t)(bh - 32) * KEYS * 128; else base = VB + (size_t)(bh - 36) * KEYS * 128;
            ((u32x4*)base)[o] = (u32x4){0u, 0u, 0u, 0u};
        }
    }
}

namespace fa {
using bf16x8 = __attribute__((ext_vector_type(8))) short;
using s16x4  = __attribute__((ext_vector_type(4))) short;
using f32x16 = __attribute__((ext_vector_type(16))) float;
constexpr int NT = KEYS / 64;
constexpr int SLOT = 16384;
constexpr float THR = 8.f;
#define SBAR() __builtin_amdgcn_sched_barrier(0)
__device__ __forceinline__ int crow(int r, int hi) { return (r & 3) + 8 * (r >> 2) + 4 * hi; }
__device__ __forceinline__ unsigned cvtpk(float lo, float hi) { unsigned r; asm volatile("v_cvt_pk_bf16_f32 %0, %1, %2" : "=v"(r) : "v"(lo), "v"(hi)); return r; }
__device__ __forceinline__ void glds16(const void* gsrc, unsigned lds_dst) { unsigned keep;
    asm volatile("s_mov_b32 %0, m0\n\ts_mov_b32 m0, %2\n\ts_nop 0\n\tglobal_load_lds_dwordx4 %1, off\n\ts_mov_b32 m0, %0" : "=&s"(keep) : "v"(gsrc), "s"(lds_dst) : "memory"); }
__device__ __forceinline__ void glds16s(const void* sbase_, unsigned voff, unsigned lds_dst) { unsigned keep;
    const unsigned long long a_ = (unsigned long long)sbase_; const unsigned long long sbase = ((unsigned long long)(unsigned)__builtin_amdgcn_readfirstlane((int)(a_ >> 32)) << 32) | (unsigned)__builtin_amdgcn_readfirstlane((int)a_);
    asm volatile("s_nop 1\n\ts_mov_b32 %0, m0\n\ts_mov_b32 m0, %3\n\ts_nop 0\n\tglobal_load_lds_dwordx4 %1, %2\n\ts_mov_b32 m0, %0" : "=&s"(keep) : "v"(voff), "s"(sbase), "s"(lds_dst) : "memory"); }
}

namespace fb {
using fa::bf16x8; using fa::s16x4; using fa::f32x16; using fa::crow; using fa::cvtpk; using fa::glds16; using fa::glds16s;
constexpr int SLOT = 16384, KSL = 4, VSL = 4;
constexpr int L_K = 0, L_V = KSL * SLOT, L_WS = L_V + VSL * SLOT, L_END = L_WS + 8 * 64 * 4;
constexpr float THR = 8.f;
typedef __attribute__((address_space(3))) const char* lds_cptr;
typedef short v4i16_t __attribute__((ext_vector_type(4)));
#define FB_SBAR() __builtin_amdgcn_sched_barrier(0)
#define FB_PIN(x) asm volatile("" : "+v"(x))
#define FB_MFMA(a, b, c) __builtin_amdgcn_mfma_f32_32x32x16_bf16(a, b, c, 0, 0, 0)
#define FB_WAIT_BAR(N) asm volatile("s_waitcnt vmcnt(" #N ") lgkmcnt(0)\n\ts_barrier" ::: "memory")
#define FB_MX3(a, b, c) __builtin_fmaxf(__builtin_fmaxf((a), (b)), (c))
__device__ __forceinline__ bf16x8 kfrag(lds_cptr kp, int f) { return *(const __attribute__((address_space(3))) bf16x8*)(kp + (f >> 1) * 2048 + (f & 1) * 512); }
__device__ __forceinline__ s16x4 vtr(lds_cptr p) { return __builtin_bit_cast(s16x4, __builtin_amdgcn_ds_read_tr16_b64_v4i16((__attribute__((address_space(3))) v4i16_t*)p)); }
__device__ __forceinline__ float rowmax(const f32x16& p0, const f32x16& p1) {
    float a = FB_MX3(p0[0], p0[1], p1[0]), b = FB_MX3(p0[2], p0[3], p1[1]); a = FB_MX3(a, p1[2], p1[3]);
#pragma unroll
    for (int r = 4; r < 16; r += 4) { a = FB_MX3(a, p0[r], p0[r + 1]); b = FB_MX3(b, p0[r + 2], p0[r + 3]); a = FB_MX3(a, p1[r], p1[r + 1]); b = FB_MX3(b, p1[r + 2], p1[r + 3]); }
    float m = __builtin_fmaxf(a, b); auto rr = __builtin_amdgcn_permlane32_swap(__float_as_uint(m), __float_as_uint(m), false, false);
    return __builtin_fmaxf(__uint_as_float(rr[0]), __uint_as_float(rr[1])); }
__device__ __forceinline__ void split3(float w, unsigned& h1, unsigned& h2, unsigned& h3) {
    h1 = __float_as_uint(w) & 0xffff0000u; const float r1 = w - __uint_as_float(h1);
    h2 = __float_as_uint(r1) & 0xffff0000u; const float r2 = r1 - __uint_as_float(h2);
    h3 = __float_as_uint(r2) & 0xffff0000u; }

template <bool DIFF, bool IDLE = false, bool NOCHK = false, int KPF_ = 2, int VPF_ = 2>
__device__ __forceinline__ void attn_unit(const bf16x8 (&qr)[DIFF ? 4 : 8], const bf16_t* __restrict__ Kh, const bf16_t* __restrict__ Vh, int tq, int wrow0, float slopeL, char* lds,
                                          int tfirst, int tbase, int n, f32x16 (&o)[4], float& l_reg, float& mhat) {
    constexpr bool active = !IDLE;
    constexpr int ND0 = DIFF ? 4 : 8, NQ = 2 * ND0;
    constexpr int KPF = KPF_, VPF = VPF_;
    const int tid = TID(), lane = tid & 63, r32 = lane & 31, hi = lane >> 5; const int wid = __builtin_amdgcn_readfirstlane(tid >> 6);
    const unsigned lds0 = (unsigned)(uintptr_t)lds; float* wsf = (float*)(lds + L_WS) + wid * 64;
    const char* ksrc = (const char*)Kh + wid * 1024;
    const char* vsrc = (const char*)Vh + wid * 1024; const unsigned loff = lane * 16;
    const unsigned kdst = lds0 + L_K + wid * 1024, vdst = lds0 + L_V + wid * 1024;
#define TILE_OF(i) ((i) == 0 ? tfirst : tbase + (i))
#define DMA_K(i, slot) do { const char* s_ = ksrc + (size_t)TILE_OF(i) * SLOT; const unsigned d_ = (unsigned)__builtin_amdgcn_readfirstlane(kdst + (slot)); glds16s(s_, loff, d_); glds16s(s_ + 8192, loff, d_ + 8192); } while (0)
#define DMA_V(i, slot) do { const char* s_ = vsrc + (size_t)TILE_OF(i) * SLOT; const unsigned d_ = (unsigned)__builtin_amdgcn_readfirstlane(vdst + (slot)); glds16s(s_, loff, d_); glds16s(s_ + 8192, loff, d_ + 8192); } while (0)
    const lds_cptr vp0 = (lds_cptr)lds + L_V + ((lane >> 4) & 1) * 2048 + ((hi ^ ((lane >> 4) & 1)) * 128) + ((lane & 15) >> 2) * 32 + (lane & 3) * 8;
    const lds_cptr kp0 = (lds_cptr)lds + L_K + hi * 1024 + r32 * 16 + (DIFF ? (wid >> 2) * 8192 : 0);
    const bool lag = false;
    mhat = 0.f; l_reg = 0.f;
#pragma unroll
    for (int d = 0; d < 4; ++d) o[d] = f32x16{};
    const f32x16 zero16 = f32x16{};
    f32x16 negm = f32x16{};
    bool resc = false;
    f32x16 pA0, pA1, pB0, pB1; bf16x8 kf[KPF]; s16x4 vlo[VPF], vhi[VPF]; u32x4 pw0, pw1, pw2, pw3;
    bf16x8 kx0 = bf16x8{}, kx1 = bf16x8{}, qx = bf16x8{}; unsigned sl1 = 0, sl2 = 0, sl3 = 0;
    if (DIFF) { if (hi == 0) { const unsigned c0 = __float_as_uint((float)r32) >> 16, c1 = __float_as_uint((float)(32 + r32)) >> 16;
            u32x4 a = {0x3F803F80u, 0x3F80u | (c0 << 16), c0 | (c0 << 16), 0u}, b = {0x3F803F80u, 0x3F80u | (c1 << 16), c1 | (c1 << 16), 0u};
            kx0 = __builtin_bit_cast(bf16x8, a); kx1 = __builtin_bit_cast(bf16x8, b); }
        split3(slopeL, sl1, sl2, sl3); }
#define SIDE_OF(j) ((j) == 0 ? 0 : (64 * ((j) - 1) + 63 <= wrow0) ? 1 : (64 * ((j) - 1) >= wrow0 + 31) ? -1 : 0)
#define BUILD_QX(j) do { if (DIFF) { const int sd_ = SIDE_OF(j); float w_ = -mhat; unsigned sg_ = 0u, keep_ = 0u; \
        if (sd_ != 0) { const float lin_ = slopeL * (float)(tq - 64 * ((j) - 1)); w_ += sd_ > 0 ? -lin_ : lin_; sg_ = sd_ > 0 ? 0u : 0x80000000u; keep_ = 0xffffffffu; } \
        unsigned h1_, h2_, h3_; split3(w_, h1_, h2_, h3_); const unsigned a1_ = (sl1 ^ sg_) & keep_, a2_ = (sl2 ^ sg_) & keep_, a3_ = (sl3 ^ sg_) & keep_; \
        u32x4 q_ = {(h1_ >> 16) | h2_, (h3_ >> 16) | a1_, (a2_ >> 16) | a3_, 0u}; if (hi != 0) q_ = (u32x4){0u, 0u, 0u, 0u}; qx = __builtin_bit_cast(bf16x8, q_); } } while (0)
#define FIXUP(C0, C1, j) do { if ((j) == 0) { _Pragma("unroll") for (int r = 8; r < 16; ++r) C0[r] = -1e30f; _Pragma("unroll") for (int r = 0; r < 16; ++r) C1[r] = -1e30f; } \
        else if (DIFF && SIDE_OF(j) == 0) { const float base_ = (float)(tq - ((j) - 1) * 64 - 4 * hi); \
            _Pragma("unroll") for (int r = 0; r < 16; ++r) { const float d_ = base_ - (float)((r & 3) + 8 * (r >> 2)); \
                C0[r] = fmaf(-slopeL, fabsf(d_), C0[r]); C1[r] = fmaf(-slopeL, fabsf(d_ - 32.f), C1[r]); } } } while (0)
#define PFLAT(P0, P1, e) ((e) < 16 ? P0[(e) & 15] : P1[(e) & 15])
#define PWSET(u, v) do { if ((u) < 4) pw0[(u) & 3] = (v); else if ((u) < 8) pw1[(u) & 3] = (v); else if ((u) < 12) pw2[(u) & 3] = (v); else pw3[(u) & 3] = (v); } while (0)
#define PAF(k) __builtin_bit_cast(bf16x8, (k) == 0 ? pw0 : (k) == 1 ? pw1 : (k) == 2 ? pw2 : pw3)
#define VFR(i) (bf16x8){vlo[i][0], vlo[i][1], vlo[i][2], vlo[i][3], vhi[i][0], vhi[i][1], vhi[i][2], vhi[i][3]}
#define VRD(slotv, f, dst) do { const lds_cptr a_ = vp0 + (slotv) + ((f) >> 2) * 4096 + ((f) & 3) * 512; vlo[dst] = vtr(a_); vhi[dst] = vtr(a_ + 256); } while (0)
#define AUNIT(P0, P1, u) do { sacc += PFLAT(P0, P1, 2 * (u)); sacc += PFLAT(P0, P1, 2 * (u) + 1); PWSET(u, cvtpk(PFLAT(P0, P1, 2 * (u)), PFLAT(P0, P1, 2 * (u) + 1))); } while (0)
#define EXPU(C0, C1, u) do { if ((u) < 8) { C0[2 * ((u) & 7)] = __builtin_amdgcn_exp2f(C0[2 * ((u) & 7)] - sub_); C0[2 * ((u) & 7) + 1] = __builtin_amdgcn_exp2f(C0[2 * ((u) & 7) + 1] - sub_); } \
        else { C1[2 * ((u) & 7)] = __builtin_amdgcn_exp2f(C1[2 * ((u) & 7)] - sub_); C1[2 * ((u) & 7) + 1] = __builtin_amdgcn_exp2f(C1[2 * ((u) & 7) + 1] - sub_); } } while (0)
#define STEP(C0, C1, P0, P1, i, GK, GV, GL, WB) do { \
    const int j_ = TILE_OF(i); const lds_cptr kp_ = kp0 + kcur; const lds_cptr kn_ = kp0 + knxt; \
    if (active) { BUILD_QX(j_); FB_SBAR(); float sacc = 0.f; \
        if (DIFF) { C0 = FB_MFMA(kx0, qx, zero16); AUNIT(P0, P1, 0); FB_PIN(sacc); FB_PIN(pw0); FB_SBAR(); \
                    C1 = FB_MFMA(kx1, qx, zero16); AUNIT(P0, P1, 1); AUNIT(P0, P1, 2); FB_PIN(sacc); FB_PIN(pw0); FB_SBAR(); } \
        _Pragma("unroll") for (int g = 0; g < NQ; ++g) { \
            if (g & 1) C1 = FB_MFMA(kf[g % KPF], qr[g >> 1], (!DIFF && g < 2) ? negm : C1); else C0 = FB_MFMA(kf[g % KPF], qr[g >> 1], (!DIFF && g < 2) ? negm : C0); \
            if (g + KPF < NQ) kf[g % KPF] = kfrag(kp_, g + KPF); \
            if (DIFF) { if (g < 5) { AUNIT(P0, P1, 3 + 2 * g); AUNIT(P0, P1, 4 + 2 * g); } else AUNIT(P0, P1, 8 + g); } else AUNIT(P0, P1, g); \
            if (g >= NQ - VPF) VRD(vprv, g - (NQ - VPF), g - (NQ - VPF)); \
            FB_PIN(sacc); FB_PIN(pw0); FB_PIN(pw1); FB_PIN(pw2); FB_PIN(pw3); FB_SBAR(); } \
        l_reg += sacc; } \
    if (GK) DMA_K((i) + 3, kfree); if (GV) DMA_V((i) + 1, vnxt); \
    float sub_ = 0.f; \
    if (active) { FIXUP(C0, C1, j_); \
        if (!NOCHK) { const float rm = rowmax(C0, C1); resc = false; \
          if (__builtin_expect(__any(rm > THR), 0)) { const float dl = __builtin_fmaxf(rm, 0.f); mhat += dl; \
              _Pragma("unroll") for (int r = 0; r < 16; ++r) { C0[r] -= dl; C1[r] -= dl; } \
              if (!DIFF) { _Pragma("unroll") for (int r = 0; r < 16; ++r) negm[r] = -mhat; asm volatile("" : "+v"(negm)); } \
              const float f = __builtin_amdgcn_exp2f(-dl); l_reg *= f; if (hi == 0) wsf[r32] = f; resc = true; } } \
        sub_ = 0.f; } \
    if (lag) { WB; } \
    if (active) { FB_SBAR(); \
        _Pragma("unroll") for (int g = 0; g < 16; ++g) { \
            o[g >> 2] = FB_MFMA(PAF(g & 3), VFR(g % VPF), o[g >> 2]); \
            if (g + VPF < 16) VRD(vprv, g + VPF, g % VPF); \
            EXPU(C0, C1, g); \
            if ((GL) && g >= 4 && g < 4 + KPF) kf[g - 4] = kfrag(kn_, g - 4); \
            FB_PIN(C0); FB_PIN(C1); FB_SBAR(); } } \
    if (!lag) { WB; } \
    } while (0)
#define RESC() do { if (active && resc) { _Pragma("unroll") for (int d_ = 0; d_ < 4; ++d_) _Pragma("unroll") for (int r = 0; r < 16; ++r) o[d_][r] *= wsf[crow(r, hi)]; } } while (0)
    int kcur = 0, knxt = SLOT, kfree = 3 * SLOT, vprv = 0, vnxt = SLOT;
#define ROT() do { kfree = kcur; kcur = knxt; knxt = (knxt == (KSL - 1) * SLOT) ? 0 : knxt + SLOT; vprv = (vnxt == 0) ? (VSL - 1) * SLOT : vnxt - SLOT; vnxt = (vnxt == (VSL - 1) * SLOT) ? 0 : vnxt + SLOT; } while (0)
    DMA_K(0, 0); DMA_V(0, 0); DMA_K(1, SLOT); DMA_K(2, 2 * SLOT);
    FB_WAIT_BAR(6);
    if (n > 3) DMA_K(3, 3 * SLOT);
    DMA_V(1, SLOT);
    if (active) { const int j0 = tfirst; BUILD_QX(j0);
        if (DIFF) { pA0 = FB_MFMA(kx0, qx, zero16); pA1 = FB_MFMA(kx1, qx, zero16); }
#pragma unroll
        for (int g = 0; g < NQ; ++g) { const bf16x8 kk = kfrag(kp0, g);
            if (g & 1) pA1 = FB_MFMA(kk, qr[g >> 1], (!DIFF && g < 2) ? zero16 : pA1); else pA0 = FB_MFMA(kk, qr[g >> 1], (!DIFF && g < 2) ? zero16 : pA0); }
        FIXUP(pA0, pA1, j0);
        const float rm = rowmax(pA0, pA1); mhat = rm;
        if (!DIFF) {
#pragma unroll
            for (int r = 0; r < 16; ++r) negm[r] = -rm;
            asm volatile("" : "+v"(negm)); }
#pragma unroll
        for (int r = 0; r < 16; ++r) { pA0[r] = __builtin_amdgcn_exp2f(pA0[r] - rm); pA1[r] = __builtin_amdgcn_exp2f(pA1[r] - rm); } }
    if (n > 3) FB_WAIT_BAR(4); else FB_WAIT_BAR(2);
    kcur = SLOT; knxt = 2 * SLOT; kfree = 0; vprv = 0; vnxt = 2 * SLOT;
    if (active) {
#pragma unroll
        for (int g = 0; g < KPF; ++g) kf[g] = kfrag(kp0 + kcur, g); }
    int i = 1;
    for (; i + 5 < n; i += 2) {
        STEP(pB0, pB1, pA0, pA1, i, true, true, true, FB_WAIT_BAR(4));
        RESC(); ROT();
        STEP(pA0, pA1, pB0, pB1, i + 1, true, true, true, FB_WAIT_BAR(4));
        RESC(); ROT();
    }
    for (; i + 1 < n; i += 2) {
        STEP(pB0, pB1, pA0, pA1, i, (i + 3 < n), (i + 1 < n), (i + 1 < n), FB_WAIT_BAR(0));
        RESC(); ROT();
        STEP(pA0, pA1, pB0, pB1, i + 1, (i + 4 < n), (i + 2 < n), (i + 2 < n), FB_WAIT_BAR(0));
        RESC(); ROT();
    }
    if (active) { float sacc = 0.f;
#pragma unroll
        for (int u = 0; u < 16; ++u) AUNIT(pA0, pA1, u);
        l_reg += sacc;
#pragma unroll
        for (int g = 0; g < 16; ++g) { VRD(vprv, g, 0); o[g >> 2] = FB_MFMA(PAF(g & 3), VFR(0), o[g >> 2]); } }
    FB_WAIT_BAR(0);
#undef TILE_OF
#undef DMA_K
#undef DMA_V
#undef SIDE_OF
#undef BUILD_QX
#undef FIXUP
#undef PFLAT
#undef PWSET
#undef PAF
#undef VFR
#undef VRD
#undef AUNIT
#undef EXPU
#undef STEP
#undef RESC
#undef ROT
}
}

namespace fc {
using fa::bf16x8; using fa::s16x4; using fa::crow; using fa::cvtpk; using fa::glds16s;
using fb::SLOT; using fb::KSL; using fb::VSL; using fb::L_K; using fb::L_V; using fb::L_WS; using fb::lds_cptr; using fb::vtr;
typedef float f4 __attribute__((ext_vector_type(4)));
#define FC_MFMA(a, b, c) __builtin_amdgcn_mfma_f32_16x16x32_bf16(a, b, c, 0, 0, 0)
constexpr int KPF = 2, VPF = 2;
__device__ __forceinline__ void attn_unit16(const bf16_t* __restrict__ q0, const bf16_t* __restrict__ Kh, const bf16_t* __restrict__ Vh, char* lds, int tfirst, int tbase, int n,
                                            f4 (&o)[2][8], float (&lsum)[2]) {
    const int tid = TID(), lane = tid & 63, i16 = lane & 15, g = lane >> 4; const int wid = __builtin_amdgcn_readfirstlane(tid >> 6);
    const unsigned lds0 = (unsigned)(uintptr_t)lds;
    const char* ksrc = (const char*)Kh + wid * 1024; const char* vsrc = (const char*)Vh + wid * 1024; const unsigned loff = lane * 16;
    const unsigned kdst = lds0 + L_K + wid * 1024, vdst = lds0 + L_V + wid * 1024;
#define TILE_OF(i) ((i) == 0 ? tfirst : tbase + (i))
#define DMA_K(i, slot) do { const char* s_ = ksrc + (size_t)TILE_OF(i) * SLOT; const unsigned d_ = (unsigned)__builtin_amdgcn_readfirstlane(kdst + (slot)); glds16s(s_, loff, d_); glds16s(s_ + 8192, loff, d_ + 8192); } while (0)
#define DMA_V(i, slot) do { const char* s_ = vsrc + (size_t)TILE_OF(i) * SLOT; const unsigned d_ = (unsigned)__builtin_amdgcn_readfirstlane(vdst + (slot)); glds16s(s_, loff, d_); glds16s(s_ + 8192, loff, d_ + 8192); } while (0)
    const lds_cptr kp0 = (lds_cptr)lds + L_K + g * 1024 + i16 * 16;
    const lds_cptr vpE = (lds_cptr)lds + L_V + g * 128 + (i16 >> 2) * 32 + (i16 & 3) * 8;
    const lds_cptr vpO = (lds_cptr)lds + L_V + ((g * 128) ^ 128) + (i16 >> 2) * 32 + (i16 & 3) * 8;
#define KFR(kp, f) (*(const __attribute__((address_space(3))) bf16x8*)((kp) + ((f) >> 2) * 4096 + ((f) & 3) * 256))
#define VRD(slotv, f, dst) do { const lds_cptr a_ = (((f) & 1) ? vpO : vpE) + (slotv) + ((f) & 7) * 2048 + ((f) >> 3) * 1024; vlo[dst] = vtr(a_); vhi[dst] = vtr(a_ + 512); } while (0)
#define VFR(i) (bf16x8){vlo[i][0], vlo[i][1], vlo[i][2], vlo[i][3], vhi[i][0], vhi[i][1], vhi[i][2], vhi[i][3]}
    bf16x8 qf[2][4];
#pragma unroll
    for (int qb = 0; qb < 2; ++qb)
#pragma unroll
        for (int ds = 0; ds < 4; ++ds) qf[qb][ds] = *reinterpret_cast<const bf16x8*>(q0 + (size_t)(16 * qb + i16) * 128 + 32 * ds + 8 * g);
#pragma unroll
    for (int qb = 0; qb < 2; ++qb)
#pragma unroll
        for (int db = 0; db < 8; ++db) o[qb][db] = (f4){0.f, 0.f, 0.f, 0.f};
    lsum[0] = 0.f; lsum[1] = 0.f;
    f4 negm0 = (f4){0.f, 0.f, 0.f, 0.f}, negm1 = (f4){0.f, 0.f, 0.f, 0.f};
    const f4 zero4 = (f4){0.f, 0.f, 0.f, 0.f};
    f4 cA[4][2], cB[4][2]; bf16x8 kf[KPF]; s16x4 vlo[VPF], vhi[VPF]; u32x4 pw[2][2];
#define AUNIT(P, u) do { const float a_ = P[2 * (((u) >> 2) & 1) + (((u) & 3) >> 1)][(u) >> 3][2 * ((u) & 1)], b_ = P[2 * (((u) >> 2) & 1) + (((u) & 3) >> 1)][(u) >> 3][2 * ((u) & 1) + 1]; \
        lsum[(u) >> 3] += a_; lsum[(u) >> 3] += b_; pw[(u) >> 3][((u) >> 2) & 1][(u) & 3] = cvtpk(a_, b_); } while (0)
#define EXPE(C, e) do { C[(e) >> 3][((e) >> 2) & 1][(e) & 3] = __builtin_amdgcn_exp2f(C[(e) >> 3][((e) >> 2) & 1][(e) & 3]); } while (0)
#define PINC(C) do { _Pragma("unroll") for (int a_ = 0; a_ < 4; ++a_) { FB_PIN(C[a_][0]); FB_PIN(C[a_][1]); } } while (0)
#define STEP(C, P, i, GK, GV, GL, WB) do { \
    const lds_cptr kp_ = kp0 + kcur; const lds_cptr kn_ = kp0 + knxt; \
    FB_SBAR(); \
    _Pragma("unroll") for (int f = 0; f < 16; ++f) { const int kb = f & 3, ds = f >> 2; \
        C[kb][0] = FC_MFMA(kf[f % KPF], qf[0][ds], ds == 0 ? negm0 : C[kb][0]); C[kb][1] = FC_MFMA(kf[f % KPF], qf[1][ds], ds == 0 ? negm1 : C[kb][1]); \
        if (f + KPF < 16) kf[f % KPF] = KFR(kp_, f + KPF); \
        AUNIT(P, f); \
        if (f >= 16 - VPF) VRD(vprv, f - (16 - VPF), f - (16 - VPF)); \
        FB_PIN(lsum[0]); FB_PIN(lsum[1]); FB_PIN(pw[0][0]); FB_PIN(pw[0][1]); FB_PIN(pw[1][0]); FB_PIN(pw[1][1]); FB_SBAR(); } \
    if (GK) DMA_K((i) + 3, kfree); if (GV) DMA_V((i) + 1, vnxt); \
    FB_SBAR(); \
    _Pragma("unroll") for (int f = 0; f < 16; ++f) { const int db = f & 7, st = f >> 3; \
        o[0][db] = FC_MFMA(__builtin_bit_cast(bf16x8, pw[0][st]), VFR(f % VPF), o[0][db]); o[1][db] = FC_MFMA(__builtin_bit_cast(bf16x8, pw[1][st]), VFR(f % VPF), o[1][db]); \
        if (f + VPF < 16) VRD(vprv, f + VPF, f % VPF); \
        EXPE(C, 2 * f); EXPE(C, 2 * f + 1); \
        if ((GL) && f >= 8 && f < 8 + KPF) kf[f - 8] = KFR(kn_, f - 8); \
        PINC(C); FB_SBAR(); } \
    WB; \
    } while (0)
    int kcur = 0, knxt = SLOT, kfree = 3 * SLOT, vprv = 0, vnxt = SLOT;
#define ROT() do { kfree = kcur; kcur = knxt; knxt = (knxt == (KSL - 1) * SLOT) ? 0 : knxt + SLOT; vprv = (vnxt == 0) ? (VSL - 1) * SLOT : vnxt - SLOT; vnxt = (vnxt == (VSL - 1) * SLOT) ? 0 : vnxt + SLOT; } while (0)
    DMA_K(0, 0); DMA_V(0, 0); DMA_K(1, SLOT); DMA_K(2, 2 * SLOT);
    FB_WAIT_BAR(6);
    if (n > 3) DMA_K(3, 3 * SLOT);
    DMA_V(1, SLOT);
    {
#pragma unroll
        for (int f = 0; f < 16; ++f) { const int kb = f & 3, ds = f >> 2; const bf16x8 kk = KFR(kp0, f);
            cA[kb][0] = FC_MFMA(kk, qf[0][ds], ds == 0 ? zero4 : cA[kb][0]); cA[kb][1] = FC_MFMA(kk, qf[1][ds], ds == 0 ? zero4 : cA[kb][1]); }
        if (tfirst == 0) {
#pragma unroll
            for (int kb = 1; kb < 4; ++kb) { cA[kb][0] = (f4){-1e30f, -1e30f, -1e30f, -1e30f}; cA[kb][1] = (f4){-1e30f, -1e30f, -1e30f, -1e30f}; } }
        float m0 = -1e30f, m1 = -1e30f;
#pragma unroll
        for (int kb = 0; kb < 4; ++kb)
#pragma unroll
            for (int r = 0; r < 4; ++r) { m0 = fmaxf(m0, cA[kb][0][r]); m1 = fmaxf(m1, cA[kb][1][r]); }
        m0 = fmaxf(m0, __shfl_xor(m0, 16)); m0 = fmaxf(m0, __shfl_xor(m0, 32)); m1 = fmaxf(m1, __shfl_xor(m1, 16)); m1 = fmaxf(m1, __shfl_xor(m1, 32));
        negm0 = (f4){-m0, -m0, -m0, -m0}; negm1 = (f4){-m1, -m1, -m1, -m1}; asm volatile("" : "+v"(negm0), "+v"(negm1));
#pragma unroll
        for (int kb = 0; kb < 4; ++kb)
#pragma unroll
            for (int r = 0; r < 4; ++r) { cA[kb][0][r] = __builtin_amdgcn_exp2f(cA[kb][0][r] - m0); cA[kb][1][r] = __builtin_amdgcn_exp2f(cA[kb][1][r] - m1); }
    }
    if (n > 3) FB_WAIT_BAR(4); else FB_WAIT_BAR(2);
    kcur = SLOT; knxt = 2 * SLOT; kfree = 0; vprv = 0; vnxt = 2 * SLOT;
#pragma unroll
    for (int f = 0; f < KPF; ++f) kf[f] = KFR(kp0 + kcur, f);
    int i = 1;
    for (; i + 5 < n; i += 2) {
        STEP(cB, cA, i, true, true, true, FB_WAIT_BAR(4)); ROT();
        STEP(cA, cB, i + 1, true, true, true, FB_WAIT_BAR(4)); ROT();
    }
    for (; i + 1 < n; i += 2) {
        STEP(cB, cA, i, (i + 3 < n), (i + 1 < n), (i + 1 < n), FB_WAIT_BAR(0)); ROT();
        STEP(cA, cB, i + 1, (i + 4 < n), (i + 2 < n), (i + 2 < n), FB_WAIT_BAR(0)); ROT();
    }
    {
#pragma unroll
        for (int u = 0; u < 16; ++u) AUNIT(cA, u);
#pragma unroll
        for (int f = 0; f < 16; ++f) { const int db = f & 7, st = f >> 3; VRD(vprv, f, 0);
            o[0][db] = FC_MFMA(__builtin_bit_cast(bf16x8, pw[0][st]), VFR(0), o[0][db]); o[1][db] = FC_MFMA(__builtin_bit_cast(bf16x8, pw[1][st]), VFR(0), o[1][db]); }
    }
    FB_WAIT_BAR(0);
    lsum[0] += __shfl_xor(lsum[0], 16); lsum[0] += __shfl_xor(lsum[0], 32); lsum[1] += __shfl_xor(lsum[1], 16); lsum[1] += __shfl_xor(lsum[1], 32);
#undef TILE_OF
#undef DMA_K
#undef DMA_V
#undef KFR
#undef VRD
#undef VFR
#undef AUNIT
#undef EXPE
#undef PINC
#undef STEP
#undef ROT
}
template <class RowPtr>
__device__ __forceinline__ void finish_tile16(f4 (&o)[2][8], const float (&lsum)[2], float* li, char* stage, int lane, RowPtr rowptr) {
    const int i16 = lane & 15, g = lane >> 4;
    if (g == 0) { li[i16] = lsum[0]; li[16 + i16] = lsum[1]; }
    asm volatile("s_waitcnt lgkmcnt(0)" ::: "memory");
    bf16_t* stg = (bf16_t*)stage;
#pragma unroll
    for (int qb = 0; qb < 2; ++qb)
#pragma unroll
        for (int r = 0; r < 4; ++r) { const int row = 16 * qb + 4 * g + r; const float rl = __builtin_amdgcn_rcpf(li[row]);
#pragma unroll
            for (int db = 0; db < 8; ++db) stg[row * 136 + 16 * db + i16] = (bf16_t)f2bf(o[qb][db][r] * rl); }
    asm volatile("s_waitcnt lgkmcnt(0)" ::: "memory");
#pragma unroll
    for (int i = 0; i < 8; ++i) { const int row = i * 4 + (lane >> 4), ch = lane & 15;
        const u32x4 v = *(const u32x4*)(stg + row * 136 + ch * 8);
        bf16_t* gp = rowptr(row); if (gp) *(u32x4*)(gp + ch * 8) = v; }
    asm volatile("s_waitcnt lgkmcnt(0)" ::: "memory");
}
}

namespace fa {
template <class RowPtr>
__device__ __forceinline__ void store_tile(const f32x16 (&y)[4], char* stage, int lane, RowPtr rowptr) {
    const int r32 = lane & 31, hi = lane >> 5;
    bf16_t* stg = (bf16_t*)stage;
#pragma unroll
    for (int r = 0; r < 16; ++r) { const int orow = crow(r, hi);
#pragma unroll
        for (int d0 = 0; d0 < 4; ++d0) stg[orow * 136 + d0 * 32 + r32] = (bf16_t)f2bf(y[d0][r]); }
    asm volatile("s_waitcnt lgkmcnt(0)" ::: "memory");
#pragma unroll
    for (int i = 0; i < 8; ++i) { const int row = i * 4 + (lane >> 4), ch = lane & 15;
        const u32x4 v = *(const u32x4*)(stg + row * 136 + ch * 8);
        bf16_t* gp = rowptr(row); if (gp) *(u32x4*)(gp + ch * 8) = v; }
    asm volatile("s_waitcnt lgkmcnt(0)" ::: "memory");
}
}

constexpr int NPRB = 4 * 11 * 2 + 16 * 11;
constexpr size_t OFF_PART = (OFF_ATT_END + 255) / 256 * 256;
constexpr size_t OFF_PML = OFF_PART + (size_t)NPRB * 32 * 128 * 4;
static_assert(OFF_PML + NPRB * 32 * 2 * 4 <= 256 * MiB, "meta partials");
#ifndef GQA_KPF
#define GQA_KPF 2
#endif
#ifndef GQA_VPF
#define GQA_VPF 2
#endif
constexpr int NRANGE = 11;
constexpr int NMINI_G = 4 * NRANGE, NMINI = 20 * NRANGE;
__device__ __forceinline__ void meta_range(int r, int& t0, int& t1) { t0 = r < 7 ? 11 * r : 77 + 13 * (r - 7); t1 = t0 + (r < 7 ? 11 : 13); }
static_assert(77 + 13 * 4 == fa::NT && NPRB == 2 * NMINI_G + 16 * NRANGE, "meta ranges");

#define LSUM2(l) do { auto rr_ = __builtin_amdgcn_permlane32_swap(__float_as_uint(l), __float_as_uint(l), false, false); l = __uint_as_float(rr_[0]) + __uint_as_float(rr_[1]); } while (0)
#define WS_() ({ unsigned char* w_ = p.ws; asm volatile("" : "+s"(w_)); w_; })
template <bool NC>
__device__ __forceinline__ void attn_gqa_section(const Params& p, char* lds, int vb, int nvb) {
    using namespace fa;
    const int tid = TID(), wid = __builtin_amdgcn_readfirstlane(tid >> 6), lane0 = tid & 63;
    for (int v = vb; v < 256; v += nvb) {
        const int xcd = v & 7, slot = v >> 3;
        for (int k = 0; k < 2; ++k) {
            f32x16 o[4]; float l_reg, m_reg;
            {
                const int b = xcd >> 2, kvh = (xcd >> 1) & 1, h = kvh * 4 + (xcd & 1) * 2 + k, bh = b * 8 + h, qb = slot;
                if constexpr (NC) {
                    fc::f4 o16[2][8]; float ls[2];
                    { unsigned char* ws = WS_(); const bf16_t *QB = (const bf16_t*)(ws + OFF_QB), *KB = (const bf16_t*)(ws + OFF_KB), *VB = (const bf16_t*)(ws + OFF_VB);
                      const size_t kvo = (size_t)(b * 2 + kvh) * KEYS * 128;
                      fc::attn_unit16(QB + ((size_t)bh * QROWS + qb * 256 + wid * 32) * 128, KB + kvo, VB + kvo, lds, 0, 0, NT, o16, ls); }
                    int lane = lane0; asm volatile("" : "+v"(lane));
                    const int wave_row0 = qb * 256 + wid * 32;
                    bf16_t* OB = (bf16_t*)(WS_() + OFF_AO) + 1024;
                    fc::finish_tile16(o16, ls, (float*)(lds + fb::L_WS) + wid * 64, lds + wid * 8704, lane, [&](int row) -> bf16_t* { return OB + (size_t)(b * SEQ + wave_row0 + row) * AOP + h * 128; });
                    __syncthreads();
                } else {
                { bf16x8 qr[8]; const int r32q = lane0 & 31, hiq = lane0 >> 5;
                  unsigned char* ws = WS_(); const bf16_t *QB = (const bf16_t*)(ws + OFF_QB), *KB = (const bf16_t*)(ws + OFF_KB), *VB = (const bf16_t*)(ws + OFF_VB);
                  const bf16_t* q = QB + ((size_t)bh * QROWS + qb * 256 + wid * 32 + r32q) * 128 + hiq * 8;
#pragma unroll
                  for (int d0 = 0; d0 < 8; ++d0) qr[d0] = *reinterpret_cast<const bf16x8*>(q + d0 * 16);
                  const size_t kvo = (size_t)(b * 2 + kvh) * KEYS * 128;
                  fb::attn_unit<false, false, NC, GQA_KPF, GQA_VPF>(qr, KB + kvo, VB + kvo, 0, 0, 0.f, lds, 0, 0, NT, o, l_reg, m_reg); }
                int lane = lane0; asm volatile("" : "+v"(lane));
                const int r32 = lane & 31, hi = lane >> 5;
                LSUM2(l_reg);
                float* li_l = (float*)(lds + fb::L_WS) + wid * 64;
                if (hi == 0) li_l[r32] = l_reg;
                asm volatile("s_waitcnt lgkmcnt(0)" ::: "memory");
#pragma unroll
                for (int r = 0; r < 16; ++r) { const float rl = __builtin_amdgcn_rcpf(li_l[crow(r, hi)]);
#pragma unroll
                    for (int d = 0; d < 4; ++d) o[d][r] *= rl; }
                const int wave_row0 = qb * 256 + wid * 32;
                bf16_t* OB = (bf16_t*)(WS_() + OFF_AO) + 1024;
                store_tile(o, lds + wid * 8704, lane, [&](int row) -> bf16_t* { return OB + (size_t)(b * SEQ + wave_row0 + row) * AOP + h * 128; });
                __syncthreads();
                }
            }
        }
    }
}
template <bool NC>
__device__ __forceinline__ void attn_diff_section(const Params& p, char* lds, int vb, int nvb) {
    using namespace fa;
    const int wid = __builtin_amdgcn_readfirstlane(TID() >> 6);
    __syncthreads();
    if (TID() == 0) ((volatile int*)(lds + fb::L_WS + 2048))[0] = (int)atomicAdd((unsigned*)(WS_() + OFF_QCTR), 1u);
    __syncthreads();
    for (;;) {
                f32x16 o[4]; float l_reg, m_reg;
                const int lane0 = TID() & 63;
                const int uq = __builtin_amdgcn_readfirstlane(((volatile int*)(lds + fb::L_WS + 2048))[0]);
                if (uq >= 1024) break;
                const int h = 7 - (uq >> 7), b = (uq >> 6) & 1, qb = uq & 63, bh = b * 8 + h, mp = wid >> 2, wq = wid & 3;
                int jlo, nvis;
                { const float* nq = (const float*)(WS_() + OFF_NRM) + (b * 8 + h) * 4; const float* nk = nq + 64;
                  const float B0 = sqrtf(nq[0] * nk[0]) + sqrtf(nq[1] * nk[1]), B1 = sqrtf(nq[2] * nk[2]) + sqrtf(nq[3] * nk[3]);
                  const float Bm = 1.02f * fmaxf(B0, B1), slopeC = exp2f(-(float)(h + 1)) * LOG2E;
                  const float dc = fminf((2.f * Bm + 152.f) / slopeC, 16384.f); const int dcut = (int)dc;
                  int lo = qb * 128 - dcut; lo = lo < 0 ? 0 : lo; int hi_ = qb * 128 + 127 + dcut; hi_ = hi_ > SEQ - 1 ? SEQ - 1 : hi_;
                  jlo = 1 + (lo >> 6); int jhi = 1 + (hi_ >> 6); nvis = jhi - jlo + 2;
                  if ((nvis & 1) == 0) { if (jhi < NT - 1) ++jhi; else --jlo; ++nvis; }
                  if (nvis < 3) { jlo = jlo > 1 ? jlo - 1 : jlo; nvis = 3; } }
                { bf16x8 qr[4]; const int r32q = lane0 & 31, hiq = lane0 >> 5; const int qrow = qb * 128 + wq * 32 + r32q;
                  unsigned char* ws = WS_(); const bf16_t *QA = (const bf16_t*)(ws + OFF_QA), *KA = (const bf16_t*)(ws + OFF_KA), *VA = (const bf16_t*)(ws + OFF_VA);
                  const bf16_t* q = QA + ((size_t)bh * QROWS + qrow) * 128 + mp * 64 + hiq * 8;
#pragma unroll
                  for (int d0 = 0; d0 < 4; ++d0) qr[d0] = *reinterpret_cast<const bf16x8*>(q + d0 * 16);
                  const float slopeL = exp2f(-(float)(h + 1)) * LOG2E;
                  const size_t kvo = (size_t)bh * KEYS * 128;
                  fb::attn_unit<true, false, NC>(qr, KA + kvo, VA + kvo, qrow, qb * 128 + wq * 32, slopeL, lds, 0, jlo - 1, nvis, o, l_reg, m_reg); }
                int lane = lane0; asm volatile("" : "+v"(lane));
                const int r32 = lane & 31, hi = lane >> 5;
                unsigned tkn = 0u; if (TID() == 0) tkn = atomicAdd((unsigned*)(WS_() + OFF_QCTR), 1u);
                LSUM2(l_reg);
                float* li_l = (float*)(lds + fb::L_WS) + wid * 64;
                if (hi == 0) li_l[r32] = l_reg;
                asm volatile("s_waitcnt lgkmcnt(0)" ::: "memory");
#pragma unroll
                for (int r = 0; r < 16; ++r) { const float rl = __builtin_amdgcn_rcpf(li_l[crow(r, hi)]);
#pragma unroll
                    for (int d = 0; d < 4; ++d) o[d][r] *= rl; }
                float* X = (float*)lds + wq * 4096;
                if (mp == 1) {
#pragma unroll
                    for (int r = 0; r < 16; ++r)
#pragma unroll
                        for (int d = 0; d < 4; ++d) X[(r * 4 + d) * 64 + lane] = o[d][r];
                }
                __syncthreads();
                if (mp == 0) {
                    const float lam = *(const float*)(WS_() + OFF_LAM);
                    float ss[16];
#pragma unroll
                    for (int r = 0; r < 16; ++r) { float a = 0.f;
#pragma unroll
                        for (int d = 0; d < 4; ++d) { const float y = o[d][r] - lam * X[(r * 4 + d) * 64 + lane]; o[d][r] = y; a += y * y; }
                        ss[r] = a; }
#pragma unroll
                    for (int r = 0; r < 16; ++r) {
                        float a = ss[r];
                        a += __shfl_xor(a, 1); a += __shfl_xor(a, 2); a += __shfl_xor(a, 4); a += __shfl_xor(a, 8); a += __shfl_xor(a, 16);
                        ss[r] = 1.0f / sqrtf(a * (1.0f / 128.f) + EPS) * (1.0f - LAM_INIT);
                    }
                    float g[4];
#pragma unroll
                    for (int d = 0; d < 4; ++d) g[d] = p.g_subln[d * 32 + r32];
#pragma unroll
                    for (int r = 0; r < 16; ++r)
#pragma unroll
                        for (int d = 0; d < 4; ++d) o[d][r] *= ss[r] * g[d];
                }
                __syncthreads();
                if (mp == 0) {
                    const int wave_row0 = qb * 128 + wq * 32;
                    bf16_t* OA = (bf16_t*)(WS_() + OFF_AO);
                    store_tile(o, lds + wid * 8704, lane, [&](int row) -> bf16_t* { return OA + (size_t)(b * SEQ + wave_row0 + row) * AOP + h * 128; });
                }
                if (TID() == 0) ((volatile int*)(lds + fb::L_WS + 2048))[0] = (int)tkn;
                __syncthreads();
    }
}
__device__ __forceinline__ void phase2b(const Params& p, int vb, int nvb) {
    const int tid = TID(), lane = tid & 63, wave = tid >> 6;
    const float* PART = (const float*)(p.ws + OFF_PART); const float* PML = (const float*)(p.ws + OFF_PML);
    bf16_t* OA = (bf16_t*)(p.ws + OFF_AO); bf16_t* OB = OA + 1024;
    const float lam = *(const float*)(p.ws + OFF_LAM);
    for (int t = vb * 8 + wave; t < 512; t += nvb * 8) {
        const int type = t >> 8, b = (t >> 7) & 1, h = (t >> 4) & 7, i = t & 15;
        float y0 = 0.f, y1 = 0.f;
        for (int mp = 0; mp < (type == 0 ? 1 : 2); ++mp) {
            int rb0, row;
            if (type == 0) { const int kvh = h >> 2, w = (h & 3) >> 1; rb0 = ((b * 2 + kvh) * NRANGE) * 2 + w; row = (h & 1) * 16 + i; }
            else { rb0 = 2 * NMINI_G + (b * 8 + h) * NRANGE; row = mp * 16 + i; }
            const int rbs = type == 0 ? 2 : 1;
            float M = -1e30f;
            for (int r = 0; r < NRANGE; ++r) M = fmaxf(M, PML[((rb0 + r * rbs) * 32 + row) * 2]);
            float L = 0.f, a0 = 0.f, a1 = 0.f;
            for (int r = 0; r < NRANGE; ++r) { const int rb = rb0 + r * rbs; const float w = exp2f(PML[(rb * 32 + row) * 2] - M);
                L += PML[(rb * 32 + row) * 2 + 1] * w; const float2 ov = *(const float2*)(PART + ((size_t)rb * 32 + row) * 128 + 2 * lane); a0 += ov.x * w; a1 += ov.y * w; }
            const float sgn = mp == 0 ? 1.f : -lam;
            y0 += sgn * a0 / L; y1 += sgn * a1 / L;
        }
        const size_t grow = (size_t)(MREAL + b * NMETA + i);
        if (type == 0) ((unsigned*)(OB + grow * AOP + h * 128))[lane] = f2bf(y0) | (f2bf(y1) << 16);
        else { const float ss = wave_sum(y0 * y0 + y1 * y1); const float rstd = 1.0f / sqrtf(ss * (1.0f / 128.f) + EPS) * (1.0f - LAM_INIT);
            ((unsigned*)(OA + grow * AOP + h * 128))[lane] = f2bf(y0 * rstd * p.g_subln[2 * lane]) | (f2bf(y1 * rstd * p.g_subln[2 * lane + 1]) << 16); }
    }
}

__device__ __forceinline__ void phase2_fast(const Params& p, char* lds, int vb, int nvb) {
    using namespace fa;
    const int tid = TID(), wid = __builtin_amdgcn_readfirstlane(tid >> 6), lane0 = tid & 63;
    for (int v = vb; v < 256; v += nvb) {
        const int xcd = v & 7, slot = v >> 3;
        if (v < NMINI) {
            f32x16 o[4]; float l_reg, m_reg; bf16x8 qr[8]; int t0, t1, rb; bool active;
            const int r32q = lane0 & 31, hiq = lane0 >> 5;
            if (v < NMINI_G) { const int g = v / NRANGE, rg = v % NRANGE, b = g >> 1, kvh = g & 1; meta_range(rg, t0, t1);
                active = wid < 2; const int h = kvh * 4 + (wid & 1) * 2 + (r32q >> 4);
                unsigned char* ws = WS_(); const bf16_t *QB = (const bf16_t*)(ws + OFF_QB), *KB = (const bf16_t*)(ws + OFF_KB), *VB = (const bf16_t*)(ws + OFF_VB);
                const bf16_t* q = QB + ((size_t)(b * 8 + h) * QROWS + SEQ + (r32q & 15)) * 128 + hiq * 8;
#pragma unroll
                for (int d0 = 0; d0 < 8; ++d0) qr[d0] = *reinterpret_cast<const bf16x8*>(q + d0 * 16);
                const size_t kvo = (size_t)(b * 2 + kvh) * KEYS * 128; rb = (g * NRANGE + rg) * 2 + (wid & 1);
                if (active) fb::attn_unit<false, false>(qr, KB + kvo, VB + kvo, 0, 0, 0.f, lds, t0, t0, t1 - t0, o, l_reg, m_reg); else fb::attn_unit<false, true>(qr, KB + kvo, VB + kvo, 0, 0, 0.f, lds, t0, t0, t1 - t0, o, l_reg, m_reg);
            } else { const int bh = (v - NMINI_G) / NRANGE, rg = (v - NMINI_G) % NRANGE; meta_range(rg, t0, t1);
                active = wid == 0; const int mp = r32q >> 4;
                unsigned char* ws = WS_(); const bf16_t *QA = (const bf16_t*)(ws + OFF_QA), *KA = (const bf16_t*)(ws + OFF_KA), *VA = (const bf16_t*)(ws + OFF_VA);
                const bf16_t* q = QA + ((size_t)bh * QROWS + SEQ + (r32q & 15)) * 128 + mp * 64 + hiq * 8;
#pragma unroll
                for (int d0 = 0; d0 < 8; ++d0) { const bf16x8 x = *reinterpret_cast<const bf16x8*>(q + (d0 & 3) * 16); qr[d0] = ((d0 >> 2) == mp) ? x : bf16x8{}; }
                const size_t kvo = (size_t)bh * KEYS * 128; rb = 2 * NMINI_G + bh * NRANGE + rg;
                if (active) fb::attn_unit<false, false>(qr, KA + kvo, VA + kvo, 0, 0, 0.f, lds, t0, t0, t1 - t0, o, l_reg, m_reg); else fb::attn_unit<false, true>(qr, KA + kvo, VA + kvo, 0, 0, 0.f, lds, t0, t0, t1 - t0, o, l_reg, m_reg);
            }
            if (active) {
                int lane = lane0; asm volatile("" : "+v"(lane));
                const int r32 = lane & 31, hi = lane >> 5;
                LSUM2(l_reg);
                unsigned char* ws = WS_(); float* PART = (float*)(ws + OFF_PART); float* PML = (float*)(ws + OFF_PML);
                float* po = PART + (size_t)rb * 32 * 128;
#pragma unroll
                for (int r = 0; r < 16; ++r)
#pragma unroll
                    for (int d = 0; d < 4; ++d) po[crow(r, hi) * 128 + d * 32 + r32] = o[d][r];
                if (hi == 0) { PML[(rb * 32 + r32) * 2] = m_reg; PML[(rb * 32 + r32) * 2 + 1] = l_reg; }
            }
            asm volatile("s_waitcnt vmcnt(0)" ::: "memory");
            __syncthreads();
            if (TID() == 0) { __builtin_amdgcn_fence(__ATOMIC_RELEASE, "agent"); asm volatile("s_waitcnt vmcnt(0)" ::: "memory");
                (void)__hip_atomic_fetch_add((unsigned*)(WS_() + OFF_MINIDONE), 1u, __ATOMIC_RELAXED, __HIP_MEMORY_SCOPE_AGENT); }
        }
    }
    __syncthreads();
    { const int t16 = TID();
      if (t16 < 64) { bool ok = true;
        float gq = fmaxf(fabsf(p.g_qnorm[t16]), fabsf(p.g_qnorm[t16 + 64])), gk = fmaxf(fabsf(p.g_knorm[t16]), fabsf(p.g_knorm[t16 + 64]));
        gq = wave_max(gq); gk = wave_max(gk);
        const float U = 1.02f * 128.f * gq * gk * CB;
        ok = 2.f * U <= 90.f;
        if (t16 < 16) { const int b = t16 >> 3, h = t16 & 7; const float* nrm = (const float*)(WS_() + OFF_NRM);
            const float* dq = nrm + (b * 8 + h) * 4; const float* dk = dq + 64;
            const float Bm = 1.02f * fmaxf(sqrtf(dq[0] * dk[0]) + sqrtf(dq[1] * dk[1]), sqrtf(dq[2] * dk[2]) + sqrtf(dq[3] * dk[3]));
            ok = ok && (2.f * Bm <= 90.f); }
        const bool all_ = __all(ok);
        if (t16 == 0) ((volatile int*)(lds + fb::L_WS + 2048))[1] = all_ ? 1 : 0; } }
    __syncthreads();
    const bool allsafe = __builtin_amdgcn_readfirstlane(((volatile int*)(lds + fb::L_WS + 2048))[1]) != 0;
    if (allsafe) attn_gqa_section<true>(p, lds, vb, nvb); else attn_gqa_section<false>(p, lds, vb, nvb);
    if (vb * 8 < 512) {
        if (TID() == 0) { unsigned* ctr = (unsigned*)(WS_() + OFF_MINIDONE); unsigned sp = 0;
            while (__hip_atomic_load(ctr, __ATOMIC_RELAXED, __HIP_MEMORY_SCOPE_AGENT) < (unsigned)NMINI) { __builtin_amdgcn_s_sleep(1); if (++sp > (1u << 24)) break; }
            __builtin_amdgcn_fence(__ATOMIC_ACQUIRE, "agent"); asm volatile("s_waitcnt vmcnt(0)" ::: "memory"); }
        __syncthreads();
        phase2b(p, vb, nvb);
    }
    if (allsafe) attn_diff_section<true>(p, lds, vb, nvb); else attn_diff_section<false>(p, lds, vb, nvb);
}
#undef LSUM2
#undef WS_
__device__ __forceinline__ float* h2_row(const Params& p, int grow) { return grow < MREAL ? p.out + (size_t)grow * DM : (float*)(p.ws + OFF_H2M) + (size_t)(grow - MREAL) * DM; }
__device__ __forceinline__ void phase4a(const Params& p, float* lds, int vb, int nvb) {
    const int tid = TID(), lane = tid & 63, wave = tid >> 6;
    for (int idx = tid; idx < DM * NEXP; idx += NTHREADS) { const int k = idx >> 4, e = idx & 15; lds[(((k >> 4) * 4 + ((k >> 2) & 3)) * 16 + e) * 4 + (k & 3)] = p.g_ffn[k] * p.w_router[idx]; }
    __syncthreads();
    bf16_t* U2 = (bf16_t*)(p.ws + OFF_UN); float* AFF = (float*)(p.ws + OFF_AFF);
    const int ri_ = lane & 15, q = lane >> 4;
    f32x4 gl[4];
#pragma unroll
    for (int c = 0; c < 4; ++c) gl[c] = *(const f32x4*)(p.g_ffn + 16 * lane + 4 * c);
    for (int t = wave * nvb + vb; t < MROWS / 16; t += 8 * nvb) {
        const int R0 = t * 16;
        const float* xrow = h2_row(p, R0 + ri_) + 4 * q;
        f32x4 acc = (f32x4){0.f, 0.f, 0.f, 0.f}; float ss = 0.f;
#pragma unroll 8
        for (int it = 0; it < 64; ++it) {
            const f32x4 x = *(const f32x4*)(xrow + 16 * it); const f32x4 w = *(const f32x4*)(lds + ((it * 4 + q) * 16 + ri_) * 4);
            acc = __builtin_amdgcn_mfma_f32_16x16x4f32(x.x, w.x, acc, 0, 0, 0); acc = __builtin_amdgcn_mfma_f32_16x16x4f32(x.y, w.y, acc, 0, 0, 0);
            acc = __builtin_amdgcn_mfma_f32_16x16x4f32(x.z, w.z, acc, 0, 0, 0); acc = __builtin_amdgcn_mfma_f32_16x16x4f32(x.w, w.w, acc, 0, 0, 0);
            ss += (x.x * x.x + x.y * x.y) + (x.z * x.z + x.w * x.w);
        }
        ss += __shfl_xor(ss, 16); ss += __shfl_xor(ss, 32);
        const float rstd_i = 1.0f / sqrtf(ss * (1.0f / DM) + EPS);
#pragma unroll
        for (int reg = 0; reg < 4; ++reg) {
            const int row = R0 + 4 * q + reg; const float lg = acc[reg] * __shfl(rstd_i, 4 * q + reg);
            float mx = lg; mx = fmaxf(mx, __shfl_xor(mx, 1)); mx = fmaxf(mx, __shfl_xor(mx, 2)); mx = fmaxf(mx, __shfl_xor(mx, 4)); mx = fmaxf(mx, __shfl_xor(mx, 8));
            const float ex = expf(lg - mx); float den = ex; den += __shfl_xor(den, 1); den += __shfl_xor(den, 2); den += __shfl_xor(den, 4); den += __shfl_xor(den, 8);
            const RowInfo ri = row_decode(row);
            AFF[((size_t)ri.b * NEXP + ri_) * LTOT + row_pos(ri)] = ex / den;
        }
        for (int rr = 0; rr < 16; ++rr) {
            const float rs = __shfl(rstd_i, rr); const float* xr = h2_row(p, R0 + rr) + 16 * lane;
            const f32x4 x0 = *(const f32x4*)xr * gl[0] * rs, x1 = *(const f32x4*)(xr + 4) * gl[1] * rs, x2 = *(const f32x4*)(xr + 8) * gl[2] * rs, x3 = *(const f32x4*)(xr + 12) * gl[3] * rs;
            u32x4* o = (u32x4*)(U2 + (size_t)(R0 + rr) * DM + 16 * lane);
            o[0] = (u32x4){f2bf(x0.x) | (f2bf(x0.y) << 16), f2bf(x0.z) | (f2bf(x0.w) << 16), f2bf(x1.x) | (f2bf(x1.y) << 16), f2bf(x1.z) | (f2bf(x1.w) << 16)};
            o[1] = (u32x4){f2bf(x2.x) | (f2bf(x2.y) << 16), f2bf(x2.z) | (f2bf(x2.w) << 16), f2bf(x3.x) | (f2bf(x3.y) << 16), f2bf(x3.z) | (f2bf(x3.w) << 16)};
        }
    }
    __syncthreads();
}

__device__ __forceinline__ void phase6(const Params& p, int vb, int nvb) {
    const int tid = TID(), lane = tid & 63, wave = tid >> 6;
    const int* SEL = (const int*)(p.ws + OFF_SEL); const bf16_t* YB = (const bf16_t*)(p.ws + OFF_YB);
    f32x4 gf[4];
#pragma unroll
    for (int j = 0; j < 4; ++j) gf[j] = ((const f32x4*)p.g_final)[lane + 64 * j];
    for (int r0 = vb * 8 + wave; r0 < MREAL; r0 += nvb * 8 * 2) {
        f32x4 v[2][4]; int sel[2];
#pragma unroll
        for (int h = 0; h < 2; ++h) { const int r = r0 + h * nvb * 8; const int rr = r < MREAL ? r : r0; const int b = rr >> 13, tok = NMETA + (rr & (SEQ - 1));
            const f32x4* xr = (const f32x4*)(p.out + (size_t)rr * DM) + lane;
#pragma unroll
            for (int j = 0; j < 4; ++j) v[h][j] = xr[64 * j];
            sel[h] = lane < NEXP ? SEL[((size_t)b * LTOT + tok) * NEXP + lane] : -1; }
#pragma unroll
        for (int h = 0; h < 2; ++h) { const int r = r0 + h * nvb * 8; if (r >= MREAL) continue; const int b = r >> 13;
            unsigned long long msk = __ballot(sel[h] >= 0);
            while (msk) { const int e = __builtin_ctzll(msk); msk &= msk - 1; const int c = __shfl(sel[h], e);
                const u32x2* y = (const u32x2*)(YB + ((size_t)e * ESLOTS + b * CAP + c) * DM) + lane;
#pragma unroll
                for (int j = 0; j < 4; ++j) { const u32x2 w = y[64 * j]; v[h][j].x += bf2f(w.x & 0xffffu); v[h][j].y += bf2f(w.x >> 16); v[h][j].z += bf2f(w.y & 0xffffu); v[h][j].w += bf2f(w.y >> 16); } }
            float s = 0.f;
#pragma unroll
            for (int j = 0; j < 4; ++j) s += (v[h][j].x * v[h][j].x + v[h][j].y * v[h][j].y) + (v[h][j].z * v[h][j].z + v[h][j].w * v[h][j].w);
            const float rstd = 1.0f / sqrtf(wave_sum(s) * (1.0f / DM) + EPS);
            f32x4* xo = (f32x4*)(p.out + (size_t)r * DM) + lane;
#pragma unroll
            for (int j = 0; j < 4; ++j) xo[64 * j] = v[h][j] * gf[j] * rstd; }
    }
}

template <class DstRow>
__device__ __forceinline__ void transpose_item(const float* __restrict__ W, int N, bf16_t* __restrict__ WT, int ldk, int koff, float* scr, int k0, int n0, int lane, DstRow dst) {
    f32x4 t_[8];
#pragma unroll
    for (int i = 0; i < 8; ++i) t_[i] = *(const f32x4*)(W + (size_t)(k0 + 8 * i + (lane >> 3)) * N + n0 + (lane & 7) * 4);
#pragma unroll
    for (int i = 0; i < 8; ++i) { float* d_ = scr + (8 * i + (lane >> 3)) * 33 + (lane & 7) * 4; d_[0] = t_[i].x; d_[1] = t_[i].y; d_[2] = t_[i].z; d_[3] = t_[i].w; }
    asm volatile("s_waitcnt vmcnt(0) lgkmcnt(0)" ::: "memory");
    const int c = lane & 7;
#pragma unroll
    for (int j = 0; j < 4; ++j) { const int n = (lane >> 3) + 8 * j; const float* sp = scr + (8 * c) * 33 + n;
        u32x4 o; o.x = f2bf(sp[0 * 33]) | (f2bf(sp[1 * 33]) << 16); o.y = f2bf(sp[2 * 33]) | (f2bf(sp[3 * 33]) << 16);
        o.z = f2bf(sp[4 * 33]) | (f2bf(sp[5 * 33]) << 16); o.w = f2bf(sp[6 * 33]) | (f2bf(sp[7 * 33]) << 16);
        *(u32x4*)(WT + (size_t)dst(n0 + n) * ldk + koff + k0 + 8 * c) = o; }
    asm volatile("s_waitcnt lgkmcnt(0)" ::: "memory");
}
__device__ __forceinline__ int rope_slot(int e) { const int half = e >> 6, el = e & 63, j = el & 31, n = el >> 5, g = half * 8 + (j >> 2); return 32 * (g >> 2) + 8 * (g & 3) + 4 * n + (j & 3); }
__device__ __forceinline__ void transpose_p0(const Params& p, float* lds, int vb, int nvb) {
    const int tid = TID(), lane = tid & 63, wave = tid >> 6;
    float* scr = lds + wave * (64 * 33);
    bf16_t* WIN = (bf16_t*)(p.ws + OFF_WIN); bf16_t* WAB = (bf16_t*)(p.ws + OFF_WAB); bf16_t* WO = (bf16_t*)(p.ws + OFF_WO);
    constexpr int I_IN = 16 * (INW / 32), I_SQ = 16 * 32;
    for (int it = vb * 8 + wave; it < I_IN + 3 * I_SQ; it += nvb * 8) {
        int r = it;
        if (r < I_IN) { const int kb = r / (INW / 32), nb = r % (INW / 32);
            transpose_item(p.w_in, INW, WIN, DM, 0, scr, kb * 64, nb * 32, lane, [](int n) { return (n >= 3072 && n < 4352) ? (n & ~127) + rope_slot(n & 127) : n; }); continue; }
        r -= I_IN; const int m = r / I_SQ, q = r % I_SQ, kb = q / 32, nb = q % 32;
        if (m == 0) transpose_item(p.w_ba, DM, WAB, 2048, 0, scr, kb * 64, nb * 32, lane, [](int n) { return n; });
        else if (m == 1) transpose_item(p.w_bb, DM, WAB, 2048, 1024, scr, kb * 64, nb * 32, lane, [](int n) { return n; });
        else transpose_item(p.w_out, DM, WO, DM, 0, scr, kb * 64, nb * 32, lane, [](int n) { return n; });
    }
}
__device__ __forceinline__ void transpose_moe(const Params& p, float* lds, int vbl, int nvbl) {
    const int tid = TID(), lane = tid & 63, wave = tid >> 6;
    float* scr = lds + wave * (64 * 33);
    bf16_t* WGU = (bf16_t*)(p.ws + OFF_WGU); bf16_t* WD = (bf16_t*)(p.ws + OFF_WD);
    constexpr int I_G = 16 * 16, I_D = 8 * 32, I_E = 2 * I_G + I_D;
    for (int it = vbl * 8 + wave; it < NEXP * I_E; it += nvbl * 8) {
        const int e = it / I_E; int r = it % I_E;
        if (r < 2 * I_G) { const int up = r / I_G, q = r % I_G, kb = q / 16, nb = q % 16;
            const float* W = (up ? p.w_up : p.w_gate) + (size_t)e * DM * EFF;
            transpose_item(W, EFF, WGU + (size_t)e * DM * DM, DM, 0, scr, kb * 64, nb * 32, lane, [up](int f) { return 8 * (f >> 2) + 4 * up + (f & 3); }); }
        else { r -= 2 * I_G; const int kb = r / 32, nb = r % 32;
            transpose_item(p.w_down + (size_t)e * EFF * DM, DM, WD + (size_t)e * DM * EFF, EFF, 0, scr, kb * 64, nb * 32, lane, [](int n) { return n; }); }
    }
}

namespace pg8 {
#define PG8_LAS __attribute__((address_space(3)))
typedef short bf16x8 __attribute__((ext_vector_type(8)));
constexpr int BM = 256, BK = 64, HALF = 128, HTB = HALF * BK * 2, STAGE_BYTES = 8 * HTB, NXCD = 8, WGM = 8;
__host__ __device__ __forceinline__ int lds_byte(int r, int c) { const int st = (r >> 4) * 2 + (c >> 5), rr = r & 15, cc = c & 31, ob = rr * 64 + cc * 2; return st * 1024 + (ob ^ (((ob >> 9) & 1) << 5)); }
__host__ __device__ __forceinline__ void stage_rc(int b, int& R, int& C) { const int st = b / 1024, sb = b % 1024, swz = sb ^ (((sb >> 9) & 1) << 5); R = (st >> 1) * 16 + swz / 64; C = (st & 1) * 32 + (swz % 64) / 2; }
__host__ __device__ __forceinline__ int perm32(int rho) { const int n = rho >> 4, i = rho & 15; return 8 * (i >> 2) + 4 * n + (i & 3); }
struct Unit { int arow0, brow0, pm, pn, e; };
struct Gemm { const bf16_t* A; const bf16_t* Bt; int K; };
struct GridOrder {
    static constexpr bool GATHER = false;
    int nM, nN, nwg, G, c;
    __device__ unsigned arow_off(const Unit&, int) const { return 0u; }
    __device__ void init(int nM_, int nN_, int G_, int c_) { nM = nM_; nN = nN_; nwg = nM * nN; G = G_; c = c_; }
    __device__ bool next(int i, Unit& u) const {
        const long L = (long)i * G + c; if (L >= nwg) return false;
        int wgid = (int)L; { const int q = nwg / NXCD, r = nwg % NXCD, xcd = wgid % NXCD, off = wgid / NXCD; wgid = (xcd < r ? xcd * (q + 1) : r * (q + 1) + (xcd - r) * q) + off; }
        const int nig = WGM * nN, gid = wgid / nig, fm = gid * WGM, gsz = (nM - fm) < WGM ? (nM - fm) : WGM;
        u.pm = fm + ((wgid % nig) % gsz); u.pn = (wgid % nig) / gsz; u.e = 0; u.arow0 = u.pm * BM; u.brow0 = u.pn * BM; return true;
    }
};
template <bool GATHER_>
struct MoeOrderT {
    static constexpr bool GATHER = GATHER_;
    int G, c; const int* idx;
    __device__ bool next(int i, Unit& u) const {
        const int L = i * G + c; if (L >= NEXP * 32) return false;
        u.e = L >> 5; const int r = L & 31; u.pm = r & 7; u.pn = r >> 3; u.arow0 = u.e * ESLOTS + u.pm * BM; u.brow0 = u.e * DM + u.pn * BM; return true;
    }
    __device__ __forceinline__ unsigned arow_off(const Unit& u, int r) const {
        const int s = u.pm * BM + r, b = s >= CAP ? 1 : 0, cc = s - b * CAP; const int tok = idx[((size_t)b * NEXP + u.e) * CAP + cc];
        return (unsigned)pos_row(b, tok) * (unsigned)(DM * 2);
    }
};
__device__ __forceinline__ unsigned cvt_pk_bf16(float lo, float hi) { unsigned r; asm volatile("v_cvt_pk_bf16_f32 %0, %1, %2" : "=v"(r) : "v"(lo), "v"(hi)); return r; }
__device__ __forceinline__ float fsig(float x) { return __builtin_amdgcn_rcpf(1.0f + __builtin_amdgcn_exp2f(-1.4426950408889634f * x)); }

template <class Epi, class Sched>
__device__ __forceinline__ void gemm_phase(PG8_LAS unsigned char* lds, const Gemm g, const Sched& S, const Epi& E) {
    const int tid = TID(), wid = __builtin_amdgcn_readfirstlane(tid >> 6), lane = tid & 63, wr = wid >> 2, wc = wid & 3, fr = lane & 15, fq = lane >> 4;
    const int K = g.K, nt = K / BK;
    constexpr bool GA = Sched::GATHER;
    const size_t kstep = (size_t)(BK * 2);
    const size_t hstep = (size_t)HALF * K * 2;
    unsigned voA[2][2], nvA[2][2], voffB[2]; int Rs[2], Cs[2];
#pragma unroll
    for (int i = 0; i < 2; ++i) { int R, C; stage_rc(tid * 16 + i * 8192, R, C); const int Rb = Epi::PERM ? ((R & ~31) + perm32(R & 31)) : R; Rs[i] = R; Cs[i] = C;
        voA[0][i] = (unsigned)(R * K + C) * 2u; voA[1][i] = 0u; nvA[0][i] = voA[0][i]; nvA[1][i] = 0u; voffB[i] = (unsigned)(Rb * K + C) * 2u; }
#define PG8_STAGEA(bufoff, base, h, VO) do { if (GA) PG8_STAGE(bufoff, base, VO[h]); else PG8_STAGE(bufoff, (base) + (h) * hstep, VO[0]); } while (0)
#define PG8_AOFF(dst, u) do { if (GA) { _Pragma("unroll") for (int h_ = 0; h_ < 2; ++h_) _Pragma("unroll") for (int i_ = 0; i_ < 2; ++i_) dst[h_][i_] = S.arow_off(u, h_ * HALF + Rs[i_]) + (unsigned)Cs[i_] * 2u; } } while (0)
    const size_t rstep = (size_t)K * 2;
    const unsigned ldsw = (unsigned)wid * 1024u;
    const int aoff = lds_byte(wr * 64 + fr, fq * 8), boff = lds_byte(wc * 32 + fr, fq * 8);
#define PG8_SA(b, h) (((b) * 2 + (h)) * HTB)
#define PG8_SB(b, h) ((4 + (b) * 2 + (h)) * HTB)
#define PG8_STAGE(bufoff, gbase, voff) do { _Pragma("unroll") for (int _i = 0; _i < 2; ++_i) \
        __builtin_amdgcn_global_load_lds((const unsigned*)((const char*)(gbase) + (voff)[_i]), (PG8_LAS unsigned*)(lds + (bufoff) + ldsw + _i * 8192), 16, 0, 0); } while (0)
#define PG8_LDA(dst, b, h) do { _Pragma("unroll") for (int m = 0; m < 4; ++m) _Pragma("unroll") for (int k = 0; k < 2; ++k) dst[m][k] = *(const PG8_LAS bf16x8*)(lds + PG8_SA(b, h) + aoff + m * 2048 + k * 1024); } while (0)
#define PG8_LDB(dst, b, h) do { _Pragma("unroll") for (int n = 0; n < 2; ++n) _Pragma("unroll") for (int k = 0; k < 2; ++k) dst[n][k] = *(const PG8_LAS bf16x8*)(lds + PG8_SB(b, h) + boff + n * 2048 + k * 1024); } while (0)
#define PG8_MMA(ai, bj, At, Bt) do { __builtin_amdgcn_s_setprio(1); _Pragma("unroll") for (int m = 0; m < 4; ++m) _Pragma("unroll") for (int n = 0; n < 2; ++n) _Pragma("unroll") for (int k = 0; k < 2; ++k) \
        acc[ai][bj][m][n] = __builtin_amdgcn_mfma_f32_16x16x32_bf16(Bt[n][k], At[m][k], acc[ai][bj][m][n], 0, 0, 0); __builtin_amdgcn_s_setprio(0); } while (0)
#define PG8_WAIT_V(n) asm volatile("s_waitcnt vmcnt(" #n ")" ::: "memory")
#define PG8_WAIT_L(n) asm volatile("s_waitcnt lgkmcnt(" #n ")" ::: "memory")
#define PG8_BAR __builtin_amdgcn_s_barrier()
#define PG8_SCHED __builtin_amdgcn_sched_barrier(0)
    Unit cur, nxt; int ui = 0;
    if (!S.next(0, cur)) return;
    f32x4 acc[2][2][4][2];
#pragma unroll
    for (int a = 0; a < 2; ++a)
#pragma unroll
        for (int b = 0; b < 2; ++b)
#pragma unroll
            for (int m = 0; m < 4; ++m)
#pragma unroll
                for (int n = 0; n < 2; ++n) acc[a][b][m][n] = (f32x4){0.f, 0.f, 0.f, 0.f};
    bf16x8 At[4][2], B0[2][2], B1[2][2];
    const char* cA = (const char*)g.A + (GA ? (size_t)0 : (size_t)cur.arow0 * rstep); const char* cB = (const char*)g.Bt + (size_t)cur.brow0 * rstep;
    PG8_AOFF(voA, cur);
    PG8_STAGE(PG8_SB(0, 0), cB, voffB); PG8_STAGE(PG8_SB(0, 1), cB + hstep, voffB); PG8_STAGEA(PG8_SA(0, 0), cA, 0, voA); PG8_STAGEA(PG8_SA(0, 1), cA, 1, voA);
    if (wr == 1) PG8_BAR;
    PG8_WAIT_V(2); PG8_BAR;
    PG8_STAGE(PG8_SB(1, 0), cB + kstep, voffB); PG8_STAGEA(PG8_SA(1, 0), cA + kstep, 0, voA); PG8_STAGE(PG8_SB(1, 1), cB + hstep + kstep, voffB);
    PG8_WAIT_V(6); PG8_BAR;
    for (;;) {
        const bool has_next = S.next(ui + 1, nxt);
        const char* nA = (has_next && !GA) ? (const char*)g.A + (size_t)nxt.arow0 * rstep : cA; const char* nB = has_next ? (const char*)g.Bt + (size_t)nxt.brow0 * rstep : cB;
        if (GA) { if (has_next) PG8_AOFF(nvA, nxt); else { _Pragma("unroll") for (int h_ = 0; h_ < 2; ++h_) _Pragma("unroll") for (int i_ = 0; i_ < 2; ++i_) nvA[h_][i_] = voA[h_][i_]; } }
        for (int t = 0; t < nt; t += 2) {
            const bool last = (t == nt - 2);
            unsigned w2[2][2];
#pragma unroll
            for (int h_ = 0; h_ < 2; ++h_)
#pragma unroll
                for (int i_ = 0; i_ < 2; ++i_) w2[h_][i_] = (GA && last) ? nvA[h_][i_] : voA[h_][i_];
            const char* a1 = cA + (size_t)(t + 1) * kstep;
            const char* a2 = last ? nA : cA + (size_t)(t + 2) * kstep; const char* b2 = last ? nB : cB + (size_t)(t + 2) * kstep;
            const char* a3 = a2 + kstep; const char* b3 = b2 + kstep;
            if constexpr (Epi::HAS_MID) { if (t == nt / 2) E.mid(acc, cur, wr, wc, fr, fq); }
            PG8_LDB(B0, 0, 0); PG8_LDB(B1, 0, 1); PG8_SCHED; PG8_LDA(At, 0, 0); PG8_STAGEA(PG8_SA(1, 1), a1, 1, voA);
            PG8_WAIT_V(8); PG8_WAIT_L(0); PG8_BAR; PG8_MMA(0, 0, At, B0); PG8_MMA(0, 1, At, B1); PG8_BAR; PG8_SCHED;
            PG8_LDA(At, 0, 1); PG8_STAGE(PG8_SB(0, 0), b2, voffB); PG8_STAGE(PG8_SB(0, 1), b2 + hstep, voffB); PG8_STAGEA(PG8_SA(0, 0), a2, 0, w2);
            PG8_WAIT_V(8); PG8_WAIT_L(0); PG8_BAR; PG8_MMA(1, 0, At, B0); PG8_MMA(1, 1, At, B1); PG8_BAR; PG8_SCHED;
            PG8_LDB(B0, 1, 0); PG8_LDB(B1, 1, 1); PG8_SCHED; PG8_LDA(At, 1, 0); PG8_STAGEA(PG8_SA(0, 1), a2, 1, w2);
            PG8_WAIT_V(8); PG8_WAIT_L(0); PG8_BAR; PG8_MMA(0, 0, At, B0); PG8_MMA(0, 1, At, B1); PG8_BAR; PG8_SCHED;
            PG8_LDA(At, 1, 1); PG8_STAGE(PG8_SB(1, 0), b3, voffB); PG8_STAGE(PG8_SB(1, 1), b3 + hstep, voffB); PG8_STAGEA(PG8_SA(1, 0), a3, 0, w2);
            PG8_WAIT_V(8); PG8_WAIT_L(0); PG8_BAR; PG8_MMA(1, 0, At, B0); PG8_MMA(1, 1, At, B1); PG8_BAR; PG8_SCHED;
        }
        if (wr == 0) PG8_BAR;
        E(acc, cur, wr, wc, fr, fq, lds);
        if (!has_next) break;
#pragma unroll
        for (int a = 0; a < 2; ++a)
#pragma unroll
            for (int b = 0; b < 2; ++b)
#pragma unroll
                for (int m = 0; m < 4; ++m)
#pragma unroll
                    for (int n = 0; n < 2; ++n) acc[a][b][m][n] = (f32x4){0.f, 0.f, 0.f, 0.f};
        cur = nxt; cA = nA; cB = nB; ++ui;
        if (GA) { _Pragma("unroll") for (int h_ = 0; h_ < 2; ++h_) _Pragma("unroll") for (int i_ = 0; i_ < 2; ++i_) voA[h_][i_] = nvA[h_][i_]; }
        if (wr == 1) PG8_BAR;
    }
    PG8_WAIT_V(0);
    PG8_BAR;
#undef PG8_AOFF
#undef PG8_STAGEA
#undef PG8_SA
#undef PG8_SB
#undef PG8_STAGE
#undef PG8_LDA
#undef PG8_LDB
#undef PG8_MMA
#undef PG8_WAIT_V
#undef PG8_WAIT_L
#undef PG8_SCHED
}
#define PG8_FOR_AM _Pragma("unroll") for (int ai = 0; ai < 2; ++ai) _Pragma("unroll") for (int m = 0; m < 4; ++m)
#define PG8_FOR_BJ _Pragma("unroll") for (int bj = 0; bj < 2; ++bj)

struct EpiInProj {
    static constexpr bool PERM = true, HAS_MID = false;
    Params p;
    __device__ __forceinline__ void operator()(f32x4 (&acc)[2][2][4][2], const Unit& u, int wr, int wc, int fr, int fq, PG8_LAS unsigned char* lds) const {
        const int pn = u.pn;
        const int sec = pn < 4 ? 0 : pn < 8 ? 1 : pn < 12 ? 2 : pn < 16 ? 3 : pn == 16 ? 4 : pn == 17 ? 5 : pn < 22 ? 6 : 7;
        const int head0 = (sec == 0 ? pn : sec == 1 ? pn - 4 : sec == 2 ? pn - 8 : sec == 3 ? pn - 12 : sec == 6 ? pn - 18 : sec == 7 ? pn - 22 : 0) * 2;
        const int cl = wc * 32 + fq * 8;
        if (sec == 3 || sec == 4) {
            PG8_LAS float* X = (PG8_LAS float*)(lds + STAGE_BYTES);
            PG8_FOR_AM { PG8_FOR_BJ { const f32x4 a = acc[ai][bj][m][0], b = acc[ai][bj][m][1];
                float ss = (a.x * a.x + a.y * a.y) + (a.z * a.z + a.w * a.w) + (b.x * b.x + b.y * b.y) + (b.z * b.z + b.w * b.w);
                ss += __shfl_xor(ss, 16); ss += __shfl_xor(ss, 32);
                if (fq == 0) X[((ai * 128 + wr * 64 + m * 16 + fr) * 2 + bj) * 4 + wc] = ss; } }
            asm volatile("s_waitcnt lgkmcnt(0)" ::: "memory"); __builtin_amdgcn_s_barrier(); asm volatile("" ::: "memory");
            const int g = wc * 4 + fq, j0 = (g & 7) * 4, e0 = (g >> 3) * 64 + j0;
            const float* gn = sec == 3 ? p.g_qnorm : p.g_knorm;
            const f32x4 g1 = *(const f32x4*)(gn + e0), g2 = *(const f32x4*)(gn + e0 + 32);
            const float sc = sec == 3 ? CB : 1.f;
            const float2* rope = (const float2*)(p.ws + OFF_ROPE);
            PG8_FOR_AM { const int rl = ai * 128 + wr * 64 + m * 16 + fr, grow = u.pm * BM + rl; RowInfo ri; if (u.pm < MREAL / BM) { ri.b = u.pm >> 5; ri.t = grow & (SEQ - 1); ri.meta = 0; ri.valid = 1; } else ri = row_decode(grow);
                f32x4 c4 = (f32x4){1.f, 1.f, 1.f, 1.f}, s4 = (f32x4){0.f, 0.f, 0.f, 0.f};
                if (!ri.meta) { const int pos = (g >> 3) ? (ri.t & 63) : (ri.t >> 6); const f32x4 t0 = *(const f32x4*)(rope + pos * 32 + j0), t1 = *(const f32x4*)(rope + pos * 32 + j0 + 2);
                    c4 = (f32x4){t0.x, t0.z, t1.x, t1.z}; s4 = (f32x4){t0.y, t0.w, t1.y, t1.w}; }
                PG8_FOR_BJ { const f32x4 pq = *(const PG8_LAS f32x4*)(X + (rl * 2 + bj) * 4);
                    const float rstd = __builtin_amdgcn_rsqf(((pq.x + pq.y) + (pq.z + pq.w)) * (1.0f / 128.f) + EPS) * sc;
                    const f32x4 x1 = acc[ai][bj][m][0] * g1 * rstd, x2 = acc[ai][bj][m][1] * g2 * rstd;
                    const f32x4 y1 = x1 * c4 - x2 * s4, y2 = x2 * c4 + x1 * s4;
                    if (ri.valid) { const int head = head0 + bj;
                        bf16_t *d1, *d2;
                        if (sec == 3) { d1 = (bf16_t*)(p.ws + OFF_QB) + ((size_t)(ri.b * 8 + head) * QROWS + row_q(ri)) * 128 + e0; d2 = d1 + 32; }
                        else { bf16_t* kb_ = (bf16_t*)(p.ws + OFF_KB) + (size_t)(ri.b * 2 + head) * KEYS * 128; const int kk = row_key(ri); d1 = kb_ + k_img(kk, e0); d2 = kb_ + k_img(kk, e0 + 32); }
                        *(u32x2*)d1 = (u32x2){cvt_pk_bf16(y1.x, y1.y), cvt_pk_bf16(y1.z, y1.w)};
                        *(u32x2*)d2 = (u32x2){cvt_pk_bf16(y2.x, y2.y), cvt_pk_bf16(y2.z, y2.w)}; } } }
            return;
        }
        if (sec <= 1) {
            const float sc2 = sec == 0 ? CA * CA : 1.f; float mx[2] = {0.f, 0.f};
            PG8_FOR_AM { PG8_FOR_BJ { const f32x4 a = acc[ai][bj][m][0], b = acc[ai][bj][m][1];
                float ss = (a.x * a.x + a.y * a.y) + (a.z * a.z + a.w * a.w) + (b.x * b.x + b.y * b.y) + (b.z * b.z + b.w * b.w);
                ss += __shfl_xor(ss, 16); ss += __shfl_xor(ss, 32); mx[bj] = fmaxf(mx[bj], ss * sc2); } }
            PG8_FOR_BJ { float v = mx[bj]; v = fmaxf(v, __shfl_xor(v, 1)); v = fmaxf(v, __shfl_xor(v, 2)); v = fmaxf(v, __shfl_xor(v, 4)); v = fmaxf(v, __shfl_xor(v, 8));
                if (fr == 0 && fq == 0) { unsigned* nw = (unsigned*)(p.ws + OFF_NRM) + (sec * 2 * 8 + head0 + bj) * 4 + wc;
                    if (u.pm < MREAL / BM) atomicMax(nw + (u.pm >> 5) * 32, __float_as_uint(v)); else { atomicMax(nw, __float_as_uint(v)); atomicMax(nw + 32, __float_as_uint(v)); } } }
        }
        PG8_FOR_AM { const int grow = u.pm * BM + ai * 128 + wr * 64 + m * 16 + fr; RowInfo ri; if (u.pm < MREAL / BM) { ri.b = u.pm >> 5; ri.t = grow & (SEQ - 1); ri.meta = 0; ri.valid = 1; } else ri = row_decode(grow);
            if (!ri.valid) continue;
            PG8_FOR_BJ { const int head = head0 + bj; f32x4 a = acc[ai][bj][m][0], b = acc[ai][bj][m][1]; bf16_t* dst;
                if (sec == 0) { dst = (bf16_t*)(p.ws + OFF_QA) + ((size_t)(ri.b * 8 + head) * QROWS + row_q(ri)) * 128 + cl; a = a * CA; b = b * CA; }
                else if (sec == 1) dst = (bf16_t*)(p.ws + OFF_KA) + (size_t)(ri.b * 8 + head) * KEYS * 128 + k_img(row_key(ri), cl);
                else if (sec == 2) dst = (bf16_t*)(p.ws + OFF_VA) + (size_t)(ri.b * 8 + head) * KEYS * 128 + v_img(row_key(ri), cl);
                else if (sec == 5) dst = (bf16_t*)(p.ws + OFF_VB) + (size_t)(ri.b * 2 + head) * KEYS * 128 + v_img(row_key(ri), cl);
                else { dst = (grow < MREAL ? (bf16_t*)p.out + (size_t)grow * 2048 : (bf16_t*)(p.ws + OFF_SGM) + (size_t)(grow - MREAL) * 2048) + (sec == 7 ? 1024 : 0) + head * 128 + cl;
                    a.x = fsig(a.x); a.y = fsig(a.y); a.z = fsig(a.z); a.w = fsig(a.w); b.x = fsig(b.x); b.y = fsig(b.y); b.z = fsig(b.z); b.w = fsig(b.w); }
                *(u32x4*)dst = (u32x4){cvt_pk_bf16(a.x, a.y), cvt_pk_bf16(a.z, a.w), cvt_pk_bf16(b.x, b.y), cvt_pk_bf16(b.z, b.w)}; } }
    }
};
__device__ __forceinline__ f32x4 bf4(u32x2 w) { return (f32x4){bf2f(w.x & 0xffffu), bf2f(w.x >> 16), bf2f(w.y & 0xffffu), bf2f(w.y >> 16)}; }
struct EpiMerge {
    static constexpr bool PERM = true, HAS_MID = true;
    Params p;
    __device__ __forceinline__ const bf16_t* sg(int grow) const { return grow < MREAL ? (const bf16_t*)p.out + (size_t)grow * 2048 : (const bf16_t*)(p.ws + OFF_SGM) + (size_t)(grow - MREAL) * 2048; }
    __device__ __forceinline__ void mid(f32x4 (&acc)[2][2][4][2], const Unit& u, int wr, int wc, int fr, int fq) const {
        PG8_FOR_AM { const int grow = u.pm * BM + ai * 128 + wr * 64 + m * 16 + fr; if (grow >= MROWS) continue; const bf16_t* s = sg(grow) + u.pn * BM + wc * 32 + fq * 8;
            PG8_FOR_BJ { const u32x4 wa = *(const u32x4*)(s + bj * 128), wb = *(const u32x4*)(s + 1024 + bj * 128);
                const f32x4 b0 = bf4((u32x2){wb.x, wb.y}), b1 = bf4((u32x2){wb.z, wb.w});
                const f32x4 r0 = (f32x4){__builtin_amdgcn_rcpf(b0.x), __builtin_amdgcn_rcpf(b0.y), __builtin_amdgcn_rcpf(b0.z), __builtin_amdgcn_rcpf(b0.w)};
                const f32x4 r1 = (f32x4){__builtin_amdgcn_rcpf(b1.x), __builtin_amdgcn_rcpf(b1.y), __builtin_amdgcn_rcpf(b1.z), __builtin_amdgcn_rcpf(b1.w)};
                acc[ai][bj][m][0] = acc[ai][bj][m][0] * bf4((u32x2){wa.x, wa.y}) * r0;
                acc[ai][bj][m][1] = acc[ai][bj][m][1] * bf4((u32x2){wa.z, wa.w}) * r1; } }
    }
    __device__ __forceinline__ void operator()(f32x4 (&acc)[2][2][4][2], const Unit& u, int wr, int wc, int fr, int fq, PG8_LAS unsigned char*) const {
        bf16_t* MG = (bf16_t*)(p.ws + OFF_MERGED);
        PG8_FOR_AM { const int grow = u.pm * BM + ai * 128 + wr * 64 + m * 16 + fr; if (grow >= MROWS) continue; const int col = u.pn * BM + wc * 32 + fq * 8; const bf16_t* s = sg(grow) + 1024 + col;
            PG8_FOR_BJ { const u32x4 wb = *(const u32x4*)(s + bj * 128);
                const f32x4 a = acc[ai][bj][m][0] * bf4((u32x2){wb.x, wb.y}), b = acc[ai][bj][m][1] * bf4((u32x2){wb.z, wb.w});
                *(u32x4*)(MG + (size_t)grow * DM + col + bj * 128) = (u32x4){cvt_pk_bf16(a.x, a.y), cvt_pk_bf16(a.z, a.w), cvt_pk_bf16(b.x, b.y), cvt_pk_bf16(b.z, b.w)}; } }
    }
};
struct EpiOut {
    static constexpr bool PERM = false, HAS_MID = false;
    Params p;
    __device__ __forceinline__ void operator()(f32x4 (&acc)[2][2][4][2], const Unit& u, int wr, int wc, int fr, int fq, PG8_LAS unsigned char*) const {
        PG8_FOR_AM { const int grow = u.pm * BM + ai * 128 + wr * 64 + m * 16 + fr; if (grow >= MROWS) continue; const int col = u.pn * BM + wc * 32 + fq * 4;
            const float* hr = h_row(p, grow) + col; float* o = h2_row(p, grow) + col;
            PG8_FOR_BJ {
#pragma unroll
                for (int n = 0; n < 2; ++n) *(f32x4*)(o + bj * 128 + n * 16) = *(const f32x4*)(hr + bj * 128 + n * 16) + acc[ai][bj][m][n]; } }
    }
};
struct EpiMoeUp {
    static constexpr bool PERM = true, HAS_MID = false;
    Params p;
    __device__ __forceinline__ void operator()(f32x4 (&acc)[2][2][4][2], const Unit& u, int wr, int wc, int fr, int fq, PG8_LAS unsigned char*) const {
        bf16_t* HID = (bf16_t*)(p.ws + OFF_HID);
        PG8_FOR_AM { const int s = u.pm * BM + ai * 128 + wr * 64 + m * 16 + fr; if (s >= ESLOTS) continue;
            PG8_FOR_BJ { const f32x4 gt = acc[ai][bj][m][0], up = acc[ai][bj][m][1]; const int f0 = (u.pn * BM + bj * 128 + wc * 32 + fq * 8) >> 1;
                const float h0 = gt.x * fsig(gt.x) * up.x, h1 = gt.y * fsig(gt.y) * up.y, h2 = gt.z * fsig(gt.z) * up.z, h3 = gt.w * fsig(gt.w) * up.w;
                *(u32x2*)(HID + ((size_t)u.e * ESLOTS + s) * EFF + f0) = (u32x2){cvt_pk_bf16(h0, h1), cvt_pk_bf16(h2, h3)}; } }
    }
};
struct EpiMoeDown {
    static constexpr bool PERM = true, HAS_MID = false;
    Params p;
    __device__ __forceinline__ void operator()(f32x4 (&acc)[2][2][4][2], const Unit& u, int wr, int wc, int fr, int fq, PG8_LAS unsigned char*) const {
        bf16_t* YB = (bf16_t*)(p.ws + OFF_YB); const float* SAFF = (const float*)(p.ws + OFF_SAFF);
        PG8_FOR_AM { const int s = u.pm * BM + ai * 128 + wr * 64 + m * 16 + fr; if (s >= ESLOTS) continue; const float af = SAFF[u.e * ESLOTS + s]; const int col = u.pn * BM + wc * 32 + fq * 8;
            PG8_FOR_BJ { const f32x4 a = acc[ai][bj][m][0] * af, b = acc[ai][bj][m][1] * af;
                *(u32x4*)(YB + ((size_t)u.e * ESLOTS + s) * DM + col + bj * 128) = (u32x4){cvt_pk_bf16(a.x, a.y), cvt_pk_bf16(a.z, a.w), cvt_pk_bf16(b.x, b.y), cvt_pk_bf16(b.z, b.w)}; } }
    }
};
#undef PG8_BAR
}

__device__ __forceinline__ void dot8(const u32x4 w, const u32x4 a, float& acc) {
    acc = fmaf(bf2f(w.x & 0xffffu), bf2f(a.x & 0xffffu), acc); acc = fmaf(bf2f(w.x >> 16), bf2f(a.x >> 16), acc);
    acc = fmaf(bf2f(w.y & 0xffffu), bf2f(a.y & 0xffffu), acc); acc = fmaf(bf2f(w.y >> 16), bf2f(a.y >> 16), acc);
    acc = fmaf(bf2f(w.z & 0xffffu), bf2f(a.z & 0xffffu), acc); acc = fmaf(bf2f(w.z >> 16), bf2f(a.z >> 16), acc);
    acc = fmaf(bf2f(w.w & 0xffffu), bf2f(a.w & 0xffffu), acc); acc = fmaf(bf2f(w.w >> 16), bf2f(a.w >> 16), acc);
}
template <int NI>
__device__ __forceinline__ void dots4(const bf16_t* w, const bf16_t* a0, size_t apitch, int lane, float (&acc)[4]) {
#pragma unroll
    for (int i = 0; i < NI; ++i) { const int k = i * 512 + lane * 8; const u32x4 wv = *(const u32x4*)(w + k);
#pragma unroll
        for (int r = 0; r < 4; ++r) dot8(wv, *(const u32x4*)(a0 + r * apitch + k), acc[r]); }
}
__device__ __forceinline__ void phase3a_meta(const Params& p, int vb, int nvb) {
    const int tid = TID(), lane = tid & 63, wave = tid >> 6;
    const bf16_t* AO = (const bf16_t*)(p.ws + OFF_AO) + (size_t)MREAL * AOP; const bf16_t* WAB = (const bf16_t*)(p.ws + OFF_WAB);
    const bf16_t* SGM = (const bf16_t*)(p.ws + OFF_SGM); bf16_t* MG = (bf16_t*)(p.ws + OFF_MERGED) + (size_t)MREAL * DM;
    for (int t = vb * 8 + wave; t < 1024 * 8; t += nvb * 8) {
        const int c = t >> 3, r0 = (t & 7) * 4;
        float pa[4] = {0.f, 0.f, 0.f, 0.f}, pb[4] = {0.f, 0.f, 0.f, 0.f};
        dots4<2>(WAB + (size_t)c * 2048, AO + (size_t)r0 * AOP, AOP, lane, pa);
        dots4<2>(WAB + (size_t)c * 2048 + 1024, AO + (size_t)r0 * AOP + 1024, AOP, lane, pb);
#pragma unroll
        for (int r = 0; r < 4; ++r) { const float sa = bf2f(SGM[(size_t)(r0 + r) * 2048 + c]), sb = bf2f(SGM[(size_t)(r0 + r) * 2048 + 1024 + c]);
            const float y = wave_sum(sa * pa[r] + sb * pb[r]); if (lane == 0) MG[(size_t)(r0 + r) * DM + c] = (bf16_t)f2bf(y); }
    }
}
__device__ __forceinline__ void phase3b_meta(const Params& p, int vb, int nvb) {
    const int tid = TID(), lane = tid & 63, wave = tid >> 6;
    const bf16_t* MG = (const bf16_t*)(p.ws + OFF_MERGED) + (size_t)MREAL * DM; const bf16_t* WO = (const bf16_t*)(p.ws + OFF_WO); float* H2M = (float*)(p.ws + OFF_H2M);
    for (int t = vb * 8 + wave; t < 1024 * 8; t += nvb * 8) {
        const int c = t >> 3, r0 = (t & 7) * 4;
        float pa[4] = {0.f, 0.f, 0.f, 0.f};
        dots4<2>(WO + (size_t)c * DM, MG + (size_t)r0 * DM, DM, lane, pa);
#pragma unroll
        for (int r = 0; r < 4; ++r) { const float y = wave_sum(pa[r]); if (lane == 0) H2M[(size_t)(r0 + r) * DM + c] = p.meta[(size_t)((r0 + r) & 15) * DM + c] + y; }
    }
}
__device__ __forceinline__ void phase5a_tail(const Params& p, unsigned char* lds, int vb, int nvb) {
    const int tid = TID(), lane = tid & 63, wave = tid >> 6;
    const bf16_t* U2 = (const bf16_t*)(p.ws + OFF_UN); const int* IDX = (const int*)(p.ws + OFF_IDX); const bf16_t* WGU = (const bf16_t*)(p.ws + OFF_WGU); bf16_t* HID = (bf16_t*)(p.ws + OFF_HID);
    const int stride = nvb * 8;
    for (int tb = vb * 8; tb < NEXP * EFF; tb += 4 * stride) {
        int tok[4];
#pragma unroll
        for (int k = 0; k < 4; ++k) { const int tk = tb + k * stride; tok[k] = tk < NEXP * EFF ? IDX[((size_t)1 * NEXP + (tk >> 9)) * CAP + (2048 - CAP) + (tid >> 7)] : 0; }
        u32x4 wv[4][2], uv[4][2];
#pragma unroll
        for (int k = 0; k < 4; ++k) { const int t = tb + wave + k * stride; const int tt = t < NEXP * EFF ? t : tb + wave; const int e = tt >> 9, f = tt & 511;
            const bf16_t* wg = WGU + ((size_t)e * DM + 8 * (f >> 2) + (f & 3)) * DM;
#pragma unroll
            for (int i = 0; i < 2; ++i) { const int kk = i * 512 + lane * 8; wv[k][i] = *(const u32x4*)(wg + kk); uv[k][i] = *(const u32x4*)(wg + 4 * DM + kk); } }
#pragma unroll
        for (int k = 0; k < 4; ++k) *(u32x4*)(lds + k * 8192 + tid * 16) = *(const u32x4*)(U2 + (size_t)pos_row(1, tok[k]) * DM + (tid & 127) * 8);
        __syncthreads();
#pragma unroll
        for (int k = 0; k < 4; ++k) { const int t = tb + wave + k * stride; if (t >= NEXP * EFF) continue; const int e = t >> 9, f = t & 511;
            float pg[4] = {0.f, 0.f, 0.f, 0.f}, pu[4] = {0.f, 0.f, 0.f, 0.f};
#pragma unroll
            for (int i = 0; i < 2; ++i)
#pragma unroll
                for (int r = 0; r < 4; ++r) { const u32x4 a = *(const u32x4*)(lds + k * 8192 + r * 2048 + (i * 512 + lane * 8) * 2); dot8(wv[k][i], a, pg[r]); dot8(uv[k][i], a, pu[r]); }
            const size_t s0 = (size_t)e * ESLOTS + 2048;
#pragma unroll
            for (int r = 0; r < 4; ++r) { const float g = wave_sum(pg[r]), u = wave_sum(pu[r]); if (lane == 0) HID[(s0 + r) * EFF + f] = (bf16_t)f2bf(g * pg8::fsig(g) * u); } }
        __syncthreads();
    }
}
__device__ __forceinline__ void phase5b_tail(const Params& p, unsigned char* lds, int vb, int nvb) {
    const int tid = TID(), lane = tid & 63, wave = tid >> 6;
    const bf16_t* HID = (const bf16_t*)(p.ws + OFF_HID); const bf16_t* WD = (const bf16_t*)(p.ws + OFF_WD); bf16_t* YB = (bf16_t*)(p.ws + OFF_YB); const float* SAFF = (const float*)(p.ws + OFF_SAFF);
    const int stride = nvb * 8;
    for (int tb = vb * 8; tb < NEXP * DM; tb += 8 * stride) {
        u32x4 wv[8];
#pragma unroll
        for (int k = 0; k < 8; ++k) { const int t = tb + wave + k * stride; const int tt = t < NEXP * DM ? t : tb + wave; wv[k] = *(const u32x4*)(WD + (size_t)tt * EFF + lane * 8); }
#pragma unroll
        for (int j = 0; j < 4; ++j) { const int k = 2 * j + (tid >> 8); const int tk = tb + k * stride; const int e = tk < NEXP * DM ? (tk >> 10) : 0;
            *(u32x4*)(lds + k * 4096 + (tid & 255) * 16) = *(const u32x4*)(HID + ((size_t)e * ESLOTS + 2048) * EFF + (tid & 255) * 8); }
        __syncthreads();
#pragma unroll
        for (int k = 0; k < 8; ++k) { const int t = tb + wave + k * stride; if (t >= NEXP * DM) continue; const int e = t >> 10, c = t & 1023;
            float pa[4] = {0.f, 0.f, 0.f, 0.f};
#pragma unroll
            for (int r = 0; r < 4; ++r) dot8(wv[k], *(const u32x4*)(lds + k * 4096 + r * 1024 + lane * 16), pa[r]);
            const size_t s0 = (size_t)e * ESLOTS + 2048;
#pragma unroll
            for (int r = 0; r < 4; ++r) { const float y = wave_sum(pa[r]); if (lane == 0) YB[(s0 + r) * DM + c] = (bf16_t)f2bf(y * SAFF[s0 + r]); } }
        __syncthreads();
    }
}

__device__ __forceinline__ void phase1_fast(const Params& p, unsigned char* lds_raw, int vb, int nvb) {
    pg8::Gemm g{(const bf16_t*)(p.ws + OFF_UN), (const bf16_t*)(p.ws + OFF_WIN), DM};
    pg8::GridOrder S; S.init(MPAD / 256, INW / 256, nvb, vb);
    pg8::EpiInProj E{p};
    pg8::gemm_phase(( __attribute__((address_space(3))) unsigned char*)lds_raw, g, S, E);
}
__device__ __forceinline__ void phase3a_fast(const Params& p, unsigned char* lds_raw, int vb, int nvb) {
    phase3a_meta(p, vb, nvb);
    pg8::Gemm g{(const bf16_t*)(p.ws + OFF_AO), (const bf16_t*)(p.ws + OFF_WAB), 2048};
    pg8::GridOrder S; S.init(MREAL / 256, DM / 256, nvb, vb);
    pg8::EpiMerge E{p};
    pg8::gemm_phase(( __attribute__((address_space(3))) unsigned char*)lds_raw, g, S, E);
}
__device__ __forceinline__ void phase3b_fast(const Params& p, unsigned char* lds_raw, int vb, int nvb) {
    phase3b_meta(p, vb, nvb);
    pg8::Gemm g{(const bf16_t*)(p.ws + OFF_MERGED), (const bf16_t*)(p.ws + OFF_WO), DM};
    pg8::GridOrder S; S.init(MREAL / 256, DM / 256, nvb, vb);
    pg8::EpiOut E{p};
    pg8::gemm_phase(( __attribute__((address_space(3))) unsigned char*)lds_raw, g, S, E);
}
__device__ __forceinline__ void phase5a_fast(const Params& p, unsigned char* lds_raw, int vb, int nvb) {
    phase5a_tail(p, lds_raw, vb, nvb);
    pg8::Gemm g{(const bf16_t*)(p.ws + OFF_UN), (const bf16_t*)(p.ws + OFF_WGU), DM};
    pg8::MoeOrderT<true> S{nvb, vb, (const int*)(p.ws + OFF_IDX)};
    pg8::EpiMoeUp E{p};
    pg8::gemm_phase(( __attribute__((address_space(3))) unsigned char*)lds_raw, g, S, E);
}
__device__ __forceinline__ void phase5b_fast(const Params& p, unsigned char* lds_raw, int vb, int nvb) {
    phase5b_tail(p, lds_raw, vb, nvb);
    pg8::Gemm g{(const bf16_t*)(p.ws + OFF_HID), (const bf16_t*)(p.ws + OFF_WD), EFF};
    pg8::MoeOrderT<false> S{nvb, vb, nullptr};
    pg8::EpiMoeDown E{p};
    pg8::gemm_phase(( __attribute__((address_space(3))) unsigned char*)lds_raw, g, S, E);
}

__device__ __forceinline__ void phase4b_fast(const Params& p, float* lds, int vb, int nvb) {
    const int tid = TID(), lane = tid & 63, wave = tid >> 6;
    constexpr int NBE = NB * NEXP;
    if (vb >= NBE || nvb <= NBE) { const bool small = nvb <= NBE; transpose_moe(p, lds, small ? vb : vb - NBE, small ? nvb : nvb - NBE); if (!small) return; }
    const float* AFF = (const float*)(p.ws + OFF_AFF); int* IDX = (int*)(p.ws + OFF_IDX); int* SEL = (int*)(p.ws + OFF_SEL); float* SAFF = (float*)(p.ws + OFF_SAFF);
    unsigned* keys = (unsigned*)lds;
    unsigned* hist = keys + 8448;
    unsigned* sh = hist + 256;
    for (int be = vb; be < NBE; be += nvb) {
        const int b = be / NEXP, e = be % NEXP;
        __syncthreads();
        for (int i = tid; i < LTOT; i += NTHREADS) keys[i] = __float_as_uint(AFF[(size_t)be * LTOT + i]);
        if (tid == 0) { sh[0] = 0u; sh[1] = CAP; }
        __syncthreads();
        for (int pass = 0; pass < 4; ++pass) {
            const int shift = 24 - 8 * pass;
            if (tid < 256) hist[tid] = 0u;
            __syncthreads();
            const unsigned prefix = sh[0], pmask = pass == 0 ? 0u : (0xffffffffu << (shift + 8));
            if (pass == 0) {
                for (int i0 = 0; i0 < LTOT; i0 += NTHREADS) { const int i = i0 + tid; const bool in = i < LTOT; const unsigned dg = in ? (keys[i] >> 24) : 0xffffffffu;
                    unsigned long long todo = __ballot(in);
                    while (todo) { const int src = __builtin_ctzll(todo); const unsigned d = (unsigned)__builtin_amdgcn_readlane((int)dg, src);
                        const unsigned long long same = __ballot(dg == d); if (lane == src) atomicAdd(&hist[d & 255u], (unsigned)__builtin_popcountll(same)); todo &= ~same; } }
            } else
            for (int i = tid; i < LTOT; i += NTHREADS) { const unsigned k = keys[i]; if ((k & pmask) == prefix) atomicAdd(&hist[(k >> shift) & 255u], 1u); }
            __syncthreads();
            if (wave == 0) {
                const unsigned rem = sh[1]; const unsigned c0 = hist[4 * lane], c1 = hist[4 * lane + 1], c2 = hist[4 * lane + 2], c3 = hist[4 * lane + 3];
                const unsigned t = c0 + c1 + c2 + c3; unsigned S = t;
#pragma unroll
                for (int o = 1; o < 64; o <<= 1) { const unsigned v = __shfl_down(S, o); if (lane + o < 64) S += v; }
                const unsigned above = S - t;
                if (S >= rem && above < rem) { unsigned d, r = rem - above;
                    if (c3 >= r) d = 3; else { r -= c3; if (c2 >= r) d = 2; else { r -= c2; if (c1 >= r) d = 1; else { r -= c1; d = 0; } } }
                    sh[0] = prefix | ((4u * lane + d) << shift); sh[1] = r; }
            }
            __syncthreads();
        }
        const unsigned T = sh[0], need_eq = sh[1];
        const int t0 = tid * 17; int cnt_gt = 0, cnt_eq = 0;
        for (int i = 0; i < 17; ++i) { const int tok = t0 + i; if (tok < LTOT) { const unsigned k = keys[tok]; cnt_gt += k > T; cnt_eq += k == T; } }
        int incl = cnt_eq;
#pragma unroll
        for (int o = 1; o < 64; o <<= 1) { const int v = __shfl_up(incl, o); if (lane >= o) incl += v; }
        if (lane == 63) sh[8 + wave] = (unsigned)incl;
        __syncthreads();
        int eq_before = incl - cnt_eq; for (int w = 0; w < wave; ++w) eq_before += (int)sh[8 + w];
        __syncthreads();
        int take_eq = (int)need_eq - eq_before; take_eq = take_eq < 0 ? 0 : (take_eq > cnt_eq ? cnt_eq : take_eq);
        const int mysel = cnt_gt + take_eq;
        incl = mysel;
#pragma unroll
        for (int o = 1; o < 64; o <<= 1) { const int v = __shfl_up(incl, o); if (lane >= o) incl += v; }
        if (lane == 63) sh[8 + wave] = (unsigned)incl;
        __syncthreads();
        int slot = incl - mysel; for (int w = 0; w < wave; ++w) slot += (int)sh[8 + w];
        int eqi = eq_before;
        for (int i = 0; i < 17; ++i) { const int tok = t0 + i; if (tok < LTOT) { const unsigned k = keys[tok];
            bool take = k > T; if (k == T) { take = eqi < (int)need_eq; ++eqi; }
            if (take) { IDX[(size_t)be * CAP + slot] = tok; SEL[((size_t)b * LTOT + tok) * NEXP + e] = slot; SAFF[(size_t)e * ESLOTS + b * CAP + slot] = __uint_as_float(k); ++slot; } else SEL[((size_t)b * LTOT + tok) * NEXP + e] = -1; } }
    }
    __syncthreads();
}
#define LAS __attribute__((address_space(3)))
#define XB_TMO      128
#define XB_XCNT(j)  (256  + 64 * (j))
#define XB_XSUB(j)  (1280 + 64 * (j))
#define XB_XGEN(j)  (2304 + 64 * (j))
#define XB_TOP      3328
#define XB_TOPGEN   3392
#define XB_SPIN_CAP (1u << 22)
__device__ __forceinline__ unsigned xb_ld(unsigned* p)              { return __hip_atomic_load(p, __ATOMIC_RELAXED, __HIP_MEMORY_SCOPE_AGENT); }
__device__ __forceinline__ unsigned xb_add(unsigned* p, unsigned v) { return __hip_atomic_fetch_add(p, v, __ATOMIC_RELAXED, __HIP_MEMORY_SCOPE_AGENT); }
__device__ __forceinline__ unsigned xb_xcc_id() { return (unsigned)__builtin_amdgcn_s_getreg((3 << 11) | 20) & 0xFu; }
#define XB_SPIN(cond, bar) do { unsigned _sp = 0; while (cond) { __builtin_amdgcn_s_sleep(1); \
    if ((++_sp & 255u) == 0u) { if (xb_ld(&(bar)[XB_TMO])) break; if (_sp > XB_SPIN_CAP) { atomicAdd(&(bar)[XB_TMO], 1u); break; } } } } while (0)
struct XcdBarrier { unsigned* bar; unsigned x; volatile LAS unsigned* st; };
__device__ __forceinline__ XcdBarrier xcd_barrier_post(unsigned* bar, volatile LAS unsigned* st) {
    XcdBarrier b; b.bar = bar; b.x = xb_xcc_id(); b.st = st;
    if (threadIdx.x == 0) (void)xb_add(&bar[XB_XCNT(b.x)], 1u);
    return b;
}
__device__ __forceinline__ void xcd_barrier_complete(unsigned* bar, unsigned x, unsigned& nloc, unsigned& nx) {
    const unsigned G = gridDim.x * gridDim.y * gridDim.z;
    unsigned sum, cnt, mine, sp = 0u;
    for (;;) {
        sum = 0u; cnt = 0u; mine = 0u;
#pragma unroll
        for (unsigned j = 0; j < 16; ++j) { const unsigned c = xb_ld(&bar[XB_XCNT(j)]); sum += c; cnt += (c > 0u) ? 1u : 0u; mine = (j == x) ? c : mine; }
        if (sum == G) break;
        __builtin_amdgcn_s_sleep(1);
        if ((++sp & 255u) == 0u) { if (xb_ld(&bar[XB_TMO])) break; if (sp > XB_SPIN_CAP) { atomicAdd(&bar[XB_TMO], 1u); break; } }
    }
    nloc = mine > 0u ? mine : 1u; nx = cnt > 0u ? cnt : 1u;
}
__device__ __forceinline__ void xcd_barrier(const XcdBarrier& b) {
    asm volatile("s_waitcnt vmcnt(0)" ::: "memory");
    __syncthreads();
    if (threadIdx.x == 0) {
        unsigned* bar = b.bar;
        __builtin_amdgcn_s_waitcnt(0);
        unsigned nloc = b.st[0], nx = b.st[1];
        if (nloc == 0u) { xcd_barrier_complete(bar, b.x, nloc, nx); b.st[0] = nloc; b.st[1] = nx; }
        const unsigned old = xb_add(&bar[XB_XSUB(b.x)], 1u);
        const unsigned gen = old / nloc;
        if (old + 1u == (gen + 1u) * nloc) {
            __builtin_amdgcn_fence(__ATOMIC_RELEASE, "agent");
            asm volatile("s_waitcnt vmcnt(0)" ::: "memory");
            const unsigned og = xb_add(&bar[XB_TOP], 1u);
            const unsigned tg = og / nx;
            if (og + 1u == (tg + 1u) * nx) xb_add(&bar[XB_TOPGEN], 1u);
            else XB_SPIN(xb_ld(&bar[XB_TOPGEN]) == tg, bar);
            __builtin_amdgcn_fence(__ATOMIC_ACQUIRE, "agent");
            xb_add(&bar[XB_XGEN(b.x)], 1u);
            asm volatile("s_waitcnt vmcnt(0)" ::: "memory");
        } else {
            XB_SPIN(xb_ld(&bar[XB_XGEN(b.x)]) == gen, bar);
            __builtin_amdgcn_fence(__ATOMIC_ACQUIRE, "agent");
            asm volatile("s_waitcnt vmcnt(0)" ::: "memory");
        }
    }
    __syncthreads();
}

constexpr int LDS_BYTES = 147456;
constexpr int LDS_BARST = LDS_BYTES - 64;
#if defined(__HIP_DEVICE_COMPILE__)
#define PHASE_PARAMS() ({ const __attribute__((address_space(4))) Params* q_ = (const __attribute__((address_space(4))) Params*)__builtin_amdgcn_kernarg_segment_ptr(); asm volatile("" : "+s"(q_)); *q_; })
#else
#define PHASE_PARAMS() (pk)
#endif
#define PHASE(call) do { const Params p = PHASE_PARAMS(); call; } while (0)
__global__ void __launch_bounds__(NTHREADS, 2) fwd_kernel(Params pk) {
    extern __shared__ __attribute__((aligned(16))) unsigned char lds_raw[];
    float* lds = (float*)lds_raw;
    cg::grid_group grid = cg::this_grid();
    const int vb = blockIdx.x, nvb = gridDim.x;
    if (threadIdx.x < 16) ((LAS unsigned*)(lds_raw + LDS_BARST))[threadIdx.x] = 0u;
    __syncthreads();
    const XcdBarrier bar = xcd_barrier_post((unsigned*)(pk.ws + OFF_CTL), (volatile LAS unsigned*)(lds_raw + LDS_BARST));
#define GRID_BAR() xcd_barrier(bar)
    PHASE(phase0(p, vb, nvb));
    PHASE(transpose_p0(p, lds, vb, nvb));
    GRID_BAR();
    if (nvb > (1 << 24)) grid.sync();
    PHASE(phase1_fast(p, lds_raw, vb, nvb));
    GRID_BAR();
    PHASE(phase2_fast(p, (char*)lds_raw, vb, nvb));
    GRID_BAR();
    PHASE(phase3a_fast(p, lds_raw, vb, nvb));
    GRID_BAR();
    PHASE(phase3b_fast(p, lds_raw, vb, nvb));
    GRID_BAR();
    PHASE(phase4a(p, lds, vb, nvb));
    GRID_BAR();
    PHASE(phase4b_fast(p, lds, vb, nvb));
    GRID_BAR();
    PHASE(phase5a_fast(p, lds_raw, vb, nvb));
    GRID_BAR();
    PHASE(phase5b_fast(p, lds_raw, vb, nvb));
    GRID_BAR();
    PHASE(phase6(p, vb, nvb));
}

extern "C" void kernel_launch(void* const* d_in, const int* in_sizes, int n_in, void* d_out, int out_size, void* d_ws, size_t ws_size, hipStream_t stream) {
    static int grid_blocks = 0;
    if (grid_blocks == 0) {
        if (n_in != 20 || in_sizes[0] != MREAL * DM || out_size != MREAL * DM || ws_size < 256 * MiB) {
            fprintf(stderr, "kernel_launch: unexpected shapes: n_in %d in0 %d out %d ws %zu\n", n_in, n_in > 0 ? in_sizes[0] : -1, out_size, ws_size); grid_blocks = -1; return; }
        int dev = 0, cus = 0, per_cu = 0;
        (void)hipGetDevice(&dev); (void)hipDeviceGetAttribute(&cus, hipDeviceAttributeMultiprocessorCount, dev);
        if (hipFuncSetAttribute((const void*)fwd_kernel, hipFuncAttributeMaxDynamicSharedMemorySize, LDS_BYTES) != hipSuccess) { fprintf(stderr, "kernel_launch: hipFuncSetAttribute failed\n"); grid_blocks = -1; return; }
        if (hipOccupancyMaxActiveBlocksPerMultiprocessor(&per_cu, (const void*)fwd_kernel, NTHREADS, LDS_BYTES) != hipSuccess || per_cu < 1) { fprintf(stderr, "kernel_launch: occupancy query failed (%d)\n", per_cu); grid_blocks = -1; return; }
        grid_blocks = cus * per_cu;
    }
    if (grid_blocks < 0) return;
    if (hipMemsetAsync((char*)d_ws + OFF_CTL, 0, CTL_WORDS * 4, stream) != hipSuccess) { fprintf(stderr, "kernel_launch: memset failed\n"); return; }
    Params p{};
    p.x = (const float*)d_in[0]; p.meta = (const float*)d_in[1]; p.g_mix = (const float*)d_in[2]; p.w_in = (const float*)d_in[3];
    p.lq1 = (const float*)d_in[4]; p.lk1 = (const float*)d_in[5]; p.lq2 = (const float*)d_in[6]; p.lk2 = (const float*)d_in[7];
    p.g_subln = (const float*)d_in[8]; p.g_qnorm = (const float*)d_in[9]; p.g_knorm = (const float*)d_in[10];
    p.w_ba = (const float*)d_in[11]; p.w_bb = (const float*)d_in[12]; p.w_out = (const float*)d_in[13]; p.g_ffn = (const float*)d_in[14];
    p.w_router = (const float*)d_in[15]; p.w_gate = (const float*)d_in[16]; p.w_up = (const float*)d_in[17]; p.w_down = (const float*)d_in[18]; p.g_final = (const float*)d_in[19];
    p.out = (float*)d_out; p.ws = (unsigned char*)d_ws;
    void* args[] = {&p};
    hipError_t e = hipLaunchCooperativeKernel((const void*)fwd_kernel, dim3(grid_blocks), dim3(NTHREADS), args, LDS_BYTES, stream);
    if (e != hipSuccess) fprintf(stderr, "kernel_launch: cooperative launch failed: %s (grid %d)\n", hipGetErrorString(e), grid_blocks);
}
```

```cpp
#include <hip/hip_runtime.h>
#include <hip/hip_cooperative_groups.h>
#include <cstdio>
#include <cstdint>
namespace cg = cooperative_groups;

typedef unsigned short bf16_t;
typedef float f32x4 __attribute__((ext_vector_type(4)));
typedef unsigned u32x2 __attribute__((ext_vector_type(2)));
typedef unsigned u32x4 __attribute__((ext_vector_type(4)));

constexpr int NB = 2, SEQ = 8192, DM = 1024, NMETA = 16, LTOT = SEQ + NMETA;
constexpr int MREAL = NB * SEQ;
constexpr int MROWS = MREAL + NB * NMETA;
constexpr int MPAD = 16640;
constexpr int INW = 6656;
constexpr int KEYS = 8256;
constexpr int QROWS = 8256;
constexpr int NEXP = 16, EFF = 512, CAP = 1026, ESLOTS = NB * CAP;
constexpr float EPS = 1e-6f;
constexpr float LOG2E = 1.4426950408889634f;
constexpr float CA = 0.125f * LOG2E;
constexpr float CB = 0.08838834764831845f * LOG2E;
constexpr float LAM_INIT = 0.2f;
constexpr int NTHREADS = 512;
constexpr int AOP = 2048;
__device__ const float INVF[32] = {1.000000000e+00f, 7.498942614e-01f, 5.623413324e-01f, 4.216965139e-01f, 3.162277639e-01f, 2.371373773e-01f, 1.778279394e-01f, 1.333521307e-01f,
    1.000000015e-01f, 7.498941571e-02f, 5.623413250e-02f, 4.216965288e-02f, 3.162277490e-02f, 2.371373773e-02f, 1.778279431e-02f, 1.333521493e-02f,
    9.999999776e-03f, 7.498941850e-03f, 5.623413250e-03f, 4.216964822e-03f, 3.162277630e-03f, 2.371373586e-03f, 1.778279431e-03f, 1.333521446e-03f,
    1.000000047e-03f, 7.498942432e-04f, 5.623413017e-04f, 4.216965172e-04f, 3.162277571e-04f, 2.371373703e-04f, 1.778279402e-04f, 1.333521504e-04f};

constexpr size_t MiB = 1u << 20;
constexpr size_t OFF_ROPE = 0;
constexpr size_t OFF_LAM = 64 * 1024;
constexpr size_t OFF_NRM = 64 * 1024 + 256;
constexpr int XCD_BAR_WORDS = 3456;
constexpr size_t OFF_CTL = 68 * 1024;
constexpr int CTL_WORDS = XCD_BAR_WORDS + 64;
constexpr size_t OFF_QCTR = OFF_CTL + (size_t)XCD_BAR_WORDS * 4;
constexpr size_t OFF_MINIDONE = OFF_QCTR + 64;
constexpr size_t OFF_AFF = 128 * 1024;
constexpr size_t OFF_IDX = OFF_AFF + (size_t)NB * NEXP * LTOT * 4 + 256;
constexpr size_t OFF_SEL = OFF_IDX + (size_t)NB * NEXP * CAP * 4 + 256;
constexpr size_t OFF_SGM = OFF_SEL + (size_t)NB * LTOT * NEXP * 4 + 256;
constexpr size_t OFF_H2M = OFF_SGM + 32 * 2048 * 2;
constexpr size_t OFF_SAFF = OFF_H2M + 32 * 1024 * 4;
constexpr size_t OFF_MISC_END = OFF_SAFF + (size_t)NEXP * ESLOTS * 4;
static_assert(OFF_MISC_END <= 4 * MiB, "misc region");
constexpr size_t OFF_WIN = 4 * MiB;
constexpr size_t OFF_WAB = OFF_WIN + (size_t)INW * DM * 2;
constexpr size_t OFF_WO = OFF_WAB + (size_t)DM * 2048 * 2;
static_assert(OFF_WO + (size_t)DM * DM * 2 <= 24 * MiB, "weights region");
constexpr size_t OFF_AO = 24 * MiB;
constexpr size_t SZ_ROWS = (size_t)MPAD * DM * 2;
constexpr size_t OFF_UN = OFF_AO;
constexpr size_t OFF_HID = OFF_AO + SZ_ROWS;
static_assert((size_t)(NEXP * ESLOTS + 256) * EFF * 2 <= SZ_ROWS, "HID overlay");
constexpr size_t OFF_ATT = OFF_AO + 2 * SZ_ROWS;
constexpr size_t SZ_QH = (size_t)NB * 8 * QROWS * 128 * 2;
constexpr size_t SZ_KVB = (size_t)NB * 2 * KEYS * 128 * 2;
constexpr size_t OFF_QA = OFF_ATT, OFF_KA = OFF_QA + SZ_QH, OFF_VA = OFF_KA + SZ_QH, OFF_QB = OFF_VA + SZ_QH, OFF_KB = OFF_QB + SZ_QH, OFF_VB = OFF_KB + SZ_KVB;
constexpr size_t OFF_ATT_END = OFF_VB + SZ_KVB;
static_assert(OFF_ATT_END <= 256 * MiB, "workspace");
constexpr size_t OFF_MERGED = OFF_ATT;
constexpr size_t OFF_WGU = OFF_ATT + 33 * MiB;
constexpr size_t OFF_WD = OFF_WGU + 32 * MiB;
constexpr size_t OFF_XS = OFF_WD + 16 * MiB;
constexpr size_t OFF_YB = OFF_XS;
static_assert(SZ_ROWS <= 33 * MiB && OFF_XS + (size_t)(NEXP * ESLOTS + 256) * DM * 2 <= 256 * MiB, "overlay map");

struct Params {
    const float *x, *meta, *g_mix, *w_in, *lq1, *lk1, *lq2, *lk2, *g_subln, *g_qnorm, *g_knorm, *w_ba, *w_bb, *w_out, *g_ffn, *w_router, *w_gate, *w_up, *w_down, *g_final;
    float* out; unsigned char* ws;
};

__device__ __forceinline__ int TID() { int t = threadIdx.x; asm volatile("" : "+v"(t)); return t; }
__device__ __forceinline__ unsigned f2bf(float f) { unsigned u = __builtin_bit_cast(unsigned, f); return (u + 0x7fffu + ((u >> 16) & 1u)) >> 16; }
__device__ __forceinline__ float bf2f(unsigned h) { return __builtin_bit_cast(float, h << 16); }
#define DPP_F(x, ctrl, rmask) __builtin_bit_cast(float, __builtin_amdgcn_update_dpp(0, __builtin_bit_cast(int, (x)), (ctrl), (rmask), 0xf, true))
__device__ __forceinline__ float wave_sum(float v) {
    v += DPP_F(v, 0xB1, 0xf);
    v += DPP_F(v, 0x4E, 0xf);
    v += DPP_F(v, 0x141, 0xf);
    v += DPP_F(v, 0x140, 0xf);
    float t = __builtin_bit_cast(float, __builtin_amdgcn_update_dpp(0, __builtin_bit_cast(int, v), 0x142, 0xa, 0xf, false)); v += t;
    t = __builtin_bit_cast(float, __builtin_amdgcn_update_dpp(0, __builtin_bit_cast(int, v), 0x143, 0xc, 0xf, false)); v += t;
    return __builtin_bit_cast(float, __builtin_amdgcn_readlane(__builtin_bit_cast(int, v), 63));
}
__device__ __forceinline__ float wave_max(float v) {
    v = fmaxf(v, DPP_F(v, 0xB1, 0xf)); v = fmaxf(v, DPP_F(v, 0x4E, 0xf)); v = fmaxf(v, DPP_F(v, 0x141, 0xf)); v = fmaxf(v, DPP_F(v, 0x140, 0xf));
    const float a = __builtin_bit_cast(float, __builtin_amdgcn_readlane(__builtin_bit_cast(int, v), 15)), b = __builtin_bit_cast(float, __builtin_amdgcn_readlane(__builtin_bit_cast(int, v), 31));
    const float c = __builtin_bit_cast(float, __builtin_amdgcn_readlane(__builtin_bit_cast(int, v), 47)), d = __builtin_bit_cast(float, __builtin_amdgcn_readlane(__builtin_bit_cast(int, v), 63));
    return fmaxf(fmaxf(a, b), fmaxf(c, d));
}
__device__ __forceinline__ size_t k_img(int kk, int col) { return (size_t)(kk >> 6) * 8192 + (col >> 3) * 512 + (kk & 63) * 8 + (col & 7); }
__device__ __forceinline__ size_t v_img(int kk, int col) { const int db = col >> 4; return (size_t)(kk >> 6) * 8192 + db * 1024 + ((((kk & 63) * 16) ^ ((db & 1) << 6)) + (col & 15)); }
struct RowInfo { int b, t, meta, valid; };
__device__ __forceinline__ RowInfo row_decode(int r) {
    RowInfo ri;
    if (r < MREAL) { ri.b = r >> 13; ri.t = r & (SEQ - 1); ri.meta = 0; ri.valid = 1; }
    else if (r < MROWS) { ri.b = (r - MREAL) >> 4; ri.t = (r - MREAL) & 15; ri.meta = 1; ri.valid = 1; }
    else { ri.b = 0; ri.t = 0; ri.meta = 1; ri.valid = 0; }
    return ri;
}
__device__ __forceinline__ int row_key(const RowInfo& ri) { return ri.meta ? ri.t : 64 + ri.t; }
__device__ __forceinline__ int row_q(const RowInfo& ri) { return ri.meta ? SEQ + ri.t : ri.t; }
__device__ __forceinline__ int row_pos(const RowInfo& ri) { return ri.meta ? ri.t : NMETA + ri.t; }
__device__ __forceinline__ int pos_row(int b, int pos) { return pos < NMETA ? MREAL + b * NMETA + pos : b * SEQ + (pos - NMETA); }
__device__ __forceinline__ const float* h_row(const Params& p, int r) { RowInfo ri = row_decode(r); return ri.meta ? p.meta + (size_t)ri.t * DM : p.x + (size_t)r * DM; }

__device__ __forceinline__ void phase0(const Params& p, int vb, int nvb) {
    const int tid = TID(), lane = tid & 63, wave = tid >> 6;
    const int gt = vb * NTHREADS + tid;
    if (gt < 128 * 32) {
        const int pos = gt >> 5, j = gt & 31;
        const float ang = (float)pos * INVF[j];
        const double xd = (double)ang, kq = __builtin_rint(xd * 0.15915494309189535);
        const double rr = (xd - kq * 6.283185307179586) * 0.25, r2 = rr * rr;
        double sn = 1.0 / 1307674368000.0, cn = 1.0 / 87178291200.0;
        sn = sn * r2 * -1.0 + 1.0 / 6227020800.0; cn = cn * r2 * -1.0 + 1.0 / 479001600.0;
        sn = sn * r2 * -1.0 + 1.0 / 39916800.0;   cn = cn * r2 * -1.0 + 1.0 / 3628800.0;
        sn = sn * r2 * -1.0 + 1.0 / 362880.0;     cn = cn * r2 * -1.0 + 1.0 / 40320.0;
        sn = sn * r2 * -1.0 + 1.0 / 5040.0;       cn = cn * r2 * -1.0 + 1.0 / 720.0;
        sn = sn * r2 * -1.0 + 1.0 / 120.0;        cn = cn * r2 * -1.0 + 1.0 / 24.0;
        sn = sn * r2 * -1.0 + 1.0 / 6.0;          cn = cn * r2 * -1.0 + 0.5;
        sn = (sn * r2 * -1.0 + 1.0) * rr;         cn = cn * r2 * -1.0 + 1.0;
        double s2 = 2.0 * sn * cn, c2 = cn * cn - sn * sn;
        double s4 = 2.0 * s2 * c2, c4 = c2 * c2 - s2 * s2;
        float2 cs; cs.x = (float)c4; cs.y = (float)s4;
        ((float2*)(p.ws + OFF_ROPE))[gt] = cs;
    }
    if (vb == 0 && tid < 256) ((unsigned*)(p.ws + OFF_NRM))[tid] = 0u;
    if (vb == 0 && wave == 0) {
        float a = p.lq1[lane] * p.lk1[lane], c = p.lq2[lane] * p.lk2[lane];
        a = wave_sum(a); c = wave_sum(c);
        if (lane == 0) *(float*)(p.ws + OFF_LAM) = expf(a) - expf(c) + LAM_INIT;
    }
    bf16_t* UN = (bf16_t*)(p.ws + OFF_UN);
    for (int r0 = vb * 8 + wave; r0 < MPAD; r0 += nvb * 8 * 2) {
        f32x4 v[2][4];
#pragma unroll
        for (int h = 0; h < 2; ++h) { const int r = r0 + h * nvb * 8;
            if (r < MROWS) { const f32x4* xr = (const f32x4*)h_row(p, r) + lane;
#pragma unroll
                for (int j = 0; j < 4; ++j) v[h][j] = xr[64 * j]; }
            else {
#pragma unroll
                for (int j = 0; j < 4; ++j) v[h][j] = (f32x4){0.f, 0.f, 0.f, 0.f}; } }
#pragma unroll
        for (int h = 0; h < 2; ++h) { const int r = r0 + h * nvb * 8; if (r >= MPAD) continue;
            float s = 0.f;
#pragma unroll
            for (int j = 0; j < 4; ++j) s += (v[h][j].x * v[h][j].x + v[h][j].y * v[h][j].y) + (v[h][j].z * v[h][j].z + v[h][j].w * v[h][j].w);
            const float rstd = 1.0f / sqrtf(wave_sum(s) * (1.0f / DM) + EPS);
            u32x2* o = (u32x2*)(UN + (size_t)r * DM) + lane;
#pragma unroll
            for (int j = 0; j < 4; ++j) { const f32x4 g = ((const f32x4*)p.g_mix)[lane + 64 * j];
                u32x2 w; w.x = f2bf(v[h][j].x * rstd * g.x) | (f2bf(v[h][j].y * rstd * g.y) << 16); w.y = f2bf(v[h][j].z * rstd * g.z) | (f2bf(v[h][j].w * rstd * g.w) << 16);
                o[64 * j] = w; } }
    }
    {
        bf16_t* KA = (bf16_t*)(p.ws + OFF_KA); bf16_t* VA = (bf16_t*)(p.ws + OFF_VA); bf16_t* KB = (bf16_t*)(p.ws + OFF_KB); bf16_t* VB = (bf16_t*)(p.ws + OFF_VB);
        const int per = 16384 / 16;
        for (int i = vb * NTHREADS + tid; i < (16 + 16 + 4 + 4) * per; i += nvb * NTHREADS) {
            const int bh = i / per, o = i % per; bf16_t* base;
            if (bh < 16) base = KA + (size_t)bh * KEYS * 128; else if (bh < 32) base = VA + (size_t)(bh - 16) * KEYS * 128;
            else if (bh < 36) base = KB + (size_t)(bh - 32) * KEYS * 128; else base = VB + (size_t)(bh - 36) * KEYS * 128;
            ((u32x4*)base)[o] = (u32x4){0u, 0u, 0u, 0u};
        }
    }
}

namespace fa {
using bf16x8 = __attribute__((ext_vector_type(8))) short;
using s16x4  = __attribute__((ext_vector_type(4))) short;
using f32x16 = __attribute__((ext_vector_type(16))) float;
constexpr int NT = KEYS / 64;
constexpr int SLOT = 16384;
constexpr float THR = 8.f;
#define SBAR() __builtin_amdgcn_sched_barrier(0)
__device__ __forceinline__ int crow(int r, int hi) { return (r & 3) + 8 * (r >> 2) + 4 * hi; }
__device__ __forceinline__ unsigned cvtpk(float lo, float hi) { unsigned r; asm volatile("v_cvt_pk_bf16_f32 %0, %1, %2" : "=v"(r) : "v"(lo), "v"(hi)); return r; }
__device__ __forceinline__ void glds16(const void* gsrc, unsigned lds_dst) { unsigned keep;
    asm volatile("s_mov_b32 %0, m0\n\ts_mov_b32 m0, %2\n\ts_nop 0\n\tglobal_load_lds_dwordx4 %1, off\n\ts_mov_b32 m0, %0" : "=&s"(keep) : "v"(gsrc), "s"(lds_dst) : "memory"); }
__device__ __forceinline__ void glds16s(const void* sbase_, unsigned voff, unsigned lds_dst) { unsigned keep;
    const unsigned long long a_ = (unsigned long long)sbase_; const unsigned long long sbase = ((unsigned long long)(unsigned)__builtin_amdgcn_readfirstlane((int)(a_ >> 32)) << 32) | (unsigned)__builtin_amdgcn_readfirstlane((int)a_);
    asm volatile("s_nop 1\n\ts_mov_b32 %0, m0\n\ts_mov_b32 m0, %3\n\ts_nop 0\n\tglobal_load_lds_dwordx4 %1, %2\n\ts_mov_b32 m0, %0" : "=&s"(keep) : "v"(voff), "s"(sbase), "s"(lds_dst) : "memory"); }
}

namespace fb {
using fa::bf16x8; using fa::s16x4; using fa::f32x16; using fa::crow; using fa::cvtpk; using fa::glds16; using fa::glds16s;
constexpr int SLOT = 16384, KSL = 4, VSL = 4;
constexpr int L_K = 0, L_V = KSL * SLOT, L_WS = L_V + VSL * SLOT, L_END = L_WS + 8 * 64 * 4;
constexpr float THR = 8.f;
typedef __attribute__((address_space(3))) const char* lds_cptr;
typedef short v4i16_t __attribute__((ext_vector_type(4)));
#define FB_SBAR() __builtin_amdgcn_sched_barrier(0)
#define FB_PIN(x) asm volatile("" : "+v"(x))
#define FB_MFMA(a, b, c) __builtin_amdgcn_mfma_f32_32x32x16_bf16(a, b, c, 0, 0, 0)
#define FB_WAIT_BAR(N) asm volatile("s_waitcnt vmcnt(" #N ") lgkmcnt(0)\n\ts_barrier" ::: "memory")
#define FB_MX3(a, b, c) __builtin_fmaxf(__builtin_fmaxf((a), (b)), (c))
__device__ __forceinline__ bf16x8 kfrag(lds_cptr kp, int f) { return *(const __attribute__((address_space(3))) bf16x8*)(kp + (f >> 1) * 2048 + (f & 1) * 512); }
__device__ __forceinline__ s16x4 vtr(lds_cptr p) { return __builtin_bit_cast(s16x4, __builtin_amdgcn_ds_read_tr16_b64_v4i16((__attribute__((address_space(3))) v4i16_t*)p)); }
__device__ __forceinline__ float rowmax(const f32x16& p0, const f32x16& p1) {
    float a = FB_MX3(p0[0], p0[1], p1[0]), b = FB_MX3(p0[2], p0[3], p1[1]); a = FB_MX3(a, p1[2], p1[3]);
#pragma unroll
    for (int r = 4; r < 16; r += 4) { a = FB_MX3(a, p0[r], p0[r + 1]); b = FB_MX3(b, p0[r + 2], p0[r + 3]); a = FB_MX3(a, p1[r], p1[r + 1]); b = FB_MX3(b, p1[r + 2], p1[r + 3]); }
    float m = __builtin_fmaxf(a, b); auto rr = __builtin_amdgcn_permlane32_swap(__float_as_uint(m), __float_as_uint(m), false, false);
    return __builtin_fmaxf(__uint_as_float(rr[0]), __uint_as_float(rr[1])); }
__device__ __forceinline__ void split3(float w, unsigned& h1, unsigned& h2, unsigned& h3) {
    h1 = __float_as_uint(w) & 0xffff0000u; const float r1 = w - __uint_as_float(h1);
    h2 = __float_as_uint(r1) & 0xffff0000u; const float r2 = r1 - __uint_as_float(h2);
    h3 = __float_as_uint(r2) & 0xffff0000u; }

template <bool DIFF, bool IDLE = false, bool NOCHK = false, int KPF_ = 2, int VPF_ = 2>
__device__ __forceinline__ void attn_unit(const bf16x8 (&qr)[DIFF ? 4 : 8], const bf16_t* __restrict__ Kh, const bf16_t* __restrict__ Vh, int tq, int wrow0, float slopeL, char* lds,
                                          int tfirst, int tbase, int n, f32x16 (&o)[4], float& l_reg, float& mhat) {
    constexpr bool active = !IDLE;
    constexpr int ND0 = DIFF ? 4 : 8, NQ = 2 * ND0;
    constexpr int KPF = KPF_, VPF = VPF_;
    const int tid = TID(), lane = tid & 63, r32 = lane & 31, hi = lane >> 5; const int wid = __builtin_amdgcn_readfirstlane(tid >> 6);
    const unsigned lds0 = (unsigned)(uintptr_t)lds; float* wsf = (float*)(lds + L_WS) + wid * 64;
    const char* ksrc = (const char*)Kh + wid * 1024;
    const char* vsrc = (const char*)Vh + wid * 1024; const unsigned loff = lane * 16;
    const unsigned kdst = lds0 + L_K + wid * 1024, vdst = lds0 + L_V + wid * 1024;
#define TILE_OF(i) ((i) == 0 ? tfirst : tbase + (i))
#define DMA_K(i, slot) do { const char* s_ = ksrc + (size_t)TILE_OF(i) * SLOT; const unsigned d_ = (unsigned)__builtin_amdgcn_readfirstlane(kdst + (slot)); glds16s(s_, loff, d_); glds16s(s_ + 8192, loff, d_ + 8192); } while (0)
#define DMA_V(i, slot) do { const char* s_ = vsrc + (size_t)TILE_OF(i) * SLOT; const unsigned d_ = (unsigned)__builtin_amdgcn_readfirstlane(vdst + (slot)); glds16s(s_, loff, d_); glds16s(s_ + 8192, loff, d_ + 8192); } while (0)
    const lds_cptr vp0 = (lds_cptr)lds + L_V + ((lane >> 4) & 1) * 2048 + ((hi ^ ((lane >> 4) & 1)) * 128) + ((lane & 15) >> 2) * 32 + (lane & 3) * 8;
    const lds_cptr kp0 = (lds_cptr)lds + L_K + hi * 1024 + r32 * 16 + (DIFF ? (wid >> 2) * 8192 : 0);
    const bool lag = false;
    mhat = 0.f; l_reg = 0.f;
#pragma unroll
    for (int d = 0; d < 4; ++d) o[d] = f32x16{};
    const f32x16 zero16 = f32x16{};
    f32x16 negm = f32x16{};
    bool resc = false;
    f32x16 pA0, pA1, pB0, pB1; bf16x8 kf[KPF]; s16x4 vlo[VPF], vhi[VPF]; u32x4 pw0, pw1, pw2, pw3;
    bf16x8 kx0 = bf16x8{}, kx1 = bf16x8{}, qx = bf16x8{}; unsigned sl1 = 0, sl2 = 0, sl3 = 0;
    if (DIFF) { if (hi == 0) { const unsigned c0 = __float_as_uint((float)r32) >> 16, c1 = __float_as_uint((float)(32 + r32)) >> 16;
            u32x4 a = {0x3F803F80u, 0x3F80u | (c0 << 16), c0 | (c0 << 16), 0u}, b = {0x3F803F80u, 0x3F80u | (c1 << 16), c1 | (c1 << 16), 0u};
            kx0 = __builtin_bit_cast(bf16x8, a); kx1 = __builtin_bit_cast(bf16x8, b); }
        split3(slopeL, sl1, sl2, sl3); }
#define SIDE_OF(j) ((j) == 0 ? 0 : (64 * ((j) - 1) + 63 <= wrow0) ? 1 : (64 * ((j) - 1) >= wrow0 + 31) ? -1 : 0)
#define BUILD_QX(j) do { if (DIFF) { const int sd_ = SIDE_OF(j); float w_ = -mhat; unsigned sg_ = 0u, keep_ = 0u; \
        if (sd_ != 0) { const float lin_ = slopeL * (float)(tq - 64 * ((j) - 1)); w_ += sd_ > 0 ? -lin_ : lin_; sg_ = sd_ > 0 ? 0u : 0x80000000u; keep_ = 0xffffffffu; } \
        unsigned h1_, h2_, h3_; split3(w_, h1_, h2_, h3_); const unsigned a1_ = (sl1 ^ sg_) & keep_, a2_ = (sl2 ^ sg_) & keep_, a3_ = (sl3 ^ sg_) & keep_; \
        u32x4 q_ = {(h1_ >> 16) | h2_, (h3_ >> 16) | a1_, (a2_ >> 16) | a3_, 0u}; if (hi != 0) q_ = (u32x4){0u, 0u, 0u, 0u}; qx = __builtin_bit_cast(bf16x8, q_); } } while (0)
#define FIXUP(C0, C1, j) do { if ((j) == 0) { _Pragma("unroll") for (int r = 8; r < 16; ++r) C0[r] = -1e30f; _Pragma("unroll") for (int r = 0; r < 16; ++r) C1[r] = -1e30f; } \
        else if (DIFF && SIDE_OF(j) == 0) { const float base_ = (float)(tq - ((j) - 1) * 64 - 4 * hi); \
            _Pragma("unroll") for (int r = 0; r < 16; ++r) { const float d_ = base_ - (float)((r & 3) + 8 * (r >> 2)); \
                C0[r] = fmaf(-slopeL, fabsf(d_), C0[r]); C1[r] = fmaf(-slopeL, fabsf(d_ - 32.f), C1[r]); } } } while (0)
#define PFLAT(P0, P1, e) ((e) < 16 ? P0[(e) & 15] : P1[(e) & 15])
#define PWSET(u, v) do { if ((u) < 4) pw0[(u) & 3] = (v); else if ((u) < 8) pw1[(u) & 3] = (v); else if ((u) < 12) pw2[(u) & 3] = (v); else pw3[(u) & 3] = (v); } while (0)
#define PAF(k) __builtin_bit_cast(bf16x8, (k) == 0 ? pw0 : (k) == 1 ? pw1 : (k) == 2 ? pw2 : pw3)
#define VFR(i) (bf16x8){vlo[i][0], vlo[i][1], vlo[i][2], vlo[i][3], vhi[i][0], vhi[i][1], vhi[i][2], vhi[i][3]}
#define VRD(slotv, f, dst) do { const lds_cptr a_ = vp0 + (slotv) + ((f) >> 2) * 4096 + ((f) & 3) * 512; vlo[dst] = vtr(a_); vhi[dst] = vtr(a_ + 256); } while (0)
#define AUNIT(P0, P1, u) do { sacc += PFLAT(P0, P1, 2 * (u)); sacc += PFLAT(P0, P1, 2 * (u) + 1); PWSET(u, cvtpk(PFLAT(P0, P1, 2 * (u)), PFLAT(P0, P1, 2 * (u) + 1))); } while (0)
#define EXPU(C0, C1, u) do { if ((u) < 8) { C0[2 * ((u) & 7)] = __builtin_amdgcn_exp2f(C0[2 * ((u) & 7)] - sub_); C0[2 * ((u) & 7) + 1] = __builtin_amdgcn_exp2f(C0[2 * ((u) & 7) + 1] - sub_); } \
        else { C1[2 * ((u) & 7)] = __builtin_amdgcn_exp2f(C1[2 * ((u) & 7)] - sub_); C1[2 * ((u) & 7) + 1] = __builtin_amdgcn_exp2f(C1[2 * ((u) & 7) + 1] - sub_); } } while (0)
#define STEP(C0, C1, P0, P1, i, GK, GV, GL, WB) do { \
    const int j_ = TILE_OF(i); const lds_cptr kp_ = kp0 + kcur; const lds_cptr kn_ = kp0 + knxt; \
    if (active) { BUILD_QX(j_); FB_SBAR(); float sacc = 0.f; \
        if (DIFF) { C0 = FB_MFMA(kx0, qx, zero16); AUNIT(P0, P1, 0); FB_PIN(sacc); FB_PIN(pw0); FB_SBAR(); \
                    C1 = FB_MFMA(kx1, qx, zero16); AUNIT(P0, P1, 1); AUNIT(P0, P1, 2); FB_PIN(sacc); FB_PIN(pw0); FB_SBAR(); } \
        _Pragma("unroll") for (int g = 0; g < NQ; ++g) { \
            if (g & 1) C1 = FB_MFMA(kf[g % KPF], qr[g >> 1], (!DIFF && g < 2) ? negm : C1); else C0 = FB_MFMA(kf[g % KPF], qr[g >> 1], (!DIFF && g < 2) ? negm : C0); \
            if (g + KPF < NQ) kf[g % KPF] = kfrag(kp_, g + KPF); \
            if (DIFF) { if (g < 5) { AUNIT(P0, P1, 3 + 2 * g); AUNIT(P0, P1, 4 + 2 * g); } else AUNIT(P0, P1, 8 + g); } else AUNIT(P0, P1, g); \
            if (g >= NQ - VPF) VRD(vprv, g - (NQ - VPF), g - (NQ - VPF)); \
            FB_PIN(sacc); FB_PIN(pw0); FB_PIN(pw1); FB_PIN(pw2); FB_PIN(pw3); FB_SBAR(); } \
        l_reg += sacc; } \
    if (GK) DMA_K((i) + 3, kfree); if (GV) DMA_V((i) + 1, vnxt); \
    float sub_ = 0.f; \
    if (active) { FIXUP(C0, C1, j_); \
        if (!NOCHK) { const float rm = rowmax(C0, C1); resc = false; \
          if (__builtin_expect(__any(rm > THR), 0)) { const float dl = __builtin_fmaxf(rm, 0.f); mhat += dl; \
              _Pragma("unroll") for (int r = 0; r < 16; ++r) { C0[r] -= dl; C1[r] -= dl; } \
              if (!DIFF) { _Pragma("unroll") for (int r = 0; r < 16; ++r) negm[r] = -mhat; asm volatile("" : "+v"(negm)); } \
              const float f = __builtin_amdgcn_exp2f(-dl); l_reg *= f; if (hi == 0) wsf[r32] = f; resc = true; } } \
        sub_ = 0.f; } \
    if (lag) { WB; } \
    if (active) { FB_SBAR(); \
        _Pragma("unroll") for (int g = 0; g < 16; ++g) { \
            o[g >> 2] = FB_MFMA(PAF(g & 3), VFR(g % VPF), o[g >> 2]); \
            if (g + VPF < 16) VRD(vprv, g + VPF, g % VPF); \
            EXPU(C0, C1, g); \
            if ((GL) && g >= 4 && g < 4 + KPF) kf[g - 4] = kfrag(kn_, g - 4); \
            FB_PIN(C0); FB_PIN(C1); FB_SBAR(); } } \
    if (!lag) { WB; } \
    } while (0)
#define RESC() do { if (active && resc) { _Pragma("unroll") for (int d_ = 0; d_ < 4; ++d_) _Pragma("unroll") for (int r = 0; r < 16; ++r) o[d_][r] *= wsf[crow(r, hi)]; } } while (0)
    int kcur = 0, knxt = SLOT, kfree = 3 * SLOT, vprv = 0, vnxt = SLOT;
#define ROT() do { kfree = kcur; kcur = knxt; knxt = (knxt == (KSL - 1) * SLOT) ? 0 : knxt + SLOT; vprv = (vnxt == 0) ? (VSL - 1) * SLOT : vnxt - SLOT; vnxt = (vnxt == (VSL - 1) * SLOT) ? 0 : vnxt + SLOT; } while (0)
    DMA_K(0, 0); DMA_V(0, 0); DMA_K(1, SLOT); DMA_K(2, 2 * SLOT);
    FB_WAIT_BAR(6);
    if (n > 3) DMA_K(3, 3 * SLOT);
    DMA_V(1, SLOT);
    if (active) { const int j0 = tfirst; BUILD_QX(j0);
        if (DIFF) { pA0 = FB_MFMA(kx0, qx, zero16); pA1 = FB_MFMA(kx1, qx, zero16); }
#pragma unroll
        for (int g = 0; g < NQ; ++g) { const bf16x8 kk = kfrag(kp0, g);
            if (g & 1) pA1 = FB_MFMA(kk, qr[g >> 1], (!DIFF && g < 2) ? zero16 : pA1); else pA0 = FB_MFMA(kk, qr[g >> 1], (!DIFF && g < 2) ? zero16 : pA0); }
        FIXUP(pA0, pA1, j0);
        const float rm = rowmax(pA0, pA1); mhat = rm;
        if (!DIFF) {
#pragma unroll
            for (int r = 0; r < 16; ++r) negm[r] = -rm;
            asm volatile("" : "+v"(negm)); }
#pragma unroll
        for (int r = 0; r < 16; ++r) { pA0[r] = __builtin_amdgcn_exp2f(pA0[r] - rm); pA1[r] = __builtin_amdgcn_exp2f(pA1[r] - rm); } }
    if (n > 3) FB_WAIT_BAR(4); else FB_WAIT_BAR(2);
    kcur = SLOT; knxt = 2 * SLOT; kfree = 0; vprv = 0; vnxt = 2 * SLOT;
    if (active) {
#pragma unroll
        for (int g = 0; g < KPF; ++g) kf[g] = kfrag(kp0 + kcur, g); }
    int i = 1;
    for (; i + 5 < n; i += 2) {
        STEP(pB0, pB1, pA0, pA1, i, true, true, true, FB_WAIT_BAR(4));
        RESC(); ROT();
        STEP(pA0, pA1, pB0, pB1, i + 1, true, true, true, FB_WAIT_BAR(4));
        RESC(); ROT();
    }
    for (; i + 1 < n; i += 2) {
        STEP(pB0, pB1, pA0, pA1, i, (i + 3 < n), (i + 1 < n), (i + 1 < n), FB_WAIT_BAR(0));
        RESC(); ROT();
        STEP(pA0, pA1, pB0, pB1, i + 1, (i + 4 < n), (i + 2 < n), (i + 2 < n), FB_WAIT_BAR(0));
        RESC(); ROT();
    }
    if (active) { float sacc = 0.f;
#pragma unroll
        for (int u = 0; u < 16; ++u) AUNIT(pA0, pA1, u);
        l_reg += sacc;
#pragma unroll
        for (int g = 0; g < 16; ++g) { VRD(vprv, g, 0); o[g >> 2] = FB_MFMA(PAF(g & 3), VFR(0), o[g >> 2]); } }
    FB_WAIT_BAR(0);
#undef TILE_OF
#undef DMA_K
#undef DMA_V
#undef SIDE_OF
#undef BUILD_QX
#undef FIXUP
#undef PFLAT
#undef PWSET
#undef PAF
#undef VFR
#undef VRD
#undef AUNIT
#undef EXPU
#undef STEP
#undef RESC
#undef ROT
}
}

namespace fc {
using fa::bf16x8; using fa::s16x4; using fa::crow; using fa::cvtpk; using fa::glds16s;
using fb::SLOT; using fb::KSL; using fb::VSL; using fb::L_K; using fb::L_V; using fb::L_WS; using fb::lds_cptr; using fb::vtr;
typedef float f4 __attribute__((ext_vector_type(4)));
#define FC_MFMA(a, b, c) __builtin_amdgcn_mfma_f32_16x16x32_bf16(a, b, c, 0, 0, 0)
constexpr int KPF = 2, VPF = 2;
__device__ __forceinline__ void attn_unit16(const bf16_t* __restrict__ q0, const bf16_t* __restrict__ Kh, const bf16_t* __restrict__ Vh, char* lds, int tfirst, int tbase, int n,
                                            f4 (&o)[2][8], float (&lsum)[2]) {
    const int tid = TID(), lane = tid & 63, i16 = lane & 15, g = lane >> 4; const int wid = __builtin_amdgcn_readfirstlane(tid >> 6);
    const unsigned lds0 = (unsigned)(uintptr_t)lds;
    const char* ksrc = (const char*)Kh + wid * 1024; const char* vsrc = (const char*)Vh + wid * 1024; const unsigned loff = lane * 16;
    const unsigned kdst = lds0 + L_K + wid * 1024, vdst = lds0 + L_V + wid * 1024;
#define TILE_OF(i) ((i) == 0 ? tfirst : tbase + (i))
#define DMA_K(i, slot) do { const char* s_ = ksrc + (size_t)TILE_OF(i) * SLOT; const unsigned d_ = (unsigned)__builtin_amdgcn_readfirstlane(kdst + (slot)); glds16s(s_, loff, d_); glds16s(s_ + 8192, loff, d_ + 8192); } while (0)
#define DMA_V(i, slot) do { const char* s_ = vsrc + (size_t)TILE_OF(i) * SLOT; const unsigned d_ = (unsigned)__builtin_amdgcn_readfirstlane(vdst + (slot)); glds16s(s_, loff, d_); glds16s(s_ + 8192, loff, d_ + 8192); } while (0)
    const lds_cptr kp0 = (lds_cptr)lds + L_K + g * 1024 + i16 * 16;
    const lds_cptr vpE = (lds_cptr)lds + L_V + g * 128 + (i16 >> 2) * 32 + (i16 & 3) * 8;
    const lds_cptr vpO = (lds_cptr)lds + L_V + ((g * 128) ^ 128) + (i16 >> 2) * 32 + (i16 & 3) * 8;
#define KFR(kp, f) (*(const __attribute__((address_space(3))) bf16x8*)((kp) + ((f) >> 2) * 4096 + ((f) & 3) * 256))
#define VRD(slotv, f, dst) do { const lds_cptr a_ = (((f) & 1) ? vpO : vpE) + (slotv) + ((f) & 7) * 2048 + ((f) >> 3) * 1024; vlo[dst] = vtr(a_); vhi[dst] = vtr(a_ + 512); } while (0)
#define VFR(i) (bf16x8){vlo[i][0], vlo[i][1], vlo[i][2], vlo[i][3], vhi[i][0], vhi[i][1], vhi[i][2], vhi[i][3]}
    bf16x8 qf[2][4];
#pragma unroll
    for (int qb = 0; qb < 2; ++qb)
#pragma unroll
        for (int ds = 0; ds < 4; ++ds) qf[qb][ds] = *reinterpret_cast<const bf16x8*>(q0 + (size_t)(16 * qb + i16) * 128 + 32 * ds + 8 * g);
#pragma unroll
    for (int qb = 0; qb < 2; ++qb)
#pragma unroll
        for (int db = 0; db < 8; ++db) o[qb][db] = (f4){0.f, 0.f, 0.f, 0.f};
    lsum[0] = 0.f; lsum[1] = 0.f;
    f4 negm0 = (f4){0.f, 0.f, 0.f, 0.f}, negm1 = (f4){0.f, 0.f, 0.f, 0.f};
    const f4 zero4 = (f4){0.f, 0.f, 0.f, 0.f};
    f4 cA[4][2], cB[4][2]; bf16x8 kf[KPF]; s16x4 vlo[VPF], vhi[VPF]; u32x4 pw[2][2];
#define AUNIT(P, u) do { const float a_ = P[2 * (((u) >> 2) & 1) + (((u) & 3) >> 1)][(u) >> 3][2 * ((u) & 1)], b_ = P[2 * (((u) >> 2) & 1) + (((u) & 3) >> 1)][(u) >> 3][2 * ((u) & 1) + 1]; \
        lsum[(u) >> 3] += a_; lsum[(u) >> 3] += b_; pw[(u) >> 3][((u) >> 2) & 1][(u) & 3] = cvtpk(a_, b_); } while (0)
#define EXPE(C, e) do { C[(e) >> 3][((e) >> 2) & 1][(e) & 3] = __builtin_amdgcn_exp2f(C[(e) >> 3][((e) >> 2) & 1][(e) & 3]); } while (0)
#define PINC(C) do { _Pragma("unroll") for (int a_ = 0; a_ < 4; ++a_) { FB_PIN(C[a_][0]); FB_PIN(C[a_][1]); } } while (0)
#define STEP(C, P, i, GK, GV, GL, WB) do { \
    const lds_cptr kp_ = kp0 + kcur; const lds_cptr kn_ = kp0 + knxt; \
    FB_SBAR(); \
    _Pragma("unroll") for (int f = 0; f < 16; ++f) { const int kb = f & 3, ds = f >> 2; \
        C[kb][0] = FC_MFMA(kf[f % KPF], qf[0][ds], ds == 0 ? negm0 : C[kb][0]); C[kb][1] = FC_MFMA(kf[f % KPF], qf[1][ds], ds == 0 ? negm1 : C[kb][1]); \
        if (f + KPF < 16) kf[f % KPF] = KFR(kp_, f + KPF); \
        AUNIT(P, f); \
        if (f >= 16 - VPF) VRD(vprv, f - (16 - VPF), f - (16 - VPF)); \
        FB_PIN(lsum[0]); FB_PIN(lsum[1]); FB_PIN(pw[0][0]); FB_PIN(pw[0][1]); FB_PIN(pw[1][0]); FB_PIN(pw[1][1]); FB_SBAR(); } \
    if (GK) DMA_K((i) + 3, kfree); if (GV) DMA_V((i) + 1, vnxt); \
    FB_SBAR(); \
    _Pragma("unroll") for (int f = 0; f < 16; ++f) { const int db = f & 7, st = f >> 3; \
        o[0][db] = FC_MFMA(__builtin_bit_cast(bf16x8, pw[0][st]), VFR(f % VPF), o[0][db]); o[1][db] = FC_MFMA(__builtin_bit_cast(bf16x8, pw[1][st]), VFR(f % VPF), o[1][db]); \
        if (f + VPF < 16) VRD(vprv, f + VPF, f % VPF); \
        EXPE(C, 2 * f); EXPE(C, 2 * f + 1); \
        if ((GL) && f >= 8 && f < 8 + KPF) kf[f - 8] = KFR(kn_, f - 8); \
        PINC(C); FB_SBAR(); } \
    WB; \
    } while (0)
    int kcur = 0, knxt = SLOT, kfree = 3 * SLOT, vprv = 0, vnxt = SLOT;
#define ROT() do { kfree = kcur; kcur = knxt; knxt = (knxt == (KSL - 1) * SLOT) ? 0 : knxt + SLOT; vprv = (vnxt == 0) ? (VSL - 1) * SLOT : vnxt - SLOT; vnxt = (vnxt == (VSL - 1) * SLOT) ? 0 : vnxt + SLOT; } while (0)
    DMA_K(0, 0); DMA_V(0, 0); DMA_K(1, SLOT); DMA_K(2, 2 * SLOT);
    FB_WAIT_BAR(6);
    if (n > 3) DMA_K(3, 3 * SLOT);
    DMA_V(1, SLOT);
    {
#pragma unroll
        for (int f = 0; f < 16; ++f) { const int kb = f & 3, ds = f >> 2; const bf16x8 kk = KFR(kp0, f);
            cA[kb][0] = FC_MFMA(kk, qf[0][ds], ds == 0 ? zero4 : cA[kb][0]); cA[kb][1] = FC_MFMA(kk, qf[1][ds], ds == 0 ? zero4 : cA[kb][1]); }
        if (tfirst == 0) {
#pragma unroll
            for (int kb = 1; kb < 4; ++kb) { cA[kb][0] = (f4){-1e30f, -1e30f, -1e30f, -1e30f}; cA[kb][1] = (f4){-1e30f, -1e30f, -1e30f, -1e30f}; } }
        float m0 = -1e30f, m1 = -1e30f;
#pragma unroll
        for (int kb = 0; kb < 4; ++kb)
#pragma unroll
            for (int r = 0; r < 4; ++r) { m0 = fmaxf(m0, cA[kb][0][r]); m1 = fmaxf(m1, cA[kb][1][r]); }
        m0 = fmaxf(m0, __shfl_xor(m0, 16)); m0 = fmaxf(m0, __shfl_xor(m0, 32)); m1 = fmaxf(m1, __shfl_xor(m1, 16)); m1 = fmaxf(m1, __shfl_xor(m1, 32));
        negm0 = (f4){-m0, -m0, -m0, -m0}; negm1 = (f4){-m1, -m1, -m1, -m1}; asm volatile("" : "+v"(negm0), "+v"(negm1));
#pragma unroll
        for (int kb = 0; kb < 4; ++kb)
#pragma unroll
            for (int r = 0; r < 4; ++r) { cA[kb][0][r] = __builtin_amdgcn_exp2f(cA[kb][0][r] - m0); cA[kb][1][r] = __builtin_amdgcn_exp2f(cA[kb][1][r] - m1); }
    }
    if (n > 3) FB_WAIT_BAR(4); else FB_WAIT_BAR(2);
    kcur = SLOT; knxt = 2 * SLOT; kfree = 0; vprv = 0; vnxt = 2 * SLOT;
#pragma unroll
    for (int f = 0; f < KPF; ++f) kf[f] = KFR(kp0 + kcur, f);
    int i = 1;
    for (; i + 5 < n; i += 2) {
        STEP(cB, cA, i, true, true, true, FB_WAIT_BAR(4)); ROT();
        STEP(cA, cB, i + 1, true, true, true, FB_WAIT_BAR(4)); ROT();
    }
    for (; i + 1 < n; i += 2) {
        STEP(cB, cA, i, (i + 3 < n), (i + 1 < n), (i + 1 < n), FB_WAIT_BAR(0)); ROT();
        STEP(cA, cB, i + 1, (i + 4 < n), (i + 2 < n), (i + 2 < n), FB_WAIT_BAR(0)); ROT();
    }
    {
#pragma unroll
        for (int u = 0; u < 16; ++u) AUNIT(cA, u);
#pragma unroll
        for (int f = 0; f < 16; ++f) { const int db = f & 7, st = f >> 3; VRD(vprv, f, 0);
            o[0][db] = FC_MFMA(__builtin_bit_cast(bf16x8, pw[0][st]), VFR(0), o[0][db]); o[1][db] = FC_MFMA(__builtin_bit_cast(bf16x8, pw[1][st]), VFR(0), o[1][db]); }
    }
    FB_WAIT_BAR(0);
    lsum[0] += __shfl_xor(lsum[0], 16); lsum[0] += __shfl_xor(lsum[0], 32); lsum[1] += __shfl_xor(lsum[1], 16); lsum[1] += __shfl_xor(lsum[1], 32);
#undef TILE_OF
#undef DMA_K
#undef DMA_V
#undef KFR
#undef VRD
#undef VFR
#undef AUNIT
#undef EXPE
#undef PINC
#undef STEP
#undef ROT
}
template <class RowPtr>
__device__ __forceinline__ void finish_tile16(f4 (&o)[2][8], const float (&lsum)[2], float* li, char* stage, int lane, RowPtr rowptr) {
    const int i16 = lane & 15, g = lane >> 4;
    if (g == 0) { li[i16] = lsum[0]; li[16 + i16] = lsum[1]; }
    asm volatile("s_waitcnt lgkmcnt(0)" ::: "memory");
    bf16_t* stg = (bf16_t*)stage;
#pragma unroll
    for (int qb = 0; qb < 2; ++qb)
#pragma unroll
        for (int r = 0; r < 4; ++r) { const int row = 16 * qb + 4 * g + r; const float rl = __builtin_amdgcn_rcpf(li[row]);
#pragma unroll
            for (int db = 0; db < 8; ++db) stg[row * 136 + 16 * db + i16] = (bf16_t)f2bf(o[qb][db][r] * rl); }
    asm volatile("s_waitcnt lgkmcnt(0)" ::: "memory");
#pragma unroll
    for (int i = 0; i < 8; ++i) { const int row = i * 4 + (lane >> 4), ch = lane & 15;
        const u32x4 v = *(const u32x4*)(stg + row * 136 + ch * 8);
        bf16_t* gp = rowptr(row); if (gp) *(u32x4*)(gp + ch * 8) = v; }
    asm volatile("s_waitcnt lgkmcnt(0)" ::: "memory");
}
}

namespace fa {
template <class RowPtr>
__device__ __forceinline__ void store_tile(const f32x16 (&y)[4], char* stage, int lane, RowPtr rowptr) {
    const int r32 = lane & 31, hi = lane >> 5;
    bf16_t* stg = (bf16_t*)stage;
#pragma unroll
    for (int r = 0; r < 16; ++r) { const int orow = crow(r, hi);
#pragma unroll
        for (int d0 = 0; d0 < 4; ++d0) stg[orow * 136 + d0 * 32 + r32] = (bf16_t)f2bf(y[d0][r]); }
    asm volatile("s_waitcnt lgkmcnt(0)" ::: "memory");
#pragma unroll
    for (int i = 0; i < 8; ++i) { const int row = i * 4 + (lane >> 4), ch = lane & 15;
        const u32x4 v = *(const u32x4*)(stg + row * 136 + ch * 8);
        bf16_t* gp = rowptr(row); if (gp) *(u32x4*)(gp + ch * 8) = v; }
    asm volatile("s_waitcnt lgkmcnt(0)" ::: "memory");
}
}

constexpr int NPRB = 4 * 11 * 2 + 16 * 11;
constexpr size_t OFF_PART = (OFF_ATT_END + 255) / 256 * 256;
constexpr size_t OFF_PML = OFF_PART + (size_t)NPRB * 32 * 128 * 4;
static_assert(OFF_PML + NPRB * 32 * 2 * 4 <= 256 * MiB, "meta partials");
#ifndef GQA_KPF
#define GQA_KPF 2
#endif
#ifndef GQA_VPF
#define GQA_VPF 2
#endif
constexpr int NRANGE = 11;
constexpr int NMINI_G = 4 * NRANGE, NMINI = 20 * NRANGE;
__device__ __forceinline__ void meta_range(int r, int& t0, int& t1) { t0 = r < 7 ? 11 * r : 77 + 13 * (r - 7); t1 = t0 + (r < 7 ? 11 : 13); }
static_assert(77 + 13 * 4 == fa::NT && NPRB == 2 * NMINI_G + 16 * NRANGE, "meta ranges");

#define LSUM2(l) do { auto rr_ = __builtin_amdgcn_permlane32_swap(__float_as_uint(l), __float_as_uint(l), false, false); l = __uint_as_float(rr_[0]) + __uint_as_float(rr_[1]); } while (0)
#define WS_() ({ unsigned char* w_ = p.ws; asm volatile("" : "+s"(w_)); w_; })
template <bool NC>
__device__ __forceinline__ void attn_gqa_section(const Params& p, char* lds, int vb, int nvb) {
    using namespace fa;
    const int tid = TID(), wid = __builtin_amdgcn_readfirstlane(tid >> 6), lane0 = tid & 63;
    for (int v = vb; v < 256; v += nvb) {
        const int xcd = v & 7, slot = v >> 3;
        for (int k = 0; k < 2; ++k) {
            f32x16 o[4]; float l_reg, m_reg;
            {
                const int b = xcd >> 2, kvh = (xcd >> 1) & 1, h = kvh * 4 + (xcd & 1) * 2 + k, bh = b * 8 + h, qb = slot;
                if constexpr (NC) {
                    fc::f4 o16[2][8]; float ls[2];
                    { unsigned char* ws = WS_(); const bf16_t *QB = (const bf16_t*)(ws + OFF_QB), *KB = (const bf16_t*)(ws + OFF_KB), *VB = (const bf16_t*)(ws + OFF_VB);
                      const size_t kvo = (size_t)(b * 2 + kvh) * KEYS * 128;
                      fc::attn_unit16(QB + ((size_t)bh * QROWS + qb * 256 + wid * 32) * 128, KB + kvo, VB + kvo, lds, 0, 0, NT, o16, ls); }
                    int lane = lane0; asm volatile("" : "+v"(lane));
                    const int wave_row0 = qb * 256 + wid * 32;
                    bf16_t* OB = (bf16_t*)(WS_() + OFF_AO) + 1024;
                    fc::finish_tile16(o16, ls, (float*)(lds + fb::L_WS) + wid * 64, lds + wid * 8704, lane, [&](int row) -> bf16_t* { return OB + (size_t)(b * SEQ + wave_row0 + row) * AOP + h * 128; });
                    __syncthreads();
                } else {
                { bf16x8 qr[8]; const int r32q = lane0 & 31, hiq = lane0 >> 5;
                  unsigned char* ws = WS_(); const bf16_t *QB = (const bf16_t*)(ws + OFF_QB), *KB = (const bf16_t*)(ws + OFF_KB), *VB = (const bf16_t*)(ws + OFF_VB);
                  const bf16_t* q = QB + ((size_t)bh * QROWS + qb * 256 + wid * 32 + r32q) * 128 + hiq * 8;
#pragma unroll
                  for (int d0 = 0; d0 < 8; ++d0) qr[d0] = *reinterpret_cast<const bf16x8*>(q + d0 * 16);
                  const size_t kvo = (size_t)(b * 2 + kvh) * KEYS * 128;
                  fb::attn_unit<false, false, NC, GQA_KPF, GQA_VPF>(qr, KB + kvo, VB + kvo, 0, 0, 0.f, lds, 0, 0, NT, o, l_reg, m_reg); }
                int lane = lane0; asm volatile("" : "+v"(lane));
                const int r32 = lane & 31, hi = lane >> 5;
                LSUM2(l_reg);
                float* li_l = (float*)(lds + fb::L_WS) + wid * 64;
                if (hi == 0) li_l[r32] = l_reg;
                asm volatile("s_waitcnt lgkmcnt(0)" ::: "memory");
#pragma unroll
                for (int r = 0; r < 16; ++r) { const float rl = __builtin_amdgcn_rcpf(li_l[crow(r, hi)]);
#pragma unroll
                    for (int d = 0; d < 4; ++d) o[d][r] *= rl; }
                const int wave_row0 = qb * 256 + wid * 32;
                bf16_t* OB = (bf16_t*)(WS_() + OFF_AO) + 1024;
                store_tile(o, lds + wid * 8704, lane, [&](int row) -> bf16_t* { return OB + (size_t)(b * SEQ + wave_row0 + row) * AOP + h * 128; });
                __syncthreads();
                }
            }
        }
    }
}
template <bool NC>
__device__ __forceinline__ void attn_diff_section(const Params& p, char* lds, int vb, int nvb) {
    using namespace fa;
    const int wid = __builtin_amdgcn_readfirstlane(TID() >> 6);
    __syncthreads();
    if (TID() == 0) ((volatile int*)(lds + fb::L_WS + 2048))[0] = (int)atomicAdd((unsigned*)(WS_() + OFF_QCTR), 1u);
    __syncthreads();
    for (;;) {
                f32x16 o[4]; float l_reg, m_reg;
                const int lane0 = TID() & 63;
                const int uq = __builtin_amdgcn_readfirstlane(((volatile int*)(lds + fb::L_WS + 2048))[0]);
                if (uq >= 1024) break;
                const int h = 7 - (uq >> 7), b = (uq >> 6) & 1, qb = uq & 63, bh = b * 8 + h, mp = wid >> 2, wq = wid & 3;
                int jlo, nvis;
                { const float* nq = (const float*)(WS_() + OFF_NRM) + (b * 8 + h) * 4; const float* nk = nq + 64;
                  const float B0 = sqrtf(nq[0] * nk[0]) + sqrtf(nq[1] * nk[1]), B1 = sqrtf(nq[2] * nk[2]) + sqrtf(nq[3] * nk[3]);
                  const float Bm = 1.02f * fmaxf(B0, B1), slopeC = exp2f(-(float)(h + 1)) * LOG2E;
                  const float dc = fminf((2.f * Bm + 152.f) / slopeC, 16384.f); const int dcut = (int)dc;
                  int lo = qb * 128 - dcut; lo = lo < 0 ? 0 : lo; int hi_ = qb * 128 + 127 + dcut; hi_ = hi_ > SEQ - 1 ? SEQ - 1 : hi_;
                  jlo = 1 + (lo >> 6); int jhi = 1 + (hi_ >> 6); nvis = jhi - jlo + 2;
                  if ((nvis & 1) == 0) { if (jhi < NT - 1) ++jhi; else --jlo; ++nvis; }
                  if (nvis < 3) { jlo = jlo > 1 ? jlo - 1 : jlo; nvis = 3; } }
                { bf16x8 qr[4]; const int r32q = lane0 & 31, hiq = lane0 >> 5; const int qrow = qb * 128 + wq * 32 + r32q;
                  unsigned char* ws = WS_(); const bf16_t *QA = (const bf16_t*)(ws + OFF_QA), *KA = (const bf16_t*)(ws + OFF_KA), *VA = (const bf16_t*)(ws + OFF_VA);
                  const bf16_t* q = QA + ((size_t)bh * QROWS + qrow) * 128 + mp * 64 + hiq * 8;
#pragma unroll
                  for (int d0 = 0; d0 < 4; ++d0) qr[d0] = *reinterpret_cast<const bf16x8*>(q + d0 * 16);
                  const float slopeL = exp2f(-(float)(h + 1)) * LOG2E;
                  const size_t kvo = (size_t)bh * KEYS * 128;
                  fb::attn_unit<true, false, NC>(qr, KA + kvo, VA + kvo, qrow, qb * 128 + wq * 32, slopeL, lds, 0, jlo - 1, nvis, o, l_reg, m_reg); }
                int lane = lane0; asm volatile("" : "+v"(lane));
                const int r32 = lane & 31, hi = lane >> 5;
                unsigned tkn = 0u; if (TID() == 0) tkn = atomicAdd((unsigned*)(WS_() + OFF_QCTR), 1u);
                LSUM2(l_reg);
                float* li_l = (float*)(lds + fb::L_WS) + wid * 64;
                if (hi == 0) li_l[r32] = l_reg;
                asm volatile("s_waitcnt lgkmcnt(0)" ::: "memory");
#pragma unroll
                for (int r = 0; r < 16; ++r) { const float rl = __builtin_amdgcn_rcpf(li_l[crow(r, hi)]);
#pragma unroll
                    for (int d = 0; d < 4; ++d) o[d][r] *= rl; }
                float* X = (float*)lds + wq * 4096;
                if (mp == 1) {
#pragma unroll
                    for (int r = 0; r < 16; ++r)
#pragma unroll
                        for (int d = 0; d < 4; ++d) X[(r * 4 + d) * 64 + lane] = o[d][r];
                }
                __syncthreads();
                if (mp == 0) {
                    const float lam = *(const float*)(WS_() + OFF_LAM);
                    float ss[16];
#pragma unroll
                    for (int r = 0; r < 16; ++r) { float a = 0.f;
#pragma unroll
                        for (int d = 0; d < 4; ++d) { const float y = o[d][r] - lam * X[(r * 4 + d) * 64 + lane]; o[d][r] = y; a += y * y; }
                        ss[r] = a; }
#pragma unroll
                    for (int r = 0; r < 16; ++r) {
                        float a = ss[r];
                        a += __shfl_xor(a, 1); a += __shfl_xor(a, 2); a += __shfl_xor(a, 4); a += __shfl_xor(a, 8); a += __shfl_xor(a, 16);
                        ss[r] = 1.0f / sqrtf(a * (1.0f / 128.f) + EPS) * (1.0f - LAM_INIT);
                    }
                    float g[4];
#pragma unroll
                    for (int d = 0; d < 4; ++d) g[d] = p.g_subln[d * 32 + r32];
#pragma unroll
                    for (int r = 0; r < 16; ++r)
#pragma unroll
                        for (int d = 0; d < 4; ++d) o[d][r] *= ss[r] * g[d];
                }
                __syncthreads();
                if (mp == 0) {
                    const int wave_row0 = qb * 128 + wq * 32;
                    bf16_t* OA = (bf16_t*)(WS_() + OFF_AO);
                    store_tile(o, lds + wid * 8704, lane, [&](int row) -> bf16_t* { return OA + (size_t)(b * SEQ + wave_row0 + row) * AOP + h * 128; });
                }
                if (TID() == 0) ((volatile int*)(lds + fb::L_WS + 2048))[0] = (int)tkn;
                __syncthreads();
    }
}
__device__ __forceinline__ void phase2b(const Params& p, int vb, int nvb) {
    const int tid = TID(), lane = tid & 63, wave = tid >> 6;
    const float* PART = (const float*)(p.ws + OFF_PART); const float* PML = (const float*)(p.ws + OFF_PML);
    bf16_t* OA = (bf16_t*)(p.ws + OFF_AO); bf16_t* OB = OA + 1024;
    const float lam = *(const float*)(p.ws + OFF_LAM);
    for (int t = vb * 8 + wave; t < 512; t += nvb * 8) {
        const int type = t >> 8, b = (t >> 7) & 1, h = (t >> 4) & 7, i = t & 15;
        float y0 = 0.f, y1 = 0.f;
        for (int mp = 0; mp < (type == 0 ? 1 : 2); ++mp) {
            int rb0, row;
            if (type == 0) { const int kvh = h >> 2, w = (h & 3) >> 1; rb0 = ((b * 2 + kvh) * NRANGE) * 2 + w; row = (h & 1) * 16 + i; }
            else { rb0 = 2 * NMINI_G + (b * 8 + h) * NRANGE; row = mp * 16 + i; }
            const int rbs = type == 0 ? 2 : 1;
            float M = -1e30f;
            for (int r = 0; r < NRANGE; ++r) M = fmaxf(M, PML[((rb0 + r * rbs) * 32 + row) * 2]);
            float L = 0.f, a0 = 0.f, a1 = 0.f;
            for (int r = 0; r < NRANGE; ++r) { const int rb = rb0 + r * rbs; const float w = exp2f(PML[(rb * 32 + row) * 2] - M);
                L += PML[(rb * 32 + row) * 2 + 1] * w; const float2 ov = *(const float2*)(PART + ((size_t)rb * 32 + row) * 128 + 2 * lane); a0 += ov.x * w; a1 += ov.y * w; }
            const float sgn = mp == 0 ? 1.f : -lam;
            y0 += sgn * a0 / L; y1 += sgn * a1 / L;
        }
        const size_t grow = (size_t)(MREAL + b * NMETA + i);
        if (type == 0) ((unsigned*)(OB + grow * AOP + h * 128))[lane] = f2bf(y0) | (f2bf(y1) << 16);
        else { const float ss = wave_sum(y0 * y0 + y1 * y1); const float rstd = 1.0f / sqrtf(ss * (1.0f / 128.f) + EPS) * (1.0f - LAM_INIT);
            ((unsigned*)(OA + grow * AOP + h * 128))[lane] = f2bf(y0 * rstd * p.g_subln[2 * lane]) | (f2bf(y1 * rstd * p.g_subln[2 * lane + 1]) << 16); }
    }
}

__device__ __forceinline__ void phase2_fast(const Params& p, char* lds, int vb, int nvb) {
    using namespace fa;
    const int tid = TID(), wid = __builtin_amdgcn_readfirstlane(tid >> 6), lane0 = tid & 63;
    for (int v = vb; v < 256; v += nvb) {
        const int xcd = v & 7, slot = v >> 3;
        if (v < NMINI) {
            f32x16 o[4]; float l_reg, m_reg; bf16x8 qr[8]; int t0, t1, rb; bool active;
            const int r32q = lane0 & 31, hiq = lane0 >> 5;
            if (v < NMINI_G) { const int g = v / NRANGE, rg = v % NRANGE, b = g >> 1, kvh = g & 1; meta_range(rg, t0, t1);
                active = wid < 2; const int h = kvh * 4 + (wid & 1) * 2 + (r32q >> 4);
                unsigned char* ws = WS_(); const bf16_t *QB = (const bf16_t*)(ws + OFF_QB), *KB = (const bf16_t*)(ws + OFF_KB), *VB = (const bf16_t*)(ws + OFF_VB);
                const bf16_t* q = QB + ((size_t)(b * 8 + h) * QROWS + SEQ + (r32q & 15)) * 128 + hiq * 8;
#pragma unroll
                for (int d0 = 0; d0 < 8; ++d0) qr[d0] = *reinterpret_cast<const bf16x8*>(q + d0 * 16);
                const size_t kvo = (size_t)(b * 2 + kvh) * KEYS * 128; rb = (g * NRANGE + rg) * 2 + (wid & 1);
                if (active) fb::attn_unit<false, false>(qr, KB + kvo, VB + kvo, 0, 0, 0.f, lds, t0, t0, t1 - t0, o, l_reg, m_reg); else fb::attn_unit<false, true>(qr, KB + kvo, VB + kvo, 0, 0, 0.f, lds, t0, t0, t1 - t0, o, l_reg, m_reg);
            } else { const int bh = (v - NMINI_G) / NRANGE, rg = (v - NMINI_G) % NRANGE; meta_range(rg, t0, t1);
                active = wid == 0; const int mp = r32q >> 4;
                unsigned char* ws = WS_(); const bf16_t *QA = (const bf16_t*)(ws + OFF_QA), *KA = (const bf16_t*)(ws + OFF_KA), *VA = (const bf16_t*)(ws + OFF_VA);
                const bf16_t* q = QA + ((size_t)bh * QROWS + SEQ + (r32q & 15)) * 128 + mp * 64 + hiq * 8;
#pragma unroll
                for (int d0 = 0; d0 < 8; ++d0) { const bf16x8 x = *reinterpret_cast<const bf16x8*>(q + (d0 & 3) * 16); qr[d0] = ((d0 >> 2) == mp) ? x : bf16x8{}; }
                const size_t kvo = (size_t)bh * KEYS * 128; rb = 2 * NMINI_G + bh * NRANGE + rg;
                if (active) fb::attn_unit<false, false>(qr, KA + kvo, VA + kvo, 0, 0, 0.f, lds, t0, t0, t1 - t0, o, l_reg, m_reg); else fb::attn_unit<false, true>(qr, KA + kvo, VA + kvo, 0, 0, 0.f, lds, t0, t0, t1 - t0, o, l_reg, m_reg);
            }
            if (active) {
                int lane = lane0; asm volatile("" : "+v"(lane));
                const int r32 = lane & 31, hi = lane >> 5;
                LSUM2(l_reg);
                unsigned char* ws = WS_(); float* PART = (float*)(ws + OFF_PART); float* PML = (float*)(ws + OFF_PML);
                float* po = PART + (size_t)rb * 32 * 128;
#pragma unroll
                for (int r = 0; r < 16; ++r)
#pragma unroll
                    for (int d = 0; d < 4; ++d) po[crow(r, hi) * 128 + d * 32 + r32] = o[d][r];
                if (hi == 0) { PML[(rb * 32 + r32) * 2] = m_reg; PML[(rb * 32 + r32) * 2 + 1] = l_reg; }
            }
            asm volatile("s_waitcnt vmcnt(0)" ::: "memory");
            __syncthreads();
            if (TID() == 0) { __builtin_amdgcn_fence(__ATOMIC_RELEASE, "agent"); asm volatile("s_waitcnt vmcnt(0)" ::: "memory");
                (void)__hip_atomic_fetch_add((unsigned*)(WS_() + OFF_MINIDONE), 1u, __ATOMIC_RELAXED, __HIP_MEMORY_SCOPE_AGENT); }
        }
    }
    __syncthreads();
    { const int t16 = TID();
      if (t16 < 64) { bool ok = true;
        float gq = fmaxf(fabsf(p.g_qnorm[t16]), fabsf(p.g_qnorm[t16 + 64])), gk = fmaxf(fabsf(p.g_knorm[t16]), fabsf(p.g_knorm[t16 + 64]));
        gq = wave_max(gq); gk = wave_max(gk);
        const float U = 1.02f * 128.f * gq * gk * CB;
        ok = 2.f * U <= 90.f;
        if (t16 < 16) { const int b = t16 >> 3, h = t16 & 7; const float* nrm = (const float*)(WS_() + OFF_NRM);
            const float* dq = nrm + (b * 8 + h) * 4; const float* dk = dq + 64;
            const float Bm = 1.02f * fmaxf(sqrtf(dq[0] * dk[0]) + sqrtf(dq[1] * dk[1]), sqrtf(dq[2] * dk[2]) + sqrtf(dq[3] * dk[3]));
            ok = ok && (2.f * Bm <= 90.f); }
        const bool all_ = __all(ok);
        if (t16 == 0) ((volatile int*)(lds + fb::L_WS + 2048))[1] = all_ ? 1 : 0; } }
    __syncthreads();
    const bool allsafe = __builtin_amdgcn_readfirstlane(((volatile int*)(lds + fb::L_WS + 2048))[1]) != 0;
    if (allsafe) attn_gqa_section<true>(p, lds, vb, nvb); else attn_gqa_section<false>(p, lds, vb, nvb);
    if (vb * 8 < 512) {
        if (TID() == 0) { unsigned* ctr = (unsigned*)(WS_() + OFF_MINIDONE); unsigned sp = 0;
            while (__hip_atomic_load(ctr, __ATOMIC_RELAXED, __HIP_MEMORY_SCOPE_AGENT) < (unsigned)NMINI) { __builtin_amdgcn_s_sleep(1); if (++sp > (1u << 24)) break; }
            __builtin_amdgcn_fence(__ATOMIC_ACQUIRE, "agent"); asm volatile("s_waitcnt vmcnt(0)" ::: "memory"); }
        __syncthreads();
        phase2b(p, vb, nvb);
    }
    if (allsafe) attn_diff_section<true>(p, lds, vb, nvb); else attn_diff_section<false>(p, lds, vb, nvb);
}
#undef LSUM2
#undef WS_
__device__ __forceinline__ float* h2_row(const Params& p, int grow) { return grow < MREAL ? p.out + (size_t)grow * DM : (float*)(p.ws + OFF_H2M) + (size_t)(grow - MREAL) * DM; }
__device__ __forceinline__ void phase4a(const Params& p, float* lds, int vb, int nvb) {
    const int tid = TID(), lane = tid & 63, wave = tid >> 6;
    for (int idx = tid; idx < DM * NEXP; idx += NTHREADS) { const int k = idx >> 4, e = idx & 15; lds[(((k >> 4) * 4 + ((k >> 2) & 3)) * 16 + e) * 4 + (k & 3)] = p.g_ffn[k] * p.w_router[idx]; }
    __syncthreads();
    bf16_t* U2 = (bf16_t*)(p.ws + OFF_UN); float* AFF = (float*)(p.ws + OFF_AFF);
    const int ri_ = lane & 15, q = lane >> 4;
    f32x4 gl[4];
#pragma unroll
    for (int c = 0; c < 4; ++c) gl[c] = *(const f32x4*)(p.g_ffn + 16 * lane + 4 * c);
    float* xch = lds + DM * NEXP;
    for (int base = vb; base < MROWS / 16; base += 4 * nvb) {
        const bool wide = base + nvb >= MROWS / 16;
        const int t = wide ? base : base + (wave >> 1) * nvb, part = wide ? wave : (wave & 1), nsp = wide ? 8 : 2;
        const bool act = t < MROWS / 16;
        const int R0 = t * 16, nit = 64 / nsp, it0 = part * nit;
        f32x4 acc = (f32x4){0.f, 0.f, 0.f, 0.f}; float ss = 0.f;
        if (act) {
            const float* xrow = h2_row(p, R0 + ri_) + 4 * q;
            for (int itb = it0; itb < it0 + nit; itb += 8) {
#pragma unroll
                for (int i8 = 0; i8 < 8; ++i8) { const int it = itb + i8;
                    const f32x4 x = *(const f32x4*)(xrow + 16 * it); const f32x4 w = *(const f32x4*)(lds + ((it * 4 + q) * 16 + ri_) * 4);
                    acc = __builtin_amdgcn_mfma_f32_16x16x4f32(x.x, w.x, acc, 0, 0, 0); acc = __builtin_amdgcn_mfma_f32_16x16x4f32(x.y, w.y, acc, 0, 0, 0);
                    acc = __builtin_amdgcn_mfma_f32_16x16x4f32(x.z, w.z, acc, 0, 0, 0); acc = __builtin_amdgcn_mfma_f32_16x16x4f32(x.w, w.w, acc, 0, 0, 0);
                    ss += (x.x * x.x + x.y * x.y) + (x.z * x.z + x.w * x.w);
                }
            }
            ss += __shfl_xor(ss, 16); ss += __shfl_xor(ss, 32);
        }
        xch[(wave * 5 + 0) * 64 + lane] = acc.x; xch[(wave * 5 + 1) * 64 + lane] = acc.y; xch[(wave * 5 + 2) * 64 + lane] = acc.z; xch[(wave * 5 + 3) * 64 + lane] = acc.w; xch[(wave * 5 + 4) * 64 + lane] = ss;
        __syncthreads();
        if (act) {
            acc = (f32x4){0.f, 0.f, 0.f, 0.f}; ss = 0.f;
            const int w0 = wave - part;
            for (int s = 0; s < nsp; ++s) { const float* xs = xch + (w0 + s) * 320 + lane; acc.x += xs[0]; acc.y += xs[64]; acc.z += xs[128]; acc.w += xs[192]; ss += xs[256]; }
            const float rstd_i = 1.0f / sqrtf(ss * (1.0f / DM) + EPS);
            if (part == 0) {
#pragma unroll
                for (int reg = 0; reg < 4; ++reg) {
                    const int row = R0 + 4 * q + reg; const float lg = acc[reg] * __shfl(rstd_i, 4 * q + reg);
                    float mx = lg; mx = fmaxf(mx, __shfl_xor(mx, 1)); mx = fmaxf(mx, __shfl_xor(mx, 2)); mx = fmaxf(mx, __shfl_xor(mx, 4)); mx = fmaxf(mx, __shfl_xor(mx, 8));
                    const float ex = expf(lg - mx); float den = ex; den += __shfl_xor(den, 1); den += __shfl_xor(den, 2); den += __shfl_xor(den, 4); den += __shfl_xor(den, 8);
                    const RowInfo ri = row_decode(row);
                    AFF[((size_t)ri.b * NEXP + ri_) * LTOT + row_pos(ri)] = ex / den;
                }
            }
            const int rbeg = wide ? 4 * wave : 8 * part, rend = wide ? (wave < 4 ? rbeg + 4 : rbeg) : rbeg + 8;
            for (int rr0 = rbeg; rr0 < rend; rr0 += 4) {
                f32x4 xv[4][4];
#pragma unroll
                for (int r4 = 0; r4 < 4; ++r4) { const float* xr = h2_row(p, R0 + rr0 + r4) + 16 * lane;
#pragma unroll
                    for (int c = 0; c < 4; ++c) xv[r4][c] = *(const f32x4*)(xr + 4 * c); }
#pragma unroll
                for (int r4 = 0; r4 < 4; ++r4) {
                    const float rs = __shfl(rstd_i, rr0 + r4);
                    const f32x4 x0 = xv[r4][0] * gl[0] * rs, x1 = xv[r4][1] * gl[1] * rs, x2 = xv[r4][2] * gl[2] * rs, x3 = xv[r4][3] * gl[3] * rs;
                    u32x4* o = (u32x4*)(U2 + (size_t)(R0 + rr0 + r4) * DM + 16 * lane);
                    o[0] = (u32x4){f2bf(x0.x) | (f2bf(x0.y) << 16), f2bf(x0.z) | (f2bf(x0.w) << 16), f2bf(x1.x) | (f2bf(x1.y) << 16), f2bf(x1.z) | (f2bf(x1.w) << 16)};
                    o[1] = (u32x4){f2bf(x2.x) | (f2bf(x2.y) << 16), f2bf(x2.z) | (f2bf(x2.w) << 16), f2bf(x3.x) | (f2bf(x3.y) << 16), f2bf(x3.z) | (f2bf(x3.w) << 16)};
                }
            }
        }
        __syncthreads();
    }
    __syncthreads();
}

__device__ __forceinline__ void phase6(const Params& p, int vb, int nvb) {
    const int tid = TID(), lane = tid & 63, wave = tid >> 6;
    const int* SEL = (const int*)(p.ws + OFF_SEL); const bf16_t* YB = (const bf16_t*)(p.ws + OFF_YB);
    f32x4 gf[4];
#pragma unroll
    for (int j = 0; j < 4; ++j) gf[j] = ((const f32x4*)p.g_final)[lane + 64 * j];
    for (int r0 = vb * 8 + wave; r0 < MREAL; r0 += nvb * 8 * 2) {
        f32x4 v[2][4]; int sel[2];
#pragma unroll
        for (int h = 0; h < 2; ++h) { const int r = r0 + h * nvb * 8; const int rr = r < MREAL ? r : r0; const int b = rr >> 13, tok = NMETA + (rr & (SEQ - 1));
            const f32x4* xr = (const f32x4*)(p.out + (size_t)rr * DM) + lane;
#pragma unroll
            for (int j = 0; j < 4; ++j) v[h][j] = xr[64 * j];
            sel[h] = lane < NEXP ? SEL[((size_t)b * LTOT + tok) * NEXP + lane] : -1; }
#pragma unroll
        for (int h = 0; h < 2; ++h) { const int r = r0 + h * nvb * 8; if (r >= MREAL) continue; const int b = r >> 13;
            unsigned long long msk = __ballot(sel[h] >= 0);
            while (msk) { const int e = __builtin_ctzll(msk); msk &= msk - 1; const int c = __shfl(sel[h], e);
                const u32x2* y = (const u32x2*)(YB + ((size_t)e * ESLOTS + b * CAP + c) * DM) + lane;
#pragma unroll
                for (int j = 0; j < 4; ++j) { const u32x2 w = y[64 * j]; v[h][j].x += bf2f(w.x & 0xffffu); v[h][j].y += bf2f(w.x >> 16); v[h][j].z += bf2f(w.y & 0xffffu); v[h][j].w += bf2f(w.y >> 16); } }
            float s = 0.f;
#pragma unroll
            for (int j = 0; j < 4; ++j) s += (v[h][j].x * v[h][j].x + v[h][j].y * v[h][j].y) + (v[h][j].z * v[h][j].z + v[h][j].w * v[h][j].w);
            const float rstd = 1.0f / sqrtf(wave_sum(s) * (1.0f / DM) + EPS);
            f32x4* xo = (f32x4*)(p.out + (size_t)r * DM) + lane;
#pragma unroll
            for (int j = 0; j < 4; ++j) xo[64 * j] = v[h][j] * gf[j] * rstd; }
    }
}

template <class DstRow>
__device__ __forceinline__ void transpose_item(const float* __restrict__ W, int N, bf16_t* __restrict__ WT, int ldk, int koff, float* scr, int k0, int n0, int lane, DstRow dst) {
    f32x4 t_[8];
#pragma unroll
    for (int i = 0; i < 8; ++i) t_[i] = *(const f32x4*)(W + (size_t)(k0 + 8 * i + (lane >> 3)) * N + n0 + (lane & 7) * 4);
#pragma unroll
    for (int i = 0; i < 8; ++i) { float* d_ = scr + (8 * i + (lane >> 3)) * 33 + (lane & 7) * 4; d_[0] = t_[i].x; d_[1] = t_[i].y; d_[2] = t_[i].z; d_[3] = t_[i].w; }
    asm volatile("s_waitcnt vmcnt(0) lgkmcnt(0)" ::: "memory");
    const int c = lane & 7;
#pragma unroll
    for (int j = 0; j < 4; ++j) { const int n = (lane >> 3) + 8 * j; const float* sp = scr + (8 * c) * 33 + n;
        u32x4 o; o.x = f2bf(sp[0 * 33]) | (f2bf(sp[1 * 33]) << 16); o.y = f2bf(sp[2 * 33]) | (f2bf(sp[3 * 33]) << 16);
        o.z = f2bf(sp[4 * 33]) | (f2bf(sp[5 * 33]) << 16); o.w = f2bf(sp[6 * 33]) | (f2bf(sp[7 * 33]) << 16);
        *(u32x4*)(WT + (size_t)dst(n0 + n) * ldk + koff + k0 + 8 * c) = o; }
    asm volatile("s_waitcnt lgkmcnt(0)" ::: "memory");
}
__device__ __forceinline__ int rope_slot(int e) { const int half = e >> 6, el = e & 63, j = el & 31, n = el >> 5, g = half * 8 + (j >> 2); return 32 * (g >> 2) + 8 * (g & 3) + 4 * n + (j & 3); }
__device__ __forceinline__ void transpose_p0(const Params& p, float* lds, int vb, int nvb) {
    const int tid = TID(), lane = tid & 63, wave = tid >> 6;
    float* scr = lds + wave * (64 * 33);
    bf16_t* WIN = (bf16_t*)(p.ws + OFF_WIN); bf16_t* WAB = (bf16_t*)(p.ws + OFF_WAB); bf16_t* WO = (bf16_t*)(p.ws + OFF_WO);
    constexpr int I_IN = 16 * (INW / 32), I_SQ = 16 * 32;
    for (int it = vb * 8 + wave; it < I_IN + 3 * I_SQ; it += nvb * 8) {
        int r = it;
        if (r < I_IN) { const int kb = r / (INW / 32), nb = r % (INW / 32);
            transpose_item(p.w_in, INW, WIN, DM, 0, scr, kb * 64, nb * 32, lane, [](int n) { return (n >= 3072 && n < 4352) ? (n & ~127) + rope_slot(n & 127) : n; }); continue; }
        r -= I_IN; const int m = r / I_SQ, q = r % I_SQ, kb = q / 32, nb = q % 32;
        if (m == 0) transpose_item(p.w_ba, DM, WAB, 2048, 0, scr, kb * 64, nb * 32, lane, [](int n) { return n; });
        else if (m == 1) transpose_item(p.w_bb, DM, WAB, 2048, 1024, scr, kb * 64, nb * 32, lane, [](int n) { return n; });
        else transpose_item(p.w_out, DM, WO, DM, 0, scr, kb * 64, nb * 32, lane, [](int n) { return n; });
    }
}
__device__ __forceinline__ void transpose_moe(const Params& p, float* lds, int vbl, int nvbl) {
    const int tid = TID(), lane = tid & 63, wave = tid >> 6;
    float* scr = lds + wave * (64 * 33);
    bf16_t* WGU = (bf16_t*)(p.ws + OFF_WGU); bf16_t* WD = (bf16_t*)(p.ws + OFF_WD);
    constexpr int I_G = 16 * 16, I_D = 8 * 32, I_E = 2 * I_G + I_D;
    for (int it = vbl * 8 + wave; it < NEXP * I_E; it += nvbl * 8) {
        const int e = it / I_E; int r = it % I_E;
        if (r < 2 * I_G) { const int up = r / I_G, q = r % I_G, kb = q / 16, nb = q % 16;
            const float* W = (up ? p.w_up : p.w_gate) + (size_t)e * DM * EFF;
            transpose_item(W, EFF, WGU + (size_t)e * DM * DM, DM, 0, scr, kb * 64, nb * 32, lane, [up](int f) { return 8 * (f >> 2) + 4 * up + (f & 3); }); }
        else { r -= 2 * I_G; const int kb = r / 32, nb = r % 32;
            transpose_item(p.w_down + (size_t)e * EFF * DM, DM, WD + (size_t)e * DM * EFF, EFF, 0, scr, kb * 64, nb * 32, lane, [](int n) { return n; }); }
    }
}

namespace pg8 {
#define PG8_LAS __attribute__((address_space(3)))
typedef short bf16x8 __attribute__((ext_vector_type(8)));
constexpr int BM = 256, BK = 64, HALF = 128, HTB = HALF * BK * 2, STAGE_BYTES = 8 * HTB, NXCD = 8, WGM = 8;
__host__ __device__ __forceinline__ int lds_byte(int r, int c) { const int st = (r >> 4) * 2 + (c >> 5), rr = r & 15, cc = c & 31, ob = rr * 64 + cc * 2; return st * 1024 + (ob ^ (((ob >> 9) & 1) << 5)); }
__host__ __device__ __forceinline__ void stage_rc(int b, int& R, int& C) { const int st = b / 1024, sb = b % 1024, swz = sb ^ (((sb >> 9) & 1) << 5); R = (st >> 1) * 16 + swz / 64; C = (st & 1) * 32 + (swz % 64) / 2; }
__host__ __device__ __forceinline__ int perm32(int rho) { const int n = rho >> 4, i = rho & 15; return 8 * (i >> 2) + 4 * n + (i & 3); }
struct Unit { int arow0, brow0, pm, pn, e; };
struct Gemm { const bf16_t* A; const bf16_t* Bt; int K; };
struct GridOrder {
    static constexpr bool GATHER = false;
    int nM, nN, nwg, G, c;
    __device__ unsigned arow_off(const Unit&, int) const { return 0u; }
    __device__ void init(int nM_, int nN_, int G_, int c_) { nM = nM_; nN = nN_; nwg = nM * nN; G = G_; c = c_; }
    __device__ bool next(int i, Unit& u) const {
        const long L = (long)i * G + c; if (L >= nwg) return false;
        int wgid = (int)L; { const int q = nwg / NXCD, r = nwg % NXCD, xcd = wgid % NXCD, off = wgid / NXCD; wgid = (xcd < r ? xcd * (q + 1) : r * (q + 1) + (xcd - r) * q) + off; }
        const int nig = WGM * nN, gid = wgid / nig, fm = gid * WGM, gsz = (nM - fm) < WGM ? (nM - fm) : WGM;
        u.pm = fm + ((wgid % nig) % gsz); u.pn = (wgid % nig) / gsz; u.e = 0; u.arow0 = u.pm * BM; u.brow0 = u.pn * BM; return true;
    }
};
template <bool GATHER_>
struct MoeOrderT {
    static constexpr bool GATHER = GATHER_;
    int G, c; const int* idx;
    __device__ bool next(int i, Unit& u) const {
        const int L = i * G + c; if (L >= NEXP * 32) return false;
        u.e = L >> 5; const int r = L & 31; u.pm = r & 7; u.pn = r >> 3; u.arow0 = u.e * ESLOTS + u.pm * BM; u.brow0 = u.e * DM + u.pn * BM; return true;
    }
    __device__ __forceinline__ unsigned arow_off(const Unit& u, int r) const {
        const int s = u.pm * BM + r, b = s >= CAP ? 1 : 0, cc = s - b * CAP; const int tok = idx[((size_t)b * NEXP + u.e) * CAP + cc];
        return (unsigned)pos_row(b, tok) * (unsigned)(DM * 2);
    }
};
__device__ __forceinline__ unsigned cvt_pk_bf16(float lo, float hi) { unsigned r; asm volatile("v_cvt_pk_bf16_f32 %0, %1, %2" : "=v"(r) : "v"(lo), "v"(hi)); return r; }
__device__ __forceinline__ float fsig(float x) { return __builtin_amdgcn_rcpf(1.0f + __builtin_amdgcn_exp2f(-1.4426950408889634f * x)); }

template <class Epi, class Sched>
__device__ __forceinline__ void gemm_phase(PG8_LAS unsigned char* lds, const Gemm g, const Sched& S, const Epi& E) {
    const int tid = TID(), wid = __builtin_amdgcn_readfirstlane(tid >> 6), lane = tid & 63, wr = wid >> 2, wc = wid & 3, fr = lane & 15, fq = lane >> 4;
    const int K = g.K, nt = K / BK;
    constexpr bool GA = Sched::GATHER;
    const size_t kstep = (size_t)(BK * 2);
    const size_t hstep = (size_t)HALF * K * 2;
    unsigned voA[2][2], nvA[2][2], voffB[2]; int Rs[2], Cs[2];
#pragma unroll
    for (int i = 0; i < 2; ++i) { int R, C; stage_rc(tid * 16 + i * 8192, R, C); const int Rb = Epi::PERM ? ((R & ~31) + perm32(R & 31)) : R; Rs[i] = R; Cs[i] = C;
        voA[0][i] = (unsigned)(R * K + C) * 2u; voA[1][i] = 0u; nvA[0][i] = voA[0][i]; nvA[1][i] = 0u; voffB[i] = (unsigned)(Rb * K + C) * 2u; }
#define PG8_STAGEA(bufoff, base, h, VO) do { if (GA) PG8_STAGE(bufoff, base, VO[h]); else PG8_STAGE(bufoff, (base) + (h) * hstep, VO[0]); } while (0)
#define PG8_AOFF(dst, u) do { if (GA) { _Pragma("unroll") for (int h_ = 0; h_ < 2; ++h_) _Pragma("unroll") for (int i_ = 0; i_ < 2; ++i_) dst[h_][i_] = S.arow_off(u, h_ * HALF + Rs[i_]) + (unsigned)Cs[i_] * 2u; } } while (0)
    const size_t rstep = (size_t)K * 2;
    const unsigned ldsw = (unsigned)wid * 1024u;
    const int aoff = lds_byte(wr * 64 + fr, fq * 8), boff = lds_byte(wc * 32 + fr, fq * 8);
#define PG8_SA(b, h) (((b) * 2 + (h)) * HTB)
#define PG8_SB(b, h) ((4 + (b) * 2 + (h)) * HTB)
#define PG8_STAGE(bufoff, gbase, voff) do { _Pragma("unroll") for (int _i = 0; _i < 2; ++_i) \
        __builtin_amdgcn_global_load_lds((const unsigned*)((const char*)(gbase) + (voff)[_i]), (PG8_LAS unsigned*)(lds + (bufoff) + ldsw + _i * 8192), 16, 0, 0); } while (0)
#define PG8_LDA(dst, b, h) do { _Pragma("unroll") for (int m = 0; m < 4; ++m) _Pragma("unroll") for (int k = 0; k < 2; ++k) dst[m][k] = *(const PG8_LAS bf16x8*)(lds + PG8_SA(b, h) + aoff + m * 2048 + k * 1024); } while (0)
#define PG8_LDB(dst, b, h) do { _Pragma("unroll") for (int n = 0; n < 2; ++n) _Pragma("unroll") for (int k = 0; k < 2; ++k) dst[n][k] = *(const PG8_LAS bf16x8*)(lds + PG8_SB(b, h) + boff + n * 2048 + k * 1024); } while (0)
#define PG8_MMA(ai, bj, At, Bt) do { __builtin_amdgcn_s_setprio(1); _Pragma("unroll") for (int m = 0; m < 4; ++m) _Pragma("unroll") for (int n = 0; n < 2; ++n) _Pragma("unroll") for (int k = 0; k < 2; ++k) \
        acc[ai][bj][m][n] = __builtin_amdgcn_mfma_f32_16x16x32_bf16(Bt[n][k], At[m][k], acc[ai][bj][m][n], 0, 0, 0); __builtin_amdgcn_s_setprio(0); } while (0)
#define PG8_WAIT_V(n) asm volatile("s_waitcnt vmcnt(" #n ")" ::: "memory")
#define PG8_WAIT_L(n) asm volatile("s_waitcnt lgkmcnt(" #n ")" ::: "memory")
#define PG8_BAR __builtin_amdgcn_s_barrier()
#define PG8_SCHED __builtin_amdgcn_sched_barrier(0)
    Unit cur, nxt; int ui = 0;
    if (!S.next(0, cur)) return;
    f32x4 acc[2][2][4][2];
#pragma unroll
    for (int a = 0; a < 2; ++a)
#pragma unroll
        for (int b = 0; b < 2; ++b)
#pragma unroll
            for (int m = 0; m < 4; ++m)
#pragma unroll
                for (int n = 0; n < 2; ++n) acc[a][b][m][n] = (f32x4){0.f, 0.f, 0.f, 0.f};
    bf16x8 At[4][2], B0[2][2], B1[2][2];
    const char* cA = (const char*)g.A + (GA ? (size_t)0 : (size_t)cur.arow0 * rstep); const char* cB = (const char*)g.Bt + (size_t)cur.brow0 * rstep;
    PG8_AOFF(voA, cur);
    PG8_STAGE(PG8_SB(0, 0), cB, voffB); PG8_STAGE(PG8_SB(0, 1), cB + hstep, voffB); PG8_STAGEA(PG8_SA(0, 0), cA, 0, voA); PG8_STAGEA(PG8_SA(0, 1), cA, 1, voA);
    if (wr == 1) PG8_BAR;
    PG8_WAIT_V(2); PG8_BAR;
    PG8_STAGE(PG8_SB(1, 0), cB + kstep, voffB); PG8_STAGEA(PG8_SA(1, 0), cA + kstep, 0, voA); PG8_STAGE(PG8_SB(1, 1), cB + hstep + kstep, voffB);
    PG8_WAIT_V(6); PG8_BAR;
    for (;;) {
        const bool has_next = S.next(ui + 1, nxt);
        const char* nA = (has_next && !GA) ? (const char*)g.A + (size_t)nxt.arow0 * rstep : cA; const char* nB = has_next ? (const char*)g.Bt + (size_t)nxt.brow0 * rstep : cB;
        if (GA) { if (has_next) PG8_AOFF(nvA, nxt); else { _Pragma("unroll") for (int h_ = 0; h_ < 2; ++h_) _Pragma("unroll") for (int i_ = 0; i_ < 2; ++i_) nvA[h_][i_] = voA[h_][i_]; } }
        for (int t = 0; t < nt; t += 2) {
            const bool last = (t == nt - 2);
            unsigned w2[2][2];
#pragma unroll
            for (int h_ = 0; h_ < 2; ++h_)
#pragma unroll
                for (int i_ = 0; i_ < 2; ++i_) w2[h_][i_] = (GA && last) ? nvA[h_][i_] : voA[h_][i_];
            const char* a1 = cA + (size_t)(t + 1) * kstep;
            const char* a2 = last ? nA : cA + (size_t)(t + 2) * kstep; const char* b2 = last ? nB : cB + (size_t)(t + 2) * kstep;
            const char* a3 = a2 + kstep; const char* b3 = b2 + kstep;
            if constexpr (Epi::HAS_MID) { if (t == nt / 2) E.mid(acc, cur, wr, wc, fr, fq); }
            PG8_LDB(B0, 0, 0); PG8_LDB(B1, 0, 1); PG8_SCHED; PG8_LDA(At, 0, 0); PG8_STAGEA(PG8_SA(1, 1), a1, 1, voA);
            PG8_WAIT_V(8); PG8_WAIT_L(0); PG8_BAR; PG8_MMA(0, 0, At, B0); PG8_MMA(0, 1, At, B1); PG8_BAR; PG8_SCHED;
            PG8_LDA(At, 0, 1); PG8_STAGE(PG8_SB(0, 0), b2, voffB); PG8_STAGE(PG8_SB(0, 1), b2 + hstep, voffB); PG8_STAGEA(PG8_SA(0, 0), a2, 0, w2);
            PG8_WAIT_V(8); PG8_WAIT_L(0); PG8_BAR; PG8_MMA(1, 0, At, B0); PG8_MMA(1, 1, At, B1); PG8_BAR; PG8_SCHED;
            PG8_LDB(B0, 1, 0); PG8_LDB(B1, 1, 1); PG8_SCHED; PG8_LDA(At, 1, 0); PG8_STAGEA(PG8_SA(0, 1), a2, 1, w2);
            PG8_WAIT_V(8); PG8_WAIT_L(0); PG8_BAR; PG8_MMA(0, 0, At, B0); PG8_MMA(0, 1, At, B1); PG8_BAR; PG8_SCHED;
            PG8_LDA(At, 1, 1); PG8_STAGE(PG8_SB(1, 0), b3, voffB); PG8_STAGE(PG8_SB(1, 1), b3 + hstep, voffB); PG8_STAGEA(PG8_SA(1, 0), a3, 0, w2);
            PG8_WAIT_V(8); PG8_WAIT_L(0); PG8_BAR; PG8_MMA(1, 0, At, B0); PG8_MMA(1, 1, At, B1); PG8_BAR; PG8_SCHED;
        }
        if (wr == 0) PG8_BAR;
        E(acc, cur, wr, wc, fr, fq, lds);
        if (!has_next) break;
#pragma unroll
        for (int a = 0; a < 2; ++a)
#pragma unroll
            for (int b = 0; b < 2; ++b)
#pragma unroll
                for (int m = 0; m < 4; ++m)
#pragma unroll
                    for (int n = 0; n < 2; ++n) acc[a][b][m][n] = (f32x4){0.f, 0.f, 0.f, 0.f};
        cur = nxt; cA = nA; cB = nB; ++ui;
        if (GA) { _Pragma("unroll") for (int h_ = 0; h_ < 2; ++h_) _Pragma("unroll") for (int i_ = 0; i_ < 2; ++i_) voA[h_][i_] = nvA[h_][i_]; }
        if (wr == 1) PG8_BAR;
    }
    PG8_WAIT_V(0);
    PG8_BAR;
#undef PG8_AOFF
#undef PG8_STAGEA
#undef PG8_SA
#undef PG8_SB
#undef PG8_STAGE
#undef PG8_LDA
#undef PG8_LDB
#undef PG8_MMA
#undef PG8_WAIT_V
#undef PG8_WAIT_L
#undef PG8_SCHED
}
#define PG8_FOR_AM _Pragma("unroll") for (int ai = 0; ai < 2; ++ai) _Pragma("unroll") for (int m = 0; m < 4; ++m)
#define PG8_FOR_BJ _Pragma("unroll") for (int bj = 0; bj < 2; ++bj)

struct EpiInProj {
    static constexpr bool PERM = true, HAS_MID = false;
    Params p;
    __device__ __forceinline__ void operator()(f32x4 (&acc)[2][2][4][2], const Unit& u, int wr, int wc, int fr, int fq, PG8_LAS unsigned char* lds) const {
        const int pn = u.pn;
        const int sec = pn < 4 ? 0 : pn < 8 ? 1 : pn < 12 ? 2 : pn < 16 ? 3 : pn == 16 ? 4 : pn == 17 ? 5 : pn < 22 ? 6 : 7;
        const int head0 = (sec == 0 ? pn : sec == 1 ? pn - 4 : sec == 2 ? pn - 8 : sec == 3 ? pn - 12 : sec == 6 ? pn - 18 : sec == 7 ? pn - 22 : 0) * 2;
        const int cl = wc * 32 + fq * 8;
        if (sec == 3 || sec == 4) {
            PG8_LAS float* X = (PG8_LAS float*)(lds + STAGE_BYTES);
            PG8_FOR_AM { PG8_FOR_BJ { const f32x4 a = acc[ai][bj][m][0], b = acc[ai][bj][m][1];
                float ss = (a.x * a.x + a.y * a.y) + (a.z * a.z + a.w * a.w) + (b.x * b.x + b.y * b.y) + (b.z * b.z + b.w * b.w);
                ss += __shfl_xor(ss, 16); ss += __shfl_xor(ss, 32);
                if (fq == 0) X[((ai * 128 + wr * 64 + m * 16 + fr) * 2 + bj) * 4 + wc] = ss; } }
            asm volatile("s_waitcnt lgkmcnt(0)" ::: "memory"); __builtin_amdgcn_s_barrier(); asm volatile("" ::: "memory");
            const int g = wc * 4 + fq, j0 = (g & 7) * 4, e0 = (g >> 3) * 64 + j0;
            const float* gn = sec == 3 ? p.g_qnorm : p.g_knorm;
            const f32x4 g1 = *(const f32x4*)(gn + e0), g2 = *(const f32x4*)(gn + e0 + 32);
            const float sc = sec == 3 ? CB : 1.f;
            const float2* rope = (const float2*)(p.ws + OFF_ROPE);
            PG8_FOR_AM { const int rl = ai * 128 + wr * 64 + m * 16 + fr, grow = u.pm * BM + rl; RowInfo ri; if (u.pm < MREAL / BM) { ri.b = u.pm >> 5; ri.t = grow & (SEQ - 1); ri.meta = 0; ri.valid = 1; } else ri = row_decode(grow);
                f32x4 c4 = (f32x4){1.f, 1.f, 1.f, 1.f}, s4 = (f32x4){0.f, 0.f, 0.f, 0.f};
                if (!ri.meta) { const int pos = (g >> 3) ? (ri.t & 63) : (ri.t >> 6); const f32x4 t0 = *(const f32x4*)(rope + pos * 32 + j0), t1 = *(const f32x4*)(rope + pos * 32 + j0 + 2);
                    c4 = (f32x4){t0.x, t0.z, t1.x, t1.z}; s4 = (f32x4){t0.y, t0.w, t1.y, t1.w}; }
                PG8_FOR_BJ { const f32x4 pq = *(const PG8_LAS f32x4*)(X + (rl * 2 + bj) * 4);
                    const float rstd = __builtin_amdgcn_rsqf(((pq.x + pq.y) + (pq.z + pq.w)) * (1.0f / 128.f) + EPS) * sc;
                    const f32x4 x1 = acc[ai][bj][m][0] * g1 * rstd, x2 = acc[ai][bj][m][1] * g2 * rstd;
                    const f32x4 y1 = x1 * c4 - x2 * s4, y2 = x2 * c4 + x1 * s4;
                    if (ri.valid) { const int head = head0 + bj;
                        bf16_t *d1, *d2;
                        if (sec == 3) { d1 = (bf16_t*)(p.ws + OFF_QB) + ((size_t)(ri.b * 8 + head) * QROWS + row_q(ri)) * 128 + e0; d2 = d1 + 32; }
                        else { bf16_t* kb_ = (bf16_t*)(p.ws + OFF_KB) + (size_t)(ri.b * 2 + head) * KEYS * 128; const int kk = row_key(ri); d1 = kb_ + k_img(kk, e0); d2 = kb_ + k_img(kk, e0 + 32); }
                        *(u32x2*)d1 = (u32x2){cvt_pk_bf16(y1.x, y1.y), cvt_pk_bf16(y1.z, y1.w)};
                        *(u32x2*)d2 = (u32x2){cvt_pk_bf16(y2.x, y2.y), cvt_pk_bf16(y2.z, y2.w)}; } } }
            return;
        }
        if (sec <= 1) {
            const float sc2 = sec == 0 ? CA * CA : 1.f; float mx[2] = {0.f, 0.f};
            PG8_FOR_AM { PG8_FOR_BJ { const f32x4 a = acc[ai][bj][m][0], b = acc[ai][bj][m][1];
                float ss = (a.x * a.x + a.y * a.y) + (a.z * a.z + a.w * a.w) + (b.x * b.x + b.y * b.y) + (b.z * b.z + b.w * b.w);
                ss += __shfl_xor(ss, 16); ss += __shfl_xor(ss, 32); mx[bj] = fmaxf(mx[bj], ss * sc2); } }
            PG8_FOR_BJ { float v = mx[bj]; v = fmaxf(v, __shfl_xor(v, 1)); v = fmaxf(v, __shfl_xor(v, 2)); v = fmaxf(v, __shfl_xor(v, 4)); v = fmaxf(v, __shfl_xor(v, 8));
                if (fr == 0 && fq == 0) { unsigned* nw = (unsigned*)(p.ws + OFF_NRM) + (sec * 2 * 8 + head0 + bj) * 4 + wc;
                    if (u.pm < MREAL / BM) atomicMax(nw + (u.pm >> 5) * 32, __float_as_uint(v)); else { atomicMax(nw, __float_as_uint(v)); atomicMax(nw + 32, __float_as_uint(v)); } } }
        }
        PG8_FOR_AM { const int grow = u.pm * BM + ai * 128 + wr * 64 + m * 16 + fr; RowInfo ri; if (u.pm < MREAL / BM) { ri.b = u.pm >> 5; ri.t = grow & (SEQ - 1); ri.meta = 0; ri.valid = 1; } else ri = row_decode(grow);
            if (!ri.valid) continue;
            PG8_FOR_BJ { const int head = head0 + bj; f32x4 a = acc[ai][bj][m][0], b = acc[ai][bj][m][1]; bf16_t* dst;
                if (sec == 0) { dst = (bf16_t*)(p.ws + OFF_QA) + ((size_t)(ri.b * 8 + head) * QROWS + row_q(ri)) * 128 + cl; a = a * CA; b = b * CA; }
                else if (sec == 1) dst = (bf16_t*)(p.ws + OFF_KA) + (size_t)(ri.b * 8 + head) * KEYS * 128 + k_img(row_key(ri), cl);
                else if (sec == 2) dst = (bf16_t*)(p.ws + OFF_VA) + (size_t)(ri.b * 8 + head) * KEYS * 128 + v_img(row_key(ri), cl);
                else if (sec == 5) dst = (bf16_t*)(p.ws + OFF_VB) + (size_t)(ri.b * 2 + head) * KEYS * 128 + v_img(row_key(ri), cl);
                else { dst = (grow < MREAL ? (bf16_t*)p.out + (size_t)grow * 2048 : (bf16_t*)(p.ws + OFF_SGM) + (size_t)(grow - MREAL) * 2048) + (sec == 7 ? 1024 : 0) + head * 128 + cl;
                    a.x = fsig(a.x); a.y = fsig(a.y); a.z = fsig(a.z); a.w = fsig(a.w); b.x = fsig(b.x); b.y = fsig(b.y); b.z = fsig(b.z); b.w = fsig(b.w); }
                *(u32x4*)dst = (u32x4){cvt_pk_bf16(a.x, a.y), cvt_pk_bf16(a.z, a.w), cvt_pk_bf16(b.x, b.y), cvt_pk_bf16(b.z, b.w)}; } }
    }
};
__device__ __forceinline__ f32x4 bf4(u32x2 w) { return (f32x4){bf2f(w.x & 0xffffu), bf2f(w.x >> 16), bf2f(w.y & 0xffffu), bf2f(w.y >> 16)}; }
struct EpiMerge {
    static constexpr bool PERM = true, HAS_MID = true;
    Params p;
    __device__ __forceinline__ const bf16_t* sg(int grow) const { return grow < MREAL ? (const bf16_t*)p.out + (size_t)grow * 2048 : (const bf16_t*)(p.ws + OFF_SGM) + (size_t)(grow - MREAL) * 2048; }
    __device__ __forceinline__ void mid(f32x4 (&acc)[2][2][4][2], const Unit& u, int wr, int wc, int fr, int fq) const {
        PG8_FOR_AM { const int grow = u.pm * BM + ai * 128 + wr * 64 + m * 16 + fr; if (grow >= MROWS) continue; const bf16_t* s = sg(grow) + u.pn * BM + wc * 32 + fq * 8;
            PG8_FOR_BJ { const u32x4 wa = *(const u32x4*)(s + bj * 128), wb = *(const u32x4*)(s + 1024 + bj * 128);
                const f32x4 b0 = bf4((u32x2){wb.x, wb.y}), b1 = bf4((u32x2){wb.z, wb.w});
                const f32x4 r0 = (f32x4){__builtin_amdgcn_rcpf(b0.x), __builtin_amdgcn_rcpf(b0.y), __builtin_amdgcn_rcpf(b0.z), __builtin_amdgcn_rcpf(b0.w)};
                const f32x4 r1 = (f32x4){__builtin_amdgcn_rcpf(b1.x), __builtin_amdgcn_rcpf(b1.y), __builtin_amdgcn_rcpf(b1.z), __builtin_amdgcn_rcpf(b1.w)};
                acc[ai][bj][m][0] = acc[ai][bj][m][0] * bf4((u32x2){wa.x, wa.y}) * r0;
                acc[ai][bj][m][1] = acc[ai][bj][m][1] * bf4((u32x2){wa.z, wa.w}) * r1; } }
    }
    __device__ __forceinline__ void operator()(f32x4 (&acc)[2][2][4][2], const Unit& u, int wr, int wc, int fr, int fq, PG8_LAS unsigned char*) const {
        bf16_t* MG = (bf16_t*)(p.ws + OFF_MERGED);
        PG8_FOR_AM { const int grow = u.pm * BM + ai * 128 + wr * 64 + m * 16 + fr; if (grow >= MROWS) continue; const int col = u.pn * BM + wc * 32 + fq * 8; const bf16_t* s = sg(grow) + 1024 + col;
            PG8_FOR_BJ { const u32x4 wb = *(const u32x4*)(s + bj * 128);
                const f32x4 a = acc[ai][bj][m][0] * bf4((u32x2){wb.x, wb.y}), b = acc[ai][bj][m][1] * bf4((u32x2){wb.z, wb.w});
                *(u32x4*)(MG + (size_t)grow * DM + col + bj * 128) = (u32x4){cvt_pk_bf16(a.x, a.y), cvt_pk_bf16(a.z, a.w), cvt_pk_bf16(b.x, b.y), cvt_pk_bf16(b.z, b.w)}; } }
    }
};
struct EpiOut {
    static constexpr bool PERM = false, HAS_MID = false;
    Params p;
    __device__ __forceinline__ void operator()(f32x4 (&acc)[2][2][4][2], const Unit& u, int wr, int wc, int fr, int fq, PG8_LAS unsigned char*) const {
        PG8_FOR_AM { const int grow = u.pm * BM + ai * 128 + wr * 64 + m * 16 + fr; if (grow >= MROWS) continue; const int col = u.pn * BM + wc * 32 + fq * 4;
            const float* hr = h_row(p, grow) + col; float* o = h2_row(p, grow) + col;
            PG8_FOR_BJ {
#pragma unroll
                for (int n = 0; n < 2; ++n) *(f32x4*)(o + bj * 128 + n * 16) = *(const f32x4*)(hr + bj * 128 + n * 16) + acc[ai][bj][m][n]; } }
    }
};
struct EpiMoeUp {
    static constexpr bool PERM = true, HAS_MID = false;
    Params p;
    __device__ __forceinline__ void operator()(f32x4 (&acc)[2][2][4][2], const Unit& u, int wr, int wc, int fr, int fq, PG8_LAS unsigned char*) const {
        bf16_t* HID = (bf16_t*)(p.ws + OFF_HID);
        PG8_FOR_AM { const int s = u.pm * BM + ai * 128 + wr * 64 + m * 16 + fr; if (s >= ESLOTS) continue;
            PG8_FOR_BJ { const f32x4 gt = acc[ai][bj][m][0], up = acc[ai][bj][m][1]; const int f0 = (u.pn * BM + bj * 128 + wc * 32 + fq * 8) >> 1;
                const float h0 = gt.x * fsig(gt.x) * up.x, h1 = gt.y * fsig(gt.y) * up.y, h2 = gt.z * fsig(gt.z) * up.z, h3 = gt.w * fsig(gt.w) * up.w;
                *(u32x2*)(HID + ((size_t)u.e * ESLOTS + s) * EFF + f0) = (u32x2){cvt_pk_bf16(h0, h1), cvt_pk_bf16(h2, h3)}; } }
    }
};
struct EpiMoeDown {
    static constexpr bool PERM = true, HAS_MID = false;
    Params p;
    __device__ __forceinline__ void operator()(f32x4 (&acc)[2][2][4][2], const Unit& u, int wr, int wc, int fr, int fq, PG8_LAS unsigned char*) const {
        bf16_t* YB = (bf16_t*)(p.ws + OFF_YB); const float* SAFF = (const float*)(p.ws + OFF_SAFF);
        PG8_FOR_AM { const int s = u.pm * BM + ai * 128 + wr * 64 + m * 16 + fr; if (s >= ESLOTS) continue; const float af = SAFF[u.e * ESLOTS + s]; const int col = u.pn * BM + wc * 32 + fq * 8;
            PG8_FOR_BJ { const f32x4 a = acc[ai][bj][m][0] * af, b = acc[ai][bj][m][1] * af;
                *(u32x4*)(YB + ((size_t)u.e * ESLOTS + s) * DM + col + bj * 128) = (u32x4){cvt_pk_bf16(a.x, a.y), cvt_pk_bf16(a.z, a.w), cvt_pk_bf16(b.x, b.y), cvt_pk_bf16(b.z, b.w)}; } }
    }
};
#undef PG8_BAR
}

__device__ __forceinline__ void dot8(const u32x4 w, const u32x4 a, float& acc) {
    acc = fmaf(bf2f(w.x & 0xffffu), bf2f(a.x & 0xffffu), acc); acc = fmaf(bf2f(w.x >> 16), bf2f(a.x >> 16), acc);
    acc = fmaf(bf2f(w.y & 0xffffu), bf2f(a.y & 0xffffu), acc); acc = fmaf(bf2f(w.y >> 16), bf2f(a.y >> 16), acc);
    acc = fmaf(bf2f(w.z & 0xffffu), bf2f(a.z & 0xffffu), acc); acc = fmaf(bf2f(w.z >> 16), bf2f(a.z >> 16), acc);
    acc = fmaf(bf2f(w.w & 0xffffu), bf2f(a.w & 0xffffu), acc); acc = fmaf(bf2f(w.w >> 16), bf2f(a.w >> 16), acc);
}
template <int NI>
__device__ __forceinline__ void dots4(const bf16_t* w, const bf16_t* a0, size_t apitch, int lane, float (&acc)[4]) {
#pragma unroll
    for (int i = 0; i < NI; ++i) { const int k = i * 512 + lane * 8; const u32x4 wv = *(const u32x4*)(w + k);
#pragma unroll
        for (int r = 0; r < 4; ++r) dot8(wv, *(const u32x4*)(a0 + r * apitch + k), acc[r]); }
}
__device__ __forceinline__ void phase3a_meta(const Params& p, int vb, int nvb) {
    const int tid = TID(), lane = tid & 63, wave = tid >> 6;
    const bf16_t* AO = (const bf16_t*)(p.ws + OFF_AO) + (size_t)MREAL * AOP; const bf16_t* WAB = (const bf16_t*)(p.ws + OFF_WAB);
    const bf16_t* SGM = (const bf16_t*)(p.ws + OFF_SGM); bf16_t* MG = (bf16_t*)(p.ws + OFF_MERGED) + (size_t)MREAL * DM;
    for (int t = vb * 8 + wave; t < 1024 * 8; t += nvb * 8) {
        const int c = t >> 3, r0 = (t & 7) * 4;
        float pa[4] = {0.f, 0.f, 0.f, 0.f}, pb[4] = {0.f, 0.f, 0.f, 0.f};
        dots4<2>(WAB + (size_t)c * 2048, AO + (size_t)r0 * AOP, AOP, lane, pa);
        dots4<2>(WAB + (size_t)c * 2048 + 1024, AO + (size_t)r0 * AOP + 1024, AOP, lane, pb);
#pragma unroll
        for (int r = 0; r < 4; ++r) { const float sa = bf2f(SGM[(size_t)(r0 + r) * 2048 + c]), sb = bf2f(SGM[(size_t)(r0 + r) * 2048 + 1024 + c]);
            const float y = wave_sum(sa * pa[r] + sb * pb[r]); if (lane == 0) MG[(size_t)(r0 + r) * DM + c] = (bf16_t)f2bf(y); }
    }
}
__device__ __forceinline__ void phase3b_meta(const Params& p, int vb, int nvb) {
    const int tid = TID(), lane = tid & 63, wave = tid >> 6;
    const bf16_t* MG = (const bf16_t*)(p.ws + OFF_MERGED) + (size_t)MREAL * DM; const bf16_t* WO = (const bf16_t*)(p.ws + OFF_WO); float* H2M = (float*)(p.ws + OFF_H2M);
    for (int t = vb * 8 + wave; t < 1024 * 8; t += nvb * 8) {
        const int c = t >> 3, r0 = (t & 7) * 4;
        float pa[4] = {0.f, 0.f, 0.f, 0.f};
        dots4<2>(WO + (size_t)c * DM, MG + (size_t)r0 * DM, DM, lane, pa);
#pragma unroll
        for (int r = 0; r < 4; ++r) { const float y = wave_sum(pa[r]); if (lane == 0) H2M[(size_t)(r0 + r) * DM + c] = p.meta[(size_t)((r0 + r) & 15) * DM + c] + y; }
    }
}
__device__ __forceinline__ void phase5a_tail(const Params& p, unsigned char* lds, int vb, int nvb) {
    const int tid = TID(), lane = tid & 63, wave = tid >> 6;
    const bf16_t* U2 = (const bf16_t*)(p.ws + OFF_UN); const int* IDX = (const int*)(p.ws + OFF_IDX); const bf16_t* WGU = (const bf16_t*)(p.ws + OFF_WGU); bf16_t* HID = (bf16_t*)(p.ws + OFF_HID);
    const int stride = nvb * 8;
    for (int tb = vb * 8; tb < NEXP * EFF; tb += 4 * stride) {
        int tok[4];
#pragma unroll
        for (int k = 0; k < 4; ++k) { const int tk = tb + k * stride; tok[k] = tk < NEXP * EFF ? IDX[((size_t)1 * NEXP + (tk >> 9)) * CAP + (2048 - CAP) + (tid >> 7)] : 0; }
        u32x4 wv[4][2], uv[4][2];
#pragma unroll
        for (int k = 0; k < 4; ++k) { const int t = tb + wave + k * stride; const int tt = t < NEXP * EFF ? t : tb + wave; const int e = tt >> 9, f = tt & 511;
            const bf16_t* wg = WGU + ((size_t)e * DM + 8 * (f >> 2) + (f & 3)) * DM;
#pragma unroll
            for (int i = 0; i < 2; ++i) { const int kk = i * 512 + lane * 8; wv[k][i] = *(const u32x4*)(wg + kk); uv[k][i] = *(const u32x4*)(wg + 4 * DM + kk); } }
#pragma unroll
        for (int k = 0; k < 4; ++k) *(u32x4*)(lds + k * 8192 + tid * 16) = *(const u32x4*)(U2 + (size_t)pos_row(1, tok[k]) * DM + (tid & 127) * 8);
        __syncthreads();
#pragma unroll
        for (int k = 0; k < 4; ++k) { const int t = tb + wave + k * stride; if (t >= NEXP * EFF) continue; const int e = t >> 9, f = t & 511;
            float pg[4] = {0.f, 0.f, 0.f, 0.f}, pu[4] = {0.f, 0.f, 0.f, 0.f};
#pragma unroll
            for (int i = 0; i < 2; ++i)
#pragma unroll
                for (int r = 0; r < 4; ++r) { const u32x4 a = *(const u32x4*)(lds + k * 8192 + r * 2048 + (i * 512 + lane * 8) * 2); dot8(wv[k][i], a, pg[r]); dot8(uv[k][i], a, pu[r]); }
            const size_t s0 = (size_t)e * ESLOTS + 2048;
#pragma unroll
            for (int r = 0; r < 4; ++r) { const float g = wave_sum(pg[r]), u = wave_sum(pu[r]); if (lane == 0) HID[(s0 + r) * EFF + f] = (bf16_t)f2bf(g * pg8::fsig(g) * u); } }
        __syncthreads();
    }
}
__device__ __forceinline__ void phase5b_tail(const Params& p, unsigned char* lds, int vb, int nvb) {
    const int tid = TID(), lane = tid & 63, wave = tid >> 6;
    const bf16_t* HID = (const bf16_t*)(p.ws + OFF_HID); const bf16_t* WD = (const bf16_t*)(p.ws + OFF_WD); bf16_t* YB = (bf16_t*)(p.ws + OFF_YB); const float* SAFF = (const float*)(p.ws + OFF_SAFF);
    const int stride = nvb * 8;
    for (int tb = vb * 8; tb < NEXP * DM; tb += 8 * stride) {
        u32x4 wv[8];
#pragma unroll
        for (int k = 0; k < 8; ++k) { const int t = tb + wave + k * stride; const int tt = t < NEXP * DM ? t : tb + wave; wv[k] = *(const u32x4*)(WD + (size_t)tt * EFF + lane * 8); }
#pragma unroll
        for (int j = 0; j < 4; ++j) { const int k = 2 * j + (tid >> 8); const int tk = tb + k * stride; const int e = tk < NEXP * DM ? (tk >> 10) : 0;
            *(u32x4*)(lds + k * 4096 + (tid & 255) * 16) = *(const u32x4*)(HID + ((size_t)e * ESLOTS + 2048) * EFF + (tid & 255) * 8); }
        __syncthreads();
#pragma unroll
        for (int k = 0; k < 8; ++k) { const int t = tb + wave + k * stride; if (t >= NEXP * DM) continue; const int e = t >> 10, c = t & 1023;
            float pa[4] = {0.f, 0.f, 0.f, 0.f};
#pragma unroll
            for (int r = 0; r < 4; ++r) dot8(wv[k], *(const u32x4*)(lds + k * 4096 + r * 1024 + lane * 16), pa[r]);
            const size_t s0 = (size_t)e * ESLOTS + 2048;
#pragma unroll
            for (int r = 0; r < 4; ++r) { const float y = wave_sum(pa[r]); if (lane == 0) YB[(s0 + r) * DM + c] = (bf16_t)f2bf(y * SAFF[s0 + r]); } }
        __syncthreads();
    }
}

__device__ __forceinline__ void phase1_fast(const Params& p, unsigned char* lds_raw, int vb, int nvb) {
    pg8::Gemm g{(const bf16_t*)(p.ws + OFF_UN), (const bf16_t*)(p.ws + OFF_WIN), DM};
    pg8::GridOrder S; S.init(MPAD / 256, INW / 256, nvb, vb);
    pg8::EpiInProj E{p};
    pg8::gemm_phase(( __attribute__((address_space(3))) unsigned char*)lds_raw, g, S, E);
}
__device__ __forceinline__ void phase3a_fast(const Params& p, unsigned char* lds_raw, int vb, int nvb) {
    phase3a_meta(p, vb, nvb);
    pg8::Gemm g{(const bf16_t*)(p.ws + OFF_AO), (const bf16_t*)(p.ws + OFF_WAB), 2048};
    pg8::GridOrder S; S.init(MREAL / 256, DM / 256, nvb, vb);
    pg8::EpiMerge E{p};
    pg8::gemm_phase(( __attribute__((address_space(3))) unsigned char*)lds_raw, g, S, E);
}
__device__ __forceinline__ void phase3b_fast(const Params& p, unsigned char* lds_raw, int vb, int nvb) {
    phase3b_meta(p, vb, nvb);
    pg8::Gemm g{(const bf16_t*)(p.ws + OFF_MERGED), (const bf16_t*)(p.ws + OFF_WO), DM};
    pg8::GridOrder S; S.init(MREAL / 256, DM / 256, nvb, vb);
    pg8::EpiOut E{p};
    pg8::gemm_phase(( __attribute__((address_space(3))) unsigned char*)lds_raw, g, S, E);
}
__device__ __forceinline__ void phase5a_fast(const Params& p, unsigned char* lds_raw, int vb, int nvb) {
    phase5a_tail(p, lds_raw, vb, nvb);
    pg8::Gemm g{(const bf16_t*)(p.ws + OFF_UN), (const bf16_t*)(p.ws + OFF_WGU), DM};
    pg8::MoeOrderT<true> S{nvb, vb, (const int*)(p.ws + OFF_IDX)};
    pg8::EpiMoeUp E{p};
    pg8::gemm_phase(( __attribute__((address_space(3))) unsigned char*)lds_raw, g, S, E);
}
__device__ __forceinline__ void phase5b_fast(const Params& p, unsigned char* lds_raw, int vb, int nvb) {
    phase5b_tail(p, lds_raw, vb, nvb);
    pg8::Gemm g{(const bf16_t*)(p.ws + OFF_HID), (const bf16_t*)(p.ws + OFF_WD), EFF};
    pg8::MoeOrderT<false> S{nvb, vb, nullptr};
    pg8::EpiMoeDown E{p};
    pg8::gemm_phase(( __attribute__((address_space(3))) unsigned char*)lds_raw, g, S, E);
}

__device__ __forceinline__ void phase4b_fast(const Params& p, float* lds, int vb, int nvb) {
    const int tid = TID(), lane = tid & 63, wave = tid >> 6;
    constexpr int NBE = NB * NEXP;
    if (vb >= NBE || nvb <= NBE) { const bool small = nvb <= NBE; transpose_moe(p, lds, small ? vb : vb - NBE, small ? nvb : nvb - NBE); if (!small) return; }
    const float* AFF = (const float*)(p.ws + OFF_AFF); int* IDX = (int*)(p.ws + OFF_IDX); int* SEL = (int*)(p.ws + OFF_SEL); float* SAFF = (float*)(p.ws + OFF_SAFF);
    unsigned* keys = (unsigned*)lds;
    unsigned* hist = keys + 8448;
    unsigned* sh = hist + 256;
    for (int be = vb; be < NBE; be += nvb) {
        const int b = be / NEXP, e = be % NEXP;
        __syncthreads();
        for (int i = tid; i < LTOT; i += NTHREADS) keys[i] = __float_as_uint(AFF[(size_t)be * LTOT + i]);
        if (tid == 0) { sh[0] = 0u; sh[1] = CAP; }
        __syncthreads();
        for (int pass = 0; pass < 4; ++pass) {
            const int shift = 24 - 8 * pass;
            if (tid < 256) hist[tid] = 0u;
            __syncthreads();
            const unsigned prefix = sh[0], pmask = pass == 0 ? 0u : (0xffffffffu << (shift + 8));
            if (pass == 0) {
                for (int i0 = 0; i0 < LTOT; i0 += NTHREADS) { const int i = i0 + tid; const bool in = i < LTOT; const unsigned dg = in ? (keys[i] >> 24) : 0xffffffffu;
                    unsigned long long todo = __ballot(in);
                    while (todo) { const int src = __builtin_ctzll(todo); const unsigned d = (unsigned)__builtin_amdgcn_readlane((int)dg, src);
                        const unsigned long long same = __ballot(dg == d); if (lane == src) atomicAdd(&hist[d & 255u], (unsigned)__builtin_popcountll(same)); todo &= ~same; } }
            } else
            for (int i = tid; i < LTOT; i += NTHREADS) { const unsigned k = keys[i]; if ((k & pmask) == prefix) atomicAdd(&hist[(k >> shift) & 255u], 1u); }
            __syncthreads();
            if (wave == 0) {
                const unsigned rem = sh[1]; const unsigned c0 = hist[4 * lane], c1 = hist[4 * lane + 1], c2 = hist[4 * lane + 2], c3 = hist[4 * lane + 3];
                const unsigned t = c0 + c1 + c2 + c3; unsigned S = t;
#pragma unroll
                for (int o = 1; o < 64; o <<= 1) { const unsigned v = __shfl_down(S, o); if (lane + o < 64) S += v; }
                const unsigned above = S - t;
                if (S >= rem && above < rem) { unsigned d, r = rem - above;
                    if (c3 >= r) d = 3; else { r -= c3; if (c2 >= r) d = 2; else { r -= c2; if (c1 >= r) d = 1; else { r -= c1; d = 0; } } }
                    sh[0] = prefix | ((4u * lane + d) << shift); sh[1] = r; }
            }
            __syncthreads();
        }
        const unsigned T = sh[0], need_eq = sh[1];
        const int t0 = tid * 17; int cnt_gt = 0, cnt_eq = 0;
        for (int i = 0; i < 17; ++i) { const int tok = t0 + i; if (tok < LTOT) { const unsigned k = keys[tok]; cnt_gt += k > T; cnt_eq += k == T; } }
        int incl = cnt_eq;
#pragma unroll
        for (int o = 1; o < 64; o <<= 1) { const int v = __shfl_up(incl, o); if (lane >= o) incl += v; }
        if (lane == 63) sh[8 + wave] = (unsigned)incl;
        __syncthreads();
        int eq_before = incl - cnt_eq; for (int w = 0; w < wave; ++w) eq_before += (int)sh[8 + w];
        __syncthreads();
        int take_eq = (int)need_eq - eq_before; take_eq = take_eq < 0 ? 0 : (take_eq > cnt_eq ? cnt_eq : take_eq);
        const int mysel = cnt_gt + take_eq;
        incl = mysel;
#pragma unroll
        for (int o = 1; o < 64; o <<= 1) { const int v = __shfl_up(incl, o); if (lane >= o) incl += v; }
        if (lane == 63) sh[8 + wave] = (unsigned)incl;
        __syncthreads();
        int slot = incl - mysel; for (int w = 0; w < wave; ++w) slot += (int)sh[8 + w];
        int eqi = eq_before;
        for (int i = 0; i < 17; ++i) { const int tok = t0 + i; if (tok < LTOT) { const unsigned k = keys[tok];
            bool take = k > T; if (k == T) { take = eqi < (int)need_eq; ++eqi; }
            if (take) { IDX[(size_t)be * CAP + slot] = tok; SEL[((size_t)b * LTOT + tok) * NEXP + e] = slot; SAFF[(size_t)e * ESLOTS + b * CAP + slot] = __uint_as_float(k); ++slot; } else SEL[((size_t)b * LTOT + tok) * NEXP + e] = -1; } }
    }
    __syncthreads();
}
#define LAS __attribute__((address_space(3)))
#define XB_TMO      128
#define XB_XCNT(j)  (256  + 64 * (j))
#define XB_XSUB(j)  (1280 + 64 * (j))
#define XB_XGEN(j)  (2304 + 64 * (j))
#define XB_TOP      3328
#define XB_TOPGEN   3392
#define XB_SPIN_CAP (1u << 22)
__device__ __forceinline__ unsigned xb_ld(unsigned* p)              { return __hip_atomic_load(p, __ATOMIC_RELAXED, __HIP_MEMORY_SCOPE_AGENT); }
__device__ __forceinline__ unsigned xb_add(unsigned* p, unsigned v) { return __hip_atomic_fetch_add(p, v, __ATOMIC_RELAXED, __HIP_MEMORY_SCOPE_AGENT); }
__device__ __forceinline__ unsigned xb_xcc_id() { return (unsigned)__builtin_amdgcn_s_getreg((3 << 11) | 20) & 0xFu; }
#define XB_SPIN(cond, bar) do { unsigned _sp = 0; while (cond) { __builtin_amdgcn_s_sleep(1); \
    if ((++_sp & 255u) == 0u) { if (xb_ld(&(bar)[XB_TMO])) break; if (_sp > XB_SPIN_CAP) { atomicAdd(&(bar)[XB_TMO], 1u); break; } } } } while (0)
struct XcdBarrier { unsigned* bar; unsigned x; volatile LAS unsigned* st; };
__device__ __forceinline__ XcdBarrier xcd_barrier_post(unsigned* bar, volatile LAS unsigned* st) {
    XcdBarrier b; b.bar = bar; b.x = xb_xcc_id(); b.st = st;
    if (threadIdx.x == 0) (void)xb_add(&bar[XB_XCNT(b.x)], 1u);
    return b;
}
__device__ __forceinline__ void xcd_barrier_complete(unsigned* bar, unsigned x, unsigned& nloc, unsigned& nx) {
    const unsigned G = gridDim.x * gridDim.y * gridDim.z;
    unsigned sum, cnt, mine, sp = 0u;
    for (;;) {
        sum = 0u; cnt = 0u; mine = 0u;
#pragma unroll
        for (unsigned j = 0; j < 16; ++j) { const unsigned c = xb_ld(&bar[XB_XCNT(j)]); sum += c; cnt += (c > 0u) ? 1u : 0u; mine = (j == x) ? c : mine; }
        if (sum == G) break;
        __builtin_amdgcn_s_sleep(1);
        if ((++sp & 255u) == 0u) { if (xb_ld(&bar[XB_TMO])) break; if (sp > XB_SPIN_CAP) { atomicAdd(&bar[XB_TMO], 1u); break; } }
    }
    nloc = mine > 0u ? mine : 1u; nx = cnt > 0u ? cnt : 1u;
}
__device__ __forceinline__ void xcd_barrier(const XcdBarrier& b) {
    asm volatile("s_waitcnt vmcnt(0)" ::: "memory");
    __syncthreads();
    if (threadIdx.x == 0) {
        unsigned* bar = b.bar;
        __builtin_amdgcn_s_waitcnt(0);
        unsigned nloc = b.st[0], nx = b.st[1];
        if (nloc == 0u) { xcd_barrier_complete(bar, b.x, nloc, nx); b.st[0] = nloc; b.st[1] = nx; }
        const unsigned old = xb_add(&bar[XB_XSUB(b.x)], 1u);
        const unsigned gen = old / nloc;
        if (old + 1u == (gen + 1u) * nloc) {
            __builtin_amdgcn_fence(__ATOMIC_RELEASE, "agent");
            asm volatile("s_waitcnt vmcnt(0)" ::: "memory");
            const unsigned og = xb_add(&bar[XB_TOP], 1u);
            const unsigned tg = og / nx;
            if (og + 1u == (tg + 1u) * nx) xb_add(&bar[XB_TOPGEN], 1u);
            else XB_SPIN(xb_ld(&bar[XB_TOPGEN]) == tg, bar);
            __builtin_amdgcn_fence(__ATOMIC_ACQUIRE, "agent");
            xb_add(&bar[XB_XGEN(b.x)], 1u);
            asm volatile("s_waitcnt vmcnt(0)" ::: "memory");
        } else {
            XB_SPIN(xb_ld(&bar[XB_XGEN(b.x)]) == gen, bar);
            __builtin_amdgcn_fence(__ATOMIC_ACQUIRE, "agent");
            asm volatile("s_waitcnt vmcnt(0)" ::: "memory");
        }
    }
    __syncthreads();
}

constexpr int LDS_BYTES = 147456;
constexpr int LDS_BARST = LDS_BYTES - 64;
#if defined(__HIP_DEVICE_COMPILE__)
#define PHASE_PARAMS() ({ const __attribute__((address_space(4))) Params* q_ = (const __attribute__((address_space(4))) Params*)__builtin_amdgcn_kernarg_segment_ptr(); asm volatile("" : "+s"(q_)); *q_; })
#else
#define PHASE_PARAMS() (pk)
#endif
#define PHASE(call) do { const Params p = PHASE_PARAMS(); call; } while (0)
__global__ void __launch_bounds__(NTHREADS, 2) fwd_kernel(Params pk) {
    extern __shared__ __attribute__((aligned(16))) unsigned char lds_raw[];
    float* lds = (float*)lds_raw;
    cg::grid_group grid = cg::this_grid();
    const int vb = blockIdx.x, nvb = gridDim.x;
    if (threadIdx.x < 16) ((LAS unsigned*)(lds_raw + LDS_BARST))[threadIdx.x] = 0u;
    __syncthreads();
    const XcdBarrier bar = xcd_barrier_post((unsigned*)(pk.ws + OFF_CTL), (volatile LAS unsigned*)(lds_raw + LDS_BARST));
#define GRID_BAR() xcd_barrier(bar)
    PHASE(phase0(p, vb, nvb));
    PHASE(transpose_p0(p, lds, vb, nvb));
    GRID_BAR();
    if (nvb > (1 << 24)) grid.sync();
    PHASE(phase1_fast(p, lds_raw, vb, nvb));
    GRID_BAR();
    PHASE(phase2_fast(p, (char*)lds_raw, vb, nvb));
    GRID_BAR();
    PHASE(phase3a_fast(p, lds_raw, vb, nvb));
    GRID_BAR();
    PHASE(phase3b_fast(p, lds_raw, vb, nvb));
    GRID_BAR();
    PHASE(phase4a(p, lds, vb, nvb));
    GRID_BAR();
    PHASE(phase4b_fast(p, lds, vb, nvb));
    GRID_BAR();
    PHASE(phase5a_fast(p, lds_raw, vb, nvb));
    GRID_BAR();
    PHASE(phase5b_fast(p, lds_raw, vb, nvb));
    GRID_BAR();
    PHASE(phase6(p, vb, nvb));
}

extern "C" void kernel_launch(void* const* d_in, const int* in_sizes, int n_in, void* d_out, int out_size, void* d_ws, size_t ws_size, hipStream_t stream) {
    static int grid_blocks = 0;
    if (grid_blocks == 0) {
        if (n_in != 20 || in_sizes[0] != MREAL * DM || out_size != MREAL * DM || ws_size < 256 * MiB) {
            fprintf(stderr, "kernel_launch: unexpected shapes: n_in %d in0 %d out %d ws %zu\n", n_in, n_in > 0 ? in_sizes[0] : -1, out_size, ws_size); grid_blocks = -1; return; }
        int dev = 0, cus = 0, per_cu = 0;
        (void)hipGetDevice(&dev); (void)hipDeviceGetAttribute(&cus, hipDeviceAttributeMultiprocessorCount, dev);
        if (hipFuncSetAttribute((const void*)fwd_kernel, hipFuncAttributeMaxDynamicSharedMemorySize, LDS_BYTES) != hipSuccess) { fprintf(stderr, "kernel_launch: hipFuncSetAttribute failed\n"); grid_blocks = -1; return; }
        if (hipOccupancyMaxActiveBlocksPerMultiprocessor(&per_cu, (const void*)fwd_kernel, NTHREADS, LDS_BYTES) != hipSuccess || per_cu < 1) { fprintf(stderr, "kernel_launch: occupancy query failed (%d)\n", per_cu); grid_blocks = -1; return; }
        grid_blocks = cus * per_cu;
    }
    if (grid_blocks < 0) return;
    if (hipMemsetAsync((char*)d_ws + OFF_CTL, 0, CTL_WORDS * 4, stream) != hipSuccess) { fprintf(stderr, "kernel_launch: memset failed\n"); return; }
    Params p{};
    p.x = (const float*)d_in[0]; p.meta = (const float*)d_in[1]; p.g_mix = (const float*)d_in[2]; p.w_in = (const float*)d_in[3];
    p.lq1 = (const float*)d_in[4]; p.lk1 = (const float*)d_in[5]; p.lq2 = (const float*)d_in[6]; p.lk2 = (const float*)d_in[7];
    p.g_subln = (const float*)d_in[8]; p.g_qnorm = (const float*)d_in[9]; p.g_knorm = (const float*)d_in[10];
    p.w_ba = (const float*)d_in[11]; p.w_bb = (const float*)d_in[12]; p.w_out = (const float*)d_in[13]; p.g_ffn = (const float*)d_in[14];
    p.w_router = (const float*)d_in[15]; p.w_gate = (const float*)d_in[16]; p.w_up = (const float*)d_in[17]; p.w_down = (const float*)d_in[18]; p.g_final = (const float*)d_in[19];
    p.out = (float*)d_out; p.ws = (unsigned char*)d_ws;
    void* args[] = {&p};
    hipError_t e = hipLaunchCooperativeKernel((const void*)fwd_kernel, dim3(grid_blocks), dim3(NTHREADS), args, LDS_BYTES, stream);
    if (e != hipSuccess) fprintf(stderr, "kernel_launch: cooperative launch failed: %s (grid %d)\n", hipGetErrorString(e), grid_blocks);
}
```
